# Optimizing an MI355X kernel written in HIP

```python
import math
import jax, jax.numpy as jnp
from jax import lax
import numpy as np

D_MODEL = 1024
BATCH = 8
SEQ = 2048
DEPTH = 4

MIX_WIDTH = D_MODEL
N_MIXERS = 4
GROUP_WIDTH = MIX_WIDTH // N_MIXERS
ATT_HEADS = 4
ATT_V_DIM = GROUP_WIDTH // ATT_HEADS
ATT_QK_DIM = ATT_V_DIM // 2
Q_BLOCK = 128
NUM_BUCKETS = 32
MAX_DISTANCE = 128
CONF_WIDTH = 31
SCONV_WIDTH = 3
SGU_HEADS = 4
SGU_HEAD_DIM = GROUP_WIDTH // SGU_HEADS
SGU_CHUNK = 128
PEER_HEADS = 8
PEER_NKEYS = 128
PEER_EXPERTS = PEER_NKEYS * PEER_NKEYS
PEER_TOPK = 16
PEER_QDIM = 256
PEER_HALF = PEER_QDIM // 2
PEER_TOK_BLOCK = 128
N_IN_SLICES = 10
MIX_IN = N_IN_SLICES * GROUP_WIDTH
N_MOD = 6
EPS = 1e-6
NEG_INF = -1e30

kernel_name = 'hybrid_diffattn_conv_sgu_peer'


def rms_norm(x, g):
    xf = x.astype(jnp.float32)
    y = xf * lax.rsqrt(jnp.mean(xf * xf, axis=-1, keepdims=True) + EPS)
    return (y * g.astype(jnp.float32)).astype(x.dtype)


def layer_norm(x, g, b):
    xf = x.astype(jnp.float32)
    mu = jnp.mean(xf, axis=-1, keepdims=True)
    var = jnp.mean(jnp.square(xf - mu), axis=-1, keepdims=True)
    y = (xf - mu) * lax.rsqrt(var + EPS)
    return (y * g.astype(jnp.float32) + b.astype(jnp.float32)).astype(x.dtype)


def causal_depthwise_conv(x, w):
    k, ch = w.shape
    return lax.conv_general_dilated(
        x, w[:, None, :].astype(x.dtype), window_strides=(1,), padding=[(k - 1, 0)],
        dimension_numbers=('NWC', 'WIO', 'NWC'), feature_group_count=ch)


def rel_bucket(rel):
    n = jnp.maximum(rel, 0)
    max_exact = NUM_BUCKETS // 2
    ratio = jnp.log(jnp.maximum(n, 1).astype(jnp.float32) / max_exact) / math.log(MAX_DISTANCE / max_exact)
    large = jnp.minimum(max_exact + (ratio * (NUM_BUCKETS - max_exact)).astype(jnp.int32), NUM_BUCKETS - 1)
    return jnp.where(n < max_exact, n, large)


def diff_attention(q, k, v, rel_bias, lam, subln_g, lam_init):
    b, s = q.shape[:2]
    scale = ATT_QK_DIM ** -0.5
    outs = []
    for i in range(s // Q_BLOCK):
        q0 = i * Q_BLOCK
        end = q0 + Q_BLOCK
        logits = jnp.einsum('bqhmd,bkhmd->bhmqk', q[:, q0:end], k[:, :end]).astype(jnp.float32) * scale
        rel = (q0 + jnp.arange(Q_BLOCK))[:, None] - jnp.arange(end)[None, :]
        bias = rel_bias[rel_bucket(rel)].astype(jnp.float32)
        logits = logits + jnp.transpose(bias, (2, 0, 1))[None, :, None]
        logits = jnp.where(rel >= 0, logits, NEG_INF)
        p = jax.nn.softmax(logits, axis=-1)
        w = (p[:, :, 0] - lam * p[:, :, 1]).astype(v.dtype)
        outs.append(jnp.einsum('bhqk,bkhd->bqhd', w, v[:, :end]))
    o = jnp.concatenate(outs, axis=1)
    o = rms_norm(o, subln_g) * (1.0 - lam_init)
    return o.reshape(b, s, ATT_HEADS * ATT_V_DIM)


def spatial_gating(u, v, ln_g, ln_b, w_s, b_s):
    b, s, _ = v.shape
    v = layer_norm(v, ln_g, ln_b).reshape(b, s // SGU_CHUNK, SGU_CHUNK, SGU_HEADS, SGU_HEAD_DIM)
    w = jnp.tril(w_s)
    z = jnp.einsum('hts,bcshd->bcthd', w, v) + jnp.transpose(b_s)[:, :, None]
    return u * z.reshape(b, s, GROUP_WIDTH)


def hybrid_mixer(h, w_in, w_out, lam_par, subln_g, conf_dw, conf_ln_g, conf_ln_b, sconv_w,
                 sgu_ln_g, sgu_ln_b, sgu_w, sgu_b, rel_bias, lam_init):
    b, s, _ = h.shape
    q, k, v, ga, gb, cb, cc, ch, su, sv = jnp.split(h @ w_in, N_IN_SLICES, axis=-1)
    lp = lam_par.astype(jnp.float32)
    lam = jnp.exp(jnp.sum(lp[0] * lp[1])) - jnp.exp(jnp.sum(lp[2] * lp[3])) + lam_init
    y_a = diff_attention(q.reshape(b, s, ATT_HEADS, 2, ATT_QK_DIM),
                         k.reshape(b, s, ATT_HEADS, 2, ATT_QK_DIM),
                         v.reshape(b, s, ATT_HEADS, ATT_V_DIM), rel_bias, lam, subln_g, lam_init)
    z = causal_depthwise_conv(ga * jax.nn.sigmoid(gb), conf_dw)
    y_b = jax.nn.silu(layer_norm(z, conf_ln_g, conf_ln_b))
    y_c = cb * causal_depthwise_conv(cc * ch, sconv_w)
    y_d = spatial_gating(jax.nn.gelu(su, approximate=False), jax.nn.gelu(sv, approximate=False),
                         sgu_ln_g, sgu_ln_b, sgu_w, sgu_b)
    return jnp.concatenate([y_a, y_b, y_c, y_d], axis=-1) @ w_out


def peer_ffn(h, wq, keys, u_tab, v_tab):
    b, s, d = h.shape
    q = (h @ wq).reshape(b, s, PEER_HEADS, 2, PEER_HALF)
    sc = jnp.einsum('bshpd,hpnd->bshpn', q, keys).astype(jnp.float32)
    half_s, half_i = lax.top_k(sc, PEER_TOPK)
    cand = (half_s[..., 0, :, None] + half_s[..., 1, None, :]).reshape(b, s, PEER_HEADS, PEER_TOPK * PEER_TOPK)
    top_s, top_c = lax.top_k(cand, PEER_TOPK)
    i1 = jnp.take_along_axis(half_i[..., 0, :], top_c // PEER_TOPK, axis=-1)
    i2 = jnp.take_along_axis(half_i[..., 1, :], top_c % PEER_TOPK, axis=-1)
    expert = i1 * PEER_NKEYS + i2
    gate = jax.nn.softmax(top_s, axis=-1).astype(h.dtype)
    n_blk = (b * s) // PEER_TOK_BLOCK

    def block(args):
        hb, eb, gb = args
        act = jax.nn.gelu(jnp.einsum('td,thkd->thk', hb, u_tab[eb]), approximate=False)
        return jnp.einsum('thk,thkd->td', gb * act, v_tab[eb])

    y = lax.map(block, (h.reshape(n_blk, PEER_TOK_BLOCK, d),
                        expert.reshape(n_blk, PEER_TOK_BLOCK, PEER_HEADS, PEER_TOPK),
                        gate.reshape(n_blk, PEER_TOK_BLOCK, PEER_HEADS, PEER_TOPK)))
    return y.reshape(b, s, d)


def setup_inputs(seed: int = 0) -> dict:
    key = jax.random.key(seed)
    ks = jax.random.split(key, 26)
    f32 = jnp.float32

    def nrm(k, shape, std):
        return jax.random.normal(k, shape, f32) * std

    L, D, G = DEPTH, D_MODEL, GROUP_WIDTH
    return {
        'x': nrm(ks[0], (BATCH, SEQ, D), 1.0),
        'c': nrm(ks[1], (BATCH, D), 1.0),
        'rel_bias': nrm(ks[2], (NUM_BUCKETS, ATT_HEADS), 0.5),
        'w_mod': nrm(ks[3], (L, D, N_MOD * D), 0.5 * D ** -0.5),
        'b_mod': nrm(ks[4], (L, N_MOD * D), 0.01),
        'norm1_g': 1.0 + nrm(ks[5], (L, D), 0.02),
        'norm2_g': 1.0 + nrm(ks[6], (L, D), 0.02),
        'w_in': nrm(ks[7], (L, D, MIX_IN), D ** -0.5),
        'w_out': nrm(ks[8], (L, MIX_WIDTH, D), MIX_WIDTH ** -0.5),
        'diff_lambda': nrm(ks[9], (L, 4, ATT_QK_DIM), 0.1),
        'subln_g': 1.0 + nrm(ks[10], (L, ATT_V_DIM), 0.02),
        'conf_dw': nrm(ks[11], (L, CONF_WIDTH, G), CONF_WIDTH ** -0.5),
        'conf_ln_g': 1.0 + nrm(ks[12], (L, G), 0.02),
        'conf_ln_b': nrm(ks[13], (L, G), 0.01),
        'sconv_w': nrm(ks[14], (L, SCONV_WIDTH, G), SCONV_WIDTH ** -0.5),
        'sgu_ln_g': 1.0 + nrm(ks[15], (L, G), 0.02),
        'sgu_ln_b': nrm(ks[16], (L, G), 0.01),
        'sgu_w': nrm(ks[17], (L, SGU_HEADS, SGU_CHUNK, SGU_CHUNK), SGU_CHUNK ** -0.5),
        'sgu_b': 1.0 + nrm(ks[18], (L, SGU_HEADS, SGU_CHUNK), 0.01),
        'peer_wq': nrm(ks[19], (L, D, PEER_HEADS * PEER_QDIM), D ** -0.5),
        'peer_keys': nrm(ks[20], (L, PEER_HEADS, 2, PEER_NKEYS, PEER_HALF), PEER_HALF ** -0.5),
        'peer_u': nrm(ks[21], (L, PEER_EXPERTS, D), D ** -0.5),
        'peer_v': nrm(ks[22], (L, PEER_EXPERTS, D), PEER_HEADS ** -0.5),
        'final_g': 1.0 + nrm(ks[23], (D,), 0.02),
    }


def reference(x, c, rel_bias, w_mod, b_mod, norm1_g, norm2_g, w_in, w_out, diff_lambda, subln_g,
              conf_dw, conf_ln_g, conf_ln_b, sconv_w, sgu_ln_g, sgu_ln_b, sgu_w, sgu_b,
              peer_wq, peer_keys, peer_u, peer_v, final_g):
    cond = jax.nn.silu(c)
    for l in range(DEPTH):
        lam_init = 0.8 - 0.6 * math.exp(-0.3 * l)
        mod = cond @ w_mod[l] + b_mod[l]
        sh1, sc1, g1, sh2, sc2, g2 = [m[:, None, :] for m in jnp.split(mod, N_MOD, axis=-1)]
        h = rms_norm(x, norm1_g[l]) * (1.0 + sc1) + sh1
        x = x + g1 * hybrid_mixer(h, w_in[l], w_out[l], diff_lambda[l], subln_g[l], conf_dw[l],
                                  conf_ln_g[l], conf_ln_b[l], sconv_w[l], sgu_ln_g[l], sgu_ln_b[l],
                                  sgu_w[l], sgu_b[l], rel_bias, lam_init)
        h = rms_norm(x, norm2_g[l]) * (1.0 + sc2) + sh2
        x = x + g2 * peer_ffn(h, peer_wq[l], peer_keys[l], peer_u[l], peer_v[l])
    return rms_norm(x, final_g)
```

```cpp
#include <hip/hip_runtime.h>
#include <stdint.h>

#define D_MODEL 1024
#define BATCH 8
#define SEQ 2048
#define DEPTH 4
#define NTOK (BATCH * SEQ)
#define MIX_IN 2560
#define N_MOD 6

__device__ const unsigned char kBucket[128] = {
    0, 1, 2, 3, 4, 5, 6, 7, 8, 9, 10, 11, 12, 13, 14, 15, 16, 16, 16, 17, 17, 18, 18, 18, 19, 19, 19, 20, 20, 20, 20, 21,
    21, 21, 21, 22, 22, 22, 22, 22, 23, 23, 23, 23, 23, 23, 24, 24, 24, 24, 24, 24, 25, 25, 25, 25, 25, 25, 25, 26, 26, 26, 26, 26,
    26, 26, 26, 27, 27, 27, 27, 27, 27, 27, 27, 27, 27, 28, 28, 28, 28, 28, 28, 28, 28, 28, 28, 29, 29, 29, 29, 29, 29, 29, 29, 29,
    29, 29, 29, 30, 30, 30, 30, 30, 30, 30, 30, 30, 30, 30, 30, 30, 30, 31, 31, 31, 31, 31, 31, 31, 31, 31, 31, 31, 31, 31, 31, 31};

__device__ __forceinline__ float gelu_exact(float v) { return 0.5f * v * (1.0f + erff(v * 0.70710678118654752f)); }
__device__ __forceinline__ float sigmoidf_(float v) { return 1.0f / (1.0f + __expf(-v)); }
__device__ __forceinline__ float wave_sum(float v) {
#pragma unroll
    for (int o = 32; o > 0; o >>= 1) v += __shfl_xor(v, o, 64);
    return v;
}
__device__ __forceinline__ float block_sum256(float v, float* red) {
    v = wave_sum(v);
    __syncthreads();
    if ((threadIdx.x & 63) == 0) red[threadIdx.x >> 6] = v;
    __syncthreads();
    return red[0] + red[1] + red[2] + red[3];
}

__global__ void __launch_bounds__(256) k_mod(const float* __restrict__ c, const float* __restrict__ w_mod, const float* __restrict__ b_mod, float* __restrict__ mod) {
    __shared__ float sc[BATCH][D_MODEL];
    for (int i = threadIdx.x; i < BATCH * D_MODEL; i += 256) { float v = c[i]; sc[i / D_MODEL][i % D_MODEL] = v / (1.0f + __expf(-v)); }
    __syncthreads();
    const int gj = blockIdx.x * 256 + threadIdx.x;
    const int l = gj / (N_MOD * D_MODEL), j = gj % (N_MOD * D_MODEL);
    float acc[BATCH];
#pragma unroll
    for (int b = 0; b < BATCH; ++b) acc[b] = 0.f;
    const float* w = w_mod + (size_t)l * D_MODEL * (N_MOD * D_MODEL) + j;
    for (int i = 0; i < D_MODEL; ++i) {
        const float wv = w[(size_t)i * (N_MOD * D_MODEL)];
#pragma unroll
        for (int b = 0; b < BATCH; ++b) acc[b] += sc[b][i] * wv;
    }
    const float bv = b_mod[(size_t)l * (N_MOD * D_MODEL) + j];
#pragma unroll
    for (int b = 0; b < BATCH; ++b) mod[((size_t)l * BATCH + b) * (N_MOD * D_MODEL) + j] = acc[b] + bv;
}

__global__ void __launch_bounds__(256) k_norm_mod(const float* __restrict__ x, const float* __restrict__ g, const float* __restrict__ modl  , int sh_idx, int sc_idx, float* __restrict__ out) {
    __shared__ float red[4];
    const int t = blockIdx.x, b = t / SEQ;
    const float* xr = x + (size_t)t * D_MODEL;
    float v[4]; float ss = 0.f;
#pragma unroll
    for (int r = 0; r < 4; ++r) { v[r] = xr[threadIdx.x + 256 * r]; ss += v[r] * v[r]; }
    ss = block_sum256(ss, red);
    const float rs = rsqrtf(ss * (1.0f / D_MODEL) + 1e-6f);
#pragma unroll
    for (int r = 0; r < 4; ++r) {
        const int col = threadIdx.x + 256 * r;
        float y = v[r] * rs * g[col];
        if (modl) y = y * (1.0f + modl[(size_t)b * (N_MOD * D_MODEL) + sc_idx * D_MODEL + col]) + modl[(size_t)b * (N_MOD * D_MODEL) + sh_idx * D_MODEL + col];
        out[(size_t)t * D_MODEL + col] = y;
    }
}

template <bool BT, int EPI>
__global__ void __launch_bounds__(256) k_gemm(const float* __restrict__ A, int lda, const float* __restrict__ B, int ldb, float* __restrict__ C, int ldc, int K,
                                               size_t sA, size_t sB, size_t sC, const float* __restrict__ gate) {
    __shared__ float As[16][68];
    __shared__ float Bs[16][68];
    A += blockIdx.z * sA; B += blockIdx.z * sB; C += blockIdx.z * sC;
    const int m0 = blockIdx.y * 64, n0 = blockIdx.x * 64;
    const int tx = threadIdx.x & 15, ty = threadIdx.x >> 4;
    float acc[4][4];
#pragma unroll
    for (int i = 0; i < 4; ++i)
#pragma unroll
        for (int j = 0; j < 4; ++j) acc[i][j] = 0.f;
    for (int k0 = 0; k0 < K; k0 += 16) {
#pragma unroll
        for (int r = 0; r < 4; ++r) {
            const int e = threadIdx.x + 256 * r;
            { const int mm = e >> 4, kk = e & 15; As[kk][mm] = A[(size_t)(m0 + mm) * lda + k0 + kk]; }
            if (BT) { const int nn = e >> 4, kk = e & 15; Bs[kk][nn] = B[(size_t)(n0 + nn) * ldb + k0 + kk]; }
            else    { const int kk = e >> 6, nn = e & 63; Bs[kk][nn] = B[(size_t)(k0 + kk) * ldb + n0 + nn]; }
        }
        __syncthreads();
#pragma unroll
        for (int kk = 0; kk < 16; ++kk) {
            float a[4], b[4];
#pragma unroll
            for (int i = 0; i < 4; ++i) a[i] = As[kk][ty * 4 + i];
#pragma unroll
            for (int j = 0; j < 4; ++j) b[j] = Bs[kk][tx * 4 + j];
#pragma unroll
            for (int i = 0; i < 4; ++i)
#pragma unroll
                for (int j = 0; j < 4; ++j) acc[i][j] += a[i] * b[j];
        }
        __syncthreads();
    }
#pragma unroll
    for (int i = 0; i < 4; ++i)
#pragma unroll
        for (int j = 0; j < 4; ++j) {
            const int m = m0 + ty * 4 + i, n = n0 + tx * 4 + j;
            float* cp = C + (size_t)m * ldc + n;
            if (EPI == 0) *cp = acc[i][j];
            else *cp = *cp + gate[(size_t)(m / SEQ) * (N_MOD * D_MODEL) + n] * acc[i][j];
        }
}

__global__ void __launch_bounds__(64) k_attn(const float* __restrict__ p, const float* __restrict__ rel_bias, float* __restrict__ ao) {
    const int blk = blockIdx.x, qb = blk & 31, m = (blk >> 5) & 1, h = (blk >> 6) & 3, b = blk >> 8;
    const int i = qb * 64 + threadIdx.x;
    const float scale = 0.17677669529663687f;
    const float* prow = p + (size_t)(b * SEQ + i) * MIX_IN + h * 64 + m * 32;
    float q[32], o[64];
#pragma unroll
    for (int d = 0; d < 32; ++d) q[d] = prow[d] * scale;
#pragma unroll
    for (int d = 0; d < 64; ++d) o[d] = 0.f;
    float mx = -1e30f, l = 0.f;
    const int jmax = qb * 64 + 63;
    for (int j = 0; j <= jmax; ++j) {
        const float* krow = p + (size_t)(b * SEQ + j) * MIX_IN + 256 + h * 64 + m * 32;
        const float* vrow = p + (size_t)(b * SEQ + j) * MIX_IN + 512 + h * 64;
        float s = 0.f;
#pragma unroll
        for (int d = 0; d < 32; ++d) s += q[d] * krow[d];
        const int n = i - j;
        if (n >= 0) {
            const int bk = n < 128 ? (int)kBucket[n] : 31;
            s += rel_bias[bk * 4 + h];
            const float mn = fmaxf(mx, s);
            const float corr = __expf(mx - mn), pp = __expf(s - mn);
            l = l * corr + pp;
#pragma unroll
            for (int d = 0; d < 64; ++d) o[d] = o[d] * corr + pp * vrow[d];
            mx = mn;
        }
    }
    const float inv = 1.0f / l;
    float* op = ao + ((size_t)((b * SEQ + i) * 4 + h) * 2 + m) * 64;
#pragma unroll
    for (int d = 0; d < 64; ++d) op[d] = o[d] * inv;
}

__global__ void __launch_bounds__(256) k_sgu_pre(const float* __restrict__ p, const float* __restrict__ ln_g, const float* __restrict__ ln_b, float* __restrict__ vln) {
    __shared__ float red[4];
    const int t = blockIdx.x, c = threadIdx.x;
    const float v = gelu_exact(p[(size_t)t * MIX_IN + 9 * 256 + c]);
    const float mu = block_sum256(v, red) * (1.0f / 256.0f);
    const float dv = v - mu;
    const float var = block_sum256(dv * dv, red) * (1.0f / 256.0f);
    vln[(size_t)t * 256 + c] = dv * rsqrtf(var + 1e-6f) * ln_g[c] + ln_b[c];
}

__global__ void __launch_bounds__(256) k_mixer(const float* __restrict__ p, const float* __restrict__ ao, const float* __restrict__ vln,
                                                const float* __restrict__ lam_par  , float lam_init, const float* __restrict__ subln_g,
                                                const float* __restrict__ conf_dw  , const float* __restrict__ conf_ln_g, const float* __restrict__ conf_ln_b,
                                                const float* __restrict__ sconv_w  , const float* __restrict__ sgu_w  , const float* __restrict__ sgu_b  ,
                                                float* __restrict__ cat) {
    __shared__ float red[4];
    const int t = blockIdx.x, c = threadIdx.x, s = t % SEQ;
    const float* pr = p + (size_t)t * MIX_IN;
    float d01 = 0.f, d23 = 0.f;
    for (int i = 0; i < 32; ++i) { d01 += lam_par[i] * lam_par[32 + i]; d23 += lam_par[64 + i] * lam_par[96 + i]; }
    const float lam = expf(d01) - expf(d23) + lam_init;
    {
        const int h = c >> 6, d = c & 63;
        const float* a = ao + ((size_t)(t * 4 + h) * 2) * 64;
        const float v = a[d] - lam * a[64 + d];
        const float ss = wave_sum(v * v);
        cat[(size_t)t * D_MODEL + c] = v * rsqrtf(ss * (1.0f / 64.0f) + 1e-6f) * subln_g[d] * (1.0f - lam_init);
    }
    {
        float z = 0.f;
        for (int j = 0; j < 31; ++j) {
            const int sp = s - 30 + j;
            if (sp >= 0) {
                const float* q = pr + (ptrdiff_t)(sp - s) * MIX_IN;
                z += conf_dw[j * 256 + c] * (q[3 * 256 + c] * sigmoidf_(q[4 * 256 + c]));
            }
        }
        const float mu = block_sum256(z, red) * (1.0f / 256.0f);
        const float dv = z - mu;
        const float var = block_sum256(dv * dv, red) * (1.0f / 256.0f);
        const float y = dv * rsqrtf(var + 1e-6f) * conf_ln_g[c] + conf_ln_b[c];
        cat[(size_t)t * D_MODEL + 256 + c] = y * sigmoidf_(y);
    }
    {
        float z = 0.f;
        for (int j = 0; j < 3; ++j) {
            const int sp = s - 2 + j;
            if (sp >= 0) {
                const float* q = pr + (ptrdiff_t)(sp - s) * MIX_IN;
                z += sconv_w[j * 256 + c] * (q[6 * 256 + c] * q[7 * 256 + c]);
            }
        }
        cat[(size_t)t * D_MODEL + 512 + c] = pr[5 * 256 + c] * z;
    }
    {
        const int h = c >> 6, tt = s & 127;
        const float* wrow = sgu_w + ((size_t)h * 128 + tt) * 128;
        const float* vb = vln + (size_t)(t - tt) * 256 + c;
        float z = sgu_b[h * 128 + tt];
        for (int ss = 0; ss <= tt; ++ss) z += wrow[ss] * vb[(size_t)ss * 256];
        cat[(size_t)t * D_MODEL + 768 + c] = gelu_exact(pr[8 * 256 + c]) * z;
    }
}

__global__ void __launch_bounds__(64) k_peer_topk(const float* __restrict__ scores, int* __restrict__ eidx, float* __restrict__ egate) {
    __shared__ float hs[2][16];
    __shared__ int hi[2][16];
    __shared__ float ts[16];
    __shared__ int tc[16];
    const int t = blockIdx.x >> 3, h = blockIdx.x & 7, lane = threadIdx.x;
    for (int pp = 0; pp < 2; ++pp) {
        const float* sr = scores + (size_t)t * 2048 + h * 256 + pp * 128;
        float v0 = sr[lane], v1 = sr[lane + 64];
        for (int k = 0; k < 16; ++k) {
            float bv; int bi;
            if (v0 >= v1) { bv = v0; bi = lane; } else { bv = v1; bi = lane + 64; }
#pragma unroll
            for (int o = 32; o > 0; o >>= 1) {
                const float ov = __shfl_xor(bv, o, 64); const int oi = __shfl_xor(bi, o, 64);
                if (ov > bv || (ov == bv && oi < bi)) { bv = ov; bi = oi; }
            }
            if (lane == 0) { hs[pp][k] = bv; hi[pp][k] = bi; }
            if (bi == lane) v0 = -3.0e38f;
            if (bi == lane + 64) v1 = -3.0e38f;
        }
    }
    __syncthreads();
    float cv[4];
#pragma unroll
    for (int r = 0; r < 4; ++r) { const int idx = lane + 64 * r; cv[r] = hs[0][idx >> 4] + hs[1][idx & 15]; }
    for (int k = 0; k < 16; ++k) {
        float bv = cv[0]; int bi = lane;
#pragma unroll
        for (int r = 1; r < 4; ++r) if (cv[r] > bv) { bv = cv[r]; bi = lane + 64 * r; }
#pragma unroll
        for (int o = 32; o > 0; o >>= 1) {
            const float ov = __shfl_xor(bv, o, 64); const int oi = __shfl_xor(bi, o, 64);
            if (ov > bv || (ov == bv && oi < bi)) { bv = ov; bi = oi; }
        }
        if (lane == 0) { ts[k] = bv; tc[k] = bi; }
#pragma unroll
        for (int r = 0; r < 4; ++r) if (bi == lane + 64 * r) cv[r] = -3.0e38f;
    }
    __syncthreads();
    if (lane < 16) {
        const float mxv = ts[0];
        float den = 0.f;
        for (int k = 0; k < 16; ++k) den += __expf(ts[k] - mxv);
        const int cidx = tc[lane];
        eidx[((size_t)t * 8 + h) * 16 + lane] = hi[0][cidx >> 4] * 128 + hi[1][cidx & 15];
        egate[((size_t)t * 8 + h) * 16 + lane] = __expf(ts[lane] - mxv) / den;
    }
}

__global__ void __launch_bounds__(256) k_peer_expert(const float* __restrict__ h2, const int* __restrict__ eidx, const float* __restrict__ egate,
                                                      const float* __restrict__ ut, const float* __restrict__ vt, const float* __restrict__ modl, float* __restrict__ x) {
    const int t = blockIdx.x * 4 + (threadIdx.x >> 6), lane = threadIdx.x & 63, b = t / SEQ;
    float4 hv[4], acc[4];
#pragma unroll
    for (int r = 0; r < 4; ++r) { hv[r] = *(const float4*)(h2 + (size_t)t * D_MODEL + r * 256 + lane * 4); acc[r] = make_float4(0.f, 0.f, 0.f, 0.f); }
    for (int k = 0; k < 128; ++k) {
        const int e = eidx[(size_t)t * 128 + k];
        const float gk = egate[(size_t)t * 128 + k];
        const float* ur = ut + (size_t)e * D_MODEL;
        const float* vr = vt + (size_t)e * D_MODEL;
        float dsum = 0.f;
#pragma unroll
        for (int r = 0; r < 4; ++r) { const float4 u = *(const float4*)(ur + r * 256 + lane * 4); dsum += hv[r].x * u.x + hv[r].y * u.y + hv[r].z * u.z + hv[r].w * u.w; }
        dsum = wave_sum(dsum);
        const float coef = gk * gelu_exact(dsum);
#pragma unroll
        for (int r = 0; r < 4; ++r) { const float4 v = *(const float4*)(vr + r * 256 + lane * 4); acc[r].x += coef * v.x; acc[r].y += coef * v.y; acc[r].z += coef * v.z; acc[r].w += coef * v.w; }
    }
#pragma unroll
    for (int r = 0; r < 4; ++r) {
        const int col = r * 256 + lane * 4;
        const float4 g = *(const float4*)(modl + (size_t)b * (N_MOD * D_MODEL) + 5 * D_MODEL + col);
        float4 xv = *(float4*)(x + (size_t)t * D_MODEL + col);
        xv.x += g.x * acc[r].x; xv.y += g.y * acc[r].y; xv.z += g.z * acc[r].z; xv.w += g.w * acc[r].w;
        *(float4*)(x + (size_t)t * D_MODEL + col) = xv;
    }
}

extern "C" void kernel_launch(void* const* d_in, const int* in_sizes, int n_in, void* d_out, int out_size, void* d_ws, size_t ws_size, hipStream_t stream) {
    const float* x_in = (const float*)d_in[0];
    const float* c = (const float*)d_in[1];
    const float* rel_bias = (const float*)d_in[2];
    const float* w_mod = (const float*)d_in[3];
    const float* b_mod = (const float*)d_in[4];
    const float* norm1_g = (const float*)d_in[5];
    const float* norm2_g = (const float*)d_in[6];
    const float* w_in = (const float*)d_in[7];
    const float* w_out = (const float*)d_in[8];
    const float* diff_lambda = (const float*)d_in[9];
    const float* subln_g = (const float*)d_in[10];
    const float* conf_dw = (const float*)d_in[11];
    const float* conf_ln_g = (const float*)d_in[12];
    const float* conf_ln_b = (const float*)d_in[13];
    const float* sconv_w = (const float*)d_in[14];
    const float* sgu_ln_g = (const float*)d_in[15];
    const float* sgu_ln_b = (const float*)d_in[16];
    const float* sgu_w = (const float*)d_in[17];
    const float* sgu_b = (const float*)d_in[18];
    const float* peer_wq = (const float*)d_in[19];
    const float* peer_keys = (const float*)d_in[20];
    const float* peer_u = (const float*)d_in[21];
    const float* peer_v = (const float*)d_in[22];
    const float* final_g = (const float*)d_in[23];
    float* out = (float*)d_out;

    char* ws = (char*)d_ws; size_t off = 0;
    auto take = [&](size_t bytes) { void* r = ws + off; off += (bytes + 255) & ~(size_t)255; return r; };
    float* mod = (float*)take((size_t)DEPTH * BATCH * N_MOD * D_MODEL * 4);
    float* xb = (float*)take((size_t)NTOK * D_MODEL * 4);
    float* hb = (float*)take((size_t)NTOK * D_MODEL * 4);
    float* pb = (float*)take((size_t)NTOK * MIX_IN * 4);
    float* ao = (float*)take((size_t)NTOK * 512 * 4);
    float* vln = (float*)take((size_t)NTOK * 256 * 4);
    float* cat = (float*)take((size_t)NTOK * D_MODEL * 4);
    float* qb = (float*)take((size_t)NTOK * 2048 * 4);
    float* sc = (float*)take((size_t)NTOK * 2048 * 4);
    int* eidx = (int*)take((size_t)NTOK * 128 * 4);
    float* egate = (float*)take((size_t)NTOK * 128 * 4);

    hipMemcpyAsync(xb, x_in, (size_t)NTOK * D_MODEL * 4, hipMemcpyDeviceToDevice, stream);
    k_mod<<<DEPTH * N_MOD * D_MODEL / 256, 256, 0, stream>>>(c, w_mod, b_mod, mod);
    for (int l = 0; l < DEPTH; ++l) {
        const float lam_init = (float)(0.8 - 0.6 * exp(-0.3 * (double)l));
        const float* modl = mod + (size_t)l * BATCH * N_MOD * D_MODEL;
        k_norm_mod<<<NTOK, 256, 0, stream>>>(xb, norm1_g + l * D_MODEL, modl, 0, 1, hb);
        k_gemm<false, 0><<<dim3(MIX_IN / 64, NTOK / 64, 1), 256, 0, stream>>>(hb, D_MODEL, w_in + (size_t)l * D_MODEL * MIX_IN, MIX_IN, pb, MIX_IN, D_MODEL, 0, 0, 0, nullptr);
        k_attn<<<BATCH * 4 * 2 * 32, 64, 0, stream>>>(pb, rel_bias, ao);
        k_sgu_pre<<<NTOK, 256, 0, stream>>>(pb, sgu_ln_g + l * 256, sgu_ln_b + l * 256, vln);
        k_mixer<<<NTOK, 256, 0, stream>>>(pb, ao, vln, diff_lambda + l * 128, lam_init, subln_g + l * 64, conf_dw + (size_t)l * 31 * 256, conf_ln_g + l * 256, conf_ln_b + l * 256,
                                          sconv_w + (size_t)l * 3 * 256, sgu_w + (size_t)l * 4 * 128 * 128, sgu_b + (size_t)l * 4 * 128, cat);
        k_gemm<false, 1><<<dim3(D_MODEL / 64, NTOK / 64, 1), 256, 0, stream>>>(cat, D_MODEL, w_out + (size_t)l * D_MODEL * D_MODEL, D_MODEL, xb, D_MODEL, D_MODEL, 0, 0, 0, modl + 2 * D_MODEL);
        k_norm_mod<<<NTOK, 256, 0, stream>>>(xb, norm2_g + l * D_MODEL, modl, 3, 4, hb);
        k_gemm<false, 0><<<dim3(2048 / 64, NTOK / 64, 1), 256, 0, stream>>>(hb, D_MODEL, peer_wq + (size_t)l * D_MODEL * 2048, 2048, qb, 2048, D_MODEL, 0, 0, 0, nullptr);
        k_gemm<true, 0><<<dim3(128 / 64, NTOK / 64, 16), 256, 0, stream>>>(qb, 2048, peer_keys + (size_t)l * 16 * 128 * 128, 128, sc, 2048, 128, 128, (size_t)128 * 128, 128, nullptr);
        k_peer_topk<<<NTOK * 8, 64, 0, stream>>>(sc, eidx, egate);
        k_peer_expert<<<NTOK / 4, 256, 0, stream>>>(hb, eidx, egate, peer_u + (size_t)l * 16384 * D_MODEL, peer_v + (size_t)l * 16384 * D_MODEL, modl, xb);
    }
    k_norm_mod<<<NTOK, 256, 0, stream>>>(xb, final_g, nullptr, 0, 0, out);
}
```

```cpp
#include <hip/hip_runtime.h>
#include <stdint.h>
#include <stdio.h>
#include <math.h>

#define D_MODEL 1024
#define BATCH 8
#define SEQ 2048
#define DEPTH 4
#define NTOK (BATCH * SEQ)
#define MIX_IN 2560
#define N_MOD 6
#define MODW (N_MOD * D_MODEL)
#define NEXP 16384

#define LAS __attribute__((address_space(3)))
typedef unsigned short bf16_t;
typedef short bf16x8 __attribute__((ext_vector_type(8)));
typedef float f32x4 __attribute__((ext_vector_type(4)));
typedef float f32x16 __attribute__((ext_vector_type(16)));
typedef unsigned u32x4 __attribute__((ext_vector_type(4)));
typedef unsigned u32x2 __attribute__((ext_vector_type(2)));

__device__ const unsigned char kBucket[128] = {
    0, 1, 2, 3, 4, 5, 6, 7, 8, 9, 10, 11, 12, 13, 14, 15, 16, 16, 16, 17, 17, 18, 18, 18, 19, 19, 19, 20, 20, 20, 20, 21,
    21, 21, 21, 22, 22, 22, 22, 22, 23, 23, 23, 23, 23, 23, 24, 24, 24, 24, 24, 24, 25, 25, 25, 25, 25, 25, 25, 26, 26, 26, 26, 26,
    26, 26, 26, 27, 27, 27, 27, 27, 27, 27, 27, 27, 27, 28, 28, 28, 28, 28, 28, 28, 28, 28, 28, 29, 29, 29, 29, 29, 29, 29, 29, 29,
    29, 29, 29, 30, 30, 30, 30, 30, 30, 30, 30, 30, 30, 30, 30, 30, 30, 31, 31, 31, 31, 31, 31, 31, 31, 31, 31, 31, 31, 31, 31, 31};

__device__ __forceinline__ float bf2f(bf16_t v) { return __uint_as_float(((unsigned)v) << 16); }
__device__ __forceinline__ float bflo(unsigned w) { return __uint_as_float(w << 16); }
__device__ __forceinline__ float bfhi(unsigned w) { return __uint_as_float(w & 0xFFFF0000u); }
__device__ __forceinline__ bf16_t f2bf(float f) { unsigned u = __float_as_uint(f); u += 0x7FFFu + ((u >> 16) & 1u); return (bf16_t)(u >> 16); }
__device__ __forceinline__ unsigned pk2(float lo, float hi) { unsigned r; asm volatile("v_cvt_pk_bf16_f32 %0, %1, %2" : "=v"(r) : "v"(lo), "v"(hi)); return r; }
__device__ __forceinline__ float ldf(const float* p) { return *p; }
__device__ __forceinline__ float ldf(const bf16_t* p) { return bf2f(*p); }

__device__ __forceinline__ float gelu_exact(float v) { return 0.5f * v * (1.0f + erff(v * 0.70710678118654752f)); }
__device__ __forceinline__ float sigmoidf_(float v) { return 1.0f / (1.0f + __expf(-v)); }
__device__ __forceinline__ float wave_sum(float v) {
#pragma unroll
    for (int o = 32; o > 0; o >>= 1) v += __shfl_xor(v, o, 64);
    return v;
}
__device__ __forceinline__ float block_sum256(float v, float* red) {
    v = wave_sum(v);
    __syncthreads();
    if ((threadIdx.x & 63) == 0) red[threadIdx.x >> 6] = v;
    __syncthreads();
    return red[0] + red[1] + red[2] + red[3];
}
#define XB_TMO      128
#define XB_XCNT(j)  (256  + 64 * (j))
#define XB_XSUB(j)  (1280 + 64 * (j))
#define XB_XGEN(j)  (2304 + 64 * (j))
#define XB_TOP      3328
#define XB_TOPGEN   3392
#define XCD_BAR_WORDS 3456
#define XB_SPIN_CAP (1u << 18)

__device__ __forceinline__ unsigned xb_ld(unsigned* p)              { return __hip_atomic_load(p, __ATOMIC_RELAXED, __HIP_MEMORY_SCOPE_AGENT); }
__device__ __forceinline__ unsigned xb_add(unsigned* p, unsigned v) { return __hip_atomic_fetch_add(p, v, __ATOMIC_RELAXED, __HIP_MEMORY_SCOPE_AGENT); }
__device__ __forceinline__ unsigned xb_xcc_id() { return (unsigned)__builtin_amdgcn_s_getreg((3 << 11) | 20) & 0xFu; }
#define XB_SPIN(cond, bar) do { unsigned _sp = 0; while (cond) { __builtin_amdgcn_s_sleep(1); \
    if ((++_sp & 255u) == 0u) { if (xb_ld(&(bar)[XB_TMO])) break; if (_sp > XB_SPIN_CAP) { atomicAdd(&(bar)[XB_TMO], 1u); break; } } } } while (0)

struct XcdBarrier {
    unsigned* bar; unsigned x;
    volatile LAS unsigned* st;
};

__device__ __forceinline__ XcdBarrier xcd_barrier_post(unsigned* bar, volatile LAS unsigned* st) {
    XcdBarrier b; b.bar = bar; b.x = xb_xcc_id(); b.st = st;
    if (threadIdx.x == 0) (void)xb_add(&bar[XB_XCNT(b.x)], 1u);
    return b;
}
__device__ __forceinline__ void xcd_barrier_complete(unsigned* bar, unsigned x, unsigned& nloc, unsigned& nx) {
    const unsigned G = gridDim.x * gridDim.y * gridDim.z;
    unsigned sum, cnt, mine, sp = 0u;
    for (;;) {
        sum = 0u; cnt = 0u; mine = 0u;
#pragma unroll
        for (unsigned j = 0; j < 16; ++j) { const unsigned c = xb_ld(&bar[XB_XCNT(j)]); sum += c; cnt += (c > 0u) ? 1u : 0u; mine = (j == x) ? c : mine; }
        if (sum == G) break;
        __builtin_amdgcn_s_sleep(1);
        if ((++sp & 255u) == 0u) { if (xb_ld(&bar[XB_TMO])) break; if (sp > XB_SPIN_CAP) { atomicAdd(&bar[XB_TMO], 1u); break; } }
    }
    nloc = mine > 0u ? mine : 1u; nx = cnt > 0u ? cnt : 1u;
}

__device__ __forceinline__ void xcd_barrier(const XcdBarrier& b) {
    asm volatile("s_waitcnt vmcnt(0)" ::: "memory");
    __syncthreads();
    if (threadIdx.x == 0) {
        unsigned* bar = b.bar;
        __builtin_amdgcn_s_waitcnt(0);
        unsigned nloc = b.st[0], nx = b.st[1];
        if (nloc == 0u) { xcd_barrier_complete(bar, b.x, nloc, nx); b.st[0] = nloc; b.st[1] = nx; }
        const unsigned old = xb_add(&bar[XB_XSUB(b.x)], 1u);
        const unsigned gen = old / nloc;
        if (old + 1u == (gen + 1u) * nloc) {
            __builtin_amdgcn_fence(__ATOMIC_RELEASE, "agent");
            asm volatile("s_waitcnt vmcnt(0)" ::: "memory");
            const unsigned og = xb_add(&bar[XB_TOP], 1u);
            const unsigned tg = og / nx;
            if (og + 1u == (tg + 1u) * nx) xb_add(&bar[XB_TOPGEN], 1u);
            else XB_SPIN(xb_ld(&bar[XB_TOPGEN]) == tg, bar);
            __builtin_amdgcn_fence(__ATOMIC_ACQUIRE, "agent");
            xb_add(&bar[XB_XGEN(b.x)], 1u);
            asm volatile("s_waitcnt vmcnt(0)" ::: "memory");
        } else {
            XB_SPIN(xb_ld(&bar[XB_XGEN(b.x)]) == gen, bar);
            __builtin_amdgcn_fence(__ATOMIC_ACQUIRE, "agent");
            asm volatile("s_waitcnt vmcnt(0)" ::: "memory");
        }
    }
    __syncthreads();
}
namespace pg8 {
#define PG8_LAS __attribute__((address_space(3)))
typedef unsigned short bf16_t;
typedef short bf16x8 __attribute__((ext_vector_type(8)));
typedef float f32x4 __attribute__((ext_vector_type(4)));
typedef unsigned u32x4 __attribute__((ext_vector_type(4)));
constexpr int BM = 256, BK = 64, HALF = 128, HTB = HALF * BK * 2  , STAGE_BYTES = 8 * HTB, NXCD = 8, WGM = 8;

__host__ __device__ __forceinline__ int lds_byte(int r, int c) { const int st = (r >> 4) * 2 + (c >> 5), rr = r & 15, cc = c & 31, ob = rr * 64 + cc * 2; return st * 1024 + (ob ^ (((ob >> 9) & 1) << 5)); }
__host__ __device__ __forceinline__ void stage_rc(int b, int& R, int& C) { const int st = b / 1024, sb = b % 1024, swz = sb ^ (((sb >> 9) & 1) << 5); R = (st >> 1) * 16 + swz / 64; C = (st & 1) * 32 + (swz % 64) / 2; }
__host__ __device__ __forceinline__ int perm32(int rho) { const int n = rho >> 4, i = rho & 15; return 8 * (i >> 2) + 4 * n + (i & 3); }

struct Unit { int pm, pn; };
struct Gemm { const bf16_t* A; const bf16_t* Bt; int M, N, K; };

struct StaticOrder {
    int nM, nN, nwg, G, c;
    __host__ __device__ void init(int M, int N, int G_, int c_) { nM = M / BM; nN = N / BM; nwg = nM * nN; G = G_; c = c_; }
    __host__ __device__ bool next(int i, Unit& u) const {
        const long L = (long)i * G + c; if (L >= nwg) return false;
        int wgid = (int)L; { const int q = nwg / NXCD, r = nwg % NXCD, xcd = wgid % NXCD, off = wgid / NXCD; wgid = (xcd < r ? xcd * (q + 1) : r * (q + 1) + (xcd - r) * q) + off; }
        const int nig = WGM * nN, gid = wgid / nig, fm = gid * WGM, gsz = (nM - fm) < WGM ? (nM - fm) : WGM;
        u.pm = fm + ((wgid % nig) % gsz); u.pn = (wgid % nig) / gsz; return true;
    }
    __device__ __forceinline__ void a_ready(const Unit&) const {}
    __device__ __forceinline__ void done(const Unit&) const {}
};
__device__ __forceinline__ unsigned cvt_pk_bf16(float lo, float hi) { unsigned r; asm volatile("v_cvt_pk_bf16_f32 %0, %1, %2" : "=v"(r) : "v"(lo), "v"(hi)); return r; }
template <class Epi, class Sched, bool STAMP = false>
__device__ __forceinline__ void gemm_phase(PG8_LAS unsigned char* lds, const Gemm g, const Sched& S, const Epi& E, unsigned long long* stamps) {
    const int tid = threadIdx.x, wid = __builtin_amdgcn_readfirstlane(tid >> 6), lane = tid & 63, wr = wid >> 2, wc = wid & 3, fr = lane & 15, fq = lane >> 4;
    const int K = g.K, nt = K / BK;
    int ts_lo = 0, ts_hi = 0, nts = 0; const unsigned long long rt_entry = STAMP ? (unsigned long long)wall_clock64() : 0ull;
#define PG8_STAMP() do { if (STAMP && wid == 0 && nts < 64) { const unsigned long long _c = (unsigned long long)clock64(); \
        ts_lo = (lane == nts) ? (int)(unsigned)_c : ts_lo; ts_hi = (lane == nts) ? (int)(unsigned)(_c >> 32) : ts_hi; ++nts; } } while (0)
    PG8_STAMP();
    unsigned voffA[2], voffB[2];
#pragma unroll
    for (int i = 0; i < 2; ++i) { int R, C; stage_rc(tid * 16 + i * 8192, R, C); const int Rb = Epi::PERM ? ((R & ~31) + perm32(R & 31)) : R;
        voffA[i] = (unsigned)(R * K + C) * 2u; voffB[i] = (unsigned)(Rb * K + C) * 2u; }
    const size_t kstep = (size_t)(BK * 2);
    const size_t hstep = (size_t)HALF * K * 2;
    const size_t tstep = 2 * hstep;
    const unsigned ldsw = (unsigned)wid * 1024u;
    const int aoff = lds_byte(wr * 64 + fr, fq * 8), boff = lds_byte(wc * 32 + fr, fq * 8);
#define PG8_SA(b, h) (((b) * 2 + (h)) * HTB)
#define PG8_SB(b, h) ((4 + (b) * 2 + (h)) * HTB)
#define PG8_STAGE(bufoff, gbase, voff) do { _Pragma("unroll") for (int _i = 0; _i < 2; ++_i) \
        __builtin_amdgcn_global_load_lds((const unsigned*)((const char*)(gbase) + (voff)[_i]), (PG8_LAS unsigned*)(lds + (bufoff) + ldsw + _i * 8192), 16, 0, 0); } while (0)
#define PG8_LDA(dst, b, h) do { _Pragma("unroll") for (int m = 0; m < 4; ++m) _Pragma("unroll") for (int k = 0; k < 2; ++k) dst[m][k] = *(const PG8_LAS bf16x8*)(lds + PG8_SA(b, h) + aoff + m * 2048 + k * 1024); } while (0)
#define PG8_LDB(dst, b, h) do { _Pragma("unroll") for (int n = 0; n < 2; ++n) _Pragma("unroll") for (int k = 0; k < 2; ++k) dst[n][k] = *(const PG8_LAS bf16x8*)(lds + PG8_SB(b, h) + boff + n * 2048 + k * 1024); } while (0)
#define PG8_MMA(ai, bj, At, Bt) do { __builtin_amdgcn_s_setprio(1); _Pragma("unroll") for (int m = 0; m < 4; ++m) _Pragma("unroll") for (int n = 0; n < 2; ++n) _Pragma("unroll") for (int k = 0; k < 2; ++k) \
        acc[ai][bj][m][n] = __builtin_amdgcn_mfma_f32_16x16x32_bf16(Bt[n][k], At[m][k], acc[ai][bj][m][n], 0, 0, 0); __builtin_amdgcn_s_setprio(0); } while (0)
#define PG8_WAIT_V(n) asm volatile("s_waitcnt vmcnt(" #n ")" ::: "memory")
#define PG8_WAIT_L(n) asm volatile("s_waitcnt lgkmcnt(" #n ")" ::: "memory")
#define PG8_BAR __builtin_amdgcn_s_barrier()
#define PG8_SCHED __builtin_amdgcn_sched_barrier(0)
    Unit cur, nxt; int ui = 0;
    if (!S.next(0, cur)) return;
    f32x4 acc[2][2][4][2];
#pragma unroll
    for (int a = 0; a < 2; ++a)
#pragma unroll
        for (int b = 0; b < 2; ++b)
#pragma unroll
            for (int m = 0; m < 4; ++m)
#pragma unroll
                for (int n = 0; n < 2; ++n) acc[a][b][m][n] = (f32x4){0.f, 0.f, 0.f, 0.f};
    bf16x8 At[4][2], B0[2][2], B1[2][2];
    const char* cA = (const char*)g.A + (size_t)cur.pm * tstep; const char* cB = (const char*)g.Bt + (size_t)cur.pn * tstep;
    S.a_ready(cur);
    PG8_STAGE(PG8_SB(0, 0), cB, voffB); PG8_STAGE(PG8_SA(0, 0), cA, voffA); PG8_STAGE(PG8_SB(0, 1), cB + hstep, voffB); PG8_STAGE(PG8_SA(0, 1), cA + hstep, voffA);
    if (wr == 1) PG8_BAR;
    PG8_WAIT_V(4); PG8_BAR;
    PG8_STAGE(PG8_SB(1, 0), cB + kstep, voffB); PG8_STAGE(PG8_SA(1, 0), cA + kstep, voffA); PG8_STAGE(PG8_SB(1, 1), cB + hstep + kstep, voffB);
    PG8_WAIT_V(6); PG8_BAR;
    PG8_STAMP();
    for (;;) {
        const bool has_next = S.next(ui + 1, nxt);
        const char* nA = has_next ? (const char*)g.A + (size_t)nxt.pm * tstep : cA; const char* nB = has_next ? (const char*)g.Bt + (size_t)nxt.pn * tstep : cB;
        for (int t = 0; t < nt; t += 2) {
            const bool last = (t == nt - 2);
            const char* a1 = cA + (size_t)(t + 1) * kstep;
            const char* a2 = last ? nA : cA + (size_t)(t + 2) * kstep; const char* b2 = last ? nB : cB + (size_t)(t + 2) * kstep;
            const char* a3 = a2 + kstep; const char* b3 = b2 + kstep;
            if (last && has_next) S.a_ready(nxt);
            PG8_LDB(B0, 0, 0); PG8_SCHED; PG8_LDA(At, 0, 0); PG8_STAGE(PG8_SA(1, 1), a1 + hstep, voffA);
            PG8_WAIT_L(8); PG8_BAR; PG8_WAIT_L(0); PG8_MMA(0, 0, At, B0); PG8_BAR; PG8_SCHED;
            PG8_LDB(B1, 0, 1); PG8_STAGE(PG8_SB(0, 0), b2, voffB);
            PG8_BAR; PG8_WAIT_L(0); PG8_MMA(0, 1, At, B1); PG8_BAR;
            PG8_LDA(At, 0, 1); PG8_STAGE(PG8_SA(0, 0), a2, voffA);
            PG8_BAR; PG8_WAIT_L(0); PG8_MMA(1, 0, At, B0); PG8_BAR; PG8_SCHED;
            PG8_STAGE(PG8_SB(0, 1), b2 + hstep, voffB);
            PG8_WAIT_V(6); PG8_BAR; PG8_MMA(1, 1, At, B1); PG8_BAR;
            PG8_LDB(B0, 1, 0); PG8_SCHED; PG8_LDA(At, 1, 0); PG8_STAGE(PG8_SA(0, 1), a2 + hstep, voffA);
            PG8_WAIT_L(8); PG8_BAR; PG8_WAIT_L(0); PG8_MMA(0, 0, At, B0); PG8_BAR; PG8_SCHED;
            PG8_LDB(B1, 1, 1); PG8_STAGE(PG8_SB(1, 0), b3, voffB);
            PG8_BAR; PG8_WAIT_L(0); PG8_MMA(0, 1, At, B1); PG8_BAR;
            PG8_LDA(At, 1, 1); PG8_STAGE(PG8_SA(1, 0), a3, voffA);
            PG8_BAR; PG8_WAIT_L(0); PG8_MMA(1, 0, At, B0); PG8_BAR; PG8_SCHED;
            PG8_STAGE(PG8_SB(1, 1), b3 + hstep, voffB);
            PG8_WAIT_V(6); PG8_BAR; PG8_MMA(1, 1, At, B1); PG8_BAR;
        }
        PG8_STAMP();
        if constexpr (!Epi::AFTER_DRAIN) { E(acc, cur, wr, wc, fr, fq); S.done(cur); }
        PG8_STAMP();
        if (!has_next) break;
#pragma unroll
        for (int a = 0; a < 2; ++a)
#pragma unroll
            for (int b = 0; b < 2; ++b)
#pragma unroll
                for (int m = 0; m < 4; ++m)
#pragma unroll
                    for (int n = 0; n < 2; ++n) acc[a][b][m][n] = (f32x4){0.f, 0.f, 0.f, 0.f};
        cur = nxt; cA = nA; cB = nB; ++ui;
    }
    PG8_WAIT_V(0);
    if (wr == 0) PG8_BAR;
    PG8_BAR;
    if constexpr (Epi::AFTER_DRAIN) { E.fused(acc, cur, wr, wc, fr, fq, lds, wid, lane); S.done(cur); }
    PG8_STAMP();
    if (STAMP && wid == 0) { stamps[lane] = lane < nts ? (((unsigned long long)(unsigned)ts_hi << 32) | (unsigned)ts_lo) : 0ull;
        if (lane == 62) stamps[62] = rt_entry; if (lane == 63) stamps[63] = (unsigned long long)wall_clock64(); }
#undef PG8_STAMP
#undef PG8_SA
#undef PG8_SB
#undef PG8_STAGE
#undef PG8_LDA
#undef PG8_LDB
#undef PG8_MMA
#undef PG8_WAIT_V
#undef PG8_WAIT_L
#undef PG8_BAR
#undef PG8_SCHED
}
}

__global__ void __launch_bounds__(256) k_mod(const float* __restrict__ c, const float* __restrict__ w_mod, const float* __restrict__ b_mod, float* __restrict__ mod) {
    __shared__ float sc[BATCH][D_MODEL];
    for (int i = threadIdx.x; i < BATCH * D_MODEL; i += 256) { float v = c[i]; sc[i / D_MODEL][i % D_MODEL] = v / (1.0f + __expf(-v)); }
    __syncthreads();
    const int gj = blockIdx.x * 256 + threadIdx.x;
    const int l = gj / (N_MOD * D_MODEL), j = gj % (N_MOD * D_MODEL);
    float acc[BATCH];
#pragma unroll
    for (int b = 0; b < BATCH; ++b) acc[b] = 0.f;
    const float* w = w_mod + (size_t)l * D_MODEL * (N_MOD * D_MODEL) + j;
    for (int i = 0; i < D_MODEL; ++i) {
        const float wv = w[(size_t)i * (N_MOD * D_MODEL)];
#pragma unroll
        for (int b = 0; b < BATCH; ++b) acc[b] += sc[b][i] * wv;
    }
    const float bv = b_mod[(size_t)l * (N_MOD * D_MODEL) + j];
#pragma unroll
    for (int b = 0; b < BATCH; ++b) mod[((size_t)l * BATCH + b) * (N_MOD * D_MODEL) + j] = acc[b] + bv;
}

__global__ void __launch_bounds__(256) k_norm_mod(const float* __restrict__ x, const float* __restrict__ g, const float* __restrict__ modl  , int sh_idx, int sc_idx, float* __restrict__ out) {
    __shared__ float red[4];
    const int t = blockIdx.x, b = t / SEQ;
    const float* xr = x + (size_t)t * D_MODEL;
    float v[4]; float ss = 0.f;
#pragma unroll
    for (int r = 0; r < 4; ++r) { v[r] = xr[threadIdx.x + 256 * r]; ss += v[r] * v[r]; }
    ss = block_sum256(ss, red);
    const float rs = rsqrtf(ss * (1.0f / D_MODEL) + 1e-6f);
#pragma unroll
    for (int r = 0; r < 4; ++r) {
        const int col = threadIdx.x + 256 * r;
        float y = v[r] * rs * g[col];
        if (modl) y = y * (1.0f + modl[(size_t)b * (N_MOD * D_MODEL) + sc_idx * D_MODEL + col]) + modl[(size_t)b * (N_MOD * D_MODEL) + sh_idx * D_MODEL + col];
        out[(size_t)t * D_MODEL + col] = y;
    }
}

template <bool BT, int EPI, class TA>
__global__ void __launch_bounds__(256) k_gemm(const TA* __restrict__ A, int lda, const float* __restrict__ B, int ldb, float* __restrict__ C, int ldc, int K,
                                               size_t sA, size_t sB, size_t sC, const float* __restrict__ gate) {
    __shared__ float As[16][68];
    __shared__ float Bs[16][68];
    A += blockIdx.z * sA; B += blockIdx.z * sB; C += blockIdx.z * sC;
    const int m0 = blockIdx.y * 64, n0 = blockIdx.x * 64;
    const int tx = threadIdx.x & 15, ty = threadIdx.x >> 4;
    float acc[4][4];
#pragma unroll
    for (int i = 0; i < 4; ++i)
#pragma unroll
        for (int j = 0; j < 4; ++j) acc[i][j] = 0.f;
    for (int k0 = 0; k0 < K; k0 += 16) {
#pragma unroll
        for (int r = 0; r < 4; ++r) {
            const int e = threadIdx.x + 256 * r;
            { const int mm = e >> 4, kk = e & 15; As[kk][mm] = ldf(A + (size_t)(m0 + mm) * lda + k0 + kk); }
            if (BT) { const int nn = e >> 4, kk = e & 15; Bs[kk][nn] = B[(size_t)(n0 + nn) * ldb + k0 + kk]; }
            else    { const int kk = e >> 6, nn = e & 63; Bs[kk][nn] = B[(size_t)(k0 + kk) * ldb + n0 + nn]; }
        }
        __syncthreads();
#pragma unroll
        for (int kk = 0; kk < 16; ++kk) {
            float a[4], b[4];
#pragma unroll
            for (int i = 0; i < 4; ++i) a[i] = As[kk][ty * 4 + i];
#pragma unroll
            for (int j = 0; j < 4; ++j) b[j] = Bs[kk][tx * 4 + j];
#pragma unroll
            for (int i = 0; i < 4; ++i)
#pragma unroll
                for (int j = 0; j < 4; ++j) acc[i][j] += a[i] * b[j];
        }
        __syncthreads();
    }
#pragma unroll
    for (int i = 0; i < 4; ++i)
#pragma unroll
        for (int j = 0; j < 4; ++j) {
            const int m = m0 + ty * 4 + i, n = n0 + tx * 4 + j;
            float* cp = C + (size_t)m * ldc + n;
            if (EPI == 0) *cp = acc[i][j];
            else *cp = *cp + gate[(size_t)(m / SEQ) * (N_MOD * D_MODEL) + n] * acc[i][j];
        }
}

__global__ void __launch_bounds__(64) k_attn(const bf16_t* __restrict__ p, const float* __restrict__ rel_bias, float* __restrict__ ao) {
    const int blk = blockIdx.x, qb = blk & 31, m = (blk >> 5) & 1, h = (blk >> 6) & 3, b = blk >> 8;
    const int i = qb * 64 + threadIdx.x;
    const float scale = 0.17677669529663687f;
    const bf16_t* prow = p + (size_t)(b * SEQ + i) * MIX_IN + h * 64 + m * 32;
    float q[32], o[64];
#pragma unroll
    for (int d = 0; d < 32; ++d) q[d] = bf2f(prow[d]) * scale;
#pragma unroll
    for (int d = 0; d < 64; ++d) o[d] = 0.f;
    float mx = -1e30f, l = 0.f;
    const int jmax = qb * 64 + 63;
    for (int j = 0; j <= jmax; ++j) {
        const bf16_t* krow = p + (size_t)(b * SEQ + j) * MIX_IN + 256 + h * 64 + m * 32;
        const bf16_t* vrow = p + (size_t)(b * SEQ + j) * MIX_IN + 512 + h * 64;
        float s = 0.f;
#pragma unroll
        for (int d = 0; d < 32; ++d) s += q[d] * bf2f(krow[d]);
        const int n = i - j;
        if (n >= 0) {
            const int bk = n < 128 ? (int)kBucket[n] : 31;
            s += rel_bias[bk * 4 + h];
            const float mn = fmaxf(mx, s);
            const float corr = __expf(mx - mn), pp = __expf(s - mn);
            l = l * corr + pp;
#pragma unroll
            for (int d = 0; d < 64; ++d) o[d] = o[d] * corr + pp * bf2f(vrow[d]);
            mx = mn;
        }
    }
    const float inv = 1.0f / l;
    float* op = ao + ((size_t)((b * SEQ + i) * 4 + h) * 2 + m) * 64;
#pragma unroll
    for (int d = 0; d < 64; ++d) op[d] = o[d] * inv;
}

__global__ void __launch_bounds__(256) k_sgu_pre(const bf16_t* __restrict__ p, const float* __restrict__ ln_g, const float* __restrict__ ln_b, float* __restrict__ vln) {
    __shared__ float red[4];
    const int t = blockIdx.x, c = threadIdx.x;
    const float v = gelu_exact(bf2f(p[(size_t)t * MIX_IN + 9 * 256 + c]));
    const float mu = block_sum256(v, red) * (1.0f / 256.0f);
    const float dv = v - mu;
    const float var = block_sum256(dv * dv, red) * (1.0f / 256.0f);
    vln[(size_t)t * 256 + c] = dv * rsqrtf(var + 1e-6f) * ln_g[c] + ln_b[c];
}

__global__ void __launch_bounds__(256) k_mixer(const bf16_t* __restrict__ p, const float* __restrict__ ao, const float* __restrict__ vln,
                                                const float* __restrict__ lam_par  , float lam_init, const float* __restrict__ subln_g,
                                                const float* __restrict__ conf_dw  , const float* __restrict__ conf_ln_g, const float* __restrict__ conf_ln_b,
                                                const float* __restrict__ sconv_w  , const float* __restrict__ sgu_w  , const float* __restrict__ sgu_b  ,
                                                bf16_t* __restrict__ cat) {
    __shared__ float red[4];
    const int t = blockIdx.x, c = threadIdx.x, s = t % SEQ;
    const bf16_t* pr = p + (size_t)t * MIX_IN;
    float d01 = 0.f, d23 = 0.f;
    for (int i = 0; i < 32; ++i) { d01 += lam_par[i] * lam_par[32 + i]; d23 += lam_par[64 + i] * lam_par[96 + i]; }
    const float lam = expf(d01) - expf(d23) + lam_init;
    if (ao) {
        const int h = c >> 6, d = c & 63;
        const float* a = ao + ((size_t)(t * 4 + h) * 2) * 64;
        const float v = a[d] - lam * a[64 + d];
        const float ss = wave_sum(v * v);
        cat[(size_t)t * D_MODEL + c] = f2bf(v * rsqrtf(ss * (1.0f / 64.0f) + 1e-6f) * subln_g[d] * (1.0f - lam_init));
    }
    {
        float z = 0.f;
        for (int j = 0; j < 31; ++j) {
            const int sp = s - 30 + j;
            if (sp >= 0) {
                const bf16_t* q = pr + (ptrdiff_t)(sp - s) * MIX_IN;
                z += conf_dw[j * 256 + c] * (bf2f(q[3 * 256 + c]) * sigmoidf_(bf2f(q[4 * 256 + c])));
            }
        }
        const float mu = block_sum256(z, red) * (1.0f / 256.0f);
        const float dv = z - mu;
        const float var = block_sum256(dv * dv, red) * (1.0f / 256.0f);
        const float y = dv * rsqrtf(var + 1e-6f) * conf_ln_g[c] + conf_ln_b[c];
        cat[(size_t)t * D_MODEL + 256 + c] = f2bf(y * sigmoidf_(y));
    }
    {
        float z = 0.f;
        for (int j = 0; j < 3; ++j) {
            const int sp = s - 2 + j;
            if (sp >= 0) {
                const bf16_t* q = pr + (ptrdiff_t)(sp - s) * MIX_IN;
                z += sconv_w[j * 256 + c] * (bf2f(q[6 * 256 + c]) * bf2f(q[7 * 256 + c]));
            }
        }
        cat[(size_t)t * D_MODEL + 512 + c] = f2bf(bf2f(pr[5 * 256 + c]) * z);
    }
    {
        const int h = c >> 6, tt = s & 127;
        const float* wrow = sgu_w + ((size_t)h * 128 + tt) * 128;
        const float* vb = vln + (size_t)(t - tt) * 256 + c;
        float z = sgu_b[h * 128 + tt];
        for (int ss = 0; ss <= tt; ++ss) z += wrow[ss] * vb[(size_t)ss * 256];
        cat[(size_t)t * D_MODEL + 768 + c] = f2bf(gelu_exact(bf2f(pr[8 * 256 + c])) * z);
    }
}

__global__ void __launch_bounds__(64) k_peer_topk(const float* __restrict__ scores, int* __restrict__ eidx, float* __restrict__ egate) {
    __shared__ float hs[2][16];
    __shared__ int hi[2][16];
    __shared__ float ts[16];
    __shared__ int tc[16];
    const int t = blockIdx.x >> 3, h = blockIdx.x & 7, lane = threadIdx.x;
    for (int pp = 0; pp < 2; ++pp) {
        const float* sr = scores + (size_t)t * 2048 + h * 256 + pp * 128;
        float v0 = sr[lane], v1 = sr[lane + 64];
        for (int k = 0; k < 16; ++k) {
            float bv; int bi;
            if (v0 >= v1) { bv = v0; bi = lane; } else { bv = v1; bi = lane + 64; }
#pragma unroll
            for (int o = 32; o > 0; o >>= 1) {
                const float ov = __shfl_xor(bv, o, 64); const int oi = __shfl_xor(bi, o, 64);
                if (ov > bv || (ov == bv && oi < bi)) { bv = ov; bi = oi; }
            }
            if (lane == 0) { hs[pp][k] = bv; hi[pp][k] = bi; }
            if (bi == lane) v0 = -3.0e38f;
            if (bi == lane + 64) v1 = -3.0e38f;
        }
    }
    __syncthreads();
    float cv[4];
#pragma unroll
    for (int r = 0; r < 4; ++r) { const int idx = lane + 64 * r; cv[r] = hs[0][idx >> 4] + hs[1][idx & 15]; }
    for (int k = 0; k < 16; ++k) {
        float bv = cv[0]; int bi = lane;
#pragma unroll
        for (int r = 1; r < 4; ++r) if (cv[r] > bv) { bv = cv[r]; bi = lane + 64 * r; }
#pragma unroll
        for (int o = 32; o > 0; o >>= 1) {
            const float ov = __shfl_xor(bv, o, 64); const int oi = __shfl_xor(bi, o, 64);
            if (ov > bv || (ov == bv && oi < bi)) { bv = ov; bi = oi; }
        }
        if (lane == 0) { ts[k] = bv; tc[k] = bi; }
#pragma unroll
        for (int r = 0; r < 4; ++r) if (bi == lane + 64 * r) cv[r] = -3.0e38f;
    }
    __syncthreads();
    if (lane < 16) {
        const float mxv = ts[0];
        float den = 0.f;
        for (int k = 0; k < 16; ++k) den += __expf(ts[k] - mxv);
        const int cidx = tc[lane];
        eidx[((size_t)t * 8 + h) * 16 + lane] = hi[0][cidx >> 4] * 128 + hi[1][cidx & 15];
        egate[((size_t)t * 8 + h) * 16 + lane] = __expf(ts[lane] - mxv) / den;
    }
}

__global__ void __launch_bounds__(256) k_peer_expert(const bf16_t* __restrict__ h2, const int* __restrict__ eidx, const float* __restrict__ egate,
                                                      const float* __restrict__ ut, const float* __restrict__ vt, const float* __restrict__ modl, float* __restrict__ x) {
    const int t = blockIdx.x * 4 + (threadIdx.x >> 6), lane = threadIdx.x & 63, b = t / SEQ;
    float4 hv[4], acc[4];
#pragma unroll
    for (int r = 0; r < 4; ++r) { { const u32x2 w = *(const u32x2*)(h2 + (size_t)t * D_MODEL + r * 256 + lane * 4); hv[r] = make_float4(bflo(w.x), bfhi(w.x), bflo(w.y), bfhi(w.y)); } acc[r] = make_float4(0.f, 0.f, 0.f, 0.f); }
    for (int k = 0; k < 128; ++k) {
        const int e = eidx[(size_t)t * 128 + k];
        const float gk = egate[(size_t)t * 128 + k];
        const float* ur = ut + (size_t)e * D_MODEL;
        const float* vr = vt + (size_t)e * D_MODEL;
        float dsum = 0.f;
#pragma unroll
        for (int r = 0; r < 4; ++r) { const float4 u = *(const float4*)(ur + r * 256 + lane * 4); dsum += hv[r].x * u.x + hv[r].y * u.y + hv[r].z * u.z + hv[r].w * u.w; }
        dsum = wave_sum(dsum);
        const float coef = gk * gelu_exact(dsum);
#pragma unroll
        for (int r = 0; r < 4; ++r) { const float4 v = *(const float4*)(vr + r * 256 + lane * 4); acc[r].x += coef * v.x; acc[r].y += coef * v.y; acc[r].z += coef * v.z; acc[r].w += coef * v.w; }
    }
#pragma unroll
    for (int r = 0; r < 4; ++r) {
        const int col = r * 256 + lane * 4;
        const float4 g = *(const float4*)(modl + (size_t)b * (N_MOD * D_MODEL) + 5 * D_MODEL + col);
        float4 xv = *(float4*)(x + (size_t)t * D_MODEL + col);
        xv.x += g.x * acc[r].x; xv.y += g.y * acc[r].y; xv.z += g.z * acc[r].z; xv.w += g.w * acc[r].w;
        *(float4*)(x + (size_t)t * D_MODEL + col) = xv;
    }
}

struct Params {
    const float *x_in, *c, *rel_bias, *w_mod, *b_mod, *norm1_g, *norm2_g, *w_in, *w_out, *diff_lambda, *subln_g, *conf_dw, *conf_ln_g, *conf_ln_b, *sconv_w,
        *sgu_ln_g, *sgu_ln_b, *sgu_w, *sgu_b, *peer_wq, *peer_keys, *peer_u, *peer_v, *final_g;
    float* out;
    unsigned* bar;
    float* mod;
    float* xb;
    bf16_t* hb;
    bf16_t* pb;
    bf16_t* cat;
    bf16_t* qb;
    bf16_t *WinT, *WoutT, *WqT, *keysb, *ub, *vb, *sguwb;
    float* ao; float* vln; float* sc; int* eidx; float* egate;
    float lam_init[DEPTH];
};

#define LDS_BYTES (144 * 1024)
#define NWAVES 8

__device__ __forceinline__ void transpose_item(const float* __restrict__ W, int K, int N, bf16_t* __restrict__ WT, LAS float* scr, int item, int lane) {
    const int nblk = N / 32, kb = item / nblk, nb = item % nblk, k0 = 64 * kb, n0 = 32 * nb;
#pragma unroll 8
    for (int i = 0; i < 32; ++i) { const int kk = 2 * i + (lane >> 5); scr[kk * 33 + (lane & 31)] = W[(size_t)(k0 + kk) * N + n0 + (lane & 31)]; }
    asm volatile("s_waitcnt lgkmcnt(0)" ::: "memory");
    const int c = lane & 7;
#pragma unroll
    for (int j = 0; j < 4; ++j) {
        const int n = (lane >> 3) + 8 * j; const LAS float* s = scr + (8 * c) * 33 + n;
        u32x4 o; o.x = pk2(s[0 * 33], s[1 * 33]); o.y = pk2(s[2 * 33], s[3 * 33]); o.z = pk2(s[4 * 33], s[5 * 33]); o.w = pk2(s[6 * 33], s[7 * 33]);
        *(u32x4*)(WT + (size_t)(n0 + n) * K + k0 + 8 * c) = o;
    }
    asm volatile("s_waitcnt lgkmcnt(0)" ::: "memory");
}
__device__ __forceinline__ void cvt8(const float* __restrict__ s, bf16_t* __restrict__ d) {
    const f32x4 a = *(const f32x4*)s, b = *(const f32x4*)(s + 4);
    u32x4 o; o.x = pk2(a[0], a[1]); o.y = pk2(a[2], a[3]); o.z = pk2(b[0], b[1]); o.w = pk2(b[2], b[3]);
    *(u32x4*)d = o;
}
__device__ __forceinline__ void phase_convert(const Params& p, LAS unsigned char* lds) {
    const int tid = threadIdx.x, wave = tid >> 6, lane = tid & 63;
    LAS float* scr = (LAS float*)(lds + wave * 16384);
    const int gw = blockIdx.x * NWAVES + wave, NGW = gridDim.x * NWAVES;
    constexpr int I_IN = (D_MODEL / 64) * (MIX_IN / 32), I_OUT = (D_MODEL / 64) * (D_MODEL / 32), I_Q = (D_MODEL / 64) * (2048 / 32), I_L = I_IN + I_OUT + I_Q;
    for (int it = gw; it < DEPTH * I_L; it += NGW) {
        const int l = it / I_L; int r = it % I_L;
        if (r < I_IN) { transpose_item(p.w_in + (size_t)l * D_MODEL * MIX_IN, D_MODEL, MIX_IN, p.WinT + (size_t)l * MIX_IN * D_MODEL, scr, r, lane); continue; } r -= I_IN;
        if (r < I_OUT) { transpose_item(p.w_out + (size_t)l * D_MODEL * D_MODEL, D_MODEL, D_MODEL, p.WoutT + (size_t)l * D_MODEL * D_MODEL, scr, r, lane); continue; } r -= I_OUT;
        transpose_item(p.peer_wq + (size_t)l * D_MODEL * 2048, D_MODEL, 2048, p.WqT + (size_t)l * 2048 * D_MODEL, scr, r, lane);
    }
    const size_t gt = (size_t)blockIdx.x * 512 + tid, NGT = (size_t)gridDim.x * 512;
    constexpr size_t N_KEYS8 = (size_t)DEPTH * 16 * 128 * 128 / 8, N_TAB8 = (size_t)DEPTH * NEXP * D_MODEL / 8, N_SGU8 = (size_t)DEPTH * 4 * 128 * 128 / 8;
    for (size_t i = gt; i < N_KEYS8; i += NGT) cvt8(p.peer_keys + i * 8, p.keysb + i * 8);
    for (size_t i = gt; i < N_TAB8; i += NGT) cvt8(p.peer_u + i * 8, p.ub + i * 8);
    for (size_t i = gt; i < N_TAB8; i += NGT) cvt8(p.peer_v + i * 8, p.vb + i * 8);
    for (size_t i = gt; i < N_SGU8; i += NGT) {
        const size_t e = i * 8; const int s0 = (int)(e & 127), t = (int)((e >> 7) & 127);
        const f32x4 a = *(const f32x4*)(p.sgu_w + e), b = *(const f32x4*)(p.sgu_w + e + 4);
        float v[8] = {a[0], a[1], a[2], a[3], b[0], b[1], b[2], b[3]};
#pragma unroll
        for (int j = 0; j < 8; ++j) v[j] = (s0 + j <= t) ? v[j] : 0.f;
        u32x4 o; o.x = pk2(v[0], v[1]); o.y = pk2(v[2], v[3]); o.z = pk2(v[4], v[5]); o.w = pk2(v[6], v[7]);
        *(u32x4*)(p.sguwb + e) = o;
    }
}

__device__ __forceinline__ void norm_row(const float* __restrict__ xr, const float* __restrict__ g, const float* __restrict__ sh, const float* __restrict__ sc, bf16_t* __restrict__ hr, int lane) {
    f32x4 v[4]; float ss = 0.f;
#pragma unroll
    for (int j = 0; j < 4; ++j) { v[j] = *(const f32x4*)(xr + j * 256 + lane * 4); ss += v[j][0] * v[j][0] + v[j][1] * v[j][1] + v[j][2] * v[j][2] + v[j][3] * v[j][3]; }
    const float rs = rsqrtf(wave_sum(ss) * (1.0f / D_MODEL) + 1e-6f);
#pragma unroll
    for (int j = 0; j < 4; ++j) {
        const int col = j * 256 + lane * 4;
        const f32x4 gv = *(const f32x4*)(g + col), scv = *(const f32x4*)(sc + col), shv = *(const f32x4*)(sh + col);
        f32x4 y;
#pragma unroll
        for (int e = 0; e < 4; ++e) y[e] = v[j][e] * rs * gv[e] * (1.0f + scv[e]) + shv[e];
        u32x2 o; o.x = pk2(y[0], y[1]); o.y = pk2(y[2], y[3]);
        *(u32x2*)(hr + col) = o;
    }
}
__device__ __forceinline__ void phase_norm(const Params& p, const float* __restrict__ x, const float* __restrict__ g, const float* __restrict__ modl, int sh_idx, int sc_idx) {
    const int wave = threadIdx.x >> 6, lane = threadIdx.x & 63;
    for (int t = blockIdx.x * NWAVES + wave; t < NTOK; t += gridDim.x * NWAVES) {
        const float* mb = modl + (size_t)(t / SEQ) * MODW;
        norm_row(x + (size_t)t * D_MODEL, g, mb + sh_idx * D_MODEL, mb + sc_idx * D_MODEL, p.hb + (size_t)t * D_MODEL, lane);
    }
}

struct EpiStoreBf16 {
    static constexpr bool PERM = true, AFTER_DRAIN = false;
    bf16_t* O; int ldc;
    __device__ __forceinline__ void operator()(const pg8::f32x4 (&acc)[2][2][4][2], const pg8::Unit& u, int wr, int wc, int fr, int fq) const {
        const int row0 = u.pm * 256 + wr * 64 + fr, col0 = u.pn * 256 + wc * 32 + 8 * fq;
#pragma unroll
        for (int ai = 0; ai < 2; ++ai)
#pragma unroll
            for (int m = 0; m < 4; ++m) {
                bf16_t* rowp = O + (size_t)(row0 + ai * 128 + m * 16) * ldc + col0;
#pragma unroll
                for (int bj = 0; bj < 2; ++bj) {
                    const pg8::f32x4 v0 = acc[ai][bj][m][0], v1 = acc[ai][bj][m][1];
                    u32x4 w; w.x = pk2(v0[0], v0[1]); w.y = pk2(v0[2], v0[3]); w.z = pk2(v1[0], v1[1]); w.w = pk2(v1[2], v1[3]);
                    *(u32x4*)(rowp + bj * 128) = w;
                }
            }
    }
};
struct EpiResid {
    static constexpr bool PERM = false, AFTER_DRAIN = false;
    const float* xin; float* xout; const float* gate;
    __device__ __forceinline__ void operator()(const pg8::f32x4 (&acc)[2][2][4][2], const pg8::Unit& u, int wr, int wc, int fr, int fq) const {
        const int row0 = u.pm * 256 + wr * 64 + fr, col0 = u.pn * 256 + wc * 32 + 4 * fq;
        const float* gb = gate + (size_t)((u.pm * 256) / SEQ) * MODW + col0;
        pg8::f32x4 gv[2][2];
#pragma unroll
        for (int bj = 0; bj < 2; ++bj)
#pragma unroll
            for (int n = 0; n < 2; ++n) gv[bj][n] = *(const pg8::f32x4*)(gb + bj * 128 + n * 16);
#pragma unroll
        for (int ai = 0; ai < 2; ++ai)
#pragma unroll
            for (int m = 0; m < 4; ++m) {
                const size_t off = (size_t)(row0 + ai * 128 + m * 16) * D_MODEL + col0;
#pragma unroll
                for (int bj = 0; bj < 2; ++bj)
#pragma unroll
                    for (int n = 0; n < 2; ++n) {
                        const pg8::f32x4 xv = *(const pg8::f32x4*)(xin + off + bj * 128 + n * 16);
                        *(pg8::f32x4*)(xout + off + bj * 128 + n * 16) = xv + gv[bj][n] * acc[ai][bj][m][n];
                    }
            }
    }
};

template <class Epi>
__device__ __forceinline__ void run_gemm(LAS unsigned char* lds, const bf16_t* A, const bf16_t* Bt, int M, int N, int K, const Epi& E) {
    pg8::StaticOrder S; S.init(M, N, (int)gridDim.x, (int)blockIdx.x);
    pg8::Gemm g; g.A = A; g.Bt = Bt; g.M = M; g.N = N; g.K = K;
    pg8::gemm_phase<Epi, pg8::StaticOrder, false>(lds, g, S, E, nullptr);
}

enum { PH_CONVERT = 0, PH_NORM1, PH_GEMM1, PH_GEMM2, PH_NORM2, PH_GEMM3 };
template <int PH>
__global__ void __launch_bounds__(512, 2) k_ph(Params p, int l) {
    extern __shared__ __attribute__((aligned(16))) unsigned char smem_raw[];
    LAS unsigned char* lds = (LAS unsigned char*)smem_raw;
    const float* modl = p.mod + (size_t)l * BATCH * MODW;
    if (PH == PH_CONVERT) phase_convert(p, lds);
    if (PH == PH_NORM1) phase_norm(p, l == 0 ? p.x_in : p.xb, p.norm1_g + l * D_MODEL, modl, 0, 1);
    if (PH == PH_GEMM1) { EpiStoreBf16 E; E.O = p.pb; E.ldc = MIX_IN; run_gemm(lds, p.hb, p.WinT + (size_t)l * MIX_IN * D_MODEL, NTOK, MIX_IN, D_MODEL, E); }
    if (PH == PH_GEMM2) { EpiResid E; E.xin = (l == 0) ? p.x_in : p.xb; E.xout = p.xb; E.gate = modl + 2 * D_MODEL; run_gemm(lds, p.cat, p.WoutT + (size_t)l * D_MODEL * D_MODEL, NTOK, D_MODEL, D_MODEL, E); }
    if (PH == PH_NORM2) phase_norm(p, p.xb, p.norm2_g + l * D_MODEL, modl, 3, 4);
    if (PH == PH_GEMM3) { EpiStoreBf16 E; E.O = p.qb; E.ldc = 2048; run_gemm(lds, p.hb, p.WqT + (size_t)l * 2048 * D_MODEL, NTOK, 2048, D_MODEL, E); }
}
typedef __bf16 bf16x2_t __attribute__((ext_vector_type(2)));
__device__ __forceinline__ float dot2bf(unsigned a, unsigned b, float c) { return __builtin_amdgcn_fdot2_f32_bf16(__builtin_bit_cast(bf16x2_t, a), __builtin_bit_cast(bf16x2_t, b), c, false); }

struct ERows { u32x4 u[4][2]; u32x4 v[4][2]; };

__device__ __forceinline__ void ex_load(ERows& R, const bf16_t* __restrict__ ut, const bf16_t* __restrict__ vt, int e0, int e1, int g, int lane) {
    const int ev = (g < 16) ? e0 : e1;
#pragma unroll
    for (int i = 0; i < 4; ++i) {
        const int e = __builtin_amdgcn_readlane(ev, (4 * g + i) & 63);
        const bf16_t* ur = ut + (size_t)e * D_MODEL + lane * 8;
        const bf16_t* vr = vt + (size_t)e * D_MODEL + lane * 8;
        R.u[i][0] = *(const u32x4*)ur; R.u[i][1] = *(const u32x4*)(ur + 512);
        R.v[i][0] = *(const u32x4*)vr; R.v[i][1] = *(const u32x4*)(vr + 512);
    }
}
__device__ __forceinline__ void ex_compute(const ERows& R, const unsigned (&hp)[8], float (&y)[16], float g0, float g1, int g, int lane) {
    float d[4];
#pragma unroll
    for (int i = 0; i < 4; ++i) {
        float s = 0.f;
#pragma unroll
        for (int j = 0; j < 4; ++j) { s = dot2bf(hp[j], R.u[i][0][j], s); s = dot2bf(hp[4 + j], R.u[i][1][j], s); }
        d[i] = s;
    }
    const bool hi = (lane & 32) != 0, hi2 = (lane & 16) != 0;
    float k0 = hi ? d[2] : d[0], k1 = hi ? d[3] : d[1];
    const float s0 = hi ? d[0] : d[2], s1 = hi ? d[1] : d[3];
    k0 += __shfl_xor(s0, 32, 64); k1 += __shfl_xor(s1, 32, 64);
    float kk = hi2 ? k1 : k0; const float sn = hi2 ? k0 : k1;
    kk += __shfl_xor(sn, 16, 64);
    kk += __shfl_xor(kk, 8, 64); kk += __shfl_xor(kk, 4, 64); kk += __shfl_xor(kk, 2, 64); kk += __shfl_xor(kk, 1, 64);
    const float gsel = (g < 16) ? g0 : g1;
    const float gk = __shfl(gsel, (4 * g + (lane >> 4)) & 63, 64);
    const float coef = gk * gelu_exact(kk);
#pragma unroll
    for (int i = 0; i < 4; ++i) {
        const float c = __int_as_float(__builtin_amdgcn_readlane(__float_as_int(coef), 16 * i));
#pragma unroll
        for (int j = 0; j < 4; ++j) {
            y[2 * j] += c * bflo(R.v[i][0][j]); y[2 * j + 1] += c * bfhi(R.v[i][0][j]);
            y[8 + 2 * j] += c * bflo(R.v[i][1][j]); y[8 + 2 * j + 1] += c * bfhi(R.v[i][1][j]);
        }
    }
}

template <bool LAST>
__device__ __forceinline__ void phase_expert(const Params& p, int l) {
    const int wave = threadIdx.x >> 6, lane = threadIdx.x & 63;
    const bf16_t* ut = p.ub + (size_t)l * NEXP * D_MODEL;
    const bf16_t* vt = p.vb + (size_t)l * NEXP * D_MODEL;
    const float* n2g = p.norm2_g + l * D_MODEL;
    const int c0 = lane * 8;
    for (int t = blockIdx.x * NWAVES + wave; t < NTOK; t += gridDim.x * NWAVES) {
        const float* mb = p.mod + ((size_t)l * BATCH + t / SEQ) * MODW;
        float xv[16];
        {
            const float* xr = p.xb + (size_t)t * D_MODEL;
            const f32x4 a = *(const f32x4*)(xr + c0), b = *(const f32x4*)(xr + c0 + 4), c = *(const f32x4*)(xr + 512 + c0), d = *(const f32x4*)(xr + 512 + c0 + 4);
#pragma unroll
            for (int e = 0; e < 4; ++e) { xv[e] = a[e]; xv[4 + e] = b[e]; xv[8 + e] = c[e]; xv[12 + e] = d[e]; }
        }
        float ss = 0.f;
#pragma unroll
        for (int e = 0; e < 16; ++e) ss += xv[e] * xv[e];
        const float rs = rsqrtf(wave_sum(ss) * (1.0f / D_MODEL) + 1e-6f);
        unsigned hp[8];
#pragma unroll
        for (int hh = 0; hh < 2; ++hh)
#pragma unroll
            for (int q = 0; q < 2; ++q) {
                const int col = hh * 512 + c0 + q * 4;
                const f32x4 gv = *(const f32x4*)(n2g + col), scv = *(const f32x4*)(mb + 4 * D_MODEL + col), shv = *(const f32x4*)(mb + 3 * D_MODEL + col);
                float h[4];
#pragma unroll
                for (int e = 0; e < 4; ++e) h[e] = xv[hh * 8 + q * 4 + e] * rs * gv[e] * (1.0f + scv[e]) + shv[e];
                hp[hh * 4 + q * 2] = pk2(h[0], h[1]); hp[hh * 4 + q * 2 + 1] = pk2(h[2], h[3]);
            }
        const int e0 = p.eidx[(size_t)t * 128 + lane], e1 = p.eidx[(size_t)t * 128 + 64 + lane];
        const float g0 = p.egate[(size_t)t * 128 + lane], g1 = p.egate[(size_t)t * 128 + 64 + lane];
        float y[16];
#pragma unroll
        for (int e = 0; e < 16; ++e) y[e] = 0.f;
        ERows RA, RB;
        ex_load(RA, ut, vt, e0, e1, 0, lane);
        for (int g = 0; g < 32; g += 2) {
            ex_load(RB, ut, vt, e0, e1, g + 1, lane);
            ex_compute(RA, hp, y, g0, g1, g, lane);
            if (g + 2 < 32) ex_load(RA, ut, vt, e0, e1, g + 2, lane);
            ex_compute(RB, hp, y, g0, g1, g + 1, lane);
        }
#pragma unroll
        for (int hh = 0; hh < 2; ++hh)
#pragma unroll
            for (int q = 0; q < 2; ++q) {
                const f32x4 g2 = *(const f32x4*)(mb + 5 * D_MODEL + hh * 512 + c0 + q * 4);
#pragma unroll
                for (int e = 0; e < 4; ++e) xv[hh * 8 + q * 4 + e] += g2[e] * y[hh * 8 + q * 4 + e];
            }
        float ss2 = 0.f;
#pragma unroll
        for (int e = 0; e < 16; ++e) ss2 += xv[e] * xv[e];
        const float rs2 = rsqrtf(wave_sum(ss2) * (1.0f / D_MODEL) + 1e-6f);
        if (LAST) {
#pragma unroll
            for (int hh = 0; hh < 2; ++hh)
#pragma unroll
                for (int q = 0; q < 2; ++q) {
                    const int col = hh * 512 + c0 + q * 4;
                    const f32x4 gv = *(const f32x4*)(p.final_g + col);
                    f32x4 o;
#pragma unroll
                    for (int e = 0; e < 4; ++e) o[e] = xv[hh * 8 + q * 4 + e] * rs2 * gv[e];
                    *(f32x4*)(p.out + (size_t)t * D_MODEL + col) = o;
                }
        } else {
            const float* mn = p.mod + ((size_t)(l + 1) * BATCH + t / SEQ) * MODW;
            const float* n1g = p.norm1_g + (l + 1) * D_MODEL;
#pragma unroll
            for (int hh = 0; hh < 2; ++hh)
#pragma unroll
                for (int q = 0; q < 2; ++q) {
                    const int col = hh * 512 + c0 + q * 4;
                    f32x4 xo;
#pragma unroll
                    for (int e = 0; e < 4; ++e) xo[e] = xv[hh * 8 + q * 4 + e];
                    *(f32x4*)(p.xb + (size_t)t * D_MODEL + col) = xo;
                    const f32x4 gv = *(const f32x4*)(n1g + col), scv = *(const f32x4*)(mn + 1 * D_MODEL + col), shv = *(const f32x4*)(mn + 0 * D_MODEL + col);
                    float h[4];
#pragma unroll
                    for (int e = 0; e < 4; ++e) h[e] = xo[e] * rs2 * gv[e] * (1.0f + scv[e]) + shv[e];
                    u32x2 o; o.x = pk2(h[0], h[1]); o.y = pk2(h[2], h[3]);
                    *(u32x2*)(p.hb + (size_t)t * D_MODEL + col) = o;
                }
        }
    }
}
template <bool LAST>
__global__ void __launch_bounds__(512, 2) k_expert(Params p, int l) { phase_expert<LAST>(p, l); }
typedef short s16x4 __attribute__((ext_vector_type(4)));
#define AT_KSTR 144
#define AT_VSTR 192
#define AT_KBUF 0
#define AT_VBUF 18432
#define AT_TBL  43008
#define AT_OEX  44032
#define AT_OSTR 272

__device__ __forceinline__ void phase_attn(const Params& p, int l, LAS unsigned char* lds) {
    const int tid = threadIdx.x, wave = tid >> 6, lane = tid & 63;
    const int w4 = wave & 3, m = wave >> 2, c = lane & 31, h = lane >> 5;
    const float LOG2E = 1.4426950408889634f;
    const float qscale = 0.17677669529663687f * LOG2E;
    float d01 = 0.f, d23 = 0.f;
    { const float* lp = p.diff_lambda + l * 128;
      for (int i = 0; i < 32; ++i) { d01 += lp[i] * lp[32 + i]; d23 += lp[64 + i] * lp[96 + i]; } }
    const float lam_init = p.lam_init[l];
    const float lam = expf(d01) - expf(d23) + lam_init;
    const float osc = 1.0f - lam_init;
    LAS float* tbl = (LAS float*)(lds + AT_TBL);
    const int skey = tid >> 3, sch = tid & 7;
    const int g16 = lane >> 4, li = lane & 15, tq = li >> 2, tp = li & 3;

    for (int u = blockIdx.x; u < 256; u += gridDim.x) {
        const int pi = u & 7, hd = (u >> 3) & 3, b = u >> 5;
        if (tid < 256) { const int bk = tid < 128 ? (int)kBucket[tid] : 31; tbl[tid] = p.rel_bias[bk * 4 + hd] * LOG2E; }
        const float c31 = p.rel_bias[31 * 4 + hd] * LOG2E;
        const bf16_t* pbase = p.pb + (size_t)b * SEQ * MIX_IN;
        const bf16_t* kg = pbase + (size_t)skey * MIX_IN + 256 + hd * 64 + sch * 8;
        const bf16_t* vg = pbase + (size_t)skey * MIX_IN + 512 + hd * 64 + sch * 8;
        for (int half = 0; half < 2; ++half) {
            const int qb = half ? 15 - pi : pi;
            const int q0w = qb * 128 + 32 * w4, nkt = 2 * qb + 2;
            const int qpos = q0w + c;
            bf16x8 qf0, qf1;
            { const bf16_t* qp = pbase + (size_t)qpos * MIX_IN + hd * 64 + m * 32 + 8 * h; qf0 = *(const bf16x8*)qp; qf1 = *(const bf16x8*)(qp + 16); }
            f32x16 O0, O1;
#pragma unroll
            for (int r = 0; r < 16; ++r) { O0[r] = 0.f; O1[r] = 0.f; }
            float mrun = -1e30f, lrun = 0.f;
            u32x4 kreg = *(const u32x4*)kg, vreg = *(const u32x4*)vg;
            *(LAS u32x4*)(lds + AT_KBUF + skey * AT_KSTR + sch * 16) = kreg;
            *(LAS u32x4*)(lds + AT_VBUF + skey * AT_VSTR + sch * 16) = vreg;
            __syncthreads();
            for (int kt = 0; kt < nkt; ++kt) {
                const int k0 = kt * 64, cur = kt & 1;
                if (kt + 1 < nkt) { kreg = *(const u32x4*)(kg + (size_t)(k0 + 64) * MIX_IN); vreg = *(const u32x4*)(vg + (size_t)(k0 + 64) * MIX_IN); }
                if (k0 <= q0w + 31) {
                    LAS unsigned char* kb_ = lds + AT_KBUF + cur * (64 * AT_KSTR);
                    LAS unsigned char* vb_ = lds + AT_VBUF + cur * (64 * AT_VSTR);
                    f32x16 s0, s1;
#pragma unroll
                    for (int r = 0; r < 16; ++r) { s0[r] = 0.f; s1[r] = 0.f; }
                    {
                        const LAS unsigned char* ka = kb_ + c * AT_KSTR + m * 64 + h * 16;
                        const bf16x8 a00 = *(const LAS bf16x8*)ka, a01 = *(const LAS bf16x8*)(ka + 32);
                        const bf16x8 a10 = *(const LAS bf16x8*)(ka + 32 * AT_KSTR), a11 = *(const LAS bf16x8*)(ka + 32 * AT_KSTR + 32);
                        s0 = __builtin_amdgcn_mfma_f32_32x32x16_bf16(a00, qf0, s0, 0, 0, 0);
                        s0 = __builtin_amdgcn_mfma_f32_32x32x16_bf16(a01, qf1, s0, 0, 0, 0);
                        s1 = __builtin_amdgcn_mfma_f32_32x32x16_bf16(a10, qf0, s1, 0, 0, 0);
                        s1 = __builtin_amdgcn_mfma_f32_32x32x16_bf16(a11, qf1, s1, 0, 0, 0);
                    }
                    const bool far = (q0w - (k0 + 63)) >= 113;
                    if (far) {
#pragma unroll
                        for (int r = 0; r < 16; ++r) { s0[r] = s0[r] * qscale + c31; s1[r] = s1[r] * qscale + c31; }
                    } else {
                        const int dbase = qpos - k0 - 4 * h;
#pragma unroll
                        for (int r = 0; r < 16; ++r) {
                            const int d0 = dbase - ((r & 3) + 8 * (r >> 2)), d1 = d0 - 32;
                            const float b0 = tbl[min(max(d0, 0), 255)], b1 = tbl[min(max(d1, 0), 255)];
                            const float v0 = s0[r] * qscale + b0, v1 = s1[r] * qscale + b1;
                            s0[r] = d0 < 0 ? -1e30f : v0; s1[r] = d1 < 0 ? -1e30f : v1;
                        }
                    }
                    float tmax = fmaxf(s0[0], s1[0]);
#pragma unroll
                    for (int r = 1; r < 16; ++r) tmax = fmaxf(tmax, fmaxf(s0[r], s1[r]));
                    tmax = fmaxf(tmax, __shfl_xor(tmax, 32, 64));
                    const float mnew = fmaxf(mrun, tmax);
                    const float alpha = __builtin_amdgcn_exp2f(mrun - mnew);
                    mrun = mnew;
                    float psum = 0.f;
#pragma unroll
                    for (int r = 0; r < 16; ++r) { s0[r] = __builtin_amdgcn_exp2f(s0[r] - mnew); s1[r] = __builtin_amdgcn_exp2f(s1[r] - mnew); psum += s0[r] + s1[r]; }
                    lrun = lrun * alpha + psum;
#pragma unroll
                    for (int r = 0; r < 16; ++r) { O0[r] *= alpha; O1[r] *= alpha; }
#pragma unroll
                    for (int kb = 0; kb < 2; ++kb)
#pragma unroll
                        for (int sp = 0; sp < 2; ++sp) {
                            u32x4 pw;
                            if (kb == 0) { pw.x = pk2(s0[8 * sp + 0], s0[8 * sp + 1]); pw.y = pk2(s0[8 * sp + 2], s0[8 * sp + 3]); pw.z = pk2(s0[8 * sp + 4], s0[8 * sp + 5]); pw.w = pk2(s0[8 * sp + 6], s0[8 * sp + 7]); }
                            else         { pw.x = pk2(s1[8 * sp + 0], s1[8 * sp + 1]); pw.y = pk2(s1[8 * sp + 2], s1[8 * sp + 3]); pw.z = pk2(s1[8 * sp + 4], s1[8 * sp + 5]); pw.w = pk2(s1[8 * sp + 6], s1[8 * sp + 7]); }
                            const bf16x8 pf = __builtin_bit_cast(bf16x8, pw);
                            const int kA = 32 * kb + 16 * sp + 4 * h;
#pragma unroll
                            for (int mb = 0; mb < 2; ++mb) {
                                LAS unsigned char* va = vb_ + (kA + tq) * AT_VSTR + (32 * mb + 16 * (g16 & 1) + 4 * tp) * 2;
                                const s16x4 t0 = __builtin_amdgcn_ds_read_tr16_b64_v4i16((LAS s16x4*)va);
                                const s16x4 t1 = __builtin_amdgcn_ds_read_tr16_b64_v4i16((LAS s16x4*)(va + 8 * AT_VSTR));
                                const bf16x8 vf = {t0[0], t0[1], t0[2], t0[3], t1[0], t1[1], t1[2], t1[3]};
                                if (mb == 0) O0 = __builtin_amdgcn_mfma_f32_32x32x16_bf16(vf, pf, O0, 0, 0, 0);
                                else         O1 = __builtin_amdgcn_mfma_f32_32x32x16_bf16(vf, pf, O1, 0, 0, 0);
                            }
                        }
                }
                if (kt + 1 < nkt) {
                    *(LAS u32x4*)(lds + AT_KBUF + (cur ^ 1) * (64 * AT_KSTR) + skey * AT_KSTR + sch * 16) = kreg;
                    *(LAS u32x4*)(lds + AT_VBUF + (cur ^ 1) * (64 * AT_VSTR) + skey * AT_VSTR + sch * 16) = vreg;
                }
                __syncthreads();
            }
            const float inv = 1.0f / (lrun + __shfl_xor(lrun, 32, 64));
            LAS unsigned char* oex = lds + AT_OEX + (32 * w4 + c) * AT_OSTR + 16 * h;
            if (m == 1) {
#pragma unroll
                for (int r4 = 0; r4 < 4; ++r4) {
                    f32x4 a, bq;
#pragma unroll
                    for (int e = 0; e < 4; ++e) { a[e] = O0[4 * r4 + e] * inv; bq[e] = O1[4 * r4 + e] * inv; }
                    *(LAS f32x4*)(oex + (8 * r4) * 4) = a;
                    *(LAS f32x4*)(oex + (32 + 8 * r4) * 4) = bq;
                }
            }
            __syncthreads();
            if (m == 0) {
                float ss = 0.f;
#pragma unroll
                for (int r4 = 0; r4 < 4; ++r4) {
                    const f32x4 a = *(const LAS f32x4*)(oex + (8 * r4) * 4), bq = *(const LAS f32x4*)(oex + (32 + 8 * r4) * 4);
#pragma unroll
                    for (int e = 0; e < 4; ++e) {
                        O0[4 * r4 + e] = O0[4 * r4 + e] * inv - lam * a[e]; O1[4 * r4 + e] = O1[4 * r4 + e] * inv - lam * bq[e];
                        ss += O0[4 * r4 + e] * O0[4 * r4 + e] + O1[4 * r4 + e] * O1[4 * r4 + e];
                    }
                }
                ss += __shfl_xor(ss, 32, 64);
                const float rstd = rsqrtf(ss * (1.0f / 64.0f) + 1e-6f) * osc;
                bf16_t* orow = p.cat + (size_t)(b * SEQ + qpos) * D_MODEL + hd * 64 + 4 * h;
                const float* sg = p.subln_g + l * 64 + 4 * h;
#pragma unroll
                for (int r4 = 0; r4 < 4; ++r4) {
                    const f32x4 ga = *(const f32x4*)(sg + 8 * r4), gb = *(const f32x4*)(sg + 32 + 8 * r4);
                    u32x2 oa, ob;
                    oa.x = pk2(O0[4 * r4 + 0] * rstd * ga[0], O0[4 * r4 + 1] * rstd * ga[1]); oa.y = pk2(O0[4 * r4 + 2] * rstd * ga[2], O0[4 * r4 + 3] * rstd * ga[3]);
                    ob.x = pk2(O1[4 * r4 + 0] * rstd * gb[0], O1[4 * r4 + 1] * rstd * gb[1]); ob.y = pk2(O1[4 * r4 + 2] * rstd * gb[2], O1[4 * r4 + 3] * rstd * gb[3]);
                    *(u32x2*)(orow + 8 * r4) = oa;
                    *(u32x2*)(orow + 32 + 8 * r4) = ob;
                }
            }
            __syncthreads();
        }
    }
}
template <int DUMMY>
__global__ void __launch_bounds__(512, 2) k_attn2(Params p, int l) {
    extern __shared__ __attribute__((aligned(16))) unsigned char smem_raw[];
    phase_attn(p, l, (LAS unsigned char*)smem_raw);
}
#define MR_VSTR 272

__device__ __forceinline__ void mixrest_conv(const Params& p, int l, int chunk, LAS unsigned char* lds) {
    const int tid = threadIdx.x, wave = tid >> 6, lane = tid & 63;
    const int t0 = chunk * 128, s0 = t0 % SEQ;
    LAS float* glu = (LAS float*)lds;
    const int c = tid & 255, th = tid >> 8;
    float w[31];
#pragma unroll
    for (int j = 0; j < 31; ++j) w[j] = p.conf_dw[((size_t)l * 31 + j) * 256 + c];
    for (int hf = 0; hf < 2; ++hf) {
        const int tb = t0 + hf * 64;
        for (int it = tid; it < 94 * 32; it += 512) {
            const int i = it >> 5, c8 = (it & 31) * 8;
            const int sp = s0 + hf * 64 - 30 + i;
            f32x4 o0 = {0.f, 0.f, 0.f, 0.f}, o1 = {0.f, 0.f, 0.f, 0.f};
            if (sp >= 0) {
                const bf16_t* pr = p.pb + (size_t)(tb - 30 + i) * MIX_IN;
                const u32x4 a = *(const u32x4*)(pr + 3 * 256 + c8), g = *(const u32x4*)(pr + 4 * 256 + c8);
                o0[0] = bflo(a.x) * sigmoidf_(bflo(g.x)); o0[1] = bfhi(a.x) * sigmoidf_(bfhi(g.x));
                o0[2] = bflo(a.y) * sigmoidf_(bflo(g.y)); o0[3] = bfhi(a.y) * sigmoidf_(bfhi(g.y));
                o1[0] = bflo(a.z) * sigmoidf_(bflo(g.z)); o1[1] = bfhi(a.z) * sigmoidf_(bfhi(g.z));
                o1[2] = bflo(a.w) * sigmoidf_(bflo(g.w)); o1[3] = bfhi(a.w) * sigmoidf_(bfhi(g.w));
            }
            *(LAS f32x4*)(glu + i * 256 + c8) = o0; *(LAS f32x4*)(glu + i * 256 + c8 + 4) = o1;
        }
        __syncthreads();
        float acc[32];
#pragma unroll
        for (int o = 0; o < 32; ++o) acc[o] = 0.f;
#pragma unroll
        for (int i = 0; i < 62; ++i) {
            const float xval = glu[(th * 32 + i) * 256 + c];
#pragma unroll
            for (int o = 0; o < 32; ++o) if (i - o >= 0 && i - o <= 30) acc[o] += w[i - o] * xval;
        }
        __syncthreads();
#pragma unroll
        for (int o = 0; o < 32; ++o) glu[(th * 32 + o) * 256 + c] = acc[o];
        __syncthreads();
        const f32x4 lg = *(const f32x4*)(p.conf_ln_g + l * 256 + lane * 4), lb = *(const f32x4*)(p.conf_ln_b + l * 256 + lane * 4);
        for (int k = 0; k < 8; ++k) {
            const int tk = wave * 8 + k;
            const f32x4 z = *(const LAS f32x4*)(glu + tk * 256 + lane * 4);
            const float mu = wave_sum(z[0] + z[1] + z[2] + z[3]) * (1.0f / 256.0f);
            f32x4 dz; float sq = 0.f;
#pragma unroll
            for (int e = 0; e < 4; ++e) { dz[e] = z[e] - mu; sq += dz[e] * dz[e]; }
            const float rstd = rsqrtf(wave_sum(sq) * (1.0f / 256.0f) + 1e-6f);
            float y[4];
#pragma unroll
            for (int e = 0; e < 4; ++e) { const float v = dz[e] * rstd * lg[e] + lb[e]; y[e] = v * sigmoidf_(v); }
            u32x2 o; o.x = pk2(y[0], y[1]); o.y = pk2(y[2], y[3]);
            *(u32x2*)(p.cat + (size_t)(tb + tk) * D_MODEL + 256 + lane * 4) = o;
        }
        __syncthreads();
    }
}

__device__ __forceinline__ void mixrest_sgu(const Params& p, int l, int chunk, LAS unsigned char* lds) {
    const int tid = threadIdx.x, wave = tid >> 6, lane = tid & 63;
    const int t0 = chunk * 128, s0 = t0 % SEQ;
    {
        const float* sw = p.sconv_w + (size_t)l * 3 * 256;
        for (int it = tid; it < 128 * 32; it += 512) {
            const int tt = it >> 5, c8 = (it & 31) * 8;
            const bf16_t* pr = p.pb + (size_t)(t0 + tt) * MIX_IN;
            float z[8];
#pragma unroll
            for (int e = 0; e < 8; ++e) z[e] = 0.f;
#pragma unroll
            for (int j = 0; j < 3; ++j) {
                if (s0 + tt - 2 + j >= 0) {
                    const bf16_t* q = pr + (ptrdiff_t)(j - 2) * MIX_IN;
                    const u32x4 a = *(const u32x4*)(q + 6 * 256 + c8), bq = *(const u32x4*)(q + 7 * 256 + c8);
                    const f32x4 w0 = *(const f32x4*)(sw + j * 256 + c8), w1 = *(const f32x4*)(sw + j * 256 + c8 + 4);
                    z[0] += w0[0] * bflo(a.x) * bflo(bq.x); z[1] += w0[1] * bfhi(a.x) * bfhi(bq.x);
                    z[2] += w0[2] * bflo(a.y) * bflo(bq.y); z[3] += w0[3] * bfhi(a.y) * bfhi(bq.y);
                    z[4] += w1[0] * bflo(a.z) * bflo(bq.z); z[5] += w1[1] * bfhi(a.z) * bfhi(bq.z);
                    z[6] += w1[2] * bflo(a.w) * bflo(bq.w); z[7] += w1[3] * bfhi(a.w) * bfhi(bq.w);
                }
            }
            const u32x4 cb = *(const u32x4*)(pr + 5 * 256 + c8);
            u32x4 o;
            o.x = pk2(bflo(cb.x) * z[0], bfhi(cb.x) * z[1]); o.y = pk2(bflo(cb.y) * z[2], bfhi(cb.y) * z[3]);
            o.z = pk2(bflo(cb.z) * z[4], bfhi(cb.z) * z[5]); o.w = pk2(bflo(cb.w) * z[6], bfhi(cb.w) * z[7]);
            *(u32x4*)(p.cat + (size_t)(t0 + tt) * D_MODEL + 512 + c8) = o;
        }
    }
    {
        const f32x4 lg = *(const f32x4*)(p.sgu_ln_g + l * 256 + lane * 4), lb = *(const f32x4*)(p.sgu_ln_b + l * 256 + lane * 4);
        for (int k = 0; k < 16; ++k) {
            const int s = wave * 16 + k;
            const u32x2 raw = *(const u32x2*)(p.pb + (size_t)(t0 + s) * MIX_IN + 9 * 256 + lane * 4);
            float v[4] = {gelu_exact(bflo(raw.x)), gelu_exact(bfhi(raw.x)), gelu_exact(bflo(raw.y)), gelu_exact(bfhi(raw.y))};
            const float mu = wave_sum(v[0] + v[1] + v[2] + v[3]) * (1.0f / 256.0f);
            float sq = 0.f;
#pragma unroll
            for (int e = 0; e < 4; ++e) { v[e] -= mu; sq += v[e] * v[e]; }
            const float rstd = rsqrtf(wave_sum(sq) * (1.0f / 256.0f) + 1e-6f);
#pragma unroll
            for (int e = 0; e < 4; ++e) *(LAS bf16_t*)(lds + (lane * 4 + e) * MR_VSTR + s * 2) = f2bf(v[e] * rstd * lg[e] + lb[e]);
        }
    }
    __syncthreads();
    {
        const int hq = wave & 3, mb = wave >> 2, c = lane & 31, hh = lane >> 5;
        bf16x8 af[8];
#pragma unroll
        for (int ks = 0; ks < 8; ++ks) af[ks] = *(const LAS bf16x8*)(lds + (hq * 64 + mb * 32 + c) * MR_VSTR + (16 * ks + 8 * hh) * 2);
        const bf16_t* wb = p.sguwb + ((size_t)(l * 4 + hq) * 128) * 128;
        f32x16 acc[4];
#pragma unroll
        for (int nb = 0; nb < 4; ++nb) {
#pragma unroll
            for (int r = 0; r < 16; ++r) acc[nb][r] = 0.f;
#pragma unroll
            for (int ks = 0; ks < 2 * nb + 2; ++ks) {
                const bf16x8 bfrag = *(const bf16x8*)(wb + (size_t)(32 * nb + c) * 128 + 16 * ks + 8 * hh);
                acc[nb] = __builtin_amdgcn_mfma_f32_32x32x16_bf16(af[ks], bfrag, acc[nb], 0, 0, 0);
            }
        }
        const float* bs = p.sgu_b + (size_t)(l * 4 + hq) * 128;
#pragma unroll
        for (int nb = 0; nb < 4; ++nb) {
            const int tt = 32 * nb + c;
            const float bias = bs[tt];
            const bf16_t* su = p.pb + (size_t)(t0 + tt) * MIX_IN + 8 * 256 + hq * 64 + mb * 32 + 4 * hh;
            bf16_t* orow = p.cat + (size_t)(t0 + tt) * D_MODEL + 768 + hq * 64 + mb * 32 + 4 * hh;
#pragma unroll
            for (int r4 = 0; r4 < 4; ++r4) {
                const u32x2 raw = *(const u32x2*)(su + 8 * r4);
                u32x2 o;
                o.x = pk2(gelu_exact(bflo(raw.x)) * (acc[nb][4 * r4 + 0] + bias), gelu_exact(bfhi(raw.x)) * (acc[nb][4 * r4 + 1] + bias));
                o.y = pk2(gelu_exact(bflo(raw.y)) * (acc[nb][4 * r4 + 2] + bias), gelu_exact(bfhi(raw.y)) * (acc[nb][4 * r4 + 3] + bias));
                *(u32x2*)(orow + 8 * r4) = o;
            }
        }
    }
    __syncthreads();
}

__device__ __forceinline__ void phase_mixrest(const Params& p, int l, LAS unsigned char* lds) {
    for (int u = blockIdx.x; u < 256; u += gridDim.x) {
        const int chunk = u >> 1;
        if (u & 1) mixrest_sgu(p, l, chunk, lds); else mixrest_conv(p, l, chunk, lds);
    }
}
template <int DUMMY>
__global__ void __launch_bounds__(512, 2) k_mixrest(Params p, int l) {
    extern __shared__ __attribute__((aligned(16))) unsigned char smem_raw[];
    phase_mixrest(p, l, (LAS unsigned char*)smem_raw);
}
__device__ __forceinline__ int f2sortable(float f) { const int x = __float_as_int(f); return x ^ ((x >> 31) & 0x7FFFFFFF); }
__device__ __forceinline__ float sortable2f(int s) { return __int_as_float(s ^ ((s >> 31) & 0x7FFFFFFF)); }

template <int N>
__device__ __forceinline__ void bitonic_sort_desc(int (&a)[N]) {
#pragma unroll
    for (int k = 2; k <= N; k <<= 1)
#pragma unroll
        for (int j = k >> 1; j > 0; j >>= 1)
#pragma unroll
            for (int i = 0; i < N; ++i) {
                const int q = i ^ j;
                if (q > i) {
                    const int hi = max(a[i], a[q]), lo = min(a[i], a[q]);
                    if ((i & k) == 0 || k == N) { a[i] = hi; a[q] = lo; } else { a[i] = lo; a[q] = hi; }
                }
            }
}
__device__ __forceinline__ void bitonic_merge_desc16(int (&a)[16]) {
#pragma unroll
    for (int j = 8; j > 0; j >>= 1)
#pragma unroll
        for (int i = 0; i < 16; ++i) {
            const int q = i ^ j;
            if (q > i) { const int hi = max(a[i], a[q]), lo = min(a[i], a[q]); a[i] = hi; a[q] = lo; }
        }
}
__device__ __forceinline__ void merge_top16(int (&a)[16], const int (&b)[16]) {
#pragma unroll
    for (int i = 0; i < 16; ++i) a[i] = max(a[i], b[15 - i]);
    bitonic_merge_desc16(a);
}

__device__ __forceinline__ void phase_topk(const Params& p, int l, LAS unsigned char* lds) {
    const int wave = threadIdx.x >> 6, lane = threadIdx.x & 63, c = lane & 31, hh = lane >> 5;
    const int hd = wave;
    LAS unsigned char* ilist = lds + wave * 1024 + c * 32;
    const int hx = hh << 2;
    for (int u = blockIdx.x; u < NTOK / 32; u += gridDim.x) {
        const int t = u * 32 + c;
        int S0[16], S1[16];
#pragma unroll
        for (int pp = 0; pp < 2; ++pp) {
            const bf16_t* qp = p.qb + (size_t)t * 2048 + hd * 256 + pp * 128 + 8 * hh;
            bf16x8 qf[8];
#pragma unroll
            for (int ks = 0; ks < 8; ++ks) qf[ks] = *(const bf16x8*)(qp + 16 * ks);
            const bf16_t* kp = p.keysb + ((size_t)((l * 8 + hd) * 2 + pp) * 128 + c) * 128 + 8 * hh;
            int K0[16], K1[16], K2[16], K3[16];
#pragma unroll
            for (int kb = 0; kb < 4; ++kb) {
                f32x16 acc;
#pragma unroll
                for (int r = 0; r < 16; ++r) acc[r] = 0.f;
#pragma unroll
                for (int ks = 0; ks < 8; ++ks) {
                    const bf16x8 a = *(const bf16x8*)(kp + (size_t)(32 * kb) * 128 + 16 * ks);
                    acc = __builtin_amdgcn_mfma_f32_32x32x16_bf16(a, qf[ks], acc, 0, 0, 0);
                }
#pragma unroll
                for (int r = 0; r < 16; ++r) {
                    const int nconst = 32 * kb + (r & 3) + 8 * (r >> 2);
                    const int key = (f2sortable(acc[r]) & ~0x7F) | (127 - nconst);
                    if (kb == 0) K0[r] = key; else if (kb == 1) K1[r] = key; else if (kb == 2) K2[r] = key; else K3[r] = key;
                }
            }
            bitonic_sort_desc<16>(K0); bitonic_sort_desc<16>(K1); bitonic_sort_desc<16>(K2); bitonic_sort_desc<16>(K3);
            merge_top16(K0, K1); merge_top16(K2, K3); merge_top16(K0, K2);
            int P[16];
#pragma unroll
            for (int i = 0; i < 16; ++i) { K0[i] ^= hx; P[i] = __shfl_xor(K0[i], 32, 64); }
            merge_top16(K0, P);
#pragma unroll
            for (int i = 0; i < 16; ++i) { if (pp == 0) S0[i] = K0[i]; else S1[i] = K0[i]; }
        }
        {
            unsigned w4[4];
#pragma unroll
            for (int q = 0; q < 4; ++q) {
                unsigned w = 0;
#pragma unroll
                for (int e = 0; e < 4; ++e) { const int sv = hh ? S1[4 * q + e] : S0[4 * q + e]; w |= (unsigned)(127 - (sv & 127)) << (8 * e); }
                w4[q] = w;
            }
            u32x4 wv; wv.x = w4[0]; wv.y = w4[1]; wv.z = w4[2]; wv.w = w4[3];
            *(LAS u32x4*)(ilist + 16 * hh) = wv;
        }
        float a[16], b[16];
#pragma unroll
        for (int i = 0; i < 16; ++i) {
            const float f1 = sortable2f(S0[i] & ~0x7F), f2 = sortable2f(S1[i] & ~0x7F);
            a[i] = hh ? f2 : f1; b[i] = hh ? f1 : f2;
        }
        int CA[16], CB[16];
        const int org = hh << 8;
        {
            int n = 0;
#pragma unroll
            for (int i = 0; i < 4; ++i)
#pragma unroll
                for (int j = i; j < 16; ++j) {
                    if ((i + 1) * (j + 1) <= 16) {
                        int key = (f2sortable(a[i] + b[j]) & ~0x1FF) | org | (i * 16 + j);
                        if (i == j) key = hh ? (int)0x80000000 : key;
                        if (n < 16) CA[n] = key; else CB[n - 16] = key;
                        ++n;
                    }
                }
#pragma unroll
            for (int q = 27; q < 32; ++q) CB[q - 16] = (int)0x80000000;
        }
        bitonic_sort_desc<16>(CA); bitonic_sort_desc<16>(CB);
        merge_top16(CA, CB);
        int F[16], PF[16];
#pragma unroll
        for (int i = 0; i < 16; ++i) PF[i] = __shfl_xor(CA[i], 32, 64);
#pragma unroll
        for (int i = 0; i < 16; ++i) F[i] = max(CA[i], PF[15 - i]);
        int mxk = F[0];
#pragma unroll
        for (int i = 1; i < 16; ++i) mxk = max(mxk, F[i]);
        const float vmax = sortable2f(mxk & ~0x1FF);
        float e[8], psum = 0.f;
#pragma unroll
        for (int i = 0; i < 8; ++i) { e[i] = __expf(sortable2f(F[i] & ~0x1FF) - vmax); psum += e[i]; }
        const float inv = 1.0f / (psum + __shfl_xor(psum, 32, 64));
        asm volatile("s_waitcnt lgkmcnt(0)" ::: "memory");
        int ex[8];
#pragma unroll
        for (int i = 0; i < 8; ++i) {
            const int low = F[i] & 0x1FF, o = low >> 8, il = (low >> 4) & 15, jl = low & 15;
            const int ri = o ? jl : il, rj = o ? il : jl;
            const int i1 = (int)*(const LAS unsigned char*)(ilist + ri), i2 = (int)*(const LAS unsigned char*)(ilist + 16 + rj);
            ex[i] = i1 * 128 + i2;
        }
        int* ep = p.eidx + ((size_t)t * 8 + hd) * 16 + hh * 8;
        float* gp = p.egate + ((size_t)t * 8 + hd) * 16 + hh * 8;
        *(u32x4*)ep = (u32x4){(unsigned)ex[0], (unsigned)ex[1], (unsigned)ex[2], (unsigned)ex[3]};
        *(u32x4*)(ep + 4) = (u32x4){(unsigned)ex[4], (unsigned)ex[5], (unsigned)ex[6], (unsigned)ex[7]};
        *(f32x4*)gp = (f32x4){e[0] * inv, e[1] * inv, e[2] * inv, e[3] * inv};
        *(f32x4*)(gp + 4) = (f32x4){e[4] * inv, e[5] * inv, e[6] * inv, e[7] * inv};
        asm volatile("s_waitcnt lgkmcnt(0)" ::: "memory");
    }
}
template <int DUMMY>
__global__ void __launch_bounds__(512, 2) k_topk(Params p, int l) {
    extern __shared__ __attribute__((aligned(16))) unsigned char smem_raw[];
    phase_topk(p, l, (LAS unsigned char*)smem_raw);
}

extern "C" void kernel_launch(void* const* d_in, const int* in_sizes, int n_in, void* d_out, int out_size, void* d_ws, size_t ws_size, hipStream_t stream) {
    Params p{};
    p.x_in = (const float*)d_in[0]; p.c = (const float*)d_in[1]; p.rel_bias = (const float*)d_in[2]; p.w_mod = (const float*)d_in[3]; p.b_mod = (const float*)d_in[4];
    p.norm1_g = (const float*)d_in[5]; p.norm2_g = (const float*)d_in[6]; p.w_in = (const float*)d_in[7]; p.w_out = (const float*)d_in[8]; p.diff_lambda = (const float*)d_in[9];
    p.subln_g = (const float*)d_in[10]; p.conf_dw = (const float*)d_in[11]; p.conf_ln_g = (const float*)d_in[12]; p.conf_ln_b = (const float*)d_in[13]; p.sconv_w = (const float*)d_in[14];
    p.sgu_ln_g = (const float*)d_in[15]; p.sgu_ln_b = (const float*)d_in[16]; p.sgu_w = (const float*)d_in[17]; p.sgu_b = (const float*)d_in[18]; p.peer_wq = (const float*)d_in[19];
    p.peer_keys = (const float*)d_in[20]; p.peer_u = (const float*)d_in[21]; p.peer_v = (const float*)d_in[22]; p.final_g = (const float*)d_in[23];
    p.out = (float*)d_out;
    for (int l = 0; l < DEPTH; ++l) p.lam_init[l] = (float)(0.8 - 0.6 * exp(-0.3 * (double)l));

    char* ws = (char*)d_ws; size_t off = 0;
    auto take = [&](size_t bytes) { void* r = ws + off; off += (bytes + 255) & ~(size_t)255; return r; };
    p.bar = (unsigned*)take((size_t)XCD_BAR_WORDS * 4);
    p.mod = (float*)take((size_t)DEPTH * BATCH * MODW * 4);
    p.xb = (float*)take((size_t)NTOK * D_MODEL * 4);
    p.hb = (bf16_t*)take((size_t)NTOK * D_MODEL * 2);
    p.pb = (bf16_t*)take((size_t)NTOK * MIX_IN * 2);
    p.cat = (bf16_t*)take((size_t)NTOK * D_MODEL * 2);
    p.qb = (bf16_t*)take((size_t)NTOK * 2048 * 2);
    p.WinT = (bf16_t*)take((size_t)DEPTH * MIX_IN * D_MODEL * 2);
    p.WoutT = (bf16_t*)take((size_t)DEPTH * D_MODEL * D_MODEL * 2);
    p.WqT = (bf16_t*)take((size_t)DEPTH * 2048 * D_MODEL * 2);
    p.keysb = (bf16_t*)take((size_t)DEPTH * 16 * 128 * 128 * 2);
    p.ub = (bf16_t*)take((size_t)DEPTH * NEXP * D_MODEL * 2);
    p.vb = (bf16_t*)take((size_t)DEPTH * NEXP * D_MODEL * 2);
    p.sguwb = (bf16_t*)take((size_t)DEPTH * 4 * 128 * 128 * 2);
    p.ao = (float*)take((size_t)NTOK * 512 * 4);
    p.vln = (float*)take((size_t)NTOK * 256 * 4);
    p.sc = (float*)take((size_t)NTOK * 2048 * 4);
    p.eidx = (int*)take((size_t)NTOK * 128 * 4);
    p.egate = (float*)take((size_t)NTOK * 128 * 4);

    static int grid = 0;
    if (grid == 0) {
        int dev = 0, cus = 0;
        if (hipGetDevice(&dev) != hipSuccess || hipDeviceGetAttribute(&cus, hipDeviceAttributeMultiprocessorCount, dev) != hipSuccess) { grid = -1; return; }
        bool ok = true;
        ok &= hipFuncSetAttribute((const void*)k_ph<PH_CONVERT>, hipFuncAttributeMaxDynamicSharedMemorySize, LDS_BYTES) == hipSuccess;
        ok &= hipFuncSetAttribute((const void*)k_ph<PH_NORM1>, hipFuncAttributeMaxDynamicSharedMemorySize, LDS_BYTES) == hipSuccess;
        ok &= hipFuncSetAttribute((const void*)k_ph<PH_GEMM1>, hipFuncAttributeMaxDynamicSharedMemorySize, LDS_BYTES) == hipSuccess;
        ok &= hipFuncSetAttribute((const void*)k_ph<PH_GEMM2>, hipFuncAttributeMaxDynamicSharedMemorySize, LDS_BYTES) == hipSuccess;
        ok &= hipFuncSetAttribute((const void*)k_ph<PH_NORM2>, hipFuncAttributeMaxDynamicSharedMemorySize, LDS_BYTES) == hipSuccess;
        ok &= hipFuncSetAttribute((const void*)k_ph<PH_GEMM3>, hipFuncAttributeMaxDynamicSharedMemorySize, LDS_BYTES) == hipSuccess;
        ok &= hipFuncSetAttribute((const void*)k_attn2<0>, hipFuncAttributeMaxDynamicSharedMemorySize, LDS_BYTES) == hipSuccess;
        ok &= hipFuncSetAttribute((const void*)k_topk<0>, hipFuncAttributeMaxDynamicSharedMemorySize, LDS_BYTES) == hipSuccess;
        ok &= hipFuncSetAttribute((const void*)k_mixrest<0>, hipFuncAttributeMaxDynamicSharedMemorySize, LDS_BYTES) == hipSuccess;
        if (!ok) { fprintf(stderr, "kernel_launch: hipFuncSetAttribute failed\n"); grid = -1; return; }
        grid = cus;
    }
    if (grid < 0) return;
    const int G = grid;

    k_mod<<<DEPTH * MODW / 256, 256, 0, stream>>>(p.c, p.w_mod, p.b_mod, p.mod);
    k_ph<PH_CONVERT><<<G, 512, LDS_BYTES, stream>>>(p, 0);
    for (int l = 0; l < DEPTH; ++l) {
        const float* modl = p.mod + (size_t)l * BATCH * MODW;
        if (l == 0) k_ph<PH_NORM1><<<G, 512, LDS_BYTES, stream>>>(p, l);
        k_ph<PH_GEMM1><<<G, 512, LDS_BYTES, stream>>>(p, l);
        k_attn2<0><<<G, 512, LDS_BYTES, stream>>>(p, l);
        k_mixrest<0><<<G, 512, LDS_BYTES, stream>>>(p, l);
        k_ph<PH_GEMM2><<<G, 512, LDS_BYTES, stream>>>(p, l);
        k_ph<PH_NORM2><<<G, 512, LDS_BYTES, stream>>>(p, l);
        k_ph<PH_GEMM3><<<G, 512, LDS_BYTES, stream>>>(p, l);
        k_topk<0><<<G, 512, LDS_BYTES, stream>>>(p, l);
        if (l == DEPTH - 1) k_expert<true><<<G, 512, 0, stream>>>(p, l); else k_expert<false><<<G, 512, 0, stream>>>(p, l);
    }
}
```

```cpp
#include <hip/hip_runtime.h>
#include <stdint.h>
#include <stdio.h>
#include <math.h>

#define D_MODEL 1024
#define BATCH 8
#define SEQ 2048
#define DEPTH 4
#define NTOK (BATCH * SEQ)
#define MIX_IN 2560
#define N_MOD 6
#define MODW (N_MOD * D_MODEL)
#define NEXP 16384

#define LAS __attribute__((address_space(3)))
typedef unsigned short bf16_t;
typedef short bf16x8 __attribute__((ext_vector_type(8)));
typedef float f32x4 __attribute__((ext_vector_type(4)));
typedef float f32x16 __attribute__((ext_vector_type(16)));
typedef unsigned u32x4 __attribute__((ext_vector_type(4)));
typedef unsigned u32x2 __attribute__((ext_vector_type(2)));

__device__ const unsigned char kBucket[128] = {
    0, 1, 2, 3, 4, 5, 6, 7, 8, 9, 10, 11, 12, 13, 14, 15, 16, 16, 16, 17, 17, 18, 18, 18, 19, 19, 19, 20, 20, 20, 20, 21,
    21, 21, 21, 22, 22, 22, 22, 22, 23, 23, 23, 23, 23, 23, 24, 24, 24, 24, 24, 24, 25, 25, 25, 25, 25, 25, 25, 26, 26, 26, 26, 26,
    26, 26, 26, 27, 27, 27, 27, 27, 27, 27, 27, 27, 27, 28, 28, 28, 28, 28, 28, 28, 28, 28, 28, 29, 29, 29, 29, 29, 29, 29, 29, 29,
    29, 29, 29, 30, 30, 30, 30, 30, 30, 30, 30, 30, 30, 30, 30, 30, 30, 31, 31, 31, 31, 31, 31, 31, 31, 31, 31, 31, 31, 31, 31, 31};

__device__ __forceinline__ float bf2f(bf16_t v) { return __uint_as_float(((unsigned)v) << 16); }
__device__ __forceinline__ float bflo(unsigned w) { return __uint_as_float(w << 16); }
__device__ __forceinline__ float bfhi(unsigned w) { return __uint_as_float(w & 0xFFFF0000u); }
__device__ __forceinline__ bf16_t f2bf(float f) { unsigned u = __float_as_uint(f); u += 0x7FFFu + ((u >> 16) & 1u); return (bf16_t)(u >> 16); }
__device__ __forceinline__ unsigned pk2(float lo, float hi) { unsigned r; asm volatile("v_cvt_pk_bf16_f32 %0, %1, %2" : "=v"(r) : "v"(lo), "v"(hi)); return r; }
__device__ __forceinline__ float ldf(const float* p) { return *p; }
__device__ __forceinline__ float ldf(const bf16_t* p) { return bf2f(*p); }

__device__ __forceinline__ float gelu_exact(float v) { return 0.5f * v * (1.0f + erff(v * 0.70710678118654752f)); }
__device__ __forceinline__ float sigmoidf_(float v) { return 1.0f / (1.0f + __expf(-v)); }
__device__ __forceinline__ float wave_sum(float v) {
#pragma unroll
    for (int o = 32; o > 0; o >>= 1) v += __shfl_xor(v, o, 64);
    return v;
}
__device__ __forceinline__ float block_sum256(float v, float* red) {
    v = wave_sum(v);
    __syncthreads();
    if ((threadIdx.x & 63) == 0) red[threadIdx.x >> 6] = v;
    __syncthreads();
    return red[0] + red[1] + red[2] + red[3];
}

__device__ __forceinline__ int tid_opaque() { int t = (int)threadIdx.x; asm volatile("" : "+v"(t)); return t; }
#define XB_TMO      128
#define XB_XCNT(j)  (256  + 64 * (j))
#define XB_XSUB(j)  (1280 + 64 * (j))
#define XB_XGEN(j)  (2304 + 64 * (j))
#define XB_TOP      3328
#define XB_TOPGEN   3392
#define XCD_BAR_WORDS 3456
#define XB_SPIN_CAP (1u << 18)

__device__ __forceinline__ unsigned xb_ld(unsigned* p)              { return __hip_atomic_load(p, __ATOMIC_RELAXED, __HIP_MEMORY_SCOPE_AGENT); }
__device__ __forceinline__ unsigned xb_add(unsigned* p, unsigned v) { return __hip_atomic_fetch_add(p, v, __ATOMIC_RELAXED, __HIP_MEMORY_SCOPE_AGENT); }
__device__ __forceinline__ unsigned xb_xcc_id() { return (unsigned)__builtin_amdgcn_s_getreg((3 << 11) | 20) & 0xFu; }
#define XB_SPIN(cond, bar) do { unsigned _sp = 0; while (cond) { __builtin_amdgcn_s_sleep(1); \
    if ((++_sp & 255u) == 0u) { if (xb_ld(&(bar)[XB_TMO])) break; if (_sp > XB_SPIN_CAP) { atomicAdd(&(bar)[XB_TMO], 1u); break; } } } } while (0)

struct XcdBarrier {
    unsigned* bar; unsigned x;
    volatile LAS unsigned* st;
};

__device__ __forceinline__ XcdBarrier xcd_barrier_post(unsigned* bar, volatile LAS unsigned* st) {
    XcdBarrier b; b.bar = bar; b.x = xb_xcc_id(); b.st = st;
    if (threadIdx.x == 0) (void)xb_add(&bar[XB_XCNT(b.x)], 1u);
    return b;
}
__device__ __forceinline__ void xcd_barrier_complete(unsigned* bar, unsigned x, unsigned& nloc, unsigned& nx) {
    const unsigned G = gridDim.x * gridDim.y * gridDim.z;
    unsigned sum, cnt, mine, sp = 0u;
    for (;;) {
        sum = 0u; cnt = 0u; mine = 0u;
#pragma unroll
        for (unsigned j = 0; j < 16; ++j) { const unsigned c = xb_ld(&bar[XB_XCNT(j)]); sum += c; cnt += (c > 0u) ? 1u : 0u; mine = (j == x) ? c : mine; }
        if (sum == G) break;
        __builtin_amdgcn_s_sleep(1);
        if ((++sp & 255u) == 0u) { if (xb_ld(&bar[XB_TMO])) break; if (sp > XB_SPIN_CAP) { atomicAdd(&bar[XB_TMO], 1u); break; } }
    }
    nloc = mine > 0u ? mine : 1u; nx = cnt > 0u ? cnt : 1u;
}

__device__ __forceinline__ void xcd_barrier(const XcdBarrier& b) {
    asm volatile("s_waitcnt vmcnt(0)" ::: "memory");
    __syncthreads();
    if (threadIdx.x == 0) {
        unsigned* bar = b.bar;
        __builtin_amdgcn_s_waitcnt(0);
        unsigned nloc = b.st[0], nx = b.st[1];
        if (nloc == 0u) { xcd_barrier_complete(bar, b.x, nloc, nx); b.st[0] = nloc; b.st[1] = nx; }
        const unsigned old = xb_add(&bar[XB_XSUB(b.x)], 1u);
        const unsigned gen = old / nloc;
        if (old + 1u == (gen + 1u) * nloc) {
            __builtin_amdgcn_fence(__ATOMIC_RELEASE, "agent");
            asm volatile("s_waitcnt vmcnt(0)" ::: "memory");
            const unsigned og = xb_add(&bar[XB_TOP], 1u);
            const unsigned tg = og / nx;
            if (og + 1u == (tg + 1u) * nx) xb_add(&bar[XB_TOPGEN], 1u);
            else XB_SPIN(xb_ld(&bar[XB_TOPGEN]) == tg, bar);
            __builtin_amdgcn_fence(__ATOMIC_ACQUIRE, "agent");
            xb_add(&bar[XB_XGEN(b.x)], 1u);
            asm volatile("s_waitcnt vmcnt(0)" ::: "memory");
        } else {
            XB_SPIN(xb_ld(&bar[XB_XGEN(b.x)]) == gen, bar);
            __builtin_amdgcn_fence(__ATOMIC_ACQUIRE, "agent");
            asm volatile("s_waitcnt vmcnt(0)" ::: "memory");
        }
    }
    __syncthreads();
}
namespace pg8 {
#define PG8_LAS __attribute__((address_space(3)))
typedef unsigned short bf16_t;
typedef short bf16x8 __attribute__((ext_vector_type(8)));
typedef float f32x4 __attribute__((ext_vector_type(4)));
typedef unsigned u32x4 __attribute__((ext_vector_type(4)));
constexpr int BM = 256, BK = 64, HALF = 128, HTB = HALF * BK * 2  , STAGE_BYTES = 8 * HTB, NXCD = 8, WGM = 8;

__host__ __device__ __forceinline__ int lds_byte(int r, int c) { const int st = (r >> 4) * 2 + (c >> 5), rr = r & 15, cc = c & 31, ob = rr * 64 + cc * 2; return st * 1024 + (ob ^ (((ob >> 9) & 1) << 5)); }
__host__ __device__ __forceinline__ void stage_rc(int b, int& R, int& C) { const int st = b / 1024, sb = b % 1024, swz = sb ^ (((sb >> 9) & 1) << 5); R = (st >> 1) * 16 + swz / 64; C = (st & 1) * 32 + (swz % 64) / 2; }
__host__ __device__ __forceinline__ int perm32(int rho) { const int n = rho >> 4, i = rho & 15; return 8 * (i >> 2) + 4 * n + (i & 3); }

struct Unit { int pm, pn; };
struct Gemm { const bf16_t* A; const bf16_t* Bt; int M, N, K; };

struct StaticOrder {
    int nM, nN, nwg, G, c;
    __host__ __device__ void init(int M, int N, int G_, int c_) { nM = M / BM; nN = N / BM; nwg = nM * nN; G = G_; c = c_; }
    __host__ __device__ bool next(int i, Unit& u) const {
        const long L = (long)i * G + c; if (L >= nwg) return false;
        int wgid = (int)L; { const int q = nwg / NXCD, r = nwg % NXCD, xcd = wgid % NXCD, off = wgid / NXCD; wgid = (xcd < r ? xcd * (q + 1) : r * (q + 1) + (xcd - r) * q) + off; }
        const int nig = WGM * nN, gid = wgid / nig, fm = gid * WGM, gsz = (nM - fm) < WGM ? (nM - fm) : WGM;
        u.pm = fm + ((wgid % nig) % gsz); u.pn = (wgid % nig) / gsz; return true;
    }
    __device__ __forceinline__ void a_ready(const Unit&) const {}
    __device__ __forceinline__ void done(const Unit&) const {}
};
__device__ __forceinline__ unsigned cvt_pk_bf16(float lo, float hi) { unsigned r; asm volatile("v_cvt_pk_bf16_f32 %0, %1, %2" : "=v"(r) : "v"(lo), "v"(hi)); return r; }
template <class Epi, class Sched, bool STAMP = false>
__device__ __forceinline__ void gemm_phase(PG8_LAS unsigned char* lds, const Gemm g, const Sched& S, const Epi& E, unsigned long long* stamps) {
    const int tid = tid_opaque(), wid = __builtin_amdgcn_readfirstlane(tid >> 6), lane = tid & 63, wr = wid >> 2, wc = wid & 3, fr = lane & 15, fq = lane >> 4;
    const int K = g.K, nt = K / BK;
    int ts_lo = 0, ts_hi = 0, nts = 0; const unsigned long long rt_entry = STAMP ? (unsigned long long)wall_clock64() : 0ull;
#define PG8_STAMP() do { if (STAMP && wid == 0 && nts < 64) { const unsigned long long _c = (unsigned long long)clock64(); \
        ts_lo = (lane == nts) ? (int)(unsigned)_c : ts_lo; ts_hi = (lane == nts) ? (int)(unsigned)(_c >> 32) : ts_hi; ++nts; } } while (0)
    PG8_STAMP();
    unsigned voffA[2], voffB[2];
#pragma unroll
    for (int i = 0; i < 2; ++i) { int R, C; stage_rc(tid * 16 + i * 8192, R, C); const int Rb = Epi::PERM ? ((R & ~31) + perm32(R & 31)) : R;
        voffA[i] = (unsigned)(R * K + C) * 2u; voffB[i] = (unsigned)(Rb * K + C) * 2u; }
    const size_t kstep = (size_t)(BK * 2);
    const size_t hstep = (size_t)HALF * K * 2;
    const size_t tstep = 2 * hstep;
    const unsigned ldsw = (unsigned)wid * 1024u;
    const int aoff = lds_byte(wr * 64 + fr, fq * 8), boff = lds_byte(wc * 32 + fr, fq * 8);
#define PG8_SA(b, h) (((b) * 2 + (h)) * HTB)
#define PG8_SB(b, h) ((4 + (b) * 2 + (h)) * HTB)
#define PG8_STAGE(bufoff, gbase, voff) do { _Pragma("unroll") for (int _i = 0; _i < 2; ++_i) \
        __builtin_amdgcn_global_load_lds((const unsigned*)((const char*)(gbase) + (voff)[_i]), (PG8_LAS unsigned*)(lds + (bufoff) + ldsw + _i * 8192), 16, 0, 0); } while (0)
#define PG8_LDA(dst, b, h) do { _Pragma("unroll") for (int m = 0; m < 4; ++m) _Pragma("unroll") for (int k = 0; k < 2; ++k) dst[m][k] = *(const PG8_LAS bf16x8*)(lds + PG8_SA(b, h) + aoff + m * 2048 + k * 1024); } while (0)
#define PG8_LDB(dst, b, h) do { _Pragma("unroll") for (int n = 0; n < 2; ++n) _Pragma("unroll") for (int k = 0; k < 2; ++k) dst[n][k] = *(const PG8_LAS bf16x8*)(lds + PG8_SB(b, h) + boff + n * 2048 + k * 1024); } while (0)
#define PG8_MMA(ai, bj, At, Bt) do { __builtin_amdgcn_s_setprio(1); _Pragma("unroll") for (int m = 0; m < 4; ++m) _Pragma("unroll") for (int n = 0; n < 2; ++n) _Pragma("unroll") for (int k = 0; k < 2; ++k) \
        acc[ai][bj][m][n] = __builtin_amdgcn_mfma_f32_16x16x32_bf16(Bt[n][k], At[m][k], acc[ai][bj][m][n], 0, 0, 0); __builtin_amdgcn_s_setprio(0); } while (0)
#define PG8_WAIT_V(n) asm volatile("s_waitcnt vmcnt(" #n ")" ::: "memory")
#define PG8_WAIT_L(n) asm volatile("s_waitcnt lgkmcnt(" #n ")" ::: "memory")
#define PG8_BAR __builtin_amdgcn_s_barrier()
#define PG8_SCHED __builtin_amdgcn_sched_barrier(0)
    Unit cur, nxt; int ui = 0;
    if (!S.next(0, cur)) return;
    f32x4 acc[2][2][4][2];
#pragma unroll
    for (int a = 0; a < 2; ++a)
#pragma unroll
        for (int b = 0; b < 2; ++b)
#pragma unroll
            for (int m = 0; m < 4; ++m)
#pragma unroll
                for (int n = 0; n < 2; ++n) acc[a][b][m][n] = (f32x4){0.f, 0.f, 0.f, 0.f};
    bf16x8 At[4][2], B0[2][2], B1[2][2];
    const char* cA = (const char*)g.A + (size_t)cur.pm * tstep; const char* cB = (const char*)g.Bt + (size_t)cur.pn * tstep;
    S.a_ready(cur);
    PG8_STAGE(PG8_SB(0, 0), cB, voffB); PG8_STAGE(PG8_SA(0, 0), cA, voffA); PG8_STAGE(PG8_SB(0, 1), cB + hstep, voffB); PG8_STAGE(PG8_SA(0, 1), cA + hstep, voffA);
    if (wr == 1) PG8_BAR;
    PG8_WAIT_V(4); PG8_BAR;
    PG8_STAGE(PG8_SB(1, 0), cB + kstep, voffB); PG8_STAGE(PG8_SA(1, 0), cA + kstep, voffA); PG8_STAGE(PG8_SB(1, 1), cB + hstep + kstep, voffB);
    PG8_WAIT_V(6); PG8_BAR;
    PG8_STAMP();
    for (;;) {
        const bool has_next = S.next(ui + 1, nxt);
        const char* nA = has_next ? (const char*)g.A + (size_t)nxt.pm * tstep : cA; const char* nB = has_next ? (const char*)g.Bt + (size_t)nxt.pn * tstep : cB;
        for (int t = 0; t < nt; t += 2) {
            const bool last = (t == nt - 2);
            const char* a1 = cA + (size_t)(t + 1) * kstep;
            const char* a2 = last ? nA : cA + (size_t)(t + 2) * kstep; const char* b2 = last ? nB : cB + (size_t)(t + 2) * kstep;
            const char* a3 = a2 + kstep; const char* b3 = b2 + kstep;
            if (last && has_next) S.a_ready(nxt);
            PG8_LDB(B0, 0, 0); PG8_SCHED; PG8_LDA(At, 0, 0); PG8_STAGE(PG8_SA(1, 1), a1 + hstep, voffA);
            PG8_WAIT_L(8); PG8_BAR; PG8_WAIT_L(0); PG8_MMA(0, 0, At, B0); PG8_BAR; PG8_SCHED;
            PG8_LDB(B1, 0, 1); PG8_STAGE(PG8_SB(0, 0), b2, voffB);
            PG8_BAR; PG8_WAIT_L(0); PG8_MMA(0, 1, At, B1); PG8_BAR;
            PG8_LDA(At, 0, 1); PG8_STAGE(PG8_SA(0, 0), a2, voffA);
            PG8_BAR; PG8_WAIT_L(0); PG8_MMA(1, 0, At, B0); PG8_BAR; PG8_SCHED;
            PG8_STAGE(PG8_SB(0, 1), b2 + hstep, voffB);
            PG8_WAIT_V(6); PG8_BAR; PG8_MMA(1, 1, At, B1); PG8_BAR;
            PG8_LDB(B0, 1, 0); PG8_SCHED; PG8_LDA(At, 1, 0); PG8_STAGE(PG8_SA(0, 1), a2 + hstep, voffA);
            PG8_WAIT_L(8); PG8_BAR; PG8_WAIT_L(0); PG8_MMA(0, 0, At, B0); PG8_BAR; PG8_SCHED;
            PG8_LDB(B1, 1, 1); PG8_STAGE(PG8_SB(1, 0), b3, voffB);
            PG8_BAR; PG8_WAIT_L(0); PG8_MMA(0, 1, At, B1); PG8_BAR;
            PG8_LDA(At, 1, 1); PG8_STAGE(PG8_SA(1, 0), a3, voffA);
            PG8_BAR; PG8_WAIT_L(0); PG8_MMA(1, 0, At, B0); PG8_BAR; PG8_SCHED;
            PG8_STAGE(PG8_SB(1, 1), b3 + hstep, voffB);
            PG8_WAIT_V(6); PG8_BAR; PG8_MMA(1, 1, At, B1); PG8_BAR;
        }
        PG8_STAMP();
        if constexpr (!Epi::AFTER_DRAIN) { E(acc, cur, wr, wc, fr, fq); S.done(cur); }
        PG8_STAMP();
        if (!has_next) break;
#pragma unroll
        for (int a = 0; a < 2; ++a)
#pragma unroll
            for (int b = 0; b < 2; ++b)
#pragma unroll
                for (int m = 0; m < 4; ++m)
#pragma unroll
                    for (int n = 0; n < 2; ++n) acc[a][b][m][n] = (f32x4){0.f, 0.f, 0.f, 0.f};
        cur = nxt; cA = nA; cB = nB; ++ui;
    }
    PG8_WAIT_V(0);
    if (wr == 0) PG8_BAR;
    PG8_BAR;
    if constexpr (Epi::AFTER_DRAIN) { E.fused(acc, cur, wr, wc, fr, fq, lds, wid, lane); S.done(cur); }
    PG8_STAMP();
    if (STAMP && wid == 0) { stamps[lane] = lane < nts ? (((unsigned long long)(unsigned)ts_hi << 32) | (unsigned)ts_lo) : 0ull;
        if (lane == 62) stamps[62] = rt_entry; if (lane == 63) stamps[63] = (unsigned long long)wall_clock64(); }
#undef PG8_STAMP
#undef PG8_SA
#undef PG8_SB
#undef PG8_STAGE
#undef PG8_LDA
#undef PG8_LDB
#undef PG8_MMA
#undef PG8_WAIT_V
#undef PG8_WAIT_L
#undef PG8_BAR
#undef PG8_SCHED
}
}

struct Params {
    const float *x_in, *c, *rel_bias, *w_mod, *b_mod, *norm1_g, *norm2_g, *w_in, *w_out, *diff_lambda, *subln_g, *conf_dw, *conf_ln_g, *conf_ln_b, *sconv_w,
        *sgu_ln_g, *sgu_ln_b, *sgu_w, *sgu_b, *peer_wq, *peer_keys, *peer_u, *peer_v, *final_g;
    float* out;
    unsigned* bar;
    float* mod;
    float* xb;
    bf16_t* hb;
    bf16_t* pb;
    bf16_t* cat;
    bf16_t* qb;
    bf16_t *WinT, *WoutT, *WqT, *keysb, *ub, *vb, *sguwb;
    int* eidx; float* egate;
    float lam_init[DEPTH];
};

#define LDS_BYTES (144 * 1024)
#define NWAVES 8

__device__ __forceinline__ void transpose_item(const float* __restrict__ W, int K, int N, bf16_t* __restrict__ WT, LAS float* scr, int item, int lane) {
    const int nblk = N / 32, kb = item / nblk, nb = item % nblk, k0 = 64 * kb, n0 = 32 * nb;
#pragma unroll 8
    for (int i = 0; i < 32; ++i) { const int kk = 2 * i + (lane >> 5); scr[kk * 33 + (lane & 31)] = W[(size_t)(k0 + kk) * N + n0 + (lane & 31)]; }
    asm volatile("s_waitcnt lgkmcnt(0)" ::: "memory");
    const int c = lane & 7;
#pragma unroll
    for (int j = 0; j < 4; ++j) {
        const int n = (lane >> 3) + 8 * j; const LAS float* s = scr + (8 * c) * 33 + n;
        u32x4 o; o.x = pk2(s[0 * 33], s[1 * 33]); o.y = pk2(s[2 * 33], s[3 * 33]); o.z = pk2(s[4 * 33], s[5 * 33]); o.w = pk2(s[6 * 33], s[7 * 33]);
        *(u32x4*)(WT + (size_t)(n0 + n) * K + k0 + 8 * c) = o;
    }
    asm volatile("s_waitcnt lgkmcnt(0)" ::: "memory");
}
__device__ __forceinline__ void cvt8(const float* __restrict__ s, bf16_t* __restrict__ d) {
    const f32x4 a = *(const f32x4*)s, b = *(const f32x4*)(s + 4);
    u32x4 o; o.x = pk2(a[0], a[1]); o.y = pk2(a[2], a[3]); o.z = pk2(b[0], b[1]); o.w = pk2(b[2], b[3]);
    *(u32x4*)d = o;
}
__device__ __forceinline__ void phase_convert(const Params& p, LAS unsigned char* lds) {
    const int tid = tid_opaque(), wave = tid >> 6, lane = tid & 63;
    LAS float* scr = (LAS float*)(lds + wave * 16384);
    const int gw = blockIdx.x * NWAVES + wave, NGW = gridDim.x * NWAVES;
    constexpr int I_IN = (D_MODEL / 64) * (MIX_IN / 32), I_OUT = (D_MODEL / 64) * (D_MODEL / 32), I_Q = (D_MODEL / 64) * (2048 / 32), I_L = I_IN + I_OUT + I_Q;
    for (int it = gw; it < DEPTH * I_L; it += NGW) {
        const int l = it / I_L; int r = it % I_L;
        if (r < I_IN) { transpose_item(p.w_in + (size_t)l * D_MODEL * MIX_IN, D_MODEL, MIX_IN, p.WinT + (size_t)l * MIX_IN * D_MODEL, scr, r, lane); continue; } r -= I_IN;
        if (r < I_OUT) { transpose_item(p.w_out + (size_t)l * D_MODEL * D_MODEL, D_MODEL, D_MODEL, p.WoutT + (size_t)l * D_MODEL * D_MODEL, scr, r, lane); continue; } r -= I_OUT;
        transpose_item(p.peer_wq + (size_t)l * D_MODEL * 2048, D_MODEL, 2048, p.WqT + (size_t)l * 2048 * D_MODEL, scr, r, lane);
    }
    const size_t gt = (size_t)blockIdx.x * 512 + tid, NGT = (size_t)gridDim.x * 512;
    constexpr size_t N_KEYS8 = (size_t)DEPTH * 16 * 128 * 128 / 8, N_TAB8 = (size_t)DEPTH * NEXP * D_MODEL / 8, N_SGU8 = (size_t)DEPTH * 4 * 128 * 128 / 8;
    for (size_t i = gt; i < N_KEYS8; i += NGT) cvt8(p.peer_keys + i * 8, p.keysb + i * 8);
    for (size_t i = gt; i < N_TAB8; i += NGT) cvt8(p.peer_u + i * 8, p.ub + i * 8);
    for (size_t i = gt; i < N_TAB8; i += NGT) cvt8(p.peer_v + i * 8, p.vb + i * 8);
    for (size_t i = gt; i < N_SGU8; i += NGT) {
        const size_t e = i * 8; const int s0 = (int)(e & 127), t = (int)((e >> 7) & 127);
        const f32x4 a = *(const f32x4*)(p.sgu_w + e), b = *(const f32x4*)(p.sgu_w + e + 4);
        float v[8] = {a[0], a[1], a[2], a[3], b[0], b[1], b[2], b[3]};
#pragma unroll
        for (int j = 0; j < 8; ++j) v[j] = (s0 + j <= t) ? v[j] : 0.f;
        u32x4 o; o.x = pk2(v[0], v[1]); o.y = pk2(v[2], v[3]); o.z = pk2(v[4], v[5]); o.w = pk2(v[6], v[7]);
        *(u32x4*)(p.sguwb + e) = o;
    }
}

__device__ __forceinline__ void norm_row(const float* __restrict__ xr, const float* __restrict__ g, const float* __restrict__ sh, const float* __restrict__ sc, bf16_t* __restrict__ hr, int lane) {
    f32x4 v[4]; float ss = 0.f;
#pragma unroll
    for (int j = 0; j < 4; ++j) { v[j] = *(const f32x4*)(xr + j * 256 + lane * 4); ss += v[j][0] * v[j][0] + v[j][1] * v[j][1] + v[j][2] * v[j][2] + v[j][3] * v[j][3]; }
    const float rs = rsqrtf(wave_sum(ss) * (1.0f / D_MODEL) + 1e-6f);
#pragma unroll
    for (int j = 0; j < 4; ++j) {
        const int col = j * 256 + lane * 4;
        const f32x4 gv = *(const f32x4*)(g + col), scv = *(const f32x4*)(sc + col), shv = *(const f32x4*)(sh + col);
        f32x4 y;
#pragma unroll
        for (int e = 0; e < 4; ++e) y[e] = v[j][e] * rs * gv[e] * (1.0f + scv[e]) + shv[e];
        u32x2 o; o.x = pk2(y[0], y[1]); o.y = pk2(y[2], y[3]);
        *(u32x2*)(hr + col) = o;
    }
}
__device__ __forceinline__ void phase_norm(const Params& p, const float* __restrict__ x, const float* __restrict__ g, const float* __restrict__ modl, int sh_idx, int sc_idx) {
    const int tid = tid_opaque(), wave = tid >> 6, lane = tid & 63;
    for (int t = blockIdx.x * NWAVES + wave; t < NTOK; t += gridDim.x * NWAVES) {
        const float* mb = modl + (size_t)(t / SEQ) * MODW;
        norm_row(x + (size_t)t * D_MODEL, g, mb + sh_idx * D_MODEL, mb + sc_idx * D_MODEL, p.hb + (size_t)t * D_MODEL, lane);
    }
}

struct EpiStoreBf16 {
    static constexpr bool PERM = true, AFTER_DRAIN = false;
    bf16_t* O; int ldc;
    __device__ __forceinline__ void operator()(const pg8::f32x4 (&acc)[2][2][4][2], const pg8::Unit& u, int wr, int wc, int fr, int fq) const {
        const int row0 = u.pm * 256 + wr * 64 + fr, col0 = u.pn * 256 + wc * 32 + 8 * fq;
#pragma unroll
        for (int ai = 0; ai < 2; ++ai)
#pragma unroll
            for (int m = 0; m < 4; ++m) {
                bf16_t* rowp = O + (size_t)(row0 + ai * 128 + m * 16) * ldc + col0;
#pragma unroll
                for (int bj = 0; bj < 2; ++bj) {
                    const pg8::f32x4 v0 = acc[ai][bj][m][0], v1 = acc[ai][bj][m][1];
                    u32x4 w; w.x = pk2(v0[0], v0[1]); w.y = pk2(v0[2], v0[3]); w.z = pk2(v1[0], v1[1]); w.w = pk2(v1[2], v1[3]);
                    *(u32x4*)(rowp + bj * 128) = w;
                }
            }
    }
};
struct EpiResid {
    static constexpr bool PERM = false, AFTER_DRAIN = false;
    const float* xin; float* xout; const float* gate;
    __device__ __forceinline__ void operator()(const pg8::f32x4 (&acc)[2][2][4][2], const pg8::Unit& u, int wr, int wc, int fr, int fq) const {
        const int row0 = u.pm * 256 + wr * 64 + fr, col0 = u.pn * 256 + wc * 32 + 4 * fq;
        const float* gb = gate + (size_t)((u.pm * 256) / SEQ) * MODW + col0;
        pg8::f32x4 gv[2][2];
#pragma unroll
        for (int bj = 0; bj < 2; ++bj)
#pragma unroll
            for (int n = 0; n < 2; ++n) gv[bj][n] = *(const pg8::f32x4*)(gb + bj * 128 + n * 16);
#pragma unroll
        for (int ai = 0; ai < 2; ++ai)
#pragma unroll
            for (int m = 0; m < 4; ++m) {
                const size_t off = (size_t)(row0 + ai * 128 + m * 16) * D_MODEL + col0;
#pragma unroll
                for (int bj = 0; bj < 2; ++bj)
#pragma unroll
                    for (int n = 0; n < 2; ++n) {
                        const pg8::f32x4 xv = *(const pg8::f32x4*)(xin + off + bj * 128 + n * 16);
                        *(pg8::f32x4*)(xout + off + bj * 128 + n * 16) = xv + gv[bj][n] * acc[ai][bj][m][n];
                    }
            }
    }
};

template <class Epi>
__device__ __forceinline__ void run_gemm(LAS unsigned char* lds, const bf16_t* A, const bf16_t* Bt, int M, int N, int K, const Epi& E) {
    pg8::StaticOrder S; S.init(M, N, (int)gridDim.x, (int)blockIdx.x);
    pg8::Gemm g; g.A = A; g.Bt = Bt; g.M = M; g.N = N; g.K = K;
    pg8::gemm_phase<Epi, pg8::StaticOrder, false>(lds, g, S, E, nullptr);
}

typedef __bf16 bf16x2_t __attribute__((ext_vector_type(2)));
__device__ __forceinline__ float dot2bf(unsigned a, unsigned b, float c) { return __builtin_amdgcn_fdot2_f32_bf16(__builtin_bit_cast(bf16x2_t, a), __builtin_bit_cast(bf16x2_t, b), c, false); }

struct ERows { u32x4 u[4][2]; u32x4 v[4][2]; };

typedef __amdgpu_buffer_rsrc_t rsrc_t;
__device__ __forceinline__ u32x4 bload16(rsrc_t r, int voff, int soff) { return __builtin_bit_cast(u32x4, __builtin_amdgcn_raw_buffer_load_b128(r, voff, soff, 0)); }
__device__ __forceinline__ void ex_load(ERows& R, rsrc_t ru, rsrc_t rv, int e0, int e1, int g, int voff) {
    const int ev = (g < 16) ? e0 : e1;
#pragma unroll
    for (int i = 0; i < 4; ++i) {
        const int so = __builtin_amdgcn_readlane(ev, (4 * g + i) & 63) * (D_MODEL * 2);
        R.u[i][0] = bload16(ru, voff, so); R.u[i][1] = bload16(ru, voff + 1024, so);
        R.v[i][0] = bload16(rv, voff, so); R.v[i][1] = bload16(rv, voff + 1024, so);
    }
}
__device__ __forceinline__ void ex_compute(const ERows& R, const unsigned (&hp)[8], float (&y)[16], float g0, float g1, int g, int lane) {
    float d[4];
#pragma unroll
    for (int i = 0; i < 4; ++i) {
        float s = 0.f;
#pragma unroll
        for (int j = 0; j < 4; ++j) { s = dot2bf(hp[j], R.u[i][0][j], s); s = dot2bf(hp[4 + j], R.u[i][1][j], s); }
        d[i] = s;
    }
    const bool hi = (lane & 32) != 0, hi2 = (lane & 16) != 0;
    float k0 = hi ? d[2] : d[0], k1 = hi ? d[3] : d[1];
    const float s0 = hi ? d[0] : d[2], s1 = hi ? d[1] : d[3];
    k0 += __shfl_xor(s0, 32, 64); k1 += __shfl_xor(s1, 32, 64);
    float kk = hi2 ? k1 : k0; const float sn = hi2 ? k0 : k1;
    kk += __shfl_xor(sn, 16, 64);
    kk += __shfl_xor(kk, 8, 64); kk += __shfl_xor(kk, 4, 64); kk += __shfl_xor(kk, 2, 64); kk += __shfl_xor(kk, 1, 64);
    const float gsel = (g < 16) ? g0 : g1;
    const float gk = __shfl(gsel, (4 * g + (lane >> 4)) & 63, 64);
    const float coef = gk * gelu_exact(kk);
#pragma unroll
    for (int i = 0; i < 4; ++i) {
        const float c = __int_as_float(__builtin_amdgcn_readlane(__float_as_int(coef), 16 * i));
#pragma unroll
        for (int j = 0; j < 4; ++j) {
            y[2 * j] += c * bflo(R.v[i][0][j]); y[2 * j + 1] += c * bfhi(R.v[i][0][j]);
            y[8 + 2 * j] += c * bflo(R.v[i][1][j]); y[8 + 2 * j + 1] += c * bfhi(R.v[i][1][j]);
        }
    }
}

__device__ __forceinline__ void phase_expert(const Params& p, int l, const bool LAST) {
    const int tid = tid_opaque(), wave = tid >> 6, lane = tid & 63;
    const rsrc_t ru = __builtin_amdgcn_make_buffer_rsrc((void*)(p.ub + (size_t)l * NEXP * D_MODEL), 0, NEXP * D_MODEL * 2, 0x00020000);
    const rsrc_t rv = __builtin_amdgcn_make_buffer_rsrc((void*)(p.vb + (size_t)l * NEXP * D_MODEL), 0, NEXP * D_MODEL * 2, 0x00020000);
    const int voff = lane * 16;
    const float* n2g = p.norm2_g + l * D_MODEL;
    const int c0 = lane * 8;
    for (int t = blockIdx.x * NWAVES + wave; t < NTOK; t += gridDim.x * NWAVES) {
        const float* mb = p.mod + ((size_t)l * BATCH + t / SEQ) * MODW;
        float xv[16];
        {
            const float* xr = p.xb + (size_t)t * D_MODEL;
            const f32x4 a = *(const f32x4*)(xr + c0), b = *(const f32x4*)(xr + c0 + 4), c = *(const f32x4*)(xr + 512 + c0), d = *(const f32x4*)(xr + 512 + c0 + 4);
#pragma unroll
            for (int e = 0; e < 4; ++e) { xv[e] = a[e]; xv[4 + e] = b[e]; xv[8 + e] = c[e]; xv[12 + e] = d[e]; }
        }
        float ss = 0.f;
#pragma unroll
        for (int e = 0; e < 16; ++e) ss += xv[e] * xv[e];
        const float rs = rsqrtf(wave_sum(ss) * (1.0f / D_MODEL) + 1e-6f);
        unsigned hp[8];
#pragma unroll
        for (int hh = 0; hh < 2; ++hh)
#pragma unroll
            for (int q = 0; q < 2; ++q) {
                const int col = hh * 512 + c0 + q * 4;
                const f32x4 gv = *(const f32x4*)(n2g + col), scv = *(const f32x4*)(mb + 4 * D_MODEL + col), shv = *(const f32x4*)(mb + 3 * D_MODEL + col);
                float h[4];
#pragma unroll
                for (int e = 0; e < 4; ++e) h[e] = xv[hh * 8 + q * 4 + e] * rs * gv[e] * (1.0f + scv[e]) + shv[e];
                hp[hh * 4 + q * 2] = pk2(h[0], h[1]); hp[hh * 4 + q * 2 + 1] = pk2(h[2], h[3]);
            }
        const int e0 = p.eidx[(size_t)t * 128 + lane], e1 = p.eidx[(size_t)t * 128 + 64 + lane];
        const float g0 = p.egate[(size_t)t * 128 + lane], g1 = p.egate[(size_t)t * 128 + 64 + lane];
        float y[16];
#pragma unroll
        for (int e = 0; e < 16; ++e) y[e] = 0.f;
        ERows RA, RB;
        ex_load(RA, ru, rv, e0, e1, 0, voff);
        for (int g = 0; g < 32; g += 2) {
            ex_load(RB, ru, rv, e0, e1, g + 1, voff);
            ex_compute(RA, hp, y, g0, g1, g, lane);
            if (g + 2 < 32) ex_load(RA, ru, rv, e0, e1, g + 2, voff);
            ex_compute(RB, hp, y, g0, g1, g + 1, lane);
        }
#pragma unroll
        for (int hh = 0; hh < 2; ++hh)
#pragma unroll
            for (int q = 0; q < 2; ++q) {
                const f32x4 g2 = *(const f32x4*)(mb + 5 * D_MODEL + hh * 512 + c0 + q * 4);
#pragma unroll
                for (int e = 0; e < 4; ++e) xv[hh * 8 + q * 4 + e] += g2[e] * y[hh * 8 + q * 4 + e];
            }
        float ss2 = 0.f;
#pragma unroll
        for (int e = 0; e < 16; ++e) ss2 += xv[e] * xv[e];
        const float rs2 = rsqrtf(wave_sum(ss2) * (1.0f / D_MODEL) + 1e-6f);
        if (LAST) {
#pragma unroll
            for (int hh = 0; hh < 2; ++hh)
#pragma unroll
                for (int q = 0; q < 2; ++q) {
                    const int col = hh * 512 + c0 + q * 4;
                    const f32x4 gv = *(const f32x4*)(p.final_g + col);
                    f32x4 o;
#pragma unroll
                    for (int e = 0; e < 4; ++e) o[e] = xv[hh * 8 + q * 4 + e] * rs2 * gv[e];
                    *(f32x4*)(p.out + (size_t)t * D_MODEL + col) = o;
                }
        } else {
            const float* mn = p.mod + ((size_t)(l + 1) * BATCH + t / SEQ) * MODW;
            const float* n1g = p.norm1_g + (l + 1) * D_MODEL;
#pragma unroll
            for (int hh = 0; hh < 2; ++hh)
#pragma unroll
                for (int q = 0; q < 2; ++q) {
                    const int col = hh * 512 + c0 + q * 4;
                    f32x4 xo;
#pragma unroll
                    for (int e = 0; e < 4; ++e) xo[e] = xv[hh * 8 + q * 4 + e];
                    *(f32x4*)(p.xb + (size_t)t * D_MODEL + col) = xo;
                    const f32x4 gv = *(const f32x4*)(n1g + col), scv = *(const f32x4*)(mn + 1 * D_MODEL + col), shv = *(const f32x4*)(mn + 0 * D_MODEL + col);
                    float h[4];
#pragma unroll
                    for (int e = 0; e < 4; ++e) h[e] = xo[e] * rs2 * gv[e] * (1.0f + scv[e]) + shv[e];
                    u32x2 o; o.x = pk2(h[0], h[1]); o.y = pk2(h[2], h[3]);
                    *(u32x2*)(p.hb + (size_t)t * D_MODEL + col) = o;
                }
        }
    }
}
__global__ void __launch_bounds__(512, 2) k_expert(Params p, int l) { phase_expert(p, l, l == DEPTH - 1); }
typedef short s16x4 __attribute__((ext_vector_type(4)));
#define AT_KSTR 144
#define AT_VSTR 192
#define AT_KBUF 0
#define AT_VBUF 18432
#define AT_TBL  43008
#define AT_OEX  44032
#define AT_OSTR 272

__device__ __forceinline__ void phase_attn(const Params& p, int l, LAS unsigned char* lds) {
    const int tid = tid_opaque(), wave = tid >> 6, lane = tid & 63;
    const int w4 = wave & 3, m = wave >> 2, c = lane & 31, h = lane >> 5;
    const float LOG2E = 1.4426950408889634f;
    const float qscale = 0.17677669529663687f * LOG2E;
    float d01 = 0.f, d23 = 0.f;
    { const float* lp = p.diff_lambda + l * 128;
      for (int i = 0; i < 32; ++i) { d01 += lp[i] * lp[32 + i]; d23 += lp[64 + i] * lp[96 + i]; } }
    const float lam_init = p.lam_init[l];
    const float lam = expf(d01) - expf(d23) + lam_init;
    const float osc = 1.0f - lam_init;
    LAS float* tbl = (LAS float*)(lds + AT_TBL);
    const int skey = tid >> 3, sch = tid & 7;
    const int g16 = lane >> 4, li = lane & 15, tq = li >> 2, tp = li & 3;

    for (int u = blockIdx.x; u < 256; u += gridDim.x) {
        const int pi = u & 7, hd = (u >> 3) & 3, b = u >> 5;
        if (tid < 256) { const int bk = tid < 128 ? (int)kBucket[tid] : 31; tbl[tid] = p.rel_bias[bk * 4 + hd] * LOG2E; }
        const float c31 = p.rel_bias[31 * 4 + hd] * LOG2E;
        const bf16_t* pbase = p.pb + (size_t)b * SEQ * MIX_IN;
        const bf16_t* kg = pbase + (size_t)skey * MIX_IN + 256 + hd * 64 + sch * 8;
        const bf16_t* vg = pbase + (size_t)skey * MIX_IN + 512 + hd * 64 + sch * 8;
        for (int half = 0; half < 2; ++half) {
            const int qb = half ? 15 - pi : pi;
            const int q0w = qb * 128 + 32 * w4, nkt = 2 * qb + 2;
            const int qpos = q0w + c;
            bf16x8 qf0, qf1;
            { const bf16_t* qp = pbase + (size_t)qpos * MIX_IN + hd * 64 + m * 32 + 8 * h; qf0 = *(const bf16x8*)qp; qf1 = *(const bf16x8*)(qp + 16); }
            f32x16 O0, O1;
#pragma unroll
            for (int r = 0; r < 16; ++r) { O0[r] = 0.f; O1[r] = 0.f; }
            float mrun = -1e30f, lrun = 0.f;
            u32x4 kreg = *(const u32x4*)kg, vreg = *(const u32x4*)vg;
            *(LAS u32x4*)(lds + AT_KBUF + skey * AT_KSTR + sch * 16) = kreg;
            *(LAS u32x4*)(lds + AT_VBUF + skey * AT_VSTR + sch * 16) = vreg;
            __syncthreads();
            for (int kt = 0; kt < nkt; ++kt) {
                const int k0 = kt * 64, cur = kt & 1;
                if (kt + 1 < nkt) { kreg = *(const u32x4*)(kg + (size_t)(k0 + 64) * MIX_IN); vreg = *(const u32x4*)(vg + (size_t)(k0 + 64) * MIX_IN); }
                if (k0 <= q0w + 31) {
                    LAS unsigned char* kb_ = lds + AT_KBUF + cur * (64 * AT_KSTR);
                    LAS unsigned char* vb_ = lds + AT_VBUF + cur * (64 * AT_VSTR);
                    f32x16 s0, s1;
#pragma unroll
                    for (int r = 0; r < 16; ++r) { s0[r] = 0.f; s1[r] = 0.f; }
                    {
                        const LAS unsigned char* ka = kb_ + c * AT_KSTR + m * 64 + h * 16;
                        const bf16x8 a00 = *(const LAS bf16x8*)ka, a01 = *(const LAS bf16x8*)(ka + 32);
                        const bf16x8 a10 = *(const LAS bf16x8*)(ka + 32 * AT_KSTR), a11 = *(const LAS bf16x8*)(ka + 32 * AT_KSTR + 32);
                        s0 = __builtin_amdgcn_mfma_f32_32x32x16_bf16(a00, qf0, s0, 0, 0, 0);
                        s0 = __builtin_amdgcn_mfma_f32_32x32x16_bf16(a01, qf1, s0, 0, 0, 0);
                        s1 = __builtin_amdgcn_mfma_f32_32x32x16_bf16(a10, qf0, s1, 0, 0, 0);
                        s1 = __builtin_amdgcn_mfma_f32_32x32x16_bf16(a11, qf1, s1, 0, 0, 0);
                    }
                    const bool far = (q0w - (k0 + 63)) >= 113;
                    if (far) {
#pragma unroll
                        for (int r = 0; r < 16; ++r) { s0[r] = s0[r] * qscale + c31; s1[r] = s1[r] * qscale + c31; }
                    } else {
                        const int dbase = qpos - k0 - 4 * h;
#pragma unroll
                        for (int r = 0; r < 16; ++r) {
                            const int d0 = dbase - ((r & 3) + 8 * (r >> 2)), d1 = d0 - 32;
                            const float b0 = tbl[min(max(d0, 0), 255)], b1 = tbl[min(max(d1, 0), 255)];
                            const float v0 = s0[r] * qscale + b0, v1 = s1[r] * qscale + b1;
                            s0[r] = d0 < 0 ? -1e30f : v0; s1[r] = d1 < 0 ? -1e30f : v1;
                        }
                    }
                    float tmax = fmaxf(s0[0], s1[0]);
#pragma unroll
                    for (int r = 1; r < 16; ++r) tmax = fmaxf(tmax, fmaxf(s0[r], s1[r]));
                    tmax = fmaxf(tmax, __shfl_xor(tmax, 32, 64));
                    const float mnew = fmaxf(mrun, tmax);
                    const float alpha = __builtin_amdgcn_exp2f(mrun - mnew);
                    mrun = mnew;
                    float psum = 0.f;
#pragma unroll
                    for (int r = 0; r < 16; ++r) { s0[r] = __builtin_amdgcn_exp2f(s0[r] - mnew); s1[r] = __builtin_amdgcn_exp2f(s1[r] - mnew); psum += s0[r] + s1[r]; }
                    lrun = lrun * alpha + psum;
#pragma unroll
                    for (int r = 0; r < 16; ++r) { O0[r] *= alpha; O1[r] *= alpha; }
#pragma unroll
                    for (int kb = 0; kb < 2; ++kb)
#pragma unroll
                        for (int sp = 0; sp < 2; ++sp) {
                            u32x4 pw;
                            if (kb == 0) { pw.x = pk2(s0[8 * sp + 0], s0[8 * sp + 1]); pw.y = pk2(s0[8 * sp + 2], s0[8 * sp + 3]); pw.z = pk2(s0[8 * sp + 4], s0[8 * sp + 5]); pw.w = pk2(s0[8 * sp + 6], s0[8 * sp + 7]); }
                            else         { pw.x = pk2(s1[8 * sp + 0], s1[8 * sp + 1]); pw.y = pk2(s1[8 * sp + 2], s1[8 * sp + 3]); pw.z = pk2(s1[8 * sp + 4], s1[8 * sp + 5]); pw.w = pk2(s1[8 * sp + 6], s1[8 * sp + 7]); }
                            const bf16x8 pf = __builtin_bit_cast(bf16x8, pw);
                            const int kA = 32 * kb + 16 * sp + 4 * h;
#pragma unroll
                            for (int mb = 0; mb < 2; ++mb) {
                                LAS unsigned char* va = vb_ + (kA + tq) * AT_VSTR + (32 * mb + 16 * (g16 & 1) + 4 * tp) * 2;
                                const s16x4 t0 = __builtin_amdgcn_ds_read_tr16_b64_v4i16((LAS s16x4*)va);
                                const s16x4 t1 = __builtin_amdgcn_ds_read_tr16_b64_v4i16((LAS s16x4*)(va + 8 * AT_VSTR));
                                const bf16x8 vf = {t0[0], t0[1], t0[2], t0[3], t1[0], t1[1], t1[2], t1[3]};
                                if (mb == 0) O0 = __builtin_amdgcn_mfma_f32_32x32x16_bf16(vf, pf, O0, 0, 0, 0);
                                else         O1 = __builtin_amdgcn_mfma_f32_32x32x16_bf16(vf, pf, O1, 0, 0, 0);
                            }
                        }
                }
                if (kt + 1 < nkt) {
                    *(LAS u32x4*)(lds + AT_KBUF + (cur ^ 1) * (64 * AT_KSTR) + skey * AT_KSTR + sch * 16) = kreg;
                    *(LAS u32x4*)(lds + AT_VBUF + (cur ^ 1) * (64 * AT_VSTR) + skey * AT_VSTR + sch * 16) = vreg;
                }
                __syncthreads();
            }
            const float inv = 1.0f / (lrun + __shfl_xor(lrun, 32, 64));
            LAS unsigned char* oex = lds + AT_OEX + (32 * w4 + c) * AT_OSTR + 16 * h;
            if (m == 1) {
#pragma unroll
                for (int r4 = 0; r4 < 4; ++r4) {
                    f32x4 a, bq;
#pragma unroll
                    for (int e = 0; e < 4; ++e) { a[e] = O0[4 * r4 + e] * inv; bq[e] = O1[4 * r4 + e] * inv; }
                    *(LAS f32x4*)(oex + (8 * r4) * 4) = a;
                    *(LAS f32x4*)(oex + (32 + 8 * r4) * 4) = bq;
                }
            }
            __syncthreads();
            if (m == 0) {
                float ss = 0.f;
#pragma unroll
                for (int r4 = 0; r4 < 4; ++r4) {
                    const f32x4 a = *(const LAS f32x4*)(oex + (8 * r4) * 4), bq = *(const LAS f32x4*)(oex + (32 + 8 * r4) * 4);
#pragma unroll
                    for (int e = 0; e < 4; ++e) {
                        O0[4 * r4 + e] = O0[4 * r4 + e] * inv - lam * a[e]; O1[4 * r4 + e] = O1[4 * r4 + e] * inv - lam * bq[e];
                        ss += O0[4 * r4 + e] * O0[4 * r4 + e] + O1[4 * r4 + e] * O1[4 * r4 + e];
                    }
                }
                ss += __shfl_xor(ss, 32, 64);
                const float rstd = rsqrtf(ss * (1.0f / 64.0f) + 1e-6f) * osc;
                bf16_t* orow = p.cat + (size_t)(b * SEQ + qpos) * D_MODEL + hd * 64 + 4 * h;
                const float* sg = p.subln_g + l * 64 + 4 * h;
#pragma unroll
                for (int r4 = 0; r4 < 4; ++r4) {
                    const f32x4 ga = *(const f32x4*)(sg + 8 * r4), gb = *(const f32x4*)(sg + 32 + 8 * r4);
                    u32x2 oa, ob;
                    oa.x = pk2(O0[4 * r4 + 0] * rstd * ga[0], O0[4 * r4 + 1] * rstd * ga[1]); oa.y = pk2(O0[4 * r4 + 2] * rstd * ga[2], O0[4 * r4 + 3] * rstd * ga[3]);
                    ob.x = pk2(O1[4 * r4 + 0] * rstd * gb[0], O1[4 * r4 + 1] * rstd * gb[1]); ob.y = pk2(O1[4 * r4 + 2] * rstd * gb[2], O1[4 * r4 + 3] * rstd * gb[3]);
                    *(u32x2*)(orow + 8 * r4) = oa;
                    *(u32x2*)(orow + 32 + 8 * r4) = ob;
                }
            }
            __syncthreads();
        }
    }
}
template <int DUMMY>
__global__ void __launch_bounds__(512, 2) k_attn2(Params p, int l) {
    extern __shared__ __attribute__((aligned(16))) unsigned char smem_raw[];
    phase_attn(p, l, (LAS unsigned char*)smem_raw);
}
#define MR_VSTR 272

__device__ __forceinline__ void mixrest_conv(const Params& p, int l, int chunk, LAS unsigned char* lds) {
    const int tid = tid_opaque(), wave = tid >> 6, lane = tid & 63;
    const int t0 = chunk * 128, s0 = t0 % SEQ;
    LAS float* glu = (LAS float*)lds;
    const int c = tid & 255, th = tid >> 8;
    float w[31];
#pragma unroll
    for (int j = 0; j < 31; ++j) w[j] = p.conf_dw[((size_t)l * 31 + j) * 256 + c];
    for (int hf = 0; hf < 2; ++hf) {
        const int tb = t0 + hf * 64;
        for (int it = tid; it < 94 * 32; it += 512) {
            const int i = it >> 5, c8 = (it & 31) * 8;
            const int sp = s0 + hf * 64 - 30 + i;
            f32x4 o0 = {0.f, 0.f, 0.f, 0.f}, o1 = {0.f, 0.f, 0.f, 0.f};
            if (sp >= 0) {
                const bf16_t* pr = p.pb + (size_t)(tb - 30 + i) * MIX_IN;
                const u32x4 a = *(const u32x4*)(pr + 3 * 256 + c8), g = *(const u32x4*)(pr + 4 * 256 + c8);
                o0[0] = bflo(a.x) * sigmoidf_(bflo(g.x)); o0[1] = bfhi(a.x) * sigmoidf_(bfhi(g.x));
                o0[2] = bflo(a.y) * sigmoidf_(bflo(g.y)); o0[3] = bfhi(a.y) * sigmoidf_(bfhi(g.y));
                o1[0] = bflo(a.z) * sigmoidf_(bflo(g.z)); o1[1] = bfhi(a.z) * sigmoidf_(bfhi(g.z));
                o1[2] = bflo(a.w) * sigmoidf_(bflo(g.w)); o1[3] = bfhi(a.w) * sigmoidf_(bfhi(g.w));
            }
            *(LAS f32x4*)(glu + i * 256 + c8) = o0; *(LAS f32x4*)(glu + i * 256 + c8 + 4) = o1;
        }
        __syncthreads();
        float acc[32];
#pragma unroll
        for (int o = 0; o < 32; ++o) acc[o] = 0.f;
#pragma unroll
        for (int i = 0; i < 62; ++i) {
            const float xval = glu[(th * 32 + i) * 256 + c];
#pragma unroll
            for (int o = 0; o < 32; ++o) if (i - o >= 0 && i - o <= 30) acc[o] += w[i - o] * xval;
        }
        __syncthreads();
#pragma unroll
        for (int o = 0; o < 32; ++o) glu[(th * 32 + o) * 256 + c] = acc[o];
        __syncthreads();
        const f32x4 lg = *(const f32x4*)(p.conf_ln_g + l * 256 + lane * 4), lb = *(const f32x4*)(p.conf_ln_b + l * 256 + lane * 4);
        for (int k = 0; k < 8; ++k) {
            const int tk = wave * 8 + k;
            const f32x4 z = *(const LAS f32x4*)(glu + tk * 256 + lane * 4);
            const float mu = wave_sum(z[0] + z[1] + z[2] + z[3]) * (1.0f / 256.0f);
            f32x4 dz; float sq = 0.f;
#pragma unroll
            for (int e = 0; e < 4; ++e) { dz[e] = z[e] - mu; sq += dz[e] * dz[e]; }
            const float rstd = rsqrtf(wave_sum(sq) * (1.0f / 256.0f) + 1e-6f);
            float y[4];
#pragma unroll
            for (int e = 0; e < 4; ++e) { const float v = dz[e] * rstd * lg[e] + lb[e]; y[e] = v * sigmoidf_(v); }
            u32x2 o; o.x = pk2(y[0], y[1]); o.y = pk2(y[2], y[3]);
            *(u32x2*)(p.cat + (size_t)(tb + tk) * D_MODEL + 256 + lane * 4) = o;
        }
        __syncthreads();
    }
}

__device__ __forceinline__ void mixrest_sgu(const Params& p, int l, int chunk, LAS unsigned char* lds) {
    const int tid = tid_opaque(), wave = tid >> 6, lane = tid & 63;
    const int t0 = chunk * 128, s0 = t0 % SEQ;
    {
        const float* sw = p.sconv_w + (size_t)l * 3 * 256;
        for (int it = tid; it < 128 * 32; it += 512) {
            const int tt = it >> 5, c8 = (it & 31) * 8;
            const bf16_t* pr = p.pb + (size_t)(t0 + tt) * MIX_IN;
            float z[8];
#pragma unroll
            for (int e = 0; e < 8; ++e) z[e] = 0.f;
#pragma unroll
            for (int j = 0; j < 3; ++j) {
                if (s0 + tt - 2 + j >= 0) {
                    const bf16_t* q = pr + (ptrdiff_t)(j - 2) * MIX_IN;
                    const u32x4 a = *(const u32x4*)(q + 6 * 256 + c8), bq = *(const u32x4*)(q + 7 * 256 + c8);
                    const f32x4 w0 = *(const f32x4*)(sw + j * 256 + c8), w1 = *(const f32x4*)(sw + j * 256 + c8 + 4);
                    z[0] += w0[0] * bflo(a.x) * bflo(bq.x); z[1] += w0[1] * bfhi(a.x) * bfhi(bq.x);
                    z[2] += w0[2] * bflo(a.y) * bflo(bq.y); z[3] += w0[3] * bfhi(a.y) * bfhi(bq.y);
                    z[4] += w1[0] * bflo(a.z) * bflo(bq.z); z[5] += w1[1] * bfhi(a.z) * bfhi(bq.z);
                    z[6] += w1[2] * bflo(a.w) * bflo(bq.w); z[7] += w1[3] * bfhi(a.w) * bfhi(bq.w);
                }
            }
            const u32x4 cb = *(const u32x4*)(pr + 5 * 256 + c8);
            u32x4 o;
            o.x = pk2(bflo(cb.x) * z[0], bfhi(cb.x) * z[1]); o.y = pk2(bflo(cb.y) * z[2], bfhi(cb.y) * z[3]);
            o.z = pk2(bflo(cb.z) * z[4], bfhi(cb.z) * z[5]); o.w = pk2(bflo(cb.w) * z[6], bfhi(cb.w) * z[7]);
            *(u32x4*)(p.cat + (size_t)(t0 + tt) * D_MODEL + 512 + c8) = o;
        }
    }
    {
        const f32x4 lg = *(const f32x4*)(p.sgu_ln_g + l * 256 + lane * 4), lb = *(const f32x4*)(p.sgu_ln_b + l * 256 + lane * 4);
        for (int k = 0; k < 16; ++k) {
            const int s = wave * 16 + k;
            const u32x2 raw = *(const u32x2*)(p.pb + (size_t)(t0 + s) * MIX_IN + 9 * 256 + lane * 4);
            float v[4] = {gelu_exact(bflo(raw.x)), gelu_exact(bfhi(raw.x)), gelu_exact(bflo(raw.y)), gelu_exact(bfhi(raw.y))};
            const float mu = wave_sum(v[0] + v[1] + v[2] + v[3]) * (1.0f / 256.0f);
            float sq = 0.f;
#pragma unroll
            for (int e = 0; e < 4; ++e) { v[e] -= mu; sq += v[e] * v[e]; }
            const float rstd = rsqrtf(wave_sum(sq) * (1.0f / 256.0f) + 1e-6f);
#pragma unroll
            for (int e = 0; e < 4; ++e) *(LAS bf16_t*)(lds + (lane * 4 + e) * MR_VSTR + s * 2) = f2bf(v[e] * rstd * lg[e] + lb[e]);
        }
    }
    __syncthreads();
    {
        const int hq = wave & 3, mb = wave >> 2, c = lane & 31, hh = lane >> 5;
        bf16x8 af[8];
#pragma unroll
        for (int ks = 0; ks < 8; ++ks) af[ks] = *(const LAS bf16x8*)(lds + (hq * 64 + mb * 32 + c) * MR_VSTR + (16 * ks + 8 * hh) * 2);
        const bf16_t* wb = p.sguwb + ((size_t)(l * 4 + hq) * 128) * 128;
        f32x16 acc[4];
#pragma unroll
        for (int nb = 0; nb < 4; ++nb) {
#pragma unroll
            for (int r = 0; r < 16; ++r) acc[nb][r] = 0.f;
#pragma unroll
            for (int ks = 0; ks < 2 * nb + 2; ++ks) {
                const bf16x8 bfrag = *(const bf16x8*)(wb + (size_t)(32 * nb + c) * 128 + 16 * ks + 8 * hh);
                acc[nb] = __builtin_amdgcn_mfma_f32_32x32x16_bf16(af[ks], bfrag, acc[nb], 0, 0, 0);
            }
        }
        const float* bs = p.sgu_b + (size_t)(l * 4 + hq) * 128;
#pragma unroll
        for (int nb = 0; nb < 4; ++nb) {
            const int tt = 32 * nb + c;
            const float bias = bs[tt];
            const bf16_t* su = p.pb + (size_t)(t0 + tt) * MIX_IN + 8 * 256 + hq * 64 + mb * 32 + 4 * hh;
            bf16_t* orow = p.cat + (size_t)(t0 + tt) * D_MODEL + 768 + hq * 64 + mb * 32 + 4 * hh;
#pragma unroll
            for (int r4 = 0; r4 < 4; ++r4) {
                const u32x2 raw = *(const u32x2*)(su + 8 * r4);
                u32x2 o;
                o.x = pk2(gelu_exact(bflo(raw.x)) * (acc[nb][4 * r4 + 0] + bias), gelu_exact(bfhi(raw.x)) * (acc[nb][4 * r4 + 1] + bias));
                o.y = pk2(gelu_exact(bflo(raw.y)) * (acc[nb][4 * r4 + 2] + bias), gelu_exact(bfhi(raw.y)) * (acc[nb][4 * r4 + 3] + bias));
                *(u32x2*)(orow + 8 * r4) = o;
            }
        }
    }
    __syncthreads();
}

__device__ __forceinline__ void phase_mixrest(const Params& p, int l, LAS unsigned char* lds) {
    for (int u = blockIdx.x; u < 256; u += gridDim.x) {
        const int chunk = u >> 1;
        if (u & 1) mixrest_sgu(p, l, chunk, lds); else mixrest_conv(p, l, chunk, lds);
    }
}
template <int DUMMY>
__global__ void __launch_bounds__(512, 2) k_mixrest(Params p, int l) {
    extern __shared__ __attribute__((aligned(16))) unsigned char smem_raw[];
    phase_mixrest(p, l, (LAS unsigned char*)smem_raw);
}
__device__ __forceinline__ int f2sortable(float f) { const int x = __float_as_int(f); return x ^ ((x >> 31) & 0x7FFFFFFF); }
__device__ __forceinline__ float sortable2f(int s) { return __int_as_float(s ^ ((s >> 31) & 0x7FFFFFFF)); }

template <int N>
__device__ __forceinline__ void bitonic_sort_desc(int (&a)[N]) {
#pragma unroll
    for (int k = 2; k <= N; k <<= 1)
#pragma unroll
        for (int j = k >> 1; j > 0; j >>= 1)
#pragma unroll
            for (int i = 0; i < N; ++i) {
                const int q = i ^ j;
                if (q > i) {
                    const int hi = max(a[i], a[q]), lo = min(a[i], a[q]);
                    if ((i & k) == 0 || k == N) { a[i] = hi; a[q] = lo; } else { a[i] = lo; a[q] = hi; }
                }
            }
}
__device__ __forceinline__ void bitonic_merge_desc16(int (&a)[16]) {
#pragma unroll
    for (int j = 8; j > 0; j >>= 1)
#pragma unroll
        for (int i = 0; i < 16; ++i) {
            const int q = i ^ j;
            if (q > i) { const int hi = max(a[i], a[q]), lo = min(a[i], a[q]); a[i] = hi; a[q] = lo; }
        }
}
__device__ __forceinline__ void merge_top16(int (&a)[16], const int (&b)[16]) {
#pragma unroll
    for (int i = 0; i < 16; ++i) a[i] = max(a[i], b[15 - i]);
    bitonic_merge_desc16(a);
}

__device__ __forceinline__ void phase_topk(const Params& p, int l, LAS unsigned char* lds) {
    const int tid = tid_opaque(), wave = __builtin_amdgcn_readfirstlane(tid >> 6), lane = tid & 63, c = lane & 31, hh = lane >> 5;
    const int hd = wave;
    LAS unsigned char* ilist = lds + wave * 1024 + c * 32;
    const int hx = hh << 2;
    const __amdgpu_buffer_rsrc_t rq = __builtin_amdgcn_make_buffer_rsrc((void*)p.qb, 0, NTOK * 2048 * 2, 0x00020000);
    const __amdgpu_buffer_rsrc_t rk = __builtin_amdgcn_make_buffer_rsrc((void*)(p.keysb + (size_t)l * 16 * 128 * 128), 0, 16 * 128 * 128 * 2, 0x00020000);
    const int qvoff = c * 4096 + hh * 16, kvoff = c * 256 + hh * 16;
    for (int u = blockIdx.x; u < NTOK / 32; u += gridDim.x) {
        const int t = u * 32 + c;
        int S0[16], S1[16];
#pragma unroll
        for (int pp = 0; pp < 2; ++pp) {
            bf16x8 qf[8];
            {
                const int qso = (u * 32) * 4096 + hd * 512 + pp * 256;
#pragma unroll
                for (int ks = 0; ks < 8; ++ks) qf[ks] = __builtin_bit_cast(bf16x8, __builtin_amdgcn_raw_buffer_load_b128(rq, qvoff + 32 * ks, qso, 0));
            }
            const int kso = ((hd * 2 + pp) * 128) * 256;
            int K0[16], K1[16], K2[16], K3[16];
#pragma unroll
            for (int kb = 0; kb < 4; ++kb) {
                asm volatile("" ::: "memory");
                f32x16 acc;
#pragma unroll
                for (int r = 0; r < 16; ++r) acc[r] = 0.f;
#pragma unroll
                for (int ks = 0; ks < 8; ++ks) {
                    const bf16x8 a = __builtin_bit_cast(bf16x8, __builtin_amdgcn_raw_buffer_load_b128(rk, kvoff + 32 * ks, kso + (32 * kb) * 256, 0));
                    acc = __builtin_amdgcn_mfma_f32_32x32x16_bf16(a, qf[ks], acc, 0, 0, 0);
                }
#pragma unroll
                for (int r = 0; r < 16; ++r) {
                    const int nconst = 32 * kb + (r & 3) + 8 * (r >> 2);
                    const int key = (f2sortable(acc[r]) & ~0x7F) | (127 - nconst);
                    if (kb == 0) K0[r] = key; else if (kb == 1) K1[r] = key; else if (kb == 2) K2[r] = key; else K3[r] = key;
                }
            }
            bitonic_sort_desc<16>(K0); bitonic_sort_desc<16>(K1); bitonic_sort_desc<16>(K2); bitonic_sort_desc<16>(K3);
            merge_top16(K0, K1); merge_top16(K2, K3); merge_top16(K0, K2);
            int P[16];
#pragma unroll
            for (int i = 0; i < 16; ++i) { K0[i] ^= hx; P[i] = __shfl_xor(K0[i], 32, 64); }
            merge_top16(K0, P);
#pragma unroll
            for (int i = 0; i < 16; ++i) { if (pp == 0) S0[i] = K0[i]; else S1[i] = K0[i]; }
        }
        {
            unsigned w4[4];
#pragma unroll
            for (int q = 0; q < 4; ++q) {
                unsigned w = 0;
#pragma unroll
                for (int e = 0; e < 4; ++e) { const int sv = hh ? S1[4 * q + e] : S0[4 * q + e]; w |= (unsigned)(127 - (sv & 127)) << (8 * e); }
                w4[q] = w;
            }
            u32x4 wv; wv.x = w4[0]; wv.y = w4[1]; wv.z = w4[2]; wv.w = w4[3];
            *(LAS u32x4*)(ilist + 16 * hh) = wv;
        }
        float a[16], b[16];
#pragma unroll
        for (int i = 0; i < 16; ++i) {
            const float f1 = sortable2f(S0[i] & ~0x7F), f2 = sortable2f(S1[i] & ~0x7F);
            a[i] = hh ? f2 : f1; b[i] = hh ? f1 : f2;
        }
        int CA[16], CB[16];
        const int org = hh << 8;
        {
            int n = 0;
#pragma unroll
            for (int i = 0; i < 4; ++i)
#pragma unroll
                for (int j = i; j < 16; ++j) {
                    if ((i + 1) * (j + 1) <= 16) {
                        int key = (f2sortable(a[i] + b[j]) & ~0x1FF) | org | (i * 16 + j);
                        if (i == j) key = hh ? (int)0x80000000 : key;
                        if (n < 16) CA[n] = key; else CB[n - 16] = key;
                        ++n;
                    }
                }
#pragma unroll
            for (int q = 27; q < 32; ++q) CB[q - 16] = (int)0x80000000;
        }
        bitonic_sort_desc<16>(CA); bitonic_sort_desc<16>(CB);
        merge_top16(CA, CB);
        int F[16], PF[16];
#pragma unroll
        for (int i = 0; i < 16; ++i) PF[i] = __shfl_xor(CA[i], 32, 64);
#pragma unroll
        for (int i = 0; i < 16; ++i) F[i] = max(CA[i], PF[15 - i]);
        int mxk = F[0];
#pragma unroll
        for (int i = 1; i < 16; ++i) mxk = max(mxk, F[i]);
        const float vmax = sortable2f(mxk & ~0x1FF);
        float e[8], psum = 0.f;
#pragma unroll
        for (int i = 0; i < 8; ++i) { e[i] = __expf(sortable2f(F[i] & ~0x1FF) - vmax); psum += e[i]; }
        const float inv = 1.0f / (psum + __shfl_xor(psum, 32, 64));
        asm volatile("s_waitcnt lgkmcnt(0)" ::: "memory");
        int ex[8];
#pragma unroll
        for (int i = 0; i < 8; ++i) {
            const int low = F[i] & 0x1FF, o = low >> 8, il = (low >> 4) & 15, jl = low & 15;
            const int ri = o ? jl : il, rj = o ? il : jl;
            const int i1 = (int)*(const LAS unsigned char*)(ilist + ri), i2 = (int)*(const LAS unsigned char*)(ilist + 16 + rj);
            ex[i] = i1 * 128 + i2;
        }
        int* ep = p.eidx + ((size_t)t * 8 + hd) * 16 + hh * 8;
        float* gp = p.egate + ((size_t)t * 8 + hd) * 16 + hh * 8;
        *(u32x4*)ep = (u32x4){(unsigned)ex[0], (unsigned)ex[1], (unsigned)ex[2], (unsigned)ex[3]};
        *(u32x4*)(ep + 4) = (u32x4){(unsigned)ex[4], (unsigned)ex[5], (unsigned)ex[6], (unsigned)ex[7]};
        *(f32x4*)gp = (f32x4){e[0] * inv, e[1] * inv, e[2] * inv, e[3] * inv};
        *(f32x4*)(gp + 4) = (f32x4){e[4] * inv, e[5] * inv, e[6] * inv, e[7] * inv};
        asm volatile("s_waitcnt lgkmcnt(0)" ::: "memory");
    }
}
template <int DUMMY>
__global__ void __launch_bounds__(512, 2) k_topk(Params p, int l) {
    extern __shared__ __attribute__((aligned(16))) unsigned char smem_raw[];
    phase_topk(p, l, (LAS unsigned char*)smem_raw);
}
__device__ __forceinline__ void phase_mod(const Params& p, LAS unsigned char* lds) {
    const int tid = tid_opaque();
    LAS float* sc = (LAS float*)lds;
    LAS float* red = (LAS float*)(lds + 32768);
    for (int i = tid; i < BATCH * D_MODEL; i += 512) { const int b = i >> 10, k = i & 1023; const float v = p.c[i]; sc[k * 8 + b] = v / (1.0f + __expf(-v)); }
    __syncthreads();
    const int kg = tid >> 5, cl = tid & 31;
    for (int u = blockIdx.x; u < DEPTH * 64; u += gridDim.x) {
        const int l = u >> 6, j0 = (u & 63) * 96;
        const float* w = p.w_mod + (size_t)l * D_MODEL * MODW + (size_t)(kg * 64) * MODW + j0 + cl;
        float acc[3][8];
#pragma unroll
        for (int q = 0; q < 3; ++q)
#pragma unroll
            for (int b = 0; b < 8; ++b) acc[q][b] = 0.f;
#pragma unroll 4
        for (int kk = 0; kk < 64; ++kk) {
            const float w0 = w[(size_t)kk * MODW], w1 = w[(size_t)kk * MODW + 32], w2 = w[(size_t)kk * MODW + 64];
            const f32x4 s0 = *(const LAS f32x4*)(sc + (kg * 64 + kk) * 8), s1 = *(const LAS f32x4*)(sc + (kg * 64 + kk) * 8 + 4);
#pragma unroll
            for (int b = 0; b < 4; ++b) { acc[0][b] += s0[b] * w0; acc[1][b] += s0[b] * w1; acc[2][b] += s0[b] * w2; acc[0][4 + b] += s1[b] * w0; acc[1][4 + b] += s1[b] * w1; acc[2][4 + b] += s1[b] * w2; }
        }
#pragma unroll
        for (int q = 0; q < 3; ++q)
#pragma unroll
            for (int b = 0; b < 8; ++b) red[((kg * 3 + q) * 8 + b) * 32 + cl] = acc[q][b];
        __syncthreads();
        for (int o = tid; o < 768; o += 512) {
            float s = 0.f;
#pragma unroll
            for (int g = 0; g < 16; ++g) s += red[g * 768 + o];
            const int ocl = o & 31, ob = (o >> 5) & 7, oq = o >> 8;
            const int j = j0 + oq * 32 + ocl;
            p.mod[((size_t)l * BATCH + ob) * MODW + j] = s + p.b_mod[(size_t)l * MODW + j];
        }
        __syncthreads();
    }
}

__global__ void __launch_bounds__(512, 2) k_mega(Params p) {
    extern __shared__ __attribute__((aligned(16))) unsigned char smem_raw[];
    LAS unsigned char* lds = (LAS unsigned char*)smem_raw;
    volatile LAS unsigned* xbw = (volatile LAS unsigned*)(lds + LDS_BYTES - 16);
    if (threadIdx.x == 0) { xbw[0] = 0u; xbw[1] = 0u; xbw[2] = 0u; xbw[3] = 0u; }
    __syncthreads();
    (void)xcd_barrier_post(p.bar, xbw);
#define GRID_SYNC() do { XcdBarrier _b; _b.bar = p.bar; _b.x = xb_xcc_id(); _b.st = (volatile LAS unsigned*)(lds + LDS_BYTES - 16); xcd_barrier(_b); } while (0)

    phase_mod(p, lds);
    phase_convert(p, lds);
    GRID_SYNC();
    phase_norm(p, p.x_in, p.norm1_g, p.mod, 0, 1);
    GRID_SYNC();
    for (int l = 0; l < DEPTH; ++l) {
        const float* modl = p.mod + (size_t)l * BATCH * MODW;
        { EpiStoreBf16 E; E.O = p.pb; E.ldc = MIX_IN; run_gemm(lds, p.hb, p.WinT + (size_t)l * MIX_IN * D_MODEL, NTOK, MIX_IN, D_MODEL, E); }
        GRID_SYNC();
        phase_attn(p, l, lds);
        phase_mixrest(p, l, lds);
        GRID_SYNC();
        { EpiResid E; E.xin = (l == 0) ? p.x_in : p.xb; E.xout = p.xb; E.gate = modl + 2 * D_MODEL; run_gemm(lds, p.cat, p.WoutT + (size_t)l * D_MODEL * D_MODEL, NTOK, D_MODEL, D_MODEL, E); }
        GRID_SYNC();
        phase_norm(p, p.xb, p.norm2_g + l * D_MODEL, modl, 3, 4);
        GRID_SYNC();
        { EpiStoreBf16 E; E.O = p.qb; E.ldc = 2048; run_gemm(lds, p.hb, p.WqT + (size_t)l * 2048 * D_MODEL, NTOK, 2048, D_MODEL, E); }
        GRID_SYNC();
        phase_topk(p, l, lds);
        GRID_SYNC();
        phase_expert(p, l, l == DEPTH - 1);
        GRID_SYNC();
    }
}
#ifndef MK_MULTI
#define MK_MULTI 0
#endif
enum { PH_CONVERT = 0, PH_NORM1, PH_GEMM1, PH_GEMM2, PH_NORM2, PH_GEMM3, PH_MOD };
template <int PH>
__global__ void __launch_bounds__(512, 2) k_ph(Params p, int l) {
    extern __shared__ __attribute__((aligned(16))) unsigned char smem_raw[];
    LAS unsigned char* lds = (LAS unsigned char*)smem_raw;
    const float* modl = p.mod + (size_t)l * BATCH * MODW;
    if (PH == PH_CONVERT) phase_convert(p, lds);
    if (PH == PH_MOD) phase_mod(p, lds);
    if (PH == PH_NORM1) phase_norm(p, l == 0 ? p.x_in : p.xb, p.norm1_g + l * D_MODEL, modl, 0, 1);
    if (PH == PH_GEMM1) { EpiStoreBf16 E; E.O = p.pb; E.ldc = MIX_IN; run_gemm(lds, p.hb, p.WinT + (size_t)l * MIX_IN * D_MODEL, NTOK, MIX_IN, D_MODEL, E); }
    if (PH == PH_GEMM2) { EpiResid E; E.xin = (l == 0) ? p.x_in : p.xb; E.xout = p.xb; E.gate = modl + 2 * D_MODEL; run_gemm(lds, p.cat, p.WoutT + (size_t)l * D_MODEL * D_MODEL, NTOK, D_MODEL, D_MODEL, E); }
    if (PH == PH_NORM2) phase_norm(p, p.xb, p.norm2_g + l * D_MODEL, modl, 3, 4);
    if (PH == PH_GEMM3) { EpiStoreBf16 E; E.O = p.qb; E.ldc = 2048; run_gemm(lds, p.hb, p.WqT + (size_t)l * 2048 * D_MODEL, NTOK, 2048, D_MODEL, E); }
}

extern "C" void kernel_launch(void* const* d_in, const int* in_sizes, int n_in, void* d_out, int out_size, void* d_ws, size_t ws_size, hipStream_t stream) {
    Params p{};
    p.x_in = (const float*)d_in[0]; p.c = (const float*)d_in[1]; p.rel_bias = (const float*)d_in[2]; p.w_mod = (const float*)d_in[3]; p.b_mod = (const float*)d_in[4];
    p.norm1_g = (const float*)d_in[5]; p.norm2_g = (const float*)d_in[6]; p.w_in = (const float*)d_in[7]; p.w_out = (const float*)d_in[8]; p.diff_lambda = (const float*)d_in[9];
    p.subln_g = (const float*)d_in[10]; p.conf_dw = (const float*)d_in[11]; p.conf_ln_g = (const float*)d_in[12]; p.conf_ln_b = (const float*)d_in[13]; p.sconv_w = (const float*)d_in[14];
    p.sgu_ln_g = (const float*)d_in[15]; p.sgu_ln_b = (const float*)d_in[16]; p.sgu_w = (const float*)d_in[17]; p.sgu_b = (const float*)d_in[18]; p.peer_wq = (const float*)d_in[19];
    p.peer_keys = (const float*)d_in[20]; p.peer_u = (const float*)d_in[21]; p.peer_v = (const float*)d_in[22]; p.final_g = (const float*)d_in[23];
    p.out = (float*)d_out;
    for (int l = 0; l < DEPTH; ++l) p.lam_init[l] = (float)(0.8 - 0.6 * exp(-0.3 * (double)l));

    char* ws = (char*)d_ws; size_t off = 0;
    auto take = [&](size_t bytes) { void* r = ws + off; off += (bytes + 255) & ~(size_t)255; return r; };
    p.bar = (unsigned*)take((size_t)XCD_BAR_WORDS * 4);
    p.mod = (float*)take((size_t)DEPTH * BATCH * MODW * 4);
    p.xb = (float*)take((size_t)NTOK * D_MODEL * 4);
    p.hb = (bf16_t*)take((size_t)NTOK * D_MODEL * 2);
    p.pb = (bf16_t*)take((size_t)NTOK * MIX_IN * 2);
    p.cat = (bf16_t*)take((size_t)NTOK * D_MODEL * 2);
    p.qb = (bf16_t*)take((size_t)NTOK * 2048 * 2);
    p.WinT = (bf16_t*)take((size_t)DEPTH * MIX_IN * D_MODEL * 2);
    p.WoutT = (bf16_t*)take((size_t)DEPTH * D_MODEL * D_MODEL * 2);
    p.WqT = (bf16_t*)take((size_t)DEPTH * 2048 * D_MODEL * 2);
    p.keysb = (bf16_t*)take((size_t)DEPTH * 16 * 128 * 128 * 2);
    p.ub = (bf16_t*)take((size_t)DEPTH * NEXP * D_MODEL * 2);
    p.vb = (bf16_t*)take((size_t)DEPTH * NEXP * D_MODEL * 2);
    p.sguwb = (bf16_t*)take((size_t)DEPTH * 4 * 128 * 128 * 2);
    p.eidx = (int*)take((size_t)NTOK * 128 * 4);
    p.egate = (float*)take((size_t)NTOK * 128 * 4);

    static int grid = 0;
    if (grid == 0) {
        int dev = 0, cus = 0;
        if (hipGetDevice(&dev) != hipSuccess || hipDeviceGetAttribute(&cus, hipDeviceAttributeMultiprocessorCount, dev) != hipSuccess) { grid = -1; return; }
        bool ok = true;
#if MK_MULTI
        ok &= hipFuncSetAttribute((const void*)k_ph<PH_CONVERT>, hipFuncAttributeMaxDynamicSharedMemorySize, LDS_BYTES) == hipSuccess;
        ok &= hipFuncSetAttribute((const void*)k_ph<PH_NORM1>, hipFuncAttributeMaxDynamicSharedMemorySize, LDS_BYTES) == hipSuccess;
        ok &= hipFuncSetAttribute((const void*)k_ph<PH_GEMM1>, hipFuncAttributeMaxDynamicSharedMemorySize, LDS_BYTES) == hipSuccess;
        ok &= hipFuncSetAttribute((const void*)k_ph<PH_GEMM2>, hipFuncAttributeMaxDynamicSharedMemorySize, LDS_BYTES) == hipSuccess;
        ok &= hipFuncSetAttribute((const void*)k_ph<PH_NORM2>, hipFuncAttributeMaxDynamicSharedMemorySize, LDS_BYTES) == hipSuccess;
        ok &= hipFuncSetAttribute((const void*)k_ph<PH_GEMM3>, hipFuncAttributeMaxDynamicSharedMemorySize, LDS_BYTES) == hipSuccess;
        ok &= hipFuncSetAttribute((const void*)k_ph<PH_MOD>, hipFuncAttributeMaxDynamicSharedMemorySize, LDS_BYTES) == hipSuccess;
        ok &= hipFuncSetAttribute((const void*)k_attn2<0>, hipFuncAttributeMaxDynamicSharedMemorySize, LDS_BYTES) == hipSuccess;
        ok &= hipFuncSetAttribute((const void*)k_topk<0>, hipFuncAttributeMaxDynamicSharedMemorySize, LDS_BYTES) == hipSuccess;
        ok &= hipFuncSetAttribute((const void*)k_mixrest<0>, hipFuncAttributeMaxDynamicSharedMemorySize, LDS_BYTES) == hipSuccess;
#else
        ok &= hipFuncSetAttribute((const void*)k_mega, hipFuncAttributeMaxDynamicSharedMemorySize, LDS_BYTES) == hipSuccess;
#endif
        if (!ok) { fprintf(stderr, "kernel_launch: hipFuncSetAttribute failed\n"); grid = -1; return; }
        grid = cus;
    }
    if (grid < 0) return;
    const int G = grid;
#if MK_MULTI
    k_ph<PH_MOD><<<G, 512, LDS_BYTES, stream>>>(p, 0);
    k_ph<PH_CONVERT><<<G, 512, LDS_BYTES, stream>>>(p, 0);
    for (int l = 0; l < DEPTH; ++l) {
        if (l == 0) k_ph<PH_NORM1><<<G, 512, LDS_BYTES, stream>>>(p, l);
        k_ph<PH_GEMM1><<<G, 512, LDS_BYTES, stream>>>(p, l);
        k_attn2<0><<<G, 512, LDS_BYTES, stream>>>(p, l);
        k_mixrest<0><<<G, 512, LDS_BYTES, stream>>>(p, l);
        k_ph<PH_GEMM2><<<G, 512, LDS_BYTES, stream>>>(p, l);
        k_ph<PH_NORM2><<<G, 512, LDS_BYTES, stream>>>(p, l);
        k_ph<PH_GEMM3><<<G, 512, LDS_BYTES, stream>>>(p, l);
        k_topk<0><<<G, 512, LDS_BYTES, stream>>>(p, l);
        k_expert<<<G, 512, 0, stream>>>(p, l);
    }
#else
    (void)hipMemsetAsync(p.bar, 0, (size_t)XCD_BAR_WORDS * 4, stream);
    k_mega<<<G, 512, LDS_BYTES, stream>>>(p);
#endif
}
```

```cpp
#include <hip/hip_runtime.h>
#include <stdint.h>
#include <stdio.h>
#include <math.h>

#define D_MODEL 1024
#define BATCH 8
#define SEQ 2048
#define DEPTH 4
#define NTOK (BATCH * SEQ)
#define MIX_IN 2560
#define N_MOD 6
#define MODW (N_MOD * D_MODEL)
#define NEXP 16384

#define LAS __attribute__((address_space(3)))
typedef unsigned short bf16_t;
typedef short bf16x8 __attribute__((ext_vector_type(8)));
typedef float f32x4 __attribute__((ext_vector_type(4)));
typedef float f32x16 __attribute__((ext_vector_type(16)));
typedef unsigned u32x4 __attribute__((ext_vector_type(4)));
typedef unsigned u32x2 __attribute__((ext_vector_type(2)));

__device__ const unsigned char kBucket[128] = {
    0, 1, 2, 3, 4, 5, 6, 7, 8, 9, 10, 11, 12, 13, 14, 15, 16, 16, 16, 17, 17, 18, 18, 18, 19, 19, 19, 20, 20, 20, 20, 21,
    21, 21, 21, 22, 22, 22, 22, 22, 23, 23, 23, 23, 23, 23, 24, 24, 24, 24, 24, 24, 25, 25, 25, 25, 25, 25, 25, 26, 26, 26, 26, 26,
    26, 26, 26, 27, 27, 27, 27, 27, 27, 27, 27, 27, 27, 28, 28, 28, 28, 28, 28, 28, 28, 28, 28, 29, 29, 29, 29, 29, 29, 29, 29, 29,
    29, 29, 29, 30, 30, 30, 30, 30, 30, 30, 30, 30, 30, 30, 30, 30, 30, 31, 31, 31, 31, 31, 31, 31, 31, 31, 31, 31, 31, 31, 31, 31};

__device__ __forceinline__ float bf2f(bf16_t v) { return __uint_as_float(((unsigned)v) << 16); }
__device__ __forceinline__ float bflo(unsigned w) { return __uint_as_float(w << 16); }
__device__ __forceinline__ float bfhi(unsigned w) { return __uint_as_float(w & 0xFFFF0000u); }
__device__ __forceinline__ bf16_t f2bf(float f) { unsigned u = __float_as_uint(f); u += 0x7FFFu + ((u >> 16) & 1u); return (bf16_t)(u >> 16); }
__device__ __forceinline__ unsigned pk2(float lo, float hi) { unsigned r; asm volatile("v_cvt_pk_bf16_f32 %0, %1, %2" : "=v"(r) : "v"(lo), "v"(hi)); return r; }
__device__ __forceinline__ float ldf(const float* p) { return *p; }
__device__ __forceinline__ float ldf(const bf16_t* p) { return bf2f(*p); }

__device__ __forceinline__ float gelu_exact(float v) { return 0.5f * v * (1.0f + erff(v * 0.70710678118654752f)); }
__device__ __forceinline__ float sigmoidf_(float v) { return 1.0f / (1.0f + __expf(-v)); }
__device__ __forceinline__ float wave_sum(float v) {
#pragma unroll
    for (int o = 32; o > 0; o >>= 1) v += __shfl_xor(v, o, 64);
    return v;
}
__device__ __forceinline__ float block_sum256(float v, float* red) {
    v = wave_sum(v);
    __syncthreads();
    if ((threadIdx.x & 63) == 0) red[threadIdx.x >> 6] = v;
    __syncthreads();
    return red[0] + red[1] + red[2] + red[3];
}

__device__ __forceinline__ int tid_opaque() { int t = (int)threadIdx.x; asm volatile("" : "+v"(t)); return t; }
#define XB_TMO      128
#define XB_XCNT(j)  (256  + 64 * (j))
#define XB_XSUB(j)  (1280 + 64 * (j))
#define XB_XGEN(j)  (2304 + 64 * (j))
#define XB_TOP      3328
#define XB_TOPGEN   3392
#define XCD_BAR_WORDS 3456
#define XB_SPIN_CAP (1u << 18)

__device__ __forceinline__ unsigned xb_ld(unsigned* p)              { return __hip_atomic_load(p, __ATOMIC_RELAXED, __HIP_MEMORY_SCOPE_AGENT); }
__device__ __forceinline__ unsigned xb_add(unsigned* p, unsigned v) { return __hip_atomic_fetch_add(p, v, __ATOMIC_RELAXED, __HIP_MEMORY_SCOPE_AGENT); }
__device__ __forceinline__ unsigned xb_xcc_id() { return (unsigned)__builtin_amdgcn_s_getreg((3 << 11) | 20) & 0xFu; }
#define XB_SPIN(cond, bar) do { unsigned _sp = 0; while (cond) { __builtin_amdgcn_s_sleep(1); \
    if ((++_sp & 255u) == 0u) { if (xb_ld(&(bar)[XB_TMO])) break; if (_sp > XB_SPIN_CAP) { atomicAdd(&(bar)[XB_TMO], 1u); break; } } } } while (0)

struct XcdBarrier {
    unsigned* bar; unsigned x;
    volatile LAS unsigned* st;
};

__device__ __forceinline__ XcdBarrier xcd_barrier_post(unsigned* bar, volatile LAS unsigned* st) {
    XcdBarrier b; b.bar = bar; b.x = xb_xcc_id(); b.st = st;
    if (threadIdx.x == 0) (void)xb_add(&bar[XB_XCNT(b.x)], 1u);
    return b;
}
__device__ __forceinline__ void xcd_barrier_complete(unsigned* bar, unsigned x, unsigned& nloc, unsigned& nx) {
    const unsigned G = gridDim.x * gridDim.y * gridDim.z;
    unsigned sum, cnt, mine, sp = 0u;
    for (;;) {
        sum = 0u; cnt = 0u; mine = 0u;
#pragma unroll
        for (unsigned j = 0; j < 16; ++j) { const unsigned c = xb_ld(&bar[XB_XCNT(j)]); sum += c; cnt += (c > 0u) ? 1u : 0u; mine = (j == x) ? c : mine; }
        if (sum == G) break;
        __builtin_amdgcn_s_sleep(1);
        if ((++sp & 255u) == 0u) { if (xb_ld(&bar[XB_TMO])) break; if (sp > XB_SPIN_CAP) { atomicAdd(&bar[XB_TMO], 1u); break; } }
    }
    nloc = mine > 0u ? mine : 1u; nx = cnt > 0u ? cnt : 1u;
}

__device__ __forceinline__ void xcd_barrier(const XcdBarrier& b) {
    asm volatile("s_waitcnt vmcnt(0)" ::: "memory");
    __syncthreads();
    if (threadIdx.x == 0) {
        unsigned* bar = b.bar;
        __builtin_amdgcn_s_waitcnt(0);
        unsigned nloc = b.st[0], nx = b.st[1];
        if (nloc == 0u) { xcd_barrier_complete(bar, b.x, nloc, nx); b.st[0] = nloc; b.st[1] = nx; }
        const unsigned old = xb_add(&bar[XB_XSUB(b.x)], 1u);
        const unsigned gen = old / nloc;
        if (old + 1u == (gen + 1u) * nloc) {
            __builtin_amdgcn_fence(__ATOMIC_RELEASE, "agent");
            asm volatile("s_waitcnt vmcnt(0)" ::: "memory");
            const unsigned og = xb_add(&bar[XB_TOP], 1u);
            const unsigned tg = og / nx;
            if (og + 1u == (tg + 1u) * nx) xb_add(&bar[XB_TOPGEN], 1u);
            else XB_SPIN(xb_ld(&bar[XB_TOPGEN]) == tg, bar);
            __builtin_amdgcn_fence(__ATOMIC_ACQUIRE, "agent");
            xb_add(&bar[XB_XGEN(b.x)], 1u);
            asm volatile("s_waitcnt vmcnt(0)" ::: "memory");
        } else {
            XB_SPIN(xb_ld(&bar[XB_XGEN(b.x)]) == gen, bar);
            __builtin_amdgcn_fence(__ATOMIC_ACQUIRE, "agent");
            asm volatile("s_waitcnt vmcnt(0)" ::: "memory");
        }
    }
    __syncthreads();
}
namespace pg8 {
#define PG8_LAS __attribute__((address_space(3)))
typedef unsigned short bf16_t;
typedef short bf16x8 __attribute__((ext_vector_type(8)));
typedef float f32x4 __attribute__((ext_vector_type(4)));
typedef unsigned u32x4 __attribute__((ext_vector_type(4)));
constexpr int BM = 256, BK = 64, HALF = 128, HTB = HALF * BK * 2  , STAGE_BYTES = 8 * HTB, NXCD = 8, WGM = 8;

__host__ __device__ __forceinline__ int lds_byte(int r, int c) { const int st = (r >> 4) * 2 + (c >> 5), rr = r & 15, cc = c & 31, ob = rr * 64 + cc * 2; return st * 1024 + (ob ^ (((ob >> 9) & 1) << 5)); }
__host__ __device__ __forceinline__ void stage_rc(int b, int& R, int& C) { const int st = b / 1024, sb = b % 1024, swz = sb ^ (((sb >> 9) & 1) << 5); R = (st >> 1) * 16 + swz / 64; C = (st & 1) * 32 + (swz % 64) / 2; }
__host__ __device__ __forceinline__ int perm32(int rho) { const int n = rho >> 4, i = rho & 15; return 8 * (i >> 2) + 4 * n + (i & 3); }

struct Unit { int pm, pn; };
struct Gemm { const bf16_t* A; const bf16_t* Bt; int M, N, K; };

struct StaticOrder {
    int nM, nN, nwg, G, c;
    __host__ __device__ void init(int M, int N, int G_, int c_) { nM = M / BM; nN = N / BM; nwg = nM * nN; G = G_; c = c_; }
    __host__ __device__ bool next(int i, Unit& u) const {
        const long L = (long)i * G + c; if (L >= nwg) return false;
        int wgid = (int)L; { const int q = nwg / NXCD, r = nwg % NXCD, xcd = wgid % NXCD, off = wgid / NXCD; wgid = (xcd < r ? xcd * (q + 1) : r * (q + 1) + (xcd - r) * q) + off; }
        const int nig = WGM * nN, gid = wgid / nig, fm = gid * WGM, gsz = (nM - fm) < WGM ? (nM - fm) : WGM;
        u.pm = fm + ((wgid % nig) % gsz); u.pn = (wgid % nig) / gsz; return true;
    }
    __device__ __forceinline__ void a_ready(const Unit&) const {}
    __device__ __forceinline__ void done(const Unit&) const {}
};
__device__ __forceinline__ unsigned cvt_pk_bf16(float lo, float hi) { unsigned r; asm volatile("v_cvt_pk_bf16_f32 %0, %1, %2" : "=v"(r) : "v"(lo), "v"(hi)); return r; }
template <class Epi, class Sched, bool STAMP = false>
__device__ __forceinline__ void gemm_phase(PG8_LAS unsigned char* lds, const Gemm g, const Sched& S, const Epi& E, unsigned long long* stamps) {
    const int tid = tid_opaque(), wid = __builtin_amdgcn_readfirstlane(tid >> 6), lane = tid & 63, wr = wid >> 2, wc = wid & 3, fr = lane & 15, fq = lane >> 4;
    const int K = g.K, nt = K / BK;
    int ts_lo = 0, ts_hi = 0, nts = 0; const unsigned long long rt_entry = STAMP ? (unsigned long long)wall_clock64() : 0ull;
#define PG8_STAMP() do { if (STAMP && wid == 0 && nts < 64) { const unsigned long long _c = (unsigned long long)clock64(); \
        ts_lo = (lane == nts) ? (int)(unsigned)_c : ts_lo; ts_hi = (lane == nts) ? (int)(unsigned)(_c >> 32) : ts_hi; ++nts; } } while (0)
    PG8_STAMP();
    unsigned voffA[2], voffB[2];
#pragma unroll
    for (int i = 0; i < 2; ++i) { int R, C; stage_rc(tid * 16 + i * 8192, R, C); const int Rb = Epi::PERM ? ((R & ~31) + perm32(R & 31)) : R;
        voffA[i] = (unsigned)(R * K + C) * 2u; voffB[i] = (unsigned)(Rb * K + C) * 2u; }
    const size_t kstep = (size_t)(BK * 2);
    const size_t hstep = (size_t)HALF * K * 2;
    const size_t tstep = 2 * hstep;
    const unsigned ldsw = (unsigned)wid * 1024u;
    const int aoff = lds_byte(wr * 64 + fr, fq * 8), boff = lds_byte(wc * 32 + fr, fq * 8);
#define PG8_SA(b, h) (((b) * 2 + (h)) * HTB)
#define PG8_SB(b, h) ((4 + (b) * 2 + (h)) * HTB)
#define PG8_STAGE(bufoff, gbase, voff) do { _Pragma("unroll") for (int _i = 0; _i < 2; ++_i) \
        __builtin_amdgcn_global_load_lds((const unsigned*)((const char*)(gbase) + (voff)[_i]), (PG8_LAS unsigned*)(lds + (bufoff) + ldsw + _i * 8192), 16, 0, 0); } while (0)
#define PG8_LDA(dst, b, h) do { _Pragma("unroll") for (int m = 0; m < 4; ++m) _Pragma("unroll") for (int k = 0; k < 2; ++k) dst[m][k] = *(const PG8_LAS bf16x8*)(lds + PG8_SA(b, h) + aoff + m * 2048 + k * 1024); } while (0)
#define PG8_LDB(dst, b, h) do { _Pragma("unroll") for (int n = 0; n < 2; ++n) _Pragma("unroll") for (int k = 0; k < 2; ++k) dst[n][k] = *(const PG8_LAS bf16x8*)(lds + PG8_SB(b, h) + boff + n * 2048 + k * 1024); } while (0)
#define PG8_MMA(ai, bj, At, Bt) do { __builtin_amdgcn_s_setprio(1); _Pragma("unroll") for (int m = 0; m < 4; ++m) _Pragma("unroll") for (int n = 0; n < 2; ++n) _Pragma("unroll") for (int k = 0; k < 2; ++k) \
        acc[ai][bj][m][n] = __builtin_amdgcn_mfma_f32_16x16x32_bf16(Bt[n][k], At[m][k], acc[ai][bj][m][n], 0, 0, 0); __builtin_amdgcn_s_setprio(0); } while (0)
#define PG8_WAIT_V(n) asm volatile("s_waitcnt vmcnt(" #n ")" ::: "memory")
#define PG8_WAIT_L(n) asm volatile("s_waitcnt lgkmcnt(" #n ")" ::: "memory")
#define PG8_BAR __builtin_amdgcn_s_barrier()
#define PG8_SCHED __builtin_amdgcn_sched_barrier(0)
    Unit cur, nxt; int ui = 0;
    if (!S.next(0, cur)) return;
    f32x4 acc[2][2][4][2];
#pragma unroll
    for (int a = 0; a < 2; ++a)
#pragma unroll
        for (int b = 0; b < 2; ++b)
#pragma unroll
            for (int m = 0; m < 4; ++m)
#pragma unroll
                for (int n = 0; n < 2; ++n) acc[a][b][m][n] = (f32x4){0.f, 0.f, 0.f, 0.f};
    bf16x8 At[4][2], B0[2][2], B1[2][2];
    const char* cA = (const char*)g.A + (size_t)cur.pm * tstep; const char* cB = (const char*)g.Bt + (size_t)cur.pn * tstep;
    S.a_ready(cur);
    PG8_STAGE(PG8_SB(0, 0), cB, voffB); PG8_STAGE(PG8_SA(0, 0), cA, voffA); PG8_STAGE(PG8_SB(0, 1), cB + hstep, voffB); PG8_STAGE(PG8_SA(0, 1), cA + hstep, voffA);
    if (wr == 1) PG8_BAR;
    PG8_WAIT_V(4); PG8_BAR;
    PG8_STAGE(PG8_SB(1, 0), cB + kstep, voffB); PG8_STAGE(PG8_SA(1, 0), cA + kstep, voffA); PG8_STAGE(PG8_SB(1, 1), cB + hstep + kstep, voffB);
    PG8_WAIT_V(6); PG8_BAR;
    PG8_STAMP();
    for (;;) {
        const bool has_next = S.next(ui + 1, nxt);
        const char* nA = has_next ? (const char*)g.A + (size_t)nxt.pm * tstep : cA; const char* nB = has_next ? (const char*)g.Bt + (size_t)nxt.pn * tstep : cB;
        for (int t = 0; t < nt; t += 2) {
            const bool last = (t == nt - 2);
            const char* a1 = cA + (size_t)(t + 1) * kstep;
            const char* a2 = last ? nA : cA + (size_t)(t + 2) * kstep; const char* b2 = last ? nB : cB + (size_t)(t + 2) * kstep;
            const char* a3 = a2 + kstep; const char* b3 = b2 + kstep;
            if (last && has_next) S.a_ready(nxt);
            PG8_LDB(B0, 0, 0); PG8_SCHED; PG8_LDA(At, 0, 0); PG8_STAGE(PG8_SA(1, 1), a1 + hstep, voffA);
            PG8_WAIT_L(8); PG8_BAR; PG8_WAIT_L(0); PG8_MMA(0, 0, At, B0); PG8_BAR; PG8_SCHED;
            PG8_LDB(B1, 0, 1); PG8_STAGE(PG8_SB(0, 0), b2, voffB);
            PG8_BAR; PG8_WAIT_L(0); PG8_MMA(0, 1, At, B1); PG8_BAR;
            PG8_LDA(At, 0, 1); PG8_STAGE(PG8_SA(0, 0), a2, voffA);
            PG8_BAR; PG8_WAIT_L(0); PG8_MMA(1, 0, At, B0); PG8_BAR; PG8_SCHED;
            PG8_STAGE(PG8_SB(0, 1), b2 + hstep, voffB);
            PG8_WAIT_V(6); PG8_BAR; PG8_MMA(1, 1, At, B1); PG8_BAR;
            PG8_LDB(B0, 1, 0); PG8_SCHED; PG8_LDA(At, 1, 0); PG8_STAGE(PG8_SA(0, 1), a2 + hstep, voffA);
            PG8_WAIT_L(8); PG8_BAR; PG8_WAIT_L(0); PG8_MMA(0, 0, At, B0); PG8_BAR; PG8_SCHED;
            PG8_LDB(B1, 1, 1); PG8_STAGE(PG8_SB(1, 0), b3, voffB);
            PG8_BAR; PG8_WAIT_L(0); PG8_MMA(0, 1, At, B1); PG8_BAR;
            PG8_LDA(At, 1, 1); PG8_STAGE(PG8_SA(1, 0), a3, voffA);
            PG8_BAR; PG8_WAIT_L(0); PG8_MMA(1, 0, At, B0); PG8_BAR; PG8_SCHED;
            PG8_STAGE(PG8_SB(1, 1), b3 + hstep, voffB);
            PG8_WAIT_V(6); PG8_BAR; PG8_MMA(1, 1, At, B1); PG8_BAR;
        }
        PG8_STAMP();
        if constexpr (!Epi::AFTER_DRAIN) { E(acc, cur, wr, wc, fr, fq); S.done(cur); }
        PG8_STAMP();
        if (!has_next) break;
#pragma unroll
        for (int a = 0; a < 2; ++a)
#pragma unroll
            for (int b = 0; b < 2; ++b)
#pragma unroll
                for (int m = 0; m < 4; ++m)
#pragma unroll
                    for (int n = 0; n < 2; ++n) acc[a][b][m][n] = (f32x4){0.f, 0.f, 0.f, 0.f};
        cur = nxt; cA = nA; cB = nB; ++ui;
    }
    PG8_WAIT_V(0);
    if (wr == 0) PG8_BAR;
    PG8_BAR;
    if constexpr (Epi::AFTER_DRAIN) { E.fused(acc, cur, wr, wc, fr, fq, lds, wid, lane); S.done(cur); }
    PG8_STAMP();
    if (STAMP && wid == 0) { stamps[lane] = lane < nts ? (((unsigned long long)(unsigned)ts_hi << 32) | (unsigned)ts_lo) : 0ull;
        if (lane == 62) stamps[62] = rt_entry; if (lane == 63) stamps[63] = (unsigned long long)wall_clock64(); }
#undef PG8_STAMP
#undef PG8_SA
#undef PG8_SB
#undef PG8_STAGE
#undef PG8_LDA
#undef PG8_LDB
#undef PG8_MMA
#undef PG8_WAIT_V
#undef PG8_WAIT_L
#undef PG8_BAR
#undef PG8_SCHED
}
}

struct Params {
    const float *x_in, *c, *rel_bias, *w_mod, *b_mod, *norm1_g, *norm2_g, *w_in, *w_out, *diff_lambda, *subln_g, *conf_dw, *conf_ln_g, *conf_ln_b, *sconv_w,
        *sgu_ln_g, *sgu_ln_b, *sgu_w, *sgu_b, *peer_wq, *peer_keys, *peer_u, *peer_v, *final_g;
    float* out;
    unsigned* bar;
    float* mod;
    float* xb;
    bf16_t* hb;
    bf16_t* pb;
    bf16_t* cat;
    bf16_t* qb;
    bf16_t *WinT, *WoutT, *WqT, *keysb, *sguwb;
    unsigned char *ub8, *vb8;
    float *uinv, *vinv;
    int* eidx; float* egate;
    float lam_init[DEPTH];
};

#define LDS_BYTES (144 * 1024)
#define NWAVES 8

__device__ __forceinline__ void transpose_item(const float* __restrict__ W, int K, int N, bf16_t* __restrict__ WT, LAS float* scr, int item, int lane) {
    const int nblk = N / 32, kb = item / nblk, nb = item % nblk, k0 = 64 * kb, n0 = 32 * nb;
#pragma unroll 8
    for (int i = 0; i < 32; ++i) { const int kk = 2 * i + (lane >> 5); scr[kk * 33 + (lane & 31)] = W[(size_t)(k0 + kk) * N + n0 + (lane & 31)]; }
    asm volatile("s_waitcnt lgkmcnt(0)" ::: "memory");
    const int c = lane & 7;
#pragma unroll
    for (int j = 0; j < 4; ++j) {
        const int n = (lane >> 3) + 8 * j; const LAS float* s = scr + (8 * c) * 33 + n;
        u32x4 o; o.x = pk2(s[0 * 33], s[1 * 33]); o.y = pk2(s[2 * 33], s[3 * 33]); o.z = pk2(s[4 * 33], s[5 * 33]); o.w = pk2(s[6 * 33], s[7 * 33]);
        *(u32x4*)(WT + (size_t)(n0 + n) * K + k0 + 8 * c) = o;
    }
    asm volatile("s_waitcnt lgkmcnt(0)" ::: "memory");
}
__device__ __forceinline__ void cvt8(const float* __restrict__ s, bf16_t* __restrict__ d) {
    const f32x4 a = *(const f32x4*)s, b = *(const f32x4*)(s + 4);
    u32x4 o; o.x = pk2(a[0], a[1]); o.y = pk2(a[2], a[3]); o.z = pk2(b[0], b[1]); o.w = pk2(b[2], b[3]);
    *(u32x4*)d = o;
}
__device__ __forceinline__ void phase_convert(const Params& p, LAS unsigned char* lds) {
    const int tid = tid_opaque(), wave = tid >> 6, lane = tid & 63;
    LAS float* scr = (LAS float*)(lds + wave * 16384);
    const int gw = blockIdx.x * NWAVES + wave, NGW = gridDim.x * NWAVES;
    constexpr int I_IN = (D_MODEL / 64) * (MIX_IN / 32), I_OUT = (D_MODEL / 64) * (D_MODEL / 32), I_Q = (D_MODEL / 64) * (2048 / 32), I_L = I_IN + I_OUT + I_Q;
    for (int it = gw; it < DEPTH * I_L; it += NGW) {
        const int l = it / I_L; int r = it % I_L;
        if (r < I_IN) { transpose_item(p.w_in + (size_t)l * D_MODEL * MIX_IN, D_MODEL, MIX_IN, p.WinT + (size_t)l * MIX_IN * D_MODEL, scr, r, lane); continue; } r -= I_IN;
        if (r < I_OUT) { transpose_item(p.w_out + (size_t)l * D_MODEL * D_MODEL, D_MODEL, D_MODEL, p.WoutT + (size_t)l * D_MODEL * D_MODEL, scr, r, lane); continue; } r -= I_OUT;
        transpose_item(p.peer_wq + (size_t)l * D_MODEL * 2048, D_MODEL, 2048, p.WqT + (size_t)l * 2048 * D_MODEL, scr, r, lane);
    }
    const size_t gt = (size_t)blockIdx.x * 512 + tid, NGT = (size_t)gridDim.x * 512;
    constexpr size_t N_KEYS8 = (size_t)DEPTH * 16 * 128 * 128 / 8, N_TAB8 = (size_t)DEPTH * NEXP * D_MODEL / 8, N_SGU8 = (size_t)DEPTH * 4 * 128 * 128 / 8;
    for (size_t i = gt; i < N_KEYS8; i += NGT) cvt8(p.peer_keys + i * 8, p.keysb + i * 8);
    for (size_t row = gw; row < (size_t)2 * DEPTH * NEXP; row += NGW) {
        const bool isv = row >= (size_t)DEPTH * NEXP; const size_t r = isv ? row - (size_t)DEPTH * NEXP : row;
        const float* src = (isv ? p.peer_v : p.peer_u) + r * D_MODEL + lane * 16;
        f32x4 a[4]; float mx = 0.f;
#pragma unroll
        for (int q = 0; q < 4; ++q) { a[q] = *(const f32x4*)(src + 4 * q); mx = fmaxf(mx, fmaxf(fmaxf(fabsf(a[q][0]), fabsf(a[q][1])), fmaxf(fabsf(a[q][2]), fabsf(a[q][3])))); }
#pragma unroll
        for (int o = 32; o > 0; o >>= 1) mx = fmaxf(mx, __shfl_xor(mx, o, 64));
        mx = fmaxf(mx, 1e-30f);
        const int ex = (int)((__float_as_uint(mx) >> 23) & 0xFF) - 127;
        const float sc = __uint_as_float((unsigned)(127 + 6 - ex) << 23);
        const float isc = __uint_as_float((unsigned)(127 - 6 + ex) << 23);
        u32x4 o;
#pragma unroll
        for (int q = 0; q < 4; ++q) {
            int pk = 0;
            pk = __builtin_amdgcn_cvt_pk_fp8_f32(a[q][0] * sc, a[q][1] * sc, pk, false);
            pk = __builtin_amdgcn_cvt_pk_fp8_f32(a[q][2] * sc, a[q][3] * sc, pk, true);
            o[q] = (unsigned)pk;
        }
        *(u32x4*)((isv ? p.vb8 : p.ub8) + r * D_MODEL + lane * 16) = o;
        if (lane == 0) (isv ? p.vinv : p.uinv)[r] = isc;
    }
    for (size_t i = gt; i < N_SGU8; i += NGT) {
        const size_t e = i * 8; const int s0 = (int)(e & 127), t = (int)((e >> 7) & 127);
        const f32x4 a = *(const f32x4*)(p.sgu_w + e), b = *(const f32x4*)(p.sgu_w + e + 4);
        float v[8] = {a[0], a[1], a[2], a[3], b[0], b[1], b[2], b[3]};
#pragma unroll
        for (int j = 0; j < 8; ++j) v[j] = (s0 + j <= t) ? v[j] : 0.f;
        u32x4 o; o.x = pk2(v[0], v[1]); o.y = pk2(v[2], v[3]); o.z = pk2(v[4], v[5]); o.w = pk2(v[6], v[7]);
        *(u32x4*)(p.sguwb + e) = o;
    }
}

__device__ __forceinline__ void norm_row(const float* __restrict__ xr, const float* __restrict__ g, const float* __restrict__ sh, const float* __restrict__ sc, bf16_t* __restrict__ hr, int lane) {
    f32x4 v[4]; float ss = 0.f;
#pragma unroll
    for (int j = 0; j < 4; ++j) { v[j] = *(const f32x4*)(xr + j * 256 + lane * 4); ss += v[j][0] * v[j][0] + v[j][1] * v[j][1] + v[j][2] * v[j][2] + v[j][3] * v[j][3]; }
    const float rs = rsqrtf(wave_sum(ss) * (1.0f / D_MODEL) + 1e-6f);
#pragma unroll
    for (int j = 0; j < 4; ++j) {
        const int col = j * 256 + lane * 4;
        const f32x4 gv = *(const f32x4*)(g + col), scv = *(const f32x4*)(sc + col), shv = *(const f32x4*)(sh + col);
        f32x4 y;
#pragma unroll
        for (int e = 0; e < 4; ++e) y[e] = v[j][e] * rs * gv[e] * (1.0f + scv[e]) + shv[e];
        u32x2 o; o.x = pk2(y[0], y[1]); o.y = pk2(y[2], y[3]);
        *(u32x2*)(hr + col) = o;
    }
}
__device__ __forceinline__ void phase_norm(const Params& p, const float* __restrict__ x, const float* __restrict__ g, const float* __restrict__ modl, int sh_idx, int sc_idx) {
    const int tid = tid_opaque(), wave = tid >> 6, lane = tid & 63;
    for (int t = blockIdx.x * NWAVES + wave; t < NTOK; t += gridDim.x * NWAVES) {
        const float* mb = modl + (size_t)(t / SEQ) * MODW;
        norm_row(x + (size_t)t * D_MODEL, g, mb + sh_idx * D_MODEL, mb + sc_idx * D_MODEL, p.hb + (size_t)t * D_MODEL, lane);
    }
}

struct EpiStoreBf16 {
    static constexpr bool PERM = true, AFTER_DRAIN = false;
    bf16_t* O; int ldc;
    __device__ __forceinline__ void operator()(const pg8::f32x4 (&acc)[2][2][4][2], const pg8::Unit& u, int wr, int wc, int fr, int fq) const {
        const int row0 = u.pm * 256 + wr * 64 + fr, col0 = u.pn * 256 + wc * 32 + 8 * fq;
#pragma unroll
        for (int ai = 0; ai < 2; ++ai)
#pragma unroll
            for (int m = 0; m < 4; ++m) {
                bf16_t* rowp = O + (size_t)(row0 + ai * 128 + m * 16) * ldc + col0;
#pragma unroll
                for (int bj = 0; bj < 2; ++bj) {
                    const pg8::f32x4 v0 = acc[ai][bj][m][0], v1 = acc[ai][bj][m][1];
                    u32x4 w; w.x = pk2(v0[0], v0[1]); w.y = pk2(v0[2], v0[3]); w.z = pk2(v1[0], v1[1]); w.w = pk2(v1[2], v1[3]);
                    *(u32x4*)(rowp + bj * 128) = w;
                }
            }
    }
};
struct EpiResid {
    static constexpr bool PERM = false, AFTER_DRAIN = false;
    const float* xin; float* xout; const float* gate;
    __device__ __forceinline__ void operator()(const pg8::f32x4 (&acc)[2][2][4][2], const pg8::Unit& u, int wr, int wc, int fr, int fq) const {
        const int row0 = u.pm * 256 + wr * 64 + fr, col0 = u.pn * 256 + wc * 32 + 4 * fq;
        const float* gb = gate + (size_t)((u.pm * 256) / SEQ) * MODW + col0;
        pg8::f32x4 gv[2][2];
#pragma unroll
        for (int bj = 0; bj < 2; ++bj)
#pragma unroll
            for (int n = 0; n < 2; ++n) gv[bj][n] = *(const pg8::f32x4*)(gb + bj * 128 + n * 16);
#pragma unroll
        for (int ai = 0; ai < 2; ++ai)
#pragma unroll
            for (int m = 0; m < 4; ++m) {
                const size_t off = (size_t)(row0 + ai * 128 + m * 16) * D_MODEL + col0;
#pragma unroll
                for (int bj = 0; bj < 2; ++bj)
#pragma unroll
                    for (int n = 0; n < 2; ++n) {
                        const pg8::f32x4 xv = *(const pg8::f32x4*)(xin + off + bj * 128 + n * 16);
                        *(pg8::f32x4*)(xout + off + bj * 128 + n * 16) = xv + gv[bj][n] * acc[ai][bj][m][n];
                    }
            }
    }
};

template <class Epi>
__device__ __forceinline__ void run_gemm(LAS unsigned char* lds, const bf16_t* A, const bf16_t* Bt, int M, int N, int K, const Epi& E) {
    pg8::StaticOrder S; S.init(M, N, (int)gridDim.x, (int)blockIdx.x);
    pg8::Gemm g; g.A = A; g.Bt = Bt; g.M = M; g.N = N; g.K = K;
    pg8::gemm_phase<Epi, pg8::StaticOrder, false>(lds, g, S, E, nullptr);
}

typedef __bf16 bf16x2_t __attribute__((ext_vector_type(2)));
__device__ __forceinline__ float dot2bf(unsigned a, unsigned b, float c) { return __builtin_amdgcn_fdot2_f32_bf16(__builtin_bit_cast(bf16x2_t, a), __builtin_bit_cast(bf16x2_t, b), c, false); }

typedef float f32x2 __attribute__((ext_vector_type(2)));
typedef __amdgpu_buffer_rsrc_t rsrc_t;
struct ERows { u32x4 u[4]; u32x4 v[4]; float ui[4]; float vi[4]; };

__device__ __forceinline__ u32x4 bload16(rsrc_t r, int voff, int soff) { return __builtin_bit_cast(u32x4, __builtin_amdgcn_raw_buffer_load_b128(r, voff, soff, 0)); }
__device__ __forceinline__ void ex_load(ERows& R, rsrc_t ru, rsrc_t rv, const float* __restrict__ uinv, const float* __restrict__ vinv, int e0, int e1, int g, int voff) {
    const int ev = (g < 16) ? e0 : e1;
#pragma unroll
    for (int i = 0; i < 4; ++i) {
        const int e = __builtin_amdgcn_readlane(ev, (4 * g + i) & 63);
        R.u[i] = bload16(ru, voff, e * D_MODEL);
        R.v[i] = bload16(rv, voff, e * D_MODEL);
        R.ui[i] = uinv[e]; R.vi[i] = vinv[e];
    }
}
__device__ __forceinline__ void ex_compute(const ERows& R, const float (&hf)[16], float (&y)[16], float g0, float g1, int g, int lane) {
    float d[4];
#pragma unroll
    for (int i = 0; i < 4; ++i) {
        f32x2 s = {0.f, 0.f};
#pragma unroll
        for (int j = 0; j < 4; ++j) {
            const f32x2 lo = __builtin_amdgcn_cvt_pk_f32_fp8((int)R.u[i][j], false), hi = __builtin_amdgcn_cvt_pk_f32_fp8((int)R.u[i][j], true);
            s = __builtin_elementwise_fma(lo, (f32x2){hf[4 * j], hf[4 * j + 1]}, s);
            s = __builtin_elementwise_fma(hi, (f32x2){hf[4 * j + 2], hf[4 * j + 3]}, s);
        }
        d[i] = (s.x + s.y) * R.ui[i];
    }
    const bool hi = (lane & 32) != 0, hi2 = (lane & 16) != 0;
    float k0 = hi ? d[2] : d[0], k1 = hi ? d[3] : d[1];
    const float s0 = hi ? d[0] : d[2], s1 = hi ? d[1] : d[3];
    k0 += __shfl_xor(s0, 32, 64); k1 += __shfl_xor(s1, 32, 64);
    float kk = hi2 ? k1 : k0; const float sn = hi2 ? k0 : k1;
    kk += __shfl_xor(sn, 16, 64);
    kk += __shfl_xor(kk, 8, 64); kk += __shfl_xor(kk, 4, 64); kk += __shfl_xor(kk, 2, 64); kk += __shfl_xor(kk, 1, 64);
    const float gsel = (g < 16) ? g0 : g1;
    const float gk = __shfl(gsel, (4 * g + (lane >> 4)) & 63, 64);
    const float coef = gk * gelu_exact(kk);
#pragma unroll
    for (int i = 0; i < 4; ++i) {
        const float c = __int_as_float(__builtin_amdgcn_readlane(__float_as_int(coef), 16 * i)) * R.vi[i];
        const f32x2 cc = {c, c};
#pragma unroll
        for (int j = 0; j < 4; ++j) {
            const f32x2 lo = __builtin_amdgcn_cvt_pk_f32_fp8((int)R.v[i][j], false), hi2v = __builtin_amdgcn_cvt_pk_f32_fp8((int)R.v[i][j], true);
            f32x2 a = {y[4 * j], y[4 * j + 1]}, b = {y[4 * j + 2], y[4 * j + 3]};
            a = __builtin_elementwise_fma(cc, lo, a); b = __builtin_elementwise_fma(cc, hi2v, b);
            y[4 * j] = a.x; y[4 * j + 1] = a.y; y[4 * j + 2] = b.x; y[4 * j + 3] = b.y;
        }
    }
}

__device__ __forceinline__ void phase_expert(const Params& p, int l, const bool LAST) {
    const int tid = tid_opaque(), wave = tid >> 6, lane = tid & 63;
    const rsrc_t ru = __builtin_amdgcn_make_buffer_rsrc((void*)(p.ub8 + (size_t)l * NEXP * D_MODEL), 0, NEXP * D_MODEL, 0x00020000);
    const rsrc_t rv = __builtin_amdgcn_make_buffer_rsrc((void*)(p.vb8 + (size_t)l * NEXP * D_MODEL), 0, NEXP * D_MODEL, 0x00020000);
    const float* uinv = p.uinv + (size_t)l * NEXP;
    const float* vinv = p.vinv + (size_t)l * NEXP;
    const int voff = lane * 16, c0 = lane * 16;
    const float* n2g = p.norm2_g + l * D_MODEL;
    for (int t = blockIdx.x * NWAVES + wave; t < NTOK; t += gridDim.x * NWAVES) {
        const float* mb = p.mod + ((size_t)l * BATCH + t / SEQ) * MODW;
        float xv[16];
#pragma unroll
        for (int q = 0; q < 4; ++q) { const f32x4 a = *(const f32x4*)(p.xb + (size_t)t * D_MODEL + c0 + 4 * q); xv[4 * q] = a[0]; xv[4 * q + 1] = a[1]; xv[4 * q + 2] = a[2]; xv[4 * q + 3] = a[3]; }
        float ss = 0.f;
#pragma unroll
        for (int e = 0; e < 16; ++e) ss += xv[e] * xv[e];
        const float rs = rsqrtf(wave_sum(ss) * (1.0f / D_MODEL) + 1e-6f);
        float hf[16];
#pragma unroll
        for (int q = 0; q < 4; ++q) {
            const int col = c0 + 4 * q;
            const f32x4 gv = *(const f32x4*)(n2g + col), scv = *(const f32x4*)(mb + 4 * D_MODEL + col), shv = *(const f32x4*)(mb + 3 * D_MODEL + col);
#pragma unroll
            for (int e = 0; e < 4; ++e) hf[4 * q + e] = xv[4 * q + e] * rs * gv[e] * (1.0f + scv[e]) + shv[e];
        }
        const int e0 = p.eidx[(size_t)t * 128 + lane], e1 = p.eidx[(size_t)t * 128 + 64 + lane];
        const float g0 = p.egate[(size_t)t * 128 + lane], g1 = p.egate[(size_t)t * 128 + 64 + lane];
        float y[16];
#pragma unroll
        for (int e = 0; e < 16; ++e) y[e] = 0.f;
        ERows RA, RB;
        ex_load(RA, ru, rv, uinv, vinv, e0, e1, 0, voff);
        for (int g = 0; g < 32; g += 2) {
            ex_load(RB, ru, rv, uinv, vinv, e0, e1, g + 1, voff);
            ex_compute(RA, hf, y, g0, g1, g, lane);
            if (g + 2 < 32) ex_load(RA, ru, rv, uinv, vinv, e0, e1, g + 2, voff);
            ex_compute(RB, hf, y, g0, g1, g + 1, lane);
        }
#pragma unroll
        for (int q = 0; q < 4; ++q) {
            const f32x4 g2 = *(const f32x4*)(mb + 5 * D_MODEL + c0 + 4 * q);
#pragma unroll
            for (int e = 0; e < 4; ++e) xv[4 * q + e] += g2[e] * y[4 * q + e];
        }
        float ss2 = 0.f;
#pragma unroll
        for (int e = 0; e < 16; ++e) ss2 += xv[e] * xv[e];
        const float rs2 = rsqrtf(wave_sum(ss2) * (1.0f / D_MODEL) + 1e-6f);
        if (LAST) {
#pragma unroll
            for (int q = 0; q < 4; ++q) {
                const int col = c0 + 4 * q;
                const f32x4 gv = *(const f32x4*)(p.final_g + col);
                f32x4 o;
#pragma unroll
                for (int e = 0; e < 4; ++e) o[e] = xv[4 * q + e] * rs2 * gv[e];
                *(f32x4*)(p.out + (size_t)t * D_MODEL + col) = o;
            }
        } else {
            const float* mn = p.mod + ((size_t)(l + 1) * BATCH + t / SEQ) * MODW;
            const float* n1g = p.norm1_g + (l + 1) * D_MODEL;
            unsigned hw[8];
#pragma unroll
            for (int q = 0; q < 4; ++q) {
                const int col = c0 + 4 * q;
                f32x4 xo;
#pragma unroll
                for (int e = 0; e < 4; ++e) xo[e] = xv[4 * q + e];
                *(f32x4*)(p.xb + (size_t)t * D_MODEL + col) = xo;
                const f32x4 gv = *(const f32x4*)(n1g + col), scv = *(const f32x4*)(mn + 1 * D_MODEL + col), shv = *(const f32x4*)(mn + 0 * D_MODEL + col);
                float h[4];
#pragma unroll
                for (int e = 0; e < 4; ++e) h[e] = xo[e] * rs2 * gv[e] * (1.0f + scv[e]) + shv[e];
                hw[2 * q] = pk2(h[0], h[1]); hw[2 * q + 1] = pk2(h[2], h[3]);
            }
            *(u32x4*)(p.hb + (size_t)t * D_MODEL + c0) = (u32x4){hw[0], hw[1], hw[2], hw[3]};
            *(u32x4*)(p.hb + (size_t)t * D_MODEL + c0 + 8) = (u32x4){hw[4], hw[5], hw[6], hw[7]};
        }
    }
}
__global__ void __launch_bounds__(512, 2) k_expert(Params p, int l) { phase_expert(p, l, l == DEPTH - 1); }
typedef short s16x4 __attribute__((ext_vector_type(4)));
#define AT_KSTR 144
#define AT_VSTR 192
#define AT_KBUF 0
#define AT_VBUF 18432
#define AT_TBL  43008
#define AT_OEX  44032
#define AT_OSTR 272

__device__ __forceinline__ void phase_attn(const Params& p, int l, LAS unsigned char* lds) {
    const int tid = tid_opaque(), wave = tid >> 6, lane = tid & 63;
    const int w4 = wave & 3, m = wave >> 2, c = lane & 31, h = lane >> 5;
    const float LOG2E = 1.4426950408889634f;
    const float qscale = 0.17677669529663687f * LOG2E;
    float d01 = 0.f, d23 = 0.f;
    { const float* lp = p.diff_lambda + l * 128;
      for (int i = 0; i < 32; ++i) { d01 += lp[i] * lp[32 + i]; d23 += lp[64 + i] * lp[96 + i]; } }
    const float lam_init = p.lam_init[l];
    const float lam = expf(d01) - expf(d23) + lam_init;
    const float osc = 1.0f - lam_init;
    LAS float* tbl = (LAS float*)(lds + AT_TBL);
    const int skey = tid >> 3, sch = tid & 7;
    const int g16 = lane >> 4, li = lane & 15, tq = li >> 2, tp = li & 3;

    for (int u = blockIdx.x; u < 256; u += gridDim.x) {
        const int pi = u & 7, hd = (u >> 3) & 3, b = u >> 5;
        if (tid < 256) { const int bk = tid < 128 ? (int)kBucket[tid] : 31; tbl[tid] = p.rel_bias[bk * 4 + hd] * LOG2E; }
        const float c31 = p.rel_bias[31 * 4 + hd] * LOG2E;
        const bf16_t* pbase = p.pb + (size_t)b * SEQ * MIX_IN;
        const bf16_t* kg = pbase + (size_t)skey * MIX_IN + 256 + hd * 64 + sch * 8;
        const bf16_t* vg = pbase + (size_t)skey * MIX_IN + 512 + hd * 64 + sch * 8;
        for (int half = 0; half < 2; ++half) {
            const int qb = half ? 15 - pi : pi;
            const int q0w = qb * 128 + 32 * w4, nkt = 2 * qb + 2;
            const int qpos = q0w + c;
            bf16x8 qf0, qf1;
            { const bf16_t* qp = pbase + (size_t)qpos * MIX_IN + hd * 64 + m * 32 + 8 * h; qf0 = *(const bf16x8*)qp; qf1 = *(const bf16x8*)(qp + 16); }
            f32x16 O0, O1;
#pragma unroll
            for (int r = 0; r < 16; ++r) { O0[r] = 0.f; O1[r] = 0.f; }
            float mrun = -1e30f, lrun = 0.f;
            u32x4 kreg = *(const u32x4*)kg, vreg = *(const u32x4*)vg;
            *(LAS u32x4*)(lds + AT_KBUF + skey * AT_KSTR + sch * 16) = kreg;
            *(LAS u32x4*)(lds + AT_VBUF + skey * AT_VSTR + sch * 16) = vreg;
            __syncthreads();
            for (int kt = 0; kt < nkt; ++kt) {
                const int k0 = kt * 64, cur = kt & 1;
                if (kt + 1 < nkt) { kreg = *(const u32x4*)(kg + (size_t)(k0 + 64) * MIX_IN); vreg = *(const u32x4*)(vg + (size_t)(k0 + 64) * MIX_IN); }
                if (k0 <= q0w + 31) {
                    LAS unsigned char* kb_ = lds + AT_KBUF + cur * (64 * AT_KSTR);
                    LAS unsigned char* vb_ = lds + AT_VBUF + cur * (64 * AT_VSTR);
                    f32x16 s0, s1;
#pragma unroll
                    for (int r = 0; r < 16; ++r) { s0[r] = 0.f; s1[r] = 0.f; }
                    {
                        const LAS unsigned char* ka = kb_ + c * AT_KSTR + m * 64 + h * 16;
                        const bf16x8 a00 = *(const LAS bf16x8*)ka, a01 = *(const LAS bf16x8*)(ka + 32);
                        const bf16x8 a10 = *(const LAS bf16x8*)(ka + 32 * AT_KSTR), a11 = *(const LAS bf16x8*)(ka + 32 * AT_KSTR + 32);
                        s0 = __builtin_amdgcn_mfma_f32_32x32x16_bf16(a00, qf0, s0, 0, 0, 0);
                        s0 = __builtin_amdgcn_mfma_f32_32x32x16_bf16(a01, qf1, s0, 0, 0, 0);
                        s1 = __builtin_amdgcn_mfma_f32_32x32x16_bf16(a10, qf0, s1, 0, 0, 0);
                        s1 = __builtin_amdgcn_mfma_f32_32x32x16_bf16(a11, qf1, s1, 0, 0, 0);
                    }
                    const bool far = (q0w - (k0 + 63)) >= 113;
                    if (far) {
#pragma unroll
                        for (int r = 0; r < 16; ++r) { s0[r] = s0[r] * qscale + c31; s1[r] = s1[r] * qscale + c31; }
                    } else {
                        const int dbase = qpos - k0 - 4 * h;
#pragma unroll
                        for (int r = 0; r < 16; ++r) {
                            const int d0 = dbase - ((r & 3) + 8 * (r >> 2)), d1 = d0 - 32;
                            const float b0 = tbl[min(max(d0, 0), 255)], b1 = tbl[min(max(d1, 0), 255)];
                            const float v0 = s0[r] * qscale + b0, v1 = s1[r] * qscale + b1;
                            s0[r] = d0 < 0 ? -1e30f : v0; s1[r] = d1 < 0 ? -1e30f : v1;
                        }
                    }
                    float tmax = fmaxf(s0[0], s1[0]);
#pragma unroll
                    for (int r = 1; r < 16; ++r) tmax = fmaxf(tmax, fmaxf(s0[r], s1[r]));
                    tmax = fmaxf(tmax, __shfl_xor(tmax, 32, 64));
                    const float mnew = fmaxf(mrun, tmax);
                    const float alpha = __builtin_amdgcn_exp2f(mrun - mnew);
                    mrun = mnew;
                    float psum = 0.f;
#pragma unroll
                    for (int r = 0; r < 16; ++r) { s0[r] = __builtin_amdgcn_exp2f(s0[r] - mnew); s1[r] = __builtin_amdgcn_exp2f(s1[r] - mnew); psum += s0[r] + s1[r]; }
                    lrun = lrun * alpha + psum;
#pragma unroll
                    for (int r = 0; r < 16; ++r) { O0[r] *= alpha; O1[r] *= alpha; }
#pragma unroll
                    for (int kb = 0; kb < 2; ++kb)
#pragma unroll
                        for (int sp = 0; sp < 2; ++sp) {
                            u32x4 pw;
                            if (kb == 0) { pw.x = pk2(s0[8 * sp + 0], s0[8 * sp + 1]); pw.y = pk2(s0[8 * sp + 2], s0[8 * sp + 3]); pw.z = pk2(s0[8 * sp + 4], s0[8 * sp + 5]); pw.w = pk2(s0[8 * sp + 6], s0[8 * sp + 7]); }
                            else         { pw.x = pk2(s1[8 * sp + 0], s1[8 * sp + 1]); pw.y = pk2(s1[8 * sp + 2], s1[8 * sp + 3]); pw.z = pk2(s1[8 * sp + 4], s1[8 * sp + 5]); pw.w = pk2(s1[8 * sp + 6], s1[8 * sp + 7]); }
                            const bf16x8 pf = __builtin_bit_cast(bf16x8, pw);
                            const int kA = 32 * kb + 16 * sp + 4 * h;
#pragma unroll
                            for (int mb = 0; mb < 2; ++mb) {
                                LAS unsigned char* va = vb_ + (kA + tq) * AT_VSTR + (32 * mb + 16 * (g16 & 1) + 4 * tp) * 2;
                                const s16x4 t0 = __builtin_amdgcn_ds_read_tr16_b64_v4i16((LAS s16x4*)va);
                                const s16x4 t1 = __builtin_amdgcn_ds_read_tr16_b64_v4i16((LAS s16x4*)(va + 8 * AT_VSTR));
                                const bf16x8 vf = {t0[0], t0[1], t0[2], t0[3], t1[0], t1[1], t1[2], t1[3]};
                                if (mb == 0) O0 = __builtin_amdgcn_mfma_f32_32x32x16_bf16(vf, pf, O0, 0, 0, 0);
                                else         O1 = __builtin_amdgcn_mfma_f32_32x32x16_bf16(vf, pf, O1, 0, 0, 0);
                            }
                        }
                }
                if (kt + 1 < nkt) {
                    *(LAS u32x4*)(lds + AT_KBUF + (cur ^ 1) * (64 * AT_KSTR) + skey * AT_KSTR + sch * 16) = kreg;
                    *(LAS u32x4*)(lds + AT_VBUF + (cur ^ 1) * (64 * AT_VSTR) + skey * AT_VSTR + sch * 16) = vreg;
                }
                __syncthreads();
            }
            const float inv = 1.0f / (lrun + __shfl_xor(lrun, 32, 64));
            LAS unsigned char* oex = lds + AT_OEX + (32 * w4 + c) * AT_OSTR + 16 * h;
            if (m == 1) {
#pragma unroll
                for (int r4 = 0; r4 < 4; ++r4) {
                    f32x4 a, bq;
#pragma unroll
                    for (int e = 0; e < 4; ++e) { a[e] = O0[4 * r4 + e] * inv; bq[e] = O1[4 * r4 + e] * inv; }
                    *(LAS f32x4*)(oex + (8 * r4) * 4) = a;
                    *(LAS f32x4*)(oex + (32 + 8 * r4) * 4) = bq;
                }
            }
            __syncthreads();
            if (m == 0) {
                float ss = 0.f;
#pragma unroll
                for (int r4 = 0; r4 < 4; ++r4) {
                    const f32x4 a = *(const LAS f32x4*)(oex + (8 * r4) * 4), bq = *(const LAS f32x4*)(oex + (32 + 8 * r4) * 4);
#pragma unroll
                    for (int e = 0; e < 4; ++e) {
                        O0[4 * r4 + e] = O0[4 * r4 + e] * inv - lam * a[e]; O1[4 * r4 + e] = O1[4 * r4 + e] * inv - lam * bq[e];
                        ss += O0[4 * r4 + e] * O0[4 * r4 + e] + O1[4 * r4 + e] * O1[4 * r4 + e];
                    }
                }
                ss += __shfl_xor(ss, 32, 64);
                const float rstd = rsqrtf(ss * (1.0f / 64.0f) + 1e-6f) * osc;
                bf16_t* orow = p.cat + (size_t)(b * SEQ + qpos) * D_MODEL + hd * 64 + 4 * h;
                const float* sg = p.subln_g + l * 64 + 4 * h;
#pragma unroll
                for (int r4 = 0; r4 < 4; ++r4) {
                    const f32x4 ga = *(const f32x4*)(sg + 8 * r4), gb = *(const f32x4*)(sg + 32 + 8 * r4);
                    u32x2 oa, ob;
                    oa.x = pk2(O0[4 * r4 + 0] * rstd * ga[0], O0[4 * r4 + 1] * rstd * ga[1]); oa.y = pk2(O0[4 * r4 + 2] * rstd * ga[2], O0[4 * r4 + 3] * rstd * ga[3]);
                    ob.x = pk2(O1[4 * r4 + 0] * rstd * gb[0], O1[4 * r4 + 1] * rstd * gb[1]); ob.y = pk2(O1[4 * r4 + 2] * rstd * gb[2], O1[4 * r4 + 3] * rstd * gb[3]);
                    *(u32x2*)(orow + 8 * r4) = oa;
                    *(u32x2*)(orow + 32 + 8 * r4) = ob;
                }
            }
            __syncthreads();
        }
    }
}
template <int DUMMY>
__global__ void __launch_bounds__(512, 2) k_attn2(Params p, int l) {
    extern __shared__ __attribute__((aligned(16))) unsigned char smem_raw[];
    phase_attn(p, l, (LAS unsigned char*)smem_raw);
}
#define MR_VSTR 272

__device__ __forceinline__ void mixrest_conv(const Params& p, int l, int chunk, LAS unsigned char* lds) {
    const int tid = tid_opaque(), wave = tid >> 6, lane = tid & 63;
    const int t0 = chunk * 128, s0 = t0 % SEQ;
    LAS float* glu = (LAS float*)lds;
    const int c = tid & 255, th = tid >> 8;
    float w[31];
#pragma unroll
    for (int j = 0; j < 31; ++j) w[j] = p.conf_dw[((size_t)l * 31 + j) * 256 + c];
    for (int hf = 0; hf < 2; ++hf) {
        const int tb = t0 + hf * 64;
        for (int it = tid; it < 94 * 32; it += 512) {
            const int i = it >> 5, c8 = (it & 31) * 8;
            const int sp = s0 + hf * 64 - 30 + i;
            f32x4 o0 = {0.f, 0.f, 0.f, 0.f}, o1 = {0.f, 0.f, 0.f, 0.f};
            if (sp >= 0) {
                const bf16_t* pr = p.pb + (size_t)(tb - 30 + i) * MIX_IN;
                const u32x4 a = *(const u32x4*)(pr + 3 * 256 + c8), g = *(const u32x4*)(pr + 4 * 256 + c8);
                o0[0] = bflo(a.x) * sigmoidf_(bflo(g.x)); o0[1] = bfhi(a.x) * sigmoidf_(bfhi(g.x));
                o0[2] = bflo(a.y) * sigmoidf_(bflo(g.y)); o0[3] = bfhi(a.y) * sigmoidf_(bfhi(g.y));
                o1[0] = bflo(a.z) * sigmoidf_(bflo(g.z)); o1[1] = bfhi(a.z) * sigmoidf_(bfhi(g.z));
                o1[2] = bflo(a.w) * sigmoidf_(bflo(g.w)); o1[3] = bfhi(a.w) * sigmoidf_(bfhi(g.w));
            }
            *(LAS f32x4*)(glu + i * 256 + c8) = o0; *(LAS f32x4*)(glu + i * 256 + c8 + 4) = o1;
        }
        __syncthreads();
        float acc[32];
#pragma unroll
        for (int o = 0; o < 32; ++o) acc[o] = 0.f;
#pragma unroll
        for (int i = 0; i < 62; ++i) {
            const float xval = glu[(th * 32 + i) * 256 + c];
#pragma unroll
            for (int o = 0; o < 32; ++o) if (i - o >= 0 && i - o <= 30) acc[o] += w[i - o] * xval;
        }
        __syncthreads();
#pragma unroll
        for (int o = 0; o < 32; ++o) glu[(th * 32 + o) * 256 + c] = acc[o];
        __syncthreads();
        const f32x4 lg = *(const f32x4*)(p.conf_ln_g + l * 256 + lane * 4), lb = *(const f32x4*)(p.conf_ln_b + l * 256 + lane * 4);
        for (int k = 0; k < 8; ++k) {
            const int tk = wave * 8 + k;
            const f32x4 z = *(const LAS f32x4*)(glu + tk * 256 + lane * 4);
            const float mu = wave_sum(z[0] + z[1] + z[2] + z[3]) * (1.0f / 256.0f);
            f32x4 dz; float sq = 0.f;
#pragma unroll
            for (int e = 0; e < 4; ++e) { dz[e] = z[e] - mu; sq += dz[e] * dz[e]; }
            const float rstd = rsqrtf(wave_sum(sq) * (1.0f / 256.0f) + 1e-6f);
            float y[4];
#pragma unroll
            for (int e = 0; e < 4; ++e) { const float v = dz[e] * rstd * lg[e] + lb[e]; y[e] = v * sigmoidf_(v); }
            u32x2 o; o.x = pk2(y[0], y[1]); o.y = pk2(y[2], y[3]);
            *(u32x2*)(p.cat + (size_t)(tb + tk) * D_MODEL + 256 + lane * 4) = o;
        }
        __syncthreads();
    }
}

__device__ __forceinline__ void mixrest_sgu(const Params& p, int l, int chunk, LAS unsigned char* lds) {
    const int tid = tid_opaque(), wave = tid >> 6, lane = tid & 63;
    const int t0 = chunk * 128, s0 = t0 % SEQ;
    {
        const float* sw = p.sconv_w + (size_t)l * 3 * 256;
        for (int it = tid; it < 128 * 32; it += 512) {
            const int tt = it >> 5, c8 = (it & 31) * 8;
            const bf16_t* pr = p.pb + (size_t)(t0 + tt) * MIX_IN;
            float z[8];
#pragma unroll
            for (int e = 0; e < 8; ++e) z[e] = 0.f;
#pragma unroll
            for (int j = 0; j < 3; ++j) {
                if (s0 + tt - 2 + j >= 0) {
                    const bf16_t* q = pr + (ptrdiff_t)(j - 2) * MIX_IN;
                    const u32x4 a = *(const u32x4*)(q + 6 * 256 + c8), bq = *(const u32x4*)(q + 7 * 256 + c8);
                    const f32x4 w0 = *(const f32x4*)(sw + j * 256 + c8), w1 = *(const f32x4*)(sw + j * 256 + c8 + 4);
                    z[0] += w0[0] * bflo(a.x) * bflo(bq.x); z[1] += w0[1] * bfhi(a.x) * bfhi(bq.x);
                    z[2] += w0[2] * bflo(a.y) * bflo(bq.y); z[3] += w0[3] * bfhi(a.y) * bfhi(bq.y);
                    z[4] += w1[0] * bflo(a.z) * bflo(bq.z); z[5] += w1[1] * bfhi(a.z) * bfhi(bq.z);
                    z[6] += w1[2] * bflo(a.w) * bflo(bq.w); z[7] += w1[3] * bfhi(a.w) * bfhi(bq.w);
                }
            }
            const u32x4 cb = *(const u32x4*)(pr + 5 * 256 + c8);
            u32x4 o;
            o.x = pk2(bflo(cb.x) * z[0], bfhi(cb.x) * z[1]); o.y = pk2(bflo(cb.y) * z[2], bfhi(cb.y) * z[3]);
            o.z = pk2(bflo(cb.z) * z[4], bfhi(cb.z) * z[5]); o.w = pk2(bflo(cb.w) * z[6], bfhi(cb.w) * z[7]);
            *(u32x4*)(p.cat + (size_t)(t0 + tt) * D_MODEL + 512 + c8) = o;
        }
    }
    {
        const f32x4 lg = *(const f32x4*)(p.sgu_ln_g + l * 256 + lane * 4), lb = *(const f32x4*)(p.sgu_ln_b + l * 256 + lane * 4);
        for (int k = 0; k < 16; ++k) {
            const int s = wave * 16 + k;
            const u32x2 raw = *(const u32x2*)(p.pb + (size_t)(t0 + s) * MIX_IN + 9 * 256 + lane * 4);
            float v[4] = {gelu_exact(bflo(raw.x)), gelu_exact(bfhi(raw.x)), gelu_exact(bflo(raw.y)), gelu_exact(bfhi(raw.y))};
            const float mu = wave_sum(v[0] + v[1] + v[2] + v[3]) * (1.0f / 256.0f);
            float sq = 0.f;
#pragma unroll
            for (int e = 0; e < 4; ++e) { v[e] -= mu; sq += v[e] * v[e]; }
            const float rstd = rsqrtf(wave_sum(sq) * (1.0f / 256.0f) + 1e-6f);
#pragma unroll
            for (int e = 0; e < 4; ++e) *(LAS bf16_t*)(lds + (lane * 4 + e) * MR_VSTR + s * 2) = f2bf(v[e] * rstd * lg[e] + lb[e]);
        }
    }
    __syncthreads();
    {
        const int hq = wave & 3, mb = wave >> 2, c = lane & 31, hh = lane >> 5;
        bf16x8 af[8];
#pragma unroll
        for (int ks = 0; ks < 8; ++ks) af[ks] = *(const LAS bf16x8*)(lds + (hq * 64 + mb * 32 + c) * MR_VSTR + (16 * ks + 8 * hh) * 2);
        const bf16_t* wb = p.sguwb + ((size_t)(l * 4 + hq) * 128) * 128;
        f32x16 acc[4];
#pragma unroll
        for (int nb = 0; nb < 4; ++nb) {
#pragma unroll
            for (int r = 0; r < 16; ++r) acc[nb][r] = 0.f;
#pragma unroll
            for (int ks = 0; ks < 2 * nb + 2; ++ks) {
                const bf16x8 bfrag = *(const bf16x8*)(wb + (size_t)(32 * nb + c) * 128 + 16 * ks + 8 * hh);
                acc[nb] = __builtin_amdgcn_mfma_f32_32x32x16_bf16(af[ks], bfrag, acc[nb], 0, 0, 0);
            }
        }
        const float* bs = p.sgu_b + (size_t)(l * 4 + hq) * 128;
#pragma unroll
        for (int nb = 0; nb < 4; ++nb) {
            const int tt = 32 * nb + c;
            const float bias = bs[tt];
            const bf16_t* su = p.pb + (size_t)(t0 + tt) * MIX_IN + 8 * 256 + hq * 64 + mb * 32 + 4 * hh;
            bf16_t* orow = p.cat + (size_t)(t0 + tt) * D_MODEL + 768 + hq * 64 + mb * 32 + 4 * hh;
#pragma unroll
            for (int r4 = 0; r4 < 4; ++r4) {
                const u32x2 raw = *(const u32x2*)(su + 8 * r4);
                u32x2 o;
                o.x = pk2(gelu_exact(bflo(raw.x)) * (acc[nb][4 * r4 + 0] + bias), gelu_exact(bfhi(raw.x)) * (acc[nb][4 * r4 + 1] + bias));
                o.y = pk2(gelu_exact(bflo(raw.y)) * (acc[nb][4 * r4 + 2] + bias), gelu_exact(bfhi(raw.y)) * (acc[nb][4 * r4 + 3] + bias));
                *(u32x2*)(orow + 8 * r4) = o;
            }
        }
    }
    __syncthreads();
}

__device__ __forceinline__ void phase_mixrest(const Params& p, int l, LAS unsigned char* lds) {
    for (int u = blockIdx.x; u < 256; u += gridDim.x) {
        const int chunk = u >> 1;
        if (u & 1) mixrest_sgu(p, l, chunk, lds); else mixrest_conv(p, l, chunk, lds);
    }
}
template <int DUMMY>
__global__ void __launch_bounds__(512, 2) k_mixrest(Params p, int l) {
    extern __shared__ __attribute__((aligned(16))) unsigned char smem_raw[];
    phase_mixrest(p, l, (LAS unsigned char*)smem_raw);
}
__device__ __forceinline__ int f2sortable(float f) { const int x = __float_as_int(f); return x ^ ((x >> 31) & 0x7FFFFFFF); }
__device__ __forceinline__ float sortable2f(int s) { return __int_as_float(s ^ ((s >> 31) & 0x7FFFFFFF)); }

template <int N>
__device__ __forceinline__ void bitonic_sort_desc(int (&a)[N]) {
#pragma unroll
    for (int k = 2; k <= N; k <<= 1)
#pragma unroll
        for (int j = k >> 1; j > 0; j >>= 1)
#pragma unroll
            for (int i = 0; i < N; ++i) {
                const int q = i ^ j;
                if (q > i) {
                    const int hi = max(a[i], a[q]), lo = min(a[i], a[q]);
                    if ((i & k) == 0 || k == N) { a[i] = hi; a[q] = lo; } else { a[i] = lo; a[q] = hi; }
                }
            }
}
__device__ __forceinline__ void bitonic_merge_desc16(int (&a)[16]) {
#pragma unroll
    for (int j = 8; j > 0; j >>= 1)
#pragma unroll
        for (int i = 0; i < 16; ++i) {
            const int q = i ^ j;
            if (q > i) { const int hi = max(a[i], a[q]), lo = min(a[i], a[q]); a[i] = hi; a[q] = lo; }
        }
}
__device__ __forceinline__ void merge_top16(int (&a)[16], const int (&b)[16]) {
#pragma unroll
    for (int i = 0; i < 16; ++i) a[i] = max(a[i], b[15 - i]);
    bitonic_merge_desc16(a);
}

__device__ __forceinline__ void phase_topk(const Params& p, int l, LAS unsigned char* lds) {
    const int tid = tid_opaque(), wave = __builtin_amdgcn_readfirstlane(tid >> 6), lane = tid & 63, c = lane & 31, hh = lane >> 5;
    const int hd = wave;
    LAS unsigned char* ilist = lds + wave * 1024 + c * 32;
    const int hx = hh << 2;
    const __amdgpu_buffer_rsrc_t rq = __builtin_amdgcn_make_buffer_rsrc((void*)p.qb, 0, NTOK * 2048 * 2, 0x00020000);
    const __amdgpu_buffer_rsrc_t rk = __builtin_amdgcn_make_buffer_rsrc((void*)(p.keysb + (size_t)l * 16 * 128 * 128), 0, 16 * 128 * 128 * 2, 0x00020000);
    const int qvoff = c * 4096 + hh * 16, kvoff = c * 256 + hh * 16;
    for (int u = blockIdx.x; u < NTOK / 32; u += gridDim.x) {
        const int t = u * 32 + c;
        int S0[16], S1[16];
#pragma unroll
        for (int pp = 0; pp < 2; ++pp) {
            bf16x8 qf[8];
            {
                const int qso = (u * 32) * 4096 + hd * 512 + pp * 256;
#pragma unroll
                for (int ks = 0; ks < 8; ++ks) qf[ks] = __builtin_bit_cast(bf16x8, __builtin_amdgcn_raw_buffer_load_b128(rq, qvoff + 32 * ks, qso, 0));
            }
            const int kso = ((hd * 2 + pp) * 128) * 256;
            int K0[16], K1[16], K2[16], K3[16];
#pragma unroll
            for (int kb = 0; kb < 4; ++kb) {
                asm volatile("" ::: "memory");
                f32x16 acc;
#pragma unroll
                for (int r = 0; r < 16; ++r) acc[r] = 0.f;
#pragma unroll
                for (int ks = 0; ks < 8; ++ks) {
                    const bf16x8 a = __builtin_bit_cast(bf16x8, __builtin_amdgcn_raw_buffer_load_b128(rk, kvoff + 32 * ks, kso + (32 * kb) * 256, 0));
                    acc = __builtin_amdgcn_mfma_f32_32x32x16_bf16(a, qf[ks], acc, 0, 0, 0);
                }
#pragma unroll
                for (int r = 0; r < 16; ++r) {
                    const int nconst = 32 * kb + (r & 3) + 8 * (r >> 2);
                    const int key = (f2sortable(acc[r]) & ~0x7F) | (127 - nconst);
                    if (kb == 0) K0[r] = key; else if (kb == 1) K1[r] = key; else if (kb == 2) K2[r] = key; else K3[r] = key;
                }
            }
            bitonic_sort_desc<16>(K0); bitonic_sort_desc<16>(K1); bitonic_sort_desc<16>(K2); bitonic_sort_desc<16>(K3);
            merge_top16(K0, K1); merge_top16(K2, K3); merge_top16(K0, K2);
            int P[16];
#pragma unroll
            for (int i = 0; i < 16; ++i) { K0[i] ^= hx; P[i] = __shfl_xor(K0[i], 32, 64); }
            merge_top16(K0, P);
#pragma unroll
            for (int i = 0; i < 16; ++i) { if (pp == 0) S0[i] = K0[i]; else S1[i] = K0[i]; }
        }
        {
            unsigned w4[4];
#pragma unroll
            for (int q = 0; q < 4; ++q) {
                unsigned w = 0;
#pragma unroll
                for (int e = 0; e < 4; ++e) { const int sv = hh ? S1[4 * q + e] : S0[4 * q + e]; w |= (unsigned)(127 - (sv & 127)) << (8 * e); }
                w4[q] = w;
            }
            u32x4 wv; wv.x = w4[0]; wv.y = w4[1]; wv.z = w4[2]; wv.w = w4[3];
            *(LAS u32x4*)(ilist + 16 * hh) = wv;
        }
        float a[16], b[16];
#pragma unroll
        for (int i = 0; i < 16; ++i) {
            const float f1 = sortable2f(S0[i] & ~0x7F), f2 = sortable2f(S1[i] & ~0x7F);
            a[i] = hh ? f2 : f1; b[i] = hh ? f1 : f2;
        }
        int CA[16], CB[16];
        const int org = hh << 8;
        {
            int n = 0;
#pragma unroll
            for (int i = 0; i < 4; ++i)
#pragma unroll
                for (int j = i; j < 16; ++j) {
                    if ((i + 1) * (j + 1) <= 16) {
                        int key = (f2sortable(a[i] + b[j]) & ~0x1FF) | org | (i * 16 + j);
                        if (i == j) key = hh ? (int)0x80000000 : key;
                        if (n < 16) CA[n] = key; else CB[n - 16] = key;
                        ++n;
                    }
                }
#pragma unroll
            for (int q = 27; q < 32; ++q) CB[q - 16] = (int)0x80000000;
        }
        bitonic_sort_desc<16>(CA); bitonic_sort_desc<16>(CB);
        merge_top16(CA, CB);
        int F[16], PF[16];
#pragma unroll
        for (int i = 0; i < 16; ++i) PF[i] = __shfl_xor(CA[i], 32, 64);
#pragma unroll
        for (int i = 0; i < 16; ++i) F[i] = max(CA[i], PF[15 - i]);
        int mxk = F[0];
#pragma unroll
        for (int i = 1; i < 16; ++i) mxk = max(mxk, F[i]);
        const float vmax = sortable2f(mxk & ~0x1FF);
        float e[8], psum = 0.f;
#pragma unroll
        for (int i = 0; i < 8; ++i) { e[i] = __expf(sortable2f(F[i] & ~0x1FF) - vmax); psum += e[i]; }
        const float inv = 1.0f / (psum + __shfl_xor(psum, 32, 64));
        asm volatile("s_waitcnt lgkmcnt(0)" ::: "memory");
        int ex[8];
#pragma unroll
        for (int i = 0; i < 8; ++i) {
            const int low = F[i] & 0x1FF, o = low >> 8, il = (low >> 4) & 15, jl = low & 15;
            const int ri = o ? jl : il, rj = o ? il : jl;
            const int i1 = (int)*(const LAS unsigned char*)(ilist + ri), i2 = (int)*(const LAS unsigned char*)(ilist + 16 + rj);
            ex[i] = i1 * 128 + i2;
        }
        int* ep = p.eidx + ((size_t)t * 8 + hd) * 16 + hh * 8;
        float* gp = p.egate + ((size_t)t * 8 + hd) * 16 + hh * 8;
        *(u32x4*)ep = (u32x4){(unsigned)ex[0], (unsigned)ex[1], (unsigned)ex[2], (unsigned)ex[3]};
        *(u32x4*)(ep + 4) = (u32x4){(unsigned)ex[4], (unsigned)ex[5], (unsigned)ex[6], (unsigned)ex[7]};
        *(f32x4*)gp = (f32x4){e[0] * inv, e[1] * inv, e[2] * inv, e[3] * inv};
        *(f32x4*)(gp + 4) = (f32x4){e[4] * inv, e[5] * inv, e[6] * inv, e[7] * inv};
        asm volatile("s_waitcnt lgkmcnt(0)" ::: "memory");
    }
}
template <int DUMMY>
__global__ void __launch_bounds__(512, 2) k_topk(Params p, int l) {
    extern __shared__ __attribute__((aligned(16))) unsigned char smem_raw[];
    phase_topk(p, l, (LAS unsigned char*)smem_raw);
}
__device__ __forceinline__ void phase_mod(const Params& p, LAS unsigned char* lds) {
    const int tid = tid_opaque();
    LAS float* sc = (LAS float*)lds;
    LAS float* red = (LAS float*)(lds + 32768);
    for (int i = tid; i < BATCH * D_MODEL; i += 512) { const int b = i >> 10, k = i & 1023; const float v = p.c[i]; sc[k * 8 + b] = v / (1.0f + __expf(-v)); }
    __syncthreads();
    const int kg = tid >> 5, cl = tid & 31;
    for (int u = blockIdx.x; u < DEPTH * 64; u += gridDim.x) {
        const int l = u >> 6, j0 = (u & 63) * 96;
        const float* w = p.w_mod + (size_t)l * D_MODEL * MODW + (size_t)(kg * 64) * MODW + j0 + cl;
        float acc[3][8];
#pragma unroll
        for (int q = 0; q < 3; ++q)
#pragma unroll
            for (int b = 0; b < 8; ++b) acc[q][b] = 0.f;
#pragma unroll 4
        for (int kk = 0; kk < 64; ++kk) {
            const float w0 = w[(size_t)kk * MODW], w1 = w[(size_t)kk * MODW + 32], w2 = w[(size_t)kk * MODW + 64];
            const f32x4 s0 = *(const LAS f32x4*)(sc + (kg * 64 + kk) * 8), s1 = *(const LAS f32x4*)(sc + (kg * 64 + kk) * 8 + 4);
#pragma unroll
            for (int b = 0; b < 4; ++b) { acc[0][b] += s0[b] * w0; acc[1][b] += s0[b] * w1; acc[2][b] += s0[b] * w2; acc[0][4 + b] += s1[b] * w0; acc[1][4 + b] += s1[b] * w1; acc[2][4 + b] += s1[b] * w2; }
        }
#pragma unroll
        for (int q = 0; q < 3; ++q)
#pragma unroll
            for (int b = 0; b < 8; ++b) red[((kg * 3 + q) * 8 + b) * 32 + cl] = acc[q][b];
        __syncthreads();
        for (int o = tid; o < 768; o += 512) {
            float s = 0.f;
#pragma unroll
            for (int g = 0; g < 16; ++g) s += red[g * 768 + o];
            const int ocl = o & 31, ob = (o >> 5) & 7, oq = o >> 8;
            const int j = j0 + oq * 32 + ocl;
            p.mod[((size_t)l * BATCH + ob) * MODW + j] = s + p.b_mod[(size_t)l * MODW + j];
        }
        __syncthreads();
    }
}

__global__ void __launch_bounds__(512, 2) k_mega(Params p) {
    extern __shared__ __attribute__((aligned(16))) unsigned char smem_raw[];
    LAS unsigned char* lds = (LAS unsigned char*)smem_raw;
    volatile LAS unsigned* xbw = (volatile LAS unsigned*)(lds + LDS_BYTES - 16);
    if (threadIdx.x == 0) { xbw[0] = 0u; xbw[1] = 0u; xbw[2] = 0u; xbw[3] = 0u; }
    __syncthreads();
    (void)xcd_barrier_post(p.bar, xbw);
#define GRID_SYNC() do { XcdBarrier _b; _b.bar = p.bar; _b.x = xb_xcc_id(); _b.st = (volatile LAS unsigned*)(lds + LDS_BYTES - 16); xcd_barrier(_b); } while (0)

    phase_mod(p, lds);
    phase_convert(p, lds);
    GRID_SYNC();
    phase_norm(p, p.x_in, p.norm1_g, p.mod, 0, 1);
    GRID_SYNC();
    for (int l = 0; l < DEPTH; ++l) {
        const float* modl = p.mod + (size_t)l * BATCH * MODW;
        { EpiStoreBf16 E; E.O = p.pb; E.ldc = MIX_IN; run_gemm(lds, p.hb, p.WinT + (size_t)l * MIX_IN * D_MODEL, NTOK, MIX_IN, D_MODEL, E); }
        GRID_SYNC();
        phase_attn(p, l, lds);
        phase_mixrest(p, l, lds);
        GRID_SYNC();
        { EpiResid E; E.xin = (l == 0) ? p.x_in : p.xb; E.xout = p.xb; E.gate = modl + 2 * D_MODEL; run_gemm(lds, p.cat, p.WoutT + (size_t)l * D_MODEL * D_MODEL, NTOK, D_MODEL, D_MODEL, E); }
        GRID_SYNC();
        phase_norm(p, p.xb, p.norm2_g + l * D_MODEL, modl, 3, 4);
        GRID_SYNC();
        { EpiStoreBf16 E; E.O = p.qb; E.ldc = 2048; run_gemm(lds, p.hb, p.WqT + (size_t)l * 2048 * D_MODEL, NTOK, 2048, D_MODEL, E); }
        GRID_SYNC();
        phase_topk(p, l, lds);
        GRID_SYNC();
        phase_expert(p, l, l == DEPTH - 1);
        GRID_SYNC();
    }
}
#ifndef MK_MULTI
#define MK_MULTI 0
#endif
enum { PH_CONVERT = 0, PH_NORM1, PH_GEMM1, PH_GEMM2, PH_NORM2, PH_GEMM3, PH_MOD };
template <int PH>
__global__ void __launch_bounds__(512, 2) k_ph(Params p, int l) {
    extern __shared__ __attribute__((aligned(16))) unsigned char smem_raw[];
    LAS unsigned char* lds = (LAS unsigned char*)smem_raw;
    const float* modl = p.mod + (size_t)l * BATCH * MODW;
    if (PH == PH_CONVERT) phase_convert(p, lds);
    if (PH == PH_MOD) phase_mod(p, lds);
    if (PH == PH_NORM1) phase_norm(p, l == 0 ? p.x_in : p.xb, p.norm1_g + l * D_MODEL, modl, 0, 1);
    if (PH == PH_GEMM1) { EpiStoreBf16 E; E.O = p.pb; E.ldc = MIX_IN; run_gemm(lds, p.hb, p.WinT + (size_t)l * MIX_IN * D_MODEL, NTOK, MIX_IN, D_MODEL, E); }
    if (PH == PH_GEMM2) { EpiResid E; E.xin = (l == 0) ? p.x_in : p.xb; E.xout = p.xb; E.gate = modl + 2 * D_MODEL; run_gemm(lds, p.cat, p.WoutT + (size_t)l * D_MODEL * D_MODEL, NTOK, D_MODEL, D_MODEL, E); }
    if (PH == PH_NORM2) phase_norm(p, p.xb, p.norm2_g + l * D_MODEL, modl, 3, 4);
    if (PH == PH_GEMM3) { EpiStoreBf16 E; E.O = p.qb; E.ldc = 2048; run_gemm(lds, p.hb, p.WqT + (size_t)l * 2048 * D_MODEL, NTOK, 2048, D_MODEL, E); }
}

extern "C" void kernel_launch(void* const* d_in, const int* in_sizes, int n_in, void* d_out, int out_size, void* d_ws, size_t ws_size, hipStream_t stream) {
    Params p{};
    p.x_in = (const float*)d_in[0]; p.c = (const float*)d_in[1]; p.rel_bias = (const float*)d_in[2]; p.w_mod = (const float*)d_in[3]; p.b_mod = (const float*)d_in[4];
    p.norm1_g = (const float*)d_in[5]; p.norm2_g = (const float*)d_in[6]; p.w_in = (const float*)d_in[7]; p.w_out = (const float*)d_in[8]; p.diff_lambda = (const float*)d_in[9];
    p.subln_g = (const float*)d_in[10]; p.conf_dw = (const float*)d_in[11]; p.conf_ln_g = (const float*)d_in[12]; p.conf_ln_b = (const float*)d_in[13]; p.sconv_w = (const float*)d_in[14];
    p.sgu_ln_g = (const float*)d_in[15]; p.sgu_ln_b = (const float*)d_in[16]; p.sgu_w = (const float*)d_in[17]; p.sgu_b = (const float*)d_in[18]; p.peer_wq = (const float*)d_in[19];
    p.peer_keys = (const float*)d_in[20]; p.peer_u = (const float*)d_in[21]; p.peer_v = (const float*)d_in[22]; p.final_g = (const float*)d_in[23];
    p.out = (float*)d_out;
    for (int l = 0; l < DEPTH; ++l) p.lam_init[l] = (float)(0.8 - 0.6 * exp(-0.3 * (double)l));

    char* ws = (char*)d_ws; size_t off = 0;
    auto take = [&](size_t bytes) { void* r = ws + off; off += (bytes + 255) & ~(size_t)255; return r; };
    p.bar = (unsigned*)take((size_t)XCD_BAR_WORDS * 4);
    p.mod = (float*)take((size_t)DEPTH * BATCH * MODW * 4);
    p.xb = (float*)take((size_t)NTOK * D_MODEL * 4);
    p.hb = (bf16_t*)take((size_t)NTOK * D_MODEL * 2);
    p.pb = (bf16_t*)take((size_t)NTOK * MIX_IN * 2);
    p.cat = (bf16_t*)take((size_t)NTOK * D_MODEL * 2);
    p.qb = (bf16_t*)take((size_t)NTOK * 2048 * 2);
    p.WinT = (bf16_t*)take((size_t)DEPTH * MIX_IN * D_MODEL * 2);
    p.WoutT = (bf16_t*)take((size_t)DEPTH * D_MODEL * D_MODEL * 2);
    p.WqT = (bf16_t*)take((size_t)DEPTH * 2048 * D_MODEL * 2);
    p.keysb = (bf16_t*)take((size_t)DEPTH * 16 * 128 * 128 * 2);
    p.ub8 = (unsigned char*)take((size_t)DEPTH * NEXP * D_MODEL);
    p.vb8 = (unsigned char*)take((size_t)DEPTH * NEXP * D_MODEL);
    p.uinv = (float*)take((size_t)DEPTH * NEXP * 4);
    p.vinv = (float*)take((size_t)DEPTH * NEXP * 4);
    p.sguwb = (bf16_t*)take((size_t)DEPTH * 4 * 128 * 128 * 2);
    p.eidx = (int*)take((size_t)NTOK * 128 * 4);
    p.egate = (float*)take((size_t)NTOK * 128 * 4);

    static int grid = 0;
    if (grid == 0) {
        int dev = 0, cus = 0;
        if (hipGetDevice(&dev) != hipSuccess || hipDeviceGetAttribute(&cus, hipDeviceAttributeMultiprocessorCount, dev) != hipSuccess) { grid = -1; return; }
        bool ok = true;
#if MK_MULTI
        ok &= hipFuncSetAttribute((const void*)k_ph<PH_CONVERT>, hipFuncAttributeMaxDynamicSharedMemorySize, LDS_BYTES) == hipSuccess;
        ok &= hipFuncSetAttribute((const void*)k_ph<PH_NORM1>, hipFuncAttributeMaxDynamicSharedMemorySize, LDS_BYTES) == hipSuccess;
        ok &= hipFuncSetAttribute((const void*)k_ph<PH_GEMM1>, hipFuncAttributeMaxDynamicSharedMemorySize, LDS_BYTES) == hipSuccess;
        ok &= hipFuncSetAttribute((const void*)k_ph<PH_GEMM2>, hipFuncAttributeMaxDynamicSharedMemorySize, LDS_BYTES) == hipSuccess;
        ok &= hipFuncSetAttribute((const void*)k_ph<PH_NORM2>, hipFuncAttributeMaxDynamicSharedMemorySize, LDS_BYTES) == hipSuccess;
        ok &= hipFuncSetAttribute((const void*)k_ph<PH_GEMM3>, hipFuncAttributeMaxDynamicSharedMemorySize, LDS_BYTES) == hipSuccess;
        ok &= hipFuncSetAttribute((const void*)k_ph<PH_MOD>, hipFuncAttributeMaxDynamicSharedMemorySize, LDS_BYTES) == hipSuccess;
        ok &= hipFuncSetAttribute((const void*)k_attn2<0>, hipFuncAttributeMaxDynamicSharedMemorySize, LDS_BYTES) == hipSuccess;
        ok &= hipFuncSetAttribute((const void*)k_topk<0>, hipFuncAttributeMaxDynamicSharedMemorySize, LDS_BYTES) == hipSuccess;
        ok &= hipFuncSetAttribute((const void*)k_mixrest<0>, hipFuncAttributeMaxDynamicSharedMemorySize, LDS_BYTES) == hipSuccess;
#else
        ok &= hipFuncSetAttribute((const void*)k_mega, hipFuncAttributeMaxDynamicSharedMemorySize, LDS_BYTES) == hipSuccess;
#endif
        if (!ok) { fprintf(stderr, "kernel_launch: hipFuncSetAttribute failed\n"); grid = -1; return; }
        grid = cus;
    }
    if (grid < 0) return;
    const int G = grid;
#if MK_MULTI
    k_ph<PH_MOD><<<G, 512, LDS_BYTES, stream>>>(p, 0);
    k_ph<PH_CONVERT><<<G, 512, LDS_BYTES, stream>>>(p, 0);
    for (int l = 0; l < DEPTH; ++l) {
        if (l == 0) k_ph<PH_NORM1><<<G, 512, LDS_BYTES, stream>>>(p, l);
        k_ph<PH_GEMM1><<<G, 512, LDS_BYTES, stream>>>(p, l);
        k_attn2<0><<<G, 512, LDS_BYTES, stream>>>(p, l);
        k_mixrest<0><<<G, 512, LDS_BYTES, stream>>>(p, l);
        k_ph<PH_GEMM2><<<G, 512, LDS_BYTES, stream>>>(p, l);
        k_ph<PH_NORM2><<<G, 512, LDS_BYTES, stream>>>(p, l);
        k_ph<PH_GEMM3><<<G, 512, LDS_BYTES, stream>>>(p, l);
        k_topk<0><<<G, 512, LDS_BYTES, stream>>>(p, l);
        k_expert<<<G, 512, 0, stream>>>(p, l);
    }
#else
    (void)hipMemsetAsync(p.bar, 0, (size_t)XCD_BAR_WORDS * 4, stream);
    k_mega<<<G, 512, LDS_BYTES, stream>>>(p);
#endif
}
```

```cpp
#include <hip/hip_runtime.h>
#include <stdint.h>
#include <stdio.h>
#include <math.h>

#define D_MODEL 1024
#define BATCH 8
#define SEQ 2048
#define DEPTH 4
#define NTOK (BATCH * SEQ)
#define MIX_IN 2560
#define N_MOD 6
#define MODW (N_MOD * D_MODEL)
#define NEXP 16384

#define MK_MULTI 0
#ifndef PROBE_MASK
#define PROBE_MASK 0
#endif
#define PROBE_TIME 0
#define PROBE_SYNTH 0
#define PROBE_UB 0
#define LAS __attribute__((address_space(3)))
typedef unsigned short bf16_t;
typedef short bf16x8 __attribute__((ext_vector_type(8)));
typedef float f32x4 __attribute__((ext_vector_type(4)));
typedef float f32x16 __attribute__((ext_vector_type(16)));
typedef unsigned u32x4 __attribute__((ext_vector_type(4)));
typedef unsigned u32x2 __attribute__((ext_vector_type(2)));
typedef float f32x2 __attribute__((ext_vector_type(2)));

__device__ const unsigned char kBucket[128] = {
    0, 1, 2, 3, 4, 5, 6, 7, 8, 9, 10, 11, 12, 13, 14, 15, 16, 16, 16, 17, 17, 18, 18, 18, 19, 19, 19, 20, 20, 20, 20, 21,
    21, 21, 21, 22, 22, 22, 22, 22, 23, 23, 23, 23, 23, 23, 24, 24, 24, 24, 24, 24, 25, 25, 25, 25, 25, 25, 25, 26, 26, 26, 26, 26,
    26, 26, 26, 27, 27, 27, 27, 27, 27, 27, 27, 27, 27, 28, 28, 28, 28, 28, 28, 28, 28, 28, 28, 29, 29, 29, 29, 29, 29, 29, 29, 29,
    29, 29, 29, 30, 30, 30, 30, 30, 30, 30, 30, 30, 30, 30, 30, 30, 30, 31, 31, 31, 31, 31, 31, 31, 31, 31, 31, 31, 31, 31, 31, 31};

__device__ __forceinline__ float bf2f(bf16_t v) { return __uint_as_float(((unsigned)v) << 16); }
__device__ __forceinline__ float bflo(unsigned w) { return __uint_as_float(w << 16); }
__device__ __forceinline__ float bfhi(unsigned w) { return __uint_as_float(w & 0xFFFF0000u); }
__device__ __forceinline__ bf16_t f2bf(float f) { unsigned u = __float_as_uint(f); u += 0x7FFFu + ((u >> 16) & 1u); return (bf16_t)(u >> 16); }
__device__ __forceinline__ unsigned pk2(float lo, float hi) { unsigned r; asm volatile("v_cvt_pk_bf16_f32 %0, %1, %2" : "=v"(r) : "v"(lo), "v"(hi)); return r; }
__device__ __forceinline__ float ldf(const float* p) { return *p; }
__device__ __forceinline__ float ldf(const bf16_t* p) { return bf2f(*p); }

__device__ __forceinline__ float gelu_as(float v) {
    const float av = fabsf(v), t = __builtin_amdgcn_rcpf(av * 0.2316418882f + 1.0f);
    float q = t * 0.5307027145f + (-0.7265760135f); q = q * t + 0.7107068705f; q = q * t + (-0.142248368f); q = q * t + 0.127414796f; q = q * t;
    const float e = __builtin_amdgcn_exp2f((v * v) * (-0.72134752044f));
    const float m = v * (q * e);
    return v < 0.f ? m : v - m;
}
template <int CTRL, int ROWMASK = 0xF>
__device__ __forceinline__ float dpp_add(float x) {
    const int y = __builtin_amdgcn_update_dpp(0, __float_as_int(x), CTRL, ROWMASK, 0xF, false);
    return x + __int_as_float(y);
}
__device__ __forceinline__ float wave_sum_l63(float v) {
    v = dpp_add<0xB1>(v);
    v = dpp_add<0x4E>(v);
    v = dpp_add<0x141>(v);
    v = dpp_add<0x140>(v);
    v = dpp_add<0x142, 0xA>(v);
    v = dpp_add<0x143, 0xC>(v);
    return v;
}
__device__ __forceinline__ float gelu_exact(float v) { return 0.5f * v * (1.0f + erff(v * 0.70710678118654752f)); }
__device__ __forceinline__ float sigmoidf_(float v) { return 1.0f / (1.0f + __expf(-v)); }
__device__ __forceinline__ float wave_sum(float v) {
#pragma unroll
    for (int o = 32; o > 0; o >>= 1) v += __shfl_xor(v, o, 64);
    return v;
}
__device__ __forceinline__ float block_sum256(float v, float* red) {
    v = wave_sum(v);
    __syncthreads();
    if ((threadIdx.x & 63) == 0) red[threadIdx.x >> 6] = v;
    __syncthreads();
    return red[0] + red[1] + red[2] + red[3];
}

__device__ __forceinline__ int tid_opaque(int wv) {
    int t;
    asm volatile("v_mbcnt_lo_u32_b32 %0, -1, 0\n\tv_mbcnt_hi_u32_b32 %0, -1, %0" : "=v"(t));
    return (wv << 6) | t;
}
__device__ __forceinline__ int launder(int v) { asm volatile("" : "+v"(v)); return v; }
#define XB_TMO      128
#define XB_XCNT(j)  (256  + 64 * (j))
#define XB_XSUB(j)  (1280 + 64 * (j))
#define XB_XGEN(j)  (2304 + 64 * (j))
#define XB_TOP      3328
#define XB_TOPGEN   3392
#define XCD_BAR_WORDS 3456
#define XB_SPIN_CAP (1u << 18)

__device__ __forceinline__ unsigned xb_ld(unsigned* p)              { return __hip_atomic_load(p, __ATOMIC_RELAXED, __HIP_MEMORY_SCOPE_AGENT); }
__device__ __forceinline__ unsigned xb_add(unsigned* p, unsigned v) { return __hip_atomic_fetch_add(p, v, __ATOMIC_RELAXED, __HIP_MEMORY_SCOPE_AGENT); }
__device__ __forceinline__ unsigned xb_xcc_id() { return (unsigned)__builtin_amdgcn_s_getreg((3 << 11) | 20) & 0xFu; }
#define XB_SPIN(cond, bar) do { unsigned _sp = 0; while (cond) { __builtin_amdgcn_s_sleep(1); \
    if ((++_sp & 255u) == 0u) { if (xb_ld(&(bar)[XB_TMO])) break; if (_sp > XB_SPIN_CAP) { atomicAdd(&(bar)[XB_TMO], 1u); break; } } } } while (0)

struct XcdBarrier {
    unsigned* bar; unsigned x;
    bool t0;
    volatile LAS unsigned* st;
};

__device__ __forceinline__ XcdBarrier xcd_barrier_post(unsigned* bar, volatile LAS unsigned* st) {
    XcdBarrier b; b.bar = bar; b.x = xb_xcc_id(); b.st = st;
    if (threadIdx.x == 0) (void)xb_add(&bar[XB_XCNT(b.x)], 1u);
    return b;
}
__device__ __forceinline__ void xcd_barrier_complete(unsigned* bar, unsigned x, unsigned& nloc, unsigned& nx) {
    const unsigned G = gridDim.x * gridDim.y * gridDim.z;
    unsigned sum, cnt, mine, sp = 0u;
    for (;;) {
        sum = 0u; cnt = 0u; mine = 0u;
#pragma unroll
        for (unsigned j = 0; j < 16; ++j) { const unsigned c = xb_ld(&bar[XB_XCNT(j)]); sum += c; cnt += (c > 0u) ? 1u : 0u; mine = (j == x) ? c : mine; }
        if (sum == G) break;
        __builtin_amdgcn_s_sleep(1);
        if ((++sp & 255u) == 0u) { if (xb_ld(&bar[XB_TMO])) break; if (sp > XB_SPIN_CAP) { atomicAdd(&bar[XB_TMO], 1u); break; } }
    }
    nloc = mine > 0u ? mine : 1u; nx = cnt > 0u ? cnt : 1u;
}

__device__ __forceinline__ void xcd_barrier(const XcdBarrier& b) {
    asm volatile("s_waitcnt vmcnt(0)" ::: "memory");
    __syncthreads();
    if (b.t0) {
        unsigned* bar = b.bar;
        __builtin_amdgcn_s_waitcnt(0);
        unsigned nloc = b.st[0], nx = b.st[1];
        if (nloc == 0u) { xcd_barrier_complete(bar, b.x, nloc, nx); b.st[0] = nloc; b.st[1] = nx; }
        const unsigned old = xb_add(&bar[XB_XSUB(b.x)], 1u);
        const unsigned gen = old / nloc;
        if (old + 1u == (gen + 1u) * nloc) {
            __builtin_amdgcn_fence(__ATOMIC_RELEASE, "agent");
            asm volatile("s_waitcnt vmcnt(0)" ::: "memory");
            const unsigned og = xb_add(&bar[XB_TOP], 1u);
            const unsigned tg = og / nx;
            if (og + 1u == (tg + 1u) * nx) xb_add(&bar[XB_TOPGEN], 1u);
            else XB_SPIN(xb_ld(&bar[XB_TOPGEN]) == tg, bar);
            __builtin_amdgcn_fence(__ATOMIC_ACQUIRE, "agent");
            xb_add(&bar[XB_XGEN(b.x)], 1u);
            asm volatile("s_waitcnt vmcnt(0)" ::: "memory");
        } else {
            XB_SPIN(xb_ld(&bar[XB_XGEN(b.x)]) == gen, bar);
            __builtin_amdgcn_fence(__ATOMIC_ACQUIRE, "agent");
            asm volatile("s_waitcnt vmcnt(0)" ::: "memory");
        }
    }
    __syncthreads();
}
namespace pg8 {
#define PG8_LAS __attribute__((address_space(3)))
typedef unsigned short bf16_t;
typedef short bf16x8 __attribute__((ext_vector_type(8)));
typedef float f32x4 __attribute__((ext_vector_type(4)));
typedef unsigned u32x4 __attribute__((ext_vector_type(4)));
constexpr int BM = 256, BK = 64, HALF = 128, HTB = HALF * BK * 2  , STAGE_BYTES = 8 * HTB, NXCD = 8, WGM = 8;

__host__ __device__ __forceinline__ int lds_byte(int r, int c) { const int st = (r >> 4) * 2 + (c >> 5), rr = r & 15, cc = c & 31, ob = rr * 64 + cc * 2; return st * 1024 + (ob ^ (((ob >> 9) & 1) << 5)); }
__host__ __device__ __forceinline__ void stage_rc(int b, int& R, int& C) { const int st = b / 1024, sb = b % 1024, swz = sb ^ (((sb >> 9) & 1) << 5); R = (st >> 1) * 16 + swz / 64; C = (st & 1) * 32 + (swz % 64) / 2; }
__host__ __device__ __forceinline__ int perm32(int rho) { const int n = rho >> 4, i = rho & 15; return 8 * (i >> 2) + 4 * n + (i & 3); }

struct Unit { int pm, pn; };
struct Gemm { const bf16_t* A; const bf16_t* Bt; int M, N, K; };

struct StaticOrder {
    int nM, nN, nwg, G, c;
    __host__ __device__ void init(int M, int N, int G_, int c_) { nM = M / BM; nN = N / BM; nwg = nM * nN; G = G_; c = c_; }
    __host__ __device__ bool next(int i, Unit& u) const {
        const long L = (long)i * G + c; if (L >= nwg) return false;
        int wgid = (int)L; { const int q = nwg / NXCD, r = nwg % NXCD, xcd = wgid % NXCD, off = wgid / NXCD; wgid = (xcd < r ? xcd * (q + 1) : r * (q + 1) + (xcd - r) * q) + off; }
        const int nig = WGM * nN, gid = wgid / nig, fm = gid * WGM, gsz = (nM - fm) < WGM ? (nM - fm) : WGM;
        u.pm = fm + ((wgid % nig) % gsz); u.pn = (wgid % nig) / gsz; return true;
    }
    __device__ __forceinline__ void a_ready(const Unit&) const {}
    __device__ __forceinline__ void done(const Unit&) const {}
};
__device__ __forceinline__ unsigned cvt_pk_bf16(float lo, float hi) { unsigned r; asm volatile("v_cvt_pk_bf16_f32 %0, %1, %2" : "=v"(r) : "v"(lo), "v"(hi)); return r; }
template <class Epi, class Sched, bool STAMP = false>
__device__ __forceinline__ void gemm_phase(PG8_LAS unsigned char* lds, const Gemm g, const Sched& S, const Epi& E, unsigned long long* stamps, int wv) {
    const int tid = tid_opaque(wv), wid = __builtin_amdgcn_readfirstlane(tid >> 6), lane = tid & 63, wr = wid >> 2, wc = wid & 3, fr = lane & 15, fq = lane >> 4;
    const int K = g.K, nt = K / BK;
    int ts_lo = 0, ts_hi = 0, nts = 0; const unsigned long long rt_entry = STAMP ? (unsigned long long)wall_clock64() : 0ull;
#define PG8_STAMP() do { if (STAMP && wid == 0 && nts < 64) { const unsigned long long _c = (unsigned long long)clock64(); \
        ts_lo = (lane == nts) ? (int)(unsigned)_c : ts_lo; ts_hi = (lane == nts) ? (int)(unsigned)(_c >> 32) : ts_hi; ++nts; } } while (0)
    PG8_STAMP();
    unsigned voffA[2], voffB[2];
#pragma unroll
    for (int i = 0; i < 2; ++i) { int R, C; stage_rc(tid * 16 + i * 8192, R, C); const int Rb = Epi::PERM ? ((R & ~31) + perm32(R & 31)) : R;
        voffA[i] = (unsigned)(R * K + C) * 2u; voffB[i] = (unsigned)(Rb * K + C) * 2u; }
    const size_t kstep = (size_t)(BK * 2);
    const size_t hstep = (size_t)HALF * K * 2;
    const size_t tstep = 2 * hstep;
    const unsigned ldsw = (unsigned)wid * 1024u;
    const int aoff = lds_byte(wr * 64 + fr, fq * 8), boff = lds_byte(wc * 32 + fr, fq * 8);
#define PG8_SA(b, h) (((b) * 2 + (h)) * HTB)
#define PG8_SB(b, h) ((4 + (b) * 2 + (h)) * HTB)
#define PG8_STAGE(bufoff, gbase, voff) do { _Pragma("unroll") for (int _i = 0; _i < 2; ++_i) \
        __builtin_amdgcn_global_load_lds((const unsigned*)((const char*)(gbase) + (voff)[_i]), (PG8_LAS unsigned*)(lds + (bufoff) + ldsw + _i * 8192), 16, 0, 0); } while (0)
#define PG8_LDA(dst, b, h) do { _Pragma("unroll") for (int m = 0; m < 4; ++m) _Pragma("unroll") for (int k = 0; k < 2; ++k) dst[m][k] = *(const PG8_LAS bf16x8*)(lds + PG8_SA(b, h) + aoff + m * 2048 + k * 1024); } while (0)
#define PG8_LDB(dst, b, h) do { _Pragma("unroll") for (int n = 0; n < 2; ++n) _Pragma("unroll") for (int k = 0; k < 2; ++k) dst[n][k] = *(const PG8_LAS bf16x8*)(lds + PG8_SB(b, h) + boff + n * 2048 + k * 1024); } while (0)
#define PG8_MMA(ai, bj, At, Bt) do { __builtin_amdgcn_s_setprio(1); _Pragma("unroll") for (int m = 0; m < 4; ++m) _Pragma("unroll") for (int n = 0; n < 2; ++n) _Pragma("unroll") for (int k = 0; k < 2; ++k) \
        acc[ai][bj][m][n] = __builtin_amdgcn_mfma_f32_16x16x32_bf16(Bt[n][k], At[m][k], acc[ai][bj][m][n], 0, 0, 0); __builtin_amdgcn_s_setprio(0); } while (0)
#define PG8_WAIT_V(n) asm volatile("s_waitcnt vmcnt(" #n ")" ::: "memory")
#define PG8_WAIT_L(n) asm volatile("s_waitcnt lgkmcnt(" #n ")" ::: "memory")
#define PG8_BAR __builtin_amdgcn_s_barrier()
#define PG8_SCHED __builtin_amdgcn_sched_barrier(0)
    Unit cur, nxt; int ui = 0;
    if (!S.next(0, cur)) return;
    f32x4 acc[2][2][4][2];
#pragma unroll
    for (int a = 0; a < 2; ++a)
#pragma unroll
        for (int b = 0; b < 2; ++b)
#pragma unroll
            for (int m = 0; m < 4; ++m)
#pragma unroll
                for (int n = 0; n < 2; ++n) acc[a][b][m][n] = (f32x4){0.f, 0.f, 0.f, 0.f};
    bf16x8 At[4][2], B0[2][2], B1[2][2];
    const char* cA = (const char*)g.A + (size_t)cur.pm * tstep; const char* cB = (const char*)g.Bt + (size_t)cur.pn * tstep;
    S.a_ready(cur);
    PG8_STAGE(PG8_SB(0, 0), cB, voffB); PG8_STAGE(PG8_SA(0, 0), cA, voffA); PG8_STAGE(PG8_SB(0, 1), cB + hstep, voffB); PG8_STAGE(PG8_SA(0, 1), cA + hstep, voffA);
    if (wr == 1) PG8_BAR;
    PG8_WAIT_V(4); PG8_BAR;
    PG8_STAGE(PG8_SB(1, 0), cB + kstep, voffB); PG8_STAGE(PG8_SA(1, 0), cA + kstep, voffA); PG8_STAGE(PG8_SB(1, 1), cB + hstep + kstep, voffB);
    PG8_WAIT_V(6); PG8_BAR;
    PG8_STAMP();
    for (;;) {
        const bool has_next = S.next(ui + 1, nxt);
        const char* nA = has_next ? (const char*)g.A + (size_t)nxt.pm * tstep : cA; const char* nB = has_next ? (const char*)g.Bt + (size_t)nxt.pn * tstep : cB;
        for (int t = 0; t < nt; t += 2) {
            const bool last = (t == nt - 2);
            const char* a1 = cA + (size_t)(t + 1) * kstep;
            const char* a2 = last ? nA : cA + (size_t)(t + 2) * kstep; const char* b2 = last ? nB : cB + (size_t)(t + 2) * kstep;
            const char* a3 = a2 + kstep; const char* b3 = b2 + kstep;
            if (last && has_next) S.a_ready(nxt);
            PG8_LDB(B0, 0, 0); PG8_SCHED; PG8_LDA(At, 0, 0); PG8_STAGE(PG8_SA(1, 1), a1 + hstep, voffA);
            PG8_WAIT_L(8); PG8_BAR; PG8_WAIT_L(0); PG8_MMA(0, 0, At, B0); PG8_BAR; PG8_SCHED;
            PG8_LDB(B1, 0, 1); PG8_STAGE(PG8_SB(0, 0), b2, voffB);
            PG8_BAR; PG8_WAIT_L(0); PG8_MMA(0, 1, At, B1); PG8_BAR;
            PG8_LDA(At, 0, 1); PG8_STAGE(PG8_SA(0, 0), a2, voffA);
            PG8_BAR; PG8_WAIT_L(0); PG8_MMA(1, 0, At, B0); PG8_BAR; PG8_SCHED;
            PG8_STAGE(PG8_SB(0, 1), b2 + hstep, voffB);
            PG8_WAIT_V(6); PG8_BAR; PG8_MMA(1, 1, At, B1); PG8_BAR;
            PG8_LDB(B0, 1, 0); PG8_SCHED; PG8_LDA(At, 1, 0); PG8_STAGE(PG8_SA(0, 1), a2 + hstep, voffA);
            PG8_WAIT_L(8); PG8_BAR; PG8_WAIT_L(0); PG8_MMA(0, 0, At, B0); PG8_BAR; PG8_SCHED;
            PG8_LDB(B1, 1, 1); PG8_STAGE(PG8_SB(1, 0), b3, voffB);
            PG8_BAR; PG8_WAIT_L(0); PG8_MMA(0, 1, At, B1); PG8_BAR;
            PG8_LDA(At, 1, 1); PG8_STAGE(PG8_SA(1, 0), a3, voffA);
            PG8_BAR; PG8_WAIT_L(0); PG8_MMA(1, 0, At, B0); PG8_BAR; PG8_SCHED;
            PG8_STAGE(PG8_SB(1, 1), b3 + hstep, voffB);
            PG8_WAIT_V(6); PG8_BAR; PG8_MMA(1, 1, At, B1); PG8_BAR;
        }
        PG8_STAMP();
        if constexpr (!Epi::AFTER_DRAIN) { E(acc, cur, wr, wc, fr, fq); S.done(cur); }
        PG8_STAMP();
        if (!has_next) break;
#pragma unroll
        for (int a = 0; a < 2; ++a)
#pragma unroll
            for (int b = 0; b < 2; ++b)
#pragma unroll
                for (int m = 0; m < 4; ++m)
#pragma unroll
                    for (int n = 0; n < 2; ++n) acc[a][b][m][n] = (f32x4){0.f, 0.f, 0.f, 0.f};
        cur = nxt; cA = nA; cB = nB; ++ui;
    }
    PG8_WAIT_V(0);
    if (wr == 0) PG8_BAR;
    PG8_BAR;
    if constexpr (Epi::AFTER_DRAIN) { E.fused(acc, cur, wr, wc, fr, fq, lds, wid, lane); S.done(cur); }
    PG8_STAMP();
    if (STAMP && wid == 0) { stamps[lane] = lane < nts ? (((unsigned long long)(unsigned)ts_hi << 32) | (unsigned)ts_lo) : 0ull;
        if (lane == 62) stamps[62] = rt_entry; if (lane == 63) stamps[63] = (unsigned long long)wall_clock64(); }
#undef PG8_STAMP
#undef PG8_SA
#undef PG8_SB
#undef PG8_STAGE
#undef PG8_LDA
#undef PG8_LDB
#undef PG8_MMA
#undef PG8_WAIT_V
#undef PG8_WAIT_L
#undef PG8_BAR
#undef PG8_SCHED
}
}

constexpr size_t ws_al(size_t x) { return (x + 255) & ~(size_t)255; }
constexpr size_t OFF_BAR = 0;
constexpr size_t OFF_MOD = OFF_BAR + ws_al((size_t)3456 * 4);
constexpr size_t OFF_XB = OFF_MOD + ws_al((size_t)DEPTH * BATCH * MODW * 4);
constexpr size_t OFF_HB = OFF_XB + ws_al((size_t)NTOK * D_MODEL * 4);
constexpr size_t OFF_PB = OFF_HB + ws_al((size_t)NTOK * D_MODEL * 2);
constexpr size_t OFF_CAT = OFF_PB + ws_al((size_t)NTOK * MIX_IN * 2);
constexpr size_t OFF_QB = OFF_CAT + ws_al((size_t)NTOK * D_MODEL * 2);
constexpr size_t OFF_WINT = OFF_QB + ws_al((size_t)NTOK * 2048 * 2);
constexpr size_t OFF_WOUTT = OFF_WINT + ws_al((size_t)DEPTH * MIX_IN * D_MODEL * 2);
constexpr size_t OFF_WQT = OFF_WOUTT + ws_al((size_t)DEPTH * D_MODEL * D_MODEL * 2);
constexpr size_t OFF_KEYSB = OFF_WQT + ws_al((size_t)DEPTH * 2048 * D_MODEL * 2);
constexpr size_t OFF_SGUWB = OFF_KEYSB + ws_al((size_t)DEPTH * 16 * 128 * 128 * 2);
constexpr size_t OFF_UB8 = OFF_SGUWB + ws_al((size_t)DEPTH * 4 * 128 * 128 * 2);
constexpr size_t OFF_VB8 = OFF_UB8 + ws_al((size_t)DEPTH * NEXP * D_MODEL);
constexpr size_t OFF_UINV = OFF_VB8 + ws_al((size_t)DEPTH * NEXP * D_MODEL);
constexpr size_t OFF_VINV = OFF_UINV + ws_al((size_t)DEPTH * NEXP * 4);
constexpr size_t OFF_EIDX = OFF_VINV + ws_al((size_t)DEPTH * NEXP * 4);
constexpr size_t OFF_EGATE = OFF_EIDX + ws_al((size_t)NTOK * 128 * 4);
constexpr size_t WS_END = OFF_EGATE + ws_al((size_t)NTOK * 128 * 4);

struct Params {
    const float *x_in, *c, *rel_bias, *w_mod, *b_mod, *norm1_g, *norm2_g, *w_in, *w_out, *diff_lambda, *subln_g, *conf_dw, *conf_ln_g, *conf_ln_b, *sconv_w,
        *sgu_ln_g, *sgu_ln_b, *sgu_w, *sgu_b, *peer_wq, *peer_keys, *peer_u, *peer_v, *final_g;
    float* out;
    unsigned char* ws;
    float lam_init[DEPTH];
    __host__ __device__ unsigned* bar() const { return (unsigned*)(ws + OFF_BAR); }
    __host__ __device__ float* mod() const { return (float*)(ws + OFF_MOD); }
    __host__ __device__ float* xb() const { return (float*)(ws + OFF_XB); }
    __host__ __device__ bf16_t* hb() const { return (bf16_t*)(ws + OFF_HB); }
    __host__ __device__ bf16_t* pb() const { return (bf16_t*)(ws + OFF_PB); }
    __host__ __device__ bf16_t* cat() const { return (bf16_t*)(ws + OFF_CAT); }
    __host__ __device__ bf16_t* qb() const { return (bf16_t*)(ws + OFF_QB); }
    __host__ __device__ bf16_t* WinT() const { return (bf16_t*)(ws + OFF_WINT); }
    __host__ __device__ bf16_t* WoutT() const { return (bf16_t*)(ws + OFF_WOUTT); }
    __host__ __device__ bf16_t* WqT() const { return (bf16_t*)(ws + OFF_WQT); }
    __host__ __device__ bf16_t* keysb() const { return (bf16_t*)(ws + OFF_KEYSB); }
    __host__ __device__ bf16_t* sguwb() const { return (bf16_t*)(ws + OFF_SGUWB); }
    __host__ __device__ unsigned char* ub8() const { return ws + OFF_UB8; }
    __host__ __device__ unsigned char* vb8() const { return ws + OFF_VB8; }
    __host__ __device__ float* uinv() const { return (float*)(ws + OFF_UINV); }
    __host__ __device__ float* vinv() const { return (float*)(ws + OFF_VINV); }
    __host__ __device__ int* eidx() const { return (int*)(ws + OFF_EIDX); }
    __host__ __device__ float* egate() const { return (float*)(ws + OFF_EGATE); }
};

#define LDS_BYTES (160 * 1024)
#define NWAVES 8

__device__ __forceinline__ void transpose_item(const float* __restrict__ W, int K, int N, bf16_t* __restrict__ WT, LAS float* scr, int item, int lane) {
    const int nblk = N / 32, kb = item / nblk, nb = item % nblk, k0 = 64 * kb, n0 = 32 * nb;
#pragma unroll 8
    for (int i = 0; i < 32; ++i) { const int kk = 2 * i + (lane >> 5); scr[kk * 33 + (lane & 31)] = W[(size_t)(k0 + kk) * N + n0 + (lane & 31)]; }
    asm volatile("s_waitcnt lgkmcnt(0)" ::: "memory");
    const int c = lane & 7;
#pragma unroll
    for (int j = 0; j < 4; ++j) {
        const int n = (lane >> 3) + 8 * j; const LAS float* s = scr + (8 * c) * 33 + n;
        u32x4 o; o.x = pk2(s[0 * 33], s[1 * 33]); o.y = pk2(s[2 * 33], s[3 * 33]); o.z = pk2(s[4 * 33], s[5 * 33]); o.w = pk2(s[6 * 33], s[7 * 33]);
        *(u32x4*)(WT + (size_t)(n0 + n) * K + k0 + 8 * c) = o;
    }
    asm volatile("s_waitcnt lgkmcnt(0)" ::: "memory");
}
__device__ __forceinline__ void cvt8(const float* __restrict__ s, bf16_t* __restrict__ d) {
    const f32x4 a = *(const f32x4*)s, b = *(const f32x4*)(s + 4);
    u32x4 o; o.x = pk2(a[0], a[1]); o.y = pk2(a[2], a[3]); o.z = pk2(b[0], b[1]); o.w = pk2(b[2], b[3]);
    *(u32x4*)d = o;
}
__device__ __forceinline__ void phase_convert(const Params& p, LAS unsigned char* lds, int wv) {
    const int tid = tid_opaque(wv), wave = tid >> 6, lane = tid & 63;
    LAS float* scr = (LAS float*)(lds + wave * 16384);
    const int gw = blockIdx.x * NWAVES + wave, NGW = gridDim.x * NWAVES;
    constexpr int I_IN = (D_MODEL / 64) * (MIX_IN / 32), I_OUT = (D_MODEL / 64) * (D_MODEL / 32), I_Q = (D_MODEL / 64) * (2048 / 32), I_L = I_IN + I_OUT + I_Q;
    for (int it = gw; it < DEPTH * I_L; it += NGW) {
        const int l = it / I_L; int r = it % I_L;
        if (r < I_IN) { transpose_item(p.w_in + (size_t)l * D_MODEL * MIX_IN, D_MODEL, MIX_IN, p.WinT() + (size_t)l * MIX_IN * D_MODEL, scr, r, lane); continue; } r -= I_IN;
        if (r < I_OUT) { transpose_item(p.w_out + (size_t)l * D_MODEL * D_MODEL, D_MODEL, D_MODEL, p.WoutT() + (size_t)l * D_MODEL * D_MODEL, scr, r, lane); continue; } r -= I_OUT;
        transpose_item(p.peer_wq + (size_t)l * D_MODEL * 2048, D_MODEL, 2048, p.WqT() + (size_t)l * 2048 * D_MODEL, scr, r, lane);
    }
    const size_t gt = (size_t)blockIdx.x * 512 + tid, NGT = (size_t)gridDim.x * 512;
    constexpr size_t N_KEYS8 = (size_t)DEPTH * 16 * 128 * 128 / 8, N_TAB8 = (size_t)DEPTH * NEXP * D_MODEL / 8, N_SGU8 = (size_t)DEPTH * 4 * 128 * 128 / 8;
    for (size_t i = gt; i < N_KEYS8; i += NGT) cvt8(p.peer_keys + i * 8, p.keysb() + i * 8);
    for (size_t row = gw; row < (size_t)2 * DEPTH * NEXP; row += NGW) {
        const bool isv = row >= (size_t)DEPTH * NEXP; const size_t r = isv ? row - (size_t)DEPTH * NEXP : row;
        const float* src = (isv ? p.peer_v : p.peer_u) + r * D_MODEL + lane * 16;
        f32x4 a[4]; float ss = 0.f;
#pragma unroll
        for (int q = 0; q < 4; ++q) { a[q] = *(const f32x4*)(src + 4 * q); ss += a[q][0] * a[q][0] + a[q][1] * a[q][1] + a[q][2] * a[q][2] + a[q][3] * a[q][3]; }
        ss = wave_sum(ss);
        const float step = fmaxf(0.335f * sqrtf(ss * (1.0f / D_MODEL)), 1e-30f), sc = 1.0f / step;
        unsigned o[2];
#pragma unroll
        for (int d = 0; d < 2; ++d) {
            unsigned w = 0;
#pragma unroll
            for (int e = 0; e < 8; ++e) {
                const float v = a[2 * d + (e >> 2)][e & 3];
                const int qv = (int)fminf(fmaxf(rintf(v * sc), -8.f), 7.f) + 8;
                w |= (unsigned)qv << (8 * (e >> 1) + 4 * (e & 1));
            }
            o[d] = w;
        }
        *(u32x2*)((isv ? p.vb8() : p.ub8()) + r * (D_MODEL / 2) + lane * 8) = (u32x2){o[0], o[1]};
        if (lane == 0) (isv ? p.vinv() : p.uinv())[r] = step;
    }
    for (size_t i = gt; i < N_SGU8; i += NGT) {
        const size_t e = i * 8; const int s0 = (int)(e & 127), t = (int)((e >> 7) & 127);
        const f32x4 a = *(const f32x4*)(p.sgu_w + e), b = *(const f32x4*)(p.sgu_w + e + 4);
        float v[8] = {a[0], a[1], a[2], a[3], b[0], b[1], b[2], b[3]};
#pragma unroll
        for (int j = 0; j < 8; ++j) v[j] = (s0 + j <= t) ? v[j] : 0.f;
        u32x4 o; o.x = pk2(v[0], v[1]); o.y = pk2(v[2], v[3]); o.z = pk2(v[4], v[5]); o.w = pk2(v[6], v[7]);
        *(u32x4*)(p.sguwb() + e) = o;
    }
}

__device__ __forceinline__ void norm_row(const float* __restrict__ xr, const float* __restrict__ g, const float* __restrict__ sh, const float* __restrict__ sc, bf16_t* __restrict__ hr, int lane) {
    f32x4 v[4]; float ss = 0.f;
#pragma unroll
    for (int j = 0; j < 4; ++j) { v[j] = *(const f32x4*)(xr + j * 256 + lane * 4); ss += v[j][0] * v[j][0] + v[j][1] * v[j][1] + v[j][2] * v[j][2] + v[j][3] * v[j][3]; }
    const float rs = rsqrtf(wave_sum(ss) * (1.0f / D_MODEL) + 1e-6f);
#pragma unroll
    for (int j = 0; j < 4; ++j) {
        const int col = j * 256 + lane * 4;
        const f32x4 gv = *(const f32x4*)(g + col), scv = *(const f32x4*)(sc + col), shv = *(const f32x4*)(sh + col);
        f32x4 y;
#pragma unroll
        for (int e = 0; e < 4; ++e) y[e] = v[j][e] * rs * gv[e] * (1.0f + scv[e]) + shv[e];
        u32x2 o; o.x = pk2(y[0], y[1]); o.y = pk2(y[2], y[3]);
        *(u32x2*)(hr + col) = o;
    }
}
__device__ __forceinline__ void phase_norm(const Params& p, const float* __restrict__ x, const float* __restrict__ g, const float* __restrict__ modl, int sh_idx, int sc_idx, int wv) {
    const int tid = tid_opaque(wv), wave = tid >> 6, lane = tid & 63;
    for (int t = blockIdx.x * NWAVES + wave; t < NTOK; t += gridDim.x * NWAVES) {
        const float* mb = modl + (size_t)(t / SEQ) * MODW;
        norm_row(x + (size_t)t * D_MODEL, g, mb + sh_idx * D_MODEL, mb + sc_idx * D_MODEL, p.hb() + (size_t)t * D_MODEL, lane);
    }
}

struct EpiStoreBf16 {
    static constexpr bool PERM = true, AFTER_DRAIN = false;
    bf16_t* O; int ldc;
    __device__ __forceinline__ void operator()(const pg8::f32x4 (&acc)[2][2][4][2], const pg8::Unit& u, int wr, int wc, int fr, int fq) const {
        const int row0 = u.pm * 256 + wr * 64 + fr, col0 = u.pn * 256 + wc * 32 + 8 * fq;
#pragma unroll
        for (int ai = 0; ai < 2; ++ai)
#pragma unroll
            for (int m = 0; m < 4; ++m) {
                bf16_t* rowp = O + (size_t)(row0 + ai * 128 + m * 16) * ldc + col0;
#pragma unroll
                for (int bj = 0; bj < 2; ++bj) {
                    const pg8::f32x4 v0 = acc[ai][bj][m][0], v1 = acc[ai][bj][m][1];
                    u32x4 w; w.x = pk2(v0[0], v0[1]); w.y = pk2(v0[2], v0[3]); w.z = pk2(v1[0], v1[1]); w.w = pk2(v1[2], v1[3]);
                    *(u32x4*)(rowp + bj * 128) = w;
                }
            }
    }
};
struct EpiResid {
    static constexpr bool PERM = false, AFTER_DRAIN = false;
    const float* xin; float* xout; const float* gate;
    __device__ __forceinline__ void operator()(const pg8::f32x4 (&acc)[2][2][4][2], const pg8::Unit& u, int wr, int wc, int fr, int fq) const {
        const int row0 = u.pm * 256 + wr * 64 + fr, col0 = u.pn * 256 + wc * 32 + 4 * fq;
        const float* gb = gate + (size_t)((u.pm * 256) / SEQ) * MODW + col0;
        pg8::f32x4 gv[2][2];
#pragma unroll
        for (int bj = 0; bj < 2; ++bj)
#pragma unroll
            for (int n = 0; n < 2; ++n) gv[bj][n] = *(const pg8::f32x4*)(gb + bj * 128 + n * 16);
#pragma unroll
        for (int ai = 0; ai < 2; ++ai)
#pragma unroll
            for (int m = 0; m < 4; ++m) {
                const size_t off = (size_t)(row0 + ai * 128 + m * 16) * D_MODEL + col0;
#pragma unroll
                for (int bj = 0; bj < 2; ++bj)
#pragma unroll
                    for (int n = 0; n < 2; ++n) {
                        const pg8::f32x4 xv = *(const pg8::f32x4*)(xin + off + bj * 128 + n * 16);
                        *(pg8::f32x4*)(xout + off + bj * 128 + n * 16) = xv + gv[bj][n] * acc[ai][bj][m][n];
                    }
            }
    }
};

template <class Epi>
__device__ __forceinline__ void run_gemm(LAS unsigned char* lds, const bf16_t* A, const bf16_t* Bt, int M, int N, int K, const Epi& E, int wv) {
    pg8::StaticOrder S; S.init(M, N, (int)gridDim.x, (int)blockIdx.x);
    pg8::Gemm g; g.A = A; g.Bt = Bt; g.M = M; g.N = N; g.K = K;
    pg8::gemm_phase<Epi, pg8::StaticOrder, false>(lds, g, S, E, nullptr, wv);
}

typedef __amdgpu_buffer_rsrc_t rsrc_t;
struct G4 { u32x2 r[4]; };
__device__ __forceinline__ u32x2 bload8(rsrc_t r, int voff, int soff) { return __builtin_bit_cast(u32x2, __builtin_amdgcn_raw_buffer_load_b64(r, voff, soff, 0)); }
#define ROWB (D_MODEL / 2)
template <int G>
__device__ __forceinline__ void ex_issue(G4& R, rsrc_t rs, int e0, int e1, int voff, int emask = 0x3FFF) {
#pragma unroll
    for (int i = 0; i < 4; ++i) {
        const int e = __builtin_amdgcn_readlane(G < 16 ? e0 : e1, (4 * G + i) & 63) & emask;
        R.r[i] = bload8(rs, voff, e * ROWB);
    }
}
template <int CTRL, int ROWMASK = 0xF>
__device__ __forceinline__ int dpp_iadd(int x) { return x + __builtin_amdgcn_update_dpp(0, x, CTRL, ROWMASK, 0xF, false); }
__device__ __forceinline__ int wave_isum_l63(int v) {
    v = dpp_iadd<0xB1>(v); v = dpp_iadd<0x4E>(v); v = dpp_iadd<0x141>(v); v = dpp_iadd<0x140>(v); v = dpp_iadd<0x142, 0xA>(v); v = dpp_iadd<0x143, 0xC>(v);
    return v;
}
template <int G>
__device__ __forceinline__ void ex_passA(const G4& R, const int (&hq)[4], int hinit, int& KK0, int& KK1, int lane) {
    int a[4];
#pragma unroll
    for (int i = 0; i < 4; ++i) {
        const unsigned x0 = R.r[i][0], x1 = R.r[i][1];
        a[i] = hinit;
        a[i] = __builtin_amdgcn_sdot4((int)(x0 & 0x0F0F0F0Fu), hq[0], a[i], false);
        a[i] = __builtin_amdgcn_sdot4((int)((x0 >> 4) & 0x0F0F0F0Fu), hq[1], a[i], false);
        a[i] = __builtin_amdgcn_sdot4((int)(x1 & 0x0F0F0F0Fu), hq[2], a[i], false);
        a[i] = __builtin_amdgcn_sdot4((int)((x1 >> 4) & 0x0F0F0F0Fu), hq[3], a[i], false);
    }
#pragma unroll
    for (int i = 0; i < 4; ++i) a[i] = dpp_iadd<0xB1>(a[i]);
#pragma unroll
    for (int i = 0; i < 4; ++i) a[i] = dpp_iadd<0x4E>(a[i]);
#pragma unroll
    for (int i = 0; i < 4; ++i) a[i] = dpp_iadd<0x141>(a[i]);
#pragma unroll
    for (int i = 0; i < 4; ++i) a[i] = dpp_iadd<0x140>(a[i]);
#pragma unroll
    for (int i = 0; i < 4; ++i) a[i] = dpp_iadd<0x142, 0xA>(a[i]);
#pragma unroll
    for (int i = 0; i < 4; ++i) a[i] = dpp_iadd<0x143, 0xC>(a[i]);
#pragma unroll
    for (int i = 0; i < 4; ++i) {
        const int tot = __builtin_amdgcn_readlane(a[i], 63);
        if (G < 16) KK0 = (lane == ((4 * G + i) & 63)) ? tot : KK0; else KK1 = (lane == ((4 * G + i) & 63)) ? tot : KK1;
    }
}
__device__ __forceinline__ void ex_passB(const G4& R, int cp, int (&yi)[16]) {
#pragma unroll
    for (int j = 0; j < 4; ++j) {
        const int sh4 = (j & 1) * 4;
        const unsigned A = (R.r[0][j >> 1] >> sh4) & 0x0F0F0F0Fu, B = (R.r[1][j >> 1] >> sh4) & 0x0F0F0F0Fu, C = (R.r[2][j >> 1] >> sh4) & 0x0F0F0F0Fu, D = (R.r[3][j >> 1] >> sh4) & 0x0F0F0F0Fu;
        const unsigned ablo = __builtin_amdgcn_perm(B, A, 0x05010400u), abhi = __builtin_amdgcn_perm(B, A, 0x07030602u);
        const unsigned cdlo = __builtin_amdgcn_perm(D, C, 0x05010400u), cdhi = __builtin_amdgcn_perm(D, C, 0x07030602u);
        const unsigned t0 = __builtin_amdgcn_perm(cdlo, ablo, 0x05040100u), t1 = __builtin_amdgcn_perm(cdlo, ablo, 0x07060302u);
        const unsigned t2 = __builtin_amdgcn_perm(cdhi, abhi, 0x05040100u), t3 = __builtin_amdgcn_perm(cdhi, abhi, 0x07060302u);
        yi[4 * j + 0] = __builtin_amdgcn_sdot4((int)t0, cp, yi[4 * j + 0], false);
        yi[4 * j + 1] = __builtin_amdgcn_sdot4((int)t1, cp, yi[4 * j + 1], false);
        yi[4 * j + 2] = __builtin_amdgcn_sdot4((int)t2, cp, yi[4 * j + 2], false);
        yi[4 * j + 3] = __builtin_amdgcn_sdot4((int)t3, cp, yi[4 * j + 3], false);
    }
}
__device__ __forceinline__ float wave_max(float v) {
#pragma unroll
    for (int o = 32; o > 0; o >>= 1) v = fmaxf(v, __shfl_xor(v, o, 64));
    return v;
}
__device__ __forceinline__ int quad_pack(int ci) {
    const int b = ci & 0xFF;
    const int d0 = __builtin_amdgcn_update_dpp(0, b, 0x00, 0xF, 0xF, false), d1 = __builtin_amdgcn_update_dpp(0, b, 0x55, 0xF, 0xF, false);
    const int d2 = __builtin_amdgcn_update_dpp(0, b, 0xAA, 0xF, 0xF, false), d3 = __builtin_amdgcn_update_dpp(0, b, 0xFF, 0xF, 0xF, false);
    return d0 | (d1 << 8) | (d2 << 16) | (d3 << 24);
}

__device__ __forceinline__ void ex_finish(const Params& p, int l, const bool LAST, int t, const float (&y)[16], int lane_) {
    const int lane = launder(lane_);
    const int c0 = lane * 16;
    const float* mb = p.mod() + ((size_t)l * BATCH + t / SEQ) * MODW;
    float xv[16];
#pragma unroll
    for (int q = 0; q < 4; ++q) {
        const f32x4 a = *(const f32x4*)(p.xb() + (size_t)t * D_MODEL + c0 + 4 * q), g2 = *(const f32x4*)(mb + 5 * D_MODEL + c0 + 4 * q);
#pragma unroll
        for (int e = 0; e < 4; ++e) xv[4 * q + e] = a[e] + g2[e] * y[4 * q + e];
    }
    float ss2 = 0.f;
#pragma unroll
    for (int e = 0; e < 16; ++e) ss2 += xv[e] * xv[e];
    const float rs2 = rsqrtf(wave_sum(ss2) * (1.0f / D_MODEL) + 1e-6f);
    if (LAST) {
#pragma unroll
        for (int q = 0; q < 4; ++q) {
            const int col = c0 + 4 * q;
            const f32x4 gv = *(const f32x4*)(p.final_g + col);
            f32x4 o;
#pragma unroll
            for (int e = 0; e < 4; ++e) o[e] = xv[4 * q + e] * rs2 * gv[e];
            *(f32x4*)(p.out + (size_t)t * D_MODEL + col) = o;
        }
    } else {
        const float* mn = p.mod() + ((size_t)(l + 1) * BATCH + t / SEQ) * MODW;
        const float* n1g = p.norm1_g + (l + 1) * D_MODEL;
        unsigned hw[8];
#pragma unroll
        for (int q = 0; q < 4; ++q) {
            const int col = c0 + 4 * q;
            f32x4 xo;
#pragma unroll
            for (int e = 0; e < 4; ++e) xo[e] = xv[4 * q + e];
            *(f32x4*)(p.xb() + (size_t)t * D_MODEL + col) = xo;
            const f32x4 gv = *(const f32x4*)(n1g + col), scv = *(const f32x4*)(mn + 1 * D_MODEL + col), shv = *(const f32x4*)(mn + 0 * D_MODEL + col);
            float h[4];
#pragma unroll
            for (int e = 0; e < 4; ++e) h[e] = xo[e] * rs2 * gv[e] * (1.0f + scv[e]) + shv[e];
            hw[2 * q] = pk2(h[0], h[1]); hw[2 * q + 1] = pk2(h[2], h[3]);
        }
        *(u32x4*)(p.hb() + (size_t)t * D_MODEL + c0) = (u32x4){hw[0], hw[1], hw[2], hw[3]};
        *(u32x4*)(p.hb() + (size_t)t * D_MODEL + c0 + 8) = (u32x4){hw[4], hw[5], hw[6], hw[7]};
    }
}


#define EXR 8
#define EXT (32 / EXR)
template <int S>
__device__ __forceinline__ void ex_turnA(G4 (&R)[EXR], const int (&hq)[4], int hinit, int& KK0, int& KK1, rsrc_t ru, rsrc_t rv, int e0, int e1, int voff, int lane, int emask) {
#define EX_A(s) ex_passA<EXR * S + s>(R[s], hq, hinit, KK0, KK1, lane); asm volatile("" ::: "memory"); if (S < EXT - 1) ex_issue<(EXR * S + s + EXR) & 31>(R[s], ru, e0, e1, voff, emask); else ex_issue<s>(R[s], rv, e0, e1, voff, emask); asm volatile("" ::: "memory");
    EX_A(0) EX_A(1) EX_A(2) EX_A(3)
#if EXR == 8
    EX_A(4) EX_A(5) EX_A(6) EX_A(7)
#endif
#undef EX_A
}
template <int S>
__device__ __forceinline__ void ex_turnB(G4 (&R)[EXR], int cpk0, int cpk1, int (&yi)[16], rsrc_t ru, rsrc_t rv, int e0, int e1, int e0n, int e1n, bool has_next, int voff, int emask) {
#define EX_B(s) ex_passB(R[s], __builtin_amdgcn_readlane((EXR * S + s) < 16 ? cpk0 : cpk1, (4 * (EXR * S + s)) & 63), yi); \
    asm volatile("" ::: "memory"); if (S < EXT - 1) ex_issue<(EXR * S + s + EXR) & 31>(R[s], rv, e0, e1, voff, emask); asm volatile("" ::: "memory");
    EX_B(0) EX_B(1) EX_B(2) EX_B(3)
#if EXR == 8
    EX_B(4) EX_B(5) EX_B(6) EX_B(7)
#endif
#undef EX_B
}

__device__ __forceinline__ void phase_expert(const Params& p, int l, const bool LAST, LAS unsigned char* lds, int wv, const int emask = 0x3FFF, const bool synth = false) {
    const int tid = tid_opaque(wv), wave = tid >> 6, lane = tid & 63;
    const rsrc_t ru = __builtin_amdgcn_make_buffer_rsrc((void*)(p.ub8() + (size_t)l * NEXP * ROWB), 0, NEXP * ROWB, 0x00020000);
    const rsrc_t rv = __builtin_amdgcn_make_buffer_rsrc((void*)(p.vb8() + (size_t)l * NEXP * ROWB), 0, NEXP * ROWB, 0x00020000);
    const float* uinv = p.uinv() + (size_t)l * NEXP;
    const float* vinv = p.vinv() + (size_t)l * NEXP;
    const int voff = lane * 8, c0 = lane * 16;
    const float* n2g = p.norm2_g + l * D_MODEL;
    const int tstep = gridDim.x * NWAVES;
    int t = blockIdx.x * NWAVES + wave;
    if (t >= NTOK) return;
    int e0 = p.eidx()[(size_t)t * 128 + lane], e1 = p.eidx()[(size_t)t * 128 + 64 + lane];
    for (; t < NTOK; t += tstep) {
        G4 R[EXR];
        ex_issue<0>(R[0], ru, e0, e1, voff, emask); ex_issue<1>(R[1], ru, e0, e1, voff, emask); ex_issue<2>(R[2], ru, e0, e1, voff, emask); ex_issue<3>(R[3], ru, e0, e1, voff, emask);
#if EXR == 8
        ex_issue<4>(R[4], ru, e0, e1, voff); ex_issue<5>(R[5], ru, e0, e1, voff); ex_issue<6>(R[6], ru, e0, e1, voff); ex_issue<7>(R[7], ru, e0, e1, voff);
#endif
        asm volatile("" ::: "memory");
        const bool has_next = (t + tstep) < NTOK;
        const int tn = has_next ? t + tstep : t;
        const int e0n = p.eidx()[(size_t)tn * 128 + lane], e1n = p.eidx()[(size_t)tn * 128 + 64 + lane];
        const float us0 = uinv[e0], us1 = uinv[e1];
        const float gv0 = p.egate()[(size_t)t * 128 + lane] * vinv[e0], gv1 = p.egate()[(size_t)t * 128 + 64 + lane] * vinv[e1];
        int hq[4]; float sh;
        {
            const float* mb = p.mod() + ((size_t)l * BATCH + t / SEQ) * MODW;
            f32x4 xq[4]; float ss = 0.f;
#pragma unroll
            for (int q = 0; q < 4; ++q) { xq[q] = *(const f32x4*)(p.xb() + (size_t)t * D_MODEL + c0 + 4 * q); ss += xq[q][0] * xq[q][0] + xq[q][1] * xq[q][1] + xq[q][2] * xq[q][2] + xq[q][3] * xq[q][3]; }
            const float rs = rsqrtf(wave_sum(ss) * (1.0f / D_MODEL) + 1e-6f);
            float hm = 0.f;
#pragma unroll
            for (int q = 0; q < 4; ++q) {
                const int col = c0 + 4 * q;
                const f32x4 gv = *(const f32x4*)(n2g + col), scv = *(const f32x4*)(mb + 4 * D_MODEL + col), shv = *(const f32x4*)(mb + 3 * D_MODEL + col);
#pragma unroll
                for (int e = 0; e < 4; ++e) { xq[q][e] = xq[q][e] * rs * gv[e] * (1.0f + scv[e]) + shv[e]; hm = fmaxf(hm, fabsf(xq[q][e])); }
            }
            hm = fmaxf(wave_max(hm), 1e-30f);
            const float qs = 127.0f / hm; sh = hm * (1.0f / 127.0f);
            int hb[16];
#pragma unroll
            for (int q = 0; q < 4; ++q)
#pragma unroll
                for (int e = 0; e < 4; ++e) hb[4 * q + e] = (int)rintf(xq[q][e] * qs);
#pragma unroll
            for (int j = 0; j < 4; ++j) {
                const int b0 = (j & 1) + 8 * (j >> 1);
                hq[j] = (hb[b0] & 0xFF) | ((hb[b0 + 2] & 0xFF) << 8) | ((hb[b0 + 4] & 0xFF) << 16) | (hb[b0 + 6] << 24);
            }
        }
        int hinit = 0;
#pragma unroll
        for (int j = 0; j < 4; ++j) hinit = __builtin_amdgcn_sdot4(hq[j], 0x01010101, hinit, false);
        hinit *= -8;
        int KK0 = 0, KK1 = 0;
        ex_turnA<0>(R, hq, hinit, KK0, KK1, ru, rv, e0, e1, voff, lane, emask); ex_turnA<1>(R, hq, hinit, KK0, KK1, ru, rv, e0, e1, voff, lane, emask);
        ex_turnA<2>(R, hq, hinit, KK0, KK1, ru, rv, e0, e1, voff, lane, emask); ex_turnA<3>(R, hq, hinit, KK0, KK1, ru, rv, e0, e1, voff, lane, emask);
#if EXR == 4
        ex_turnA<4>(R, hq, hinit, KK0, KK1, ru, rv, e0, e1, voff, lane, emask); ex_turnA<5>(R, hq, hinit, KK0, KK1, ru, rv, e0, e1, voff, lane, emask);
        ex_turnA<6>(R, hq, hinit, KK0, KK1, ru, rv, e0, e1, voff, lane, emask); ex_turnA<7>(R, hq, hinit, KK0, KK1, ru, rv, e0, e1, voff, lane, emask);
#endif
        const float cf0 = gelu_as((float)KK0 * (us0 * sh)) * gv0, cf1 = gelu_as((float)KK1 * (us1 * sh)) * gv1;
        const float cm = fmaxf(wave_max(fmaxf(fabsf(cf0), fabsf(cf1))), 1e-30f);
        const float cq = 127.0f / cm;
        const int cpk0 = quad_pack((int)rintf(cf0 * cq)), cpk1 = quad_pack((int)rintf(cf1 * cq));
        int yi[16];
#pragma unroll
        for (int e = 0; e < 16; ++e) yi[e] = 0;
        ex_turnB<0>(R, cpk0, cpk1, yi, ru, rv, e0, e1, e0n, e1n, has_next, voff, emask); ex_turnB<1>(R, cpk0, cpk1, yi, ru, rv, e0, e1, e0n, e1n, has_next, voff, emask);
        ex_turnB<2>(R, cpk0, cpk1, yi, ru, rv, e0, e1, e0n, e1n, has_next, voff, emask); ex_turnB<3>(R, cpk0, cpk1, yi, ru, rv, e0, e1, e0n, e1n, has_next, voff, emask);
#if EXR == 4
        ex_turnB<4>(R, cpk0, cpk1, yi, ru, rv, e0, e1, e0n, e1n, has_next, voff, emask); ex_turnB<5>(R, cpk0, cpk1, yi, ru, rv, e0, e1, e0n, e1n, has_next, voff, emask);
        ex_turnB<6>(R, cpk0, cpk1, yi, ru, rv, e0, e1, e0n, e1n, has_next, voff, emask); ex_turnB<7>(R, cpk0, cpk1, yi, ru, rv, e0, e1, e0n, e1n, has_next, voff, emask);
#endif
        const int ci0s = (int)rintf(cf0 * cq) + (int)rintf(cf1 * cq);
        const int csum8 = 8 * __builtin_amdgcn_readlane(wave_isum_l63(ci0s), 63);
        float y[16];
        const float ys = cm * (1.0f / 127.0f);
#pragma unroll
        for (int j = 0; j < 4; ++j)
#pragma unroll
            for (int e = 0; e < 4; ++e) y[(j & 1) + 2 * e + 8 * (j >> 1)] = (float)(yi[4 * j + e] - csum8) * ys;
        if (synth) {
#pragma unroll
            for (int q = 0; q < 4; ++q) *(f32x4*)((float*)p.qb() + (size_t)t * D_MODEL + c0 + 4 * q) = (f32x4){y[4 * q], y[4 * q + 1], y[4 * q + 2], y[4 * q + 3]};
        } else ex_finish(p, l, LAST, t, y, lane);
        e0 = e0n; e1 = e1n;
    }
}
#if MK_MULTI
__global__ void __launch_bounds__(512, 2) k_expert(Params p, int l) {
    extern __shared__ __attribute__((aligned(16))) unsigned char smem_raw[];
    phase_expert(p, l, l == DEPTH - 1, (LAS unsigned char*)smem_raw, __builtin_amdgcn_readfirstlane((int)threadIdx.x >> 6));
}
#endif
typedef short s16x4 __attribute__((ext_vector_type(4)));
#define AT_KSTR 144
#define AT_VSTR 192
#define AT_KBUF 0
#define AT_VBUF 18432
#define AT_TBL  43008
#define AT_OEX  44032
#define AT_OSTR 272

__device__ __forceinline__ void phase_attn(const Params& p, int l, LAS unsigned char* lds, int wv) {
    const int tid = tid_opaque(wv), wave = tid >> 6, lane = tid & 63;
    const int w4 = wave & 3, m = wave >> 2, c = lane & 31, h = lane >> 5;
    const float LOG2E = 1.4426950408889634f;
    const float qscale = 0.17677669529663687f * LOG2E;
    float d01 = 0.f, d23 = 0.f;
    { const float* lp = p.diff_lambda + l * 128;
      for (int i = 0; i < 32; ++i) { d01 += lp[i] * lp[32 + i]; d23 += lp[64 + i] * lp[96 + i]; } }
    const float lam_init = p.lam_init[l];
    const float lam = expf(d01) - expf(d23) + lam_init;
    const float osc = 1.0f - lam_init;
    LAS float* tbl = (LAS float*)(lds + AT_TBL);
    const int skey = tid >> 3, sch = tid & 7;
    const int g16 = lane >> 4, li = lane & 15, tq = li >> 2, tp = li & 3;

    for (int u = blockIdx.x; u < 256; u += gridDim.x) {
        const int pi = u & 7, hd = (u >> 3) & 3, b = u >> 5;
        if (tid < 256) { const int bk = tid < 128 ? (int)kBucket[tid] : 31; tbl[tid] = p.rel_bias[bk * 4 + hd] * LOG2E; }
        const float c31 = p.rel_bias[31 * 4 + hd] * LOG2E;
        const bf16_t* pbase = p.pb() + (size_t)b * SEQ * MIX_IN;
        const bf16_t* kg = pbase + (size_t)skey * MIX_IN + 256 + hd * 64 + sch * 8;
        const bf16_t* vg = pbase + (size_t)skey * MIX_IN + 512 + hd * 64 + sch * 8;
        for (int half = 0; half < 2; ++half) {
            const int qb = half ? 15 - pi : pi;
            const int q0w = qb * 128 + 32 * w4, nkt = 2 * qb + 2;
            const int qpos = q0w + c;
            bf16x8 qf0, qf1;
            { const bf16_t* qp = pbase + (size_t)qpos * MIX_IN + hd * 64 + m * 32 + 8 * h; qf0 = *(const bf16x8*)qp; qf1 = *(const bf16x8*)(qp + 16); }
            f32x16 O0, O1;
#pragma unroll
            for (int r = 0; r < 16; ++r) { O0[r] = 0.f; O1[r] = 0.f; }
            float mrun = -1e30f, lrun = 0.f;
            u32x4 kreg = *(const u32x4*)kg, vreg = *(const u32x4*)vg;
            *(LAS u32x4*)(lds + AT_KBUF + skey * AT_KSTR + sch * 16) = kreg;
            *(LAS u32x4*)(lds + AT_VBUF + skey * AT_VSTR + sch * 16) = vreg;
            __syncthreads();
            for (int kt = 0; kt < nkt; ++kt) {
                const int k0 = kt * 64, cur = kt & 1;
                if (kt + 1 < nkt) { kreg = *(const u32x4*)(kg + (size_t)(k0 + 64) * MIX_IN); vreg = *(const u32x4*)(vg + (size_t)(k0 + 64) * MIX_IN); }
                if (k0 <= q0w + 31) {
                    LAS unsigned char* kb_ = lds + AT_KBUF + cur * (64 * AT_KSTR);
                    LAS unsigned char* vb_ = lds + AT_VBUF + cur * (64 * AT_VSTR);
                    f32x16 s0, s1;
#pragma unroll
                    for (int r = 0; r < 16; ++r) { s0[r] = 0.f; s1[r] = 0.f; }
                    {
                        const LAS unsigned char* ka = kb_ + c * AT_KSTR + m * 64 + h * 16;
                        const bf16x8 a00 = *(const LAS bf16x8*)ka, a01 = *(const LAS bf16x8*)(ka + 32);
                        const bf16x8 a10 = *(const LAS bf16x8*)(ka + 32 * AT_KSTR), a11 = *(const LAS bf16x8*)(ka + 32 * AT_KSTR + 32);
                        s0 = __builtin_amdgcn_mfma_f32_32x32x16_bf16(a00, qf0, s0, 0, 0, 0);
                        s0 = __builtin_amdgcn_mfma_f32_32x32x16_bf16(a01, qf1, s0, 0, 0, 0);
                        s1 = __builtin_amdgcn_mfma_f32_32x32x16_bf16(a10, qf0, s1, 0, 0, 0);
                        s1 = __builtin_amdgcn_mfma_f32_32x32x16_bf16(a11, qf1, s1, 0, 0, 0);
                    }
                    const bool far = (q0w - (k0 + 63)) >= 113;
                    if (far) {
#pragma unroll
                        for (int r = 0; r < 16; ++r) { s0[r] = s0[r] * qscale + c31; s1[r] = s1[r] * qscale + c31; }
                    } else {
                        const int dbase = qpos - k0 - 4 * h;
#pragma unroll
                        for (int r = 0; r < 16; ++r) {
                            const int d0 = dbase - ((r & 3) + 8 * (r >> 2)), d1 = d0 - 32;
                            const float b0 = tbl[min(max(d0, 0), 255)], b1 = tbl[min(max(d1, 0), 255)];
                            const float v0 = s0[r] * qscale + b0, v1 = s1[r] * qscale + b1;
                            s0[r] = d0 < 0 ? -1e30f : v0; s1[r] = d1 < 0 ? -1e30f : v1;
                        }
                    }
                    float tmax = fmaxf(s0[0], s1[0]);
#pragma unroll
                    for (int r = 1; r < 16; ++r) tmax = fmaxf(tmax, fmaxf(s0[r], s1[r]));
                    tmax = fmaxf(tmax, __shfl_xor(tmax, 32, 64));
                    const float mnew = fmaxf(mrun, tmax);
                    const float alpha = __builtin_amdgcn_exp2f(mrun - mnew);
                    mrun = mnew;
                    float psum = 0.f;
#pragma unroll
                    for (int r = 0; r < 16; ++r) { s0[r] = __builtin_amdgcn_exp2f(s0[r] - mnew); s1[r] = __builtin_amdgcn_exp2f(s1[r] - mnew); psum += s0[r] + s1[r]; }
                    lrun = lrun * alpha + psum;
#pragma unroll
                    for (int r = 0; r < 16; ++r) { O0[r] *= alpha; O1[r] *= alpha; }
#pragma unroll
                    for (int kb = 0; kb < 2; ++kb)
#pragma unroll
                        for (int sp = 0; sp < 2; ++sp) {
                            u32x4 pw;
                            if (kb == 0) { pw.x = pk2(s0[8 * sp + 0], s0[8 * sp + 1]); pw.y = pk2(s0[8 * sp + 2], s0[8 * sp + 3]); pw.z = pk2(s0[8 * sp + 4], s0[8 * sp + 5]); pw.w = pk2(s0[8 * sp + 6], s0[8 * sp + 7]); }
                            else         { pw.x = pk2(s1[8 * sp + 0], s1[8 * sp + 1]); pw.y = pk2(s1[8 * sp + 2], s1[8 * sp + 3]); pw.z = pk2(s1[8 * sp + 4], s1[8 * sp + 5]); pw.w = pk2(s1[8 * sp + 6], s1[8 * sp + 7]); }
                            const bf16x8 pf = __builtin_bit_cast(bf16x8, pw);
                            const int kA = 32 * kb + 16 * sp + 4 * h;
#pragma unroll
                            for (int mb = 0; mb < 2; ++mb) {
                                LAS unsigned char* va = vb_ + (kA + tq) * AT_VSTR + (32 * mb + 16 * (g16 & 1) + 4 * tp) * 2;
                                const s16x4 t0 = __builtin_amdgcn_ds_read_tr16_b64_v4i16((LAS s16x4*)va);
                                const s16x4 t1 = __builtin_amdgcn_ds_read_tr16_b64_v4i16((LAS s16x4*)(va + 8 * AT_VSTR));
                                const bf16x8 vf = {t0[0], t0[1], t0[2], t0[3], t1[0], t1[1], t1[2], t1[3]};
                                if (mb == 0) O0 = __builtin_amdgcn_mfma_f32_32x32x16_bf16(vf, pf, O0, 0, 0, 0);
                                else         O1 = __builtin_amdgcn_mfma_f32_32x32x16_bf16(vf, pf, O1, 0, 0, 0);
                            }
                        }
                }
                if (kt + 1 < nkt) {
                    *(LAS u32x4*)(lds + AT_KBUF + (cur ^ 1) * (64 * AT_KSTR) + skey * AT_KSTR + sch * 16) = kreg;
                    *(LAS u32x4*)(lds + AT_VBUF + (cur ^ 1) * (64 * AT_VSTR) + skey * AT_VSTR + sch * 16) = vreg;
                }
                __syncthreads();
            }
            const float inv = 1.0f / (lrun + __shfl_xor(lrun, 32, 64));
            LAS unsigned char* oex = lds + AT_OEX + (32 * w4 + c) * AT_OSTR + 16 * h;
            if (m == 1) {
#pragma unroll
                for (int r4 = 0; r4 < 4; ++r4) {
                    f32x4 a, bq;
#pragma unroll
                    for (int e = 0; e < 4; ++e) { a[e] = O0[4 * r4 + e] * inv; bq[e] = O1[4 * r4 + e] * inv; }
                    *(LAS f32x4*)(oex + (8 * r4) * 4) = a;
                    *(LAS f32x4*)(oex + (32 + 8 * r4) * 4) = bq;
                }
            }
            __syncthreads();
            if (m == 0) {
                float ss = 0.f;
#pragma unroll
                for (int r4 = 0; r4 < 4; ++r4) {
                    const f32x4 a = *(const LAS f32x4*)(oex + (8 * r4) * 4), bq = *(const LAS f32x4*)(oex + (32 + 8 * r4) * 4);
#pragma unroll
                    for (int e = 0; e < 4; ++e) {
                        O0[4 * r4 + e] = O0[4 * r4 + e] * inv - lam * a[e]; O1[4 * r4 + e] = O1[4 * r4 + e] * inv - lam * bq[e];
                        ss += O0[4 * r4 + e] * O0[4 * r4 + e] + O1[4 * r4 + e] * O1[4 * r4 + e];
                    }
                }
                ss += __shfl_xor(ss, 32, 64);
                const float rstd = rsqrtf(ss * (1.0f / 64.0f) + 1e-6f) * osc;
                bf16_t* orow = p.cat() + (size_t)(b * SEQ + qpos) * D_MODEL + hd * 64 + 4 * h;
                const float* sg = p.subln_g + l * 64 + 4 * h;
#pragma unroll
                for (int r4 = 0; r4 < 4; ++r4) {
                    const f32x4 ga = *(const f32x4*)(sg + 8 * r4), gb = *(const f32x4*)(sg + 32 + 8 * r4);
                    u32x2 oa, ob;
                    oa.x = pk2(O0[4 * r4 + 0] * rstd * ga[0], O0[4 * r4 + 1] * rstd * ga[1]); oa.y = pk2(O0[4 * r4 + 2] * rstd * ga[2], O0[4 * r4 + 3] * rstd * ga[3]);
                    ob.x = pk2(O1[4 * r4 + 0] * rstd * gb[0], O1[4 * r4 + 1] * rstd * gb[1]); ob.y = pk2(O1[4 * r4 + 2] * rstd * gb[2], O1[4 * r4 + 3] * rstd * gb[3]);
                    *(u32x2*)(orow + 8 * r4) = oa;
                    *(u32x2*)(orow + 32 + 8 * r4) = ob;
                }
            }
            __syncthreads();
        }
    }
}
#if MK_MULTI
template <int DUMMY>
__global__ void __launch_bounds__(512, 2) k_attn2(Params p, int l) {
    extern __shared__ __attribute__((aligned(16))) unsigned char smem_raw[];
    phase_attn(p, l, (LAS unsigned char*)smem_raw, __builtin_amdgcn_readfirstlane((int)threadIdx.x >> 6));
}
#endif
#define MR_VSTR 272

__device__ __forceinline__ void mixrest_conv(const Params& p, int l, int chunk, LAS unsigned char* lds, int wv) {
    const int tid = tid_opaque(wv), wave = tid >> 6, lane = tid & 63;
    const int t0 = chunk * 128, s0 = t0 % SEQ;
    LAS float* glu = (LAS float*)lds;
    const int c = tid & 255, th = tid >> 8;
    float w[31];
#pragma unroll
    for (int j = 0; j < 31; ++j) w[j] = p.conf_dw[((size_t)l * 31 + j) * 256 + c];
    for (int hf = 0; hf < 2; ++hf) {
        const int tb = t0 + hf * 64;
        for (int it = tid; it < 94 * 32; it += 512) {
            const int i = it >> 5, c8 = (it & 31) * 8;
            const int sp = s0 + hf * 64 - 30 + i;
            f32x4 o0 = {0.f, 0.f, 0.f, 0.f}, o1 = {0.f, 0.f, 0.f, 0.f};
            if (sp >= 0) {
                const bf16_t* pr = p.pb() + (size_t)(tb - 30 + i) * MIX_IN;
                const u32x4 a = *(const u32x4*)(pr + 3 * 256 + c8), g = *(const u32x4*)(pr + 4 * 256 + c8);
                o0[0] = bflo(a.x) * sigmoidf_(bflo(g.x)); o0[1] = bfhi(a.x) * sigmoidf_(bfhi(g.x));
                o0[2] = bflo(a.y) * sigmoidf_(bflo(g.y)); o0[3] = bfhi(a.y) * sigmoidf_(bfhi(g.y));
                o1[0] = bflo(a.z) * sigmoidf_(bflo(g.z)); o1[1] = bfhi(a.z) * sigmoidf_(bfhi(g.z));
                o1[2] = bflo(a.w) * sigmoidf_(bflo(g.w)); o1[3] = bfhi(a.w) * sigmoidf_(bfhi(g.w));
            }
            *(LAS f32x4*)(glu + i * 256 + c8) = o0; *(LAS f32x4*)(glu + i * 256 + c8 + 4) = o1;
        }
        __syncthreads();
        float acc[32];
#pragma unroll
        for (int o = 0; o < 32; ++o) acc[o] = 0.f;
#pragma unroll
        for (int i = 0; i < 62; ++i) {
            const float xval = glu[(th * 32 + i) * 256 + c];
#pragma unroll
            for (int o = 0; o < 32; ++o) if (i - o >= 0 && i - o <= 30) acc[o] += w[i - o] * xval;
        }
        __syncthreads();
#pragma unroll
        for (int o = 0; o < 32; ++o) glu[(th * 32 + o) * 256 + c] = acc[o];
        __syncthreads();
        const f32x4 lg = *(const f32x4*)(p.conf_ln_g + l * 256 + lane * 4), lb = *(const f32x4*)(p.conf_ln_b + l * 256 + lane * 4);
        for (int k = 0; k < 8; ++k) {
            const int tk = wave * 8 + k;
            const f32x4 z = *(const LAS f32x4*)(glu + tk * 256 + lane * 4);
            const float mu = wave_sum(z[0] + z[1] + z[2] + z[3]) * (1.0f / 256.0f);
            f32x4 dz; float sq = 0.f;
#pragma unroll
            for (int e = 0; e < 4; ++e) { dz[e] = z[e] - mu; sq += dz[e] * dz[e]; }
            const float rstd = rsqrtf(wave_sum(sq) * (1.0f / 256.0f) + 1e-6f);
            float y[4];
#pragma unroll
            for (int e = 0; e < 4; ++e) { const float v = dz[e] * rstd * lg[e] + lb[e]; y[e] = v * sigmoidf_(v); }
            u32x2 o; o.x = pk2(y[0], y[1]); o.y = pk2(y[2], y[3]);
            *(u32x2*)(p.cat() + (size_t)(tb + tk) * D_MODEL + 256 + lane * 4) = o;
        }
        __syncthreads();
    }
}

__device__ __forceinline__ void mixrest_sgu(const Params& p, int l, int chunk, LAS unsigned char* lds, int wv) {
    const int tid = tid_opaque(wv), wave = tid >> 6, lane = tid & 63;
    const int t0 = chunk * 128, s0 = t0 % SEQ;
    {
        const float* sw = p.sconv_w + (size_t)l * 3 * 256;
        for (int it = tid; it < 128 * 32; it += 512) {
            const int tt = it >> 5, c8 = (it & 31) * 8;
            const bf16_t* pr = p.pb() + (size_t)(t0 + tt) * MIX_IN;
            float z[8];
#pragma unroll
            for (int e = 0; e < 8; ++e) z[e] = 0.f;
#pragma unroll
            for (int j = 0; j < 3; ++j) {
                if (s0 + tt - 2 + j >= 0) {
                    const bf16_t* q = pr + (ptrdiff_t)(j - 2) * MIX_IN;
                    const u32x4 a = *(const u32x4*)(q + 6 * 256 + c8), bq = *(const u32x4*)(q + 7 * 256 + c8);
                    const f32x4 w0 = *(const f32x4*)(sw + j * 256 + c8), w1 = *(const f32x4*)(sw + j * 256 + c8 + 4);
                    z[0] += w0[0] * bflo(a.x) * bflo(bq.x); z[1] += w0[1] * bfhi(a.x) * bfhi(bq.x);
                    z[2] += w0[2] * bflo(a.y) * bflo(bq.y); z[3] += w0[3] * bfhi(a.y) * bfhi(bq.y);
                    z[4] += w1[0] * bflo(a.z) * bflo(bq.z); z[5] += w1[1] * bfhi(a.z) * bfhi(bq.z);
                    z[6] += w1[2] * bflo(a.w) * bflo(bq.w); z[7] += w1[3] * bfhi(a.w) * bfhi(bq.w);
                }
            }
            const u32x4 cb = *(const u32x4*)(pr + 5 * 256 + c8);
            u32x4 o;
            o.x = pk2(bflo(cb.x) * z[0], bfhi(cb.x) * z[1]); o.y = pk2(bflo(cb.y) * z[2], bfhi(cb.y) * z[3]);
            o.z = pk2(bflo(cb.z) * z[4], bfhi(cb.z) * z[5]); o.w = pk2(bflo(cb.w) * z[6], bfhi(cb.w) * z[7]);
            *(u32x4*)(p.cat() + (size_t)(t0 + tt) * D_MODEL + 512 + c8) = o;
        }
    }
    {
        const f32x4 lg = *(const f32x4*)(p.sgu_ln_g + l * 256 + lane * 4), lb = *(const f32x4*)(p.sgu_ln_b + l * 256 + lane * 4);
        for (int k = 0; k < 16; ++k) {
            const int s = wave * 16 + k;
            const u32x2 raw = *(const u32x2*)(p.pb() + (size_t)(t0 + s) * MIX_IN + 9 * 256 + lane * 4);
            float v[4] = {gelu_exact(bflo(raw.x)), gelu_exact(bfhi(raw.x)), gelu_exact(bflo(raw.y)), gelu_exact(bfhi(raw.y))};
            const float mu = wave_sum(v[0] + v[1] + v[2] + v[3]) * (1.0f / 256.0f);
            float sq = 0.f;
#pragma unroll
            for (int e = 0; e < 4; ++e) { v[e] -= mu; sq += v[e] * v[e]; }
            const float rstd = rsqrtf(wave_sum(sq) * (1.0f / 256.0f) + 1e-6f);
#pragma unroll
            for (int e = 0; e < 4; ++e) *(LAS bf16_t*)(lds + (lane * 4 + e) * MR_VSTR + s * 2) = f2bf(v[e] * rstd * lg[e] + lb[e]);
        }
    }
    __syncthreads();
    {
        const int hq = wave & 3, mb = wave >> 2, c = lane & 31, hh = lane >> 5;
        bf16x8 af[8];
#pragma unroll
        for (int ks = 0; ks < 8; ++ks) af[ks] = *(const LAS bf16x8*)(lds + (hq * 64 + mb * 32 + c) * MR_VSTR + (16 * ks + 8 * hh) * 2);
        const bf16_t* wb = p.sguwb() + ((size_t)(l * 4 + hq) * 128) * 128;
        f32x16 acc[4];
#pragma unroll
        for (int nb = 0; nb < 4; ++nb) {
#pragma unroll
            for (int r = 0; r < 16; ++r) acc[nb][r] = 0.f;
#pragma unroll
            for (int ks = 0; ks < 2 * nb + 2; ++ks) {
                const bf16x8 bfrag = *(const bf16x8*)(wb + (size_t)(32 * nb + c) * 128 + 16 * ks + 8 * hh);
                acc[nb] = __builtin_amdgcn_mfma_f32_32x32x16_bf16(af[ks], bfrag, acc[nb], 0, 0, 0);
            }
        }
        const float* bs = p.sgu_b + (size_t)(l * 4 + hq) * 128;
#pragma unroll
        for (int nb = 0; nb < 4; ++nb) {
            const int tt = 32 * nb + c;
            const float bias = bs[tt];
            const bf16_t* su = p.pb() + (size_t)(t0 + tt) * MIX_IN + 8 * 256 + hq * 64 + mb * 32 + 4 * hh;
            bf16_t* orow = p.cat() + (size_t)(t0 + tt) * D_MODEL + 768 + hq * 64 + mb * 32 + 4 * hh;
#pragma unroll
            for (int r4 = 0; r4 < 4; ++r4) {
                const u32x2 raw = *(const u32x2*)(su + 8 * r4);
                u32x2 o;
                o.x = pk2(gelu_exact(bflo(raw.x)) * (acc[nb][4 * r4 + 0] + bias), gelu_exact(bfhi(raw.x)) * (acc[nb][4 * r4 + 1] + bias));
                o.y = pk2(gelu_exact(bflo(raw.y)) * (acc[nb][4 * r4 + 2] + bias), gelu_exact(bfhi(raw.y)) * (acc[nb][4 * r4 + 3] + bias));
                *(u32x2*)(orow + 8 * r4) = o;
            }
        }
    }
    __syncthreads();
}

__device__ __forceinline__ void phase_mixrest(const Params& p, int l, LAS unsigned char* lds, int wv) {
    for (int u = blockIdx.x; u < 256; u += gridDim.x) {
        const int chunk = u >> 1;
        if (u & 1) mixrest_sgu(p, l, chunk, lds, wv); else mixrest_conv(p, l, chunk, lds, wv);
    }
}
#if MK_MULTI
template <int DUMMY>
__global__ void __launch_bounds__(512, 2) k_mixrest(Params p, int l) {
    extern __shared__ __attribute__((aligned(16))) unsigned char smem_raw[];
    phase_mixrest(p, l, (LAS unsigned char*)smem_raw, __builtin_amdgcn_readfirstlane((int)threadIdx.x >> 6));
}
#endif
__device__ __forceinline__ int f2sortable(float f) { const int x = __float_as_int(f); return x ^ ((x >> 31) & 0x7FFFFFFF); }
__device__ __forceinline__ float sortable2f(int s) { return __int_as_float(s ^ ((s >> 31) & 0x7FFFFFFF)); }

template <int N>
__device__ __forceinline__ void bitonic_sort_desc(int (&a)[N]) {
#pragma unroll
    for (int k = 2; k <= N; k <<= 1)
#pragma unroll
        for (int j = k >> 1; j > 0; j >>= 1)
#pragma unroll
            for (int i = 0; i < N; ++i) {
                const int q = i ^ j;
                if (q > i) {
                    const int hi = max(a[i], a[q]), lo = min(a[i], a[q]);
                    if ((i & k) == 0 || k == N) { a[i] = hi; a[q] = lo; } else { a[i] = lo; a[q] = hi; }
                }
            }
}
__device__ __forceinline__ void bitonic_merge_desc16(int (&a)[16]) {
#pragma unroll
    for (int j = 8; j > 0; j >>= 1)
#pragma unroll
        for (int i = 0; i < 16; ++i) {
            const int q = i ^ j;
            if (q > i) { const int hi = max(a[i], a[q]), lo = min(a[i], a[q]); a[i] = hi; a[q] = lo; }
        }
}
__device__ __forceinline__ void merge_top16(int (&a)[16], const int (&b)[16]) {
#pragma unroll
    for (int i = 0; i < 16; ++i) a[i] = max(a[i], b[15 - i]);
    bitonic_merge_desc16(a);
}

__device__ __forceinline__ void phase_topk(const Params& p, int l, LAS unsigned char* lds, int wv) {
    const int tid = tid_opaque(wv), wave = __builtin_amdgcn_readfirstlane(tid >> 6), lane = tid & 63, c = lane & 31, hh = lane >> 5;
    const int hd = wave;
    LAS unsigned char* ilist = lds + wave * 1024 + c * 32;
    const int hx = hh << 2;
    const __amdgpu_buffer_rsrc_t rq = __builtin_amdgcn_make_buffer_rsrc((void*)p.qb(), 0, NTOK * 2048 * 2, 0x00020000);
    const __amdgpu_buffer_rsrc_t rk = __builtin_amdgcn_make_buffer_rsrc((void*)(p.keysb() + (size_t)l * 16 * 128 * 128), 0, 16 * 128 * 128 * 2, 0x00020000);
    const int qvoff = c * 4096 + hh * 16, kvoff = c * 256 + hh * 16;
    for (int u = blockIdx.x; u < NTOK / 32; u += gridDim.x) {
        const int t = u * 32 + c;
        int S0[16], S1[16];
#pragma unroll
        for (int pp = 0; pp < 2; ++pp) {
            bf16x8 qf[8];
            {
                const int qso = (u * 32) * 4096 + hd * 512 + pp * 256;
#pragma unroll
                for (int ks = 0; ks < 8; ++ks) qf[ks] = __builtin_bit_cast(bf16x8, __builtin_amdgcn_raw_buffer_load_b128(rq, qvoff + 32 * ks, qso, 0));
            }
            const int kso = ((hd * 2 + pp) * 128) * 256;
            int K0[16], K1[16], K2[16], K3[16];
#pragma unroll
            for (int kb = 0; kb < 4; ++kb) {
                asm volatile("" ::: "memory");
                f32x16 acc;
#pragma unroll
                for (int r = 0; r < 16; ++r) acc[r] = 0.f;
#pragma unroll
                for (int ks = 0; ks < 8; ++ks) {
                    const bf16x8 a = __builtin_bit_cast(bf16x8, __builtin_amdgcn_raw_buffer_load_b128(rk, kvoff + 32 * ks, kso + (32 * kb) * 256, 0));
                    acc = __builtin_amdgcn_mfma_f32_32x32x16_bf16(a, qf[ks], acc, 0, 0, 0);
                }
#pragma unroll
                for (int r = 0; r < 16; ++r) {
                    const int nconst = 32 * kb + (r & 3) + 8 * (r >> 2);
                    const int key = (f2sortable(acc[r]) & ~0x7F) | (127 - nconst);
                    if (kb == 0) K0[r] = key; else if (kb == 1) K1[r] = key; else if (kb == 2) K2[r] = key; else K3[r] = key;
                }
            }
            bitonic_sort_desc<16>(K0); bitonic_sort_desc<16>(K1); bitonic_sort_desc<16>(K2); bitonic_sort_desc<16>(K3);
            merge_top16(K0, K1); merge_top16(K2, K3); merge_top16(K0, K2);
            int P[16];
#pragma unroll
            for (int i = 0; i < 16; ++i) { K0[i] ^= hx; P[i] = __shfl_xor(K0[i], 32, 64); }
            merge_top16(K0, P);
#pragma unroll
            for (int i = 0; i < 16; ++i) { if (pp == 0) S0[i] = K0[i]; else S1[i] = K0[i]; }
        }
        {
            unsigned w4[4];
#pragma unroll
            for (int q = 0; q < 4; ++q) {
                unsigned w = 0;
#pragma unroll
                for (int e = 0; e < 4; ++e) { const int sv = hh ? S1[4 * q + e] : S0[4 * q + e]; w |= (unsigned)(127 - (sv & 127)) << (8 * e); }
                w4[q] = w;
            }
            u32x4 wv; wv.x = w4[0]; wv.y = w4[1]; wv.z = w4[2]; wv.w = w4[3];
            *(LAS u32x4*)(ilist + 16 * hh) = wv;
        }
        float a[16], b[16];
#pragma unroll
        for (int i = 0; i < 16; ++i) {
            const float f1 = sortable2f(S0[i] & ~0x7F), f2 = sortable2f(S1[i] & ~0x7F);
            a[i] = hh ? f2 : f1; b[i] = hh ? f1 : f2;
        }
        int CA[16], CB[16];
        const int org = hh << 8;
        {
            int n = 0;
#pragma unroll
            for (int i = 0; i < 4; ++i)
#pragma unroll
                for (int j = i; j < 16; ++j) {
                    if ((i + 1) * (j + 1) <= 16) {
                        int key = (f2sortable(a[i] + b[j]) & ~0x1FF) | org | (i * 16 + j);
                        if (i == j) key = hh ? (int)0x80000000 : key;
                        if (n < 16) CA[n] = key; else CB[n - 16] = key;
                        ++n;
                    }
                }
#pragma unroll
            for (int q = 27; q < 32; ++q) CB[q - 16] = (int)0x80000000;
        }
        bitonic_sort_desc<16>(CA); bitonic_sort_desc<16>(CB);
        merge_top16(CA, CB);
        int F[16], PF[16];
#pragma unroll
        for (int i = 0; i < 16; ++i) PF[i] = __shfl_xor(CA[i], 32, 64);
#pragma unroll
        for (int i = 0; i < 16; ++i) F[i] = max(CA[i], PF[15 - i]);
        int mxk = F[0];
#pragma unroll
        for (int i = 1; i < 16; ++i) mxk = max(mxk, F[i]);
        const float vmax = sortable2f(mxk & ~0x1FF);
        float e[8], psum = 0.f;
#pragma unroll
        for (int i = 0; i < 8; ++i) { e[i] = __expf(sortable2f(F[i] & ~0x1FF) - vmax); psum += e[i]; }
        const float inv = 1.0f / (psum + __shfl_xor(psum, 32, 64));
        asm volatile("s_waitcnt lgkmcnt(0)" ::: "memory");
        int ex[8];
#pragma unroll
        for (int i = 0; i < 8; ++i) {
            const int low = F[i] & 0x1FF, o = low >> 8, il = (low >> 4) & 15, jl = low & 15;
            const int ri = o ? jl : il, rj = o ? il : jl;
            const int i1 = (int)*(const LAS unsigned char*)(ilist + ri), i2 = (int)*(const LAS unsigned char*)(ilist + 16 + rj);
            ex[i] = i1 * 128 + i2;
        }
        int* ep = p.eidx() + ((size_t)t * 8 + hd) * 16 + hh * 8;
        float* gp = p.egate() + ((size_t)t * 8 + hd) * 16 + hh * 8;
        *(u32x4*)ep = (u32x4){(unsigned)ex[0], (unsigned)ex[1], (unsigned)ex[2], (unsigned)ex[3]};
        *(u32x4*)(ep + 4) = (u32x4){(unsigned)ex[4], (unsigned)ex[5], (unsigned)ex[6], (unsigned)ex[7]};
        *(f32x4*)gp = (f32x4){e[0] * inv, e[1] * inv, e[2] * inv, e[3] * inv};
        *(f32x4*)(gp + 4) = (f32x4){e[4] * inv, e[5] * inv, e[6] * inv, e[7] * inv};
        asm volatile("s_waitcnt lgkmcnt(0)" ::: "memory");
    }
}
#if MK_MULTI
template <int DUMMY>
__global__ void __launch_bounds__(512, 2) k_topk(Params p, int l) {
    extern __shared__ __attribute__((aligned(16))) unsigned char smem_raw[];
    phase_topk(p, l, (LAS unsigned char*)smem_raw, __builtin_amdgcn_readfirstlane((int)threadIdx.x >> 6));
}
#endif
#if PROBE_UB
__device__ __forceinline__ void ubench(int iters, unsigned seed) {
    float r[16]; f32x2 r2[8];
#pragma unroll
    for (int i = 0; i < 16; ++i) r[i] = __uint_as_float(seed + i);
#pragma unroll
    for (int i = 0; i < 8; ++i) r2[i] = (f32x2){r[2 * i], r[2 * i + 1]};
    float a = __uint_as_float(seed * 3u + 1u), b = __uint_as_float(seed * 5u + 7u);
    for (int it = 0; it < iters; ++it) {
#if PROBE_UB == 1
        asm volatile("v_fma_f32 %0, %16, %17, %0\n\tv_fma_f32 %1, %16, %17, %1\n\tv_fma_f32 %2, %16, %17, %2\n\tv_fma_f32 %3, %16, %17, %3\n\tv_fma_f32 %4, %16, %17, %4\n\tv_fma_f32 %5, %16, %17, %5\n\tv_fma_f32 %6, %16, %17, %6\n\tv_fma_f32 %7, %16, %17, %7\n\tv_fma_f32 %8, %16, %17, %8\n\tv_fma_f32 %9, %16, %17, %9\n\tv_fma_f32 %10, %16, %17, %10\n\tv_fma_f32 %11, %16, %17, %11\n\tv_fma_f32 %12, %16, %17, %12\n\tv_fma_f32 %13, %16, %17, %13\n\tv_fma_f32 %14, %16, %17, %14\n\tv_fma_f32 %15, %16, %17, %15\n\t" : "+v"(r[0]), "+v"(r[1]), "+v"(r[2]), "+v"(r[3]), "+v"(r[4]), "+v"(r[5]), "+v"(r[6]), "+v"(r[7]), "+v"(r[8]), "+v"(r[9]), "+v"(r[10]), "+v"(r[11]), "+v"(r[12]), "+v"(r[13]), "+v"(r[14]), "+v"(r[15]) : "v"(a), "v"(b) : "s40", "vcc");
        asm volatile("v_fma_f32 %0, %16, %17, %0\n\tv_fma_f32 %1, %16, %17, %1\n\tv_fma_f32 %2, %16, %17, %2\n\tv_fma_f32 %3, %16, %17, %3\n\tv_fma_f32 %4, %16, %17, %4\n\tv_fma_f32 %5, %16, %17, %5\n\tv_fma_f32 %6, %16, %17, %6\n\tv_fma_f32 %7, %16, %17, %7\n\tv_fma_f32 %8, %16, %17, %8\n\tv_fma_f32 %9, %16, %17, %9\n\tv_fma_f32 %10, %16, %17, %10\n\tv_fma_f32 %11, %16, %17, %11\n\tv_fma_f32 %12, %16, %17, %12\n\tv_fma_f32 %13, %16, %17, %13\n\tv_fma_f32 %14, %16, %17, %14\n\tv_fma_f32 %15, %16, %17, %15\n\t" : "+v"(r[0]), "+v"(r[1]), "+v"(r[2]), "+v"(r[3]), "+v"(r[4]), "+v"(r[5]), "+v"(r[6]), "+v"(r[7]), "+v"(r[8]), "+v"(r[9]), "+v"(r[10]), "+v"(r[11]), "+v"(r[12]), "+v"(r[13]), "+v"(r[14]), "+v"(r[15]) : "v"(a), "v"(b) : "s40", "vcc");
#endif
#if PROBE_UB == 2
        asm volatile("v_dot4c_i32_i8 %0, %16, %17\n\tv_dot4c_i32_i8 %1, %16, %17\n\tv_dot4c_i32_i8 %2, %16, %17\n\tv_dot4c_i32_i8 %3, %16, %17\n\tv_dot4c_i32_i8 %4, %16, %17\n\tv_dot4c_i32_i8 %5, %16, %17\n\tv_dot4c_i32_i8 %6, %16, %17\n\tv_dot4c_i32_i8 %7, %16, %17\n\tv_dot4c_i32_i8 %8, %16, %17\n\tv_dot4c_i32_i8 %9, %16, %17\n\tv_dot4c_i32_i8 %10, %16, %17\n\tv_dot4c_i32_i8 %11, %16, %17\n\tv_dot4c_i32_i8 %12, %16, %17\n\tv_dot4c_i32_i8 %13, %16, %17\n\tv_dot4c_i32_i8 %14, %16, %17\n\tv_dot4c_i32_i8 %15, %16, %17\n\t" : "+v"(r[0]), "+v"(r[1]), "+v"(r[2]), "+v"(r[3]), "+v"(r[4]), "+v"(r[5]), "+v"(r[6]), "+v"(r[7]), "+v"(r[8]), "+v"(r[9]), "+v"(r[10]), "+v"(r[11]), "+v"(r[12]), "+v"(r[13]), "+v"(r[14]), "+v"(r[15]) : "v"(a), "v"(b) : "s40", "vcc");
        asm volatile("v_dot4c_i32_i8 %0, %16, %17\n\tv_dot4c_i32_i8 %1, %16, %17\n\tv_dot4c_i32_i8 %2, %16, %17\n\tv_dot4c_i32_i8 %3, %16, %17\n\tv_dot4c_i32_i8 %4, %16, %17\n\tv_dot4c_i32_i8 %5, %16, %17\n\tv_dot4c_i32_i8 %6, %16, %17\n\tv_dot4c_i32_i8 %7, %16, %17\n\tv_dot4c_i32_i8 %8, %16, %17\n\tv_dot4c_i32_i8 %9, %16, %17\n\tv_dot4c_i32_i8 %10, %16, %17\n\tv_dot4c_i32_i8 %11, %16, %17\n\tv_dot4c_i32_i8 %12, %16, %17\n\tv_dot4c_i32_i8 %13, %16, %17\n\tv_dot4c_i32_i8 %14, %16, %17\n\tv_dot4c_i32_i8 %15, %16, %17\n\t" : "+v"(r[0]), "+v"(r[1]), "+v"(r[2]), "+v"(r[3]), "+v"(r[4]), "+v"(r[5]), "+v"(r[6]), "+v"(r[7]), "+v"(r[8]), "+v"(r[9]), "+v"(r[10]), "+v"(r[11]), "+v"(r[12]), "+v"(r[13]), "+v"(r[14]), "+v"(r[15]) : "v"(a), "v"(b) : "s40", "vcc");
#endif
#if PROBE_UB == 3
        asm volatile("v_perm_b32 %0, %0, %16, %17\n\tv_perm_b32 %1, %1, %16, %17\n\tv_perm_b32 %2, %2, %16, %17\n\tv_perm_b32 %3, %3, %16, %17\n\tv_perm_b32 %4, %4, %16, %17\n\tv_perm_b32 %5, %5, %16, %17\n\tv_perm_b32 %6, %6, %16, %17\n\tv_perm_b32 %7, %7, %16, %17\n\tv_perm_b32 %8, %8, %16, %17\n\tv_perm_b32 %9, %9, %16, %17\n\tv_perm_b32 %10, %10, %16, %17\n\tv_perm_b32 %11, %11, %16, %17\n\tv_perm_b32 %12, %12, %16, %17\n\tv_perm_b32 %13, %13, %16, %17\n\tv_perm_b32 %14, %14, %16, %17\n\tv_perm_b32 %15, %15, %16, %17\n\t" : "+v"(r[0]), "+v"(r[1]), "+v"(r[2]), "+v"(r[3]), "+v"(r[4]), "+v"(r[5]), "+v"(r[6]), "+v"(r[7]), "+v"(r[8]), "+v"(r[9]), "+v"(r[10]), "+v"(r[11]), "+v"(r[12]), "+v"(r[13]), "+v"(r[14]), "+v"(r[15]) : "v"(a), "v"(b) : "s40", "vcc");
        asm volatile("v_perm_b32 %0, %0, %16, %17\n\tv_perm_b32 %1, %1, %16, %17\n\tv_perm_b32 %2, %2, %16, %17\n\tv_perm_b32 %3, %3, %16, %17\n\tv_perm_b32 %4, %4, %16, %17\n\tv_perm_b32 %5, %5, %16, %17\n\tv_perm_b32 %6, %6, %16, %17\n\tv_perm_b32 %7, %7, %16, %17\n\tv_perm_b32 %8, %8, %16, %17\n\tv_perm_b32 %9, %9, %16, %17\n\tv_perm_b32 %10, %10, %16, %17\n\tv_perm_b32 %11, %11, %16, %17\n\tv_perm_b32 %12, %12, %16, %17\n\tv_perm_b32 %13, %13, %16, %17\n\tv_perm_b32 %14, %14, %16, %17\n\tv_perm_b32 %15, %15, %16, %17\n\t" : "+v"(r[0]), "+v"(r[1]), "+v"(r[2]), "+v"(r[3]), "+v"(r[4]), "+v"(r[5]), "+v"(r[6]), "+v"(r[7]), "+v"(r[8]), "+v"(r[9]), "+v"(r[10]), "+v"(r[11]), "+v"(r[12]), "+v"(r[13]), "+v"(r[14]), "+v"(r[15]) : "v"(a), "v"(b) : "s40", "vcc");
#endif
#if PROBE_UB == 4
        asm volatile("v_add_u32_dpp %0, %0, %0 quad_perm:[1,0,3,2] row_mask:0xf bank_mask:0xf\n\tv_add_u32_dpp %1, %1, %1 quad_perm:[1,0,3,2] row_mask:0xf bank_mask:0xf\n\tv_add_u32_dpp %2, %2, %2 quad_perm:[1,0,3,2] row_mask:0xf bank_mask:0xf\n\tv_add_u32_dpp %3, %3, %3 quad_perm:[1,0,3,2] row_mask:0xf bank_mask:0xf\n\tv_add_u32_dpp %4, %4, %4 quad_perm:[1,0,3,2] row_mask:0xf bank_mask:0xf\n\tv_add_u32_dpp %5, %5, %5 quad_perm:[1,0,3,2] row_mask:0xf bank_mask:0xf\n\tv_add_u32_dpp %6, %6, %6 quad_perm:[1,0,3,2] row_mask:0xf bank_mask:0xf\n\tv_add_u32_dpp %7, %7, %7 quad_perm:[1,0,3,2] row_mask:0xf bank_mask:0xf\n\tv_add_u32_dpp %8, %8, %8 quad_perm:[1,0,3,2] row_mask:0xf bank_mask:0xf\n\tv_add_u32_dpp %9, %9, %9 quad_perm:[1,0,3,2] row_mask:0xf bank_mask:0xf\n\tv_add_u32_dpp %10, %10, %10 quad_perm:[1,0,3,2] row_mask:0xf bank_mask:0xf\n\tv_add_u32_dpp %11, %11, %11 quad_perm:[1,0,3,2] row_mask:0xf bank_mask:0xf\n\tv_add_u32_dpp %12, %12, %12 quad_perm:[1,0,3,2] row_mask:0xf bank_mask:0xf\n\tv_add_u32_dpp %13, %13, %13 quad_perm:[1,0,3,2] row_mask:0xf bank_mask:0xf\n\tv_add_u32_dpp %14, %14, %14 quad_perm:[1,0,3,2] row_mask:0xf bank_mask:0xf\n\tv_add_u32_dpp %15, %15, %15 quad_perm:[1,0,3,2] row_mask:0xf bank_mask:0xf\n\t" : "+v"(r[0]), "+v"(r[1]), "+v"(r[2]), "+v"(r[3]), "+v"(r[4]), "+v"(r[5]), "+v"(r[6]), "+v"(r[7]), "+v"(r[8]), "+v"(r[9]), "+v"(r[10]), "+v"(r[11]), "+v"(r[12]), "+v"(r[13]), "+v"(r[14]), "+v"(r[15]) : "v"(a), "v"(b) : "s40", "vcc");
        asm volatile("v_add_u32_dpp %0, %0, %0 quad_perm:[1,0,3,2] row_mask:0xf bank_mask:0xf\n\tv_add_u32_dpp %1, %1, %1 quad_perm:[1,0,3,2] row_mask:0xf bank_mask:0xf\n\tv_add_u32_dpp %2, %2, %2 quad_perm:[1,0,3,2] row_mask:0xf bank_mask:0xf\n\tv_add_u32_dpp %3, %3, %3 quad_perm:[1,0,3,2] row_mask:0xf bank_mask:0xf\n\tv_add_u32_dpp %4, %4, %4 quad_perm:[1,0,3,2] row_mask:0xf bank_mask:0xf\n\tv_add_u32_dpp %5, %5, %5 quad_perm:[1,0,3,2] row_mask:0xf bank_mask:0xf\n\tv_add_u32_dpp %6, %6, %6 quad_perm:[1,0,3,2] row_mask:0xf bank_mask:0xf\n\tv_add_u32_dpp %7, %7, %7 quad_perm:[1,0,3,2] row_mask:0xf bank_mask:0xf\n\tv_add_u32_dpp %8, %8, %8 quad_perm:[1,0,3,2] row_mask:0xf bank_mask:0xf\n\tv_add_u32_dpp %9, %9, %9 quad_perm:[1,0,3,2] row_mask:0xf bank_mask:0xf\n\tv_add_u32_dpp %10, %10, %10 quad_perm:[1,0,3,2] row_mask:0xf bank_mask:0xf\n\tv_add_u32_dpp %11, %11, %11 quad_perm:[1,0,3,2] row_mask:0xf bank_mask:0xf\n\tv_add_u32_dpp %12, %12, %12 quad_perm:[1,0,3,2] row_mask:0xf bank_mask:0xf\n\tv_add_u32_dpp %13, %13, %13 quad_perm:[1,0,3,2] row_mask:0xf bank_mask:0xf\n\tv_add_u32_dpp %14, %14, %14 quad_perm:[1,0,3,2] row_mask:0xf bank_mask:0xf\n\tv_add_u32_dpp %15, %15, %15 quad_perm:[1,0,3,2] row_mask:0xf bank_mask:0xf\n\t" : "+v"(r[0]), "+v"(r[1]), "+v"(r[2]), "+v"(r[3]), "+v"(r[4]), "+v"(r[5]), "+v"(r[6]), "+v"(r[7]), "+v"(r[8]), "+v"(r[9]), "+v"(r[10]), "+v"(r[11]), "+v"(r[12]), "+v"(r[13]), "+v"(r[14]), "+v"(r[15]) : "v"(a), "v"(b) : "s40", "vcc");
#endif
#if PROBE_UB == 5
        asm volatile("v_readlane_b32 s40, %0, 5\n\tv_readlane_b32 s40, %1, 5\n\tv_readlane_b32 s40, %2, 5\n\tv_readlane_b32 s40, %3, 5\n\tv_readlane_b32 s40, %4, 5\n\tv_readlane_b32 s40, %5, 5\n\tv_readlane_b32 s40, %6, 5\n\tv_readlane_b32 s40, %7, 5\n\tv_readlane_b32 s40, %8, 5\n\tv_readlane_b32 s40, %9, 5\n\tv_readlane_b32 s40, %10, 5\n\tv_readlane_b32 s40, %11, 5\n\tv_readlane_b32 s40, %12, 5\n\tv_readlane_b32 s40, %13, 5\n\tv_readlane_b32 s40, %14, 5\n\tv_readlane_b32 s40, %15, 5\n\t" : "+v"(r[0]), "+v"(r[1]), "+v"(r[2]), "+v"(r[3]), "+v"(r[4]), "+v"(r[5]), "+v"(r[6]), "+v"(r[7]), "+v"(r[8]), "+v"(r[9]), "+v"(r[10]), "+v"(r[11]), "+v"(r[12]), "+v"(r[13]), "+v"(r[14]), "+v"(r[15]) : "v"(a), "v"(b) : "s40", "vcc");
        asm volatile("v_readlane_b32 s40, %0, 5\n\tv_readlane_b32 s40, %1, 5\n\tv_readlane_b32 s40, %2, 5\n\tv_readlane_b32 s40, %3, 5\n\tv_readlane_b32 s40, %4, 5\n\tv_readlane_b32 s40, %5, 5\n\tv_readlane_b32 s40, %6, 5\n\tv_readlane_b32 s40, %7, 5\n\tv_readlane_b32 s40, %8, 5\n\tv_readlane_b32 s40, %9, 5\n\tv_readlane_b32 s40, %10, 5\n\tv_readlane_b32 s40, %11, 5\n\tv_readlane_b32 s40, %12, 5\n\tv_readlane_b32 s40, %13, 5\n\tv_readlane_b32 s40, %14, 5\n\tv_readlane_b32 s40, %15, 5\n\t" : "+v"(r[0]), "+v"(r[1]), "+v"(r[2]), "+v"(r[3]), "+v"(r[4]), "+v"(r[5]), "+v"(r[6]), "+v"(r[7]), "+v"(r[8]), "+v"(r[9]), "+v"(r[10]), "+v"(r[11]), "+v"(r[12]), "+v"(r[13]), "+v"(r[14]), "+v"(r[15]) : "v"(a), "v"(b) : "s40", "vcc");
#endif
#if PROBE_UB == 6
        asm volatile("v_cvt_pk_f32_fp8 %0, %16\n\tv_cvt_pk_f32_fp8 %1, %16\n\tv_cvt_pk_f32_fp8 %2, %16\n\tv_cvt_pk_f32_fp8 %3, %16\n\tv_cvt_pk_f32_fp8 %4, %16\n\tv_cvt_pk_f32_fp8 %5, %16\n\tv_cvt_pk_f32_fp8 %6, %16\n\tv_cvt_pk_f32_fp8 %7, %16\n\t" : "+v"(r2[0]), "+v"(r2[1]), "+v"(r2[2]), "+v"(r2[3]), "+v"(r2[4]), "+v"(r2[5]), "+v"(r2[6]), "+v"(r2[7]), "+v"(r[8]), "+v"(r[9]), "+v"(r[10]), "+v"(r[11]), "+v"(r[12]), "+v"(r[13]), "+v"(r[14]), "+v"(r[15]) : "v"(a), "v"(b) : "s40", "vcc");
        asm volatile("v_cvt_pk_f32_fp8 %0, %16\n\tv_cvt_pk_f32_fp8 %1, %16\n\tv_cvt_pk_f32_fp8 %2, %16\n\tv_cvt_pk_f32_fp8 %3, %16\n\tv_cvt_pk_f32_fp8 %4, %16\n\tv_cvt_pk_f32_fp8 %5, %16\n\tv_cvt_pk_f32_fp8 %6, %16\n\tv_cvt_pk_f32_fp8 %7, %16\n\t" : "+v"(r2[0]), "+v"(r2[1]), "+v"(r2[2]), "+v"(r2[3]), "+v"(r2[4]), "+v"(r2[5]), "+v"(r2[6]), "+v"(r2[7]), "+v"(r[8]), "+v"(r[9]), "+v"(r[10]), "+v"(r[11]), "+v"(r[12]), "+v"(r[13]), "+v"(r[14]), "+v"(r[15]) : "v"(a), "v"(b) : "s40", "vcc");
        asm volatile("v_cvt_pk_f32_fp8 %0, %16\n\tv_cvt_pk_f32_fp8 %1, %16\n\tv_cvt_pk_f32_fp8 %2, %16\n\tv_cvt_pk_f32_fp8 %3, %16\n\tv_cvt_pk_f32_fp8 %4, %16\n\tv_cvt_pk_f32_fp8 %5, %16\n\tv_cvt_pk_f32_fp8 %6, %16\n\tv_cvt_pk_f32_fp8 %7, %16\n\t" : "+v"(r2[0]), "+v"(r2[1]), "+v"(r2[2]), "+v"(r2[3]), "+v"(r2[4]), "+v"(r2[5]), "+v"(r2[6]), "+v"(r2[7]), "+v"(r[8]), "+v"(r[9]), "+v"(r[10]), "+v"(r[11]), "+v"(r[12]), "+v"(r[13]), "+v"(r[14]), "+v"(r[15]) : "v"(a), "v"(b) : "s40", "vcc");
        asm volatile("v_cvt_pk_f32_fp8 %0, %16\n\tv_cvt_pk_f32_fp8 %1, %16\n\tv_cvt_pk_f32_fp8 %2, %16\n\tv_cvt_pk_f32_fp8 %3, %16\n\tv_cvt_pk_f32_fp8 %4, %16\n\tv_cvt_pk_f32_fp8 %5, %16\n\tv_cvt_pk_f32_fp8 %6, %16\n\tv_cvt_pk_f32_fp8 %7, %16\n\t" : "+v"(r2[0]), "+v"(r2[1]), "+v"(r2[2]), "+v"(r2[3]), "+v"(r2[4]), "+v"(r2[5]), "+v"(r2[6]), "+v"(r2[7]), "+v"(r[8]), "+v"(r[9]), "+v"(r[10]), "+v"(r[11]), "+v"(r[12]), "+v"(r[13]), "+v"(r[14]), "+v"(r[15]) : "v"(a), "v"(b) : "s40", "vcc");
#endif
#if PROBE_UB == 7
        asm volatile("v_pk_fma_f32 %0, %0, %0, %0\n\tv_pk_fma_f32 %1, %1, %1, %1\n\tv_pk_fma_f32 %2, %2, %2, %2\n\tv_pk_fma_f32 %3, %3, %3, %3\n\tv_pk_fma_f32 %4, %4, %4, %4\n\tv_pk_fma_f32 %5, %5, %5, %5\n\tv_pk_fma_f32 %6, %6, %6, %6\n\tv_pk_fma_f32 %7, %7, %7, %7\n\t" : "+v"(r2[0]), "+v"(r2[1]), "+v"(r2[2]), "+v"(r2[3]), "+v"(r2[4]), "+v"(r2[5]), "+v"(r2[6]), "+v"(r2[7]), "+v"(r[8]), "+v"(r[9]), "+v"(r[10]), "+v"(r[11]), "+v"(r[12]), "+v"(r[13]), "+v"(r[14]), "+v"(r[15]) : "v"(a), "v"(b) : "s40", "vcc");
        asm volatile("v_pk_fma_f32 %0, %0, %0, %0\n\tv_pk_fma_f32 %1, %1, %1, %1\n\tv_pk_fma_f32 %2, %2, %2, %2\n\tv_pk_fma_f32 %3, %3, %3, %3\n\tv_pk_fma_f32 %4, %4, %4, %4\n\tv_pk_fma_f32 %5, %5, %5, %5\n\tv_pk_fma_f32 %6, %6, %6, %6\n\tv_pk_fma_f32 %7, %7, %7, %7\n\t" : "+v"(r2[0]), "+v"(r2[1]), "+v"(r2[2]), "+v"(r2[3]), "+v"(r2[4]), "+v"(r2[5]), "+v"(r2[6]), "+v"(r2[7]), "+v"(r[8]), "+v"(r[9]), "+v"(r[10]), "+v"(r[11]), "+v"(r[12]), "+v"(r[13]), "+v"(r[14]), "+v"(r[15]) : "v"(a), "v"(b) : "s40", "vcc");
        asm volatile("v_pk_fma_f32 %0, %0, %0, %0\n\tv_pk_fma_f32 %1, %1, %1, %1\n\tv_pk_fma_f32 %2, %2, %2, %2\n\tv_pk_fma_f32 %3, %3, %3, %3\n\tv_pk_fma_f32 %4, %4, %4, %4\n\tv_pk_fma_f32 %5, %5, %5, %5\n\tv_pk_fma_f32 %6, %6, %6, %6\n\tv_pk_fma_f32 %7, %7, %7, %7\n\t" : "+v"(r2[0]), "+v"(r2[1]), "+v"(r2[2]), "+v"(r2[3]), "+v"(r2[4]), "+v"(r2[5]), "+v"(r2[6]), "+v"(r2[7]), "+v"(r[8]), "+v"(r[9]), "+v"(r[10]), "+v"(r[11]), "+v"(r[12]), "+v"(r[13]), "+v"(r[14]), "+v"(r[15]) : "v"(a), "v"(b) : "s40", "vcc");
        asm volatile("v_pk_fma_f32 %0, %0, %0, %0\n\tv_pk_fma_f32 %1, %1, %1, %1\n\tv_pk_fma_f32 %2, %2, %2, %2\n\tv_pk_fma_f32 %3, %3, %3, %3\n\tv_pk_fma_f32 %4, %4, %4, %4\n\tv_pk_fma_f32 %5, %5, %5, %5\n\tv_pk_fma_f32 %6, %6, %6, %6\n\tv_pk_fma_f32 %7, %7, %7, %7\n\t" : "+v"(r2[0]), "+v"(r2[1]), "+v"(r2[2]), "+v"(r2[3]), "+v"(r2[4]), "+v"(r2[5]), "+v"(r2[6]), "+v"(r2[7]), "+v"(r[8]), "+v"(r[9]), "+v"(r[10]), "+v"(r[11]), "+v"(r[12]), "+v"(r[13]), "+v"(r[14]), "+v"(r[15]) : "v"(a), "v"(b) : "s40", "vcc");
#endif
#if PROBE_UB == 8
        asm volatile("v_dot2c_f32_bf16 %0, %16, %17\n\tv_dot2c_f32_bf16 %1, %16, %17\n\tv_dot2c_f32_bf16 %2, %16, %17\n\tv_dot2c_f32_bf16 %3, %16, %17\n\tv_dot2c_f32_bf16 %4, %16, %17\n\tv_dot2c_f32_bf16 %5, %16, %17\n\tv_dot2c_f32_bf16 %6, %16, %17\n\tv_dot2c_f32_bf16 %7, %16, %17\n\tv_dot2c_f32_bf16 %8, %16, %17\n\tv_dot2c_f32_bf16 %9, %16, %17\n\tv_dot2c_f32_bf16 %10, %16, %17\n\tv_dot2c_f32_bf16 %11, %16, %17\n\tv_dot2c_f32_bf16 %12, %16, %17\n\tv_dot2c_f32_bf16 %13, %16, %17\n\tv_dot2c_f32_bf16 %14, %16, %17\n\tv_dot2c_f32_bf16 %15, %16, %17\n\t" : "+v"(r[0]), "+v"(r[1]), "+v"(r[2]), "+v"(r[3]), "+v"(r[4]), "+v"(r[5]), "+v"(r[6]), "+v"(r[7]), "+v"(r[8]), "+v"(r[9]), "+v"(r[10]), "+v"(r[11]), "+v"(r[12]), "+v"(r[13]), "+v"(r[14]), "+v"(r[15]) : "v"(a), "v"(b) : "s40", "vcc");
        asm volatile("v_dot2c_f32_bf16 %0, %16, %17\n\tv_dot2c_f32_bf16 %1, %16, %17\n\tv_dot2c_f32_bf16 %2, %16, %17\n\tv_dot2c_f32_bf16 %3, %16, %17\n\tv_dot2c_f32_bf16 %4, %16, %17\n\tv_dot2c_f32_bf16 %5, %16, %17\n\tv_dot2c_f32_bf16 %6, %16, %17\n\tv_dot2c_f32_bf16 %7, %16, %17\n\tv_dot2c_f32_bf16 %8, %16, %17\n\tv_dot2c_f32_bf16 %9, %16, %17\n\tv_dot2c_f32_bf16 %10, %16, %17\n\tv_dot2c_f32_bf16 %11, %16, %17\n\tv_dot2c_f32_bf16 %12, %16, %17\n\tv_dot2c_f32_bf16 %13, %16, %17\n\tv_dot2c_f32_bf16 %14, %16, %17\n\tv_dot2c_f32_bf16 %15, %16, %17\n\t" : "+v"(r[0]), "+v"(r[1]), "+v"(r[2]), "+v"(r[3]), "+v"(r[4]), "+v"(r[5]), "+v"(r[6]), "+v"(r[7]), "+v"(r[8]), "+v"(r[9]), "+v"(r[10]), "+v"(r[11]), "+v"(r[12]), "+v"(r[13]), "+v"(r[14]), "+v"(r[15]) : "v"(a), "v"(b) : "s40", "vcc");
#endif
#if PROBE_UB == 9
        asm volatile("v_cndmask_b32 %0, %0, %16, vcc\n\tv_cndmask_b32 %1, %1, %16, vcc\n\tv_cndmask_b32 %2, %2, %16, vcc\n\tv_cndmask_b32 %3, %3, %16, vcc\n\tv_cndmask_b32 %4, %4, %16, vcc\n\tv_cndmask_b32 %5, %5, %16, vcc\n\tv_cndmask_b32 %6, %6, %16, vcc\n\tv_cndmask_b32 %7, %7, %16, vcc\n\tv_cndmask_b32 %8, %8, %16, vcc\n\tv_cndmask_b32 %9, %9, %16, vcc\n\tv_cndmask_b32 %10, %10, %16, vcc\n\tv_cndmask_b32 %11, %11, %16, vcc\n\tv_cndmask_b32 %12, %12, %16, vcc\n\tv_cndmask_b32 %13, %13, %16, vcc\n\tv_cndmask_b32 %14, %14, %16, vcc\n\tv_cndmask_b32 %15, %15, %16, vcc\n\t" : "+v"(r[0]), "+v"(r[1]), "+v"(r[2]), "+v"(r[3]), "+v"(r[4]), "+v"(r[5]), "+v"(r[6]), "+v"(r[7]), "+v"(r[8]), "+v"(r[9]), "+v"(r[10]), "+v"(r[11]), "+v"(r[12]), "+v"(r[13]), "+v"(r[14]), "+v"(r[15]) : "v"(a), "v"(b) : "s40", "vcc");
        asm volatile("v_cndmask_b32 %0, %0, %16, vcc\n\tv_cndmask_b32 %1, %1, %16, vcc\n\tv_cndmask_b32 %2, %2, %16, vcc\n\tv_cndmask_b32 %3, %3, %16, vcc\n\tv_cndmask_b32 %4, %4, %16, vcc\n\tv_cndmask_b32 %5, %5, %16, vcc\n\tv_cndmask_b32 %6, %6, %16, vcc\n\tv_cndmask_b32 %7, %7, %16, vcc\n\tv_cndmask_b32 %8, %8, %16, vcc\n\tv_cndmask_b32 %9, %9, %16, vcc\n\tv_cndmask_b32 %10, %10, %16, vcc\n\tv_cndmask_b32 %11, %11, %16, vcc\n\tv_cndmask_b32 %12, %12, %16, vcc\n\tv_cndmask_b32 %13, %13, %16, vcc\n\tv_cndmask_b32 %14, %14, %16, vcc\n\tv_cndmask_b32 %15, %15, %16, vcc\n\t" : "+v"(r[0]), "+v"(r[1]), "+v"(r[2]), "+v"(r[3]), "+v"(r[4]), "+v"(r[5]), "+v"(r[6]), "+v"(r[7]), "+v"(r[8]), "+v"(r[9]), "+v"(r[10]), "+v"(r[11]), "+v"(r[12]), "+v"(r[13]), "+v"(r[14]), "+v"(r[15]) : "v"(a), "v"(b) : "s40", "vcc");
#endif
#if PROBE_UB == 10
        asm volatile("v_max_i32 %0, %0, %16\n\tv_max_i32 %1, %1, %16\n\tv_max_i32 %2, %2, %16\n\tv_max_i32 %3, %3, %16\n\tv_max_i32 %4, %4, %16\n\tv_max_i32 %5, %5, %16\n\tv_max_i32 %6, %6, %16\n\tv_max_i32 %7, %7, %16\n\tv_max_i32 %8, %8, %16\n\tv_max_i32 %9, %9, %16\n\tv_max_i32 %10, %10, %16\n\tv_max_i32 %11, %11, %16\n\tv_max_i32 %12, %12, %16\n\tv_max_i32 %13, %13, %16\n\tv_max_i32 %14, %14, %16\n\tv_max_i32 %15, %15, %16\n\t" : "+v"(r[0]), "+v"(r[1]), "+v"(r[2]), "+v"(r[3]), "+v"(r[4]), "+v"(r[5]), "+v"(r[6]), "+v"(r[7]), "+v"(r[8]), "+v"(r[9]), "+v"(r[10]), "+v"(r[11]), "+v"(r[12]), "+v"(r[13]), "+v"(r[14]), "+v"(r[15]) : "v"(a), "v"(b) : "s40", "vcc");
        asm volatile("v_max_i32 %0, %0, %16\n\tv_max_i32 %1, %1, %16\n\tv_max_i32 %2, %2, %16\n\tv_max_i32 %3, %3, %16\n\tv_max_i32 %4, %4, %16\n\tv_max_i32 %5, %5, %16\n\tv_max_i32 %6, %6, %16\n\tv_max_i32 %7, %7, %16\n\tv_max_i32 %8, %8, %16\n\tv_max_i32 %9, %9, %16\n\tv_max_i32 %10, %10, %16\n\tv_max_i32 %11, %11, %16\n\tv_max_i32 %12, %12, %16\n\tv_max_i32 %13, %13, %16\n\tv_max_i32 %14, %14, %16\n\tv_max_i32 %15, %15, %16\n\t" : "+v"(r[0]), "+v"(r[1]), "+v"(r[2]), "+v"(r[3]), "+v"(r[4]), "+v"(r[5]), "+v"(r[6]), "+v"(r[7]), "+v"(r[8]), "+v"(r[9]), "+v"(r[10]), "+v"(r[11]), "+v"(r[12]), "+v"(r[13]), "+v"(r[14]), "+v"(r[15]) : "v"(a), "v"(b) : "s40", "vcc");
#endif
#if PROBE_UB == 11
        asm volatile("v_exp_f32 %0, %0\n\tv_exp_f32 %1, %1\n\tv_exp_f32 %2, %2\n\tv_exp_f32 %3, %3\n\tv_exp_f32 %4, %4\n\tv_exp_f32 %5, %5\n\tv_exp_f32 %6, %6\n\tv_exp_f32 %7, %7\n\tv_exp_f32 %8, %8\n\tv_exp_f32 %9, %9\n\tv_exp_f32 %10, %10\n\tv_exp_f32 %11, %11\n\tv_exp_f32 %12, %12\n\tv_exp_f32 %13, %13\n\tv_exp_f32 %14, %14\n\tv_exp_f32 %15, %15\n\t" : "+v"(r[0]), "+v"(r[1]), "+v"(r[2]), "+v"(r[3]), "+v"(r[4]), "+v"(r[5]), "+v"(r[6]), "+v"(r[7]), "+v"(r[8]), "+v"(r[9]), "+v"(r[10]), "+v"(r[11]), "+v"(r[12]), "+v"(r[13]), "+v"(r[14]), "+v"(r[15]) : "v"(a), "v"(b) : "s40", "vcc");
        asm volatile("v_exp_f32 %0, %0\n\tv_exp_f32 %1, %1\n\tv_exp_f32 %2, %2\n\tv_exp_f32 %3, %3\n\tv_exp_f32 %4, %4\n\tv_exp_f32 %5, %5\n\tv_exp_f32 %6, %6\n\tv_exp_f32 %7, %7\n\tv_exp_f32 %8, %8\n\tv_exp_f32 %9, %9\n\tv_exp_f32 %10, %10\n\tv_exp_f32 %11, %11\n\tv_exp_f32 %12, %12\n\tv_exp_f32 %13, %13\n\tv_exp_f32 %14, %14\n\tv_exp_f32 %15, %15\n\t" : "+v"(r[0]), "+v"(r[1]), "+v"(r[2]), "+v"(r[3]), "+v"(r[4]), "+v"(r[5]), "+v"(r[6]), "+v"(r[7]), "+v"(r[8]), "+v"(r[9]), "+v"(r[10]), "+v"(r[11]), "+v"(r[12]), "+v"(r[13]), "+v"(r[14]), "+v"(r[15]) : "v"(a), "v"(b) : "s40", "vcc");
#endif
#if PROBE_UB == 12
        asm volatile("v_fmac_f32 %0, %16, %17\n\tv_fmac_f32 %1, %16, %17\n\tv_fmac_f32 %2, %16, %17\n\tv_fmac_f32 %3, %16, %17\n\tv_fmac_f32 %4, %16, %17\n\tv_fmac_f32 %5, %16, %17\n\tv_fmac_f32 %6, %16, %17\n\tv_fmac_f32 %7, %16, %17\n\tv_fmac_f32 %8, %16, %17\n\tv_fmac_f32 %9, %16, %17\n\tv_fmac_f32 %10, %16, %17\n\tv_fmac_f32 %11, %16, %17\n\tv_fmac_f32 %12, %16, %17\n\tv_fmac_f32 %13, %16, %17\n\tv_fmac_f32 %14, %16, %17\n\tv_fmac_f32 %15, %16, %17\n\t" : "+v"(r[0]), "+v"(r[1]), "+v"(r[2]), "+v"(r[3]), "+v"(r[4]), "+v"(r[5]), "+v"(r[6]), "+v"(r[7]), "+v"(r[8]), "+v"(r[9]), "+v"(r[10]), "+v"(r[11]), "+v"(r[12]), "+v"(r[13]), "+v"(r[14]), "+v"(r[15]) : "v"(a), "v"(b) : "s40", "vcc");
        asm volatile("v_fmac_f32 %0, %16, %17\n\tv_fmac_f32 %1, %16, %17\n\tv_fmac_f32 %2, %16, %17\n\tv_fmac_f32 %3, %16, %17\n\tv_fmac_f32 %4, %16, %17\n\tv_fmac_f32 %5, %16, %17\n\tv_fmac_f32 %6, %16, %17\n\tv_fmac_f32 %7, %16, %17\n\tv_fmac_f32 %8, %16, %17\n\tv_fmac_f32 %9, %16, %17\n\tv_fmac_f32 %10, %16, %17\n\tv_fmac_f32 %11, %16, %17\n\tv_fmac_f32 %12, %16, %17\n\tv_fmac_f32 %13, %16, %17\n\tv_fmac_f32 %14, %16, %17\n\tv_fmac_f32 %15, %16, %17\n\t" : "+v"(r[0]), "+v"(r[1]), "+v"(r[2]), "+v"(r[3]), "+v"(r[4]), "+v"(r[5]), "+v"(r[6]), "+v"(r[7]), "+v"(r[8]), "+v"(r[9]), "+v"(r[10]), "+v"(r[11]), "+v"(r[12]), "+v"(r[13]), "+v"(r[14]), "+v"(r[15]) : "v"(a), "v"(b) : "s40", "vcc");
#endif
#if PROBE_UB == 13
        asm volatile("v_add_u32_dpp %0, %16, %0 quad_perm:[1,0,3,2] row_mask:0xf bank_mask:0xf\n\tv_add_u32_dpp %1, %16, %1 quad_perm:[1,0,3,2] row_mask:0xf bank_mask:0xf\n\tv_add_u32_dpp %2, %16, %2 quad_perm:[1,0,3,2] row_mask:0xf bank_mask:0xf\n\tv_add_u32_dpp %3, %16, %3 quad_perm:[1,0,3,2] row_mask:0xf bank_mask:0xf\n\tv_add_u32_dpp %4, %16, %4 quad_perm:[1,0,3,2] row_mask:0xf bank_mask:0xf\n\tv_add_u32_dpp %5, %16, %5 quad_perm:[1,0,3,2] row_mask:0xf bank_mask:0xf\n\tv_add_u32_dpp %6, %16, %6 quad_perm:[1,0,3,2] row_mask:0xf bank_mask:0xf\n\tv_add_u32_dpp %7, %16, %7 quad_perm:[1,0,3,2] row_mask:0xf bank_mask:0xf\n\tv_add_u32_dpp %8, %16, %8 quad_perm:[1,0,3,2] row_mask:0xf bank_mask:0xf\n\tv_add_u32_dpp %9, %16, %9 quad_perm:[1,0,3,2] row_mask:0xf bank_mask:0xf\n\tv_add_u32_dpp %10, %16, %10 quad_perm:[1,0,3,2] row_mask:0xf bank_mask:0xf\n\tv_add_u32_dpp %11, %16, %11 quad_perm:[1,0,3,2] row_mask:0xf bank_mask:0xf\n\tv_add_u32_dpp %12, %16, %12 quad_perm:[1,0,3,2] row_mask:0xf bank_mask:0xf\n\tv_add_u32_dpp %13, %16, %13 quad_perm:[1,0,3,2] row_mask:0xf bank_mask:0xf\n\tv_add_u32_dpp %14, %16, %14 quad_perm:[1,0,3,2] row_mask:0xf bank_mask:0xf\n\tv_add_u32_dpp %15, %16, %15 quad_perm:[1,0,3,2] row_mask:0xf bank_mask:0xf\n\t" : "+v"(r[0]), "+v"(r[1]), "+v"(r[2]), "+v"(r[3]), "+v"(r[4]), "+v"(r[5]), "+v"(r[6]), "+v"(r[7]), "+v"(r[8]), "+v"(r[9]), "+v"(r[10]), "+v"(r[11]), "+v"(r[12]), "+v"(r[13]), "+v"(r[14]), "+v"(r[15]) : "v"(a), "v"(b) : "s40", "vcc");
        asm volatile("v_add_u32_dpp %0, %16, %0 quad_perm:[1,0,3,2] row_mask:0xf bank_mask:0xf\n\tv_add_u32_dpp %1, %16, %1 quad_perm:[1,0,3,2] row_mask:0xf bank_mask:0xf\n\tv_add_u32_dpp %2, %16, %2 quad_perm:[1,0,3,2] row_mask:0xf bank_mask:0xf\n\tv_add_u32_dpp %3, %16, %3 quad_perm:[1,0,3,2] row_mask:0xf bank_mask:0xf\n\tv_add_u32_dpp %4, %16, %4 quad_perm:[1,0,3,2] row_mask:0xf bank_mask:0xf\n\tv_add_u32_dpp %5, %16, %5 quad_perm:[1,0,3,2] row_mask:0xf bank_mask:0xf\n\tv_add_u32_dpp %6, %16, %6 quad_perm:[1,0,3,2] row_mask:0xf bank_mask:0xf\n\tv_add_u32_dpp %7, %16, %7 quad_perm:[1,0,3,2] row_mask:0xf bank_mask:0xf\n\tv_add_u32_dpp %8, %16, %8 quad_perm:[1,0,3,2] row_mask:0xf bank_mask:0xf\n\tv_add_u32_dpp %9, %16, %9 quad_perm:[1,0,3,2] row_mask:0xf bank_mask:0xf\n\tv_add_u32_dpp %10, %16, %10 quad_perm:[1,0,3,2] row_mask:0xf bank_mask:0xf\n\tv_add_u32_dpp %11, %16, %11 quad_perm:[1,0,3,2] row_mask:0xf bank_mask:0xf\n\tv_add_u32_dpp %12, %16, %12 quad_perm:[1,0,3,2] row_mask:0xf bank_mask:0xf\n\tv_add_u32_dpp %13, %16, %13 quad_perm:[1,0,3,2] row_mask:0xf bank_mask:0xf\n\tv_add_u32_dpp %14, %16, %14 quad_perm:[1,0,3,2] row_mask:0xf bank_mask:0xf\n\tv_add_u32_dpp %15, %16, %15 quad_perm:[1,0,3,2] row_mask:0xf bank_mask:0xf\n\t" : "+v"(r[0]), "+v"(r[1]), "+v"(r[2]), "+v"(r[3]), "+v"(r[4]), "+v"(r[5]), "+v"(r[6]), "+v"(r[7]), "+v"(r[8]), "+v"(r[9]), "+v"(r[10]), "+v"(r[11]), "+v"(r[12]), "+v"(r[13]), "+v"(r[14]), "+v"(r[15]) : "v"(a), "v"(b) : "s40", "vcc");
#endif
#if PROBE_UB == 14
        asm volatile("v_cvt_f32_ubyte1 %0, %16\n\tv_cvt_f32_ubyte1 %1, %16\n\tv_cvt_f32_ubyte1 %2, %16\n\tv_cvt_f32_ubyte1 %3, %16\n\tv_cvt_f32_ubyte1 %4, %16\n\tv_cvt_f32_ubyte1 %5, %16\n\tv_cvt_f32_ubyte1 %6, %16\n\tv_cvt_f32_ubyte1 %7, %16\n\tv_cvt_f32_ubyte1 %8, %16\n\tv_cvt_f32_ubyte1 %9, %16\n\tv_cvt_f32_ubyte1 %10, %16\n\tv_cvt_f32_ubyte1 %11, %16\n\tv_cvt_f32_ubyte1 %12, %16\n\tv_cvt_f32_ubyte1 %13, %16\n\tv_cvt_f32_ubyte1 %14, %16\n\tv_cvt_f32_ubyte1 %15, %16\n\t" : "+v"(r[0]), "+v"(r[1]), "+v"(r[2]), "+v"(r[3]), "+v"(r[4]), "+v"(r[5]), "+v"(r[6]), "+v"(r[7]), "+v"(r[8]), "+v"(r[9]), "+v"(r[10]), "+v"(r[11]), "+v"(r[12]), "+v"(r[13]), "+v"(r[14]), "+v"(r[15]) : "v"(a), "v"(b) : "s40", "vcc");
        asm volatile("v_cvt_f32_ubyte1 %0, %16\n\tv_cvt_f32_ubyte1 %1, %16\n\tv_cvt_f32_ubyte1 %2, %16\n\tv_cvt_f32_ubyte1 %3, %16\n\tv_cvt_f32_ubyte1 %4, %16\n\tv_cvt_f32_ubyte1 %5, %16\n\tv_cvt_f32_ubyte1 %6, %16\n\tv_cvt_f32_ubyte1 %7, %16\n\tv_cvt_f32_ubyte1 %8, %16\n\tv_cvt_f32_ubyte1 %9, %16\n\tv_cvt_f32_ubyte1 %10, %16\n\tv_cvt_f32_ubyte1 %11, %16\n\tv_cvt_f32_ubyte1 %12, %16\n\tv_cvt_f32_ubyte1 %13, %16\n\tv_cvt_f32_ubyte1 %14, %16\n\tv_cvt_f32_ubyte1 %15, %16\n\t" : "+v"(r[0]), "+v"(r[1]), "+v"(r[2]), "+v"(r[3]), "+v"(r[4]), "+v"(r[5]), "+v"(r[6]), "+v"(r[7]), "+v"(r[8]), "+v"(r[9]), "+v"(r[10]), "+v"(r[11]), "+v"(r[12]), "+v"(r[13]), "+v"(r[14]), "+v"(r[15]) : "v"(a), "v"(b) : "s40", "vcc");
#endif
    }
    float s = 0.f;
#pragma unroll
    for (int i = 0; i < 16; ++i) s += r[i];
#pragma unroll
    for (int i = 0; i < 8; ++i) s += r2[i].x + r2[i].y;
    if (s == 1.2345e-33f) asm volatile("s_nop 0" ::: "memory");
}
#endif
__device__ __forceinline__ void phase_mod(const Params& p, LAS unsigned char* lds, int wv) {
    const int tid = tid_opaque(wv);
    LAS float* sc = (LAS float*)lds;
    LAS float* red = (LAS float*)(lds + 32768);
    for (int i = tid; i < BATCH * D_MODEL; i += 512) { const int b = i >> 10, k = i & 1023; const float v = p.c[i]; sc[k * 8 + b] = v / (1.0f + __expf(-v)); }
    __syncthreads();
    const int kg = tid >> 5, cl = tid & 31;
    for (int u = blockIdx.x; u < DEPTH * 64; u += gridDim.x) {
        const int l = u >> 6, j0 = (u & 63) * 96;
        const float* w = p.w_mod + (size_t)l * D_MODEL * MODW + (size_t)(kg * 64) * MODW + j0 + cl;
        float acc[3][8];
#pragma unroll
        for (int q = 0; q < 3; ++q)
#pragma unroll
            for (int b = 0; b < 8; ++b) acc[q][b] = 0.f;
#pragma unroll 4
        for (int kk = 0; kk < 64; ++kk) {
            const float w0 = w[(size_t)kk * MODW], w1 = w[(size_t)kk * MODW + 32], w2 = w[(size_t)kk * MODW + 64];
            const f32x4 s0 = *(const LAS f32x4*)(sc + (kg * 64 + kk) * 8), s1 = *(const LAS f32x4*)(sc + (kg * 64 + kk) * 8 + 4);
#pragma unroll
            for (int b = 0; b < 4; ++b) { acc[0][b] += s0[b] * w0; acc[1][b] += s0[b] * w1; acc[2][b] += s0[b] * w2; acc[0][4 + b] += s1[b] * w0; acc[1][4 + b] += s1[b] * w1; acc[2][4 + b] += s1[b] * w2; }
        }
#pragma unroll
        for (int q = 0; q < 3; ++q)
#pragma unroll
            for (int b = 0; b < 8; ++b) red[((kg * 3 + q) * 8 + b) * 32 + cl] = acc[q][b];
        __syncthreads();
        for (int o = tid; o < 768; o += 512) {
            float s = 0.f;
#pragma unroll
            for (int g = 0; g < 16; ++g) s += red[g * 768 + o];
            const int ocl = o & 31, ob = (o >> 5) & 7, oq = o >> 8;
            const int j = j0 + oq * 32 + ocl;
            p.mod()[((size_t)l * BATCH + ob) * MODW + j] = s + p.b_mod[(size_t)l * MODW + j];
        }
        __syncthreads();
    }
}

#ifndef PROBE_TIME
#define PROBE_TIME 0
#endif
#if PROBE_TIME || PROBE_UB
#define PT_BEGIN(k) do { if ((k) == PROBE_TIME) pt_t0 = __builtin_amdgcn_s_memrealtime(); } while (0)
#define PT_END(k) do { if ((k) == PROBE_TIME) pt_acc += __builtin_amdgcn_s_memrealtime() - pt_t0; } while (0)
#else
#define PT_BEGIN(k) do { } while (0)
#define PT_END(k) do { } while (0)
#endif
__global__ void __launch_bounds__(512, 2) k_mega(Params p) {
    extern __shared__ __attribute__((aligned(16))) unsigned char smem_raw[];
    LAS unsigned char* lds = (LAS unsigned char*)smem_raw;
    volatile LAS unsigned* xbw = (volatile LAS unsigned*)(lds + LDS_BYTES - 16);
    const int wv = __builtin_amdgcn_readfirstlane((int)threadIdx.x >> 6);
    if (threadIdx.x == 0) { xbw[0] = 0u; xbw[1] = 0u; xbw[2] = 0u; xbw[3] = 0u; }
    __syncthreads();
    (void)xcd_barrier_post(p.bar(), xbw);
#define GRID_SYNC() do { XcdBarrier _b; _b.bar = p.bar(); _b.x = xb_xcc_id(); _b.st = (volatile LAS unsigned*)(lds + LDS_BYTES - 16); _b.t0 = (tid_opaque(wv) == 0); xcd_barrier(_b); } while (0)
#if PROBE_TIME || PROBE_UB
    unsigned long long pt_t0 = 0, pt_acc = 0;
#endif
#if PROBE_UB
    { GRID_SYNC(); const unsigned long long u0 = __builtin_amdgcn_s_memrealtime(); ubench(4000, (unsigned)blockIdx.x); pt_acc += __builtin_amdgcn_s_memrealtime() - u0; GRID_SYNC(); }
#endif
    PT_BEGIN(1);
    for (int rep = 0; rep < ((PROBE_MASK & 8) ? 2 : 1); ++rep) { phase_mod(p, lds, wv); phase_convert(p, lds, wv); }
    GRID_SYNC();
    PT_END(1); PT_BEGIN(2);
    phase_norm(p, p.x_in, p.norm1_g, p.mod(), 0, 1, wv);
    GRID_SYNC();
    PT_END(2);
    for (int l = 0; l < DEPTH; ++l) {
        const float* modl = p.mod() + (size_t)l * BATCH * MODW;
        PT_BEGIN(3);
        for (int rep = 0; rep < ((PROBE_MASK & 1) ? 2 : 1); ++rep) { EpiStoreBf16 E; E.O = p.pb(); E.ldc = MIX_IN; run_gemm(lds, p.hb(), p.WinT() + (size_t)l * MIX_IN * D_MODEL, NTOK, MIX_IN, D_MODEL, E, wv); }
        GRID_SYNC();
        PT_END(3); PT_BEGIN(4); PT_BEGIN(10);
        for (int rep = 0; rep < ((PROBE_MASK & 2) ? 2 : 1); ++rep) phase_attn(p, l, lds, wv);
        PT_END(10);
        for (int rep = 0; rep < ((PROBE_MASK & 16) ? 2 : 1); ++rep) phase_mixrest(p, l, lds, wv);
        GRID_SYNC();
        PT_END(4); PT_BEGIN(5);
        { EpiResid E; E.xin = (l == 0) ? p.x_in : p.xb(); E.xout = p.xb(); E.gate = modl + 2 * D_MODEL; run_gemm(lds, p.cat(), p.WoutT() + (size_t)l * D_MODEL * D_MODEL, NTOK, D_MODEL, D_MODEL, E, wv); }
        GRID_SYNC();
        PT_END(5); PT_BEGIN(6);
        phase_norm(p, p.xb(), p.norm2_g + l * D_MODEL, modl, 3, 4, wv);
        GRID_SYNC();
        PT_END(6); PT_BEGIN(7);
        for (int rep = 0; rep < ((PROBE_MASK & 1) ? 2 : 1); ++rep) { EpiStoreBf16 E; E.O = p.qb(); E.ldc = 2048; run_gemm(lds, p.hb(), p.WqT() + (size_t)l * 2048 * D_MODEL, NTOK, 2048, D_MODEL, E, wv); }
        GRID_SYNC();
        PT_END(7); PT_BEGIN(8);
        for (int rep = 0; rep < ((PROBE_MASK & 4) ? 2 : 1); ++rep) phase_topk(p, l, lds, wv);
        GRID_SYNC();
        PT_END(8); PT_BEGIN(9); PT_BEGIN(11);
        PT_BEGIN(12);
        if (PROBE_SYNTH) phase_expert(p, l, false, lds, wv, PROBE_SYNTH, true);
        PT_END(12);
        phase_expert(p, l, l == DEPTH - 1, lds, wv);
        PT_END(11);
        GRID_SYNC();
        PT_END(9);
    }
#if PROBE_TIME || PROBE_UB
    if (blockIdx.x == 0) {
        const unsigned long long t1 = __builtin_amdgcn_s_memrealtime();
        while (__builtin_amdgcn_s_memrealtime() - t1 < 4ull * pt_acc) __builtin_amdgcn_s_sleep(8);
    }
#endif
}
#if MK_MULTI
enum { PH_CONVERT = 0, PH_NORM1, PH_GEMM1, PH_GEMM2, PH_NORM2, PH_GEMM3, PH_MOD };
template <int PH>
__global__ void __launch_bounds__(512, 2) k_ph(Params p, int l) {
    extern __shared__ __attribute__((aligned(16))) unsigned char smem_raw[];
    LAS unsigned char* lds = (LAS unsigned char*)smem_raw;
    const int wv = __builtin_amdgcn_readfirstlane((int)threadIdx.x >> 6);
    const float* modl = p.mod() + (size_t)l * BATCH * MODW;
    if (PH == PH_CONVERT) phase_convert(p, lds, wv);
    if (PH == PH_MOD) phase_mod(p, lds, wv);
    if (PH == PH_NORM1) phase_norm(p, l == 0 ? p.x_in : p.xb(), p.norm1_g + l * D_MODEL, modl, 0, 1, wv);
    if (PH == PH_GEMM1) { EpiStoreBf16 E; E.O = p.pb(); E.ldc = MIX_IN; run_gemm(lds, p.hb(), p.WinT() + (size_t)l * MIX_IN * D_MODEL, NTOK, MIX_IN, D_MODEL, E, wv); }
    if (PH == PH_GEMM2) { EpiResid E; E.xin = (l == 0) ? p.x_in : p.xb(); E.xout = p.xb(); E.gate = modl + 2 * D_MODEL; run_gemm(lds, p.cat(), p.WoutT() + (size_t)l * D_MODEL * D_MODEL, NTOK, D_MODEL, D_MODEL, E, wv); }
    if (PH == PH_NORM2) phase_norm(p, p.xb(), p.norm2_g + l * D_MODEL, modl, 3, 4, wv);
    if (PH == PH_GEMM3) { EpiStoreBf16 E; E.O = p.qb(); E.ldc = 2048; run_gemm(lds, p.hb(), p.WqT() + (size_t)l * 2048 * D_MODEL, NTOK, 2048, D_MODEL, E, wv); }
}

#endif

extern "C" void kernel_launch(void* const* d_in, const int* in_sizes, int n_in, void* d_out, int out_size, void* d_ws, size_t ws_size, hipStream_t stream) {
    Params p{};
    p.x_in = (const float*)d_in[0]; p.c = (const float*)d_in[1]; p.rel_bias = (const float*)d_in[2]; p.w_mod = (const float*)d_in[3]; p.b_mod = (const float*)d_in[4];
    p.norm1_g = (const float*)d_in[5]; p.norm2_g = (const float*)d_in[6]; p.w_in = (const float*)d_in[7]; p.w_out = (const float*)d_in[8]; p.diff_lambda = (const float*)d_in[9];
    p.subln_g = (const float*)d_in[10]; p.conf_dw = (const float*)d_in[11]; p.conf_ln_g = (const float*)d_in[12]; p.conf_ln_b = (const float*)d_in[13]; p.sconv_w = (const float*)d_in[14];
    p.sgu_ln_g = (const float*)d_in[15]; p.sgu_ln_b = (const float*)d_in[16]; p.sgu_w = (const float*)d_in[17]; p.sgu_b = (const float*)d_in[18]; p.peer_wq = (const float*)d_in[19];
    p.peer_keys = (const float*)d_in[20]; p.peer_u = (const float*)d_in[21]; p.peer_v = (const float*)d_in[22]; p.final_g = (const float*)d_in[23];
    p.out = (float*)d_out;
    for (int l = 0; l < DEPTH; ++l) p.lam_init[l] = (float)(0.8 - 0.6 * exp(-0.3 * (double)l));

    p.ws = (unsigned char*)d_ws;
    if (ws_size < WS_END) { fprintf(stderr, "kernel_launch: workspace too small\n"); return; }

    static int grid = 0;
    if (grid == 0) {
        int dev = 0, cus = 0;
        if (hipGetDevice(&dev) != hipSuccess || hipDeviceGetAttribute(&cus, hipDeviceAttributeMultiprocessorCount, dev) != hipSuccess) { grid = -1; return; }
        bool ok = true;
#if MK_MULTI
        ok &= hipFuncSetAttribute((const void*)k_ph<PH_CONVERT>, hipFuncAttributeMaxDynamicSharedMemorySize, LDS_BYTES) == hipSuccess;
        ok &= hipFuncSetAttribute((const void*)k_ph<PH_NORM1>, hipFuncAttributeMaxDynamicSharedMemorySize, LDS_BYTES) == hipSuccess;
        ok &= hipFuncSetAttribute((const void*)k_ph<PH_GEMM1>, hipFuncAttributeMaxDynamicSharedMemorySize, LDS_BYTES) == hipSuccess;
        ok &= hipFuncSetAttribute((const void*)k_ph<PH_GEMM2>, hipFuncAttributeMaxDynamicSharedMemorySize, LDS_BYTES) == hipSuccess;
        ok &= hipFuncSetAttribute((const void*)k_ph<PH_NORM2>, hipFuncAttributeMaxDynamicSharedMemorySize, LDS_BYTES) == hipSuccess;
        ok &= hipFuncSetAttribute((const void*)k_ph<PH_GEMM3>, hipFuncAttributeMaxDynamicSharedMemorySize, LDS_BYTES) == hipSuccess;
        ok &= hipFuncSetAttribute((const void*)k_ph<PH_MOD>, hipFuncAttributeMaxDynamicSharedMemorySize, LDS_BYTES) == hipSuccess;
        ok &= hipFuncSetAttribute((const void*)k_attn2<0>, hipFuncAttributeMaxDynamicSharedMemorySize, LDS_BYTES) == hipSuccess;
        ok &= hipFuncSetAttribute((const void*)k_topk<0>, hipFuncAttributeMaxDynamicSharedMemorySize, LDS_BYTES) == hipSuccess;
        ok &= hipFuncSetAttribute((const void*)k_mixrest<0>, hipFuncAttributeMaxDynamicSharedMemorySize, LDS_BYTES) == hipSuccess;
        ok &= hipFuncSetAttribute((const void*)k_expert, hipFuncAttributeMaxDynamicSharedMemorySize, LDS_BYTES) == hipSuccess;
#else
        ok &= hipFuncSetAttribute((const void*)k_mega, hipFuncAttributeMaxDynamicSharedMemorySize, LDS_BYTES) == hipSuccess;
#endif
        if (!ok) { fprintf(stderr, "kernel_launch: hipFuncSetAttribute failed\n"); grid = -1; return; }
        grid = cus;
    }
    if (grid < 0) return;
    const int G = grid;
#if MK_MULTI
    k_ph<PH_MOD><<<G, 512, LDS_BYTES, stream>>>(p, 0);
    k_ph<PH_CONVERT><<<G, 512, LDS_BYTES, stream>>>(p, 0);
    for (int l = 0; l < DEPTH; ++l) {
        if (l == 0) k_ph<PH_NORM1><<<G, 512, LDS_BYTES, stream>>>(p, l);
        k_ph<PH_GEMM1><<<G, 512, LDS_BYTES, stream>>>(p, l);
        k_attn2<0><<<G, 512, LDS_BYTES, stream>>>(p, l);
        k_mixrest<0><<<G, 512, LDS_BYTES, stream>>>(p, l);
        k_ph<PH_GEMM2><<<G, 512, LDS_BYTES, stream>>>(p, l);
        k_ph<PH_NORM2><<<G, 512, LDS_BYTES, stream>>>(p, l);
        k_ph<PH_GEMM3><<<G, 512, LDS_BYTES, stream>>>(p, l);
        k_topk<0><<<G, 512, LDS_BYTES, stream>>>(p, l);
        k_expert<<<G, 512, LDS_BYTES, stream>>>(p, l);
    }
#else
    (void)hipMemsetAsync(p.bar(), 0, (size_t)XCD_BAR_WORDS * 4, stream);
    k_mega<<<G, 512, LDS_BYTES, stream>>>(p);
#endif
}
```

```cpp
#include <hip/hip_runtime.h>
#include <stdint.h>
#include <stdio.h>
#include <math.h>

#define D_MODEL 1024
#define BATCH 8
#define SEQ 2048
#define DEPTH 4
#define NTOK (BATCH * SEQ)
#define MIX_IN 2560
#define N_MOD 6
#define MODW (N_MOD * D_MODEL)
#define NEXP 16384

#define MK_MULTI 0
#define FUSE_TOPK_EXPERT 0
#define EXPERT_MAP_GROUPED 1
#ifndef PROBE_MASK
#define PROBE_MASK 0
#endif
#define PROBE_TIME 0
#define PROBE_SYNTH 0
#define PROBE_UB 0
#define PROBE_BLOCK 0
#define LAS __attribute__((address_space(3)))
typedef unsigned short bf16_t;
typedef short bf16x8 __attribute__((ext_vector_type(8)));
typedef float f32x4 __attribute__((ext_vector_type(4)));
typedef float f32x16 __attribute__((ext_vector_type(16)));
typedef unsigned u32x4 __attribute__((ext_vector_type(4)));
typedef unsigned u32x2 __attribute__((ext_vector_type(2)));
typedef float f32x2 __attribute__((ext_vector_type(2)));

__device__ const unsigned char kBucket[128] = {
    0, 1, 2, 3, 4, 5, 6, 7, 8, 9, 10, 11, 12, 13, 14, 15, 16, 16, 16, 17, 17, 18, 18, 18, 19, 19, 19, 20, 20, 20, 20, 21,
    21, 21, 21, 22, 22, 22, 22, 22, 23, 23, 23, 23, 23, 23, 24, 24, 24, 24, 24, 24, 25, 25, 25, 25, 25, 25, 25, 26, 26, 26, 26, 26,
    26, 26, 26, 27, 27, 27, 27, 27, 27, 27, 27, 27, 27, 28, 28, 28, 28, 28, 28, 28, 28, 28, 28, 29, 29, 29, 29, 29, 29, 29, 29, 29,
    29, 29, 29, 30, 30, 30, 30, 30, 30, 30, 30, 30, 30, 30, 30, 30, 30, 31, 31, 31, 31, 31, 31, 31, 31, 31, 31, 31, 31, 31, 31, 31};

__device__ __forceinline__ float bf2f(bf16_t v) { return __uint_as_float(((unsigned)v) << 16); }
__device__ __forceinline__ float bflo(unsigned w) { return __uint_as_float(w << 16); }
__device__ __forceinline__ float bfhi(unsigned w) { return __uint_as_float(w & 0xFFFF0000u); }
__device__ __forceinline__ bf16_t f2bf(float f) { unsigned u = __float_as_uint(f); u += 0x7FFFu + ((u >> 16) & 1u); return (bf16_t)(u >> 16); }
__device__ __forceinline__ unsigned pk2(float lo, float hi) { unsigned r; asm volatile("v_cvt_pk_bf16_f32 %0, %1, %2" : "=v"(r) : "v"(lo), "v"(hi)); return r; }
__device__ __forceinline__ float ldf(const float* p) { return *p; }
__device__ __forceinline__ float ldf(const bf16_t* p) { return bf2f(*p); }

__device__ __forceinline__ float gelu_as(float v) {
    const float av = fabsf(v), t = __builtin_amdgcn_rcpf(av * 0.2316418882f + 1.0f);
    float q = t * 0.5307027145f + (-0.7265760135f); q = q * t + 0.7107068705f; q = q * t + (-0.142248368f); q = q * t + 0.127414796f; q = q * t;
    const float e = __builtin_amdgcn_exp2f((v * v) * (-0.72134752044f));
    const float m = v * (q * e);
    return v < 0.f ? m : v - m;
}
template <int CTRL, int ROWMASK = 0xF>
__device__ __forceinline__ float dpp_add(float x) {
    const int y = __builtin_amdgcn_update_dpp(0, __float_as_int(x), CTRL, ROWMASK, 0xF, false);
    return x + __int_as_float(y);
}
__device__ __forceinline__ float wave_sum_l63(float v) {
    v = dpp_add<0xB1>(v);
    v = dpp_add<0x4E>(v);
    v = dpp_add<0x141>(v);
    v = dpp_add<0x140>(v);
    v = dpp_add<0x142, 0xA>(v);
    v = dpp_add<0x143, 0xC>(v);
    return v;
}
__device__ __forceinline__ float gelu_exact(float v) { return 0.5f * v * (1.0f + erff(v * 0.70710678118654752f)); }
__device__ __forceinline__ float sigmoidf_(float v) { return 1.0f / (1.0f + __expf(-v)); }
__device__ __forceinline__ float wave_sum(float v) {
#pragma unroll
    for (int o = 32; o > 0; o >>= 1) v += __shfl_xor(v, o, 64);
    return v;
}
__device__ __forceinline__ float block_sum256(float v, float* red) {
    v = wave_sum(v);
    __syncthreads();
    if ((threadIdx.x & 63) == 0) red[threadIdx.x >> 6] = v;
    __syncthreads();
    return red[0] + red[1] + red[2] + red[3];
}

__device__ __forceinline__ int tid_opaque(int wv) {
    int t;
    asm volatile("v_mbcnt_lo_u32_b32 %0, -1, 0\n\tv_mbcnt_hi_u32_b32 %0, -1, %0" : "=v"(t));
    return (wv << 6) | t;
}
__device__ __forceinline__ int launder(int v) { asm volatile("" : "+v"(v)); return v; }
#define XB_TMO      128
#define XB_XCNT(j)  (256  + 64 * (j))
#define XB_XSUB(j)  (1280 + 64 * (j))
#define XB_XGEN(j)  (2304 + 64 * (j))
#define XB_TOP      3328
#define XB_TOPGEN   3392
#define XCD_BAR_WORDS 3456
#define XB_SPIN_CAP (1u << 18)

__device__ __forceinline__ unsigned xb_ld(unsigned* p)              { return __hip_atomic_load(p, __ATOMIC_RELAXED, __HIP_MEMORY_SCOPE_AGENT); }
__device__ __forceinline__ unsigned xb_add(unsigned* p, unsigned v) { return __hip_atomic_fetch_add(p, v, __ATOMIC_RELAXED, __HIP_MEMORY_SCOPE_AGENT); }
__device__ __forceinline__ unsigned xb_xcc_id() { return (unsigned)__builtin_amdgcn_s_getreg((3 << 11) | 20) & 0xFu; }
#define XB_SPIN(cond, bar) do { unsigned _sp = 0; while (cond) { __builtin_amdgcn_s_sleep(1); \
    if ((++_sp & 255u) == 0u) { if (xb_ld(&(bar)[XB_TMO])) break; if (_sp > XB_SPIN_CAP) { atomicAdd(&(bar)[XB_TMO], 1u); break; } } } } while (0)

struct XcdBarrier {
    unsigned* bar; unsigned x;
    bool t0;
    volatile LAS unsigned* st;
};

__device__ __forceinline__ XcdBarrier xcd_barrier_post(unsigned* bar, volatile LAS unsigned* st) {
    XcdBarrier b; b.bar = bar; b.x = xb_xcc_id(); b.st = st;
    if (threadIdx.x == 0) (void)xb_add(&bar[XB_XCNT(b.x)], 1u);
    return b;
}
__device__ __forceinline__ void xcd_barrier_complete(unsigned* bar, unsigned x, unsigned& nloc, unsigned& nx) {
    const unsigned G = gridDim.x * gridDim.y * gridDim.z;
    unsigned sum, cnt, mine, sp = 0u;
    for (;;) {
        sum = 0u; cnt = 0u; mine = 0u;
#pragma unroll
        for (unsigned j = 0; j < 16; ++j) { const unsigned c = xb_ld(&bar[XB_XCNT(j)]); sum += c; cnt += (c > 0u) ? 1u : 0u; mine = (j == x) ? c : mine; }
        if (sum == G) break;
        __builtin_amdgcn_s_sleep(1);
        if ((++sp & 255u) == 0u) { if (xb_ld(&bar[XB_TMO])) break; if (sp > XB_SPIN_CAP) { atomicAdd(&bar[XB_TMO], 1u); break; } }
    }
    nloc = mine > 0u ? mine : 1u; nx = cnt > 0u ? cnt : 1u;
}

__device__ __forceinline__ void xcd_barrier(const XcdBarrier& b) {
    asm volatile("s_waitcnt vmcnt(0)" ::: "memory");
    __syncthreads();
    if (b.t0) {
        unsigned* bar = b.bar;
        __builtin_amdgcn_s_waitcnt(0);
        unsigned nloc = b.st[0], nx = b.st[1];
        if (nloc == 0u) { xcd_barrier_complete(bar, b.x, nloc, nx); b.st[0] = nloc; b.st[1] = nx; }
        const unsigned old = xb_add(&bar[XB_XSUB(b.x)], 1u);
        const unsigned gen = old / nloc;
        if (old + 1u == (gen + 1u) * nloc) {
            __builtin_amdgcn_fence(__ATOMIC_RELEASE, "agent");
            asm volatile("s_waitcnt vmcnt(0)" ::: "memory");
            const unsigned og = xb_add(&bar[XB_TOP], 1u);
            const unsigned tg = og / nx;
            if (og + 1u == (tg + 1u) * nx) xb_add(&bar[XB_TOPGEN], 1u);
            else XB_SPIN(xb_ld(&bar[XB_TOPGEN]) == tg, bar);
            __builtin_amdgcn_fence(__ATOMIC_ACQUIRE, "agent");
            xb_add(&bar[XB_XGEN(b.x)], 1u);
            asm volatile("s_waitcnt vmcnt(0)" ::: "memory");
        } else {
            XB_SPIN(xb_ld(&bar[XB_XGEN(b.x)]) == gen, bar);
            __builtin_amdgcn_fence(__ATOMIC_ACQUIRE, "agent");
            asm volatile("s_waitcnt vmcnt(0)" ::: "memory");
        }
    }
    __syncthreads();
}
namespace pg8 {
#define PG8_LAS __attribute__((address_space(3)))
typedef unsigned short bf16_t;
typedef short bf16x8 __attribute__((ext_vector_type(8)));
typedef float f32x4 __attribute__((ext_vector_type(4)));
typedef unsigned u32x4 __attribute__((ext_vector_type(4)));
constexpr int BM = 256, BK = 64, HALF = 128, HTB = HALF * BK * 2  , STAGE_BYTES = 8 * HTB, NXCD = 8, WGM = 8;

__host__ __device__ __forceinline__ int lds_byte(int r, int c) { const int st = (r >> 4) * 2 + (c >> 5), rr = r & 15, cc = c & 31, ob = rr * 64 + cc * 2; return st * 1024 + (ob ^ (((ob >> 9) & 1) << 5)); }
__host__ __device__ __forceinline__ void stage_rc(int b, int& R, int& C) { const int st = b / 1024, sb = b % 1024, swz = sb ^ (((sb >> 9) & 1) << 5); R = (st >> 1) * 16 + swz / 64; C = (st & 1) * 32 + (swz % 64) / 2; }
__host__ __device__ __forceinline__ int perm32(int rho) { const int n = rho >> 4, i = rho & 15; return 8 * (i >> 2) + 4 * n + (i & 3); }

struct Unit { int pm, pn; };
struct Gemm { const bf16_t* A; const bf16_t* Bt; int M, N, K; };

struct StaticOrder {
    int nM, nN, nwg, G, c;
    __host__ __device__ void init(int M, int N, int G_, int c_) { nM = M / BM; nN = N / BM; nwg = nM * nN; G = G_; c = c_; }
    __host__ __device__ bool next(int i, Unit& u) const {
        const long L = (long)i * G + c; if (L >= nwg) return false;
        int wgid = (int)L; { const int q = nwg / NXCD, r = nwg % NXCD, xcd = wgid % NXCD, off = wgid / NXCD; wgid = (xcd < r ? xcd * (q + 1) : r * (q + 1) + (xcd - r) * q) + off; }
        const int nig = WGM * nN, gid = wgid / nig, fm = gid * WGM, gsz = (nM - fm) < WGM ? (nM - fm) : WGM;
        u.pm = fm + ((wgid % nig) % gsz); u.pn = (wgid % nig) / gsz; return true;
    }
    __device__ __forceinline__ void a_ready(const Unit&) const {}
    __device__ __forceinline__ void done(const Unit&) const {}
};
__device__ __forceinline__ unsigned cvt_pk_bf16(float lo, float hi) { unsigned r; asm volatile("v_cvt_pk_bf16_f32 %0, %1, %2" : "=v"(r) : "v"(lo), "v"(hi)); return r; }
template <class Epi, class Sched, bool STAMP = false>
__device__ __forceinline__ void gemm_phase(PG8_LAS unsigned char* lds, const Gemm g, const Sched& S, const Epi& E, unsigned long long* stamps, int wv) {
    const int tid = tid_opaque(wv), wid = __builtin_amdgcn_readfirstlane(tid >> 6), lane = tid & 63, wr = wid >> 2, wc = wid & 3, fr = lane & 15, fq = lane >> 4;
    const int K = g.K, nt = K / BK;
    int ts_lo = 0, ts_hi = 0, nts = 0; const unsigned long long rt_entry = STAMP ? (unsigned long long)wall_clock64() : 0ull;
#define PG8_STAMP() do { if (STAMP && wid == 0 && nts < 64) { const unsigned long long _c = (unsigned long long)clock64(); \
        ts_lo = (lane == nts) ? (int)(unsigned)_c : ts_lo; ts_hi = (lane == nts) ? (int)(unsigned)(_c >> 32) : ts_hi; ++nts; } } while (0)
    PG8_STAMP();
    unsigned voffA[2], voffB[2];
#pragma unroll
    for (int i = 0; i < 2; ++i) { int R, C; stage_rc(tid * 16 + i * 8192, R, C); const int Rb = Epi::PERM ? ((R & ~31) + perm32(R & 31)) : R;
        voffA[i] = (unsigned)(R * K + C) * 2u; voffB[i] = (unsigned)(Rb * K + C) * 2u; }
    const size_t kstep = (size_t)(BK * 2);
    const size_t hstep = (size_t)HALF * K * 2;
    const size_t tstep = 2 * hstep;
    const unsigned ldsw = (unsigned)wid * 1024u;
    const int aoff = lds_byte(wr * 64 + fr, fq * 8), boff = lds_byte(wc * 32 + fr, fq * 8);
#define PG8_SA(b, h) (((b) * 2 + (h)) * HTB)
#define PG8_SB(b, h) ((4 + (b) * 2 + (h)) * HTB)
#define PG8_STAGE(bufoff, gbase, voff) do { _Pragma("unroll") for (int _i = 0; _i < 2; ++_i) \
        __builtin_amdgcn_global_load_lds((const unsigned*)((const char*)(gbase) + (voff)[_i]), (PG8_LAS unsigned*)(lds + (bufoff) + ldsw + _i * 8192), 16, 0, 0); } while (0)
#define PG8_LDA(dst, b, h) do { _Pragma("unroll") for (int m = 0; m < 4; ++m) _Pragma("unroll") for (int k = 0; k < 2; ++k) dst[m][k] = *(const PG8_LAS bf16x8*)(lds + PG8_SA(b, h) + aoff + m * 2048 + k * 1024); } while (0)
#define PG8_LDB(dst, b, h) do { _Pragma("unroll") for (int n = 0; n < 2; ++n) _Pragma("unroll") for (int k = 0; k < 2; ++k) dst[n][k] = *(const PG8_LAS bf16x8*)(lds + PG8_SB(b, h) + boff + n * 2048 + k * 1024); } while (0)
#define PG8_MMA(ai, bj, At, Bt) do { __builtin_amdgcn_s_setprio(1); _Pragma("unroll") for (int m = 0; m < 4; ++m) _Pragma("unroll") for (int n = 0; n < 2; ++n) _Pragma("unroll") for (int k = 0; k < 2; ++k) \
        acc[ai][bj][m][n] = __builtin_amdgcn_mfma_f32_16x16x32_bf16(Bt[n][k], At[m][k], acc[ai][bj][m][n], 0, 0, 0); __builtin_amdgcn_s_setprio(0); } while (0)
#define PG8_WAIT_V(n) asm volatile("s_waitcnt vmcnt(" #n ")" ::: "memory")
#define PG8_WAIT_L(n) asm volatile("s_waitcnt lgkmcnt(" #n ")" ::: "memory")
#define PG8_BAR __builtin_amdgcn_s_barrier()
#define PG8_SCHED __builtin_amdgcn_sched_barrier(0)
    Unit cur, nxt; int ui = 0;
    if (!S.next(0, cur)) return;
    f32x4 acc[2][2][4][2];
#pragma unroll
    for (int a = 0; a < 2; ++a)
#pragma unroll
        for (int b = 0; b < 2; ++b)
#pragma unroll
            for (int m = 0; m < 4; ++m)
#pragma unroll
                for (int n = 0; n < 2; ++n) acc[a][b][m][n] = (f32x4){0.f, 0.f, 0.f, 0.f};
    bf16x8 At[4][2], B0[2][2], B1[2][2];
    const char* cA = (const char*)g.A + (size_t)cur.pm * tstep; const char* cB = (const char*)g.Bt + (size_t)cur.pn * tstep;
    S.a_ready(cur);
    PG8_STAGE(PG8_SB(0, 0), cB, voffB); PG8_STAGE(PG8_SA(0, 0), cA, voffA); PG8_STAGE(PG8_SB(0, 1), cB + hstep, voffB); PG8_STAGE(PG8_SA(0, 1), cA + hstep, voffA);
    if (wr == 1) PG8_BAR;
    PG8_WAIT_V(4); PG8_BAR;
    PG8_STAGE(PG8_SB(1, 0), cB + kstep, voffB); PG8_STAGE(PG8_SA(1, 0), cA + kstep, voffA); PG8_STAGE(PG8_SB(1, 1), cB + hstep + kstep, voffB);
    PG8_WAIT_V(6); PG8_BAR;
    PG8_STAMP();
    for (;;) {
        const bool has_next = S.next(ui + 1, nxt);
        const char* nA = has_next ? (const char*)g.A + (size_t)nxt.pm * tstep : cA; const char* nB = has_next ? (const char*)g.Bt + (size_t)nxt.pn * tstep : cB;
        for (int t = 0; t < nt; t += 2) {
            const bool last = (t == nt - 2);
            const char* a1 = cA + (size_t)(t + 1) * kstep;
            const char* a2 = last ? nA : cA + (size_t)(t + 2) * kstep; const char* b2 = last ? nB : cB + (size_t)(t + 2) * kstep;
            const char* a3 = a2 + kstep; const char* b3 = b2 + kstep;
            if (last && has_next) S.a_ready(nxt);
            PG8_LDB(B0, 0, 0); PG8_SCHED; PG8_LDA(At, 0, 0); PG8_STAGE(PG8_SA(1, 1), a1 + hstep, voffA);
            PG8_WAIT_L(8); PG8_BAR; PG8_WAIT_L(0); PG8_MMA(0, 0, At, B0); PG8_BAR; PG8_SCHED;
            PG8_LDB(B1, 0, 1); PG8_STAGE(PG8_SB(0, 0), b2, voffB);
            PG8_BAR; PG8_WAIT_L(0); PG8_MMA(0, 1, At, B1); PG8_BAR;
            PG8_LDA(At, 0, 1); PG8_STAGE(PG8_SA(0, 0), a2, voffA);
            PG8_BAR; PG8_WAIT_L(0); PG8_MMA(1, 0, At, B0); PG8_BAR; PG8_SCHED;
            PG8_STAGE(PG8_SB(0, 1), b2 + hstep, voffB);
            PG8_WAIT_V(6); PG8_BAR; PG8_MMA(1, 1, At, B1); PG8_BAR;
            PG8_LDB(B0, 1, 0); PG8_SCHED; PG8_LDA(At, 1, 0); PG8_STAGE(PG8_SA(0, 1), a2 + hstep, voffA);
            PG8_WAIT_L(8); PG8_BAR; PG8_WAIT_L(0); PG8_MMA(0, 0, At, B0); PG8_BAR; PG8_SCHED;
            PG8_LDB(B1, 1, 1); PG8_STAGE(PG8_SB(1, 0), b3, voffB);
            PG8_BAR; PG8_WAIT_L(0); PG8_MMA(0, 1, At, B1); PG8_BAR;
            PG8_LDA(At, 1, 1); PG8_STAGE(PG8_SA(1, 0), a3, voffA);
            PG8_BAR; PG8_WAIT_L(0); PG8_MMA(1, 0, At, B0); PG8_BAR; PG8_SCHED;
            PG8_STAGE(PG8_SB(1, 1), b3 + hstep, voffB);
            PG8_WAIT_V(6); PG8_BAR; PG8_MMA(1, 1, At, B1); PG8_BAR;
        }
        PG8_STAMP();
        if constexpr (!Epi::AFTER_DRAIN) { E(acc, cur, wr, wc, fr, fq); S.done(cur); }
        PG8_STAMP();
        if (!has_next) break;
#pragma unroll
        for (int a = 0; a < 2; ++a)
#pragma unroll
            for (int b = 0; b < 2; ++b)
#pragma unroll
                for (int m = 0; m < 4; ++m)
#pragma unroll
                    for (int n = 0; n < 2; ++n) acc[a][b][m][n] = (f32x4){0.f, 0.f, 0.f, 0.f};
        cur = nxt; cA = nA; cB = nB; ++ui;
    }
    PG8_WAIT_V(0);
    if (wr == 0) PG8_BAR;
    PG8_BAR;
    if constexpr (Epi::AFTER_DRAIN) { E.fused(acc, cur, wr, wc, fr, fq, lds, wid, lane); S.done(cur); }
    PG8_STAMP();
    if (STAMP && wid == 0) { stamps[lane] = lane < nts ? (((unsigned long long)(unsigned)ts_hi << 32) | (unsigned)ts_lo) : 0ull;
        if (lane == 62) stamps[62] = rt_entry; if (lane == 63) stamps[63] = (unsigned long long)wall_clock64(); }
#undef PG8_STAMP
#undef PG8_SA
#undef PG8_SB
#undef PG8_STAGE
#undef PG8_LDA
#undef PG8_LDB
#undef PG8_MMA
#undef PG8_WAIT_V
#undef PG8_WAIT_L
#undef PG8_BAR
#undef PG8_SCHED
}
}

constexpr size_t ws_al(size_t x) { return (x + 255) & ~(size_t)255; }
constexpr size_t OFF_BAR = 0;
constexpr size_t OFF_CTR = OFF_BAR + ws_al((size_t)3456 * 4);
constexpr size_t CTR_BYTES = 64 * 256;
constexpr size_t OFF_MOD = OFF_CTR + CTR_BYTES;
constexpr size_t OFF_XB = OFF_MOD + ws_al((size_t)DEPTH * BATCH * MODW * 4);
constexpr size_t OFF_HB = OFF_XB + ws_al((size_t)NTOK * D_MODEL * 4);
constexpr size_t OFF_PB = OFF_HB + ws_al((size_t)NTOK * D_MODEL * 2);
constexpr size_t OFF_CAT = OFF_PB + ws_al((size_t)NTOK * MIX_IN * 2);
constexpr size_t OFF_QB = OFF_CAT + ws_al((size_t)NTOK * D_MODEL * 2);
constexpr size_t OFF_WINT = OFF_QB + ws_al((size_t)NTOK * 2048 * 2);
constexpr size_t OFF_WOUTT = OFF_WINT + ws_al((size_t)DEPTH * MIX_IN * D_MODEL * 2);
constexpr size_t OFF_WQT = OFF_WOUTT + ws_al((size_t)DEPTH * D_MODEL * D_MODEL * 2);
constexpr size_t OFF_KEYSB = OFF_WQT + ws_al((size_t)DEPTH * 2048 * D_MODEL * 2);
constexpr size_t OFF_SGUWB = OFF_KEYSB + ws_al((size_t)DEPTH * 16 * 128 * 128 * 2);
constexpr size_t OFF_UB8 = OFF_SGUWB + ws_al((size_t)DEPTH * 4 * 128 * 128 * 2);
constexpr size_t OFF_VB8 = OFF_UB8 + ws_al((size_t)DEPTH * NEXP * D_MODEL);
constexpr size_t OFF_UINV = OFF_VB8 + ws_al((size_t)DEPTH * NEXP * D_MODEL);
constexpr size_t OFF_VINV = OFF_UINV + ws_al((size_t)DEPTH * NEXP * 4);
constexpr size_t OFF_EIDX = OFF_VINV + ws_al((size_t)DEPTH * NEXP * 4);
constexpr size_t OFF_EGATE = OFF_EIDX + ws_al((size_t)NTOK * 128 * 4);
constexpr size_t OFF_SSQ = OFF_EGATE + ws_al((size_t)NTOK * 128 * 4);
constexpr size_t OFF_BIASQ = OFF_SSQ + ws_al((size_t)NTOK * 16 * 4);
constexpr size_t WS_END = OFF_BIASQ + ws_al((size_t)DEPTH * BATCH * 2048 * 4);

struct Params {
    const float *x_in, *c, *rel_bias, *w_mod, *b_mod, *norm1_g, *norm2_g, *w_in, *w_out, *diff_lambda, *subln_g, *conf_dw, *conf_ln_g, *conf_ln_b, *sconv_w,
        *sgu_ln_g, *sgu_ln_b, *sgu_w, *sgu_b, *peer_wq, *peer_keys, *peer_u, *peer_v, *final_g;
    float* out;
    unsigned char* ws;
    float lam_init[DEPTH];
    __host__ __device__ unsigned* bar() const { return (unsigned*)(ws + OFF_BAR); }
    __host__ __device__ unsigned* ctr(int i) const { return (unsigned*)(ws + OFF_CTR + (size_t)i * 256); }
    __host__ __device__ float* mod() const { return (float*)(ws + OFF_MOD); }
    __host__ __device__ float* xb() const { return (float*)(ws + OFF_XB); }
    __host__ __device__ bf16_t* hb() const { return (bf16_t*)(ws + OFF_HB); }
    __host__ __device__ bf16_t* pb() const { return (bf16_t*)(ws + OFF_PB); }
    __host__ __device__ bf16_t* cat() const { return (bf16_t*)(ws + OFF_CAT); }
    __host__ __device__ bf16_t* qb() const { return (bf16_t*)(ws + OFF_QB); }
    __host__ __device__ bf16_t* WinT() const { return (bf16_t*)(ws + OFF_WINT); }
    __host__ __device__ bf16_t* WoutT() const { return (bf16_t*)(ws + OFF_WOUTT); }
    __host__ __device__ bf16_t* WqT() const { return (bf16_t*)(ws + OFF_WQT); }
    __host__ __device__ bf16_t* keysb() const { return (bf16_t*)(ws + OFF_KEYSB); }
    __host__ __device__ bf16_t* sguwb() const { return (bf16_t*)(ws + OFF_SGUWB); }
    __host__ __device__ unsigned char* ub8() const { return ws + OFF_UB8; }
    __host__ __device__ unsigned char* vb8() const { return ws + OFF_VB8; }
    __host__ __device__ float* uinv() const { return (float*)(ws + OFF_UINV); }
    __host__ __device__ float* vinv() const { return (float*)(ws + OFF_VINV); }
    __host__ __device__ int* eidx() const { return (int*)(ws + OFF_EIDX); }
    __host__ __device__ float* egate() const { return (float*)(ws + OFF_EGATE); }
    __host__ __device__ float* ssq() const { return (float*)(ws + OFF_SSQ); }
    __host__ __device__ float* biasq() const { return (float*)(ws + OFF_BIASQ); }
};

#define LDS_BYTES (160 * 1024)
#define NWAVES 8

__device__ __forceinline__ void transpose_item(const float* __restrict__ W, int K, int N, bf16_t* __restrict__ WT, LAS float* scr, int item, int lane) {
    const int nblk = N / 32, kb = item / nblk, nb = item % nblk, k0 = 64 * kb, n0 = 32 * nb;
#pragma unroll 8
    for (int i = 0; i < 32; ++i) { const int kk = 2 * i + (lane >> 5); scr[kk * 33 + (lane & 31)] = W[(size_t)(k0 + kk) * N + n0 + (lane & 31)]; }
    asm volatile("s_waitcnt lgkmcnt(0)" ::: "memory");
    const int c = lane & 7;
#pragma unroll
    for (int j = 0; j < 4; ++j) {
        const int n = (lane >> 3) + 8 * j; const LAS float* s = scr + (8 * c) * 33 + n;
        u32x4 o; o.x = pk2(s[0 * 33], s[1 * 33]); o.y = pk2(s[2 * 33], s[3 * 33]); o.z = pk2(s[4 * 33], s[5 * 33]); o.w = pk2(s[6 * 33], s[7 * 33]);
        *(u32x4*)(WT + (size_t)(n0 + n) * K + k0 + 8 * c) = o;
    }
    asm volatile("s_waitcnt lgkmcnt(0)" ::: "memory");
}
__device__ __forceinline__ void cvt8(const float* __restrict__ s, bf16_t* __restrict__ d) {
    const f32x4 a = *(const f32x4*)s, b = *(const f32x4*)(s + 4);
    u32x4 o; o.x = pk2(a[0], a[1]); o.y = pk2(a[2], a[3]); o.z = pk2(b[0], b[1]); o.w = pk2(b[2], b[3]);
    *(u32x4*)d = o;
}
__device__ __forceinline__ void phase_convert(const Params& p, LAS unsigned char* lds, int wv) {
    const int tid = tid_opaque(wv), wave = tid >> 6, lane = tid & 63;
    LAS float* scr = (LAS float*)(lds + wave * 16384);
    const int gw = blockIdx.x * NWAVES + wave, NGW = gridDim.x * NWAVES;
    constexpr int I_IN = (D_MODEL / 64) * (MIX_IN / 32), I_OUT = (D_MODEL / 64) * (D_MODEL / 32), I_Q = (D_MODEL / 64) * (2048 / 32), I_L = I_IN + I_OUT + I_Q;
    for (int it = gw; it < DEPTH * I_L; it += NGW) {
        const int l = it / I_L; int r = it % I_L;
        if (r < I_IN) { transpose_item(p.w_in + (size_t)l * D_MODEL * MIX_IN, D_MODEL, MIX_IN, p.WinT() + (size_t)l * MIX_IN * D_MODEL, scr, r, lane); continue; } r -= I_IN;
        if (r < I_OUT) { transpose_item(p.w_out + (size_t)l * D_MODEL * D_MODEL, D_MODEL, D_MODEL, p.WoutT() + (size_t)l * D_MODEL * D_MODEL, scr, r, lane); continue; } r -= I_OUT;
        transpose_item(p.peer_wq + (size_t)l * D_MODEL * 2048, D_MODEL, 2048, p.WqT() + (size_t)l * 2048 * D_MODEL, scr, r, lane);
    }
    const size_t gt = (size_t)blockIdx.x * 512 + tid, NGT = (size_t)gridDim.x * 512;
    constexpr size_t N_KEYS8 = (size_t)DEPTH * 16 * 128 * 128 / 8, N_TAB8 = (size_t)DEPTH * NEXP * D_MODEL / 8, N_SGU8 = (size_t)DEPTH * 4 * 128 * 128 / 8;
    for (size_t i = gt; i < N_KEYS8; i += NGT) cvt8(p.peer_keys + i * 8, p.keysb() + i * 8);
    for (size_t row = gw; row < (size_t)2 * DEPTH * NEXP; row += NGW) {
        const bool isv = row >= (size_t)DEPTH * NEXP; const size_t r = isv ? row - (size_t)DEPTH * NEXP : row;
        const float* src = (isv ? p.peer_v : p.peer_u) + r * D_MODEL + lane * 16;
        f32x4 a[4]; float ss = 0.f;
#pragma unroll
        for (int q = 0; q < 4; ++q) { a[q] = *(const f32x4*)(src + 4 * q); ss += a[q][0] * a[q][0] + a[q][1] * a[q][1] + a[q][2] * a[q][2] + a[q][3] * a[q][3]; }
        ss = wave_sum(ss);
        const float step = fmaxf(0.335f * sqrtf(ss * (1.0f / D_MODEL)), 1e-30f), sc = 1.0f / step;
        unsigned o[2];
#pragma unroll
        for (int d = 0; d < 2; ++d) {
            unsigned w = 0;
#pragma unroll
            for (int e = 0; e < 8; ++e) {
                const float v = a[2 * d + (e >> 2)][e & 3];
                const int qv = (int)fminf(fmaxf(rintf(v * sc), -8.f), 7.f) + 8;
                w |= (unsigned)qv << (8 * (e >> 1) + 4 * (e & 1));
            }
            o[d] = w;
        }
        *(u32x2*)((isv ? p.vb8() : p.ub8()) + r * (D_MODEL / 2) + lane * 8) = (u32x2){o[0], o[1]};
        if (lane == 0) (isv ? p.vinv() : p.uinv())[r] = step;
    }
    for (size_t i = gt; i < N_SGU8; i += NGT) {
        const size_t e = i * 8; const int s0 = (int)(e & 127), t = (int)((e >> 7) & 127);
        const f32x4 a = *(const f32x4*)(p.sgu_w + e), b = *(const f32x4*)(p.sgu_w + e + 4);
        float v[8] = {a[0], a[1], a[2], a[3], b[0], b[1], b[2], b[3]};
#pragma unroll
        for (int j = 0; j < 8; ++j) v[j] = (s0 + j <= t) ? v[j] : 0.f;
        u32x4 o; o.x = pk2(v[0], v[1]); o.y = pk2(v[2], v[3]); o.z = pk2(v[4], v[5]); o.w = pk2(v[6], v[7]);
        *(u32x4*)(p.sguwb() + e) = o;
    }
}

__device__ __forceinline__ void norm_row(const float* __restrict__ xr, const float* __restrict__ g, const float* __restrict__ sh, const float* __restrict__ sc, bf16_t* __restrict__ hr, int lane) {
    f32x4 v[4]; float ss = 0.f;
#pragma unroll
    for (int j = 0; j < 4; ++j) { v[j] = *(const f32x4*)(xr + j * 256 + lane * 4); ss += v[j][0] * v[j][0] + v[j][1] * v[j][1] + v[j][2] * v[j][2] + v[j][3] * v[j][3]; }
    const float rs = rsqrtf(wave_sum(ss) * (1.0f / D_MODEL) + 1e-6f);
#pragma unroll
    for (int j = 0; j < 4; ++j) {
        const int col = j * 256 + lane * 4;
        const f32x4 gv = *(const f32x4*)(g + col), scv = *(const f32x4*)(sc + col), shv = *(const f32x4*)(sh + col);
        f32x4 y;
#pragma unroll
        for (int e = 0; e < 4; ++e) y[e] = v[j][e] * rs * gv[e] * (1.0f + scv[e]) + shv[e];
        u32x2 o; o.x = pk2(y[0], y[1]); o.y = pk2(y[2], y[3]);
        *(u32x2*)(hr + col) = o;
    }
}
__device__ __forceinline__ void phase_norm(const Params& p, const float* __restrict__ x, const float* __restrict__ g, const float* __restrict__ modl, int sh_idx, int sc_idx, int wv) {
    const int tid = tid_opaque(wv), wave = tid >> 6, lane = tid & 63;
    for (int t = blockIdx.x * NWAVES + wave; t < NTOK; t += gridDim.x * NWAVES) {
        const float* mb = modl + (size_t)(t / SEQ) * MODW;
        norm_row(x + (size_t)t * D_MODEL, g, mb + sh_idx * D_MODEL, mb + sc_idx * D_MODEL, p.hb() + (size_t)t * D_MODEL, lane);
    }
}

struct EpiStoreBf16 {
    static constexpr bool PERM = true, AFTER_DRAIN = false;
    bf16_t* O; int ldc;
    __device__ __forceinline__ void operator()(const pg8::f32x4 (&acc)[2][2][4][2], const pg8::Unit& u, int wr, int wc, int fr, int fq) const {
        const int row0 = u.pm * 256 + wr * 64 + fr, col0 = u.pn * 256 + wc * 32 + 8 * fq;
#pragma unroll
        for (int ai = 0; ai < 2; ++ai)
#pragma unroll
            for (int m = 0; m < 4; ++m) {
                bf16_t* rowp = O + (size_t)(row0 + ai * 128 + m * 16) * ldc + col0;
#pragma unroll
                for (int bj = 0; bj < 2; ++bj) {
                    const pg8::f32x4 v0 = acc[ai][bj][m][0], v1 = acc[ai][bj][m][1];
                    u32x4 w; w.x = pk2(v0[0], v0[1]); w.y = pk2(v0[2], v0[3]); w.z = pk2(v1[0], v1[1]); w.w = pk2(v1[2], v1[3]);
                    *(u32x4*)(rowp + bj * 128) = w;
                }
            }
    }
};
struct EpiResid {
    static constexpr bool PERM = false, AFTER_DRAIN = false;
    const float* xin; float* xout; const float* gate;
    __device__ __forceinline__ void operator()(const pg8::f32x4 (&acc)[2][2][4][2], const pg8::Unit& u, int wr, int wc, int fr, int fq) const {
        const int row0 = u.pm * 256 + wr * 64 + fr, col0 = u.pn * 256 + wc * 32 + 4 * fq;
        const float* gb = gate + (size_t)((u.pm * 256) / SEQ) * MODW + col0;
        pg8::f32x4 gv[2][2];
#pragma unroll
        for (int bj = 0; bj < 2; ++bj)
#pragma unroll
            for (int n = 0; n < 2; ++n) gv[bj][n] = *(const pg8::f32x4*)(gb + bj * 128 + n * 16);
#pragma unroll
        for (int ai = 0; ai < 2; ++ai)
#pragma unroll
            for (int m = 0; m < 4; ++m) {
                const size_t off = (size_t)(row0 + ai * 128 + m * 16) * D_MODEL + col0;
#pragma unroll
                for (int bj = 0; bj < 2; ++bj)
#pragma unroll
                    for (int n = 0; n < 2; ++n) {
                        const pg8::f32x4 xv = *(const pg8::f32x4*)(xin + off + bj * 128 + n * 16);
                        *(pg8::f32x4*)(xout + off + bj * 128 + n * 16) = xv + gv[bj][n] * acc[ai][bj][m][n];
                    }
            }
    }
};

struct EpiResidNorm {
    static constexpr bool PERM = false, AFTER_DRAIN = false;
    const float* xin; float* xout; const float* modl; const float* n2g; bf16_t* hb; float* ssq;
    __device__ __forceinline__ void operator()(const pg8::f32x4 (&acc)[2][2][4][2], const pg8::Unit& u, int wr, int wc, int fr, int fq) const {
        const int row0 = u.pm * 256 + wr * 64 + fr, col0 = u.pn * 256 + wc * 32 + 4 * fq;
        const float* mb = modl + (size_t)((u.pm * 256) / SEQ) * MODW;
        pg8::f32x4 gv[2][2], gm[2][2];
#pragma unroll
        for (int bj = 0; bj < 2; ++bj)
#pragma unroll
            for (int n = 0; n < 2; ++n) {
                const int c = col0 + bj * 128 + n * 16;
                gv[bj][n] = *(const pg8::f32x4*)(mb + 2 * D_MODEL + c);
                gm[bj][n] = *(const pg8::f32x4*)(n2g + c) * (*(const pg8::f32x4*)(mb + 4 * D_MODEL + c) + 1.0f);
            }
#pragma unroll
        for (int ai = 0; ai < 2; ++ai)
#pragma unroll
            for (int m = 0; m < 4; ++m) {
                const int row = row0 + ai * 128 + m * 16;
                const size_t off = (size_t)row * D_MODEL + col0;
                float sq = 0.f;
#pragma unroll
                for (int bj = 0; bj < 2; ++bj)
#pragma unroll
                    for (int n = 0; n < 2; ++n) {
                        const pg8::f32x4 xv = *(const pg8::f32x4*)(xin + off + bj * 128 + n * 16) + gv[bj][n] * acc[ai][bj][m][n];
                        *(pg8::f32x4*)(xout + off + bj * 128 + n * 16) = xv;
                        sq += xv[0] * xv[0] + xv[1] * xv[1] + xv[2] * xv[2] + xv[3] * xv[3];
                        const pg8::f32x4 hv = xv * gm[bj][n];
                        u32x2 o; o.x = pk2(hv[0], hv[1]); o.y = pk2(hv[2], hv[3]);
                        *(u32x2*)(hb + off + bj * 128 + n * 16) = o;
                    }
                sq += __shfl_xor(sq, 16, 64); sq += __shfl_xor(sq, 32, 64);
                if (fq == 0) ssq[(size_t)row * 16 + u.pn * 4 + wc] = sq;
            }
    }
};
struct EpiQ {
    static constexpr bool PERM = true, AFTER_DRAIN = false;
    bf16_t* O; const float* ssq; const float* biasq;
    __device__ __forceinline__ void operator()(const pg8::f32x4 (&acc)[2][2][4][2], const pg8::Unit& u, int wr, int wc, int fr, int fq) const {
        const int row0 = u.pm * 256 + wr * 64 + fr, col0 = u.pn * 256 + wc * 32 + 8 * fq;
        const float* bb = biasq + (size_t)((u.pm * 256) / SEQ) * 2048 + col0;
        pg8::f32x4 bv[2][2];
#pragma unroll
        for (int bj = 0; bj < 2; ++bj)
#pragma unroll
            for (int n = 0; n < 2; ++n) bv[bj][n] = *(const pg8::f32x4*)(bb + bj * 128 + 4 * n);
#pragma unroll
        for (int ai = 0; ai < 2; ++ai)
#pragma unroll
            for (int m = 0; m < 4; ++m) {
                const int row = row0 + ai * 128 + m * 16;
                const pg8::f32x4 s0 = *(const pg8::f32x4*)(ssq + (size_t)row * 16), s1 = *(const pg8::f32x4*)(ssq + (size_t)row * 16 + 4), s2 = *(const pg8::f32x4*)(ssq + (size_t)row * 16 + 8), s3 = *(const pg8::f32x4*)(ssq + (size_t)row * 16 + 12);
                const float tot = (((s0[0] + s0[1]) + (s0[2] + s0[3])) + ((s1[0] + s1[1]) + (s1[2] + s1[3]))) + (((s2[0] + s2[1]) + (s2[2] + s2[3])) + ((s3[0] + s3[1]) + (s3[2] + s3[3])));
                const float rs = rsqrtf(tot * (1.0f / D_MODEL) + 1e-6f);
                bf16_t* rowp = O + (size_t)row * 2048 + col0;
#pragma unroll
                for (int bj = 0; bj < 2; ++bj) {
                    const pg8::f32x4 v0 = acc[ai][bj][m][0] * rs + bv[bj][0], v1 = acc[ai][bj][m][1] * rs + bv[bj][1];
                    u32x4 w; w.x = pk2(v0[0], v0[1]); w.y = pk2(v0[2], v0[3]); w.z = pk2(v1[0], v1[1]); w.w = pk2(v1[2], v1[3]);
                    *(u32x4*)(rowp + bj * 128) = w;
                }
            }
    }
};

template <class Epi>
__device__ __forceinline__ void run_gemm(LAS unsigned char* lds, const bf16_t* A, const bf16_t* Bt, int M, int N, int K, const Epi& E, int wv) {
    pg8::StaticOrder S; S.init(M, N, (int)gridDim.x, (int)blockIdx.x);
    pg8::Gemm g; g.A = A; g.Bt = Bt; g.M = M; g.N = N; g.K = K;
    pg8::gemm_phase<Epi, pg8::StaticOrder, false>(lds, g, S, E, nullptr, wv);
}

typedef __amdgpu_buffer_rsrc_t rsrc_t;
struct G4 { u32x2 r[4]; };
__device__ __forceinline__ u32x2 bload8(rsrc_t r, int voff, int soff) { return __builtin_bit_cast(u32x2, __builtin_amdgcn_raw_buffer_load_b64(r, voff, soff, 0)); }
#define ROWB (D_MODEL / 2)
template <int G>
__device__ __forceinline__ void ex_issue(G4& R, rsrc_t rs, int e0, int e1, int voff, int emask = 0x3FFF) {
#pragma unroll
    for (int i = 0; i < 4; ++i) {
        const int e = __builtin_amdgcn_readlane(G < 16 ? e0 : e1, (4 * G + i) & 63) & emask;
        R.r[i] = bload8(rs, voff, e * ROWB);
    }
}
template <int CTRL, int ROWMASK = 0xF>
__device__ __forceinline__ int dpp_iadd(int x) { return x + __builtin_amdgcn_update_dpp(0, x, CTRL, ROWMASK, 0xF, false); }
__device__ __forceinline__ int wave_isum_l63(int v) {
    v = dpp_iadd<0xB1>(v); v = dpp_iadd<0x4E>(v); v = dpp_iadd<0x141>(v); v = dpp_iadd<0x140>(v); v = dpp_iadd<0x142, 0xA>(v); v = dpp_iadd<0x143, 0xC>(v);
    return v;
}
template <int G>
__device__ __forceinline__ void ex_passA(const G4& R, const int (&hq)[4], int hinit, int& KK0, int& KK1, int lane) {
    int a[4];
#pragma unroll
    for (int i = 0; i < 4; ++i) {
        const unsigned x0 = R.r[i][0], x1 = R.r[i][1];
        a[i] = hinit;
        a[i] = __builtin_amdgcn_sdot4((int)(x0 & 0x0F0F0F0Fu), hq[0], a[i], false);
        a[i] = __builtin_amdgcn_sdot4((int)((x0 >> 4) & 0x0F0F0F0Fu), hq[1], a[i], false);
        a[i] = __builtin_amdgcn_sdot4((int)(x1 & 0x0F0F0F0Fu), hq[2], a[i], false);
        a[i] = __builtin_amdgcn_sdot4((int)((x1 >> 4) & 0x0F0F0F0Fu), hq[3], a[i], false);
    }
#pragma unroll
    for (int i = 0; i < 4; ++i) a[i] = dpp_iadd<0xB1>(a[i]);
#pragma unroll
    for (int i = 0; i < 4; ++i) a[i] = dpp_iadd<0x4E>(a[i]);
#pragma unroll
    for (int i = 0; i < 4; ++i) a[i] = dpp_iadd<0x141>(a[i]);
#pragma unroll
    for (int i = 0; i < 4; ++i) a[i] = dpp_iadd<0x140>(a[i]);
#pragma unroll
    for (int i = 0; i < 4; ++i) a[i] = dpp_iadd<0x142, 0xA>(a[i]);
#pragma unroll
    for (int i = 0; i < 4; ++i) a[i] = dpp_iadd<0x143, 0xC>(a[i]);
#pragma unroll
    for (int i = 0; i < 4; ++i) {
        const int tot = __builtin_amdgcn_readlane(a[i], 63);
        if (G < 16) KK0 = (lane == ((4 * G + i) & 63)) ? tot : KK0; else KK1 = (lane == ((4 * G + i) & 63)) ? tot : KK1;
    }
}
__device__ __forceinline__ void ex_passB(const G4& R, int cp, int (&yi)[16]) {
#pragma unroll
    for (int j = 0; j < 4; ++j) {
        const int sh4 = (j & 1) * 4;
        const unsigned A = (R.r[0][j >> 1] >> sh4) & 0x0F0F0F0Fu, B = (R.r[1][j >> 1] >> sh4) & 0x0F0F0F0Fu, C = (R.r[2][j >> 1] >> sh4) & 0x0F0F0F0Fu, D = (R.r[3][j >> 1] >> sh4) & 0x0F0F0F0Fu;
        const unsigned ablo = __builtin_amdgcn_perm(B, A, 0x05010400u), abhi = __builtin_amdgcn_perm(B, A, 0x07030602u);
        const unsigned cdlo = __builtin_amdgcn_perm(D, C, 0x05010400u), cdhi = __builtin_amdgcn_perm(D, C, 0x07030602u);
        const unsigned t0 = __builtin_amdgcn_perm(cdlo, ablo, 0x05040100u), t1 = __builtin_amdgcn_perm(cdlo, ablo, 0x07060302u);
        const unsigned t2 = __builtin_amdgcn_perm(cdhi, abhi, 0x05040100u), t3 = __builtin_amdgcn_perm(cdhi, abhi, 0x07060302u);
        yi[4 * j + 0] = __builtin_amdgcn_sdot4((int)t0, cp, yi[4 * j + 0], false);
        yi[4 * j + 1] = __builtin_amdgcn_sdot4((int)t1, cp, yi[4 * j + 1], false);
        yi[4 * j + 2] = __builtin_amdgcn_sdot4((int)t2, cp, yi[4 * j + 2], false);
        yi[4 * j + 3] = __builtin_amdgcn_sdot4((int)t3, cp, yi[4 * j + 3], false);
    }
}
__device__ __forceinline__ float wave_max(float v) {
#pragma unroll
    for (int o = 32; o > 0; o >>= 1) v = fmaxf(v, __shfl_xor(v, o, 64));
    return v;
}
__device__ __forceinline__ int quad_pack(int ci) {
    const int b = ci & 0xFF;
    const int d0 = __builtin_amdgcn_update_dpp(0, b, 0x00, 0xF, 0xF, false), d1 = __builtin_amdgcn_update_dpp(0, b, 0x55, 0xF, 0xF, false);
    const int d2 = __builtin_amdgcn_update_dpp(0, b, 0xAA, 0xF, 0xF, false), d3 = __builtin_amdgcn_update_dpp(0, b, 0xFF, 0xF, 0xF, false);
    return d0 | (d1 << 8) | (d2 << 16) | (d3 << 24);
}

__device__ __forceinline__ void ex_finish(const Params& p, int l, const bool LAST, int t, const float (&y)[16], int lane_) {
    const int lane = launder(lane_);
    const int c0 = lane * 16;
    const float* mb = p.mod() + ((size_t)l * BATCH + t / SEQ) * MODW;
    float xv[16];
#pragma unroll
    for (int q = 0; q < 4; ++q) {
        const f32x4 a = *(const f32x4*)(p.xb() + (size_t)t * D_MODEL + c0 + 4 * q), g2 = *(const f32x4*)(mb + 5 * D_MODEL + c0 + 4 * q);
#pragma unroll
        for (int e = 0; e < 4; ++e) xv[4 * q + e] = a[e] + g2[e] * y[4 * q + e];
    }
    float ss2 = 0.f;
#pragma unroll
    for (int e = 0; e < 16; ++e) ss2 += xv[e] * xv[e];
    const float rs2 = rsqrtf(wave_sum(ss2) * (1.0f / D_MODEL) + 1e-6f);
    if (LAST) {
#pragma unroll
        for (int q = 0; q < 4; ++q) {
            const int col = c0 + 4 * q;
            const f32x4 gv = *(const f32x4*)(p.final_g + col);
            f32x4 o;
#pragma unroll
            for (int e = 0; e < 4; ++e) o[e] = xv[4 * q + e] * rs2 * gv[e];
            *(f32x4*)(p.out + (size_t)t * D_MODEL + col) = o;
        }
    } else {
        const float* mn = p.mod() + ((size_t)(l + 1) * BATCH + t / SEQ) * MODW;
        const float* n1g = p.norm1_g + (l + 1) * D_MODEL;
        unsigned hw[8];
#pragma unroll
        for (int q = 0; q < 4; ++q) {
            const int col = c0 + 4 * q;
            f32x4 xo;
#pragma unroll
            for (int e = 0; e < 4; ++e) xo[e] = xv[4 * q + e];
            *(f32x4*)(p.xb() + (size_t)t * D_MODEL + col) = xo;
            const f32x4 gv = *(const f32x4*)(n1g + col), scv = *(const f32x4*)(mn + 1 * D_MODEL + col), shv = *(const f32x4*)(mn + 0 * D_MODEL + col);
            float h[4];
#pragma unroll
            for (int e = 0; e < 4; ++e) h[e] = xo[e] * rs2 * gv[e] * (1.0f + scv[e]) + shv[e];
            hw[2 * q] = pk2(h[0], h[1]); hw[2 * q + 1] = pk2(h[2], h[3]);
        }
        *(u32x4*)(p.hb() + (size_t)t * D_MODEL + c0) = (u32x4){hw[0], hw[1], hw[2], hw[3]};
        *(u32x4*)(p.hb() + (size_t)t * D_MODEL + c0 + 8) = (u32x4){hw[4], hw[5], hw[6], hw[7]};
    }
}


#define EXR 8
#define EXT (32 / EXR)
template <int S>
__device__ __forceinline__ void ex_turnA(G4 (&R)[EXR], const int (&hq)[4], int hinit, int& KK0, int& KK1, rsrc_t ru, rsrc_t rv, int e0, int e1, int voff, int lane, int emask) {
#define EX_A(s) ex_passA<EXR * S + s>(R[s], hq, hinit, KK0, KK1, lane); asm volatile("" ::: "memory"); if (S < EXT - 1) ex_issue<(EXR * S + s + EXR) & 31>(R[s], ru, e0, e1, voff, emask); else ex_issue<s>(R[s], rv, e0, e1, voff, emask); asm volatile("" ::: "memory");
    EX_A(0) EX_A(1) EX_A(2) EX_A(3)
#if EXR == 8
    EX_A(4) EX_A(5) EX_A(6) EX_A(7)
#endif
#undef EX_A
}
template <int S>
__device__ __forceinline__ void ex_turnB(G4 (&R)[EXR], int cpk0, int cpk1, int (&yi)[16], rsrc_t ru, rsrc_t rv, int e0, int e1, int e0n, int e1n, bool has_next, int voff, int emask) {
#define EX_B(s) ex_passB(R[s], __builtin_amdgcn_readlane((EXR * S + s) < 16 ? cpk0 : cpk1, (4 * (EXR * S + s)) & 63), yi); \
    asm volatile("" ::: "memory"); if (S < EXT - 1) ex_issue<(EXR * S + s + EXR) & 31>(R[s], rv, e0, e1, voff, emask); asm volatile("" ::: "memory");
    EX_B(0) EX_B(1) EX_B(2) EX_B(3)
#if EXR == 8
    EX_B(4) EX_B(5) EX_B(6) EX_B(7)
#endif
#undef EX_B
}

__device__ __forceinline__ void phase_expert(const Params& p, int l, const bool LAST, LAS unsigned char* lds, int wv, const int emask = 0x3FFF, const bool synth = false) {
    const int tid = tid_opaque(wv), wave = tid >> 6, lane = tid & 63;
    const rsrc_t ru = __builtin_amdgcn_make_buffer_rsrc((void*)(p.ub8() + (size_t)l * NEXP * ROWB), 0, NEXP * ROWB, 0x00020000);
    const rsrc_t rv = __builtin_amdgcn_make_buffer_rsrc((void*)(p.vb8() + (size_t)l * NEXP * ROWB), 0, NEXP * ROWB, 0x00020000);
    const float* uinv = p.uinv() + (size_t)l * NEXP;
    const float* vinv = p.vinv() + (size_t)l * NEXP;
    const int voff = lane * 8, c0 = lane * 16;
    const float* n2g = p.norm2_g + l * D_MODEL;
    const int tstep = gridDim.x * NWAVES;
    int t = blockIdx.x * NWAVES + wave;
    if (t >= NTOK) return;
    int e0 = p.eidx()[(size_t)t * 128 + lane], e1 = p.eidx()[(size_t)t * 128 + 64 + lane];
    for (; t < NTOK; t += tstep) {
        G4 R[EXR];
        ex_issue<0>(R[0], ru, e0, e1, voff, emask); ex_issue<1>(R[1], ru, e0, e1, voff, emask); ex_issue<2>(R[2], ru, e0, e1, voff, emask); ex_issue<3>(R[3], ru, e0, e1, voff, emask);
#if EXR == 8
        ex_issue<4>(R[4], ru, e0, e1, voff); ex_issue<5>(R[5], ru, e0, e1, voff); ex_issue<6>(R[6], ru, e0, e1, voff); ex_issue<7>(R[7], ru, e0, e1, voff);
#endif
        asm volatile("" ::: "memory");
        const bool has_next = (t + tstep) < NTOK;
        const int tn = has_next ? t + tstep : t;
        const int e0n = p.eidx()[(size_t)tn * 128 + lane], e1n = p.eidx()[(size_t)tn * 128 + 64 + lane];
        const float us0 = uinv[e0], us1 = uinv[e1];
        const float gv0 = p.egate()[(size_t)t * 128 + lane] * vinv[e0], gv1 = p.egate()[(size_t)t * 128 + 64 + lane] * vinv[e1];
        int hq[4]; float sh;
        {
            const float* mb = p.mod() + ((size_t)l * BATCH + t / SEQ) * MODW;
            f32x4 xq[4]; float ss = 0.f;
#pragma unroll
            for (int q = 0; q < 4; ++q) { xq[q] = *(const f32x4*)(p.xb() + (size_t)t * D_MODEL + c0 + 4 * q); ss += xq[q][0] * xq[q][0] + xq[q][1] * xq[q][1] + xq[q][2] * xq[q][2] + xq[q][3] * xq[q][3]; }
            const float rs = rsqrtf(wave_sum(ss) * (1.0f / D_MODEL) + 1e-6f);
            float hm = 0.f;
#pragma unroll
            for (int q = 0; q < 4; ++q) {
                const int col = c0 + 4 * q;
                const f32x4 gv = *(const f32x4*)(n2g + col), scv = *(const f32x4*)(mb + 4 * D_MODEL + col), shv = *(const f32x4*)(mb + 3 * D_MODEL + col);
#pragma unroll
                for (int e = 0; e < 4; ++e) { xq[q][e] = xq[q][e] * rs * gv[e] * (1.0f + scv[e]) + shv[e]; hm = fmaxf(hm, fabsf(xq[q][e])); }
            }
            hm = fmaxf(wave_max(hm), 1e-30f);
            const float qs = 127.0f / hm; sh = hm * (1.0f / 127.0f);
            int hb[16];
#pragma unroll
            for (int q = 0; q < 4; ++q)
#pragma unroll
                for (int e = 0; e < 4; ++e) hb[4 * q + e] = (int)rintf(xq[q][e] * qs);
#pragma unroll
            for (int j = 0; j < 4; ++j) {
                const int b0 = (j & 1) + 8 * (j >> 1);
                hq[j] = (hb[b0] & 0xFF) | ((hb[b0 + 2] & 0xFF) << 8) | ((hb[b0 + 4] & 0xFF) << 16) | (hb[b0 + 6] << 24);
            }
        }
        int hinit = 0;
#pragma unroll
        for (int j = 0; j < 4; ++j) hinit = __builtin_amdgcn_sdot4(hq[j], 0x01010101, hinit, false);
        hinit *= -8;
        int KK0 = 0, KK1 = 0;
        ex_turnA<0>(R, hq, hinit, KK0, KK1, ru, rv, e0, e1, voff, lane, emask); ex_turnA<1>(R, hq, hinit, KK0, KK1, ru, rv, e0, e1, voff, lane, emask);
        ex_turnA<2>(R, hq, hinit, KK0, KK1, ru, rv, e0, e1, voff, lane, emask); ex_turnA<3>(R, hq, hinit, KK0, KK1, ru, rv, e0, e1, voff, lane, emask);
#if EXR == 4
        ex_turnA<4>(R, hq, hinit, KK0, KK1, ru, rv, e0, e1, voff, lane, emask); ex_turnA<5>(R, hq, hinit, KK0, KK1, ru, rv, e0, e1, voff, lane, emask);
        ex_turnA<6>(R, hq, hinit, KK0, KK1, ru, rv, e0, e1, voff, lane, emask); ex_turnA<7>(R, hq, hinit, KK0, KK1, ru, rv, e0, e1, voff, lane, emask);
#endif
        const float cf0 = gelu_as((float)KK0 * (us0 * sh)) * gv0, cf1 = gelu_as((float)KK1 * (us1 * sh)) * gv1;
        const float cm = fmaxf(wave_max(fmaxf(fabsf(cf0), fabsf(cf1))), 1e-30f);
        const float cq = 127.0f / cm;
        const int cpk0 = quad_pack((int)rintf(cf0 * cq)), cpk1 = quad_pack((int)rintf(cf1 * cq));
        int yi[16];
#pragma unroll
        for (int e = 0; e < 16; ++e) yi[e] = 0;
        ex_turnB<0>(R, cpk0, cpk1, yi, ru, rv, e0, e1, e0n, e1n, has_next, voff, emask); ex_turnB<1>(R, cpk0, cpk1, yi, ru, rv, e0, e1, e0n, e1n, has_next, voff, emask);
        ex_turnB<2>(R, cpk0, cpk1, yi, ru, rv, e0, e1, e0n, e1n, has_next, voff, emask); ex_turnB<3>(R, cpk0, cpk1, yi, ru, rv, e0, e1, e0n, e1n, has_next, voff, emask);
#if EXR == 4
        ex_turnB<4>(R, cpk0, cpk1, yi, ru, rv, e0, e1, e0n, e1n, has_next, voff, emask); ex_turnB<5>(R, cpk0, cpk1, yi, ru, rv, e0, e1, e0n, e1n, has_next, voff, emask);
        ex_turnB<6>(R, cpk0, cpk1, yi, ru, rv, e0, e1, e0n, e1n, has_next, voff, emask); ex_turnB<7>(R, cpk0, cpk1, yi, ru, rv, e0, e1, e0n, e1n, has_next, voff, emask);
#endif
        const int ci0s = (int)rintf(cf0 * cq) + (int)rintf(cf1 * cq);
        const int csum8 = 8 * __builtin_amdgcn_readlane(wave_isum_l63(ci0s), 63);
        float y[16];
        const float ys = cm * (1.0f / 127.0f);
#pragma unroll
        for (int j = 0; j < 4; ++j)
#pragma unroll
            for (int e = 0; e < 4; ++e) y[(j & 1) + 2 * e + 8 * (j >> 1)] = (float)(yi[4 * j + e] - csum8) * ys;
        if (synth) {
#pragma unroll
            for (int q = 0; q < 4; ++q) *(f32x4*)((float*)p.qb() + (size_t)t * D_MODEL + c0 + 4 * q) = (f32x4){y[4 * q], y[4 * q + 1], y[4 * q + 2], y[4 * q + 3]};
        } else ex_finish(p, l, LAST, t, y, lane);
        e0 = e0n; e1 = e1n;
    }
}
#if MK_MULTI
__global__ void __launch_bounds__(512, 2) k_expert(Params p, int l) {
    extern __shared__ __attribute__((aligned(16))) unsigned char smem_raw[];
    phase_expert(p, l, l == DEPTH - 1, (LAS unsigned char*)smem_raw, __builtin_amdgcn_readfirstlane((int)threadIdx.x >> 6));
}
#endif
typedef short s16x4 __attribute__((ext_vector_type(4)));
#define AT_KSTR 144
#define AT_VSTR 192
#define AT_KBUF 0
#define AT_VBUF 18432
#define AT_TBL  43008
#define AT_OEX  44032
#define AT_OSTR 272

__device__ __forceinline__ void phase_attn(const Params& p, int l, LAS unsigned char* lds, int wv) {
    const int tid = tid_opaque(wv), wave = tid >> 6, lane = tid & 63;
    const int w4 = wave & 3, m = wave >> 2, c = lane & 31, h = lane >> 5;
    const float LOG2E = 1.4426950408889634f;
    const float qscale = 0.17677669529663687f * LOG2E;
    float d01 = 0.f, d23 = 0.f;
    { const float* lp = p.diff_lambda + l * 128;
      for (int i = 0; i < 32; ++i) { d01 += lp[i] * lp[32 + i]; d23 += lp[64 + i] * lp[96 + i]; } }
    const float lam_init = p.lam_init[l];
    const float lam = expf(d01) - expf(d23) + lam_init;
    const float osc = 1.0f - lam_init;
    LAS float* tbl = (LAS float*)(lds + AT_TBL);
    const int skey = tid >> 3, sch = tid & 7;
    const int g16 = lane >> 4, li = lane & 15, tq = li >> 2, tp = li & 3;

    for (int u = blockIdx.x; u < 256; u += gridDim.x) {
        const int pi = u & 7, hd = (u >> 3) & 3, b = u >> 5;
        if (tid < 256) { const int bk = tid < 128 ? (int)kBucket[tid] : 31; tbl[tid] = p.rel_bias[bk * 4 + hd] * LOG2E; }
        const float c31 = p.rel_bias[31 * 4 + hd] * LOG2E;
        const bf16_t* pbase = p.pb() + (size_t)b * SEQ * MIX_IN;
        const bf16_t* kg = pbase + (size_t)skey * MIX_IN + 256 + hd * 64 + sch * 8;
        const bf16_t* vg = pbase + (size_t)skey * MIX_IN + 512 + hd * 64 + sch * 8;
        for (int half = 0; half < 2; ++half) {
            const int qb = half ? 15 - pi : pi;
            const int q0w = qb * 128 + 32 * w4, nkt = 2 * qb + 2;
            const int qpos = q0w + c;
            bf16x8 qf0, qf1;
            { const bf16_t* qp = pbase + (size_t)qpos * MIX_IN + hd * 64 + m * 32 + 8 * h; qf0 = *(const bf16x8*)qp; qf1 = *(const bf16x8*)(qp + 16); }
            f32x16 O0, O1;
#pragma unroll
            for (int r = 0; r < 16; ++r) { O0[r] = 0.f; O1[r] = 0.f; }
            float mrun = -1e30f, lrun = 0.f;
            u32x4 kreg = *(const u32x4*)kg, vreg = *(const u32x4*)vg;
            *(LAS u32x4*)(lds + AT_KBUF + skey * AT_KSTR + sch * 16) = kreg;
            *(LAS u32x4*)(lds + AT_VBUF + skey * AT_VSTR + sch * 16) = vreg;
            __syncthreads();
            for (int kt = 0; kt < nkt; ++kt) {
                const int k0 = kt * 64, cur = kt & 1;
                if (kt + 1 < nkt) { kreg = *(const u32x4*)(kg + (size_t)(k0 + 64) * MIX_IN); vreg = *(const u32x4*)(vg + (size_t)(k0 + 64) * MIX_IN); }
                if (k0 <= q0w + 31) {
                    LAS unsigned char* kb_ = lds + AT_KBUF + cur * (64 * AT_KSTR);
                    LAS unsigned char* vb_ = lds + AT_VBUF + cur * (64 * AT_VSTR);
                    f32x16 s0, s1;
#pragma unroll
                    for (int r = 0; r < 16; ++r) { s0[r] = 0.f; s1[r] = 0.f; }
                    {
                        const LAS unsigned char* ka = kb_ + c * AT_KSTR + m * 64 + h * 16;
                        const bf16x8 a00 = *(const LAS bf16x8*)ka, a01 = *(const LAS bf16x8*)(ka + 32);
                        const bf16x8 a10 = *(const LAS bf16x8*)(ka + 32 * AT_KSTR), a11 = *(const LAS bf16x8*)(ka + 32 * AT_KSTR + 32);
                        s0 = __builtin_amdgcn_mfma_f32_32x32x16_bf16(a00, qf0, s0, 0, 0, 0);
                        s0 = __builtin_amdgcn_mfma_f32_32x32x16_bf16(a01, qf1, s0, 0, 0, 0);
                        s1 = __builtin_amdgcn_mfma_f32_32x32x16_bf16(a10, qf0, s1, 0, 0, 0);
                        s1 = __builtin_amdgcn_mfma_f32_32x32x16_bf16(a11, qf1, s1, 0, 0, 0);
                    }
                    const bool far = (q0w - (k0 + 63)) >= 113;
                    if (far) {
#pragma unroll
                        for (int r = 0; r < 16; ++r) { s0[r] = s0[r] * qscale + c31; s1[r] = s1[r] * qscale + c31; }
                    } else {
                        const int dbase = qpos - k0 - 4 * h;
#pragma unroll
                        for (int r = 0; r < 16; ++r) {
                            const int d0 = dbase - ((r & 3) + 8 * (r >> 2)), d1 = d0 - 32;
                            const float b0 = tbl[min(max(d0, 0), 255)], b1 = tbl[min(max(d1, 0), 255)];
                            const float v0 = s0[r] * qscale + b0, v1 = s1[r] * qscale + b1;
                            s0[r] = d0 < 0 ? -1e30f : v0; s1[r] = d1 < 0 ? -1e30f : v1;
                        }
                    }
                    float tmax = fmaxf(s0[0], s1[0]);
#pragma unroll
                    for (int r = 1; r < 16; ++r) tmax = fmaxf(tmax, fmaxf(s0[r], s1[r]));
                    tmax = fmaxf(tmax, __shfl_xor(tmax, 32, 64));
                    const float mnew = fmaxf(mrun, tmax);
                    const float alpha = __builtin_amdgcn_exp2f(mrun - mnew);
                    mrun = mnew;
                    float psum = 0.f;
#pragma unroll
                    for (int r = 0; r < 16; ++r) { s0[r] = __builtin_amdgcn_exp2f(s0[r] - mnew); s1[r] = __builtin_amdgcn_exp2f(s1[r] - mnew); psum += s0[r] + s1[r]; }
                    lrun = lrun * alpha + psum;
#pragma unroll
                    for (int r = 0; r < 16; ++r) { O0[r] *= alpha; O1[r] *= alpha; }
#pragma unroll
                    for (int kb = 0; kb < 2; ++kb)
#pragma unroll
                        for (int sp = 0; sp < 2; ++sp) {
                            u32x4 pw;
                            if (kb == 0) { pw.x = pk2(s0[8 * sp + 0], s0[8 * sp + 1]); pw.y = pk2(s0[8 * sp + 2], s0[8 * sp + 3]); pw.z = pk2(s0[8 * sp + 4], s0[8 * sp + 5]); pw.w = pk2(s0[8 * sp + 6], s0[8 * sp + 7]); }
                            else         { pw.x = pk2(s1[8 * sp + 0], s1[8 * sp + 1]); pw.y = pk2(s1[8 * sp + 2], s1[8 * sp + 3]); pw.z = pk2(s1[8 * sp + 4], s1[8 * sp + 5]); pw.w = pk2(s1[8 * sp + 6], s1[8 * sp + 7]); }
                            const bf16x8 pf = __builtin_bit_cast(bf16x8, pw);
                            const int kA = 32 * kb + 16 * sp + 4 * h;
#pragma unroll
                            for (int mb = 0; mb < 2; ++mb) {
                                LAS unsigned char* va = vb_ + (kA + tq) * AT_VSTR + (32 * mb + 16 * (g16 & 1) + 4 * tp) * 2;
                                const s16x4 t0 = __builtin_amdgcn_ds_read_tr16_b64_v4i16((LAS s16x4*)va);
                                const s16x4 t1 = __builtin_amdgcn_ds_read_tr16_b64_v4i16((LAS s16x4*)(va + 8 * AT_VSTR));
                                const bf16x8 vf = {t0[0], t0[1], t0[2], t0[3], t1[0], t1[1], t1[2], t1[3]};
                                if (mb == 0) O0 = __builtin_amdgcn_mfma_f32_32x32x16_bf16(vf, pf, O0, 0, 0, 0);
                                else         O1 = __builtin_amdgcn_mfma_f32_32x32x16_bf16(vf, pf, O1, 0, 0, 0);
                            }
                        }
                }
                if (kt + 1 < nkt) {
                    *(LAS u32x4*)(lds + AT_KBUF + (cur ^ 1) * (64 * AT_KSTR) + skey * AT_KSTR + sch * 16) = kreg;
                    *(LAS u32x4*)(lds + AT_VBUF + (cur ^ 1) * (64 * AT_VSTR) + skey * AT_VSTR + sch * 16) = vreg;
                }
                __syncthreads();
            }
            const float inv = 1.0f / (lrun + __shfl_xor(lrun, 32, 64));
            LAS unsigned char* oex = lds + AT_OEX + (32 * w4 + c) * AT_OSTR + 16 * h;
            if (m == 1) {
#pragma unroll
                for (int r4 = 0; r4 < 4; ++r4) {
                    f32x4 a, bq;
#pragma unroll
                    for (int e = 0; e < 4; ++e) { a[e] = O0[4 * r4 + e] * inv; bq[e] = O1[4 * r4 + e] * inv; }
                    *(LAS f32x4*)(oex + (8 * r4) * 4) = a;
                    *(LAS f32x4*)(oex + (32 + 8 * r4) * 4) = bq;
                }
            }
            __syncthreads();
            if (m == 0) {
                float ss = 0.f;
#pragma unroll
                for (int r4 = 0; r4 < 4; ++r4) {
                    const f32x4 a = *(const LAS f32x4*)(oex + (8 * r4) * 4), bq = *(const LAS f32x4*)(oex + (32 + 8 * r4) * 4);
#pragma unroll
                    for (int e = 0; e < 4; ++e) {
                        O0[4 * r4 + e] = O0[4 * r4 + e] * inv - lam * a[e]; O1[4 * r4 + e] = O1[4 * r4 + e] * inv - lam * bq[e];
                        ss += O0[4 * r4 + e] * O0[4 * r4 + e] + O1[4 * r4 + e] * O1[4 * r4 + e];
                    }
                }
                ss += __shfl_xor(ss, 32, 64);
                const float rstd = rsqrtf(ss * (1.0f / 64.0f) + 1e-6f) * osc;
                bf16_t* orow = p.cat() + (size_t)(b * SEQ + qpos) * D_MODEL + hd * 64 + 4 * h;
                const float* sg = p.subln_g + l * 64 + 4 * h;
#pragma unroll
                for (int r4 = 0; r4 < 4; ++r4) {
                    const f32x4 ga = *(const f32x4*)(sg + 8 * r4), gb = *(const f32x4*)(sg + 32 + 8 * r4);
                    u32x2 oa, ob;
                    oa.x = pk2(O0[4 * r4 + 0] * rstd * ga[0], O0[4 * r4 + 1] * rstd * ga[1]); oa.y = pk2(O0[4 * r4 + 2] * rstd * ga[2], O0[4 * r4 + 3] * rstd * ga[3]);
                    ob.x = pk2(O1[4 * r4 + 0] * rstd * gb[0], O1[4 * r4 + 1] * rstd * gb[1]); ob.y = pk2(O1[4 * r4 + 2] * rstd * gb[2], O1[4 * r4 + 3] * rstd * gb[3]);
                    *(u32x2*)(orow + 8 * r4) = oa;
                    *(u32x2*)(orow + 32 + 8 * r4) = ob;
                }
            }
            __syncthreads();
        }
    }
}
#if MK_MULTI
template <int DUMMY>
__global__ void __launch_bounds__(512, 2) k_attn2(Params p, int l) {
    extern __shared__ __attribute__((aligned(16))) unsigned char smem_raw[];
    phase_attn(p, l, (LAS unsigned char*)smem_raw, __builtin_amdgcn_readfirstlane((int)threadIdx.x >> 6));
}
#endif
#define MR_VSTR 272

__device__ __forceinline__ void mixrest_conv(const Params& p, int l, int chunk, LAS unsigned char* lds, int wv) {
    const int tid = tid_opaque(wv), wave = tid >> 6, lane = tid & 63;
    const int t0 = chunk * 128, s0 = t0 % SEQ;
    LAS float* glu = (LAS float*)lds;
    const int c = tid & 255, th = tid >> 8;
    float w[31];
#pragma unroll
    for (int j = 0; j < 31; ++j) w[j] = p.conf_dw[((size_t)l * 31 + j) * 256 + c];
    for (int hf = 0; hf < 2; ++hf) {
        const int tb = t0 + hf * 64;
        for (int it = tid; it < 94 * 32; it += 512) {
            const int i = it >> 5, c8 = (it & 31) * 8;
            const int sp = s0 + hf * 64 - 30 + i;
            f32x4 o0 = {0.f, 0.f, 0.f, 0.f}, o1 = {0.f, 0.f, 0.f, 0.f};
            if (sp >= 0) {
                const bf16_t* pr = p.pb() + (size_t)(tb - 30 + i) * MIX_IN;
                const u32x4 a = *(const u32x4*)(pr + 3 * 256 + c8), g = *(const u32x4*)(pr + 4 * 256 + c8);
                o0[0] = bflo(a.x) * sigmoidf_(bflo(g.x)); o0[1] = bfhi(a.x) * sigmoidf_(bfhi(g.x));
                o0[2] = bflo(a.y) * sigmoidf_(bflo(g.y)); o0[3] = bfhi(a.y) * sigmoidf_(bfhi(g.y));
                o1[0] = bflo(a.z) * sigmoidf_(bflo(g.z)); o1[1] = bfhi(a.z) * sigmoidf_(bfhi(g.z));
                o1[2] = bflo(a.w) * sigmoidf_(bflo(g.w)); o1[3] = bfhi(a.w) * sigmoidf_(bfhi(g.w));
            }
            *(LAS f32x4*)(glu + i * 256 + c8) = o0; *(LAS f32x4*)(glu + i * 256 + c8 + 4) = o1;
        }
        __syncthreads();
        float acc[32];
#pragma unroll
        for (int o = 0; o < 32; ++o) acc[o] = 0.f;
#pragma unroll
        for (int i = 0; i < 62; ++i) {
            const float xval = glu[(th * 32 + i) * 256 + c];
#pragma unroll
            for (int o = 0; o < 32; ++o) if (i - o >= 0 && i - o <= 30) acc[o] += w[i - o] * xval;
        }
        __syncthreads();
#pragma unroll
        for (int o = 0; o < 32; ++o) glu[(th * 32 + o) * 256 + c] = acc[o];
        __syncthreads();
        const f32x4 lg = *(const f32x4*)(p.conf_ln_g + l * 256 + lane * 4), lb = *(const f32x4*)(p.conf_ln_b + l * 256 + lane * 4);
        for (int k = 0; k < 8; ++k) {
            const int tk = wave * 8 + k;
            const f32x4 z = *(const LAS f32x4*)(glu + tk * 256 + lane * 4);
            const float mu = wave_sum(z[0] + z[1] + z[2] + z[3]) * (1.0f / 256.0f);
            f32x4 dz; float sq = 0.f;
#pragma unroll
            for (int e = 0; e < 4; ++e) { dz[e] = z[e] - mu; sq += dz[e] * dz[e]; }
            const float rstd = rsqrtf(wave_sum(sq) * (1.0f / 256.0f) + 1e-6f);
            float y[4];
#pragma unroll
            for (int e = 0; e < 4; ++e) { const float v = dz[e] * rstd * lg[e] + lb[e]; y[e] = v * sigmoidf_(v); }
            u32x2 o; o.x = pk2(y[0], y[1]); o.y = pk2(y[2], y[3]);
            *(u32x2*)(p.cat() + (size_t)(tb + tk) * D_MODEL + 256 + lane * 4) = o;
        }
        __syncthreads();
    }
}

__device__ __forceinline__ void mixrest_sgu(const Params& p, int l, int chunk, LAS unsigned char* lds, int wv) {
    const int tid = tid_opaque(wv), wave = tid >> 6, lane = tid & 63;
    const int t0 = chunk * 128, s0 = t0 % SEQ;
    {
        const float* sw = p.sconv_w + (size_t)l * 3 * 256;
        for (int it = tid; it < 128 * 32; it += 512) {
            const int tt = it >> 5, c8 = (it & 31) * 8;
            const bf16_t* pr = p.pb() + (size_t)(t0 + tt) * MIX_IN;
            float z[8];
#pragma unroll
            for (int e = 0; e < 8; ++e) z[e] = 0.f;
#pragma unroll
            for (int j = 0; j < 3; ++j) {
                if (s0 + tt - 2 + j >= 0) {
                    const bf16_t* q = pr + (ptrdiff_t)(j - 2) * MIX_IN;
                    const u32x4 a = *(const u32x4*)(q + 6 * 256 + c8), bq = *(const u32x4*)(q + 7 * 256 + c8);
                    const f32x4 w0 = *(const f32x4*)(sw + j * 256 + c8), w1 = *(const f32x4*)(sw + j * 256 + c8 + 4);
                    z[0] += w0[0] * bflo(a.x) * bflo(bq.x); z[1] += w0[1] * bfhi(a.x) * bfhi(bq.x);
                    z[2] += w0[2] * bflo(a.y) * bflo(bq.y); z[3] += w0[3] * bfhi(a.y) * bfhi(bq.y);
                    z[4] += w1[0] * bflo(a.z) * bflo(bq.z); z[5] += w1[1] * bfhi(a.z) * bfhi(bq.z);
                    z[6] += w1[2] * bflo(a.w) * bflo(bq.w); z[7] += w1[3] * bfhi(a.w) * bfhi(bq.w);
                }
            }
            const u32x4 cb = *(const u32x4*)(pr + 5 * 256 + c8);
            u32x4 o;
            o.x = pk2(bflo(cb.x) * z[0], bfhi(cb.x) * z[1]); o.y = pk2(bflo(cb.y) * z[2], bfhi(cb.y) * z[3]);
            o.z = pk2(bflo(cb.z) * z[4], bfhi(cb.z) * z[5]); o.w = pk2(bflo(cb.w) * z[6], bfhi(cb.w) * z[7]);
            *(u32x4*)(p.cat() + (size_t)(t0 + tt) * D_MODEL + 512 + c8) = o;
        }
    }
    {
        const f32x4 lg = *(const f32x4*)(p.sgu_ln_g + l * 256 + lane * 4), lb = *(const f32x4*)(p.sgu_ln_b + l * 256 + lane * 4);
        for (int k = 0; k < 16; ++k) {
            const int s = wave * 16 + k;
            const u32x2 raw = *(const u32x2*)(p.pb() + (size_t)(t0 + s) * MIX_IN + 9 * 256 + lane * 4);
            float v[4] = {gelu_as(bflo(raw.x)), gelu_as(bfhi(raw.x)), gelu_as(bflo(raw.y)), gelu_as(bfhi(raw.y))};
            const float mu = wave_sum(v[0] + v[1] + v[2] + v[3]) * (1.0f / 256.0f);
            float sq = 0.f;
#pragma unroll
            for (int e = 0; e < 4; ++e) { v[e] -= mu; sq += v[e] * v[e]; }
            const float rstd = rsqrtf(wave_sum(sq) * (1.0f / 256.0f) + 1e-6f);
#pragma unroll
            for (int e = 0; e < 4; ++e) *(LAS bf16_t*)(lds + (lane * 4 + e) * MR_VSTR + s * 2) = f2bf(v[e] * rstd * lg[e] + lb[e]);
        }
    }
    __syncthreads();
    {
        const int hq = wave & 3, mb = wave >> 2, c = lane & 31, hh = lane >> 5;
        bf16x8 af[8];
#pragma unroll
        for (int ks = 0; ks < 8; ++ks) af[ks] = *(const LAS bf16x8*)(lds + (hq * 64 + mb * 32 + c) * MR_VSTR + (16 * ks + 8 * hh) * 2);
        const bf16_t* wb = p.sguwb() + ((size_t)(l * 4 + hq) * 128) * 128;
        f32x16 acc[4];
#pragma unroll
        for (int nb = 0; nb < 4; ++nb) {
#pragma unroll
            for (int r = 0; r < 16; ++r) acc[nb][r] = 0.f;
#pragma unroll
            for (int ks = 0; ks < 2 * nb + 2; ++ks) {
                const bf16x8 bfrag = *(const bf16x8*)(wb + (size_t)(32 * nb + c) * 128 + 16 * ks + 8 * hh);
                acc[nb] = __builtin_amdgcn_mfma_f32_32x32x16_bf16(af[ks], bfrag, acc[nb], 0, 0, 0);
            }
        }
        const float* bs = p.sgu_b + (size_t)(l * 4 + hq) * 128;
#pragma unroll
        for (int nb = 0; nb < 4; ++nb) {
            const int tt = 32 * nb + c;
            const float bias = bs[tt];
            const bf16_t* su = p.pb() + (size_t)(t0 + tt) * MIX_IN + 8 * 256 + hq * 64 + mb * 32 + 4 * hh;
            bf16_t* orow = p.cat() + (size_t)(t0 + tt) * D_MODEL + 768 + hq * 64 + mb * 32 + 4 * hh;
#pragma unroll
            for (int r4 = 0; r4 < 4; ++r4) {
                const u32x2 raw = *(const u32x2*)(su + 8 * r4);
                u32x2 o;
                o.x = pk2(gelu_as(bflo(raw.x)) * (acc[nb][4 * r4 + 0] + bias), gelu_as(bfhi(raw.x)) * (acc[nb][4 * r4 + 1] + bias));
                o.y = pk2(gelu_as(bflo(raw.y)) * (acc[nb][4 * r4 + 2] + bias), gelu_as(bfhi(raw.y)) * (acc[nb][4 * r4 + 3] + bias));
                *(u32x2*)(orow + 8 * r4) = o;
            }
        }
    }
    __syncthreads();
}

__device__ __forceinline__ void phase_mixrest(const Params& p, int l, LAS unsigned char* lds, int wv) {
    for (int u = blockIdx.x; u < 256; u += gridDim.x) {
        const int chunk = u >> 1;
        if (u & 1) mixrest_sgu(p, l, chunk, lds, wv); else mixrest_conv(p, l, chunk, lds, wv);
    }
}
#if MK_MULTI
template <int DUMMY>
__global__ void __launch_bounds__(512, 2) k_mixrest(Params p, int l) {
    extern __shared__ __attribute__((aligned(16))) unsigned char smem_raw[];
    phase_mixrest(p, l, (LAS unsigned char*)smem_raw, __builtin_amdgcn_readfirstlane((int)threadIdx.x >> 6));
}
#endif
__device__ __forceinline__ int f2sortable(float f) { const int x = __float_as_int(f); return x ^ ((x >> 31) & 0x7FFFFFFF); }
__device__ __forceinline__ float sortable2f(int s) { return __int_as_float(s ^ ((s >> 31) & 0x7FFFFFFF)); }

template <int N>
__device__ __forceinline__ void bitonic_sort_desc(int (&a)[N]) {
#pragma unroll
    for (int k = 2; k <= N; k <<= 1)
#pragma unroll
        for (int j = k >> 1; j > 0; j >>= 1)
#pragma unroll
            for (int i = 0; i < N; ++i) {
                const int q = i ^ j;
                if (q > i) {
                    const int hi = max(a[i], a[q]), lo = min(a[i], a[q]);
                    if ((i & k) == 0 || k == N) { a[i] = hi; a[q] = lo; } else { a[i] = lo; a[q] = hi; }
                }
            }
}
__device__ __forceinline__ void bitonic_merge_desc16(int (&a)[16]) {
#pragma unroll
    for (int j = 8; j > 0; j >>= 1)
#pragma unroll
        for (int i = 0; i < 16; ++i) {
            const int q = i ^ j;
            if (q > i) { const int hi = max(a[i], a[q]), lo = min(a[i], a[q]); a[i] = hi; a[q] = lo; }
        }
}
__device__ __forceinline__ void merge_top16(int (&a)[16], const int (&b)[16]) {
#pragma unroll
    for (int i = 0; i < 16; ++i) a[i] = max(a[i], b[15 - i]);
    bitonic_merge_desc16(a);
}

template <bool TO_LDS>
__device__ __forceinline__ void topk_unit(const Params& p, int l, int u, LAS unsigned char* lds, int wave, int lane, LAS int* le, LAS float* lg) {
    const int c = lane & 31, hh = lane >> 5;
    const int hd = wave;
    LAS unsigned char* ilist = lds + wave * 1024 + c * 32;
    const int hx = hh << 2;
    const __amdgpu_buffer_rsrc_t rq = __builtin_amdgcn_make_buffer_rsrc((void*)p.qb(), 0, NTOK * 2048 * 2, 0x00020000);
    const __amdgpu_buffer_rsrc_t rk = __builtin_amdgcn_make_buffer_rsrc((void*)(p.keysb() + (size_t)l * 16 * 128 * 128), 0, 16 * 128 * 128 * 2, 0x00020000);
    const int qvoff = c * 4096 + hh * 16, kvoff = c * 256 + hh * 16;
    {
        const int t = u * 32 + c;
        int S0[16], S1[16];
#pragma unroll
        for (int pp = 0; pp < 2; ++pp) {
            bf16x8 qf[8];
            {
                const int qso = (u * 32) * 4096 + hd * 512 + pp * 256;
#pragma unroll
                for (int ks = 0; ks < 8; ++ks) qf[ks] = __builtin_bit_cast(bf16x8, __builtin_amdgcn_raw_buffer_load_b128(rq, qvoff + 32 * ks, qso, 0));
            }
            const int kso = ((hd * 2 + pp) * 128) * 256;
            int K0[16], K1[16], K2[16], K3[16];
#pragma unroll
            for (int kb = 0; kb < 4; ++kb) {
                asm volatile("" ::: "memory");
                f32x16 acc;
#pragma unroll
                for (int r = 0; r < 16; ++r) acc[r] = 0.f;
#pragma unroll
                for (int ks = 0; ks < 8; ++ks) {
                    const bf16x8 a = __builtin_bit_cast(bf16x8, __builtin_amdgcn_raw_buffer_load_b128(rk, kvoff + 32 * ks, kso + (32 * kb) * 256, 0));
                    acc = __builtin_amdgcn_mfma_f32_32x32x16_bf16(a, qf[ks], acc, 0, 0, 0);
                }
#pragma unroll
                for (int r = 0; r < 16; ++r) {
                    const int nconst = 32 * kb + (r & 3) + 8 * (r >> 2);
                    const int key = (f2sortable(acc[r]) & ~0x7F) | (127 - nconst);
                    if (kb == 0) K0[r] = key; else if (kb == 1) K1[r] = key; else if (kb == 2) K2[r] = key; else K3[r] = key;
                }
            }
            bitonic_sort_desc<16>(K0); bitonic_sort_desc<16>(K1); bitonic_sort_desc<16>(K2); bitonic_sort_desc<16>(K3);
            merge_top16(K0, K1); merge_top16(K2, K3); merge_top16(K0, K2);
            int P[16];
#pragma unroll
            for (int i = 0; i < 16; ++i) { K0[i] ^= hx; P[i] = __shfl_xor(K0[i], 32, 64); }
            merge_top16(K0, P);
#pragma unroll
            for (int i = 0; i < 16; ++i) { if (pp == 0) S0[i] = K0[i]; else S1[i] = K0[i]; }
        }
        {
            unsigned w4[4];
#pragma unroll
            for (int q = 0; q < 4; ++q) {
                unsigned w = 0;
#pragma unroll
                for (int e = 0; e < 4; ++e) { const int sv = hh ? S1[4 * q + e] : S0[4 * q + e]; w |= (unsigned)(127 - (sv & 127)) << (8 * e); }
                w4[q] = w;
            }
            u32x4 wv; wv.x = w4[0]; wv.y = w4[1]; wv.z = w4[2]; wv.w = w4[3];
            *(LAS u32x4*)(ilist + 16 * hh) = wv;
        }
        float a[16], b[16];
#pragma unroll
        for (int i = 0; i < 16; ++i) {
            const float f1 = sortable2f(S0[i] & ~0x7F), f2 = sortable2f(S1[i] & ~0x7F);
            a[i] = hh ? f2 : f1; b[i] = hh ? f1 : f2;
        }
        int CA[16], CB[16];
        const int org = hh << 8;
        {
            int n = 0;
#pragma unroll
            for (int i = 0; i < 4; ++i)
#pragma unroll
                for (int j = i; j < 16; ++j) {
                    if ((i + 1) * (j + 1) <= 16) {
                        int key = (f2sortable(a[i] + b[j]) & ~0x1FF) | org | (i * 16 + j);
                        if (i == j) key = hh ? (int)0x80000000 : key;
                        if (n < 16) CA[n] = key; else CB[n - 16] = key;
                        ++n;
                    }
                }
#pragma unroll
            for (int q = 27; q < 32; ++q) CB[q - 16] = (int)0x80000000;
        }
        bitonic_sort_desc<16>(CA); bitonic_sort_desc<16>(CB);
        merge_top16(CA, CB);
        int F[16], PF[16];
#pragma unroll
        for (int i = 0; i < 16; ++i) PF[i] = __shfl_xor(CA[i], 32, 64);
#pragma unroll
        for (int i = 0; i < 16; ++i) F[i] = max(CA[i], PF[15 - i]);
        int mxk = F[0];
#pragma unroll
        for (int i = 1; i < 16; ++i) mxk = max(mxk, F[i]);
        const float vmax = sortable2f(mxk & ~0x1FF);
        float e[8], psum = 0.f;
#pragma unroll
        for (int i = 0; i < 8; ++i) { e[i] = __expf(sortable2f(F[i] & ~0x1FF) - vmax); psum += e[i]; }
        const float inv = 1.0f / (psum + __shfl_xor(psum, 32, 64));
        asm volatile("s_waitcnt lgkmcnt(0)" ::: "memory");
        int ex[8];
#pragma unroll
        for (int i = 0; i < 8; ++i) {
            const int low = F[i] & 0x1FF, o = low >> 8, il = (low >> 4) & 15, jl = low & 15;
            const int ri = o ? jl : il, rj = o ? il : jl;
            const int i1 = (int)*(const LAS unsigned char*)(ilist + ri), i2 = (int)*(const LAS unsigned char*)(ilist + 16 + rj);
            ex[i] = i1 * 128 + i2;
        }
        if (TO_LDS) {
            LAS int* ep = le + (c * 8 + hd) * 16 + hh * 8;
            LAS float* gp = lg + (c * 8 + hd) * 16 + hh * 8;
            *(LAS u32x4*)ep = (u32x4){(unsigned)ex[0], (unsigned)ex[1], (unsigned)ex[2], (unsigned)ex[3]};
            *(LAS u32x4*)(ep + 4) = (u32x4){(unsigned)ex[4], (unsigned)ex[5], (unsigned)ex[6], (unsigned)ex[7]};
            *(LAS f32x4*)gp = (f32x4){e[0] * inv, e[1] * inv, e[2] * inv, e[3] * inv};
            *(LAS f32x4*)(gp + 4) = (f32x4){e[4] * inv, e[5] * inv, e[6] * inv, e[7] * inv};
        } else {
            int* ep = p.eidx() + ((size_t)t * 8 + hd) * 16 + hh * 8;
            float* gp = p.egate() + ((size_t)t * 8 + hd) * 16 + hh * 8;
            *(u32x4*)ep = (u32x4){(unsigned)ex[0], (unsigned)ex[1], (unsigned)ex[2], (unsigned)ex[3]};
            *(u32x4*)(ep + 4) = (u32x4){(unsigned)ex[4], (unsigned)ex[5], (unsigned)ex[6], (unsigned)ex[7]};
            *(f32x4*)gp = (f32x4){e[0] * inv, e[1] * inv, e[2] * inv, e[3] * inv};
            *(f32x4*)(gp + 4) = (f32x4){e[4] * inv, e[5] * inv, e[6] * inv, e[7] * inv};
        }
        asm volatile("s_waitcnt lgkmcnt(0)" ::: "memory");
    }
}
__device__ __forceinline__ void phase_topk(const Params& p, int l, LAS unsigned char* lds, int wv) {
    const int tid = tid_opaque(wv), wave = __builtin_amdgcn_readfirstlane(tid >> 6), lane = tid & 63;
    for (int u = blockIdx.x; u < NTOK / 32; u += gridDim.x) topk_unit<false>(p, l, u, lds, wave, lane, nullptr, nullptr);
}
#if MK_MULTI
template <int DUMMY>
__global__ void __launch_bounds__(512, 2) k_topk(Params p, int l) {
    extern __shared__ __attribute__((aligned(16))) unsigned char smem_raw[];
    phase_topk(p, l, (LAS unsigned char*)smem_raw, __builtin_amdgcn_readfirstlane((int)threadIdx.x >> 6));
}
#endif
#if PROBE_UB
__device__ __forceinline__ void ubench(int iters, unsigned seed) {
    float r[16]; f32x2 r2[8];
#pragma unroll
    for (int i = 0; i < 16; ++i) r[i] = __uint_as_float(seed + i);
#pragma unroll
    for (int i = 0; i < 8; ++i) r2[i] = (f32x2){r[2 * i], r[2 * i + 1]};
    float a = __uint_as_float(seed * 3u + 1u), b = __uint_as_float(seed * 5u + 7u);
    for (int it = 0; it < iters; ++it) {
#if PROBE_UB == 1
        asm volatile("v_fma_f32 %0, %16, %17, %0\n\tv_fma_f32 %1, %16, %17, %1\n\tv_fma_f32 %2, %16, %17, %2\n\tv_fma_f32 %3, %16, %17, %3\n\tv_fma_f32 %4, %16, %17, %4\n\tv_fma_f32 %5, %16, %17, %5\n\tv_fma_f32 %6, %16, %17, %6\n\tv_fma_f32 %7, %16, %17, %7\n\tv_fma_f32 %8, %16, %17, %8\n\tv_fma_f32 %9, %16, %17, %9\n\tv_fma_f32 %10, %16, %17, %10\n\tv_fma_f32 %11, %16, %17, %11\n\tv_fma_f32 %12, %16, %17, %12\n\tv_fma_f32 %13, %16, %17, %13\n\tv_fma_f32 %14, %16, %17, %14\n\tv_fma_f32 %15, %16, %17, %15\n\t" : "+v"(r[0]), "+v"(r[1]), "+v"(r[2]), "+v"(r[3]), "+v"(r[4]), "+v"(r[5]), "+v"(r[6]), "+v"(r[7]), "+v"(r[8]), "+v"(r[9]), "+v"(r[10]), "+v"(r[11]), "+v"(r[12]), "+v"(r[13]), "+v"(r[14]), "+v"(r[15]) : "v"(a), "v"(b) : "s40", "vcc");
        asm volatile("v_fma_f32 %0, %16, %17, %0\n\tv_fma_f32 %1, %16, %17, %1\n\tv_fma_f32 %2, %16, %17, %2\n\tv_fma_f32 %3, %16, %17, %3\n\tv_fma_f32 %4, %16, %17, %4\n\tv_fma_f32 %5, %16, %17, %5\n\tv_fma_f32 %6, %16, %17, %6\n\tv_fma_f32 %7, %16, %17, %7\n\tv_fma_f32 %8, %16, %17, %8\n\tv_fma_f32 %9, %16, %17, %9\n\tv_fma_f32 %10, %16, %17, %10\n\tv_fma_f32 %11, %16, %17, %11\n\tv_fma_f32 %12, %16, %17, %12\n\tv_fma_f32 %13, %16, %17, %13\n\tv_fma_f32 %14, %16, %17, %14\n\tv_fma_f32 %15, %16, %17, %15\n\t" : "+v"(r[0]), "+v"(r[1]), "+v"(r[2]), "+v"(r[3]), "+v"(r[4]), "+v"(r[5]), "+v"(r[6]), "+v"(r[7]), "+v"(r[8]), "+v"(r[9]), "+v"(r[10]), "+v"(r[11]), "+v"(r[12]), "+v"(r[13]), "+v"(r[14]), "+v"(r[15]) : "v"(a), "v"(b) : "s40", "vcc");
#endif
#if PROBE_UB == 2
        asm volatile("v_dot4c_i32_i8 %0, %16, %17\n\tv_dot4c_i32_i8 %1, %16, %17\n\tv_dot4c_i32_i8 %2, %16, %17\n\tv_dot4c_i32_i8 %3, %16, %17\n\tv_dot4c_i32_i8 %4, %16, %17\n\tv_dot4c_i32_i8 %5, %16, %17\n\tv_dot4c_i32_i8 %6, %16, %17\n\tv_dot4c_i32_i8 %7, %16, %17\n\tv_dot4c_i32_i8 %8, %16, %17\n\tv_dot4c_i32_i8 %9, %16, %17\n\tv_dot4c_i32_i8 %10, %16, %17\n\tv_dot4c_i32_i8 %11, %16, %17\n\tv_dot4c_i32_i8 %12, %16, %17\n\tv_dot4c_i32_i8 %13, %16, %17\n\tv_dot4c_i32_i8 %14, %16, %17\n\tv_dot4c_i32_i8 %15, %16, %17\n\t" : "+v"(r[0]), "+v"(r[1]), "+v"(r[2]), "+v"(r[3]), "+v"(r[4]), "+v"(r[5]), "+v"(r[6]), "+v"(r[7]), "+v"(r[8]), "+v"(r[9]), "+v"(r[10]), "+v"(r[11]), "+v"(r[12]), "+v"(r[13]), "+v"(r[14]), "+v"(r[15]) : "v"(a), "v"(b) : "s40", "vcc");
        asm volatile("v_dot4c_i32_i8 %0, %16, %17\n\tv_dot4c_i32_i8 %1, %16, %17\n\tv_dot4c_i32_i8 %2, %16, %17\n\tv_dot4c_i32_i8 %3, %16, %17\n\tv_dot4c_i32_i8 %4, %16, %17\n\tv_dot4c_i32_i8 %5, %16, %17\n\tv_dot4c_i32_i8 %6, %16, %17\n\tv_dot4c_i32_i8 %7, %16, %17\n\tv_dot4c_i32_i8 %8, %16, %17\n\tv_dot4c_i32_i8 %9, %16, %17\n\tv_dot4c_i32_i8 %10, %16, %17\n\tv_dot4c_i32_i8 %11, %16, %17\n\tv_dot4c_i32_i8 %12, %16, %17\n\tv_dot4c_i32_i8 %13, %16, %17\n\tv_dot4c_i32_i8 %14, %16, %17\n\tv_dot4c_i32_i8 %15, %16, %17\n\t" : "+v"(r[0]), "+v"(r[1]), "+v"(r[2]), "+v"(r[3]), "+v"(r[4]), "+v"(r[5]), "+v"(r[6]), "+v"(r[7]), "+v"(r[8]), "+v"(r[9]), "+v"(r[10]), "+v"(r[11]), "+v"(r[12]), "+v"(r[13]), "+v"(r[14]), "+v"(r[15]) : "v"(a), "v"(b) : "s40", "vcc");
#endif
#if PROBE_UB == 3
        asm volatile("v_perm_b32 %0, %0, %16, %17\n\tv_perm_b32 %1, %1, %16, %17\n\tv_perm_b32 %2, %2, %16, %17\n\tv_perm_b32 %3, %3, %16, %17\n\tv_perm_b32 %4, %4, %16, %17\n\tv_perm_b32 %5, %5, %16, %17\n\tv_perm_b32 %6, %6, %16, %17\n\tv_perm_b32 %7, %7, %16, %17\n\tv_perm_b32 %8, %8, %16, %17\n\tv_perm_b32 %9, %9, %16, %17\n\tv_perm_b32 %10, %10, %16, %17\n\tv_perm_b32 %11, %11, %16, %17\n\tv_perm_b32 %12, %12, %16, %17\n\tv_perm_b32 %13, %13, %16, %17\n\tv_perm_b32 %14, %14, %16, %17\n\tv_perm_b32 %15, %15, %16, %17\n\t" : "+v"(r[0]), "+v"(r[1]), "+v"(r[2]), "+v"(r[3]), "+v"(r[4]), "+v"(r[5]), "+v"(r[6]), "+v"(r[7]), "+v"(r[8]), "+v"(r[9]), "+v"(r[10]), "+v"(r[11]), "+v"(r[12]), "+v"(r[13]), "+v"(r[14]), "+v"(r[15]) : "v"(a), "v"(b) : "s40", "vcc");
        asm volatile("v_perm_b32 %0, %0, %16, %17\n\tv_perm_b32 %1, %1, %16, %17\n\tv_perm_b32 %2, %2, %16, %17\n\tv_perm_b32 %3, %3, %16, %17\n\tv_perm_b32 %4, %4, %16, %17\n\tv_perm_b32 %5, %5, %16, %17\n\tv_perm_b32 %6, %6, %16, %17\n\tv_perm_b32 %7, %7, %16, %17\n\tv_perm_b32 %8, %8, %16, %17\n\tv_perm_b32 %9, %9, %16, %17\n\tv_perm_b32 %10, %10, %16, %17\n\tv_perm_b32 %11, %11, %16, %17\n\tv_perm_b32 %12, %12, %16, %17\n\tv_perm_b32 %13, %13, %16, %17\n\tv_perm_b32 %14, %14, %16, %17\n\tv_perm_b32 %15, %15, %16, %17\n\t" : "+v"(r[0]), "+v"(r[1]), "+v"(r[2]), "+v"(r[3]), "+v"(r[4]), "+v"(r[5]), "+v"(r[6]), "+v"(r[7]), "+v"(r[8]), "+v"(r[9]), "+v"(r[10]), "+v"(r[11]), "+v"(r[12]), "+v"(r[13]), "+v"(r[14]), "+v"(r[15]) : "v"(a), "v"(b) : "s40", "vcc");
#endif
#if PROBE_UB == 4
        asm volatile("v_add_u32_dpp %0, %0, %0 quad_perm:[1,0,3,2] row_mask:0xf bank_mask:0xf\n\tv_add_u32_dpp %1, %1, %1 quad_perm:[1,0,3,2] row_mask:0xf bank_mask:0xf\n\tv_add_u32_dpp %2, %2, %2 quad_perm:[1,0,3,2] row_mask:0xf bank_mask:0xf\n\tv_add_u32_dpp %3, %3, %3 quad_perm:[1,0,3,2] row_mask:0xf bank_mask:0xf\n\tv_add_u32_dpp %4, %4, %4 quad_perm:[1,0,3,2] row_mask:0xf bank_mask:0xf\n\tv_add_u32_dpp %5, %5, %5 quad_perm:[1,0,3,2] row_mask:0xf bank_mask:0xf\n\tv_add_u32_dpp %6, %6, %6 quad_perm:[1,0,3,2] row_mask:0xf bank_mask:0xf\n\tv_add_u32_dpp %7, %7, %7 quad_perm:[1,0,3,2] row_mask:0xf bank_mask:0xf\n\tv_add_u32_dpp %8, %8, %8 quad_perm:[1,0,3,2] row_mask:0xf bank_mask:0xf\n\tv_add_u32_dpp %9, %9, %9 quad_perm:[1,0,3,2] row_mask:0xf bank_mask:0xf\n\tv_add_u32_dpp %10, %10, %10 quad_perm:[1,0,3,2] row_mask:0xf bank_mask:0xf\n\tv_add_u32_dpp %11, %11, %11 quad_perm:[1,0,3,2] row_mask:0xf bank_mask:0xf\n\tv_add_u32_dpp %12, %12, %12 quad_perm:[1,0,3,2] row_mask:0xf bank_mask:0xf\n\tv_add_u32_dpp %13, %13, %13 quad_perm:[1,0,3,2] row_mask:0xf bank_mask:0xf\n\tv_add_u32_dpp %14, %14, %14 quad_perm:[1,0,3,2] row_mask:0xf bank_mask:0xf\n\tv_add_u32_dpp %15, %15, %15 quad_perm:[1,0,3,2] row_mask:0xf bank_mask:0xf\n\t" : "+v"(r[0]), "+v"(r[1]), "+v"(r[2]), "+v"(r[3]), "+v"(r[4]), "+v"(r[5]), "+v"(r[6]), "+v"(r[7]), "+v"(r[8]), "+v"(r[9]), "+v"(r[10]), "+v"(r[11]), "+v"(r[12]), "+v"(r[13]), "+v"(r[14]), "+v"(r[15]) : "v"(a), "v"(b) : "s40", "vcc");
        asm volatile("v_add_u32_dpp %0, %0, %0 quad_perm:[1,0,3,2] row_mask:0xf bank_mask:0xf\n\tv_add_u32_dpp %1, %1, %1 quad_perm:[1,0,3,2] row_mask:0xf bank_mask:0xf\n\tv_add_u32_dpp %2, %2, %2 quad_perm:[1,0,3,2] row_mask:0xf bank_mask:0xf\n\tv_add_u32_dpp %3, %3, %3 quad_perm:[1,0,3,2] row_mask:0xf bank_mask:0xf\n\tv_add_u32_dpp %4, %4, %4 quad_perm:[1,0,3,2] row_mask:0xf bank_mask:0xf\n\tv_add_u32_dpp %5, %5, %5 quad_perm:[1,0,3,2] row_mask:0xf bank_mask:0xf\n\tv_add_u32_dpp %6, %6, %6 quad_perm:[1,0,3,2] row_mask:0xf bank_mask:0xf\n\tv_add_u32_dpp %7, %7, %7 quad_perm:[1,0,3,2] row_mask:0xf bank_mask:0xf\n\tv_add_u32_dpp %8, %8, %8 quad_perm:[1,0,3,2] row_mask:0xf bank_mask:0xf\n\tv_add_u32_dpp %9, %9, %9 quad_perm:[1,0,3,2] row_mask:0xf bank_mask:0xf\n\tv_add_u32_dpp %10, %10, %10 quad_perm:[1,0,3,2] row_mask:0xf bank_mask:0xf\n\tv_add_u32_dpp %11, %11, %11 quad_perm:[1,0,3,2] row_mask:0xf bank_mask:0xf\n\tv_add_u32_dpp %12, %12, %12 quad_perm:[1,0,3,2] row_mask:0xf bank_mask:0xf\n\tv_add_u32_dpp %13, %13, %13 quad_perm:[1,0,3,2] row_mask:0xf bank_mask:0xf\n\tv_add_u32_dpp %14, %14, %14 quad_perm:[1,0,3,2] row_mask:0xf bank_mask:0xf\n\tv_add_u32_dpp %15, %15, %15 quad_perm:[1,0,3,2] row_mask:0xf bank_mask:0xf\n\t" : "+v"(r[0]), "+v"(r[1]), "+v"(r[2]), "+v"(r[3]), "+v"(r[4]), "+v"(r[5]), "+v"(r[6]), "+v"(r[7]), "+v"(r[8]), "+v"(r[9]), "+v"(r[10]), "+v"(r[11]), "+v"(r[12]), "+v"(r[13]), "+v"(r[14]), "+v"(r[15]) : "v"(a), "v"(b) : "s40", "vcc");
#endif
#if PROBE_UB == 5
        asm volatile("v_readlane_b32 s40, %0, 5\n\tv_readlane_b32 s40, %1, 5\n\tv_readlane_b32 s40, %2, 5\n\tv_readlane_b32 s40, %3, 5\n\tv_readlane_b32 s40, %4, 5\n\tv_readlane_b32 s40, %5, 5\n\tv_readlane_b32 s40, %6, 5\n\tv_readlane_b32 s40, %7, 5\n\tv_readlane_b32 s40, %8, 5\n\tv_readlane_b32 s40, %9, 5\n\tv_readlane_b32 s40, %10, 5\n\tv_readlane_b32 s40, %11, 5\n\tv_readlane_b32 s40, %12, 5\n\tv_readlane_b32 s40, %13, 5\n\tv_readlane_b32 s40, %14, 5\n\tv_readlane_b32 s40, %15, 5\n\t" : "+v"(r[0]), "+v"(r[1]), "+v"(r[2]), "+v"(r[3]), "+v"(r[4]), "+v"(r[5]), "+v"(r[6]), "+v"(r[7]), "+v"(r[8]), "+v"(r[9]), "+v"(r[10]), "+v"(r[11]), "+v"(r[12]), "+v"(r[13]), "+v"(r[14]), "+v"(r[15]) : "v"(a), "v"(b) : "s40", "vcc");
        asm volatile("v_readlane_b32 s40, %0, 5\n\tv_readlane_b32 s40, %1, 5\n\tv_readlane_b32 s40, %2, 5\n\tv_readlane_b32 s40, %3, 5\n\tv_readlane_b32 s40, %4, 5\n\tv_readlane_b32 s40, %5, 5\n\tv_readlane_b32 s40, %6, 5\n\tv_readlane_b32 s40, %7, 5\n\tv_readlane_b32 s40, %8, 5\n\tv_readlane_b32 s40, %9, 5\n\tv_readlane_b32 s40, %10, 5\n\tv_readlane_b32 s40, %11, 5\n\tv_readlane_b32 s40, %12, 5\n\tv_readlane_b32 s40, %13, 5\n\tv_readlane_b32 s40, %14, 5\n\tv_readlane_b32 s40, %15, 5\n\t" : "+v"(r[0]), "+v"(r[1]), "+v"(r[2]), "+v"(r[3]), "+v"(r[4]), "+v"(r[5]), "+v"(r[6]), "+v"(r[7]), "+v"(r[8]), "+v"(r[9]), "+v"(r[10]), "+v"(r[11]), "+v"(r[12]), "+v"(r[13]), "+v"(r[14]), "+v"(r[15]) : "v"(a), "v"(b) : "s40", "vcc");
#endif
#if PROBE_UB == 6
        asm volatile("v_cvt_pk_f32_fp8 %0, %16\n\tv_cvt_pk_f32_fp8 %1, %16\n\tv_cvt_pk_f32_fp8 %2, %16\n\tv_cvt_pk_f32_fp8 %3, %16\n\tv_cvt_pk_f32_fp8 %4, %16\n\tv_cvt_pk_f32_fp8 %5, %16\n\tv_cvt_pk_f32_fp8 %6, %16\n\tv_cvt_pk_f32_fp8 %7, %16\n\t" : "+v"(r2[0]), "+v"(r2[1]), "+v"(r2[2]), "+v"(r2[3]), "+v"(r2[4]), "+v"(r2[5]), "+v"(r2[6]), "+v"(r2[7]), "+v"(r[8]), "+v"(r[9]), "+v"(r[10]), "+v"(r[11]), "+v"(r[12]), "+v"(r[13]), "+v"(r[14]), "+v"(r[15]) : "v"(a), "v"(b) : "s40", "vcc");
        asm volatile("v_cvt_pk_f32_fp8 %0, %16\n\tv_cvt_pk_f32_fp8 %1, %16\n\tv_cvt_pk_f32_fp8 %2, %16\n\tv_cvt_pk_f32_fp8 %3, %16\n\tv_cvt_pk_f32_fp8 %4, %16\n\tv_cvt_pk_f32_fp8 %5, %16\n\tv_cvt_pk_f32_fp8 %6, %16\n\tv_cvt_pk_f32_fp8 %7, %16\n\t" : "+v"(r2[0]), "+v"(r2[1]), "+v"(r2[2]), "+v"(r2[3]), "+v"(r2[4]), "+v"(r2[5]), "+v"(r2[6]), "+v"(r2[7]), "+v"(r[8]), "+v"(r[9]), "+v"(r[10]), "+v"(r[11]), "+v"(r[12]), "+v"(r[13]), "+v"(r[14]), "+v"(r[15]) : "v"(a), "v"(b) : "s40", "vcc");
        asm volatile("v_cvt_pk_f32_fp8 %0, %16\n\tv_cvt_pk_f32_fp8 %1, %16\n\tv_cvt_pk_f32_fp8 %2, %16\n\tv_cvt_pk_f32_fp8 %3, %16\n\tv_cvt_pk_f32_fp8 %4, %16\n\tv_cvt_pk_f32_fp8 %5, %16\n\tv_cvt_pk_f32_fp8 %6, %16\n\tv_cvt_pk_f32_fp8 %7, %16\n\t" : "+v"(r2[0]), "+v"(r2[1]), "+v"(r2[2]), "+v"(r2[3]), "+v"(r2[4]), "+v"(r2[5]), "+v"(r2[6]), "+v"(r2[7]), "+v"(r[8]), "+v"(r[9]), "+v"(r[10]), "+v"(r[11]), "+v"(r[12]), "+v"(r[13]), "+v"(r[14]), "+v"(r[15]) : "v"(a), "v"(b) : "s40", "vcc");
        asm volatile("v_cvt_pk_f32_fp8 %0, %16\n\tv_cvt_pk_f32_fp8 %1, %16\n\tv_cvt_pk_f32_fp8 %2, %16\n\tv_cvt_pk_f32_fp8 %3, %16\n\tv_cvt_pk_f32_fp8 %4, %16\n\tv_cvt_pk_f32_fp8 %5, %16\n\tv_cvt_pk_f32_fp8 %6, %16\n\tv_cvt_pk_f32_fp8 %7, %16\n\t" : "+v"(r2[0]), "+v"(r2[1]), "+v"(r2[2]), "+v"(r2[3]), "+v"(r2[4]), "+v"(r2[5]), "+v"(r2[6]), "+v"(r2[7]), "+v"(r[8]), "+v"(r[9]), "+v"(r[10]), "+v"(r[11]), "+v"(r[12]), "+v"(r[13]), "+v"(r[14]), "+v"(r[15]) : "v"(a), "v"(b) : "s40", "vcc");
#endif
#if PROBE_UB == 7
        asm volatile("v_pk_fma_f32 %0, %0, %0, %0\n\tv_pk_fma_f32 %1, %1, %1, %1\n\tv_pk_fma_f32 %2, %2, %2, %2\n\tv_pk_fma_f32 %3, %3, %3, %3\n\tv_pk_fma_f32 %4, %4, %4, %4\n\tv_pk_fma_f32 %5, %5, %5, %5\n\tv_pk_fma_f32 %6, %6, %6, %6\n\tv_pk_fma_f32 %7, %7, %7, %7\n\t" : "+v"(r2[0]), "+v"(r2[1]), "+v"(r2[2]), "+v"(r2[3]), "+v"(r2[4]), "+v"(r2[5]), "+v"(r2[6]), "+v"(r2[7]), "+v"(r[8]), "+v"(r[9]), "+v"(r[10]), "+v"(r[11]), "+v"(r[12]), "+v"(r[13]), "+v"(r[14]), "+v"(r[15]) : "v"(a), "v"(b) : "s40", "vcc");
        asm volatile("v_pk_fma_f32 %0, %0, %0, %0\n\tv_pk_fma_f32 %1, %1, %1, %1\n\tv_pk_fma_f32 %2, %2, %2, %2\n\tv_pk_fma_f32 %3, %3, %3, %3\n\tv_pk_fma_f32 %4, %4, %4, %4\n\tv_pk_fma_f32 %5, %5, %5, %5\n\tv_pk_fma_f32 %6, %6, %6, %6\n\tv_pk_fma_f32 %7, %7, %7, %7\n\t" : "+v"(r2[0]), "+v"(r2[1]), "+v"(r2[2]), "+v"(r2[3]), "+v"(r2[4]), "+v"(r2[5]), "+v"(r2[6]), "+v"(r2[7]), "+v"(r[8]), "+v"(r[9]), "+v"(r[10]), "+v"(r[11]), "+v"(r[12]), "+v"(r[13]), "+v"(r[14]), "+v"(r[15]) : "v"(a), "v"(b) : "s40", "vcc");
        asm volatile("v_pk_fma_f32 %0, %0, %0, %0\n\tv_pk_fma_f32 %1, %1, %1, %1\n\tv_pk_fma_f32 %2, %2, %2, %2\n\tv_pk_fma_f32 %3, %3, %3, %3\n\tv_pk_fma_f32 %4, %4, %4, %4\n\tv_pk_fma_f32 %5, %5, %5, %5\n\tv_pk_fma_f32 %6, %6, %6, %6\n\tv_pk_fma_f32 %7, %7, %7, %7\n\t" : "+v"(r2[0]), "+v"(r2[1]), "+v"(r2[2]), "+v"(r2[3]), "+v"(r2[4]), "+v"(r2[5]), "+v"(r2[6]), "+v"(r2[7]), "+v"(r[8]), "+v"(r[9]), "+v"(r[10]), "+v"(r[11]), "+v"(r[12]), "+v"(r[13]), "+v"(r[14]), "+v"(r[15]) : "v"(a), "v"(b) : "s40", "vcc");
        asm volatile("v_pk_fma_f32 %0, %0, %0, %0\n\tv_pk_fma_f32 %1, %1, %1, %1\n\tv_pk_fma_f32 %2, %2, %2, %2\n\tv_pk_fma_f32 %3, %3, %3, %3\n\tv_pk_fma_f32 %4, %4, %4, %4\n\tv_pk_fma_f32 %5, %5, %5, %5\n\tv_pk_fma_f32 %6, %6, %6, %6\n\tv_pk_fma_f32 %7, %7, %7, %7\n\t" : "+v"(r2[0]), "+v"(r2[1]), "+v"(r2[2]), "+v"(r2[3]), "+v"(r2[4]), "+v"(r2[5]), "+v"(r2[6]), "+v"(r2[7]), "+v"(r[8]), "+v"(r[9]), "+v"(r[10]), "+v"(r[11]), "+v"(r[12]), "+v"(r[13]), "+v"(r[14]), "+v"(r[15]) : "v"(a), "v"(b) : "s40", "vcc");
#endif
#if PROBE_UB == 8
        asm volatile("v_dot2c_f32_bf16 %0, %16, %17\n\tv_dot2c_f32_bf16 %1, %16, %17\n\tv_dot2c_f32_bf16 %2, %16, %17\n\tv_dot2c_f32_bf16 %3, %16, %17\n\tv_dot2c_f32_bf16 %4, %16, %17\n\tv_dot2c_f32_bf16 %5, %16, %17\n\tv_dot2c_f32_bf16 %6, %16, %17\n\tv_dot2c_f32_bf16 %7, %16, %17\n\tv_dot2c_f32_bf16 %8, %16, %17\n\tv_dot2c_f32_bf16 %9, %16, %17\n\tv_dot2c_f32_bf16 %10, %16, %17\n\tv_dot2c_f32_bf16 %11, %16, %17\n\tv_dot2c_f32_bf16 %12, %16, %17\n\tv_dot2c_f32_bf16 %13, %16, %17\n\tv_dot2c_f32_bf16 %14, %16, %17\n\tv_dot2c_f32_bf16 %15, %16, %17\n\t" : "+v"(r[0]), "+v"(r[1]), "+v"(r[2]), "+v"(r[3]), "+v"(r[4]), "+v"(r[5]), "+v"(r[6]), "+v"(r[7]), "+v"(r[8]), "+v"(r[9]), "+v"(r[10]), "+v"(r[11]), "+v"(r[12]), "+v"(r[13]), "+v"(r[14]), "+v"(r[15]) : "v"(a), "v"(b) : "s40", "vcc");
        asm volatile("v_dot2c_f32_bf16 %0, %16, %17\n\tv_dot2c_f32_bf16 %1, %16, %17\n\tv_dot2c_f32_bf16 %2, %16, %17\n\tv_dot2c_f32_bf16 %3, %16, %17\n\tv_dot2c_f32_bf16 %4, %16, %17\n\tv_dot2c_f32_bf16 %5, %16, %17\n\tv_dot2c_f32_bf16 %6, %16, %17\n\tv_dot2c_f32_bf16 %7, %16, %17\n\tv_dot2c_f32_bf16 %8, %16, %17\n\tv_dot2c_f32_bf16 %9, %16, %17\n\tv_dot2c_f32_bf16 %10, %16, %17\n\tv_dot2c_f32_bf16 %11, %16, %17\n\tv_dot2c_f32_bf16 %12, %16, %17\n\tv_dot2c_f32_bf16 %13, %16, %17\n\tv_dot2c_f32_bf16 %14, %16, %17\n\tv_dot2c_f32_bf16 %15, %16, %17\n\t" : "+v"(r[0]), "+v"(r[1]), "+v"(r[2]), "+v"(r[3]), "+v"(r[4]), "+v"(r[5]), "+v"(r[6]), "+v"(r[7]), "+v"(r[8]), "+v"(r[9]), "+v"(r[10]), "+v"(r[11]), "+v"(r[12]), "+v"(r[13]), "+v"(r[14]), "+v"(r[15]) : "v"(a), "v"(b) : "s40", "vcc");
#endif
#if PROBE_UB == 9
        asm volatile("v_cndmask_b32 %0, %0, %16, vcc\n\tv_cndmask_b32 %1, %1, %16, vcc\n\tv_cndmask_b32 %2, %2, %16, vcc\n\tv_cndmask_b32 %3, %3, %16, vcc\n\tv_cndmask_b32 %4, %4, %16, vcc\n\tv_cndmask_b32 %5, %5, %16, vcc\n\tv_cndmask_b32 %6, %6, %16, vcc\n\tv_cndmask_b32 %7, %7, %16, vcc\n\tv_cndmask_b32 %8, %8, %16, vcc\n\tv_cndmask_b32 %9, %9, %16, vcc\n\tv_cndmask_b32 %10, %10, %16, vcc\n\tv_cndmask_b32 %11, %11, %16, vcc\n\tv_cndmask_b32 %12, %12, %16, vcc\n\tv_cndmask_b32 %13, %13, %16, vcc\n\tv_cndmask_b32 %14, %14, %16, vcc\n\tv_cndmask_b32 %15, %15, %16, vcc\n\t" : "+v"(r[0]), "+v"(r[1]), "+v"(r[2]), "+v"(r[3]), "+v"(r[4]), "+v"(r[5]), "+v"(r[6]), "+v"(r[7]), "+v"(r[8]), "+v"(r[9]), "+v"(r[10]), "+v"(r[11]), "+v"(r[12]), "+v"(r[13]), "+v"(r[14]), "+v"(r[15]) : "v"(a), "v"(b) : "s40", "vcc");
        asm volatile("v_cndmask_b32 %0, %0, %16, vcc\n\tv_cndmask_b32 %1, %1, %16, vcc\n\tv_cndmask_b32 %2, %2, %16, vcc\n\tv_cndmask_b32 %3, %3, %16, vcc\n\tv_cndmask_b32 %4, %4, %16, vcc\n\tv_cndmask_b32 %5, %5, %16, vcc\n\tv_cndmask_b32 %6, %6, %16, vcc\n\tv_cndmask_b32 %7, %7, %16, vcc\n\tv_cndmask_b32 %8, %8, %16, vcc\n\tv_cndmask_b32 %9, %9, %16, vcc\n\tv_cndmask_b32 %10, %10, %16, vcc\n\tv_cndmask_b32 %11, %11, %16, vcc\n\tv_cndmask_b32 %12, %12, %16, vcc\n\tv_cndmask_b32 %13, %13, %16, vcc\n\tv_cndmask_b32 %14, %14, %16, vcc\n\tv_cndmask_b32 %15, %15, %16, vcc\n\t" : "+v"(r[0]), "+v"(r[1]), "+v"(r[2]), "+v"(r[3]), "+v"(r[4]), "+v"(r[5]), "+v"(r[6]), "+v"(r[7]), "+v"(r[8]), "+v"(r[9]), "+v"(r[10]), "+v"(r[11]), "+v"(r[12]), "+v"(r[13]), "+v"(r[14]), "+v"(r[15]) : "v"(a), "v"(b) : "s40", "vcc");
#endif
#if PROBE_UB == 10
        asm volatile("v_max_i32 %0, %0, %16\n\tv_max_i32 %1, %1, %16\n\tv_max_i32 %2, %2, %16\n\tv_max_i32 %3, %3, %16\n\tv_max_i32 %4, %4, %16\n\tv_max_i32 %5, %5, %16\n\tv_max_i32 %6, %6, %16\n\tv_max_i32 %7, %7, %16\n\tv_max_i32 %8, %8, %16\n\tv_max_i32 %9, %9, %16\n\tv_max_i32 %10, %10, %16\n\tv_max_i32 %11, %11, %16\n\tv_max_i32 %12, %12, %16\n\tv_max_i32 %13, %13, %16\n\tv_max_i32 %14, %14, %16\n\tv_max_i32 %15, %15, %16\n\t" : "+v"(r[0]), "+v"(r[1]), "+v"(r[2]), "+v"(r[3]), "+v"(r[4]), "+v"(r[5]), "+v"(r[6]), "+v"(r[7]), "+v"(r[8]), "+v"(r[9]), "+v"(r[10]), "+v"(r[11]), "+v"(r[12]), "+v"(r[13]), "+v"(r[14]), "+v"(r[15]) : "v"(a), "v"(b) : "s40", "vcc");
        asm volatile("v_max_i32 %0, %0, %16\n\tv_max_i32 %1, %1, %16\n\tv_max_i32 %2, %2, %16\n\tv_max_i32 %3, %3, %16\n\tv_max_i32 %4, %4, %16\n\tv_max_i32 %5, %5, %16\n\tv_max_i32 %6, %6, %16\n\tv_max_i32 %7, %7, %16\n\tv_max_i32 %8, %8, %16\n\tv_max_i32 %9, %9, %16\n\tv_max_i32 %10, %10, %16\n\tv_max_i32 %11, %11, %16\n\tv_max_i32 %12, %12, %16\n\tv_max_i32 %13, %13, %16\n\tv_max_i32 %14, %14, %16\n\tv_max_i32 %15, %15, %16\n\t" : "+v"(r[0]), "+v"(r[1]), "+v"(r[2]), "+v"(r[3]), "+v"(r[4]), "+v"(r[5]), "+v"(r[6]), "+v"(r[7]), "+v"(r[8]), "+v"(r[9]), "+v"(r[10]), "+v"(r[11]), "+v"(r[12]), "+v"(r[13]), "+v"(r[14]), "+v"(r[15]) : "v"(a), "v"(b) : "s40", "vcc");
#endif
#if PROBE_UB == 11
        asm volatile("v_exp_f32 %0, %0\n\tv_exp_f32 %1, %1\n\tv_exp_f32 %2, %2\n\tv_exp_f32 %3, %3\n\tv_exp_f32 %4, %4\n\tv_exp_f32 %5, %5\n\tv_exp_f32 %6, %6\n\tv_exp_f32 %7, %7\n\tv_exp_f32 %8, %8\n\tv_exp_f32 %9, %9\n\tv_exp_f32 %10, %10\n\tv_exp_f32 %11, %11\n\tv_exp_f32 %12, %12\n\tv_exp_f32 %13, %13\n\tv_exp_f32 %14, %14\n\tv_exp_f32 %15, %15\n\t" : "+v"(r[0]), "+v"(r[1]), "+v"(r[2]), "+v"(r[3]), "+v"(r[4]), "+v"(r[5]), "+v"(r[6]), "+v"(r[7]), "+v"(r[8]), "+v"(r[9]), "+v"(r[10]), "+v"(r[11]), "+v"(r[12]), "+v"(r[13]), "+v"(r[14]), "+v"(r[15]) : "v"(a), "v"(b) : "s40", "vcc");
        asm volatile("v_exp_f32 %0, %0\n\tv_exp_f32 %1, %1\n\tv_exp_f32 %2, %2\n\tv_exp_f32 %3, %3\n\tv_exp_f32 %4, %4\n\tv_exp_f32 %5, %5\n\tv_exp_f32 %6, %6\n\tv_exp_f32 %7, %7\n\tv_exp_f32 %8, %8\n\tv_exp_f32 %9, %9\n\tv_exp_f32 %10, %10\n\tv_exp_f32 %11, %11\n\tv_exp_f32 %12, %12\n\tv_exp_f32 %13, %13\n\tv_exp_f32 %14, %14\n\tv_exp_f32 %15, %15\n\t" : "+v"(r[0]), "+v"(r[1]), "+v"(r[2]), "+v"(r[3]), "+v"(r[4]), "+v"(r[5]), "+v"(r[6]), "+v"(r[7]), "+v"(r[8]), "+v"(r[9]), "+v"(r[10]), "+v"(r[11]), "+v"(r[12]), "+v"(r[13]), "+v"(r[14]), "+v"(r[15]) : "v"(a), "v"(b) : "s40", "vcc");
#endif
#if PROBE_UB == 12
        asm volatile("v_fmac_f32 %0, %16, %17\n\tv_fmac_f32 %1, %16, %17\n\tv_fmac_f32 %2, %16, %17\n\tv_fmac_f32 %3, %16, %17\n\tv_fmac_f32 %4, %16, %17\n\tv_fmac_f32 %5, %16, %17\n\tv_fmac_f32 %6, %16, %17\n\tv_fmac_f32 %7, %16, %17\n\tv_fmac_f32 %8, %16, %17\n\tv_fmac_f32 %9, %16, %17\n\tv_fmac_f32 %10, %16, %17\n\tv_fmac_f32 %11, %16, %17\n\tv_fmac_f32 %12, %16, %17\n\tv_fmac_f32 %13, %16, %17\n\tv_fmac_f32 %14, %16, %17\n\tv_fmac_f32 %15, %16, %17\n\t" : "+v"(r[0]), "+v"(r[1]), "+v"(r[2]), "+v"(r[3]), "+v"(r[4]), "+v"(r[5]), "+v"(r[6]), "+v"(r[7]), "+v"(r[8]), "+v"(r[9]), "+v"(r[10]), "+v"(r[11]), "+v"(r[12]), "+v"(r[13]), "+v"(r[14]), "+v"(r[15]) : "v"(a), "v"(b) : "s40", "vcc");
        asm volatile("v_fmac_f32 %0, %16, %17\n\tv_fmac_f32 %1, %16, %17\n\tv_fmac_f32 %2, %16, %17\n\tv_fmac_f32 %3, %16, %17\n\tv_fmac_f32 %4, %16, %17\n\tv_fmac_f32 %5, %16, %17\n\tv_fmac_f32 %6, %16, %17\n\tv_fmac_f32 %7, %16, %17\n\tv_fmac_f32 %8, %16, %17\n\tv_fmac_f32 %9, %16, %17\n\tv_fmac_f32 %10, %16, %17\n\tv_fmac_f32 %11, %16, %17\n\tv_fmac_f32 %12, %16, %17\n\tv_fmac_f32 %13, %16, %17\n\tv_fmac_f32 %14, %16, %17\n\tv_fmac_f32 %15, %16, %17\n\t" : "+v"(r[0]), "+v"(r[1]), "+v"(r[2]), "+v"(r[3]), "+v"(r[4]), "+v"(r[5]), "+v"(r[6]), "+v"(r[7]), "+v"(r[8]), "+v"(r[9]), "+v"(r[10]), "+v"(r[11]), "+v"(r[12]), "+v"(r[13]), "+v"(r[14]), "+v"(r[15]) : "v"(a), "v"(b) : "s40", "vcc");
#endif
#if PROBE_UB == 13
        asm volatile("v_add_u32_dpp %0, %16, %0 quad_perm:[1,0,3,2] row_mask:0xf bank_mask:0xf\n\tv_add_u32_dpp %1, %16, %1 quad_perm:[1,0,3,2] row_mask:0xf bank_mask:0xf\n\tv_add_u32_dpp %2, %16, %2 quad_perm:[1,0,3,2] row_mask:0xf bank_mask:0xf\n\tv_add_u32_dpp %3, %16, %3 quad_perm:[1,0,3,2] row_mask:0xf bank_mask:0xf\n\tv_add_u32_dpp %4, %16, %4 quad_perm:[1,0,3,2] row_mask:0xf bank_mask:0xf\n\tv_add_u32_dpp %5, %16, %5 quad_perm:[1,0,3,2] row_mask:0xf bank_mask:0xf\n\tv_add_u32_dpp %6, %16, %6 quad_perm:[1,0,3,2] row_mask:0xf bank_mask:0xf\n\tv_add_u32_dpp %7, %16, %7 quad_perm:[1,0,3,2] row_mask:0xf bank_mask:0xf\n\tv_add_u32_dpp %8, %16, %8 quad_perm:[1,0,3,2] row_mask:0xf bank_mask:0xf\n\tv_add_u32_dpp %9, %16, %9 quad_perm:[1,0,3,2] row_mask:0xf bank_mask:0xf\n\tv_add_u32_dpp %10, %16, %10 quad_perm:[1,0,3,2] row_mask:0xf bank_mask:0xf\n\tv_add_u32_dpp %11, %16, %11 quad_perm:[1,0,3,2] row_mask:0xf bank_mask:0xf\n\tv_add_u32_dpp %12, %16, %12 quad_perm:[1,0,3,2] row_mask:0xf bank_mask:0xf\n\tv_add_u32_dpp %13, %16, %13 quad_perm:[1,0,3,2] row_mask:0xf bank_mask:0xf\n\tv_add_u32_dpp %14, %16, %14 quad_perm:[1,0,3,2] row_mask:0xf bank_mask:0xf\n\tv_add_u32_dpp %15, %16, %15 quad_perm:[1,0,3,2] row_mask:0xf bank_mask:0xf\n\t" : "+v"(r[0]), "+v"(r[1]), "+v"(r[2]), "+v"(r[3]), "+v"(r[4]), "+v"(r[5]), "+v"(r[6]), "+v"(r[7]), "+v"(r[8]), "+v"(r[9]), "+v"(r[10]), "+v"(r[11]), "+v"(r[12]), "+v"(r[13]), "+v"(r[14]), "+v"(r[15]) : "v"(a), "v"(b) : "s40", "vcc");
        asm volatile("v_add_u32_dpp %0, %16, %0 quad_perm:[1,0,3,2] row_mask:0xf bank_mask:0xf\n\tv_add_u32_dpp %1, %16, %1 quad_perm:[1,0,3,2] row_mask:0xf bank_mask:0xf\n\tv_add_u32_dpp %2, %16, %2 quad_perm:[1,0,3,2] row_mask:0xf bank_mask:0xf\n\tv_add_u32_dpp %3, %16, %3 quad_perm:[1,0,3,2] row_mask:0xf bank_mask:0xf\n\tv_add_u32_dpp %4, %16, %4 quad_perm:[1,0,3,2] row_mask:0xf bank_mask:0xf\n\tv_add_u32_dpp %5, %16, %5 quad_perm:[1,0,3,2] row_mask:0xf bank_mask:0xf\n\tv_add_u32_dpp %6, %16, %6 quad_perm:[1,0,3,2] row_mask:0xf bank_mask:0xf\n\tv_add_u32_dpp %7, %16, %7 quad_perm:[1,0,3,2] row_mask:0xf bank_mask:0xf\n\tv_add_u32_dpp %8, %16, %8 quad_perm:[1,0,3,2] row_mask:0xf bank_mask:0xf\n\tv_add_u32_dpp %9, %16, %9 quad_perm:[1,0,3,2] row_mask:0xf bank_mask:0xf\n\tv_add_u32_dpp %10, %16, %10 quad_perm:[1,0,3,2] row_mask:0xf bank_mask:0xf\n\tv_add_u32_dpp %11, %16, %11 quad_perm:[1,0,3,2] row_mask:0xf bank_mask:0xf\n\tv_add_u32_dpp %12, %16, %12 quad_perm:[1,0,3,2] row_mask:0xf bank_mask:0xf\n\tv_add_u32_dpp %13, %16, %13 quad_perm:[1,0,3,2] row_mask:0xf bank_mask:0xf\n\tv_add_u32_dpp %14, %16, %14 quad_perm:[1,0,3,2] row_mask:0xf bank_mask:0xf\n\tv_add_u32_dpp %15, %16, %15 quad_perm:[1,0,3,2] row_mask:0xf bank_mask:0xf\n\t" : "+v"(r[0]), "+v"(r[1]), "+v"(r[2]), "+v"(r[3]), "+v"(r[4]), "+v"(r[5]), "+v"(r[6]), "+v"(r[7]), "+v"(r[8]), "+v"(r[9]), "+v"(r[10]), "+v"(r[11]), "+v"(r[12]), "+v"(r[13]), "+v"(r[14]), "+v"(r[15]) : "v"(a), "v"(b) : "s40", "vcc");
#endif
#if PROBE_UB == 14
        asm volatile("v_cvt_f32_ubyte1 %0, %16\n\tv_cvt_f32_ubyte1 %1, %16\n\tv_cvt_f32_ubyte1 %2, %16\n\tv_cvt_f32_ubyte1 %3, %16\n\tv_cvt_f32_ubyte1 %4, %16\n\tv_cvt_f32_ubyte1 %5, %16\n\tv_cvt_f32_ubyte1 %6, %16\n\tv_cvt_f32_ubyte1 %7, %16\n\tv_cvt_f32_ubyte1 %8, %16\n\tv_cvt_f32_ubyte1 %9, %16\n\tv_cvt_f32_ubyte1 %10, %16\n\tv_cvt_f32_ubyte1 %11, %16\n\tv_cvt_f32_ubyte1 %12, %16\n\tv_cvt_f32_ubyte1 %13, %16\n\tv_cvt_f32_ubyte1 %14, %16\n\tv_cvt_f32_ubyte1 %15, %16\n\t" : "+v"(r[0]), "+v"(r[1]), "+v"(r[2]), "+v"(r[3]), "+v"(r[4]), "+v"(r[5]), "+v"(r[6]), "+v"(r[7]), "+v"(r[8]), "+v"(r[9]), "+v"(r[10]), "+v"(r[11]), "+v"(r[12]), "+v"(r[13]), "+v"(r[14]), "+v"(r[15]) : "v"(a), "v"(b) : "s40", "vcc");
        asm volatile("v_cvt_f32_ubyte1 %0, %16\n\tv_cvt_f32_ubyte1 %1, %16\n\tv_cvt_f32_ubyte1 %2, %16\n\tv_cvt_f32_ubyte1 %3, %16\n\tv_cvt_f32_ubyte1 %4, %16\n\tv_cvt_f32_ubyte1 %5, %16\n\tv_cvt_f32_ubyte1 %6, %16\n\tv_cvt_f32_ubyte1 %7, %16\n\tv_cvt_f32_ubyte1 %8, %16\n\tv_cvt_f32_ubyte1 %9, %16\n\tv_cvt_f32_ubyte1 %10, %16\n\tv_cvt_f32_ubyte1 %11, %16\n\tv_cvt_f32_ubyte1 %12, %16\n\tv_cvt_f32_ubyte1 %13, %16\n\tv_cvt_f32_ubyte1 %14, %16\n\tv_cvt_f32_ubyte1 %15, %16\n\t" : "+v"(r[0]), "+v"(r[1]), "+v"(r[2]), "+v"(r[3]), "+v"(r[4]), "+v"(r[5]), "+v"(r[6]), "+v"(r[7]), "+v"(r[8]), "+v"(r[9]), "+v"(r[10]), "+v"(r[11]), "+v"(r[12]), "+v"(r[13]), "+v"(r[14]), "+v"(r[15]) : "v"(a), "v"(b) : "s40", "vcc");
#endif
#if PROBE_UB == 16
        asm volatile("v_max_f32 %0, %0, %16\n\tv_max_f32 %1, %1, %16\n\tv_max_f32 %2, %2, %16\n\tv_max_f32 %3, %3, %16\n\tv_max_f32 %4, %4, %16\n\tv_max_f32 %5, %5, %16\n\tv_max_f32 %6, %6, %16\n\tv_max_f32 %7, %7, %16\n\tv_max_f32 %8, %8, %16\n\tv_max_f32 %9, %9, %16\n\tv_max_f32 %10, %10, %16\n\tv_max_f32 %11, %11, %16\n\tv_max_f32 %12, %12, %16\n\tv_max_f32 %13, %13, %16\n\tv_max_f32 %14, %14, %16\n\tv_max_f32 %15, %15, %16\n\t" : "+v"(r[0]), "+v"(r[1]), "+v"(r[2]), "+v"(r[3]), "+v"(r[4]), "+v"(r[5]), "+v"(r[6]), "+v"(r[7]), "+v"(r[8]), "+v"(r[9]), "+v"(r[10]), "+v"(r[11]), "+v"(r[12]), "+v"(r[13]), "+v"(r[14]), "+v"(r[15]) : "v"(a), "v"(b) : "s40", "s41", "vcc");
        asm volatile("v_max_f32 %0, %0, %16\n\tv_max_f32 %1, %1, %16\n\tv_max_f32 %2, %2, %16\n\tv_max_f32 %3, %3, %16\n\tv_max_f32 %4, %4, %16\n\tv_max_f32 %5, %5, %16\n\tv_max_f32 %6, %6, %16\n\tv_max_f32 %7, %7, %16\n\tv_max_f32 %8, %8, %16\n\tv_max_f32 %9, %9, %16\n\tv_max_f32 %10, %10, %16\n\tv_max_f32 %11, %11, %16\n\tv_max_f32 %12, %12, %16\n\tv_max_f32 %13, %13, %16\n\tv_max_f32 %14, %14, %16\n\tv_max_f32 %15, %15, %16\n\t" : "+v"(r[0]), "+v"(r[1]), "+v"(r[2]), "+v"(r[3]), "+v"(r[4]), "+v"(r[5]), "+v"(r[6]), "+v"(r[7]), "+v"(r[8]), "+v"(r[9]), "+v"(r[10]), "+v"(r[11]), "+v"(r[12]), "+v"(r[13]), "+v"(r[14]), "+v"(r[15]) : "v"(a), "v"(b) : "s40", "s41", "vcc");
#endif
#if PROBE_UB == 17
        asm volatile("v_cndmask_b32 %0, %0, %16, s[40:41]\n\tv_cndmask_b32 %1, %1, %16, s[40:41]\n\tv_cndmask_b32 %2, %2, %16, s[40:41]\n\tv_cndmask_b32 %3, %3, %16, s[40:41]\n\tv_cndmask_b32 %4, %4, %16, s[40:41]\n\tv_cndmask_b32 %5, %5, %16, s[40:41]\n\tv_cndmask_b32 %6, %6, %16, s[40:41]\n\tv_cndmask_b32 %7, %7, %16, s[40:41]\n\tv_cndmask_b32 %8, %8, %16, s[40:41]\n\tv_cndmask_b32 %9, %9, %16, s[40:41]\n\tv_cndmask_b32 %10, %10, %16, s[40:41]\n\tv_cndmask_b32 %11, %11, %16, s[40:41]\n\tv_cndmask_b32 %12, %12, %16, s[40:41]\n\tv_cndmask_b32 %13, %13, %16, s[40:41]\n\tv_cndmask_b32 %14, %14, %16, s[40:41]\n\tv_cndmask_b32 %15, %15, %16, s[40:41]\n\t" : "+v"(r[0]), "+v"(r[1]), "+v"(r[2]), "+v"(r[3]), "+v"(r[4]), "+v"(r[5]), "+v"(r[6]), "+v"(r[7]), "+v"(r[8]), "+v"(r[9]), "+v"(r[10]), "+v"(r[11]), "+v"(r[12]), "+v"(r[13]), "+v"(r[14]), "+v"(r[15]) : "v"(a), "v"(b) : "s40", "s41", "vcc");
        asm volatile("v_cndmask_b32 %0, %0, %16, s[40:41]\n\tv_cndmask_b32 %1, %1, %16, s[40:41]\n\tv_cndmask_b32 %2, %2, %16, s[40:41]\n\tv_cndmask_b32 %3, %3, %16, s[40:41]\n\tv_cndmask_b32 %4, %4, %16, s[40:41]\n\tv_cndmask_b32 %5, %5, %16, s[40:41]\n\tv_cndmask_b32 %6, %6, %16, s[40:41]\n\tv_cndmask_b32 %7, %7, %16, s[40:41]\n\tv_cndmask_b32 %8, %8, %16, s[40:41]\n\tv_cndmask_b32 %9, %9, %16, s[40:41]\n\tv_cndmask_b32 %10, %10, %16, s[40:41]\n\tv_cndmask_b32 %11, %11, %16, s[40:41]\n\tv_cndmask_b32 %12, %12, %16, s[40:41]\n\tv_cndmask_b32 %13, %13, %16, s[40:41]\n\tv_cndmask_b32 %14, %14, %16, s[40:41]\n\tv_cndmask_b32 %15, %15, %16, s[40:41]\n\t" : "+v"(r[0]), "+v"(r[1]), "+v"(r[2]), "+v"(r[3]), "+v"(r[4]), "+v"(r[5]), "+v"(r[6]), "+v"(r[7]), "+v"(r[8]), "+v"(r[9]), "+v"(r[10]), "+v"(r[11]), "+v"(r[12]), "+v"(r[13]), "+v"(r[14]), "+v"(r[15]) : "v"(a), "v"(b) : "s40", "s41", "vcc");
#endif
#if PROBE_UB == 18
        asm volatile("v_min_u32 %0, %0, %16\n\tv_min_u32 %1, %1, %16\n\tv_min_u32 %2, %2, %16\n\tv_min_u32 %3, %3, %16\n\tv_min_u32 %4, %4, %16\n\tv_min_u32 %5, %5, %16\n\tv_min_u32 %6, %6, %16\n\tv_min_u32 %7, %7, %16\n\tv_min_u32 %8, %8, %16\n\tv_min_u32 %9, %9, %16\n\tv_min_u32 %10, %10, %16\n\tv_min_u32 %11, %11, %16\n\tv_min_u32 %12, %12, %16\n\tv_min_u32 %13, %13, %16\n\tv_min_u32 %14, %14, %16\n\tv_min_u32 %15, %15, %16\n\t" : "+v"(r[0]), "+v"(r[1]), "+v"(r[2]), "+v"(r[3]), "+v"(r[4]), "+v"(r[5]), "+v"(r[6]), "+v"(r[7]), "+v"(r[8]), "+v"(r[9]), "+v"(r[10]), "+v"(r[11]), "+v"(r[12]), "+v"(r[13]), "+v"(r[14]), "+v"(r[15]) : "v"(a), "v"(b) : "s40", "s41", "vcc");
        asm volatile("v_min_u32 %0, %0, %16\n\tv_min_u32 %1, %1, %16\n\tv_min_u32 %2, %2, %16\n\tv_min_u32 %3, %3, %16\n\tv_min_u32 %4, %4, %16\n\tv_min_u32 %5, %5, %16\n\tv_min_u32 %6, %6, %16\n\tv_min_u32 %7, %7, %16\n\tv_min_u32 %8, %8, %16\n\tv_min_u32 %9, %9, %16\n\tv_min_u32 %10, %10, %16\n\tv_min_u32 %11, %11, %16\n\tv_min_u32 %12, %12, %16\n\tv_min_u32 %13, %13, %16\n\tv_min_u32 %14, %14, %16\n\tv_min_u32 %15, %15, %16\n\t" : "+v"(r[0]), "+v"(r[1]), "+v"(r[2]), "+v"(r[3]), "+v"(r[4]), "+v"(r[5]), "+v"(r[6]), "+v"(r[7]), "+v"(r[8]), "+v"(r[9]), "+v"(r[10]), "+v"(r[11]), "+v"(r[12]), "+v"(r[13]), "+v"(r[14]), "+v"(r[15]) : "v"(a), "v"(b) : "s40", "s41", "vcc");
#endif
#if PROBE_UB == 19
        asm volatile("v_and_b32 %0, %0, %16\n\tv_and_b32 %1, %1, %16\n\tv_and_b32 %2, %2, %16\n\tv_and_b32 %3, %3, %16\n\tv_and_b32 %4, %4, %16\n\tv_and_b32 %5, %5, %16\n\tv_and_b32 %6, %6, %16\n\tv_and_b32 %7, %7, %16\n\tv_and_b32 %8, %8, %16\n\tv_and_b32 %9, %9, %16\n\tv_and_b32 %10, %10, %16\n\tv_and_b32 %11, %11, %16\n\tv_and_b32 %12, %12, %16\n\tv_and_b32 %13, %13, %16\n\tv_and_b32 %14, %14, %16\n\tv_and_b32 %15, %15, %16\n\t" : "+v"(r[0]), "+v"(r[1]), "+v"(r[2]), "+v"(r[3]), "+v"(r[4]), "+v"(r[5]), "+v"(r[6]), "+v"(r[7]), "+v"(r[8]), "+v"(r[9]), "+v"(r[10]), "+v"(r[11]), "+v"(r[12]), "+v"(r[13]), "+v"(r[14]), "+v"(r[15]) : "v"(a), "v"(b) : "s40", "s41", "vcc");
        asm volatile("v_and_b32 %0, %0, %16\n\tv_and_b32 %1, %1, %16\n\tv_and_b32 %2, %2, %16\n\tv_and_b32 %3, %3, %16\n\tv_and_b32 %4, %4, %16\n\tv_and_b32 %5, %5, %16\n\tv_and_b32 %6, %6, %16\n\tv_and_b32 %7, %7, %16\n\tv_and_b32 %8, %8, %16\n\tv_and_b32 %9, %9, %16\n\tv_and_b32 %10, %10, %16\n\tv_and_b32 %11, %11, %16\n\tv_and_b32 %12, %12, %16\n\tv_and_b32 %13, %13, %16\n\tv_and_b32 %14, %14, %16\n\tv_and_b32 %15, %15, %16\n\t" : "+v"(r[0]), "+v"(r[1]), "+v"(r[2]), "+v"(r[3]), "+v"(r[4]), "+v"(r[5]), "+v"(r[6]), "+v"(r[7]), "+v"(r[8]), "+v"(r[9]), "+v"(r[10]), "+v"(r[11]), "+v"(r[12]), "+v"(r[13]), "+v"(r[14]), "+v"(r[15]) : "v"(a), "v"(b) : "s40", "s41", "vcc");
#endif
#if PROBE_UB == 20
        asm volatile("v_lshrrev_b32 %0, 4, %0\n\tv_lshrrev_b32 %1, 4, %1\n\tv_lshrrev_b32 %2, 4, %2\n\tv_lshrrev_b32 %3, 4, %3\n\tv_lshrrev_b32 %4, 4, %4\n\tv_lshrrev_b32 %5, 4, %5\n\tv_lshrrev_b32 %6, 4, %6\n\tv_lshrrev_b32 %7, 4, %7\n\tv_lshrrev_b32 %8, 4, %8\n\tv_lshrrev_b32 %9, 4, %9\n\tv_lshrrev_b32 %10, 4, %10\n\tv_lshrrev_b32 %11, 4, %11\n\tv_lshrrev_b32 %12, 4, %12\n\tv_lshrrev_b32 %13, 4, %13\n\tv_lshrrev_b32 %14, 4, %14\n\tv_lshrrev_b32 %15, 4, %15\n\t" : "+v"(r[0]), "+v"(r[1]), "+v"(r[2]), "+v"(r[3]), "+v"(r[4]), "+v"(r[5]), "+v"(r[6]), "+v"(r[7]), "+v"(r[8]), "+v"(r[9]), "+v"(r[10]), "+v"(r[11]), "+v"(r[12]), "+v"(r[13]), "+v"(r[14]), "+v"(r[15]) : "v"(a), "v"(b) : "s40", "s41", "vcc");
        asm volatile("v_lshrrev_b32 %0, 4, %0\n\tv_lshrrev_b32 %1, 4, %1\n\tv_lshrrev_b32 %2, 4, %2\n\tv_lshrrev_b32 %3, 4, %3\n\tv_lshrrev_b32 %4, 4, %4\n\tv_lshrrev_b32 %5, 4, %5\n\tv_lshrrev_b32 %6, 4, %6\n\tv_lshrrev_b32 %7, 4, %7\n\tv_lshrrev_b32 %8, 4, %8\n\tv_lshrrev_b32 %9, 4, %9\n\tv_lshrrev_b32 %10, 4, %10\n\tv_lshrrev_b32 %11, 4, %11\n\tv_lshrrev_b32 %12, 4, %12\n\tv_lshrrev_b32 %13, 4, %13\n\tv_lshrrev_b32 %14, 4, %14\n\tv_lshrrev_b32 %15, 4, %15\n\t" : "+v"(r[0]), "+v"(r[1]), "+v"(r[2]), "+v"(r[3]), "+v"(r[4]), "+v"(r[5]), "+v"(r[6]), "+v"(r[7]), "+v"(r[8]), "+v"(r[9]), "+v"(r[10]), "+v"(r[11]), "+v"(r[12]), "+v"(r[13]), "+v"(r[14]), "+v"(r[15]) : "v"(a), "v"(b) : "s40", "s41", "vcc");
#endif
#if PROBE_UB == 21
        asm volatile("v_mul_f32 %0, %0, %16\n\tv_mul_f32 %1, %1, %16\n\tv_mul_f32 %2, %2, %16\n\tv_mul_f32 %3, %3, %16\n\tv_mul_f32 %4, %4, %16\n\tv_mul_f32 %5, %5, %16\n\tv_mul_f32 %6, %6, %16\n\tv_mul_f32 %7, %7, %16\n\tv_mul_f32 %8, %8, %16\n\tv_mul_f32 %9, %9, %16\n\tv_mul_f32 %10, %10, %16\n\tv_mul_f32 %11, %11, %16\n\tv_mul_f32 %12, %12, %16\n\tv_mul_f32 %13, %13, %16\n\tv_mul_f32 %14, %14, %16\n\tv_mul_f32 %15, %15, %16\n\t" : "+v"(r[0]), "+v"(r[1]), "+v"(r[2]), "+v"(r[3]), "+v"(r[4]), "+v"(r[5]), "+v"(r[6]), "+v"(r[7]), "+v"(r[8]), "+v"(r[9]), "+v"(r[10]), "+v"(r[11]), "+v"(r[12]), "+v"(r[13]), "+v"(r[14]), "+v"(r[15]) : "v"(a), "v"(b) : "s40", "s41", "vcc");
        asm volatile("v_mul_f32 %0, %0, %16\n\tv_mul_f32 %1, %1, %16\n\tv_mul_f32 %2, %2, %16\n\tv_mul_f32 %3, %3, %16\n\tv_mul_f32 %4, %4, %16\n\tv_mul_f32 %5, %5, %16\n\tv_mul_f32 %6, %6, %16\n\tv_mul_f32 %7, %7, %16\n\tv_mul_f32 %8, %8, %16\n\tv_mul_f32 %9, %9, %16\n\tv_mul_f32 %10, %10, %16\n\tv_mul_f32 %11, %11, %16\n\tv_mul_f32 %12, %12, %16\n\tv_mul_f32 %13, %13, %16\n\tv_mul_f32 %14, %14, %16\n\tv_mul_f32 %15, %15, %16\n\t" : "+v"(r[0]), "+v"(r[1]), "+v"(r[2]), "+v"(r[3]), "+v"(r[4]), "+v"(r[5]), "+v"(r[6]), "+v"(r[7]), "+v"(r[8]), "+v"(r[9]), "+v"(r[10]), "+v"(r[11]), "+v"(r[12]), "+v"(r[13]), "+v"(r[14]), "+v"(r[15]) : "v"(a), "v"(b) : "s40", "s41", "vcc");
#endif
#if PROBE_UB == 22
        asm volatile("v_add_u32 %0, %0, %16\n\tv_add_u32 %1, %1, %16\n\tv_add_u32 %2, %2, %16\n\tv_add_u32 %3, %3, %16\n\tv_add_u32 %4, %4, %16\n\tv_add_u32 %5, %5, %16\n\tv_add_u32 %6, %6, %16\n\tv_add_u32 %7, %7, %16\n\tv_add_u32 %8, %8, %16\n\tv_add_u32 %9, %9, %16\n\tv_add_u32 %10, %10, %16\n\tv_add_u32 %11, %11, %16\n\tv_add_u32 %12, %12, %16\n\tv_add_u32 %13, %13, %16\n\tv_add_u32 %14, %14, %16\n\tv_add_u32 %15, %15, %16\n\t" : "+v"(r[0]), "+v"(r[1]), "+v"(r[2]), "+v"(r[3]), "+v"(r[4]), "+v"(r[5]), "+v"(r[6]), "+v"(r[7]), "+v"(r[8]), "+v"(r[9]), "+v"(r[10]), "+v"(r[11]), "+v"(r[12]), "+v"(r[13]), "+v"(r[14]), "+v"(r[15]) : "v"(a), "v"(b) : "s40", "s41", "vcc");
        asm volatile("v_add_u32 %0, %0, %16\n\tv_add_u32 %1, %1, %16\n\tv_add_u32 %2, %2, %16\n\tv_add_u32 %3, %3, %16\n\tv_add_u32 %4, %4, %16\n\tv_add_u32 %5, %5, %16\n\tv_add_u32 %6, %6, %16\n\tv_add_u32 %7, %7, %16\n\tv_add_u32 %8, %8, %16\n\tv_add_u32 %9, %9, %16\n\tv_add_u32 %10, %10, %16\n\tv_add_u32 %11, %11, %16\n\tv_add_u32 %12, %12, %16\n\tv_add_u32 %13, %13, %16\n\tv_add_u32 %14, %14, %16\n\tv_add_u32 %15, %15, %16\n\t" : "+v"(r[0]), "+v"(r[1]), "+v"(r[2]), "+v"(r[3]), "+v"(r[4]), "+v"(r[5]), "+v"(r[6]), "+v"(r[7]), "+v"(r[8]), "+v"(r[9]), "+v"(r[10]), "+v"(r[11]), "+v"(r[12]), "+v"(r[13]), "+v"(r[14]), "+v"(r[15]) : "v"(a), "v"(b) : "s40", "s41", "vcc");
#endif
#if PROBE_UB == 23
        asm volatile("v_cvt_pk_bf16_f32 %0, %0, %16\n\tv_cvt_pk_bf16_f32 %1, %1, %16\n\tv_cvt_pk_bf16_f32 %2, %2, %16\n\tv_cvt_pk_bf16_f32 %3, %3, %16\n\tv_cvt_pk_bf16_f32 %4, %4, %16\n\tv_cvt_pk_bf16_f32 %5, %5, %16\n\tv_cvt_pk_bf16_f32 %6, %6, %16\n\tv_cvt_pk_bf16_f32 %7, %7, %16\n\tv_cvt_pk_bf16_f32 %8, %8, %16\n\tv_cvt_pk_bf16_f32 %9, %9, %16\n\tv_cvt_pk_bf16_f32 %10, %10, %16\n\tv_cvt_pk_bf16_f32 %11, %11, %16\n\tv_cvt_pk_bf16_f32 %12, %12, %16\n\tv_cvt_pk_bf16_f32 %13, %13, %16\n\tv_cvt_pk_bf16_f32 %14, %14, %16\n\tv_cvt_pk_bf16_f32 %15, %15, %16\n\t" : "+v"(r[0]), "+v"(r[1]), "+v"(r[2]), "+v"(r[3]), "+v"(r[4]), "+v"(r[5]), "+v"(r[6]), "+v"(r[7]), "+v"(r[8]), "+v"(r[9]), "+v"(r[10]), "+v"(r[11]), "+v"(r[12]), "+v"(r[13]), "+v"(r[14]), "+v"(r[15]) : "v"(a), "v"(b) : "s40", "s41", "vcc");
        asm volatile("v_cvt_pk_bf16_f32 %0, %0, %16\n\tv_cvt_pk_bf16_f32 %1, %1, %16\n\tv_cvt_pk_bf16_f32 %2, %2, %16\n\tv_cvt_pk_bf16_f32 %3, %3, %16\n\tv_cvt_pk_bf16_f32 %4, %4, %16\n\tv_cvt_pk_bf16_f32 %5, %5, %16\n\tv_cvt_pk_bf16_f32 %6, %6, %16\n\tv_cvt_pk_bf16_f32 %7, %7, %16\n\tv_cvt_pk_bf16_f32 %8, %8, %16\n\tv_cvt_pk_bf16_f32 %9, %9, %16\n\tv_cvt_pk_bf16_f32 %10, %10, %16\n\tv_cvt_pk_bf16_f32 %11, %11, %16\n\tv_cvt_pk_bf16_f32 %12, %12, %16\n\tv_cvt_pk_bf16_f32 %13, %13, %16\n\tv_cvt_pk_bf16_f32 %14, %14, %16\n\tv_cvt_pk_bf16_f32 %15, %15, %16\n\t" : "+v"(r[0]), "+v"(r[1]), "+v"(r[2]), "+v"(r[3]), "+v"(r[4]), "+v"(r[5]), "+v"(r[6]), "+v"(r[7]), "+v"(r[8]), "+v"(r[9]), "+v"(r[10]), "+v"(r[11]), "+v"(r[12]), "+v"(r[13]), "+v"(r[14]), "+v"(r[15]) : "v"(a), "v"(b) : "s40", "s41", "vcc");
#endif
    }
    float s = 0.f;
#pragma unroll
    for (int i = 0; i < 16; ++i) s += r[i];
#pragma unroll
    for (int i = 0; i < 8; ++i) s += r2[i].x + r2[i].y;
    if (s == 1.2345e-33f) asm volatile("s_nop 0" ::: "memory");
}
#endif
__device__ __forceinline__ void phase_mod(const Params& p, LAS unsigned char* lds, int wv) {
    const int tid = tid_opaque(wv);
    LAS float* sc = (LAS float*)lds;
    LAS float* red = (LAS float*)(lds + 32768);
    for (int i = tid; i < BATCH * D_MODEL; i += 512) { const int b = i >> 10, k = i & 1023; const float v = p.c[i]; sc[k * 8 + b] = v / (1.0f + __expf(-v)); }
    __syncthreads();
    const int kg = tid >> 5, cl = tid & 31;
    for (int u = blockIdx.x; u < DEPTH * 64; u += gridDim.x) {
        const int l = u >> 6, j0 = (u & 63) * 96;
        const float* w = p.w_mod + (size_t)l * D_MODEL * MODW + (size_t)(kg * 64) * MODW + j0 + cl;
        float acc[3][8];
#pragma unroll
        for (int q = 0; q < 3; ++q)
#pragma unroll
            for (int b = 0; b < 8; ++b) acc[q][b] = 0.f;
#pragma unroll 4
        for (int kk = 0; kk < 64; ++kk) {
            const float w0 = w[(size_t)kk * MODW], w1 = w[(size_t)kk * MODW + 32], w2 = w[(size_t)kk * MODW + 64];
            const f32x4 s0 = *(const LAS f32x4*)(sc + (kg * 64 + kk) * 8), s1 = *(const LAS f32x4*)(sc + (kg * 64 + kk) * 8 + 4);
#pragma unroll
            for (int b = 0; b < 4; ++b) { acc[0][b] += s0[b] * w0; acc[1][b] += s0[b] * w1; acc[2][b] += s0[b] * w2; acc[0][4 + b] += s1[b] * w0; acc[1][4 + b] += s1[b] * w1; acc[2][4 + b] += s1[b] * w2; }
        }
#pragma unroll
        for (int q = 0; q < 3; ++q)
#pragma unroll
            for (int b = 0; b < 8; ++b) red[((kg * 3 + q) * 8 + b) * 32 + cl] = acc[q][b];
        __syncthreads();
        for (int o = tid; o < 768; o += 512) {
            float s = 0.f;
#pragma unroll
            for (int g = 0; g < 16; ++g) s += red[g * 768 + o];
            const int ocl = o & 31, ob = (o >> 5) & 7, oq = o >> 8;
            const int j = j0 + oq * 32 + ocl;
            p.mod()[((size_t)l * BATCH + ob) * MODW + j] = s + p.b_mod[(size_t)l * MODW + j];
        }
        __syncthreads();
    }
}

__device__ __forceinline__ void phase_biasq(const Params& p, int wv) {
    const int tid = tid_opaque(wv), wave = tid >> 6, lane = tid & 63;
    for (int it = blockIdx.x * NWAVES + wave; it < DEPTH * 2048; it += gridDim.x * NWAVES) {
        const int l = it >> 11, n = it & 2047;
        const bf16_t* wr = p.WqT() + ((size_t)l * 2048 + n) * D_MODEL + lane * 16;
        const u32x4 w0 = *(const u32x4*)wr, w1 = *(const u32x4*)(wr + 8);
        float w[16];
#pragma unroll
        for (int e = 0; e < 4; ++e) { w[2 * e] = bflo(w0[e]); w[2 * e + 1] = bfhi(w0[e]); w[8 + 2 * e] = bflo(w1[e]); w[8 + 2 * e + 1] = bfhi(w1[e]); }
#pragma unroll 1
        for (int b = 0; b < BATCH; ++b) {
            const float* sh = p.mod() + ((size_t)l * BATCH + b) * MODW + 3 * D_MODEL + lane * 16;
            float s = 0.f;
#pragma unroll
            for (int q = 0; q < 4; ++q) { const f32x4 v = *(const f32x4*)(sh + 4 * q); s += v[0] * w[4 * q] + v[1] * w[4 * q + 1] + v[2] * w[4 * q + 2] + v[3] * w[4 * q + 3]; }
            s = wave_sum(s);
            if (lane == 0) p.biasq()[((size_t)l * BATCH + b) * 2048 + n] = s;
        }
    }
}

#ifndef PROBE_TIME
#define PROBE_TIME 0
#endif
#if PROBE_TIME || PROBE_UB
#define PT_BEGIN(k) do { if ((k) == PROBE_TIME) pt_t0 = __builtin_amdgcn_s_memrealtime(); } while (0)
#define PT_END(k) do { if ((k) == PROBE_TIME) pt_acc += __builtin_amdgcn_s_memrealtime() - pt_t0; } while (0)
#else
#define PT_BEGIN(k) do { } while (0)
#define PT_END(k) do { } while (0)
#endif
__global__ void __launch_bounds__(512, 2) k_mega(Params p) {
    extern __shared__ __attribute__((aligned(16))) unsigned char smem_raw[];
    LAS unsigned char* lds = (LAS unsigned char*)smem_raw;
    volatile LAS unsigned* xbw = (volatile LAS unsigned*)(lds + LDS_BYTES - 16);
    const int wv = __builtin_amdgcn_readfirstlane((int)threadIdx.x >> 6);
    if (threadIdx.x == 0) { xbw[0] = 0u; xbw[1] = 0u; xbw[2] = 0u; xbw[3] = 0u; }
    __syncthreads();
    (void)xcd_barrier_post(p.bar(), xbw);
#define GRID_SYNC_AT(k) do { PT_BEGIN(30 + (k)); GRID_SYNC(); PT_END(30 + (k)); } while (0)
#define GRID_SYNC() do { XcdBarrier _b; _b.bar = p.bar(); _b.x = xb_xcc_id(); _b.st = (volatile LAS unsigned*)(lds + LDS_BYTES - 16); _b.t0 = (tid_opaque(wv) == 0); PT_BEGIN(20); xcd_barrier(_b); PT_END(20); } while (0)
#if PROBE_TIME || PROBE_UB
    unsigned long long pt_t0 = 0, pt_acc = 0;
#endif
#if PROBE_UB
    { GRID_SYNC(); const unsigned long long u0 = __builtin_amdgcn_s_memrealtime(); ubench(4000, (unsigned)blockIdx.x); pt_acc += __builtin_amdgcn_s_memrealtime() - u0; GRID_SYNC(); }
#endif
#if PROBE_MASK & 32
    for (int rep = 0; rep < 20; ++rep) GRID_SYNC();
#endif
    PT_BEGIN(1);
    for (int rep = 0; rep < ((PROBE_MASK & 8) ? 2 : 1); ++rep) { phase_mod(p, lds, wv); phase_convert(p, lds, wv); }
    GRID_SYNC();
    PT_END(1); PT_BEGIN(2);
    phase_norm(p, p.x_in, p.norm1_g, p.mod(), 0, 1, wv);
    phase_biasq(p, wv);
    GRID_SYNC();
    PT_END(2);
    for (int l = 0; l < DEPTH; ++l) {
        const float* modl = p.mod() + (size_t)l * BATCH * MODW;
        PT_BEGIN(3);
        for (int rep = 0; rep < ((PROBE_MASK & 1) ? 2 : 1); ++rep) { EpiStoreBf16 E; E.O = p.pb(); E.ldc = MIX_IN; run_gemm(lds, p.hb(), p.WinT() + (size_t)l * MIX_IN * D_MODEL, NTOK, MIX_IN, D_MODEL, E, wv); }
        GRID_SYNC_AT(2);
        PT_END(3); PT_BEGIN(4); PT_BEGIN(10);
        for (int rep = 0; rep < ((PROBE_MASK & 2) ? 2 : 1); ++rep) phase_attn(p, l, lds, wv);
        PT_END(10);
        for (int rep = 0; rep < ((PROBE_MASK & 16) ? 2 : 1); ++rep) phase_mixrest(p, l, lds, wv);
        GRID_SYNC_AT(3);
        PT_END(4); PT_BEGIN(5);
        { EpiResidNorm E; E.xin = (l == 0) ? p.x_in : p.xb(); E.xout = p.xb(); E.modl = modl; E.n2g = p.norm2_g + l * D_MODEL; E.hb = p.hb(); E.ssq = p.ssq();
          run_gemm(lds, p.cat(), p.WoutT() + (size_t)l * D_MODEL * D_MODEL, NTOK, D_MODEL, D_MODEL, E, wv); }
        GRID_SYNC_AT(4);
        PT_END(5);
        PT_BEGIN(7);
        for (int rep = 0; rep < ((PROBE_MASK & 1) ? 2 : 1); ++rep) { EpiQ E; E.O = p.qb(); E.ssq = p.ssq(); E.biasq = p.biasq() + (size_t)l * BATCH * 2048; run_gemm(lds, p.hb(), p.WqT() + (size_t)l * 2048 * D_MODEL, NTOK, 2048, D_MODEL, E, wv); }
        GRID_SYNC_AT(5);
        PT_END(7); PT_BEGIN(8);
        for (int rep = 0; rep < ((PROBE_MASK & 4) ? 2 : 1); ++rep) phase_topk(p, l, lds, wv);
        GRID_SYNC_AT(6);
        PT_END(8); PT_BEGIN(9); PT_BEGIN(11);
        PT_BEGIN(12);
        if (PROBE_SYNTH) phase_expert(p, l, false, lds, wv, PROBE_SYNTH, true);
        PT_END(12);
        phase_expert(p, l, l == DEPTH - 1, lds, wv);
        PT_END(11);
        GRID_SYNC_AT(7);
        PT_END(9);
    }
#if PROBE_TIME || PROBE_UB
    if (blockIdx.x == PROBE_BLOCK) {
        const unsigned long long t1 = __builtin_amdgcn_s_memrealtime();
        while (__builtin_amdgcn_s_memrealtime() - t1 < 4ull * pt_acc) __builtin_amdgcn_s_sleep(8);
    }
#endif
}
#if MK_MULTI
enum { PH_CONVERT = 0, PH_NORM1, PH_GEMM1, PH_GEMM2, PH_NORM2, PH_GEMM3, PH_MOD };
template <int PH>
__global__ void __launch_bounds__(512, 2) k_ph(Params p, int l) {
    extern __shared__ __attribute__((aligned(16))) unsigned char smem_raw[];
    LAS unsigned char* lds = (LAS unsigned char*)smem_raw;
    const int wv = __builtin_amdgcn_readfirstlane((int)threadIdx.x >> 6);
    const float* modl = p.mod() + (size_t)l * BATCH * MODW;
    if (PH == PH_CONVERT) phase_convert(p, lds, wv);
    if (PH == PH_MOD) phase_mod(p, lds, wv);
    if (PH == PH_NORM1) phase_norm(p, l == 0 ? p.x_in : p.xb(), p.norm1_g + l * D_MODEL, modl, 0, 1, wv);
    if (PH == PH_GEMM1) { EpiStoreBf16 E; E.O = p.pb(); E.ldc = MIX_IN; run_gemm(lds, p.hb(), p.WinT() + (size_t)l * MIX_IN * D_MODEL, NTOK, MIX_IN, D_MODEL, E, wv); }
    if (PH == PH_GEMM2) { EpiResid E; E.xin = (l == 0) ? p.x_in : p.xb(); E.xout = p.xb(); E.gate = modl + 2 * D_MODEL; run_gemm(lds, p.cat(), p.WoutT() + (size_t)l * D_MODEL * D_MODEL, NTOK, D_MODEL, D_MODEL, E, wv); }
    if (PH == PH_NORM2) phase_norm(p, p.xb(), p.norm2_g + l * D_MODEL, modl, 3, 4, wv);
    if (PH == PH_GEMM3) { EpiStoreBf16 E; E.O = p.qb(); E.ldc = 2048; run_gemm(lds, p.hb(), p.WqT() + (size_t)l * 2048 * D_MODEL, NTOK, 2048, D_MODEL, E, wv); }
}

#endif

extern "C" void kernel_launch(void* const* d_in, const int* in_sizes, int n_in, void* d_out, int out_size, void* d_ws, size_t ws_size, hipStream_t stream) {
    Params p{};
    p.x_in = (const float*)d_in[0]; p.c = (const float*)d_in[1]; p.rel_bias = (const float*)d_in[2]; p.w_mod = (const float*)d_in[3]; p.b_mod = (const float*)d_in[4];
    p.norm1_g = (const float*)d_in[5]; p.norm2_g = (const float*)d_in[6]; p.w_in = (const float*)d_in[7]; p.w_out = (const float*)d_in[8]; p.diff_lambda = (const float*)d_in[9];
    p.subln_g = (const float*)d_in[10]; p.conf_dw = (const float*)d_in[11]; p.conf_ln_g = (const float*)d_in[12]; p.conf_ln_b = (const float*)d_in[13]; p.sconv_w = (const float*)d_in[14];
    p.sgu_ln_g = (const float*)d_in[15]; p.sgu_ln_b = (const float*)d_in[16]; p.sgu_w = (const float*)d_in[17]; p.sgu_b = (const float*)d_in[18]; p.peer_wq = (const float*)d_in[19];
    p.peer_keys = (const float*)d_in[20]; p.peer_u = (const float*)d_in[21]; p.peer_v = (const float*)d_in[22]; p.final_g = (const float*)d_in[23];
    p.out = (float*)d_out;
    for (int l = 0; l < DEPTH; ++l) p.lam_init[l] = (float)(0.8 - 0.6 * exp(-0.3 * (double)l));

    p.ws = (unsigned char*)d_ws;
    if (ws_size < WS_END) { fprintf(stderr, "kernel_launch: workspace too small\n"); return; }

    static int grid = 0;
    if (grid == 0) {
        int dev = 0, cus = 0;
        if (hipGetDevice(&dev) != hipSuccess || hipDeviceGetAttribute(&cus, hipDeviceAttributeMultiprocessorCount, dev) != hipSuccess) { grid = -1; return; }
        bool ok = true;
#if MK_MULTI
        ok &= hipFuncSetAttribute((const void*)k_ph<PH_CONVERT>, hipFuncAttributeMaxDynamicSharedMemorySize, LDS_BYTES) == hipSuccess;
        ok &= hipFuncSetAttribute((const void*)k_ph<PH_NORM1>, hipFuncAttributeMaxDynamicSharedMemorySize, LDS_BYTES) == hipSuccess;
        ok &= hipFuncSetAttribute((const void*)k_ph<PH_GEMM1>, hipFuncAttributeMaxDynamicSharedMemorySize, LDS_BYTES) == hipSuccess;
        ok &= hipFuncSetAttribute((const void*)k_ph<PH_GEMM2>, hipFuncAttributeMaxDynamicSharedMemorySize, LDS_BYTES) == hipSuccess;
        ok &= hipFuncSetAttribute((const void*)k_ph<PH_NORM2>, hipFuncAttributeMaxDynamicSharedMemorySize, LDS_BYTES) == hipSuccess;
        ok &= hipFuncSetAttribute((const void*)k_ph<PH_GEMM3>, hipFuncAttributeMaxDynamicSharedMemorySize, LDS_BYTES) == hipSuccess;
        ok &= hipFuncSetAttribute((const void*)k_ph<PH_MOD>, hipFuncAttributeMaxDynamicSharedMemorySize, LDS_BYTES) == hipSuccess;
        ok &= hipFuncSetAttribute((const void*)k_attn2<0>, hipFuncAttributeMaxDynamicSharedMemorySize, LDS_BYTES) == hipSuccess;
        ok &= hipFuncSetAttribute((const void*)k_topk<0>, hipFuncAttributeMaxDynamicSharedMemorySize, LDS_BYTES) == hipSuccess;
        ok &= hipFuncSetAttribute((const void*)k_mixrest<0>, hipFuncAttributeMaxDynamicSharedMemorySize, LDS_BYTES) == hipSuccess;
        ok &= hipFuncSetAttribute((const void*)k_expert, hipFuncAttributeMaxDynamicSharedMemorySize, LDS_BYTES) == hipSuccess;
#else
        ok &= hipFuncSetAttribute((const void*)k_mega, hipFuncAttributeMaxDynamicSharedMemorySize, LDS_BYTES) == hipSuccess;
#endif
        if (!ok) { fprintf(stderr, "kernel_launch: hipFuncSetAttribute failed\n"); grid = -1; return; }
        grid = cus;
    }
    if (grid < 0) return;
    const int G = grid;
#if MK_MULTI
    k_ph<PH_MOD><<<G, 512, LDS_BYTES, stream>>>(p, 0);
    k_ph<PH_CONVERT><<<G, 512, LDS_BYTES, stream>>>(p, 0);
    for (int l = 0; l < DEPTH; ++l) {
        if (l == 0) k_ph<PH_NORM1><<<G, 512, LDS_BYTES, stream>>>(p, l);
        k_ph<PH_GEMM1><<<G, 512, LDS_BYTES, stream>>>(p, l);
        k_attn2<0><<<G, 512, LDS_BYTES, stream>>>(p, l);
        k_mixrest<0><<<G, 512, LDS_BYTES, stream>>>(p, l);
        k_ph<PH_GEMM2><<<G, 512, LDS_BYTES, stream>>>(p, l);
        k_ph<PH_NORM2><<<G, 512, LDS_BYTES, stream>>>(p, l);
        k_ph<PH_GEMM3><<<G, 512, LDS_BYTES, stream>>>(p, l);
        k_topk<0><<<G, 512, LDS_BYTES, stream>>>(p, l);
        k_expert<<<G, 512, LDS_BYTES, stream>>>(p, l);
    }
#else
    (void)hipMemsetAsync(p.ws + OFF_BAR, 0, OFF_MOD - OFF_BAR, stream);
    k_mega<<<G, 512, LDS_BYTES, stream>>>(p);
#endif
}
```

```cpp
#include <hip/hip_runtime.h>
#include <stdint.h>
#include <stdio.h>
#include <math.h>

#define D_MODEL 1024
#define BATCH 8
#define SEQ 2048
#define DEPTH 4
#define NTOK (BATCH * SEQ)
#define MIX_IN 2560
#define N_MOD 6
#define MODW (N_MOD * D_MODEL)
#define NEXP 16384

#define MK_MULTI 0
#define FUSE_TOPK_EXPERT 0
#define EXPERT_MAP_GROUPED 1
#ifndef PROBE_MASK
#define PROBE_MASK 0
#endif
#define PROBE_TIME 0
#define PROBE_SYNTH 0
#define PROBE_UB 0
#define PROBE_BLOCK 0
#define LAS __attribute__((address_space(3)))
typedef unsigned short bf16_t;
typedef short bf16x8 __attribute__((ext_vector_type(8)));
typedef float f32x4 __attribute__((ext_vector_type(4)));
typedef float f32x16 __attribute__((ext_vector_type(16)));
typedef unsigned u32x4 __attribute__((ext_vector_type(4)));
typedef unsigned u32x2 __attribute__((ext_vector_type(2)));
typedef float f32x2 __attribute__((ext_vector_type(2)));

__device__ const unsigned char kBucket[128] = {
    0, 1, 2, 3, 4, 5, 6, 7, 8, 9, 10, 11, 12, 13, 14, 15, 16, 16, 16, 17, 17, 18, 18, 18, 19, 19, 19, 20, 20, 20, 20, 21,
    21, 21, 21, 22, 22, 22, 22, 22, 23, 23, 23, 23, 23, 23, 24, 24, 24, 24, 24, 24, 25, 25, 25, 25, 25, 25, 25, 26, 26, 26, 26, 26,
    26, 26, 26, 27, 27, 27, 27, 27, 27, 27, 27, 27, 27, 28, 28, 28, 28, 28, 28, 28, 28, 28, 28, 29, 29, 29, 29, 29, 29, 29, 29, 29,
    29, 29, 29, 30, 30, 30, 30, 30, 30, 30, 30, 30, 30, 30, 30, 30, 30, 31, 31, 31, 31, 31, 31, 31, 31, 31, 31, 31, 31, 31, 31, 31};

__device__ __forceinline__ float bf2f(bf16_t v) { return __uint_as_float(((unsigned)v) << 16); }
__device__ __forceinline__ float bflo(unsigned w) { return __uint_as_float(w << 16); }
__device__ __forceinline__ float bfhi(unsigned w) { return __uint_as_float(w & 0xFFFF0000u); }
__device__ __forceinline__ bf16_t f2bf(float f) { unsigned u = __float_as_uint(f); u += 0x7FFFu + ((u >> 16) & 1u); return (bf16_t)(u >> 16); }
__device__ __forceinline__ unsigned pk2(float lo, float hi) { unsigned r; asm volatile("v_cvt_pk_bf16_f32 %0, %1, %2" : "=v"(r) : "v"(lo), "v"(hi)); return r; }
__device__ __forceinline__ float ldf(const float* p) { return *p; }
__device__ __forceinline__ float ldf(const bf16_t* p) { return bf2f(*p); }

__device__ __forceinline__ float gelu_as(float v) {
    const float av = fabsf(v), t = __builtin_amdgcn_rcpf(av * 0.2316418882f + 1.0f);
    float q = t * 0.5307027145f + (-0.7265760135f); q = q * t + 0.7107068705f; q = q * t + (-0.142248368f); q = q * t + 0.127414796f; q = q * t;
    const float e = __builtin_amdgcn_exp2f((v * v) * (-0.72134752044f));
    const float m = v * (q * e);
    return v < 0.f ? m : v - m;
}
template <int CTRL, int ROWMASK = 0xF>
__device__ __forceinline__ float dpp_add(float x) {
    const int y = __builtin_amdgcn_update_dpp(0, __float_as_int(x), CTRL, ROWMASK, 0xF, false);
    return x + __int_as_float(y);
}
__device__ __forceinline__ float wave_sum_l63(float v) {
    v = dpp_add<0xB1>(v);
    v = dpp_add<0x4E>(v);
    v = dpp_add<0x141>(v);
    v = dpp_add<0x140>(v);
    v = dpp_add<0x142, 0xA>(v);
    v = dpp_add<0x143, 0xC>(v);
    return v;
}
__device__ __forceinline__ float gelu_exact(float v) { return 0.5f * v * (1.0f + erff(v * 0.70710678118654752f)); }
__device__ __forceinline__ float sigmoidf_(float v) { return 1.0f / (1.0f + __expf(-v)); }
__device__ __forceinline__ float wave_sum(float v) {
#pragma unroll
    for (int o = 32; o > 0; o >>= 1) v += __shfl_xor(v, o, 64);
    return v;
}
__device__ __forceinline__ float block_sum256(float v, float* red) {
    v = wave_sum(v);
    __syncthreads();
    if ((threadIdx.x & 63) == 0) red[threadIdx.x >> 6] = v;
    __syncthreads();
    return red[0] + red[1] + red[2] + red[3];
}

__device__ __forceinline__ int tid_opaque(int wv) {
    int t;
    asm volatile("v_mbcnt_lo_u32_b32 %0, -1, 0\n\tv_mbcnt_hi_u32_b32 %0, -1, %0" : "=v"(t));
    return (wv << 6) | t;
}
__device__ __forceinline__ int launder(int v) { asm volatile("" : "+v"(v)); return v; }
#define XB_TMO      128
#define XB_XCNT(j)  (256  + 64 * (j))
#define XB_XSUB(j)  (1280 + 64 * (j))
#define XB_XGEN(j)  (2304 + 64 * (j))
#define XB_TOP      3328
#define XB_TOPGEN   3392
#define XCD_BAR_WORDS 3456
#define XB_SPIN_CAP (1u << 18)

__device__ __forceinline__ unsigned xb_ld(unsigned* p)              { return __hip_atomic_load(p, __ATOMIC_RELAXED, __HIP_MEMORY_SCOPE_AGENT); }
__device__ __forceinline__ unsigned xb_add(unsigned* p, unsigned v) { return __hip_atomic_fetch_add(p, v, __ATOMIC_RELAXED, __HIP_MEMORY_SCOPE_AGENT); }
__device__ __forceinline__ unsigned xb_xcc_id() { return (unsigned)__builtin_amdgcn_s_getreg((3 << 11) | 20) & 0xFu; }
#define XB_SPIN(cond, bar) do { unsigned _sp = 0; while (cond) { __builtin_amdgcn_s_sleep(1); \
    if ((++_sp & 255u) == 0u) { if (xb_ld(&(bar)[XB_TMO])) break; if (_sp > XB_SPIN_CAP) { atomicAdd(&(bar)[XB_TMO], 1u); break; } } } } while (0)

struct XcdBarrier {
    unsigned* bar; unsigned x;
    bool t0;
    volatile LAS unsigned* st;
};

__device__ __forceinline__ XcdBarrier xcd_barrier_post(unsigned* bar, volatile LAS unsigned* st) {
    XcdBarrier b; b.bar = bar; b.x = xb_xcc_id(); b.st = st;
    if (threadIdx.x == 0) (void)xb_add(&bar[XB_XCNT(b.x)], 1u);
    return b;
}
__device__ __forceinline__ void xcd_barrier_complete(unsigned* bar, unsigned x, unsigned& nloc, unsigned& nx) {
    const unsigned G = gridDim.x * gridDim.y * gridDim.z;
    unsigned sum, cnt, mine, sp = 0u;
    for (;;) {
        sum = 0u; cnt = 0u; mine = 0u;
#pragma unroll
        for (unsigned j = 0; j < 16; ++j) { const unsigned c = xb_ld(&bar[XB_XCNT(j)]); sum += c; cnt += (c > 0u) ? 1u : 0u; mine = (j == x) ? c : mine; }
        if (sum == G) break;
        __builtin_amdgcn_s_sleep(1);
        if ((++sp & 255u) == 0u) { if (xb_ld(&bar[XB_TMO])) break; if (sp > XB_SPIN_CAP) { atomicAdd(&bar[XB_TMO], 1u); break; } }
    }
    nloc = mine > 0u ? mine : 1u; nx = cnt > 0u ? cnt : 1u;
}

__device__ __forceinline__ void xcd_barrier(const XcdBarrier& b) {
    asm volatile("s_waitcnt vmcnt(0)" ::: "memory");
    __syncthreads();
    if (b.t0) {
        unsigned* bar = b.bar;
        __builtin_amdgcn_s_waitcnt(0);
        unsigned nloc = b.st[0], nx = b.st[1];
        if (nloc == 0u) { xcd_barrier_complete(bar, b.x, nloc, nx); b.st[0] = nloc; b.st[1] = nx; }
        const unsigned old = xb_add(&bar[XB_XSUB(b.x)], 1u);
        const unsigned gen = old / nloc;
        if (old + 1u == (gen + 1u) * nloc) {
            __builtin_amdgcn_fence(__ATOMIC_RELEASE, "agent");
            asm volatile("s_waitcnt vmcnt(0)" ::: "memory");
            const unsigned og = xb_add(&bar[XB_TOP], 1u);
            const unsigned tg = og / nx;
            if (og + 1u == (tg + 1u) * nx) xb_add(&bar[XB_TOPGEN], 1u);
            else XB_SPIN(xb_ld(&bar[XB_TOPGEN]) == tg, bar);
            __builtin_amdgcn_fence(__ATOMIC_ACQUIRE, "agent");
            xb_add(&bar[XB_XGEN(b.x)], 1u);
            asm volatile("s_waitcnt vmcnt(0)" ::: "memory");
        } else {
            XB_SPIN(xb_ld(&bar[XB_XGEN(b.x)]) == gen, bar);
            __builtin_amdgcn_fence(__ATOMIC_ACQUIRE, "agent");
            asm volatile("s_waitcnt vmcnt(0)" ::: "memory");
        }
    }
    __syncthreads();
}
namespace pg8 {
#define PG8_LAS __attribute__((address_space(3)))
typedef unsigned short bf16_t;
typedef short bf16x8 __attribute__((ext_vector_type(8)));
typedef float f32x4 __attribute__((ext_vector_type(4)));
typedef unsigned u32x4 __attribute__((ext_vector_type(4)));
constexpr int BM = 256, BK = 64, HALF = 128, HTB = HALF * BK * 2  , STAGE_BYTES = 8 * HTB, NXCD = 8, WGM = 8;

__host__ __device__ __forceinline__ int lds_byte(int r, int c) { const int st = (r >> 4) * 2 + (c >> 5), rr = r & 15, cc = c & 31, ob = rr * 64 + cc * 2; return st * 1024 + (ob ^ (((ob >> 9) & 1) << 5)); }
__host__ __device__ __forceinline__ void stage_rc(int b, int& R, int& C) { const int st = b / 1024, sb = b % 1024, swz = sb ^ (((sb >> 9) & 1) << 5); R = (st >> 1) * 16 + swz / 64; C = (st & 1) * 32 + (swz % 64) / 2; }
__host__ __device__ __forceinline__ int perm32(int rho) { const int n = rho >> 4, i = rho & 15; return 8 * (i >> 2) + 4 * n + (i & 3); }

struct Unit { int pm, pn; };
struct Gemm { const bf16_t* A; const bf16_t* Bt; int M, N, K; };

struct StaticOrder {
    int nM, nN, nwg, G, c;
    __host__ __device__ void init(int M, int N, int G_, int c_) { nM = M / BM; nN = N / BM; nwg = nM * nN; G = G_; c = c_; }
    __host__ __device__ bool next(int i, Unit& u) const {
        const long L = (long)i * G + c; if (L >= nwg) return false;
        int wgid = (int)L; { const int q = nwg / NXCD, r = nwg % NXCD, xcd = wgid % NXCD, off = wgid / NXCD; wgid = (xcd < r ? xcd * (q + 1) : r * (q + 1) + (xcd - r) * q) + off; }
        const int nig = WGM * nN, gid = wgid / nig, fm = gid * WGM, gsz = (nM - fm) < WGM ? (nM - fm) : WGM;
        u.pm = fm + ((wgid % nig) % gsz); u.pn = (wgid % nig) / gsz; return true;
    }
    __device__ __forceinline__ void a_ready(const Unit&) const {}
    __device__ __forceinline__ void done(const Unit&) const {}
};
__device__ __forceinline__ unsigned cvt_pk_bf16(float lo, float hi) { unsigned r; asm volatile("v_cvt_pk_bf16_f32 %0, %1, %2" : "=v"(r) : "v"(lo), "v"(hi)); return r; }
template <class Epi, class Sched, bool STAMP = false>
__device__ __forceinline__ void gemm_phase(PG8_LAS unsigned char* lds, const Gemm g, const Sched& S, const Epi& E, unsigned long long* stamps, int wv) {
    const int tid = tid_opaque(wv), wid = __builtin_amdgcn_readfirstlane(tid >> 6), lane = tid & 63, wr = wid >> 2, wc = wid & 3, fr = lane & 15, fq = lane >> 4;
    const int K = g.K, nt = K / BK;
    int ts_lo = 0, ts_hi = 0, nts = 0; const unsigned long long rt_entry = STAMP ? (unsigned long long)wall_clock64() : 0ull;
#define PG8_STAMP() do { if (STAMP && wid == 0 && nts < 64) { const unsigned long long _c = (unsigned long long)clock64(); \
        ts_lo = (lane == nts) ? (int)(unsigned)_c : ts_lo; ts_hi = (lane == nts) ? (int)(unsigned)(_c >> 32) : ts_hi; ++nts; } } while (0)
    PG8_STAMP();
    unsigned voffA[2], voffB[2];
#pragma unroll
    for (int i = 0; i < 2; ++i) { int R, C; stage_rc(tid * 16 + i * 8192, R, C); const int Rb = Epi::PERM ? ((R & ~31) + perm32(R & 31)) : R;
        voffA[i] = (unsigned)(R * K + C) * 2u; voffB[i] = (unsigned)(Rb * K + C) * 2u; }
    const size_t kstep = (size_t)(BK * 2);
    const size_t hstep = (size_t)HALF * K * 2;
    const size_t tstep = 2 * hstep;
    const unsigned ldsw = (unsigned)wid * 1024u;
    const int aoff = lds_byte(wr * 64 + fr, fq * 8), boff = lds_byte(wc * 32 + fr, fq * 8);
#define PG8_SA(b, h) (((b) * 2 + (h)) * HTB)
#define PG8_SB(b, h) ((4 + (b) * 2 + (h)) * HTB)
#define PG8_STAGE(bufoff, gbase, voff) do { _Pragma("unroll") for (int _i = 0; _i < 2; ++_i) \
        __builtin_amdgcn_global_load_lds((const unsigned*)((const char*)(gbase) + (voff)[_i]), (PG8_LAS unsigned*)(lds + (bufoff) + ldsw + _i * 8192), 16, 0, 0); } while (0)
#define PG8_LDA(dst, b, h) do { _Pragma("unroll") for (int m = 0; m < 4; ++m) _Pragma("unroll") for (int k = 0; k < 2; ++k) dst[m][k] = *(const PG8_LAS bf16x8*)(lds + PG8_SA(b, h) + aoff + m * 2048 + k * 1024); } while (0)
#define PG8_LDB(dst, b, h) do { _Pragma("unroll") for (int n = 0; n < 2; ++n) _Pragma("unroll") for (int k = 0; k < 2; ++k) dst[n][k] = *(const PG8_LAS bf16x8*)(lds + PG8_SB(b, h) + boff + n * 2048 + k * 1024); } while (0)
#define PG8_MMA(ai, bj, At, Bt) do { __builtin_amdgcn_s_setprio(1); _Pragma("unroll") for (int m = 0; m < 4; ++m) _Pragma("unroll") for (int n = 0; n < 2; ++n) _Pragma("unroll") for (int k = 0; k < 2; ++k) \
        acc[ai][bj][m][n] = __builtin_amdgcn_mfma_f32_16x16x32_bf16(Bt[n][k], At[m][k], acc[ai][bj][m][n], 0, 0, 0); __builtin_amdgcn_s_setprio(0); } while (0)
#define PG8_WAIT_V(n) asm volatile("s_waitcnt vmcnt(" #n ")" ::: "memory")
#define PG8_WAIT_L(n) asm volatile("s_waitcnt lgkmcnt(" #n ")" ::: "memory")
#define PG8_BAR __builtin_amdgcn_s_barrier()
#define PG8_SCHED __builtin_amdgcn_sched_barrier(0)
    Unit cur, nxt; int ui = 0;
    if (!S.next(0, cur)) return;
    f32x4 acc[2][2][4][2];
#pragma unroll
    for (int a = 0; a < 2; ++a)
#pragma unroll
        for (int b = 0; b < 2; ++b)
#pragma unroll
            for (int m = 0; m < 4; ++m)
#pragma unroll
                for (int n = 0; n < 2; ++n) acc[a][b][m][n] = (f32x4){0.f, 0.f, 0.f, 0.f};
    bf16x8 At[4][2], B0[2][2], B1[2][2];
    const char* cA = (const char*)g.A + (size_t)cur.pm * tstep; const char* cB = (const char*)g.Bt + (size_t)cur.pn * tstep;
    S.a_ready(cur);
    PG8_STAGE(PG8_SB(0, 0), cB, voffB); PG8_STAGE(PG8_SA(0, 0), cA, voffA); PG8_STAGE(PG8_SB(0, 1), cB + hstep, voffB); PG8_STAGE(PG8_SA(0, 1), cA + hstep, voffA);
    if (wr == 1) PG8_BAR;
    PG8_WAIT_V(4); PG8_BAR;
    PG8_STAGE(PG8_SB(1, 0), cB + kstep, voffB); PG8_STAGE(PG8_SA(1, 0), cA + kstep, voffA); PG8_STAGE(PG8_SB(1, 1), cB + hstep + kstep, voffB);
    PG8_WAIT_V(6); PG8_BAR;
    PG8_STAMP();
    for (;;) {
        const bool has_next = S.next(ui + 1, nxt);
        const char* nA = has_next ? (const char*)g.A + (size_t)nxt.pm * tstep : cA; const char* nB = has_next ? (const char*)g.Bt + (size_t)nxt.pn * tstep : cB;
        for (int t = 0; t < nt; t += 2) {
            const bool last = (t == nt - 2);
            const char* a1 = cA + (size_t)(t + 1) * kstep;
            const char* a2 = last ? nA : cA + (size_t)(t + 2) * kstep; const char* b2 = last ? nB : cB + (size_t)(t + 2) * kstep;
            const char* a3 = a2 + kstep; const char* b3 = b2 + kstep;
            if (last && has_next) S.a_ready(nxt);
            PG8_LDB(B0, 0, 0); PG8_SCHED; PG8_LDA(At, 0, 0); PG8_STAGE(PG8_SA(1, 1), a1 + hstep, voffA);
            PG8_WAIT_L(8); PG8_BAR; PG8_WAIT_L(0); PG8_MMA(0, 0, At, B0); PG8_BAR; PG8_SCHED;
            PG8_LDB(B1, 0, 1); PG8_STAGE(PG8_SB(0, 0), b2, voffB);
            PG8_BAR; PG8_WAIT_L(0); PG8_MMA(0, 1, At, B1); PG8_BAR;
            PG8_LDA(At, 0, 1); PG8_STAGE(PG8_SA(0, 0), a2, voffA);
            PG8_BAR; PG8_WAIT_L(0); PG8_MMA(1, 0, At, B0); PG8_BAR; PG8_SCHED;
            PG8_STAGE(PG8_SB(0, 1), b2 + hstep, voffB);
            PG8_WAIT_V(6); PG8_BAR; PG8_MMA(1, 1, At, B1); PG8_BAR;
            PG8_LDB(B0, 1, 0); PG8_SCHED; PG8_LDA(At, 1, 0); PG8_STAGE(PG8_SA(0, 1), a2 + hstep, voffA);
            PG8_WAIT_L(8); PG8_BAR; PG8_WAIT_L(0); PG8_MMA(0, 0, At, B0); PG8_BAR; PG8_SCHED;
            PG8_LDB(B1, 1, 1); PG8_STAGE(PG8_SB(1, 0), b3, voffB);
            PG8_BAR; PG8_WAIT_L(0); PG8_MMA(0, 1, At, B1); PG8_BAR;
            PG8_LDA(At, 1, 1); PG8_STAGE(PG8_SA(1, 0), a3, voffA);
            PG8_BAR; PG8_WAIT_L(0); PG8_MMA(1, 0, At, B0); PG8_BAR; PG8_SCHED;
            PG8_STAGE(PG8_SB(1, 1), b3 + hstep, voffB);
            PG8_WAIT_V(6); PG8_BAR; PG8_MMA(1, 1, At, B1); PG8_BAR;
        }
        PG8_STAMP();
        if constexpr (!Epi::AFTER_DRAIN) { E(acc, cur, wr, wc, fr, fq); S.done(cur); }
        PG8_STAMP();
        if (!has_next) break;
#pragma unroll
        for (int a = 0; a < 2; ++a)
#pragma unroll
            for (int b = 0; b < 2; ++b)
#pragma unroll
                for (int m = 0; m < 4; ++m)
#pragma unroll
                    for (int n = 0; n < 2; ++n) acc[a][b][m][n] = (f32x4){0.f, 0.f, 0.f, 0.f};
        cur = nxt; cA = nA; cB = nB; ++ui;
    }
    PG8_WAIT_V(0);
    if (wr == 0) PG8_BAR;
    PG8_BAR;
    if constexpr (Epi::AFTER_DRAIN) { E.fused(acc, cur, wr, wc, fr, fq, lds, wid, lane); S.done(cur); }
    PG8_STAMP();
    if (STAMP && wid == 0) { stamps[lane] = lane < nts ? (((unsigned long long)(unsigned)ts_hi << 32) | (unsigned)ts_lo) : 0ull;
        if (lane == 62) stamps[62] = rt_entry; if (lane == 63) stamps[63] = (unsigned long long)wall_clock64(); }
#undef PG8_STAMP
#undef PG8_SA
#undef PG8_SB
#undef PG8_STAGE
#undef PG8_LDA
#undef PG8_LDB
#undef PG8_MMA
#undef PG8_WAIT_V
#undef PG8_WAIT_L
#undef PG8_BAR
#undef PG8_SCHED
}
}

constexpr size_t ws_al(size_t x) { return (x + 255) & ~(size_t)255; }
constexpr size_t OFF_BAR = 0;
constexpr size_t OFF_CTR = OFF_BAR + ws_al((size_t)3456 * 4);
constexpr size_t CTR_BYTES = 64 * 256;
constexpr size_t OFF_MOD = OFF_CTR + CTR_BYTES;
constexpr size_t OFF_XB = OFF_MOD + ws_al((size_t)DEPTH * BATCH * MODW * 4);
constexpr size_t OFF_HB = OFF_XB + ws_al((size_t)NTOK * D_MODEL * 4);
constexpr size_t OFF_PB = OFF_HB + ws_al((size_t)NTOK * D_MODEL * 2);
constexpr size_t OFF_CAT = OFF_PB + ws_al((size_t)NTOK * MIX_IN * 2);
constexpr size_t OFF_QB = OFF_CAT + ws_al((size_t)NTOK * D_MODEL * 2);
constexpr size_t OFF_WINT = OFF_QB + ws_al((size_t)NTOK * 2048 * 2);
constexpr size_t OFF_WOUTT = OFF_WINT + ws_al((size_t)DEPTH * MIX_IN * D_MODEL * 2);
constexpr size_t OFF_WQT = OFF_WOUTT + ws_al((size_t)DEPTH * D_MODEL * D_MODEL * 2);
constexpr size_t OFF_KEYSB = OFF_WQT + ws_al((size_t)DEPTH * 2048 * D_MODEL * 2);
constexpr size_t OFF_SGUWB = OFF_KEYSB + ws_al((size_t)DEPTH * 16 * 128 * 128 * 2);
constexpr size_t OFF_UB8 = OFF_SGUWB + ws_al((size_t)DEPTH * 4 * 128 * 128 * 2);
constexpr size_t OFF_VB8 = OFF_UB8 + ws_al((size_t)DEPTH * NEXP * D_MODEL);
constexpr size_t OFF_UINV = OFF_VB8 + ws_al((size_t)DEPTH * NEXP * D_MODEL);
constexpr size_t OFF_VINV = OFF_UINV + ws_al((size_t)DEPTH * NEXP * 4);
constexpr size_t OFF_EIDX = OFF_VINV + ws_al((size_t)DEPTH * NEXP * 4);
constexpr size_t OFF_EGATE = OFF_EIDX + ws_al((size_t)NTOK * 128 * 4);
constexpr size_t OFF_SSQ = OFF_EGATE + ws_al((size_t)NTOK * 128 * 4);
constexpr size_t OFF_BIASQ = OFF_SSQ + ws_al((size_t)NTOK * 16 * 4);
constexpr size_t WS_END = OFF_BIASQ + ws_al((size_t)DEPTH * BATCH * 2048 * 4);

struct Params {
    const float *x_in, *c, *rel_bias, *w_mod, *b_mod, *norm1_g, *norm2_g, *w_in, *w_out, *diff_lambda, *subln_g, *conf_dw, *conf_ln_g, *conf_ln_b, *sconv_w,
        *sgu_ln_g, *sgu_ln_b, *sgu_w, *sgu_b, *peer_wq, *peer_keys, *peer_u, *peer_v, *final_g;
    float* out;
    unsigned char* ws;
    float lam_init[DEPTH];
    __host__ __device__ unsigned* bar() const { return (unsigned*)(ws + OFF_BAR); }
    __host__ __device__ unsigned* ctr(int i) const { return (unsigned*)(ws + OFF_CTR + (size_t)i * 256); }
    __host__ __device__ float* mod() const { return (float*)(ws + OFF_MOD); }
    __host__ __device__ float* xb() const { return (float*)(ws + OFF_XB); }
    __host__ __device__ bf16_t* hb() const { return (bf16_t*)(ws + OFF_HB); }
    __host__ __device__ bf16_t* pb() const { return (bf16_t*)(ws + OFF_PB); }
    __host__ __device__ bf16_t* cat() const { return (bf16_t*)(ws + OFF_CAT); }
    __host__ __device__ bf16_t* qb() const { return (bf16_t*)(ws + OFF_QB); }
    __host__ __device__ bf16_t* WinT() const { return (bf16_t*)(ws + OFF_WINT); }
    __host__ __device__ bf16_t* WoutT() const { return (bf16_t*)(ws + OFF_WOUTT); }
    __host__ __device__ bf16_t* WqT() const { return (bf16_t*)(ws + OFF_WQT); }
    __host__ __device__ bf16_t* keysb() const { return (bf16_t*)(ws + OFF_KEYSB); }
    __host__ __device__ bf16_t* sguwb() const { return (bf16_t*)(ws + OFF_SGUWB); }
    __host__ __device__ unsigned char* ub8() const { return ws + OFF_UB8; }
    __host__ __device__ unsigned char* vb8() const { return ws + OFF_VB8; }
    __host__ __device__ float* uinv() const { return (float*)(ws + OFF_UINV); }
    __host__ __device__ float* vinv() const { return (float*)(ws + OFF_VINV); }
    __host__ __device__ int* eidx() const { return (int*)(ws + OFF_EIDX); }
    __host__ __device__ float* egate() const { return (float*)(ws + OFF_EGATE); }
    __host__ __device__ float* ssq() const { return (float*)(ws + OFF_SSQ); }
    __host__ __device__ float* biasq() const { return (float*)(ws + OFF_BIASQ); }
};

#define LDS_BYTES (160 * 1024)
#define NWAVES 8

__device__ __forceinline__ void transpose_item(const float* __restrict__ W, int K, int N, bf16_t* __restrict__ WT, LAS float* scr, int item, int lane) {
    const int nblk = N / 32, kb = item / nblk, nb = item % nblk, k0 = 64 * kb, n0 = 32 * nb;
#pragma unroll 8
    for (int i = 0; i < 32; ++i) { const int kk = 2 * i + (lane >> 5); scr[kk * 33 + (lane & 31)] = W[(size_t)(k0 + kk) * N + n0 + (lane & 31)]; }
    asm volatile("s_waitcnt lgkmcnt(0)" ::: "memory");
    const int c = lane & 7;
#pragma unroll
    for (int j = 0; j < 4; ++j) {
        const int n = (lane >> 3) + 8 * j; const LAS float* s = scr + (8 * c) * 33 + n;
        u32x4 o; o.x = pk2(s[0 * 33], s[1 * 33]); o.y = pk2(s[2 * 33], s[3 * 33]); o.z = pk2(s[4 * 33], s[5 * 33]); o.w = pk2(s[6 * 33], s[7 * 33]);
        *(u32x4*)(WT + (size_t)(n0 + n) * K + k0 + 8 * c) = o;
    }
    asm volatile("s_waitcnt lgkmcnt(0)" ::: "memory");
}
__device__ __forceinline__ void cvt8(const float* __restrict__ s, bf16_t* __restrict__ d) {
    const f32x4 a = *(const f32x4*)s, b = *(const f32x4*)(s + 4);
    u32x4 o; o.x = pk2(a[0], a[1]); o.y = pk2(a[2], a[3]); o.z = pk2(b[0], b[1]); o.w = pk2(b[2], b[3]);
    *(u32x4*)d = o;
}
#define CV_NR 4
__device__ __forceinline__ void convert_table_row(const Params& p, int tr0, int lane) {
    f32x4 a[CV_NR][4];
#pragma unroll
    for (int h2 = 0; h2 < CV_NR; ++h2) {
        const int tr = tr0 + h2, l = tr / (2 * NEXP), w2 = tr % (2 * NEXP); const bool isv = w2 >= NEXP; const size_t r = (size_t)l * NEXP + (isv ? w2 - NEXP : w2);
        const float* src = (isv ? p.peer_v : p.peer_u) + r * D_MODEL + lane * 16;
#pragma unroll
        for (int q = 0; q < 4; ++q) a[h2][q] = *(const f32x4*)(src + 4 * q);
    }
#pragma unroll
    for (int h2 = 0; h2 < CV_NR; ++h2) {
        const int tr = tr0 + h2, l = tr / (2 * NEXP), w2 = tr % (2 * NEXP); const bool isv = w2 >= NEXP; const size_t r = (size_t)l * NEXP + (isv ? w2 - NEXP : w2);
        float ss = 0.f;
#pragma unroll
        for (int q = 0; q < 4; ++q) ss += a[h2][q][0] * a[h2][q][0] + a[h2][q][1] * a[h2][q][1] + a[h2][q][2] * a[h2][q][2] + a[h2][q][3] * a[h2][q][3];
        ss = wave_sum(ss);
        const float step = fmaxf(0.335f * sqrtf(ss * (1.0f / D_MODEL)), 1e-30f), sc = 1.0f / step;
        unsigned o[2];
#pragma unroll
        for (int d = 0; d < 2; ++d) {
            unsigned w = 0;
#pragma unroll
            for (int e = 0; e < 8; ++e) {
                const float v = a[h2][2 * d + (e >> 2)][e & 3];
                const int qv = (int)fminf(fmaxf(rintf(v * sc), -8.f), 7.f) + 8;
                w |= (unsigned)qv << (8 * (e >> 1) + 4 * (e & 1));
            }
            o[d] = w;
        }
        *(u32x2*)((isv ? p.vb8() : p.ub8()) + r * (D_MODEL / 2) + lane * 8) = (u32x2){o[0], o[1]};
        if (lane == 0) (isv ? p.vinv() : p.uinv())[r] = step;
    }
}
constexpr int CV_I_IN = (D_MODEL / 64) * (MIX_IN / 32), CV_I_OUT = (D_MODEL / 64) * (D_MODEL / 32), CV_I_Q = (D_MODEL / 64) * (2048 / 32), CV_I_L = CV_I_IN + CV_I_OUT + CV_I_Q;
__device__ __forceinline__ void convert_weight_item(const Params& p, int l, int r, LAS float* scr, int lane) {
    if (r < CV_I_IN) { transpose_item(p.w_in + (size_t)l * D_MODEL * MIX_IN, D_MODEL, MIX_IN, p.WinT() + (size_t)l * MIX_IN * D_MODEL, scr, r, lane); return; } r -= CV_I_IN;
    if (r < CV_I_OUT) { transpose_item(p.w_out + (size_t)l * D_MODEL * D_MODEL, D_MODEL, D_MODEL, p.WoutT() + (size_t)l * D_MODEL * D_MODEL, scr, r, lane); return; } r -= CV_I_OUT;
    transpose_item(p.peer_wq + (size_t)l * D_MODEL * 2048, D_MODEL, 2048, p.WqT() + (size_t)l * 2048 * D_MODEL, scr, r, lane);
}
__device__ __forceinline__ void phase_convert(const Params& p, LAS unsigned char* lds, int wv) {
    const int tid = tid_opaque(wv), wave = tid >> 6, lane = tid & 63;
    LAS float* scr = (LAS float*)(lds + wave * 16384);
    const int gw = blockIdx.x * NWAVES + wave, NGW = gridDim.x * NWAVES;
    for (int it = gw; it < CV_I_L; it += NGW) convert_weight_item(p, 0, it, scr, lane);
    const size_t gt = (size_t)blockIdx.x * 512 + tid, NGT = (size_t)gridDim.x * 512;
    constexpr size_t N_KEYS8 = (size_t)DEPTH * 16 * 128 * 128 / 8, N_SGU8 = (size_t)DEPTH * 4 * 128 * 128 / 8;
    for (size_t i = gt; i < N_KEYS8; i += NGT) cvt8(p.peer_keys + i * 8, p.keysb() + i * 8);
    for (int tr = CV_NR * gw; tr < 2 * NEXP; tr += CV_NR * NGW) convert_table_row(p, tr, lane);
    for (size_t i = gt; i < N_SGU8; i += NGT) {
        const size_t e = i * 8; const int s0 = (int)(e & 127), t = (int)((e >> 7) & 127);
        const f32x4 a = *(const f32x4*)(p.sgu_w + e), b = *(const f32x4*)(p.sgu_w + e + 4);
        float v[8] = {a[0], a[1], a[2], a[3], b[0], b[1], b[2], b[3]};
#pragma unroll
        for (int j = 0; j < 8; ++j) v[j] = (s0 + j <= t) ? v[j] : 0.f;
        u32x4 o; o.x = pk2(v[0], v[1]); o.y = pk2(v[2], v[3]); o.z = pk2(v[4], v[5]); o.w = pk2(v[6], v[7]);
        *(u32x4*)(p.sguwb() + e) = o;
    }
}
__device__ __forceinline__ void convert_in_gemm1_slack(const Params& p, int l, LAS unsigned char* lds, int wv) {
    const int G = (int)gridDim.x;
    int rem = 640 - 2 * G;
    if (rem <= 0 || rem >= G) rem = 0;
    if ((int)blockIdx.x < rem) return;
    const int tid = tid_opaque(wv), wave = tid >> 6, lane = tid & 63;
    LAS float* scr = (LAS float*)(lds + wave * 16384);
    const int cw = ((int)blockIdx.x - rem) * NWAVES + wave, NCW = (G - rem) * NWAVES;
    if (l + 1 < DEPTH) for (int it = cw; it < CV_I_L; it += NCW) convert_weight_item(p, l + 1, it, scr, lane);
    constexpr int S_ROWS = (DEPTH - 1) * 2 * NEXP, W_ROWS = S_ROWS / DEPTH;
    for (int sr = l * W_ROWS + CV_NR * cw; sr < (l + 1) * W_ROWS; sr += CV_NR * NCW) convert_table_row(p, 2 * NEXP + sr, lane);
}

__device__ __forceinline__ void norm_row(const float* __restrict__ xr, const float* __restrict__ g, const float* __restrict__ sh, const float* __restrict__ sc, bf16_t* __restrict__ hr, int lane) {
    f32x4 v[4]; float ss = 0.f;
#pragma unroll
    for (int j = 0; j < 4; ++j) { v[j] = *(const f32x4*)(xr + j * 256 + lane * 4); ss += v[j][0] * v[j][0] + v[j][1] * v[j][1] + v[j][2] * v[j][2] + v[j][3] * v[j][3]; }
    const float rs = rsqrtf(wave_sum(ss) * (1.0f / D_MODEL) + 1e-6f);
#pragma unroll
    for (int j = 0; j < 4; ++j) {
        const int col = j * 256 + lane * 4;
        const f32x4 gv = *(const f32x4*)(g + col), scv = *(const f32x4*)(sc + col), shv = *(const f32x4*)(sh + col);
        f32x4 y;
#pragma unroll
        for (int e = 0; e < 4; ++e) y[e] = v[j][e] * rs * gv[e] * (1.0f + scv[e]) + shv[e];
        u32x2 o; o.x = pk2(y[0], y[1]); o.y = pk2(y[2], y[3]);
        *(u32x2*)(hr + col) = o;
    }
}
__device__ __forceinline__ void phase_norm(const Params& p, const float* __restrict__ x, const float* __restrict__ g, const float* __restrict__ modl, int sh_idx, int sc_idx, int wv) {
    const int tid = tid_opaque(wv), wave = tid >> 6, lane = tid & 63;
    for (int t = blockIdx.x * NWAVES + wave; t < NTOK; t += gridDim.x * NWAVES) {
        const float* mb = modl + (size_t)(t / SEQ) * MODW;
        norm_row(x + (size_t)t * D_MODEL, g, mb + sh_idx * D_MODEL, mb + sc_idx * D_MODEL, p.hb() + (size_t)t * D_MODEL, lane);
    }
}

struct EpiStoreBf16 {
    static constexpr bool PERM = true, AFTER_DRAIN = false;
    bf16_t* O; int ldc;
    __device__ __forceinline__ void operator()(const pg8::f32x4 (&acc)[2][2][4][2], const pg8::Unit& u, int wr, int wc, int fr, int fq) const {
        const int row0 = u.pm * 256 + wr * 64 + fr, col0 = u.pn * 256 + wc * 32 + 8 * fq;
#pragma unroll
        for (int ai = 0; ai < 2; ++ai)
#pragma unroll
            for (int m = 0; m < 4; ++m) {
                bf16_t* rowp = O + (size_t)(row0 + ai * 128 + m * 16) * ldc + col0;
#pragma unroll
                for (int bj = 0; bj < 2; ++bj) {
                    const pg8::f32x4 v0 = acc[ai][bj][m][0], v1 = acc[ai][bj][m][1];
                    u32x4 w; w.x = pk2(v0[0], v0[1]); w.y = pk2(v0[2], v0[3]); w.z = pk2(v1[0], v1[1]); w.w = pk2(v1[2], v1[3]);
                    *(u32x4*)(rowp + bj * 128) = w;
                }
            }
    }
};
struct EpiResid {
    static constexpr bool PERM = false, AFTER_DRAIN = false;
    const float* xin; float* xout; const float* gate;
    __device__ __forceinline__ void operator()(const pg8::f32x4 (&acc)[2][2][4][2], const pg8::Unit& u, int wr, int wc, int fr, int fq) const {
        const int row0 = u.pm * 256 + wr * 64 + fr, col0 = u.pn * 256 + wc * 32 + 4 * fq;
        const float* gb = gate + (size_t)((u.pm * 256) / SEQ) * MODW + col0;
        pg8::f32x4 gv[2][2];
#pragma unroll
        for (int bj = 0; bj < 2; ++bj)
#pragma unroll
            for (int n = 0; n < 2; ++n) gv[bj][n] = *(const pg8::f32x4*)(gb + bj * 128 + n * 16);
#pragma unroll
        for (int ai = 0; ai < 2; ++ai)
#pragma unroll
            for (int m = 0; m < 4; ++m) {
                const size_t off = (size_t)(row0 + ai * 128 + m * 16) * D_MODEL + col0;
#pragma unroll
                for (int bj = 0; bj < 2; ++bj)
#pragma unroll
                    for (int n = 0; n < 2; ++n) {
                        const pg8::f32x4 xv = *(const pg8::f32x4*)(xin + off + bj * 128 + n * 16);
                        *(pg8::f32x4*)(xout + off + bj * 128 + n * 16) = xv + gv[bj][n] * acc[ai][bj][m][n];
                    }
            }
    }
};

struct EpiResidNorm {
    static constexpr bool PERM = false, AFTER_DRAIN = false;
    const float* xin; float* xout; const float* modl; const float* n2g; bf16_t* hb; float* ssq;
    __device__ __forceinline__ void operator()(const pg8::f32x4 (&acc)[2][2][4][2], const pg8::Unit& u, int wr, int wc, int fr, int fq) const {
        const int row0 = u.pm * 256 + wr * 64 + fr, col0 = u.pn * 256 + wc * 32 + 4 * fq;
        const float* mb = modl + (size_t)((u.pm * 256) / SEQ) * MODW;
        pg8::f32x4 gv[2][2], gm[2][2];
#pragma unroll
        for (int bj = 0; bj < 2; ++bj)
#pragma unroll
            for (int n = 0; n < 2; ++n) {
                const int c = col0 + bj * 128 + n * 16;
                gv[bj][n] = *(const pg8::f32x4*)(mb + 2 * D_MODEL + c);
                gm[bj][n] = *(const pg8::f32x4*)(n2g + c) * (*(const pg8::f32x4*)(mb + 4 * D_MODEL + c) + 1.0f);
            }
#pragma unroll
        for (int ai = 0; ai < 2; ++ai)
#pragma unroll
            for (int m = 0; m < 4; ++m) {
                const int row = row0 + ai * 128 + m * 16;
                const size_t off = (size_t)row * D_MODEL + col0;
                float sq = 0.f;
#pragma unroll
                for (int bj = 0; bj < 2; ++bj)
#pragma unroll
                    for (int n = 0; n < 2; ++n) {
                        const pg8::f32x4 xv = *(const pg8::f32x4*)(xin + off + bj * 128 + n * 16) + gv[bj][n] * acc[ai][bj][m][n];
                        *(pg8::f32x4*)(xout + off + bj * 128 + n * 16) = xv;
                        sq += xv[0] * xv[0] + xv[1] * xv[1] + xv[2] * xv[2] + xv[3] * xv[3];
                        const pg8::f32x4 hv = xv * gm[bj][n];
                        u32x2 o; o.x = pk2(hv[0], hv[1]); o.y = pk2(hv[2], hv[3]);
                        *(u32x2*)(hb + off + bj * 128 + n * 16) = o;
                    }
                sq += __shfl_xor(sq, 16, 64); sq += __shfl_xor(sq, 32, 64);
                if (fq == 0) ssq[(size_t)row * 16 + u.pn * 4 + wc] = sq;
            }
    }
};
struct EpiQ {
    static constexpr bool PERM = true, AFTER_DRAIN = false;
    bf16_t* O; const float* ssq; const float* biasq;
    __device__ __forceinline__ void operator()(const pg8::f32x4 (&acc)[2][2][4][2], const pg8::Unit& u, int wr, int wc, int fr, int fq) const {
        const int row0 = u.pm * 256 + wr * 64 + fr, col0 = u.pn * 256 + wc * 32 + 8 * fq;
        const float* bb = biasq + (size_t)((u.pm * 256) / SEQ) * 2048 + col0;
        pg8::f32x4 bv[2][2];
#pragma unroll
        for (int bj = 0; bj < 2; ++bj)
#pragma unroll
            for (int n = 0; n < 2; ++n) bv[bj][n] = *(const pg8::f32x4*)(bb + bj * 128 + 4 * n);
#pragma unroll
        for (int ai = 0; ai < 2; ++ai)
#pragma unroll
            for (int m = 0; m < 4; ++m) {
                const int row = row0 + ai * 128 + m * 16;
                const pg8::f32x4 s0 = *(const pg8::f32x4*)(ssq + (size_t)row * 16), s1 = *(const pg8::f32x4*)(ssq + (size_t)row * 16 + 4), s2 = *(const pg8::f32x4*)(ssq + (size_t)row * 16 + 8), s3 = *(const pg8::f32x4*)(ssq + (size_t)row * 16 + 12);
                const float tot = (((s0[0] + s0[1]) + (s0[2] + s0[3])) + ((s1[0] + s1[1]) + (s1[2] + s1[3]))) + (((s2[0] + s2[1]) + (s2[2] + s2[3])) + ((s3[0] + s3[1]) + (s3[2] + s3[3])));
                const float rs = rsqrtf(tot * (1.0f / D_MODEL) + 1e-6f);
                bf16_t* rowp = O + (size_t)row * 2048 + col0;
#pragma unroll
                for (int bj = 0; bj < 2; ++bj) {
                    const pg8::f32x4 v0 = acc[ai][bj][m][0] * rs + bv[bj][0], v1 = acc[ai][bj][m][1] * rs + bv[bj][1];
                    u32x4 w; w.x = pk2(v0[0], v0[1]); w.y = pk2(v0[2], v0[3]); w.z = pk2(v1[0], v1[1]); w.w = pk2(v1[2], v1[3]);
                    *(u32x4*)(rowp + bj * 128) = w;
                }
            }
    }
};

template <class Epi>
__device__ __forceinline__ void run_gemm(LAS unsigned char* lds, const bf16_t* A, const bf16_t* Bt, int M, int N, int K, const Epi& E, int wv) {
    pg8::StaticOrder S; S.init(M, N, (int)gridDim.x, (int)blockIdx.x);
    pg8::Gemm g; g.A = A; g.Bt = Bt; g.M = M; g.N = N; g.K = K;
    pg8::gemm_phase<Epi, pg8::StaticOrder, false>(lds, g, S, E, nullptr, wv);
}

typedef __amdgpu_buffer_rsrc_t rsrc_t;
struct G4 { u32x2 r[4]; };
__device__ __forceinline__ u32x2 bload8(rsrc_t r, int voff, int soff) { return __builtin_bit_cast(u32x2, __builtin_amdgcn_raw_buffer_load_b64(r, voff, soff, 0)); }
#define ROWB (D_MODEL / 2)
template <int G>
__device__ __forceinline__ void ex_issue(G4& R, rsrc_t rs, int e0, int e1, int voff, int emask = 0x3FFF) {
#pragma unroll
    for (int i = 0; i < 4; ++i) {
        const int e = __builtin_amdgcn_readlane(G < 16 ? e0 : e1, (4 * G + i) & 63) & emask;
        R.r[i] = bload8(rs, voff, e * ROWB);
    }
}
template <int CTRL, int ROWMASK = 0xF>
__device__ __forceinline__ int dpp_iadd(int x) { return x + __builtin_amdgcn_update_dpp(0, x, CTRL, ROWMASK, 0xF, false); }
__device__ __forceinline__ int wave_isum_l63(int v) {
    v = dpp_iadd<0xB1>(v); v = dpp_iadd<0x4E>(v); v = dpp_iadd<0x141>(v); v = dpp_iadd<0x140>(v); v = dpp_iadd<0x142, 0xA>(v); v = dpp_iadd<0x143, 0xC>(v);
    return v;
}
template <int G>
__device__ __forceinline__ void ex_passA(const G4& R, const int (&hq)[4], int hinit, int& KK0, int& KK1, int lane) {
    int a[4];
#pragma unroll
    for (int i = 0; i < 4; ++i) a[i] = hinit;
#pragma unroll
    for (int i = 0; i < 4; ++i) a[i] = __builtin_amdgcn_sdot4((int)(R.r[i][0] & 0x0F0F0F0Fu), hq[0], a[i], false);
#pragma unroll
    for (int i = 0; i < 4; ++i) a[i] = __builtin_amdgcn_sdot4((int)((R.r[i][0] >> 4) & 0x0F0F0F0Fu), hq[1], a[i], false);
#pragma unroll
    for (int i = 0; i < 4; ++i) a[i] = __builtin_amdgcn_sdot4((int)(R.r[i][1] & 0x0F0F0F0Fu), hq[2], a[i], false);
#pragma unroll
    for (int i = 0; i < 4; ++i) a[i] = __builtin_amdgcn_sdot4((int)((R.r[i][1] >> 4) & 0x0F0F0F0Fu), hq[3], a[i], false);
#pragma unroll
    for (int i = 0; i < 4; ++i) a[i] = dpp_iadd<0xB1>(a[i]);
#pragma unroll
    for (int i = 0; i < 4; ++i) a[i] = dpp_iadd<0x4E>(a[i]);
#pragma unroll
    for (int i = 0; i < 4; ++i) a[i] = dpp_iadd<0x141>(a[i]);
#pragma unroll
    for (int i = 0; i < 4; ++i) a[i] = dpp_iadd<0x140>(a[i]);
#pragma unroll
    for (int i = 0; i < 4; ++i) a[i] = dpp_iadd<0x142, 0xA>(a[i]);
#pragma unroll
    for (int i = 0; i < 4; ++i) a[i] = dpp_iadd<0x143, 0xC>(a[i]);
#pragma unroll
    for (int i = 0; i < 4; ++i) {
        const int tot = __builtin_amdgcn_readlane(a[i], 63);
        if (G < 16) KK0 = (lane == ((4 * G + i) & 63)) ? tot : KK0; else KK1 = (lane == ((4 * G + i) & 63)) ? tot : KK1;
    }
}
__device__ __forceinline__ void ex_passB(const G4& R, int cp, int (&yi)[16]) {
#pragma unroll
    for (int j = 0; j < 4; ++j) {
        const int sh4 = (j & 1) * 4;
        const unsigned A = (R.r[0][j >> 1] >> sh4) & 0x0F0F0F0Fu, B = (R.r[1][j >> 1] >> sh4) & 0x0F0F0F0Fu, C = (R.r[2][j >> 1] >> sh4) & 0x0F0F0F0Fu, D = (R.r[3][j >> 1] >> sh4) & 0x0F0F0F0Fu;
        const unsigned ablo = __builtin_amdgcn_perm(B, A, 0x05010400u), abhi = __builtin_amdgcn_perm(B, A, 0x07030602u);
        const unsigned cdlo = __builtin_amdgcn_perm(D, C, 0x05010400u), cdhi = __builtin_amdgcn_perm(D, C, 0x07030602u);
        const unsigned t0 = __builtin_amdgcn_perm(cdlo, ablo, 0x05040100u), t1 = __builtin_amdgcn_perm(cdlo, ablo, 0x07060302u);
        const unsigned t2 = __builtin_amdgcn_perm(cdhi, abhi, 0x05040100u), t3 = __builtin_amdgcn_perm(cdhi, abhi, 0x07060302u);
        yi[4 * j + 0] = __builtin_amdgcn_sdot4((int)t0, cp, yi[4 * j + 0], false);
        yi[4 * j + 1] = __builtin_amdgcn_sdot4((int)t1, cp, yi[4 * j + 1], false);
        yi[4 * j + 2] = __builtin_amdgcn_sdot4((int)t2, cp, yi[4 * j + 2], false);
        yi[4 * j + 3] = __builtin_amdgcn_sdot4((int)t3, cp, yi[4 * j + 3], false);
    }
}
__device__ __forceinline__ float wave_max(float v) {
#pragma unroll
    for (int o = 32; o > 0; o >>= 1) v = fmaxf(v, __shfl_xor(v, o, 64));
    return v;
}
__device__ __forceinline__ int quad_pack(int ci) {
    const int b = ci & 0xFF;
    const int d0 = __builtin_amdgcn_update_dpp(0, b, 0x00, 0xF, 0xF, false), d1 = __builtin_amdgcn_update_dpp(0, b, 0x55, 0xF, 0xF, false);
    const int d2 = __builtin_amdgcn_update_dpp(0, b, 0xAA, 0xF, 0xF, false), d3 = __builtin_amdgcn_update_dpp(0, b, 0xFF, 0xF, 0xF, false);
    return d0 | (d1 << 8) | (d2 << 16) | (d3 << 24);
}

__device__ __forceinline__ void ex_finish(const Params& p, int l, const bool LAST, int t, const float (&y)[16], int lane_) {
    const int lane = launder(lane_);
    const int c0 = lane * 16;
    const float* mb = p.mod() + ((size_t)l * BATCH + t / SEQ) * MODW;
    float xv[16];
#pragma unroll
    for (int q = 0; q < 4; ++q) {
        const f32x4 a = *(const f32x4*)(p.xb() + (size_t)t * D_MODEL + c0 + 4 * q), g2 = *(const f32x4*)(mb + 5 * D_MODEL + c0 + 4 * q);
#pragma unroll
        for (int e = 0; e < 4; ++e) xv[4 * q + e] = a[e] + g2[e] * y[4 * q + e];
    }
    float ss2 = 0.f;
#pragma unroll
    for (int e = 0; e < 16; ++e) ss2 += xv[e] * xv[e];
    const float rs2 = rsqrtf(wave_sum(ss2) * (1.0f / D_MODEL) + 1e-6f);
    if (LAST) {
#pragma unroll
        for (int q = 0; q < 4; ++q) {
            const int col = c0 + 4 * q;
            const f32x4 gv = *(const f32x4*)(p.final_g + col);
            f32x4 o;
#pragma unroll
            for (int e = 0; e < 4; ++e) o[e] = xv[4 * q + e] * rs2 * gv[e];
            *(f32x4*)(p.out + (size_t)t * D_MODEL + col) = o;
        }
    } else {
        const float* mn = p.mod() + ((size_t)(l + 1) * BATCH + t / SEQ) * MODW;
        const float* n1g = p.norm1_g + (l + 1) * D_MODEL;
        unsigned hw[8];
#pragma unroll
        for (int q = 0; q < 4; ++q) {
            const int col = c0 + 4 * q;
            f32x4 xo;
#pragma unroll
            for (int e = 0; e < 4; ++e) xo[e] = xv[4 * q + e];
            *(f32x4*)(p.xb() + (size_t)t * D_MODEL + col) = xo;
            const f32x4 gv = *(const f32x4*)(n1g + col), scv = *(const f32x4*)(mn + 1 * D_MODEL + col), shv = *(const f32x4*)(mn + 0 * D_MODEL + col);
            float h[4];
#pragma unroll
            for (int e = 0; e < 4; ++e) h[e] = xo[e] * rs2 * gv[e] * (1.0f + scv[e]) + shv[e];
            hw[2 * q] = pk2(h[0], h[1]); hw[2 * q + 1] = pk2(h[2], h[3]);
        }
        *(u32x4*)(p.hb() + (size_t)t * D_MODEL + c0) = (u32x4){hw[0], hw[1], hw[2], hw[3]};
        *(u32x4*)(p.hb() + (size_t)t * D_MODEL + c0 + 8) = (u32x4){hw[4], hw[5], hw[6], hw[7]};
    }
}


#define EXR 8
#define EXT (32 / EXR)
template <int S>
__device__ __forceinline__ void ex_turnA(G4 (&R)[EXR], const int (&hq)[4], int hinit, int& KK0, int& KK1, rsrc_t ru, rsrc_t rv, int e0, int e1, int voff, int lane, int emask) {
#define EX_A(s) ex_passA<EXR * S + s>(R[s], hq, hinit, KK0, KK1, lane); asm volatile("" ::: "memory"); if (S < EXT - 1) ex_issue<(EXR * S + s + EXR) & 31>(R[s], ru, e0, e1, voff, emask); else ex_issue<s>(R[s], rv, e0, e1, voff, emask); asm volatile("" ::: "memory");
    EX_A(0) EX_A(1) EX_A(2) EX_A(3)
#if EXR == 8
    EX_A(4) EX_A(5) EX_A(6) EX_A(7)
#endif
#undef EX_A
}
template <int S>
__device__ __forceinline__ void ex_turnB(G4 (&R)[EXR], int cpk0, int cpk1, int (&yi)[16], rsrc_t ru, rsrc_t rv, int e0, int e1, int e0n, int e1n, bool has_next, int voff, int emask) {
#define EX_B(s) ex_passB(R[s], __builtin_amdgcn_readlane((EXR * S + s) < 16 ? cpk0 : cpk1, (4 * (EXR * S + s)) & 63), yi); \
    asm volatile("" ::: "memory"); if (S < EXT - 1) ex_issue<(EXR * S + s + EXR) & 31>(R[s], rv, e0, e1, voff, emask); asm volatile("" ::: "memory");
    EX_B(0) EX_B(1) EX_B(2) EX_B(3)
#if EXR == 8
    EX_B(4) EX_B(5) EX_B(6) EX_B(7)
#endif
#undef EX_B
}

__device__ __forceinline__ void phase_expert(const Params& p, int l, const bool LAST, LAS unsigned char* lds, int wv, const int emask = 0x3FFF, const bool synth = false) {
    const int tid = tid_opaque(wv), wave = tid >> 6, lane = tid & 63;
    const rsrc_t ru = __builtin_amdgcn_make_buffer_rsrc((void*)(p.ub8() + (size_t)l * NEXP * ROWB), 0, NEXP * ROWB, 0x00020000);
    const rsrc_t rv = __builtin_amdgcn_make_buffer_rsrc((void*)(p.vb8() + (size_t)l * NEXP * ROWB), 0, NEXP * ROWB, 0x00020000);
    const float* uinv = p.uinv() + (size_t)l * NEXP;
    const float* vinv = p.vinv() + (size_t)l * NEXP;
    const int voff = lane * 8, c0 = lane * 16;
    const float* n2g = p.norm2_g + l * D_MODEL;
    const int tstep = gridDim.x * NWAVES;
    int t = blockIdx.x * NWAVES + wave;
    if (t >= NTOK) return;
    int e0 = p.eidx()[(size_t)t * 128 + lane], e1 = p.eidx()[(size_t)t * 128 + 64 + lane];
    for (; t < NTOK; t += tstep) {
        G4 R[EXR];
        ex_issue<0>(R[0], ru, e0, e1, voff, emask); ex_issue<1>(R[1], ru, e0, e1, voff, emask); ex_issue<2>(R[2], ru, e0, e1, voff, emask); ex_issue<3>(R[3], ru, e0, e1, voff, emask);
#if EXR == 8
        ex_issue<4>(R[4], ru, e0, e1, voff); ex_issue<5>(R[5], ru, e0, e1, voff); ex_issue<6>(R[6], ru, e0, e1, voff); ex_issue<7>(R[7], ru, e0, e1, voff);
#endif
        asm volatile("" ::: "memory");
        const bool has_next = (t + tstep) < NTOK;
        const int tn = has_next ? t + tstep : t;
        const int e0n = p.eidx()[(size_t)tn * 128 + lane], e1n = p.eidx()[(size_t)tn * 128 + 64 + lane];
        const float us0 = uinv[e0], us1 = uinv[e1];
        const float gv0 = p.egate()[(size_t)t * 128 + lane] * vinv[e0], gv1 = p.egate()[(size_t)t * 128 + 64 + lane] * vinv[e1];
        int hq[4]; float sh;
        {
            const float* mb = p.mod() + ((size_t)l * BATCH + t / SEQ) * MODW;
            f32x4 xq[4]; float ss = 0.f;
#pragma unroll
            for (int q = 0; q < 4; ++q) { xq[q] = *(const f32x4*)(p.xb() + (size_t)t * D_MODEL + c0 + 4 * q); ss += xq[q][0] * xq[q][0] + xq[q][1] * xq[q][1] + xq[q][2] * xq[q][2] + xq[q][3] * xq[q][3]; }
            const float rs = rsqrtf(wave_sum(ss) * (1.0f / D_MODEL) + 1e-6f);
            float hm = 0.f;
#pragma unroll
            for (int q = 0; q < 4; ++q) {
                const int col = c0 + 4 * q;
                const f32x4 gv = *(const f32x4*)(n2g + col), scv = *(const f32x4*)(mb + 4 * D_MODEL + col), shv = *(const f32x4*)(mb + 3 * D_MODEL + col);
#pragma unroll
                for (int e = 0; e < 4; ++e) { xq[q][e] = xq[q][e] * rs * gv[e] * (1.0f + scv[e]) + shv[e]; hm = fmaxf(hm, fabsf(xq[q][e])); }
            }
            hm = fmaxf(wave_max(hm), 1e-30f);
            const float qs = 127.0f / hm; sh = hm * (1.0f / 127.0f);
            int hb[16];
#pragma unroll
            for (int q = 0; q < 4; ++q)
#pragma unroll
                for (int e = 0; e < 4; ++e) hb[4 * q + e] = (int)rintf(xq[q][e] * qs);
#pragma unroll
            for (int j = 0; j < 4; ++j) {
                const int b0 = (j & 1) + 8 * (j >> 1);
                hq[j] = (hb[b0] & 0xFF) | ((hb[b0 + 2] & 0xFF) << 8) | ((hb[b0 + 4] & 0xFF) << 16) | (hb[b0 + 6] << 24);
            }
        }
        int hinit = 0;
#pragma unroll
        for (int j = 0; j < 4; ++j) hinit = __builtin_amdgcn_sdot4(hq[j], 0x01010101, hinit, false);
        hinit *= -8;
        int KK0 = 0, KK1 = 0;
        ex_turnA<0>(R, hq, hinit, KK0, KK1, ru, rv, e0, e1, voff, lane, emask); ex_turnA<1>(R, hq, hinit, KK0, KK1, ru, rv, e0, e1, voff, lane, emask);
        ex_turnA<2>(R, hq, hinit, KK0, KK1, ru, rv, e0, e1, voff, lane, emask); ex_turnA<3>(R, hq, hinit, KK0, KK1, ru, rv, e0, e1, voff, lane, emask);
#if EXR == 4
        ex_turnA<4>(R, hq, hinit, KK0, KK1, ru, rv, e0, e1, voff, lane, emask); ex_turnA<5>(R, hq, hinit, KK0, KK1, ru, rv, e0, e1, voff, lane, emask);
        ex_turnA<6>(R, hq, hinit, KK0, KK1, ru, rv, e0, e1, voff, lane, emask); ex_turnA<7>(R, hq, hinit, KK0, KK1, ru, rv, e0, e1, voff, lane, emask);
#endif
        const float cf0 = gelu_as((float)KK0 * (us0 * sh)) * gv0, cf1 = gelu_as((float)KK1 * (us1 * sh)) * gv1;
        const float cm = fmaxf(wave_max(fmaxf(fabsf(cf0), fabsf(cf1))), 1e-30f);
        const float cq = 127.0f / cm;
        const int cpk0 = quad_pack((int)rintf(cf0 * cq)), cpk1 = quad_pack((int)rintf(cf1 * cq));
        int yi[16];
#pragma unroll
        for (int e = 0; e < 16; ++e) yi[e] = 0;
        ex_turnB<0>(R, cpk0, cpk1, yi, ru, rv, e0, e1, e0n, e1n, has_next, voff, emask); ex_turnB<1>(R, cpk0, cpk1, yi, ru, rv, e0, e1, e0n, e1n, has_next, voff, emask);
        ex_turnB<2>(R, cpk0, cpk1, yi, ru, rv, e0, e1, e0n, e1n, has_next, voff, emask); ex_turnB<3>(R, cpk0, cpk1, yi, ru, rv, e0, e1, e0n, e1n, has_next, voff, emask);
#if EXR == 4
        ex_turnB<4>(R, cpk0, cpk1, yi, ru, rv, e0, e1, e0n, e1n, has_next, voff, emask); ex_turnB<5>(R, cpk0, cpk1, yi, ru, rv, e0, e1, e0n, e1n, has_next, voff, emask);
        ex_turnB<6>(R, cpk0, cpk1, yi, ru, rv, e0, e1, e0n, e1n, has_next, voff, emask); ex_turnB<7>(R, cpk0, cpk1, yi, ru, rv, e0, e1, e0n, e1n, has_next, voff, emask);
#endif
        const int ci0s = (int)rintf(cf0 * cq) + (int)rintf(cf1 * cq);
        const int csum8 = 8 * __builtin_amdgcn_readlane(wave_isum_l63(ci0s), 63);
        float y[16];
        const float ys = cm * (1.0f / 127.0f);
#pragma unroll
        for (int j = 0; j < 4; ++j)
#pragma unroll
            for (int e = 0; e < 4; ++e) y[(j & 1) + 2 * e + 8 * (j >> 1)] = (float)(yi[4 * j + e] - csum8) * ys;
        if (synth) {
#pragma unroll
            for (int q = 0; q < 4; ++q) *(f32x4*)((float*)p.qb() + (size_t)t * D_MODEL + c0 + 4 * q) = (f32x4){y[4 * q], y[4 * q + 1], y[4 * q + 2], y[4 * q + 3]};
        } else ex_finish(p, l, LAST, t, y, lane);
        e0 = e0n; e1 = e1n;
    }
}
#if MK_MULTI
__global__ void __launch_bounds__(512, 2) k_expert(Params p, int l) {
    extern __shared__ __attribute__((aligned(16))) unsigned char smem_raw[];
    phase_expert(p, l, l == DEPTH - 1, (LAS unsigned char*)smem_raw, __builtin_amdgcn_readfirstlane((int)threadIdx.x >> 6));
}
#endif
typedef short s16x4 __attribute__((ext_vector_type(4)));
#define AT_KSTR 144
#define AT_VSTR 192
#define AT_KBUF 0
#define AT_VBUF 18432
#define AT_TBL  43008
#define AT_OEX  44032
#define AT_OSTR 272

__device__ __forceinline__ void phase_attn(const Params& p, int l, LAS unsigned char* lds, int wv) {
    const int tid = tid_opaque(wv), wave = tid >> 6, lane = tid & 63;
    const int w4 = wave & 3, m = wave >> 2, c = lane & 31, h = lane >> 5;
    const float LOG2E = 1.4426950408889634f;
    const float qscale = 0.17677669529663687f * LOG2E;
    float d01 = 0.f, d23 = 0.f;
    { const float* lp = p.diff_lambda + l * 128;
      for (int i = 0; i < 32; ++i) { d01 += lp[i] * lp[32 + i]; d23 += lp[64 + i] * lp[96 + i]; } }
    const float lam_init = p.lam_init[l];
    const float lam = expf(d01) - expf(d23) + lam_init;
    const float osc = 1.0f - lam_init;
    LAS float* tbl = (LAS float*)(lds + AT_TBL);
    const int skey = tid >> 3, sch = tid & 7;
    const int g16 = lane >> 4, li = lane & 15, tq = li >> 2, tp = li & 3;

    for (int u = blockIdx.x; u < 256; u += gridDim.x) {
        const int pi = u & 7, hd = (u >> 3) & 3, b = u >> 5;
        if (tid < 256) { const int bk = tid < 128 ? (int)kBucket[tid] : 31; tbl[tid] = p.rel_bias[bk * 4 + hd] * LOG2E; }
        const float c31 = p.rel_bias[31 * 4 + hd] * LOG2E;
        const bf16_t* pbase = p.pb() + (size_t)b * SEQ * MIX_IN;
        const bf16_t* kg = pbase + (size_t)skey * MIX_IN + 256 + hd * 64 + sch * 8;
        const bf16_t* vg = pbase + (size_t)skey * MIX_IN + 512 + hd * 64 + sch * 8;
        for (int half = 0; half < 2; ++half) {
            const int qb = half ? 15 - pi : pi;
            const int q0w = qb * 128 + 32 * w4, nkt = 2 * qb + 2;
            const int qpos = q0w + c;
            bf16x8 qf0, qf1;
            { const bf16_t* qp = pbase + (size_t)qpos * MIX_IN + hd * 64 + m * 32 + 8 * h; qf0 = *(const bf16x8*)qp; qf1 = *(const bf16x8*)(qp + 16); }
            f32x16 O0, O1;
#pragma unroll
            for (int r = 0; r < 16; ++r) { O0[r] = 0.f; O1[r] = 0.f; }
            float mrun = -1e30f, lrun = 0.f;
            u32x4 kreg = *(const u32x4*)kg, vreg = *(const u32x4*)vg;
            *(LAS u32x4*)(lds + AT_KBUF + skey * AT_KSTR + sch * 16) = kreg;
            *(LAS u32x4*)(lds + AT_VBUF + skey * AT_VSTR + sch * 16) = vreg;
            __syncthreads();
            for (int kt = 0; kt < nkt; ++kt) {
                const int k0 = kt * 64, cur = kt & 1;
                if (kt + 1 < nkt) { kreg = *(const u32x4*)(kg + (size_t)(k0 + 64) * MIX_IN); vreg = *(const u32x4*)(vg + (size_t)(k0 + 64) * MIX_IN); }
                if (k0 <= q0w + 31) {
                    LAS unsigned char* kb_ = lds + AT_KBUF + cur * (64 * AT_KSTR);
                    LAS unsigned char* vb_ = lds + AT_VBUF + cur * (64 * AT_VSTR);
                    f32x16 s0, s1;
#pragma unroll
                    for (int r = 0; r < 16; ++r) { s0[r] = 0.f; s1[r] = 0.f; }
                    {
                        const LAS unsigned char* ka = kb_ + c * AT_KSTR + m * 64 + h * 16;
                        const bf16x8 a00 = *(const LAS bf16x8*)ka, a01 = *(const LAS bf16x8*)(ka + 32);
                        const bf16x8 a10 = *(const LAS bf16x8*)(ka + 32 * AT_KSTR), a11 = *(const LAS bf16x8*)(ka + 32 * AT_KSTR + 32);
                        s0 = __builtin_amdgcn_mfma_f32_32x32x16_bf16(a00, qf0, s0, 0, 0, 0);
                        s0 = __builtin_amdgcn_mfma_f32_32x32x16_bf16(a01, qf1, s0, 0, 0, 0);
                        s1 = __builtin_amdgcn_mfma_f32_32x32x16_bf16(a10, qf0, s1, 0, 0, 0);
                        s1 = __builtin_amdgcn_mfma_f32_32x32x16_bf16(a11, qf1, s1, 0, 0, 0);
                    }
                    const bool far = (q0w - (k0 + 63)) >= 113;
                    if (far) {
#pragma unroll
                        for (int r = 0; r < 16; ++r) { s0[r] = s0[r] * qscale + c31; s1[r] = s1[r] * qscale + c31; }
                    } else {
                        const int dbase = qpos - k0 - 4 * h;
#pragma unroll
                        for (int r = 0; r < 16; ++r) {
                            const int d0 = dbase - ((r & 3) + 8 * (r >> 2)), d1 = d0 - 32;
                            const float b0 = tbl[min(max(d0, 0), 255)], b1 = tbl[min(max(d1, 0), 255)];
                            const float v0 = s0[r] * qscale + b0, v1 = s1[r] * qscale + b1;
                            s0[r] = d0 < 0 ? -1e30f : v0; s1[r] = d1 < 0 ? -1e30f : v1;
                        }
                    }
                    float tmax = fmaxf(s0[0], s1[0]);
#pragma unroll
                    for (int r = 1; r < 16; ++r) tmax = fmaxf(tmax, fmaxf(s0[r], s1[r]));
                    tmax = fmaxf(tmax, __shfl_xor(tmax, 32, 64));
                    const float mnew = fmaxf(mrun, tmax);
                    const float alpha = __builtin_amdgcn_exp2f(mrun - mnew);
                    mrun = mnew;
                    float psum = 0.f;
#pragma unroll
                    for (int r = 0; r < 16; ++r) { s0[r] = __builtin_amdgcn_exp2f(s0[r] - mnew); s1[r] = __builtin_amdgcn_exp2f(s1[r] - mnew); psum += s0[r] + s1[r]; }
                    lrun = lrun * alpha + psum;
#pragma unroll
                    for (int r = 0; r < 16; ++r) { O0[r] *= alpha; O1[r] *= alpha; }
#pragma unroll
                    for (int kb = 0; kb < 2; ++kb)
#pragma unroll
                        for (int sp = 0; sp < 2; ++sp) {
                            u32x4 pw;
                            if (kb == 0) { pw.x = pk2(s0[8 * sp + 0], s0[8 * sp + 1]); pw.y = pk2(s0[8 * sp + 2], s0[8 * sp + 3]); pw.z = pk2(s0[8 * sp + 4], s0[8 * sp + 5]); pw.w = pk2(s0[8 * sp + 6], s0[8 * sp + 7]); }
                            else         { pw.x = pk2(s1[8 * sp + 0], s1[8 * sp + 1]); pw.y = pk2(s1[8 * sp + 2], s1[8 * sp + 3]); pw.z = pk2(s1[8 * sp + 4], s1[8 * sp + 5]); pw.w = pk2(s1[8 * sp + 6], s1[8 * sp + 7]); }
                            const bf16x8 pf = __builtin_bit_cast(bf16x8, pw);
                            const int kA = 32 * kb + 16 * sp + 4 * h;
#pragma unroll
                            for (int mb = 0; mb < 2; ++mb) {
                                LAS unsigned char* va = vb_ + (kA + tq) * AT_VSTR + (32 * mb + 16 * (g16 & 1) + 4 * tp) * 2;
                                const s16x4 t0 = __builtin_amdgcn_ds_read_tr16_b64_v4i16((LAS s16x4*)va);
                                const s16x4 t1 = __builtin_amdgcn_ds_read_tr16_b64_v4i16((LAS s16x4*)(va + 8 * AT_VSTR));
                                const bf16x8 vf = {t0[0], t0[1], t0[2], t0[3], t1[0], t1[1], t1[2], t1[3]};
                                if (mb == 0) O0 = __builtin_amdgcn_mfma_f32_32x32x16_bf16(vf, pf, O0, 0, 0, 0);
                                else         O1 = __builtin_amdgcn_mfma_f32_32x32x16_bf16(vf, pf, O1, 0, 0, 0);
                            }
                        }
                }
                if (kt + 1 < nkt) {
                    *(LAS u32x4*)(lds + AT_KBUF + (cur ^ 1) * (64 * AT_KSTR) + skey * AT_KSTR + sch * 16) = kreg;
                    *(LAS u32x4*)(lds + AT_VBUF + (cur ^ 1) * (64 * AT_VSTR) + skey * AT_VSTR + sch * 16) = vreg;
                }
                __syncthreads();
            }
            const float inv = 1.0f / (lrun + __shfl_xor(lrun, 32, 64));
            LAS unsigned char* oex = lds + AT_OEX + (32 * w4 + c) * AT_OSTR + 16 * h;
            if (m == 1) {
#pragma unroll
                for (int r4 = 0; r4 < 4; ++r4) {
                    f32x4 a, bq;
#pragma unroll
                    for (int e = 0; e < 4; ++e) { a[e] = O0[4 * r4 + e] * inv; bq[e] = O1[4 * r4 + e] * inv; }
                    *(LAS f32x4*)(oex + (8 * r4) * 4) = a;
                    *(LAS f32x4*)(oex + (32 + 8 * r4) * 4) = bq;
                }
            }
            __syncthreads();
            if (m == 0) {
                float ss = 0.f;
#pragma unroll
                for (int r4 = 0; r4 < 4; ++r4) {
                    const f32x4 a = *(const LAS f32x4*)(oex + (8 * r4) * 4), bq = *(const LAS f32x4*)(oex + (32 + 8 * r4) * 4);
#pragma unroll
                    for (int e = 0; e < 4; ++e) {
                        O0[4 * r4 + e] = O0[4 * r4 + e] * inv - lam * a[e]; O1[4 * r4 + e] = O1[4 * r4 + e] * inv - lam * bq[e];
                        ss += O0[4 * r4 + e] * O0[4 * r4 + e] + O1[4 * r4 + e] * O1[4 * r4 + e];
                    }
                }
                ss += __shfl_xor(ss, 32, 64);
                const float rstd = rsqrtf(ss * (1.0f / 64.0f) + 1e-6f) * osc;
                bf16_t* orow = p.cat() + (size_t)(b * SEQ + qpos) * D_MODEL + hd * 64 + 4 * h;
                const float* sg = p.subln_g + l * 64 + 4 * h;
#pragma unroll
                for (int r4 = 0; r4 < 4; ++r4) {
                    const f32x4 ga = *(const f32x4*)(sg + 8 * r4), gb = *(const f32x4*)(sg + 32 + 8 * r4);
                    u32x2 oa, ob;
                    oa.x = pk2(O0[4 * r4 + 0] * rstd * ga[0], O0[4 * r4 + 1] * rstd * ga[1]); oa.y = pk2(O0[4 * r4 + 2] * rstd * ga[2], O0[4 * r4 + 3] * rstd * ga[3]);
                    ob.x = pk2(O1[4 * r4 + 0] * rstd * gb[0], O1[4 * r4 + 1] * rstd * gb[1]); ob.y = pk2(O1[4 * r4 + 2] * rstd * gb[2], O1[4 * r4 + 3] * rstd * gb[3]);
                    *(u32x2*)(orow + 8 * r4) = oa;
                    *(u32x2*)(orow + 32 + 8 * r4) = ob;
                }
            }
            __syncthreads();
        }
    }
}
#if MK_MULTI
template <int DUMMY>
__global__ void __launch_bounds__(512, 2) k_attn2(Params p, int l) {
    extern __shared__ __attribute__((aligned(16))) unsigned char smem_raw[];
    phase_attn(p, l, (LAS unsigned char*)smem_raw, __builtin_amdgcn_readfirstlane((int)threadIdx.x >> 6));
}
#endif
#define MR_VSTR 272

__device__ __forceinline__ void mixrest_conv(const Params& p, int l, int chunk, LAS unsigned char* lds, int wv) {
    const int tid = tid_opaque(wv), wave = tid >> 6, lane = tid & 63;
    const int t0 = chunk * 128, s0 = t0 % SEQ;
    LAS float* glu = (LAS float*)lds;
    const int c = tid & 255, th = tid >> 8;
    float w[31];
#pragma unroll
    for (int j = 0; j < 31; ++j) w[j] = p.conf_dw[((size_t)l * 31 + j) * 256 + c];
    for (int hf = 0; hf < 2; ++hf) {
        const int tb = t0 + hf * 64;
        for (int it = tid; it < 94 * 32; it += 512) {
            const int i = it >> 5, c8 = (it & 31) * 8;
            const int sp = s0 + hf * 64 - 30 + i;
            f32x4 o0 = {0.f, 0.f, 0.f, 0.f}, o1 = {0.f, 0.f, 0.f, 0.f};
            if (sp >= 0) {
                const bf16_t* pr = p.pb() + (size_t)(tb - 30 + i) * MIX_IN;
                const u32x4 a = *(const u32x4*)(pr + 3 * 256 + c8), g = *(const u32x4*)(pr + 4 * 256 + c8);
                o0[0] = bflo(a.x) * sigmoidf_(bflo(g.x)); o0[1] = bfhi(a.x) * sigmoidf_(bfhi(g.x));
                o0[2] = bflo(a.y) * sigmoidf_(bflo(g.y)); o0[3] = bfhi(a.y) * sigmoidf_(bfhi(g.y));
                o1[0] = bflo(a.z) * sigmoidf_(bflo(g.z)); o1[1] = bfhi(a.z) * sigmoidf_(bfhi(g.z));
                o1[2] = bflo(a.w) * sigmoidf_(bflo(g.w)); o1[3] = bfhi(a.w) * sigmoidf_(bfhi(g.w));
            }
            *(LAS f32x4*)(glu + i * 256 + c8) = o0; *(LAS f32x4*)(glu + i * 256 + c8 + 4) = o1;
        }
        __syncthreads();
        float acc[32];
#pragma unroll
        for (int o = 0; o < 32; ++o) acc[o] = 0.f;
#pragma unroll
        for (int i = 0; i < 62; ++i) {
            const float xval = glu[(th * 32 + i) * 256 + c];
#pragma unroll
            for (int o = 0; o < 32; ++o) if (i - o >= 0 && i - o <= 30) acc[o] += w[i - o] * xval;
        }
        __syncthreads();
#pragma unroll
        for (int o = 0; o < 32; ++o) glu[(th * 32 + o) * 256 + c] = acc[o];
        __syncthreads();
        const f32x4 lg = *(const f32x4*)(p.conf_ln_g + l * 256 + lane * 4), lb = *(const f32x4*)(p.conf_ln_b + l * 256 + lane * 4);
        for (int k = 0; k < 8; ++k) {
            const int tk = wave * 8 + k;
            const f32x4 z = *(const LAS f32x4*)(glu + tk * 256 + lane * 4);
            const float mu = wave_sum(z[0] + z[1] + z[2] + z[3]) * (1.0f / 256.0f);
            f32x4 dz; float sq = 0.f;
#pragma unroll
            for (int e = 0; e < 4; ++e) { dz[e] = z[e] - mu; sq += dz[e] * dz[e]; }
            const float rstd = rsqrtf(wave_sum(sq) * (1.0f / 256.0f) + 1e-6f);
            float y[4];
#pragma unroll
            for (int e = 0; e < 4; ++e) { const float v = dz[e] * rstd * lg[e] + lb[e]; y[e] = v * sigmoidf_(v); }
            u32x2 o; o.x = pk2(y[0], y[1]); o.y = pk2(y[2], y[3]);
            *(u32x2*)(p.cat() + (size_t)(tb + tk) * D_MODEL + 256 + lane * 4) = o;
        }
        __syncthreads();
    }
}

__device__ __forceinline__ void mixrest_sgu(const Params& p, int l, int chunk, LAS unsigned char* lds, int wv) {
    const int tid = tid_opaque(wv), wave = tid >> 6, lane = tid & 63;
    const int t0 = chunk * 128, s0 = t0 % SEQ;
    {
        const float* sw = p.sconv_w + (size_t)l * 3 * 256;
        for (int it = tid; it < 128 * 32; it += 512) {
            const int tt = it >> 5, c8 = (it & 31) * 8;
            const bf16_t* pr = p.pb() + (size_t)(t0 + tt) * MIX_IN;
            float z[8];
#pragma unroll
            for (int e = 0; e < 8; ++e) z[e] = 0.f;
#pragma unroll
            for (int j = 0; j < 3; ++j) {
                if (s0 + tt - 2 + j >= 0) {
                    const bf16_t* q = pr + (ptrdiff_t)(j - 2) * MIX_IN;
                    const u32x4 a = *(const u32x4*)(q + 6 * 256 + c8), bq = *(const u32x4*)(q + 7 * 256 + c8);
                    const f32x4 w0 = *(const f32x4*)(sw + j * 256 + c8), w1 = *(const f32x4*)(sw + j * 256 + c8 + 4);
                    z[0] += w0[0] * bflo(a.x) * bflo(bq.x); z[1] += w0[1] * bfhi(a.x) * bfhi(bq.x);
                    z[2] += w0[2] * bflo(a.y) * bflo(bq.y); z[3] += w0[3] * bfhi(a.y) * bfhi(bq.y);
                    z[4] += w1[0] * bflo(a.z) * bflo(bq.z); z[5] += w1[1] * bfhi(a.z) * bfhi(bq.z);
                    z[6] += w1[2] * bflo(a.w) * bflo(bq.w); z[7] += w1[3] * bfhi(a.w) * bfhi(bq.w);
                }
            }
            const u32x4 cb = *(const u32x4*)(pr + 5 * 256 + c8);
            u32x4 o;
            o.x = pk2(bflo(cb.x) * z[0], bfhi(cb.x) * z[1]); o.y = pk2(bflo(cb.y) * z[2], bfhi(cb.y) * z[3]);
            o.z = pk2(bflo(cb.z) * z[4], bfhi(cb.z) * z[5]); o.w = pk2(bflo(cb.w) * z[6], bfhi(cb.w) * z[7]);
            *(u32x4*)(p.cat() + (size_t)(t0 + tt) * D_MODEL + 512 + c8) = o;
        }
    }
    {
        const f32x4 lg = *(const f32x4*)(p.sgu_ln_g + l * 256 + lane * 4), lb = *(const f32x4*)(p.sgu_ln_b + l * 256 + lane * 4);
        for (int k = 0; k < 16; ++k) {
            const int s = wave * 16 + k;
            const u32x2 raw = *(const u32x2*)(p.pb() + (size_t)(t0 + s) * MIX_IN + 9 * 256 + lane * 4);
            float v[4] = {gelu_as(bflo(raw.x)), gelu_as(bfhi(raw.x)), gelu_as(bflo(raw.y)), gelu_as(bfhi(raw.y))};
            const float mu = wave_sum(v[0] + v[1] + v[2] + v[3]) * (1.0f / 256.0f);
            float sq = 0.f;
#pragma unroll
            for (int e = 0; e < 4; ++e) { v[e] -= mu; sq += v[e] * v[e]; }
            const float rstd = rsqrtf(wave_sum(sq) * (1.0f / 256.0f) + 1e-6f);
#pragma unroll
            for (int e = 0; e < 4; ++e) *(LAS bf16_t*)(lds + (lane * 4 + e) * MR_VSTR + s * 2) = f2bf(v[e] * rstd * lg[e] + lb[e]);
        }
    }
    __syncthreads();
    {
        const int hq = wave & 3, mb = wave >> 2, c = lane & 31, hh = lane >> 5;
        bf16x8 af[8];
#pragma unroll
        for (int ks = 0; ks < 8; ++ks) af[ks] = *(const LAS bf16x8*)(lds + (hq * 64 + mb * 32 + c) * MR_VSTR + (16 * ks + 8 * hh) * 2);
        const bf16_t* wb = p.sguwb() + ((size_t)(l * 4 + hq) * 128) * 128;
        f32x16 acc[4];
#pragma unroll
        for (int nb = 0; nb < 4; ++nb) {
#pragma unroll
            for (int r = 0; r < 16; ++r) acc[nb][r] = 0.f;
#pragma unroll
            for (int ks = 0; ks < 2 * nb + 2; ++ks) {
                const bf16x8 bfrag = *(const bf16x8*)(wb + (size_t)(32 * nb + c) * 128 + 16 * ks + 8 * hh);
                acc[nb] = __builtin_amdgcn_mfma_f32_32x32x16_bf16(af[ks], bfrag, acc[nb], 0, 0, 0);
            }
        }
        const float* bs = p.sgu_b + (size_t)(l * 4 + hq) * 128;
#pragma unroll
        for (int nb = 0; nb < 4; ++nb) {
            const int tt = 32 * nb + c;
            const float bias = bs[tt];
            const bf16_t* su = p.pb() + (size_t)(t0 + tt) * MIX_IN + 8 * 256 + hq * 64 + mb * 32 + 4 * hh;
            bf16_t* orow = p.cat() + (size_t)(t0 + tt) * D_MODEL + 768 + hq * 64 + mb * 32 + 4 * hh;
#pragma unroll
            for (int r4 = 0; r4 < 4; ++r4) {
                const u32x2 raw = *(const u32x2*)(su + 8 * r4);
                u32x2 o;
                o.x = pk2(gelu_as(bflo(raw.x)) * (acc[nb][4 * r4 + 0] + bias), gelu_as(bfhi(raw.x)) * (acc[nb][4 * r4 + 1] + bias));
                o.y = pk2(gelu_as(bflo(raw.y)) * (acc[nb][4 * r4 + 2] + bias), gelu_as(bfhi(raw.y)) * (acc[nb][4 * r4 + 3] + bias));
                *(u32x2*)(orow + 8 * r4) = o;
            }
        }
    }
    __syncthreads();
}

__device__ __forceinline__ void phase_mixrest(const Params& p, int l, LAS unsigned char* lds, int wv) {
    for (int u = blockIdx.x; u < 256; u += gridDim.x) {
        const int chunk = u >> 1;
        if (u & 1) mixrest_sgu(p, l, chunk, lds, wv); else mixrest_conv(p, l, chunk, lds, wv);
    }
}
#if MK_MULTI
template <int DUMMY>
__global__ void __launch_bounds__(512, 2) k_mixrest(Params p, int l) {
    extern __shared__ __attribute__((aligned(16))) unsigned char smem_raw[];
    phase_mixrest(p, l, (LAS unsigned char*)smem_raw, __builtin_amdgcn_readfirstlane((int)threadIdx.x >> 6));
}
#endif
__device__ __forceinline__ int f2sortable(float f) { const int x = __float_as_int(f); return x ^ ((x >> 31) & 0x7FFFFFFF); }
__device__ __forceinline__ float sortable2f(int s) { return __int_as_float(s ^ ((s >> 31) & 0x7FFFFFFF)); }

template <int N>
__device__ __forceinline__ void bitonic_sort_desc(int (&a)[N]) {
#pragma unroll
    for (int k = 2; k <= N; k <<= 1)
#pragma unroll
        for (int j = k >> 1; j > 0; j >>= 1)
#pragma unroll
            for (int i = 0; i < N; ++i) {
                const int q = i ^ j;
                if (q > i) {
                    const int hi = max(a[i], a[q]), lo = min(a[i], a[q]);
                    if ((i & k) == 0 || k == N) { a[i] = hi; a[q] = lo; } else { a[i] = lo; a[q] = hi; }
                }
            }
}
__device__ __forceinline__ void bitonic_merge_desc16(int (&a)[16]) {
#pragma unroll
    for (int j = 8; j > 0; j >>= 1)
#pragma unroll
        for (int i = 0; i < 16; ++i) {
            const int q = i ^ j;
            if (q > i) { const int hi = max(a[i], a[q]), lo = min(a[i], a[q]); a[i] = hi; a[q] = lo; }
        }
}
__device__ __forceinline__ void merge_top16(int (&a)[16], const int (&b)[16]) {
#pragma unroll
    for (int i = 0; i < 16; ++i) a[i] = max(a[i], b[15 - i]);
    bitonic_merge_desc16(a);
}

#define TK_KEYS 8192
#define TK_KSTR 272
template <bool TO_LDS>
__device__ __forceinline__ void topk_unit(const Params& p, int l, int u, int hd, LAS unsigned char* lds, int wave, int lane, LAS int* le, LAS float* lg) {
    const int c = lane & 31, hh = lane >> 5;
    LAS unsigned char* ilist = lds + wave * 1024 + c * 32;
    const int hx = hh << 2;
    const __amdgpu_buffer_rsrc_t rq = __builtin_amdgcn_make_buffer_rsrc((void*)p.qb(), 0, NTOK * 2048 * 2, 0x00020000);
    const int qvoff = c * 4096 + hh * 16;
    {
        const int t = u * 32 + c;
        int S0[16], S1[16];
#pragma unroll
        for (int pp = 0; pp < 2; ++pp) {
            bf16x8 qf[8];
            {
                const int qso = (u * 32) * 4096 + hd * 512 + pp * 256;
#pragma unroll
                for (int ks = 0; ks < 8; ++ks) qf[ks] = __builtin_bit_cast(bf16x8, __builtin_amdgcn_raw_buffer_load_b128(rq, qvoff + 32 * ks, qso, 0));
            }
            const LAS unsigned char* kl = lds + TK_KEYS + (pp * 128 + c) * TK_KSTR + hh * 16;
            int K0[16], K1[16], K2[16], K3[16];
#pragma unroll
            for (int kb = 0; kb < 4; ++kb) {
                asm volatile("" ::: "memory");
                f32x16 acc;
#pragma unroll
                for (int r = 0; r < 16; ++r) acc[r] = 0.f;
#pragma unroll
                for (int ks = 0; ks < 8; ++ks) {
                    const bf16x8 a = *(const LAS bf16x8*)(kl + (32 * kb) * TK_KSTR + 32 * ks);
                    acc = __builtin_amdgcn_mfma_f32_32x32x16_bf16(a, qf[ks], acc, 0, 0, 0);
                }
#pragma unroll
                for (int r = 0; r < 16; ++r) {
                    const int nconst = 32 * kb + (r & 3) + 8 * (r >> 2);
                    const int key = (f2sortable(acc[r]) & ~0x7F) | (127 - nconst);
                    if (kb == 0) K0[r] = key; else if (kb == 1) K1[r] = key; else if (kb == 2) K2[r] = key; else K3[r] = key;
                }
            }
            bitonic_sort_desc<16>(K0); bitonic_sort_desc<16>(K1); bitonic_sort_desc<16>(K2); bitonic_sort_desc<16>(K3);
            merge_top16(K0, K1); merge_top16(K2, K3); merge_top16(K0, K2);
            int P[16];
#pragma unroll
            for (int i = 0; i < 16; ++i) { K0[i] ^= hx; P[i] = __shfl_xor(K0[i], 32, 64); }
            merge_top16(K0, P);
#pragma unroll
            for (int i = 0; i < 16; ++i) { if (pp == 0) S0[i] = K0[i]; else S1[i] = K0[i]; }
        }
        {
            unsigned w4[4];
#pragma unroll
            for (int q = 0; q < 4; ++q) {
                unsigned w = 0;
#pragma unroll
                for (int e = 0; e < 4; ++e) { const int sv = hh ? S1[4 * q + e] : S0[4 * q + e]; w |= (unsigned)(127 - (sv & 127)) << (8 * e); }
                w4[q] = w;
            }
            u32x4 wv; wv.x = w4[0]; wv.y = w4[1]; wv.z = w4[2]; wv.w = w4[3];
            *(LAS u32x4*)(ilist + 16 * hh) = wv;
        }
        float a[16], b[16];
#pragma unroll
        for (int i = 0; i < 16; ++i) {
            const float f1 = sortable2f(S0[i] & ~0x7F), f2 = sortable2f(S1[i] & ~0x7F);
            a[i] = hh ? f2 : f1; b[i] = hh ? f1 : f2;
        }
        int CA[16], CB[16];
        const int org = hh << 8;
        {
            int n = 0;
#pragma unroll
            for (int i = 0; i < 4; ++i)
#pragma unroll
                for (int j = i; j < 16; ++j) {
                    if ((i + 1) * (j + 1) <= 16) {
                        int key = (f2sortable(a[i] + b[j]) & ~0x1FF) | org | (i * 16 + j);
                        if (i == j) key = hh ? (int)0x80000000 : key;
                        if (n < 16) CA[n] = key; else CB[n - 16] = key;
                        ++n;
                    }
                }
#pragma unroll
            for (int q = 27; q < 32; ++q) CB[q - 16] = (int)0x80000000;
        }
        bitonic_sort_desc<16>(CA); bitonic_sort_desc<16>(CB);
        merge_top16(CA, CB);
        int F[16], PF[16];
#pragma unroll
        for (int i = 0; i < 16; ++i) PF[i] = __shfl_xor(CA[i], 32, 64);
#pragma unroll
        for (int i = 0; i < 16; ++i) F[i] = max(CA[i], PF[15 - i]);
        int mxk = F[0];
#pragma unroll
        for (int i = 1; i < 16; ++i) mxk = max(mxk, F[i]);
        const float vmax = sortable2f(mxk & ~0x1FF);
        float e[8], psum = 0.f;
#pragma unroll
        for (int i = 0; i < 8; ++i) { e[i] = __expf(sortable2f(F[i] & ~0x1FF) - vmax); psum += e[i]; }
        const float inv = 1.0f / (psum + __shfl_xor(psum, 32, 64));
        asm volatile("s_waitcnt lgkmcnt(0)" ::: "memory");
        int ex[8];
#pragma unroll
        for (int i = 0; i < 8; ++i) {
            const int low = F[i] & 0x1FF, o = low >> 8, il = (low >> 4) & 15, jl = low & 15;
            const int ri = o ? jl : il, rj = o ? il : jl;
            const int i1 = (int)*(const LAS unsigned char*)(ilist + ri), i2 = (int)*(const LAS unsigned char*)(ilist + 16 + rj);
            ex[i] = i1 * 128 + i2;
        }
        if (TO_LDS) {
            LAS int* ep = le + (c * 8 + hd) * 16 + hh * 8;
            LAS float* gp = lg + (c * 8 + hd) * 16 + hh * 8;
            *(LAS u32x4*)ep = (u32x4){(unsigned)ex[0], (unsigned)ex[1], (unsigned)ex[2], (unsigned)ex[3]};
            *(LAS u32x4*)(ep + 4) = (u32x4){(unsigned)ex[4], (unsigned)ex[5], (unsigned)ex[6], (unsigned)ex[7]};
            *(LAS f32x4*)gp = (f32x4){e[0] * inv, e[1] * inv, e[2] * inv, e[3] * inv};
            *(LAS f32x4*)(gp + 4) = (f32x4){e[4] * inv, e[5] * inv, e[6] * inv, e[7] * inv};
        } else {
            int* ep = p.eidx() + ((size_t)t * 8 + hd) * 16 + hh * 8;
            float* gp = p.egate() + ((size_t)t * 8 + hd) * 16 + hh * 8;
            *(u32x4*)ep = (u32x4){(unsigned)ex[0], (unsigned)ex[1], (unsigned)ex[2], (unsigned)ex[3]};
            *(u32x4*)(ep + 4) = (u32x4){(unsigned)ex[4], (unsigned)ex[5], (unsigned)ex[6], (unsigned)ex[7]};
            *(f32x4*)gp = (f32x4){e[0] * inv, e[1] * inv, e[2] * inv, e[3] * inv};
            *(f32x4*)(gp + 4) = (f32x4){e[4] * inv, e[5] * inv, e[6] * inv, e[7] * inv};
        }
        asm volatile("s_waitcnt lgkmcnt(0)" ::: "memory");
    }
}
__device__ __forceinline__ void phase_topk(const Params& p, int l, LAS unsigned char* lds, int wv) {
    const int tid = tid_opaque(wv), wave = __builtin_amdgcn_readfirstlane(tid >> 6), lane = tid & 63;
    int cur_hd = -1;
    for (int u = blockIdx.x; u < 8 * (NTOK / 256); u += gridDim.x) {
        const int hd = u & 7, tg = u >> 3;
        if (hd != cur_hd) {
            __syncthreads();
            const bf16_t* kg = p.keysb() + ((size_t)(l * 8 + hd) * 2) * 128 * 128;
            for (int i = tid; i < 2 * 128 * 16; i += 512) {
                const u32x4 v = *(const u32x4*)(kg + (size_t)(i >> 4) * 128 + (i & 15) * 8);
                *(LAS u32x4*)(lds + TK_KEYS + (i >> 4) * TK_KSTR + (i & 15) * 16) = v;
            }
            __syncthreads();
            cur_hd = hd;
        }
        topk_unit<false>(p, l, tg * 8 + wave, hd, lds, wave, lane, nullptr, nullptr);
    }
}
#if MK_MULTI
template <int DUMMY>
__global__ void __launch_bounds__(512, 2) k_topk(Params p, int l) {
    extern __shared__ __attribute__((aligned(16))) unsigned char smem_raw[];
    phase_topk(p, l, (LAS unsigned char*)smem_raw, __builtin_amdgcn_readfirstlane((int)threadIdx.x >> 6));
}
#endif
#if PROBE_UB
__device__ __forceinline__ void ubench(int iters, unsigned seed) {
    float r[16]; f32x2 r2[8];
#pragma unroll
    for (int i = 0; i < 16; ++i) r[i] = __uint_as_float(seed + i);
#pragma unroll
    for (int i = 0; i < 8; ++i) r2[i] = (f32x2){r[2 * i], r[2 * i + 1]};
    float a = __uint_as_float(seed * 3u + 1u), b = __uint_as_float(seed * 5u + 7u);
    for (int it = 0; it < iters; ++it) {
#if PROBE_UB == 1
        asm volatile("v_fma_f32 %0, %16, %17, %0\n\tv_fma_f32 %1, %16, %17, %1\n\tv_fma_f32 %2, %16, %17, %2\n\tv_fma_f32 %3, %16, %17, %3\n\tv_fma_f32 %4, %16, %17, %4\n\tv_fma_f32 %5, %16, %17, %5\n\tv_fma_f32 %6, %16, %17, %6\n\tv_fma_f32 %7, %16, %17, %7\n\tv_fma_f32 %8, %16, %17, %8\n\tv_fma_f32 %9, %16, %17, %9\n\tv_fma_f32 %10, %16, %17, %10\n\tv_fma_f32 %11, %16, %17, %11\n\tv_fma_f32 %12, %16, %17, %12\n\tv_fma_f32 %13, %16, %17, %13\n\tv_fma_f32 %14, %16, %17, %14\n\tv_fma_f32 %15, %16, %17, %15\n\t" : "+v"(r[0]), "+v"(r[1]), "+v"(r[2]), "+v"(r[3]), "+v"(r[4]), "+v"(r[5]), "+v"(r[6]), "+v"(r[7]), "+v"(r[8]), "+v"(r[9]), "+v"(r[10]), "+v"(r[11]), "+v"(r[12]), "+v"(r[13]), "+v"(r[14]), "+v"(r[15]) : "v"(a), "v"(b) : "s40", "vcc");
        asm volatile("v_fma_f32 %0, %16, %17, %0\n\tv_fma_f32 %1, %16, %17, %1\n\tv_fma_f32 %2, %16, %17, %2\n\tv_fma_f32 %3, %16, %17, %3\n\tv_fma_f32 %4, %16, %17, %4\n\tv_fma_f32 %5, %16, %17, %5\n\tv_fma_f32 %6, %16, %17, %6\n\tv_fma_f32 %7, %16, %17, %7\n\tv_fma_f32 %8, %16, %17, %8\n\tv_fma_f32 %9, %16, %17, %9\n\tv_fma_f32 %10, %16, %17, %10\n\tv_fma_f32 %11, %16, %17, %11\n\tv_fma_f32 %12, %16, %17, %12\n\tv_fma_f32 %13, %16, %17, %13\n\tv_fma_f32 %14, %16, %17, %14\n\tv_fma_f32 %15, %16, %17, %15\n\t" : "+v"(r[0]), "+v"(r[1]), "+v"(r[2]), "+v"(r[3]), "+v"(r[4]), "+v"(r[5]), "+v"(r[6]), "+v"(r[7]), "+v"(r[8]), "+v"(r[9]), "+v"(r[10]), "+v"(r[11]), "+v"(r[12]), "+v"(r[13]), "+v"(r[14]), "+v"(r[15]) : "v"(a), "v"(b) : "s40", "vcc");
#endif
#if PROBE_UB == 2
        asm volatile("v_dot4c_i32_i8 %0, %16, %17\n\tv_dot4c_i32_i8 %1, %16, %17\n\tv_dot4c_i32_i8 %2, %16, %17\n\tv_dot4c_i32_i8 %3, %16, %17\n\tv_dot4c_i32_i8 %4, %16, %17\n\tv_dot4c_i32_i8 %5, %16, %17\n\tv_dot4c_i32_i8 %6, %16, %17\n\tv_dot4c_i32_i8 %7, %16, %17\n\tv_dot4c_i32_i8 %8, %16, %17\n\tv_dot4c_i32_i8 %9, %16, %17\n\tv_dot4c_i32_i8 %10, %16, %17\n\tv_dot4c_i32_i8 %11, %16, %17\n\tv_dot4c_i32_i8 %12, %16, %17\n\tv_dot4c_i32_i8 %13, %16, %17\n\tv_dot4c_i32_i8 %14, %16, %17\n\tv_dot4c_i32_i8 %15, %16, %17\n\t" : "+v"(r[0]), "+v"(r[1]), "+v"(r[2]), "+v"(r[3]), "+v"(r[4]), "+v"(r[5]), "+v"(r[6]), "+v"(r[7]), "+v"(r[8]), "+v"(r[9]), "+v"(r[10]), "+v"(r[11]), "+v"(r[12]), "+v"(r[13]), "+v"(r[14]), "+v"(r[15]) : "v"(a), "v"(b) : "s40", "vcc");
        asm volatile("v_dot4c_i32_i8 %0, %16, %17\n\tv_dot4c_i32_i8 %1, %16, %17\n\tv_dot4c_i32_i8 %2, %16, %17\n\tv_dot4c_i32_i8 %3, %16, %17\n\tv_dot4c_i32_i8 %4, %16, %17\n\tv_dot4c_i32_i8 %5, %16, %17\n\tv_dot4c_i32_i8 %6, %16, %17\n\tv_dot4c_i32_i8 %7, %16, %17\n\tv_dot4c_i32_i8 %8, %16, %17\n\tv_dot4c_i32_i8 %9, %16, %17\n\tv_dot4c_i32_i8 %10, %16, %17\n\tv_dot4c_i32_i8 %11, %16, %17\n\tv_dot4c_i32_i8 %12, %16, %17\n\tv_dot4c_i32_i8 %13, %16, %17\n\tv_dot4c_i32_i8 %14, %16, %17\n\tv_dot4c_i32_i8 %15, %16, %17\n\t" : "+v"(r[0]), "+v"(r[1]), "+v"(r[2]), "+v"(r[3]), "+v"(r[4]), "+v"(r[5]), "+v"(r[6]), "+v"(r[7]), "+v"(r[8]), "+v"(r[9]), "+v"(r[10]), "+v"(r[11]), "+v"(r[12]), "+v"(r[13]), "+v"(r[14]), "+v"(r[15]) : "v"(a), "v"(b) : "s40", "vcc");
#endif
#if PROBE_UB == 3
        asm volatile("v_perm_b32 %0, %0, %16, %17\n\tv_perm_b32 %1, %1, %16, %17\n\tv_perm_b32 %2, %2, %16, %17\n\tv_perm_b32 %3, %3, %16, %17\n\tv_perm_b32 %4, %4, %16, %17\n\tv_perm_b32 %5, %5, %16, %17\n\tv_perm_b32 %6, %6, %16, %17\n\tv_perm_b32 %7, %7, %16, %17\n\tv_perm_b32 %8, %8, %16, %17\n\tv_perm_b32 %9, %9, %16, %17\n\tv_perm_b32 %10, %10, %16, %17\n\tv_perm_b32 %11, %11, %16, %17\n\tv_perm_b32 %12, %12, %16, %17\n\tv_perm_b32 %13, %13, %16, %17\n\tv_perm_b32 %14, %14, %16, %17\n\tv_perm_b32 %15, %15, %16, %17\n\t" : "+v"(r[0]), "+v"(r[1]), "+v"(r[2]), "+v"(r[3]), "+v"(r[4]), "+v"(r[5]), "+v"(r[6]), "+v"(r[7]), "+v"(r[8]), "+v"(r[9]), "+v"(r[10]), "+v"(r[11]), "+v"(r[12]), "+v"(r[13]), "+v"(r[14]), "+v"(r[15]) : "v"(a), "v"(b) : "s40", "vcc");
        asm volatile("v_perm_b32 %0, %0, %16, %17\n\tv_perm_b32 %1, %1, %16, %17\n\tv_perm_b32 %2, %2, %16, %17\n\tv_perm_b32 %3, %3, %16, %17\n\tv_perm_b32 %4, %4, %16, %17\n\tv_perm_b32 %5, %5, %16, %17\n\tv_perm_b32 %6, %6, %16, %17\n\tv_perm_b32 %7, %7, %16, %17\n\tv_perm_b32 %8, %8, %16, %17\n\tv_perm_b32 %9, %9, %16, %17\n\tv_perm_b32 %10, %10, %16, %17\n\tv_perm_b32 %11, %11, %16, %17\n\tv_perm_b32 %12, %12, %16, %17\n\tv_perm_b32 %13, %13, %16, %17\n\tv_perm_b32 %14, %14, %16, %17\n\tv_perm_b32 %15, %15, %16, %17\n\t" : "+v"(r[0]), "+v"(r[1]), "+v"(r[2]), "+v"(r[3]), "+v"(r[4]), "+v"(r[5]), "+v"(r[6]), "+v"(r[7]), "+v"(r[8]), "+v"(r[9]), "+v"(r[10]), "+v"(r[11]), "+v"(r[12]), "+v"(r[13]), "+v"(r[14]), "+v"(r[15]) : "v"(a), "v"(b) : "s40", "vcc");
#endif
#if PROBE_UB == 4
        asm volatile("v_add_u32_dpp %0, %0, %0 quad_perm:[1,0,3,2] row_mask:0xf bank_mask:0xf\n\tv_add_u32_dpp %1, %1, %1 quad_perm:[1,0,3,2] row_mask:0xf bank_mask:0xf\n\tv_add_u32_dpp %2, %2, %2 quad_perm:[1,0,3,2] row_mask:0xf bank_mask:0xf\n\tv_add_u32_dpp %3, %3, %3 quad_perm:[1,0,3,2] row_mask:0xf bank_mask:0xf\n\tv_add_u32_dpp %4, %4, %4 quad_perm:[1,0,3,2] row_mask:0xf bank_mask:0xf\n\tv_add_u32_dpp %5, %5, %5 quad_perm:[1,0,3,2] row_mask:0xf bank_mask:0xf\n\tv_add_u32_dpp %6, %6, %6 quad_perm:[1,0,3,2] row_mask:0xf bank_mask:0xf\n\tv_add_u32_dpp %7, %7, %7 quad_perm:[1,0,3,2] row_mask:0xf bank_mask:0xf\n\tv_add_u32_dpp %8, %8, %8 quad_perm:[1,0,3,2] row_mask:0xf bank_mask:0xf\n\tv_add_u32_dpp %9, %9, %9 quad_perm:[1,0,3,2] row_mask:0xf bank_mask:0xf\n\tv_add_u32_dpp %10, %10, %10 quad_perm:[1,0,3,2] row_mask:0xf bank_mask:0xf\n\tv_add_u32_dpp %11, %11, %11 quad_perm:[1,0,3,2] row_mask:0xf bank_mask:0xf\n\tv_add_u32_dpp %12, %12, %12 quad_perm:[1,0,3,2] row_mask:0xf bank_mask:0xf\n\tv_add_u32_dpp %13, %13, %13 quad_perm:[1,0,3,2] row_mask:0xf bank_mask:0xf\n\tv_add_u32_dpp %14, %14, %14 quad_perm:[1,0,3,2] row_mask:0xf bank_mask:0xf\n\tv_add_u32_dpp %15, %15, %15 quad_perm:[1,0,3,2] row_mask:0xf bank_mask:0xf\n\t" : "+v"(r[0]), "+v"(r[1]), "+v"(r[2]), "+v"(r[3]), "+v"(r[4]), "+v"(r[5]), "+v"(r[6]), "+v"(r[7]), "+v"(r[8]), "+v"(r[9]), "+v"(r[10]), "+v"(r[11]), "+v"(r[12]), "+v"(r[13]), "+v"(r[14]), "+v"(r[15]) : "v"(a), "v"(b) : "s40", "vcc");
        asm volatile("v_add_u32_dpp %0, %0, %0 quad_perm:[1,0,3,2] row_mask:0xf bank_mask:0xf\n\tv_add_u32_dpp %1, %1, %1 quad_perm:[1,0,3,2] row_mask:0xf bank_mask:0xf\n\tv_add_u32_dpp %2, %2, %2 quad_perm:[1,0,3,2] row_mask:0xf bank_mask:0xf\n\tv_add_u32_dpp %3, %3, %3 quad_perm:[1,0,3,2] row_mask:0xf bank_mask:0xf\n\tv_add_u32_dpp %4, %4, %4 quad_perm:[1,0,3,2] row_mask:0xf bank_mask:0xf\n\tv_add_u32_dpp %5, %5, %5 quad_perm:[1,0,3,2] row_mask:0xf bank_mask:0xf\n\tv_add_u32_dpp %6, %6, %6 quad_perm:[1,0,3,2] row_mask:0xf bank_mask:0xf\n\tv_add_u32_dpp %7, %7, %7 quad_perm:[1,0,3,2] row_mask:0xf bank_mask:0xf\n\tv_add_u32_dpp %8, %8, %8 quad_perm:[1,0,3,2] row_mask:0xf bank_mask:0xf\n\tv_add_u32_dpp %9, %9, %9 quad_perm:[1,0,3,2] row_mask:0xf bank_mask:0xf\n\tv_add_u32_dpp %10, %10, %10 quad_perm:[1,0,3,2] row_mask:0xf bank_mask:0xf\n\tv_add_u32_dpp %11, %11, %11 quad_perm:[1,0,3,2] row_mask:0xf bank_mask:0xf\n\tv_add_u32_dpp %12, %12, %12 quad_perm:[1,0,3,2] row_mask:0xf bank_mask:0xf\n\tv_add_u32_dpp %13, %13, %13 quad_perm:[1,0,3,2] row_mask:0xf bank_mask:0xf\n\tv_add_u32_dpp %14, %14, %14 quad_perm:[1,0,3,2] row_mask:0xf bank_mask:0xf\n\tv_add_u32_dpp %15, %15, %15 quad_perm:[1,0,3,2] row_mask:0xf bank_mask:0xf\n\t" : "+v"(r[0]), "+v"(r[1]), "+v"(r[2]), "+v"(r[3]), "+v"(r[4]), "+v"(r[5]), "+v"(r[6]), "+v"(r[7]), "+v"(r[8]), "+v"(r[9]), "+v"(r[10]), "+v"(r[11]), "+v"(r[12]), "+v"(r[13]), "+v"(r[14]), "+v"(r[15]) : "v"(a), "v"(b) : "s40", "vcc");
#endif
#if PROBE_UB == 5
        asm volatile("v_readlane_b32 s40, %0, 5\n\tv_readlane_b32 s40, %1, 5\n\tv_readlane_b32 s40, %2, 5\n\tv_readlane_b32 s40, %3, 5\n\tv_readlane_b32 s40, %4, 5\n\tv_readlane_b32 s40, %5, 5\n\tv_readlane_b32 s40, %6, 5\n\tv_readlane_b32 s40, %7, 5\n\tv_readlane_b32 s40, %8, 5\n\tv_readlane_b32 s40, %9, 5\n\tv_readlane_b32 s40, %10, 5\n\tv_readlane_b32 s40, %11, 5\n\tv_readlane_b32 s40, %12, 5\n\tv_readlane_b32 s40, %13, 5\n\tv_readlane_b32 s40, %14, 5\n\tv_readlane_b32 s40, %15, 5\n\t" : "+v"(r[0]), "+v"(r[1]), "+v"(r[2]), "+v"(r[3]), "+v"(r[4]), "+v"(r[5]), "+v"(r[6]), "+v"(r[7]), "+v"(r[8]), "+v"(r[9]), "+v"(r[10]), "+v"(r[11]), "+v"(r[12]), "+v"(r[13]), "+v"(r[14]), "+v"(r[15]) : "v"(a), "v"(b) : "s40", "vcc");
        asm volatile("v_readlane_b32 s40, %0, 5\n\tv_readlane_b32 s40, %1, 5\n\tv_readlane_b32 s40, %2, 5\n\tv_readlane_b32 s40, %3, 5\n\tv_readlane_b32 s40, %4, 5\n\tv_readlane_b32 s40, %5, 5\n\tv_readlane_b32 s40, %6, 5\n\tv_readlane_b32 s40, %7, 5\n\tv_readlane_b32 s40, %8, 5\n\tv_readlane_b32 s40, %9, 5\n\tv_readlane_b32 s40, %10, 5\n\tv_readlane_b32 s40, %11, 5\n\tv_readlane_b32 s40, %12, 5\n\tv_readlane_b32 s40, %13, 5\n\tv_readlane_b32 s40, %14, 5\n\tv_readlane_b32 s40, %15, 5\n\t" : "+v"(r[0]), "+v"(r[1]), "+v"(r[2]), "+v"(r[3]), "+v"(r[4]), "+v"(r[5]), "+v"(r[6]), "+v"(r[7]), "+v"(r[8]), "+v"(r[9]), "+v"(r[10]), "+v"(r[11]), "+v"(r[12]), "+v"(r[13]), "+v"(r[14]), "+v"(r[15]) : "v"(a), "v"(b) : "s40", "vcc");
#endif
#if PROBE_UB == 6
        asm volatile("v_cvt_pk_f32_fp8 %0, %16\n\tv_cvt_pk_f32_fp8 %1, %16\n\tv_cvt_pk_f32_fp8 %2, %16\n\tv_cvt_pk_f32_fp8 %3, %16\n\tv_cvt_pk_f32_fp8 %4, %16\n\tv_cvt_pk_f32_fp8 %5, %16\n\tv_cvt_pk_f32_fp8 %6, %16\n\tv_cvt_pk_f32_fp8 %7, %16\n\t" : "+v"(r2[0]), "+v"(r2[1]), "+v"(r2[2]), "+v"(r2[3]), "+v"(r2[4]), "+v"(r2[5]), "+v"(r2[6]), "+v"(r2[7]), "+v"(r[8]), "+v"(r[9]), "+v"(r[10]), "+v"(r[11]), "+v"(r[12]), "+v"(r[13]), "+v"(r[14]), "+v"(r[15]) : "v"(a), "v"(b) : "s40", "vcc");
        asm volatile("v_cvt_pk_f32_fp8 %0, %16\n\tv_cvt_pk_f32_fp8 %1, %16\n\tv_cvt_pk_f32_fp8 %2, %16\n\tv_cvt_pk_f32_fp8 %3, %16\n\tv_cvt_pk_f32_fp8 %4, %16\n\tv_cvt_pk_f32_fp8 %5, %16\n\tv_cvt_pk_f32_fp8 %6, %16\n\tv_cvt_pk_f32_fp8 %7, %16\n\t" : "+v"(r2[0]), "+v"(r2[1]), "+v"(r2[2]), "+v"(r2[3]), "+v"(r2[4]), "+v"(r2[5]), "+v"(r2[6]), "+v"(r2[7]), "+v"(r[8]), "+v"(r[9]), "+v"(r[10]), "+v"(r[11]), "+v"(r[12]), "+v"(r[13]), "+v"(r[14]), "+v"(r[15]) : "v"(a), "v"(b) : "s40", "vcc");
        asm volatile("v_cvt_pk_f32_fp8 %0, %16\n\tv_cvt_pk_f32_fp8 %1, %16\n\tv_cvt_pk_f32_fp8 %2, %16\n\tv_cvt_pk_f32_fp8 %3, %16\n\tv_cvt_pk_f32_fp8 %4, %16\n\tv_cvt_pk_f32_fp8 %5, %16\n\tv_cvt_pk_f32_fp8 %6, %16\n\tv_cvt_pk_f32_fp8 %7, %16\n\t" : "+v"(r2[0]), "+v"(r2[1]), "+v"(r2[2]), "+v"(r2[3]), "+v"(r2[4]), "+v"(r2[5]), "+v"(r2[6]), "+v"(r2[7]), "+v"(r[8]), "+v"(r[9]), "+v"(r[10]), "+v"(r[11]), "+v"(r[12]), "+v"(r[13]), "+v"(r[14]), "+v"(r[15]) : "v"(a), "v"(b) : "s40", "vcc");
        asm volatile("v_cvt_pk_f32_fp8 %0, %16\n\tv_cvt_pk_f32_fp8 %1, %16\n\tv_cvt_pk_f32_fp8 %2, %16\n\tv_cvt_pk_f32_fp8 %3, %16\n\tv_cvt_pk_f32_fp8 %4, %16\n\tv_cvt_pk_f32_fp8 %5, %16\n\tv_cvt_pk_f32_fp8 %6, %16\n\tv_cvt_pk_f32_fp8 %7, %16\n\t" : "+v"(r2[0]), "+v"(r2[1]), "+v"(r2[2]), "+v"(r2[3]), "+v"(r2[4]), "+v"(r2[5]), "+v"(r2[6]), "+v"(r2[7]), "+v"(r[8]), "+v"(r[9]), "+v"(r[10]), "+v"(r[11]), "+v"(r[12]), "+v"(r[13]), "+v"(r[14]), "+v"(r[15]) : "v"(a), "v"(b) : "s40", "vcc");
#endif
#if PROBE_UB == 7
        asm volatile("v_pk_fma_f32 %0, %0, %0, %0\n\tv_pk_fma_f32 %1, %1, %1, %1\n\tv_pk_fma_f32 %2, %2, %2, %2\n\tv_pk_fma_f32 %3, %3, %3, %3\n\tv_pk_fma_f32 %4, %4, %4, %4\n\tv_pk_fma_f32 %5, %5, %5, %5\n\tv_pk_fma_f32 %6, %6, %6, %6\n\tv_pk_fma_f32 %7, %7, %7, %7\n\t" : "+v"(r2[0]), "+v"(r2[1]), "+v"(r2[2]), "+v"(r2[3]), "+v"(r2[4]), "+v"(r2[5]), "+v"(r2[6]), "+v"(r2[7]), "+v"(r[8]), "+v"(r[9]), "+v"(r[10]), "+v"(r[11]), "+v"(r[12]), "+v"(r[13]), "+v"(r[14]), "+v"(r[15]) : "v"(a), "v"(b) : "s40", "vcc");
        asm volatile("v_pk_fma_f32 %0, %0, %0, %0\n\tv_pk_fma_f32 %1, %1, %1, %1\n\tv_pk_fma_f32 %2, %2, %2, %2\n\tv_pk_fma_f32 %3, %3, %3, %3\n\tv_pk_fma_f32 %4, %4, %4, %4\n\tv_pk_fma_f32 %5, %5, %5, %5\n\tv_pk_fma_f32 %6, %6, %6, %6\n\tv_pk_fma_f32 %7, %7, %7, %7\n\t" : "+v"(r2[0]), "+v"(r2[1]), "+v"(r2[2]), "+v"(r2[3]), "+v"(r2[4]), "+v"(r2[5]), "+v"(r2[6]), "+v"(r2[7]), "+v"(r[8]), "+v"(r[9]), "+v"(r[10]), "+v"(r[11]), "+v"(r[12]), "+v"(r[13]), "+v"(r[14]), "+v"(r[15]) : "v"(a), "v"(b) : "s40", "vcc");
        asm volatile("v_pk_fma_f32 %0, %0, %0, %0\n\tv_pk_fma_f32 %1, %1, %1, %1\n\tv_pk_fma_f32 %2, %2, %2, %2\n\tv_pk_fma_f32 %3, %3, %3, %3\n\tv_pk_fma_f32 %4, %4, %4, %4\n\tv_pk_fma_f32 %5, %5, %5, %5\n\tv_pk_fma_f32 %6, %6, %6, %6\n\tv_pk_fma_f32 %7, %7, %7, %7\n\t" : "+v"(r2[0]), "+v"(r2[1]), "+v"(r2[2]), "+v"(r2[3]), "+v"(r2[4]), "+v"(r2[5]), "+v"(r2[6]), "+v"(r2[7]), "+v"(r[8]), "+v"(r[9]), "+v"(r[10]), "+v"(r[11]), "+v"(r[12]), "+v"(r[13]), "+v"(r[14]), "+v"(r[15]) : "v"(a), "v"(b) : "s40", "vcc");
        asm volatile("v_pk_fma_f32 %0, %0, %0, %0\n\tv_pk_fma_f32 %1, %1, %1, %1\n\tv_pk_fma_f32 %2, %2, %2, %2\n\tv_pk_fma_f32 %3, %3, %3, %3\n\tv_pk_fma_f32 %4, %4, %4, %4\n\tv_pk_fma_f32 %5, %5, %5, %5\n\tv_pk_fma_f32 %6, %6, %6, %6\n\tv_pk_fma_f32 %7, %7, %7, %7\n\t" : "+v"(r2[0]), "+v"(r2[1]), "+v"(r2[2]), "+v"(r2[3]), "+v"(r2[4]), "+v"(r2[5]), "+v"(r2[6]), "+v"(r2[7]), "+v"(r[8]), "+v"(r[9]), "+v"(r[10]), "+v"(r[11]), "+v"(r[12]), "+v"(r[13]), "+v"(r[14]), "+v"(r[15]) : "v"(a), "v"(b) : "s40", "vcc");
#endif
#if PROBE_UB == 8
        asm volatile("v_dot2c_f32_bf16 %0, %16, %17\n\tv_dot2c_f32_bf16 %1, %16, %17\n\tv_dot2c_f32_bf16 %2, %16, %17\n\tv_dot2c_f32_bf16 %3, %16, %17\n\tv_dot2c_f32_bf16 %4, %16, %17\n\tv_dot2c_f32_bf16 %5, %16, %17\n\tv_dot2c_f32_bf16 %6, %16, %17\n\tv_dot2c_f32_bf16 %7, %16, %17\n\tv_dot2c_f32_bf16 %8, %16, %17\n\tv_dot2c_f32_bf16 %9, %16, %17\n\tv_dot2c_f32_bf16 %10, %16, %17\n\tv_dot2c_f32_bf16 %11, %16, %17\n\tv_dot2c_f32_bf16 %12, %16, %17\n\tv_dot2c_f32_bf16 %13, %16, %17\n\tv_dot2c_f32_bf16 %14, %16, %17\n\tv_dot2c_f32_bf16 %15, %16, %17\n\t" : "+v"(r[0]), "+v"(r[1]), "+v"(r[2]), "+v"(r[3]), "+v"(r[4]), "+v"(r[5]), "+v"(r[6]), "+v"(r[7]), "+v"(r[8]), "+v"(r[9]), "+v"(r[10]), "+v"(r[11]), "+v"(r[12]), "+v"(r[13]), "+v"(r[14]), "+v"(r[15]) : "v"(a), "v"(b) : "s40", "vcc");
        asm volatile("v_dot2c_f32_bf16 %0, %16, %17\n\tv_dot2c_f32_bf16 %1, %16, %17\n\tv_dot2c_f32_bf16 %2, %16, %17\n\tv_dot2c_f32_bf16 %3, %16, %17\n\tv_dot2c_f32_bf16 %4, %16, %17\n\tv_dot2c_f32_bf16 %5, %16, %17\n\tv_dot2c_f32_bf16 %6, %16, %17\n\tv_dot2c_f32_bf16 %7, %16, %17\n\tv_dot2c_f32_bf16 %8, %16, %17\n\tv_dot2c_f32_bf16 %9, %16, %17\n\tv_dot2c_f32_bf16 %10, %16, %17\n\tv_dot2c_f32_bf16 %11, %16, %17\n\tv_dot2c_f32_bf16 %12, %16, %17\n\tv_dot2c_f32_bf16 %13, %16, %17\n\tv_dot2c_f32_bf16 %14, %16, %17\n\tv_dot2c_f32_bf16 %15, %16, %17\n\t" : "+v"(r[0]), "+v"(r[1]), "+v"(r[2]), "+v"(r[3]), "+v"(r[4]), "+v"(r[5]), "+v"(r[6]), "+v"(r[7]), "+v"(r[8]), "+v"(r[9]), "+v"(r[10]), "+v"(r[11]), "+v"(r[12]), "+v"(r[13]), "+v"(r[14]), "+v"(r[15]) : "v"(a), "v"(b) : "s40", "vcc");
#endif
#if PROBE_UB == 9
        asm volatile("v_cndmask_b32 %0, %0, %16, vcc\n\tv_cndmask_b32 %1, %1, %16, vcc\n\tv_cndmask_b32 %2, %2, %16, vcc\n\tv_cndmask_b32 %3, %3, %16, vcc\n\tv_cndmask_b32 %4, %4, %16, vcc\n\tv_cndmask_b32 %5, %5, %16, vcc\n\tv_cndmask_b32 %6, %6, %16, vcc\n\tv_cndmask_b32 %7, %7, %16, vcc\n\tv_cndmask_b32 %8, %8, %16, vcc\n\tv_cndmask_b32 %9, %9, %16, vcc\n\tv_cndmask_b32 %10, %10, %16, vcc\n\tv_cndmask_b32 %11, %11, %16, vcc\n\tv_cndmask_b32 %12, %12, %16, vcc\n\tv_cndmask_b32 %13, %13, %16, vcc\n\tv_cndmask_b32 %14, %14, %16, vcc\n\tv_cndmask_b32 %15, %15, %16, vcc\n\t" : "+v"(r[0]), "+v"(r[1]), "+v"(r[2]), "+v"(r[3]), "+v"(r[4]), "+v"(r[5]), "+v"(r[6]), "+v"(r[7]), "+v"(r[8]), "+v"(r[9]), "+v"(r[10]), "+v"(r[11]), "+v"(r[12]), "+v"(r[13]), "+v"(r[14]), "+v"(r[15]) : "v"(a), "v"(b) : "s40", "vcc");
        asm volatile("v_cndmask_b32 %0, %0, %16, vcc\n\tv_cndmask_b32 %1, %1, %16, vcc\n\tv_cndmask_b32 %2, %2, %16, vcc\n\tv_cndmask_b32 %3, %3, %16, vcc\n\tv_cndmask_b32 %4, %4, %16, vcc\n\tv_cndmask_b32 %5, %5, %16, vcc\n\tv_cndmask_b32 %6, %6, %16, vcc\n\tv_cndmask_b32 %7, %7, %16, vcc\n\tv_cndmask_b32 %8, %8, %16, vcc\n\tv_cndmask_b32 %9, %9, %16, vcc\n\tv_cndmask_b32 %10, %10, %16, vcc\n\tv_cndmask_b32 %11, %11, %16, vcc\n\tv_cndmask_b32 %12, %12, %16, vcc\n\tv_cndmask_b32 %13, %13, %16, vcc\n\tv_cndmask_b32 %14, %14, %16, vcc\n\tv_cndmask_b32 %15, %15, %16, vcc\n\t" : "+v"(r[0]), "+v"(r[1]), "+v"(r[2]), "+v"(r[3]), "+v"(r[4]), "+v"(r[5]), "+v"(r[6]), "+v"(r[7]), "+v"(r[8]), "+v"(r[9]), "+v"(r[10]), "+v"(r[11]), "+v"(r[12]), "+v"(r[13]), "+v"(r[14]), "+v"(r[15]) : "v"(a), "v"(b) : "s40", "vcc");
#endif
#if PROBE_UB == 10
        asm volatile("v_max_i32 %0, %0, %16\n\tv_max_i32 %1, %1, %16\n\tv_max_i32 %2, %2, %16\n\tv_max_i32 %3, %3, %16\n\tv_max_i32 %4, %4, %16\n\tv_max_i32 %5, %5, %16\n\tv_max_i32 %6, %6, %16\n\tv_max_i32 %7, %7, %16\n\tv_max_i32 %8, %8, %16\n\tv_max_i32 %9, %9, %16\n\tv_max_i32 %10, %10, %16\n\tv_max_i32 %11, %11, %16\n\tv_max_i32 %12, %12, %16\n\tv_max_i32 %13, %13, %16\n\tv_max_i32 %14, %14, %16\n\tv_max_i32 %15, %15, %16\n\t" : "+v"(r[0]), "+v"(r[1]), "+v"(r[2]), "+v"(r[3]), "+v"(r[4]), "+v"(r[5]), "+v"(r[6]), "+v"(r[7]), "+v"(r[8]), "+v"(r[9]), "+v"(r[10]), "+v"(r[11]), "+v"(r[12]), "+v"(r[13]), "+v"(r[14]), "+v"(r[15]) : "v"(a), "v"(b) : "s40", "vcc");
        asm volatile("v_max_i32 %0, %0, %16\n\tv_max_i32 %1, %1, %16\n\tv_max_i32 %2, %2, %16\n\tv_max_i32 %3, %3, %16\n\tv_max_i32 %4, %4, %16\n\tv_max_i32 %5, %5, %16\n\tv_max_i32 %6, %6, %16\n\tv_max_i32 %7, %7, %16\n\tv_max_i32 %8, %8, %16\n\tv_max_i32 %9, %9, %16\n\tv_max_i32 %10, %10, %16\n\tv_max_i32 %11, %11, %16\n\tv_max_i32 %12, %12, %16\n\tv_max_i32 %13, %13, %16\n\tv_max_i32 %14, %14, %16\n\tv_max_i32 %15, %15, %16\n\t" : "+v"(r[0]), "+v"(r[1]), "+v"(r[2]), "+v"(r[3]), "+v"(r[4]), "+v"(r[5]), "+v"(r[6]), "+v"(r[7]), "+v"(r[8]), "+v"(r[9]), "+v"(r[10]), "+v"(r[11]), "+v"(r[12]), "+v"(r[13]), "+v"(r[14]), "+v"(r[15]) : "v"(a), "v"(b) : "s40", "vcc");
#endif
#if PROBE_UB == 11
        asm volatile("v_exp_f32 %0, %0\n\tv_exp_f32 %1, %1\n\tv_exp_f32 %2, %2\n\tv_exp_f32 %3, %3\n\tv_exp_f32 %4, %4\n\tv_exp_f32 %5, %5\n\tv_exp_f32 %6, %6\n\tv_exp_f32 %7, %7\n\tv_exp_f32 %8, %8\n\tv_exp_f32 %9, %9\n\tv_exp_f32 %10, %10\n\tv_exp_f32 %11, %11\n\tv_exp_f32 %12, %12\n\tv_exp_f32 %13, %13\n\tv_exp_f32 %14, %14\n\tv_exp_f32 %15, %15\n\t" : "+v"(r[0]), "+v"(r[1]), "+v"(r[2]), "+v"(r[3]), "+v"(r[4]), "+v"(r[5]), "+v"(r[6]), "+v"(r[7]), "+v"(r[8]), "+v"(r[9]), "+v"(r[10]), "+v"(r[11]), "+v"(r[12]), "+v"(r[13]), "+v"(r[14]), "+v"(r[15]) : "v"(a), "v"(b) : "s40", "vcc");
        asm volatile("v_exp_f32 %0, %0\n\tv_exp_f32 %1, %1\n\tv_exp_f32 %2, %2\n\tv_exp_f32 %3, %3\n\tv_exp_f32 %4, %4\n\tv_exp_f32 %5, %5\n\tv_exp_f32 %6, %6\n\tv_exp_f32 %7, %7\n\tv_exp_f32 %8, %8\n\tv_exp_f32 %9, %9\n\tv_exp_f32 %10, %10\n\tv_exp_f32 %11, %11\n\tv_exp_f32 %12, %12\n\tv_exp_f32 %13, %13\n\tv_exp_f32 %14, %14\n\tv_exp_f32 %15, %15\n\t" : "+v"(r[0]), "+v"(r[1]), "+v"(r[2]), "+v"(r[3]), "+v"(r[4]), "+v"(r[5]), "+v"(r[6]), "+v"(r[7]), "+v"(r[8]), "+v"(r[9]), "+v"(r[10]), "+v"(r[11]), "+v"(r[12]), "+v"(r[13]), "+v"(r[14]), "+v"(r[15]) : "v"(a), "v"(b) : "s40", "vcc");
#endif
#if PROBE_UB == 12
        asm volatile("v_fmac_f32 %0, %16, %17\n\tv_fmac_f32 %1, %16, %17\n\tv_fmac_f32 %2, %16, %17\n\tv_fmac_f32 %3, %16, %17\n\tv_fmac_f32 %4, %16, %17\n\tv_fmac_f32 %5, %16, %17\n\tv_fmac_f32 %6, %16, %17\n\tv_fmac_f32 %7, %16, %17\n\tv_fmac_f32 %8, %16, %17\n\tv_fmac_f32 %9, %16, %17\n\tv_fmac_f32 %10, %16, %17\n\tv_fmac_f32 %11, %16, %17\n\tv_fmac_f32 %12, %16, %17\n\tv_fmac_f32 %13, %16, %17\n\tv_fmac_f32 %14, %16, %17\n\tv_fmac_f32 %15, %16, %17\n\t" : "+v"(r[0]), "+v"(r[1]), "+v"(r[2]), "+v"(r[3]), "+v"(r[4]), "+v"(r[5]), "+v"(r[6]), "+v"(r[7]), "+v"(r[8]), "+v"(r[9]), "+v"(r[10]), "+v"(r[11]), "+v"(r[12]), "+v"(r[13]), "+v"(r[14]), "+v"(r[15]) : "v"(a), "v"(b) : "s40", "vcc");
        asm volatile("v_fmac_f32 %0, %16, %17\n\tv_fmac_f32 %1, %16, %17\n\tv_fmac_f32 %2, %16, %17\n\tv_fmac_f32 %3, %16, %17\n\tv_fmac_f32 %4, %16, %17\n\tv_fmac_f32 %5, %16, %17\n\tv_fmac_f32 %6, %16, %17\n\tv_fmac_f32 %7, %16, %17\n\tv_fmac_f32 %8, %16, %17\n\tv_fmac_f32 %9, %16, %17\n\tv_fmac_f32 %10, %16, %17\n\tv_fmac_f32 %11, %16, %17\n\tv_fmac_f32 %12, %16, %17\n\tv_fmac_f32 %13, %16, %17\n\tv_fmac_f32 %14, %16, %17\n\tv_fmac_f32 %15, %16, %17\n\t" : "+v"(r[0]), "+v"(r[1]), "+v"(r[2]), "+v"(r[3]), "+v"(r[4]), "+v"(r[5]), "+v"(r[6]), "+v"(r[7]), "+v"(r[8]), "+v"(r[9]), "+v"(r[10]), "+v"(r[11]), "+v"(r[12]), "+v"(r[13]), "+v"(r[14]), "+v"(r[15]) : "v"(a), "v"(b) : "s40", "vcc");
#endif
#if PROBE_UB == 13
        asm volatile("v_add_u32_dpp %0, %16, %0 quad_perm:[1,0,3,2] row_mask:0xf bank_mask:0xf\n\tv_add_u32_dpp %1, %16, %1 quad_perm:[1,0,3,2] row_mask:0xf bank_mask:0xf\n\tv_add_u32_dpp %2, %16, %2 quad_perm:[1,0,3,2] row_mask:0xf bank_mask:0xf\n\tv_add_u32_dpp %3, %16, %3 quad_perm:[1,0,3,2] row_mask:0xf bank_mask:0xf\n\tv_add_u32_dpp %4, %16, %4 quad_perm:[1,0,3,2] row_mask:0xf bank_mask:0xf\n\tv_add_u32_dpp %5, %16, %5 quad_perm:[1,0,3,2] row_mask:0xf bank_mask:0xf\n\tv_add_u32_dpp %6, %16, %6 quad_perm:[1,0,3,2] row_mask:0xf bank_mask:0xf\n\tv_add_u32_dpp %7, %16, %7 quad_perm:[1,0,3,2] row_mask:0xf bank_mask:0xf\n\tv_add_u32_dpp %8, %16, %8 quad_perm:[1,0,3,2] row_mask:0xf bank_mask:0xf\n\tv_add_u32_dpp %9, %16, %9 quad_perm:[1,0,3,2] row_mask:0xf bank_mask:0xf\n\tv_add_u32_dpp %10, %16, %10 quad_perm:[1,0,3,2] row_mask:0xf bank_mask:0xf\n\tv_add_u32_dpp %11, %16, %11 quad_perm:[1,0,3,2] row_mask:0xf bank_mask:0xf\n\tv_add_u32_dpp %12, %16, %12 quad_perm:[1,0,3,2] row_mask:0xf bank_mask:0xf\n\tv_add_u32_dpp %13, %16, %13 quad_perm:[1,0,3,2] row_mask:0xf bank_mask:0xf\n\tv_add_u32_dpp %14, %16, %14 quad_perm:[1,0,3,2] row_mask:0xf bank_mask:0xf\n\tv_add_u32_dpp %15, %16, %15 quad_perm:[1,0,3,2] row_mask:0xf bank_mask:0xf\n\t" : "+v"(r[0]), "+v"(r[1]), "+v"(r[2]), "+v"(r[3]), "+v"(r[4]), "+v"(r[5]), "+v"(r[6]), "+v"(r[7]), "+v"(r[8]), "+v"(r[9]), "+v"(r[10]), "+v"(r[11]), "+v"(r[12]), "+v"(r[13]), "+v"(r[14]), "+v"(r[15]) : "v"(a), "v"(b) : "s40", "vcc");
        asm volatile("v_add_u32_dpp %0, %16, %0 quad_perm:[1,0,3,2] row_mask:0xf bank_mask:0xf\n\tv_add_u32_dpp %1, %16, %1 quad_perm:[1,0,3,2] row_mask:0xf bank_mask:0xf\n\tv_add_u32_dpp %2, %16, %2 quad_perm:[1,0,3,2] row_mask:0xf bank_mask:0xf\n\tv_add_u32_dpp %3, %16, %3 quad_perm:[1,0,3,2] row_mask:0xf bank_mask:0xf\n\tv_add_u32_dpp %4, %16, %4 quad_perm:[1,0,3,2] row_mask:0xf bank_mask:0xf\n\tv_add_u32_dpp %5, %16, %5 quad_perm:[1,0,3,2] row_mask:0xf bank_mask:0xf\n\tv_add_u32_dpp %6, %16, %6 quad_perm:[1,0,3,2] row_mask:0xf bank_mask:0xf\n\tv_add_u32_dpp %7, %16, %7 quad_perm:[1,0,3,2] row_mask:0xf bank_mask:0xf\n\tv_add_u32_dpp %8, %16, %8 quad_perm:[1,0,3,2] row_mask:0xf bank_mask:0xf\n\tv_add_u32_dpp %9, %16, %9 quad_perm:[1,0,3,2] row_mask:0xf bank_mask:0xf\n\tv_add_u32_dpp %10, %16, %10 quad_perm:[1,0,3,2] row_mask:0xf bank_mask:0xf\n\tv_add_u32_dpp %11, %16, %11 quad_perm:[1,0,3,2] row_mask:0xf bank_mask:0xf\n\tv_add_u32_dpp %12, %16, %12 quad_perm:[1,0,3,2] row_mask:0xf bank_mask:0xf\n\tv_add_u32_dpp %13, %16, %13 quad_perm:[1,0,3,2] row_mask:0xf bank_mask:0xf\n\tv_add_u32_dpp %14, %16, %14 quad_perm:[1,0,3,2] row_mask:0xf bank_mask:0xf\n\tv_add_u32_dpp %15, %16, %15 quad_perm:[1,0,3,2] row_mask:0xf bank_mask:0xf\n\t" : "+v"(r[0]), "+v"(r[1]), "+v"(r[2]), "+v"(r[3]), "+v"(r[4]), "+v"(r[5]), "+v"(r[6]), "+v"(r[7]), "+v"(r[8]), "+v"(r[9]), "+v"(r[10]), "+v"(r[11]), "+v"(r[12]), "+v"(r[13]), "+v"(r[14]), "+v"(r[15]) : "v"(a), "v"(b) : "s40", "vcc");
#endif
#if PROBE_UB == 14
        asm volatile("v_cvt_f32_ubyte1 %0, %16\n\tv_cvt_f32_ubyte1 %1, %16\n\tv_cvt_f32_ubyte1 %2, %16\n\tv_cvt_f32_ubyte1 %3, %16\n\tv_cvt_f32_ubyte1 %4, %16\n\tv_cvt_f32_ubyte1 %5, %16\n\tv_cvt_f32_ubyte1 %6, %16\n\tv_cvt_f32_ubyte1 %7, %16\n\tv_cvt_f32_ubyte1 %8, %16\n\tv_cvt_f32_ubyte1 %9, %16\n\tv_cvt_f32_ubyte1 %10, %16\n\tv_cvt_f32_ubyte1 %11, %16\n\tv_cvt_f32_ubyte1 %12, %16\n\tv_cvt_f32_ubyte1 %13, %16\n\tv_cvt_f32_ubyte1 %14, %16\n\tv_cvt_f32_ubyte1 %15, %16\n\t" : "+v"(r[0]), "+v"(r[1]), "+v"(r[2]), "+v"(r[3]), "+v"(r[4]), "+v"(r[5]), "+v"(r[6]), "+v"(r[7]), "+v"(r[8]), "+v"(r[9]), "+v"(r[10]), "+v"(r[11]), "+v"(r[12]), "+v"(r[13]), "+v"(r[14]), "+v"(r[15]) : "v"(a), "v"(b) : "s40", "vcc");
        asm volatile("v_cvt_f32_ubyte1 %0, %16\n\tv_cvt_f32_ubyte1 %1, %16\n\tv_cvt_f32_ubyte1 %2, %16\n\tv_cvt_f32_ubyte1 %3, %16\n\tv_cvt_f32_ubyte1 %4, %16\n\tv_cvt_f32_ubyte1 %5, %16\n\tv_cvt_f32_ubyte1 %6, %16\n\tv_cvt_f32_ubyte1 %7, %16\n\tv_cvt_f32_ubyte1 %8, %16\n\tv_cvt_f32_ubyte1 %9, %16\n\tv_cvt_f32_ubyte1 %10, %16\n\tv_cvt_f32_ubyte1 %11, %16\n\tv_cvt_f32_ubyte1 %12, %16\n\tv_cvt_f32_ubyte1 %13, %16\n\tv_cvt_f32_ubyte1 %14, %16\n\tv_cvt_f32_ubyte1 %15, %16\n\t" : "+v"(r[0]), "+v"(r[1]), "+v"(r[2]), "+v"(r[3]), "+v"(r[4]), "+v"(r[5]), "+v"(r[6]), "+v"(r[7]), "+v"(r[8]), "+v"(r[9]), "+v"(r[10]), "+v"(r[11]), "+v"(r[12]), "+v"(r[13]), "+v"(r[14]), "+v"(r[15]) : "v"(a), "v"(b) : "s40", "vcc");
#endif
#if PROBE_UB == 16
        asm volatile("v_max_f32 %0, %0, %16\n\tv_max_f32 %1, %1, %16\n\tv_max_f32 %2, %2, %16\n\tv_max_f32 %3, %3, %16\n\tv_max_f32 %4, %4, %16\n\tv_max_f32 %5, %5, %16\n\tv_max_f32 %6, %6, %16\n\tv_max_f32 %7, %7, %16\n\tv_max_f32 %8, %8, %16\n\tv_max_f32 %9, %9, %16\n\tv_max_f32 %10, %10, %16\n\tv_max_f32 %11, %11, %16\n\tv_max_f32 %12, %12, %16\n\tv_max_f32 %13, %13, %16\n\tv_max_f32 %14, %14, %16\n\tv_max_f32 %15, %15, %16\n\t" : "+v"(r[0]), "+v"(r[1]), "+v"(r[2]), "+v"(r[3]), "+v"(r[4]), "+v"(r[5]), "+v"(r[6]), "+v"(r[7]), "+v"(r[8]), "+v"(r[9]), "+v"(r[10]), "+v"(r[11]), "+v"(r[12]), "+v"(r[13]), "+v"(r[14]), "+v"(r[15]) : "v"(a), "v"(b) : "s40", "s41", "vcc");
        asm volatile("v_max_f32 %0, %0, %16\n\tv_max_f32 %1, %1, %16\n\tv_max_f32 %2, %2, %16\n\tv_max_f32 %3, %3, %16\n\tv_max_f32 %4, %4, %16\n\tv_max_f32 %5, %5, %16\n\tv_max_f32 %6, %6, %16\n\tv_max_f32 %7, %7, %16\n\tv_max_f32 %8, %8, %16\n\tv_max_f32 %9, %9, %16\n\tv_max_f32 %10, %10, %16\n\tv_max_f32 %11, %11, %16\n\tv_max_f32 %12, %12, %16\n\tv_max_f32 %13, %13, %16\n\tv_max_f32 %14, %14, %16\n\tv_max_f32 %15, %15, %16\n\t" : "+v"(r[0]), "+v"(r[1]), "+v"(r[2]), "+v"(r[3]), "+v"(r[4]), "+v"(r[5]), "+v"(r[6]), "+v"(r[7]), "+v"(r[8]), "+v"(r[9]), "+v"(r[10]), "+v"(r[11]), "+v"(r[12]), "+v"(r[13]), "+v"(r[14]), "+v"(r[15]) : "v"(a), "v"(b) : "s40", "s41", "vcc");
#endif
#if PROBE_UB == 17
        asm volatile("v_cndmask_b32 %0, %0, %16, s[40:41]\n\tv_cndmask_b32 %1, %1, %16, s[40:41]\n\tv_cndmask_b32 %2, %2, %16, s[40:41]\n\tv_cndmask_b32 %3, %3, %16, s[40:41]\n\tv_cndmask_b32 %4, %4, %16, s[40:41]\n\tv_cndmask_b32 %5, %5, %16, s[40:41]\n\tv_cndmask_b32 %6, %6, %16, s[40:41]\n\tv_cndmask_b32 %7, %7, %16, s[40:41]\n\tv_cndmask_b32 %8, %8, %16, s[40:41]\n\tv_cndmask_b32 %9, %9, %16, s[40:41]\n\tv_cndmask_b32 %10, %10, %16, s[40:41]\n\tv_cndmask_b32 %11, %11, %16, s[40:41]\n\tv_cndmask_b32 %12, %12, %16, s[40:41]\n\tv_cndmask_b32 %13, %13, %16, s[40:41]\n\tv_cndmask_b32 %14, %14, %16, s[40:41]\n\tv_cndmask_b32 %15, %15, %16, s[40:41]\n\t" : "+v"(r[0]), "+v"(r[1]), "+v"(r[2]), "+v"(r[3]), "+v"(r[4]), "+v"(r[5]), "+v"(r[6]), "+v"(r[7]), "+v"(r[8]), "+v"(r[9]), "+v"(r[10]), "+v"(r[11]), "+v"(r[12]), "+v"(r[13]), "+v"(r[14]), "+v"(r[15]) : "v"(a), "v"(b) : "s40", "s41", "vcc");
        asm volatile("v_cndmask_b32 %0, %0, %16, s[40:41]\n\tv_cndmask_b32 %1, %1, %16, s[40:41]\n\tv_cndmask_b32 %2, %2, %16, s[40:41]\n\tv_cndmask_b32 %3, %3, %16, s[40:41]\n\tv_cndmask_b32 %4, %4, %16, s[40:41]\n\tv_cndmask_b32 %5, %5, %16, s[40:41]\n\tv_cndmask_b32 %6, %6, %16, s[40:41]\n\tv_cndmask_b32 %7, %7, %16, s[40:41]\n\tv_cndmask_b32 %8, %8, %16, s[40:41]\n\tv_cndmask_b32 %9, %9, %16, s[40:41]\n\tv_cndmask_b32 %10, %10, %16, s[40:41]\n\tv_cndmask_b32 %11, %11, %16, s[40:41]\n\tv_cndmask_b32 %12, %12, %16, s[40:41]\n\tv_cndmask_b32 %13, %13, %16, s[40:41]\n\tv_cndmask_b32 %14, %14, %16, s[40:41]\n\tv_cndmask_b32 %15, %15, %16, s[40:41]\n\t" : "+v"(r[0]), "+v"(r[1]), "+v"(r[2]), "+v"(r[3]), "+v"(r[4]), "+v"(r[5]), "+v"(r[6]), "+v"(r[7]), "+v"(r[8]), "+v"(r[9]), "+v"(r[10]), "+v"(r[11]), "+v"(r[12]), "+v"(r[13]), "+v"(r[14]), "+v"(r[15]) : "v"(a), "v"(b) : "s40", "s41", "vcc");
#endif
#if PROBE_UB == 18
        asm volatile("v_min_u32 %0, %0, %16\n\tv_min_u32 %1, %1, %16\n\tv_min_u32 %2, %2, %16\n\tv_min_u32 %3, %3, %16\n\tv_min_u32 %4, %4, %16\n\tv_min_u32 %5, %5, %16\n\tv_min_u32 %6, %6, %16\n\tv_min_u32 %7, %7, %16\n\tv_min_u32 %8, %8, %16\n\tv_min_u32 %9, %9, %16\n\tv_min_u32 %10, %10, %16\n\tv_min_u32 %11, %11, %16\n\tv_min_u32 %12, %12, %16\n\tv_min_u32 %13, %13, %16\n\tv_min_u32 %14, %14, %16\n\tv_min_u32 %15, %15, %16\n\t" : "+v"(r[0]), "+v"(r[1]), "+v"(r[2]), "+v"(r[3]), "+v"(r[4]), "+v"(r[5]), "+v"(r[6]), "+v"(r[7]), "+v"(r[8]), "+v"(r[9]), "+v"(r[10]), "+v"(r[11]), "+v"(r[12]), "+v"(r[13]), "+v"(r[14]), "+v"(r[15]) : "v"(a), "v"(b) : "s40", "s41", "vcc");
        asm volatile("v_min_u32 %0, %0, %16\n\tv_min_u32 %1, %1, %16\n\tv_min_u32 %2, %2, %16\n\tv_min_u32 %3, %3, %16\n\tv_min_u32 %4, %4, %16\n\tv_min_u32 %5, %5, %16\n\tv_min_u32 %6, %6, %16\n\tv_min_u32 %7, %7, %16\n\tv_min_u32 %8, %8, %16\n\tv_min_u32 %9, %9, %16\n\tv_min_u32 %10, %10, %16\n\tv_min_u32 %11, %11, %16\n\tv_min_u32 %12, %12, %16\n\tv_min_u32 %13, %13, %16\n\tv_min_u32 %14, %14, %16\n\tv_min_u32 %15, %15, %16\n\t" : "+v"(r[0]), "+v"(r[1]), "+v"(r[2]), "+v"(r[3]), "+v"(r[4]), "+v"(r[5]), "+v"(r[6]), "+v"(r[7]), "+v"(r[8]), "+v"(r[9]), "+v"(r[10]), "+v"(r[11]), "+v"(r[12]), "+v"(r[13]), "+v"(r[14]), "+v"(r[15]) : "v"(a), "v"(b) : "s40", "s41", "vcc");
#endif
#if PROBE_UB == 19
        asm volatile("v_and_b32 %0, %0, %16\n\tv_and_b32 %1, %1, %16\n\tv_and_b32 %2, %2, %16\n\tv_and_b32 %3, %3, %16\n\tv_and_b32 %4, %4, %16\n\tv_and_b32 %5, %5, %16\n\tv_and_b32 %6, %6, %16\n\tv_and_b32 %7, %7, %16\n\tv_and_b32 %8, %8, %16\n\tv_and_b32 %9, %9, %16\n\tv_and_b32 %10, %10, %16\n\tv_and_b32 %11, %11, %16\n\tv_and_b32 %12, %12, %16\n\tv_and_b32 %13, %13, %16\n\tv_and_b32 %14, %14, %16\n\tv_and_b32 %15, %15, %16\n\t" : "+v"(r[0]), "+v"(r[1]), "+v"(r[2]), "+v"(r[3]), "+v"(r[4]), "+v"(r[5]), "+v"(r[6]), "+v"(r[7]), "+v"(r[8]), "+v"(r[9]), "+v"(r[10]), "+v"(r[11]), "+v"(r[12]), "+v"(r[13]), "+v"(r[14]), "+v"(r[15]) : "v"(a), "v"(b) : "s40", "s41", "vcc");
        asm volatile("v_and_b32 %0, %0, %16\n\tv_and_b32 %1, %1, %16\n\tv_and_b32 %2, %2, %16\n\tv_and_b32 %3, %3, %16\n\tv_and_b32 %4, %4, %16\n\tv_and_b32 %5, %5, %16\n\tv_and_b32 %6, %6, %16\n\tv_and_b32 %7, %7, %16\n\tv_and_b32 %8, %8, %16\n\tv_and_b32 %9, %9, %16\n\tv_and_b32 %10, %10, %16\n\tv_and_b32 %11, %11, %16\n\tv_and_b32 %12, %12, %16\n\tv_and_b32 %13, %13, %16\n\tv_and_b32 %14, %14, %16\n\tv_and_b32 %15, %15, %16\n\t" : "+v"(r[0]), "+v"(r[1]), "+v"(r[2]), "+v"(r[3]), "+v"(r[4]), "+v"(r[5]), "+v"(r[6]), "+v"(r[7]), "+v"(r[8]), "+v"(r[9]), "+v"(r[10]), "+v"(r[11]), "+v"(r[12]), "+v"(r[13]), "+v"(r[14]), "+v"(r[15]) : "v"(a), "v"(b) : "s40", "s41", "vcc");
#endif
#if PROBE_UB == 20
        asm volatile("v_lshrrev_b32 %0, 4, %0\n\tv_lshrrev_b32 %1, 4, %1\n\tv_lshrrev_b32 %2, 4, %2\n\tv_lshrrev_b32 %3, 4, %3\n\tv_lshrrev_b32 %4, 4, %4\n\tv_lshrrev_b32 %5, 4, %5\n\tv_lshrrev_b32 %6, 4, %6\n\tv_lshrrev_b32 %7, 4, %7\n\tv_lshrrev_b32 %8, 4, %8\n\tv_lshrrev_b32 %9, 4, %9\n\tv_lshrrev_b32 %10, 4, %10\n\tv_lshrrev_b32 %11, 4, %11\n\tv_lshrrev_b32 %12, 4, %12\n\tv_lshrrev_b32 %13, 4, %13\n\tv_lshrrev_b32 %14, 4, %14\n\tv_lshrrev_b32 %15, 4, %15\n\t" : "+v"(r[0]), "+v"(r[1]), "+v"(r[2]), "+v"(r[3]), "+v"(r[4]), "+v"(r[5]), "+v"(r[6]), "+v"(r[7]), "+v"(r[8]), "+v"(r[9]), "+v"(r[10]), "+v"(r[11]), "+v"(r[12]), "+v"(r[13]), "+v"(r[14]), "+v"(r[15]) : "v"(a), "v"(b) : "s40", "s41", "vcc");
        asm volatile("v_lshrrev_b32 %0, 4, %0\n\tv_lshrrev_b32 %1, 4, %1\n\tv_lshrrev_b32 %2, 4, %2\n\tv_lshrrev_b32 %3, 4, %3\n\tv_lshrrev_b32 %4, 4, %4\n\tv_lshrrev_b32 %5, 4, %5\n\tv_lshrrev_b32 %6, 4, %6\n\tv_lshrrev_b32 %7, 4, %7\n\tv_lshrrev_b32 %8, 4, %8\n\tv_lshrrev_b32 %9, 4, %9\n\tv_lshrrev_b32 %10, 4, %10\n\tv_lshrrev_b32 %11, 4, %11\n\tv_lshrrev_b32 %12, 4, %12\n\tv_lshrrev_b32 %13, 4, %13\n\tv_lshrrev_b32 %14, 4, %14\n\tv_lshrrev_b32 %15, 4, %15\n\t" : "+v"(r[0]), "+v"(r[1]), "+v"(r[2]), "+v"(r[3]), "+v"(r[4]), "+v"(r[5]), "+v"(r[6]), "+v"(r[7]), "+v"(r[8]), "+v"(r[9]), "+v"(r[10]), "+v"(r[11]), "+v"(r[12]), "+v"(r[13]), "+v"(r[14]), "+v"(r[15]) : "v"(a), "v"(b) : "s40", "s41", "vcc");
#endif
#if PROBE_UB == 21
        asm volatile("v_mul_f32 %0, %0, %16\n\tv_mul_f32 %1, %1, %16\n\tv_mul_f32 %2, %2, %16\n\tv_mul_f32 %3, %3, %16\n\tv_mul_f32 %4, %4, %16\n\tv_mul_f32 %5, %5, %16\n\tv_mul_f32 %6, %6, %16\n\tv_mul_f32 %7, %7, %16\n\tv_mul_f32 %8, %8, %16\n\tv_mul_f32 %9, %9, %16\n\tv_mul_f32 %10, %10, %16\n\tv_mul_f32 %11, %11, %16\n\tv_mul_f32 %12, %12, %16\n\tv_mul_f32 %13, %13, %16\n\tv_mul_f32 %14, %14, %16\n\tv_mul_f32 %15, %15, %16\n\t" : "+v"(r[0]), "+v"(r[1]), "+v"(r[2]), "+v"(r[3]), "+v"(r[4]), "+v"(r[5]), "+v"(r[6]), "+v"(r[7]), "+v"(r[8]), "+v"(r[9]), "+v"(r[10]), "+v"(r[11]), "+v"(r[12]), "+v"(r[13]), "+v"(r[14]), "+v"(r[15]) : "v"(a), "v"(b) : "s40", "s41", "vcc");
        asm volatile("v_mul_f32 %0, %0, %16\n\tv_mul_f32 %1, %1, %16\n\tv_mul_f32 %2, %2, %16\n\tv_mul_f32 %3, %3, %16\n\tv_mul_f32 %4, %4, %16\n\tv_mul_f32 %5, %5, %16\n\tv_mul_f32 %6, %6, %16\n\tv_mul_f32 %7, %7, %16\n\tv_mul_f32 %8, %8, %16\n\tv_mul_f32 %9, %9, %16\n\tv_mul_f32 %10, %10, %16\n\tv_mul_f32 %11, %11, %16\n\tv_mul_f32 %12, %12, %16\n\tv_mul_f32 %13, %13, %16\n\tv_mul_f32 %14, %14, %16\n\tv_mul_f32 %15, %15, %16\n\t" : "+v"(r[0]), "+v"(r[1]), "+v"(r[2]), "+v"(r[3]), "+v"(r[4]), "+v"(r[5]), "+v"(r[6]), "+v"(r[7]), "+v"(r[8]), "+v"(r[9]), "+v"(r[10]), "+v"(r[11]), "+v"(r[12]), "+v"(r[13]), "+v"(r[14]), "+v"(r[15]) : "v"(a), "v"(b) : "s40", "s41", "vcc");
#endif
#if PROBE_UB == 22
        asm volatile("v_add_u32 %0, %0, %16\n\tv_add_u32 %1, %1, %16\n\tv_add_u32 %2, %2, %16\n\tv_add_u32 %3, %3, %16\n\tv_add_u32 %4, %4, %16\n\tv_add_u32 %5, %5, %16\n\tv_add_u32 %6, %6, %16\n\tv_add_u32 %7, %7, %16\n\tv_add_u32 %8, %8, %16\n\tv_add_u32 %9, %9, %16\n\tv_add_u32 %10, %10, %16\n\tv_add_u32 %11, %11, %16\n\tv_add_u32 %12, %12, %16\n\tv_add_u32 %13, %13, %16\n\tv_add_u32 %14, %14, %16\n\tv_add_u32 %15, %15, %16\n\t" : "+v"(r[0]), "+v"(r[1]), "+v"(r[2]), "+v"(r[3]), "+v"(r[4]), "+v"(r[5]), "+v"(r[6]), "+v"(r[7]), "+v"(r[8]), "+v"(r[9]), "+v"(r[10]), "+v"(r[11]), "+v"(r[12]), "+v"(r[13]), "+v"(r[14]), "+v"(r[15]) : "v"(a), "v"(b) : "s40", "s41", "vcc");
        asm volatile("v_add_u32 %0, %0, %16\n\tv_add_u32 %1, %1, %16\n\tv_add_u32 %2, %2, %16\n\tv_add_u32 %3, %3, %16\n\tv_add_u32 %4, %4, %16\n\tv_add_u32 %5, %5, %16\n\tv_add_u32 %6, %6, %16\n\tv_add_u32 %7, %7, %16\n\tv_add_u32 %8, %8, %16\n\tv_add_u32 %9, %9, %16\n\tv_add_u32 %10, %10, %16\n\tv_add_u32 %11, %11, %16\n\tv_add_u32 %12, %12, %16\n\tv_add_u32 %13, %13, %16\n\tv_add_u32 %14, %14, %16\n\tv_add_u32 %15, %15, %16\n\t" : "+v"(r[0]), "+v"(r[1]), "+v"(r[2]), "+v"(r[3]), "+v"(r[4]), "+v"(r[5]), "+v"(r[6]), "+v"(r[7]), "+v"(r[8]), "+v"(r[9]), "+v"(r[10]), "+v"(r[11]), "+v"(r[12]), "+v"(r[13]), "+v"(r[14]), "+v"(r[15]) : "v"(a), "v"(b) : "s40", "s41", "vcc");
#endif
#if PROBE_UB == 23
        asm volatile("v_cvt_pk_bf16_f32 %0, %0, %16\n\tv_cvt_pk_bf16_f32 %1, %1, %16\n\tv_cvt_pk_bf16_f32 %2, %2, %16\n\tv_cvt_pk_bf16_f32 %3, %3, %16\n\tv_cvt_pk_bf16_f32 %4, %4, %16\n\tv_cvt_pk_bf16_f32 %5, %5, %16\n\tv_cvt_pk_bf16_f32 %6, %6, %16\n\tv_cvt_pk_bf16_f32 %7, %7, %16\n\tv_cvt_pk_bf16_f32 %8, %8, %16\n\tv_cvt_pk_bf16_f32 %9, %9, %16\n\tv_cvt_pk_bf16_f32 %10, %10, %16\n\tv_cvt_pk_bf16_f32 %11, %11, %16\n\tv_cvt_pk_bf16_f32 %12, %12, %16\n\tv_cvt_pk_bf16_f32 %13, %13, %16\n\tv_cvt_pk_bf16_f32 %14, %14, %16\n\tv_cvt_pk_bf16_f32 %15, %15, %16\n\t" : "+v"(r[0]), "+v"(r[1]), "+v"(r[2]), "+v"(r[3]), "+v"(r[4]), "+v"(r[5]), "+v"(r[6]), "+v"(r[7]), "+v"(r[8]), "+v"(r[9]), "+v"(r[10]), "+v"(r[11]), "+v"(r[12]), "+v"(r[13]), "+v"(r[14]), "+v"(r[15]) : "v"(a), "v"(b) : "s40", "s41", "vcc");
        asm volatile("v_cvt_pk_bf16_f32 %0, %0, %16\n\tv_cvt_pk_bf16_f32 %1, %1, %16\n\tv_cvt_pk_bf16_f32 %2, %2, %16\n\tv_cvt_pk_bf16_f32 %3, %3, %16\n\tv_cvt_pk_bf16_f32 %4, %4, %16\n\tv_cvt_pk_bf16_f32 %5, %5, %16\n\tv_cvt_pk_bf16_f32 %6, %6, %16\n\tv_cvt_pk_bf16_f32 %7, %7, %16\n\tv_cvt_pk_bf16_f32 %8, %8, %16\n\tv_cvt_pk_bf16_f32 %9, %9, %16\n\tv_cvt_pk_bf16_f32 %10, %10, %16\n\tv_cvt_pk_bf16_f32 %11, %11, %16\n\tv_cvt_pk_bf16_f32 %12, %12, %16\n\tv_cvt_pk_bf16_f32 %13, %13, %16\n\tv_cvt_pk_bf16_f32 %14, %14, %16\n\tv_cvt_pk_bf16_f32 %15, %15, %16\n\t" : "+v"(r[0]), "+v"(r[1]), "+v"(r[2]), "+v"(r[3]), "+v"(r[4]), "+v"(r[5]), "+v"(r[6]), "+v"(r[7]), "+v"(r[8]), "+v"(r[9]), "+v"(r[10]), "+v"(r[11]), "+v"(r[12]), "+v"(r[13]), "+v"(r[14]), "+v"(r[15]) : "v"(a), "v"(b) : "s40", "s41", "vcc");
#endif
    }
    float s = 0.f;
#pragma unroll
    for (int i = 0; i < 16; ++i) s += r[i];
#pragma unroll
    for (int i = 0; i < 8; ++i) s += r2[i].x + r2[i].y;
    if (s == 1.2345e-33f) asm volatile("s_nop 0" ::: "memory");
}
#endif
__device__ __forceinline__ void phase_mod(const Params& p, LAS unsigned char* lds, int wv) {
    const int tid = tid_opaque(wv);
    LAS float* sc = (LAS float*)lds;
    LAS float* red = (LAS float*)(lds + 32768);
    for (int i = tid; i < BATCH * D_MODEL; i += 512) { const int b = i >> 10, k = i & 1023; const float v = p.c[i]; sc[k * 8 + b] = v / (1.0f + __expf(-v)); }
    __syncthreads();
    const int kg = tid >> 5, cl = tid & 31;
    for (int u = blockIdx.x; u < DEPTH * 64; u += gridDim.x) {
        const int l = u >> 6, j0 = (u & 63) * 96;
        const float* w = p.w_mod + (size_t)l * D_MODEL * MODW + (size_t)(kg * 64) * MODW + j0 + cl;
        float acc[3][8];
#pragma unroll
        for (int q = 0; q < 3; ++q)
#pragma unroll
            for (int b = 0; b < 8; ++b) acc[q][b] = 0.f;
#pragma unroll 4
        for (int kk = 0; kk < 64; ++kk) {
            const float w0 = w[(size_t)kk * MODW], w1 = w[(size_t)kk * MODW + 32], w2 = w[(size_t)kk * MODW + 64];
            const f32x4 s0 = *(const LAS f32x4*)(sc + (kg * 64 + kk) * 8), s1 = *(const LAS f32x4*)(sc + (kg * 64 + kk) * 8 + 4);
#pragma unroll
            for (int b = 0; b < 4; ++b) { acc[0][b] += s0[b] * w0; acc[1][b] += s0[b] * w1; acc[2][b] += s0[b] * w2; acc[0][4 + b] += s1[b] * w0; acc[1][4 + b] += s1[b] * w1; acc[2][4 + b] += s1[b] * w2; }
        }
#pragma unroll
        for (int q = 0; q < 3; ++q)
#pragma unroll
            for (int b = 0; b < 8; ++b) red[((kg * 3 + q) * 8 + b) * 32 + cl] = acc[q][b];
        __syncthreads();
        for (int o = tid; o < 768; o += 512) {
            float s = 0.f;
#pragma unroll
            for (int g = 0; g < 16; ++g) s += red[g * 768 + o];
            const int ocl = o & 31, ob = (o >> 5) & 7, oq = o >> 8;
            const int j = j0 + oq * 32 + ocl;
            p.mod()[((size_t)l * BATCH + ob) * MODW + j] = s + p.b_mod[(size_t)l * MODW + j];
        }
        __syncthreads();
    }
}

__device__ __forceinline__ void phase_biasq(const Params& p, int l, int wv) {
    const int tid = tid_opaque(wv), wave = tid >> 6, lane = tid & 63;
    for (int n = blockIdx.x * NWAVES + wave; n < 2048; n += gridDim.x * NWAVES) {
        const bf16_t* wr = p.WqT() + ((size_t)l * 2048 + n) * D_MODEL + lane * 16;
        const u32x4 w0 = *(const u32x4*)wr, w1 = *(const u32x4*)(wr + 8);
        float w[16];
#pragma unroll
        for (int e = 0; e < 4; ++e) { w[2 * e] = bflo(w0[e]); w[2 * e + 1] = bfhi(w0[e]); w[8 + 2 * e] = bflo(w1[e]); w[8 + 2 * e + 1] = bfhi(w1[e]); }
#pragma unroll 1
        for (int b = 0; b < BATCH; ++b) {
            const float* sh = p.mod() + ((size_t)l * BATCH + b) * MODW + 3 * D_MODEL + lane * 16;
            float s = 0.f;
#pragma unroll
            for (int q = 0; q < 4; ++q) { const f32x4 v = *(const f32x4*)(sh + 4 * q); s += v[0] * w[4 * q] + v[1] * w[4 * q + 1] + v[2] * w[4 * q + 2] + v[3] * w[4 * q + 3]; }
            s = wave_sum(s);
            if (lane == 0) p.biasq()[((size_t)l * BATCH + b) * 2048 + n] = s;
        }
    }
}

#ifndef PROBE_TIME
#define PROBE_TIME 0
#endif
#if PROBE_TIME || PROBE_UB
#define PT_BEGIN(k) do { if ((k) == PROBE_TIME) pt_t0 = __builtin_amdgcn_s_memrealtime(); } while (0)
#define PT_END(k) do { if ((k) == PROBE_TIME) pt_acc += __builtin_amdgcn_s_memrealtime() - pt_t0; } while (0)
#else
#define PT_BEGIN(k) do { } while (0)
#define PT_END(k) do { } while (0)
#endif
__global__ void __launch_bounds__(512, 2) k_mega(Params p) {
    extern __shared__ __attribute__((aligned(16))) unsigned char smem_raw[];
    LAS unsigned char* lds = (LAS unsigned char*)smem_raw;
    volatile LAS unsigned* xbw = (volatile LAS unsigned*)(lds + LDS_BYTES - 16);
    const int wv = __builtin_amdgcn_readfirstlane((int)threadIdx.x >> 6);
    if (threadIdx.x == 0) { xbw[0] = 0u; xbw[1] = 0u; xbw[2] = 0u; xbw[3] = 0u; }
    __syncthreads();
    (void)xcd_barrier_post(p.bar(), xbw);
#define GRID_SYNC_AT(k) do { PT_BEGIN(30 + (k)); GRID_SYNC(); PT_END(30 + (k)); } while (0)
#define GRID_SYNC() do { XcdBarrier _b; _b.bar = p.bar(); _b.x = xb_xcc_id(); _b.st = (volatile LAS unsigned*)(lds + LDS_BYTES - 16); _b.t0 = (tid_opaque(wv) == 0); PT_BEGIN(20); xcd_barrier(_b); PT_END(20); } while (0)
#if PROBE_TIME || PROBE_UB
    unsigned long long pt_t0 = 0, pt_acc = 0;
#endif
#if PROBE_UB
    { GRID_SYNC(); const unsigned long long u0 = __builtin_amdgcn_s_memrealtime(); ubench(4000, (unsigned)blockIdx.x); pt_acc += __builtin_amdgcn_s_memrealtime() - u0; GRID_SYNC(); }
#endif
#if PROBE_MASK & 32
    for (int rep = 0; rep < 20; ++rep) GRID_SYNC();
#endif
    PT_BEGIN(1);
    for (int rep = 0; rep < ((PROBE_MASK & 8) ? 2 : 1); ++rep) { phase_mod(p, lds, wv); phase_convert(p, lds, wv); }
    GRID_SYNC();
    PT_END(1); PT_BEGIN(2);
    phase_norm(p, p.x_in, p.norm1_g, p.mod(), 0, 1, wv);
    GRID_SYNC();
    PT_END(2);
    for (int l = 0; l < DEPTH; ++l) {
        const float* modl = p.mod() + (size_t)l * BATCH * MODW;
        PT_BEGIN(3);
        for (int rep = 0; rep < ((PROBE_MASK & 1) ? 2 : 1); ++rep) { EpiStoreBf16 E; E.O = p.pb(); E.ldc = MIX_IN; run_gemm(lds, p.hb(), p.WinT() + (size_t)l * MIX_IN * D_MODEL, NTOK, MIX_IN, D_MODEL, E, wv); }
        convert_in_gemm1_slack(p, l, lds, wv);
        GRID_SYNC_AT(2);
        PT_END(3); PT_BEGIN(4); PT_BEGIN(10);
        for (int rep = 0; rep < ((PROBE_MASK & 2) ? 2 : 1); ++rep) phase_attn(p, l, lds, wv);
        PT_END(10);
        for (int rep = 0; rep < ((PROBE_MASK & 16) ? 2 : 1); ++rep) phase_mixrest(p, l, lds, wv);
        phase_biasq(p, l, wv);
        GRID_SYNC_AT(3);
        PT_END(4); PT_BEGIN(5);
        { EpiResidNorm E; E.xin = (l == 0) ? p.x_in : p.xb(); E.xout = p.xb(); E.modl = modl; E.n2g = p.norm2_g + l * D_MODEL; E.hb = p.hb(); E.ssq = p.ssq();
          run_gemm(lds, p.cat(), p.WoutT() + (size_t)l * D_MODEL * D_MODEL, NTOK, D_MODEL, D_MODEL, E, wv); }
        GRID_SYNC_AT(4);
        PT_END(5);
        PT_BEGIN(7);
        for (int rep = 0; rep < ((PROBE_MASK & 1) ? 2 : 1); ++rep) { EpiQ E; E.O = p.qb(); E.ssq = p.ssq(); E.biasq = p.biasq() + (size_t)l * BATCH * 2048; run_gemm(lds, p.hb(), p.WqT() + (size_t)l * 2048 * D_MODEL, NTOK, 2048, D_MODEL, E, wv); }
        GRID_SYNC_AT(5);
        PT_END(7); PT_BEGIN(8);
        for (int rep = 0; rep < ((PROBE_MASK & 4) ? 2 : 1); ++rep) phase_topk(p, l, lds, wv);
        GRID_SYNC_AT(6);
        PT_END(8); PT_BEGIN(9); PT_BEGIN(11);
        PT_BEGIN(12);
        if (PROBE_SYNTH) phase_expert(p, l, false, lds, wv, PROBE_SYNTH, true);
        PT_END(12);
        phase_expert(p, l, l == DEPTH - 1, lds, wv);
        PT_END(11);
        GRID_SYNC_AT(7);
        PT_END(9);
    }
#if PROBE_TIME || PROBE_UB
    if (blockIdx.x == PROBE_BLOCK) {
        const unsigned long long t1 = __builtin_amdgcn_s_memrealtime();
        while (__builtin_amdgcn_s_memrealtime() - t1 < 4ull * pt_acc) __builtin_amdgcn_s_sleep(8);
    }
#endif
}
#if MK_MULTI
enum { PH_CONVERT = 0, PH_NORM1, PH_GEMM1, PH_GEMM2, PH_NORM2, PH_GEMM3, PH_MOD };
template <int PH>
__global__ void __launch_bounds__(512, 2) k_ph(Params p, int l) {
    extern __shared__ __attribute__((aligned(16))) unsigned char smem_raw[];
    LAS unsigned char* lds = (LAS unsigned char*)smem_raw;
    const int wv = __builtin_amdgcn_readfirstlane((int)threadIdx.x >> 6);
    const float* modl = p.mod() + (size_t)l * BATCH * MODW;
    if (PH == PH_CONVERT) phase_convert(p, lds, wv);
    if (PH == PH_MOD) phase_mod(p, lds, wv);
    if (PH == PH_NORM1) phase_norm(p, l == 0 ? p.x_in : p.xb(), p.norm1_g + l * D_MODEL, modl, 0, 1, wv);
    if (PH == PH_GEMM1) { EpiStoreBf16 E; E.O = p.pb(); E.ldc = MIX_IN; run_gemm(lds, p.hb(), p.WinT() + (size_t)l * MIX_IN * D_MODEL, NTOK, MIX_IN, D_MODEL, E, wv); }
    if (PH == PH_GEMM2) { EpiResid E; E.xin = (l == 0) ? p.x_in : p.xb(); E.xout = p.xb(); E.gate = modl + 2 * D_MODEL; run_gemm(lds, p.cat(), p.WoutT() + (size_t)l * D_MODEL * D_MODEL, NTOK, D_MODEL, D_MODEL, E, wv); }
    if (PH == PH_NORM2) phase_norm(p, p.xb(), p.norm2_g + l * D_MODEL, modl, 3, 4, wv);
    if (PH == PH_GEMM3) { EpiStoreBf16 E; E.O = p.qb(); E.ldc = 2048; run_gemm(lds, p.hb(), p.WqT() + (size_t)l * 2048 * D_MODEL, NTOK, 2048, D_MODEL, E, wv); }
}

#endif

extern "C" void kernel_launch(void* const* d_in, const int* in_sizes, int n_in, void* d_out, int out_size, void* d_ws, size_t ws_size, hipStream_t stream) {
    Params p{};
    p.x_in = (const float*)d_in[0]; p.c = (const float*)d_in[1]; p.rel_bias = (const float*)d_in[2]; p.w_mod = (const float*)d_in[3]; p.b_mod = (const float*)d_in[4];
    p.norm1_g = (const float*)d_in[5]; p.norm2_g = (const float*)d_in[6]; p.w_in = (const float*)d_in[7]; p.w_out = (const float*)d_in[8]; p.diff_lambda = (const float*)d_in[9];
    p.subln_g = (const float*)d_in[10]; p.conf_dw = (const float*)d_in[11]; p.conf_ln_g = (const float*)d_in[12]; p.conf_ln_b = (const float*)d_in[13]; p.sconv_w = (const float*)d_in[14];
    p.sgu_ln_g = (const float*)d_in[15]; p.sgu_ln_b = (const float*)d_in[16]; p.sgu_w = (const float*)d_in[17]; p.sgu_b = (const float*)d_in[18]; p.peer_wq = (const float*)d_in[19];
    p.peer_keys = (const float*)d_in[20]; p.peer_u = (const float*)d_in[21]; p.peer_v = (const float*)d_in[22]; p.final_g = (const float*)d_in[23];
    p.out = (float*)d_out;
    for (int l = 0; l < DEPTH; ++l) p.lam_init[l] = (float)(0.8 - 0.6 * exp(-0.3 * (double)l));

    p.ws = (unsigned char*)d_ws;
    if (ws_size < WS_END) { fprintf(stderr, "kernel_launch: workspace too small\n"); return; }

    static int grid = 0;
    if (grid == 0) {
        int dev = 0, cus = 0;
        if (hipGetDevice(&dev) != hipSuccess || hipDeviceGetAttribute(&cus, hipDeviceAttributeMultiprocessorCount, dev) != hipSuccess) { grid = -1; return; }
        bool ok = true;
#if MK_MULTI
        ok &= hipFuncSetAttribute((const void*)k_ph<PH_CONVERT>, hipFuncAttributeMaxDynamicSharedMemorySize, LDS_BYTES) == hipSuccess;
        ok &= hipFuncSetAttribute((const void*)k_ph<PH_NORM1>, hipFuncAttributeMaxDynamicSharedMemorySize, LDS_BYTES) == hipSuccess;
        ok &= hipFuncSetAttribute((const void*)k_ph<PH_GEMM1>, hipFuncAttributeMaxDynamicSharedMemorySize, LDS_BYTES) == hipSuccess;
        ok &= hipFuncSetAttribute((const void*)k_ph<PH_GEMM2>, hipFuncAttributeMaxDynamicSharedMemorySize, LDS_BYTES) == hipSuccess;
        ok &= hipFuncSetAttribute((const void*)k_ph<PH_NORM2>, hipFuncAttributeMaxDynamicSharedMemorySize, LDS_BYTES) == hipSuccess;
        ok &= hipFuncSetAttribute((const void*)k_ph<PH_GEMM3>, hipFuncAttributeMaxDynamicSharedMemorySize, LDS_BYTES) == hipSuccess;
        ok &= hipFuncSetAttribute((const void*)k_ph<PH_MOD>, hipFuncAttributeMaxDynamicSharedMemorySize, LDS_BYTES) == hipSuccess;
        ok &= hipFuncSetAttribute((const void*)k_attn2<0>, hipFuncAttributeMaxDynamicSharedMemorySize, LDS_BYTES) == hipSuccess;
        ok &= hipFuncSetAttribute((const void*)k_topk<0>, hipFuncAttributeMaxDynamicSharedMemorySize, LDS_BYTES) == hipSuccess;
        ok &= hipFuncSetAttribute((const void*)k_mixrest<0>, hipFuncAttributeMaxDynamicSharedMemorySize, LDS_BYTES) == hipSuccess;
        ok &= hipFuncSetAttribute((const void*)k_expert, hipFuncAttributeMaxDynamicSharedMemorySize, LDS_BYTES) == hipSuccess;
#else
        ok &= hipFuncSetAttribute((const void*)k_mega, hipFuncAttributeMaxDynamicSharedMemorySize, LDS_BYTES) == hipSuccess;
#endif
        if (!ok) { fprintf(stderr, "kernel_launch: hipFuncSetAttribute failed\n"); grid = -1; return; }
        grid = cus;
    }
    if (grid < 0) return;
    const int G = grid;
#if MK_MULTI
    k_ph<PH_MOD><<<G, 512, LDS_BYTES, stream>>>(p, 0);
    k_ph<PH_CONVERT><<<G, 512, LDS_BYTES, stream>>>(p, 0);
    for (int l = 0; l < DEPTH; ++l) {
        if (l == 0) k_ph<PH_NORM1><<<G, 512, LDS_BYTES, stream>>>(p, l);
        k_ph<PH_GEMM1><<<G, 512, LDS_BYTES, stream>>>(p, l);
        k_attn2<0><<<G, 512, LDS_BYTES, stream>>>(p, l);
        k_mixrest<0><<<G, 512, LDS_BYTES, stream>>>(p, l);
        k_ph<PH_GEMM2><<<G, 512, LDS_BYTES, stream>>>(p, l);
        k_ph<PH_NORM2><<<G, 512, LDS_BYTES, stream>>>(p, l);
        k_ph<PH_GEMM3><<<G, 512, LDS_BYTES, stream>>>(p, l);
        k_topk<0><<<G, 512, LDS_BYTES, stream>>>(p, l);
        k_expert<<<G, 512, LDS_BYTES, stream>>>(p, l);
    }
#else
    (void)hipMemsetAsync(p.ws + OFF_BAR, 0, OFF_MOD - OFF_BAR, stream);
    k_mega<<<G, 512, LDS_BYTES, stream>>>(p);
#endif
}
```

```cpp
#include <hip/hip_runtime.h>
#include <stdint.h>
#include <stdio.h>
#include <math.h>

#define D_MODEL 1024
#define BATCH 8
#define SEQ 2048
#define DEPTH 4
#define NTOK (BATCH * SEQ)
#define MIX_IN 2560
#define N_MOD 6
#define MODW (N_MOD * D_MODEL)
#define NEXP 16384

#define MK_MULTI 0
#define FUSE_TOPK_EXPERT 0
#define EXPERT_MAP_GROUPED 1
#ifndef PROBE_MASK
#define PROBE_MASK 0
#endif
#define PROBE_TIME 0
#define PROBE_SYNTH 0
#define PROBE_UB 0
#define PROBE_BLOCK 0
#define LAS __attribute__((address_space(3)))
typedef unsigned short bf16_t;
typedef short bf16x8 __attribute__((ext_vector_type(8)));
typedef float f32x4 __attribute__((ext_vector_type(4)));
typedef float f32x16 __attribute__((ext_vector_type(16)));
typedef unsigned u32x4 __attribute__((ext_vector_type(4)));
typedef unsigned u32x2 __attribute__((ext_vector_type(2)));
typedef float f32x2 __attribute__((ext_vector_type(2)));

__device__ const unsigned char kBucket[128] = {
    0, 1, 2, 3, 4, 5, 6, 7, 8, 9, 10, 11, 12, 13, 14, 15, 16, 16, 16, 17, 17, 18, 18, 18, 19, 19, 19, 20, 20, 20, 20, 21,
    21, 21, 21, 22, 22, 22, 22, 22, 23, 23, 23, 23, 23, 23, 24, 24, 24, 24, 24, 24, 25, 25, 25, 25, 25, 25, 25, 26, 26, 26, 26, 26,
    26, 26, 26, 27, 27, 27, 27, 27, 27, 27, 27, 27, 27, 28, 28, 28, 28, 28, 28, 28, 28, 28, 28, 29, 29, 29, 29, 29, 29, 29, 29, 29,
    29, 29, 29, 30, 30, 30, 30, 30, 30, 30, 30, 30, 30, 30, 30, 30, 30, 31, 31, 31, 31, 31, 31, 31, 31, 31, 31, 31, 31, 31, 31, 31};

__device__ __forceinline__ float bf2f(bf16_t v) { return __uint_as_float(((unsigned)v) << 16); }
__device__ __forceinline__ float bflo(unsigned w) { return __uint_as_float(w << 16); }
__device__ __forceinline__ float bfhi(unsigned w) { return __uint_as_float(w & 0xFFFF0000u); }
__device__ __forceinline__ bf16_t f2bf(float f) { unsigned u = __float_as_uint(f); u += 0x7FFFu + ((u >> 16) & 1u); return (bf16_t)(u >> 16); }
__device__ __forceinline__ unsigned pk2(float lo, float hi) { unsigned r; asm volatile("v_cvt_pk_bf16_f32 %0, %1, %2" : "=v"(r) : "v"(lo), "v"(hi)); return r; }
__device__ __forceinline__ float ldf(const float* p) { return *p; }
__device__ __forceinline__ float ldf(const bf16_t* p) { return bf2f(*p); }

__device__ __forceinline__ float gelu_as(float v) {
    const float av = fabsf(v), t = __builtin_amdgcn_rcpf(av * 0.2316418882f + 1.0f);
    float q = t * 0.5307027145f + (-0.7265760135f); q = q * t + 0.7107068705f; q = q * t + (-0.142248368f); q = q * t + 0.127414796f; q = q * t;
    const float e = __builtin_amdgcn_exp2f((v * v) * (-0.72134752044f));
    const float m = v * (q * e);
    return v < 0.f ? m : v - m;
}
template <int CTRL, int ROWMASK = 0xF>
__device__ __forceinline__ float dpp_add(float x) {
    const int y = __builtin_amdgcn_update_dpp(0, __float_as_int(x), CTRL, ROWMASK, 0xF, false);
    return x + __int_as_float(y);
}
__device__ __forceinline__ float wave_sum_l63(float v) {
    v = dpp_add<0xB1>(v);
    v = dpp_add<0x4E>(v);
    v = dpp_add<0x141>(v);
    v = dpp_add<0x140>(v);
    v = dpp_add<0x142, 0xA>(v);
    v = dpp_add<0x143, 0xC>(v);
    return v;
}
__device__ __forceinline__ float gelu_exact(float v) { return 0.5f * v * (1.0f + erff(v * 0.70710678118654752f)); }
__device__ __forceinline__ float sigmoidf_(float v) { return 1.0f / (1.0f + __expf(-v)); }
__device__ __forceinline__ float wave_sum(float v) {
#pragma unroll
    for (int o = 32; o > 0; o >>= 1) v += __shfl_xor(v, o, 64);
    return v;
}
__device__ __forceinline__ float block_sum256(float v, float* red) {
    v = wave_sum(v);
    __syncthreads();
    if ((threadIdx.x & 63) == 0) red[threadIdx.x >> 6] = v;
    __syncthreads();
    return red[0] + red[1] + red[2] + red[3];
}

__device__ __forceinline__ int tid_opaque(int wv) {
    int t;
    asm volatile("v_mbcnt_lo_u32_b32 %0, -1, 0\n\tv_mbcnt_hi_u32_b32 %0, -1, %0" : "=v"(t));
    return (wv << 6) | t;
}
__device__ __forceinline__ int launder(int v) { asm volatile("" : "+v"(v)); return v; }
#define XB_TMO      128
#define XB_XCNT(j)  (256  + 64 * (j))
#define XB_XSUB(j)  (1280 + 64 * (j))
#define XB_XGEN(j)  (2304 + 64 * (j))
#define XB_TOP      3328
#define XB_TOPGEN   3392
#define XCD_BAR_WORDS 3456
#define XB_SPIN_CAP (1u << 18)

__device__ __forceinline__ unsigned xb_ld(unsigned* p)              { return __hip_atomic_load(p, __ATOMIC_RELAXED, __HIP_MEMORY_SCOPE_AGENT); }
__device__ __forceinline__ unsigned xb_add(unsigned* p, unsigned v) { return __hip_atomic_fetch_add(p, v, __ATOMIC_RELAXED, __HIP_MEMORY_SCOPE_AGENT); }
__device__ __forceinline__ unsigned xb_xcc_id() { return (unsigned)__builtin_amdgcn_s_getreg((3 << 11) | 20) & 0xFu; }
#define XB_SPIN(cond, bar) do { unsigned _sp = 0; while (cond) { __builtin_amdgcn_s_sleep(1); \
    if ((++_sp & 255u) == 0u) { if (xb_ld(&(bar)[XB_TMO])) break; if (_sp > XB_SPIN_CAP) { atomicAdd(&(bar)[XB_TMO], 1u); break; } } } } while (0)

struct XcdBarrier {
    unsigned* bar; unsigned x;
    bool t0;
    volatile LAS unsigned* st;
};

__device__ __forceinline__ XcdBarrier xcd_barrier_post(unsigned* bar, volatile LAS unsigned* st) {
    XcdBarrier b; b.bar = bar; b.x = xb_xcc_id(); b.st = st;
    if (threadIdx.x == 0) (void)xb_add(&bar[XB_XCNT(b.x)], 1u);
    return b;
}
__device__ __forceinline__ void xcd_barrier_complete(unsigned* bar, unsigned x, unsigned& nloc, unsigned& nx) {
    const unsigned G = gridDim.x * gridDim.y * gridDim.z;
    unsigned sum, cnt, mine, sp = 0u;
    for (;;) {
        sum = 0u; cnt = 0u; mine = 0u;
#pragma unroll
        for (unsigned j = 0; j < 16; ++j) { const unsigned c = xb_ld(&bar[XB_XCNT(j)]); sum += c; cnt += (c > 0u) ? 1u : 0u; mine = (j == x) ? c : mine; }
        if (sum == G) break;
        __builtin_amdgcn_s_sleep(1);
        if ((++sp & 255u) == 0u) { if (xb_ld(&bar[XB_TMO])) break; if (sp > XB_SPIN_CAP) { atomicAdd(&bar[XB_TMO], 1u); break; } }
    }
    nloc = mine > 0u ? mine : 1u; nx = cnt > 0u ? cnt : 1u;
}

__device__ __forceinline__ void xcd_barrier(const XcdBarrier& b) {
    asm volatile("s_waitcnt vmcnt(0)" ::: "memory");
    __syncthreads();
    if (b.t0) {
        unsigned* bar = b.bar;
        __builtin_amdgcn_s_waitcnt(0);
        unsigned nloc = b.st[0], nx = b.st[1];
        if (nloc == 0u) { xcd_barrier_complete(bar, b.x, nloc, nx); b.st[0] = nloc; b.st[1] = nx; }
        const unsigned old = xb_add(&bar[XB_XSUB(b.x)], 1u);
        const unsigned gen = old / nloc;
        if (old + 1u == (gen + 1u) * nloc) {
            __builtin_amdgcn_fence(__ATOMIC_RELEASE, "agent");
            asm volatile("s_waitcnt vmcnt(0)" ::: "memory");
            const unsigned og = xb_add(&bar[XB_TOP], 1u);
            const unsigned tg = og / nx;
            if (og + 1u == (tg + 1u) * nx) xb_add(&bar[XB_TOPGEN], 1u);
            else XB_SPIN(xb_ld(&bar[XB_TOPGEN]) == tg, bar);
            __builtin_amdgcn_fence(__ATOMIC_ACQUIRE, "agent");
            xb_add(&bar[XB_XGEN(b.x)], 1u);
            asm volatile("s_waitcnt vmcnt(0)" ::: "memory");
        } else {
            XB_SPIN(xb_ld(&bar[XB_XGEN(b.x)]) == gen, bar);
            __builtin_amdgcn_fence(__ATOMIC_ACQUIRE, "agent");
            asm volatile("s_waitcnt vmcnt(0)" ::: "memory");
        }
    }
    __syncthreads();
}
namespace pg8 {
#define PG8_LAS __attribute__((address_space(3)))
typedef unsigned short bf16_t;
typedef short bf16x8 __attribute__((ext_vector_type(8)));
typedef float f32x4 __attribute__((ext_vector_type(4)));
typedef unsigned u32x4 __attribute__((ext_vector_type(4)));
constexpr int BM = 256, BK = 64, HALF = 128, HTB = HALF * BK * 2  , STAGE_BYTES = 8 * HTB, NXCD = 8, WGM = 8;

__host__ __device__ __forceinline__ int lds_byte(int r, int c) { const int st = (r >> 4) * 2 + (c >> 5), rr = r & 15, cc = c & 31, ob = rr * 64 + cc * 2; return st * 1024 + (ob ^ (((ob >> 9) & 1) << 5)); }
__host__ __device__ __forceinline__ void stage_rc(int b, int& R, int& C) { const int st = b / 1024, sb = b % 1024, swz = sb ^ (((sb >> 9) & 1) << 5); R = (st >> 1) * 16 + swz / 64; C = (st & 1) * 32 + (swz % 64) / 2; }
__host__ __device__ __forceinline__ int perm32(int rho) { const int n = rho >> 4, i = rho & 15; return 8 * (i >> 2) + 4 * n + (i & 3); }

struct Unit { int pm, pn; };
struct Gemm { const bf16_t* A; const bf16_t* Bt; int M, N, K; };

struct StaticOrder {
    int nM, nN, nwg, G, c;
    __host__ __device__ void init(int M, int N, int G_, int c_) { nM = M / BM; nN = N / BM; nwg = nM * nN; G = G_; c = c_; }
    __host__ __device__ bool next(int i, Unit& u) const {
        const long L = (long)i * G + c; if (L >= nwg) return false;
        int wgid = (int)L; { const int q = nwg / NXCD, r = nwg % NXCD, xcd = wgid % NXCD, off = wgid / NXCD; wgid = (xcd < r ? xcd * (q + 1) : r * (q + 1) + (xcd - r) * q) + off; }
        const int nig = WGM * nN, gid = wgid / nig, fm = gid * WGM, gsz = (nM - fm) < WGM ? (nM - fm) : WGM;
        u.pm = fm + ((wgid % nig) % gsz); u.pn = (wgid % nig) / gsz; return true;
    }
    __device__ __forceinline__ void a_ready(const Unit&) const {}
    __device__ __forceinline__ void done(const Unit&) const {}
};
__device__ __forceinline__ unsigned cvt_pk_bf16(float lo, float hi) { unsigned r; asm volatile("v_cvt_pk_bf16_f32 %0, %1, %2" : "=v"(r) : "v"(lo), "v"(hi)); return r; }
template <class Epi, class Sched, bool STAMP = false>
__device__ __forceinline__ void gemm_phase(PG8_LAS unsigned char* lds, const Gemm g, const Sched& S, const Epi& E, unsigned long long* stamps, int wv) {
    const int tid = tid_opaque(wv), wid = __builtin_amdgcn_readfirstlane(tid >> 6), lane = tid & 63, wr = wid >> 2, wc = wid & 3, fr = lane & 15, fq = lane >> 4;
    const int K = g.K, nt = K / BK;
    int ts_lo = 0, ts_hi = 0, nts = 0; const unsigned long long rt_entry = STAMP ? (unsigned long long)wall_clock64() : 0ull;
#define PG8_STAMP() do { if (STAMP && wid == 0 && nts < 64) { const unsigned long long _c = (unsigned long long)clock64(); \
        ts_lo = (lane == nts) ? (int)(unsigned)_c : ts_lo; ts_hi = (lane == nts) ? (int)(unsigned)(_c >> 32) : ts_hi; ++nts; } } while (0)
    PG8_STAMP();
    unsigned voffA[2], voffB[2];
#pragma unroll
    for (int i = 0; i < 2; ++i) { int R, C; stage_rc(tid * 16 + i * 8192, R, C); const int Rb = Epi::PERM ? ((R & ~31) + perm32(R & 31)) : R;
        voffA[i] = (unsigned)(R * K + C) * 2u; voffB[i] = (unsigned)(Rb * K + C) * 2u; }
    const size_t kstep = (size_t)(BK * 2);
    const size_t hstep = (size_t)HALF * K * 2;
    const size_t tstep = 2 * hstep;
    const unsigned ldsw = (unsigned)wid * 1024u;
    const int aoff = lds_byte(wr * 64 + fr, fq * 8), boff = lds_byte(wc * 32 + fr, fq * 8);
#define PG8_SA(b, h) (((b) * 2 + (h)) * HTB)
#define PG8_SB(b, h) ((4 + (b) * 2 + (h)) * HTB)
#define PG8_STAGE(bufoff, gbase, voff) do { _Pragma("unroll") for (int _i = 0; _i < 2; ++_i) \
        __builtin_amdgcn_global_load_lds((const unsigned*)((const char*)(gbase) + (voff)[_i]), (PG8_LAS unsigned*)(lds + (bufoff) + ldsw + _i * 8192), 16, 0, 0); } while (0)
#define PG8_LDA(dst, b, h) do { _Pragma("unroll") for (int m = 0; m < 4; ++m) _Pragma("unroll") for (int k = 0; k < 2; ++k) dst[m][k] = *(const PG8_LAS bf16x8*)(lds + PG8_SA(b, h) + aoff + m * 2048 + k * 1024); } while (0)
#define PG8_LDB(dst, b, h) do { _Pragma("unroll") for (int n = 0; n < 2; ++n) _Pragma("unroll") for (int k = 0; k < 2; ++k) dst[n][k] = *(const PG8_LAS bf16x8*)(lds + PG8_SB(b, h) + boff + n * 2048 + k * 1024); } while (0)
#define PG8_MMA(ai, bj, At, Bt) do { __builtin_amdgcn_s_setprio(1); _Pragma("unroll") for (int m = 0; m < 4; ++m) _Pragma("unroll") for (int n = 0; n < 2; ++n) _Pragma("unroll") for (int k = 0; k < 2; ++k) \
        acc[ai][bj][m][n] = __builtin_amdgcn_mfma_f32_16x16x32_bf16(Bt[n][k], At[m][k], acc[ai][bj][m][n], 0, 0, 0); __builtin_amdgcn_s_setprio(0); } while (0)
#define PG8_WAIT_V(n) asm volatile("s_waitcnt vmcnt(" #n ")" ::: "memory")
#define PG8_WAIT_L(n) asm volatile("s_waitcnt lgkmcnt(" #n ")" ::: "memory")
#define PG8_BAR __builtin_amdgcn_s_barrier()
#define PG8_SCHED __builtin_amdgcn_sched_barrier(0)
    Unit cur, nxt; int ui = 0;
    if (!S.next(0, cur)) return;
    f32x4 acc[2][2][4][2];
#pragma unroll
    for (int a = 0; a < 2; ++a)
#pragma unroll
        for (int b = 0; b < 2; ++b)
#pragma unroll
            for (int m = 0; m < 4; ++m)
#pragma unroll
                for (int n = 0; n < 2; ++n) acc[a][b][m][n] = (f32x4){0.f, 0.f, 0.f, 0.f};
    bf16x8 At[4][2], B0[2][2], B1[2][2];
    const char* cA = (const char*)g.A + (size_t)cur.pm * tstep; const char* cB = (const char*)g.Bt + (size_t)cur.pn * tstep;
    S.a_ready(cur);
    PG8_STAGE(PG8_SB(0, 0), cB, voffB); PG8_STAGE(PG8_SA(0, 0), cA, voffA); PG8_STAGE(PG8_SB(0, 1), cB + hstep, voffB); PG8_STAGE(PG8_SA(0, 1), cA + hstep, voffA);
    if (wr == 1) PG8_BAR;
    PG8_WAIT_V(4); PG8_BAR;
    PG8_STAGE(PG8_SB(1, 0), cB + kstep, voffB); PG8_STAGE(PG8_SA(1, 0), cA + kstep, voffA); PG8_STAGE(PG8_SB(1, 1), cB + hstep + kstep, voffB);
    PG8_WAIT_V(6); PG8_BAR;
    PG8_STAMP();
    for (;;) {
        const bool has_next = S.next(ui + 1, nxt);
        const char* nA = has_next ? (const char*)g.A + (size_t)nxt.pm * tstep : cA; const char* nB = has_next ? (const char*)g.Bt + (size_t)nxt.pn * tstep : cB;
        for (int t = 0; t < nt; t += 2) {
            const bool last = (t == nt - 2);
            const char* a1 = cA + (size_t)(t + 1) * kstep;
            const char* a2 = last ? nA : cA + (size_t)(t + 2) * kstep; const char* b2 = last ? nB : cB + (size_t)(t + 2) * kstep;
            const char* a3 = a2 + kstep; const char* b3 = b2 + kstep;
            if (last && has_next) S.a_ready(nxt);
            PG8_LDB(B0, 0, 0); PG8_SCHED; PG8_LDA(At, 0, 0); PG8_STAGE(PG8_SA(1, 1), a1 + hstep, voffA);
            PG8_WAIT_L(8); PG8_BAR; PG8_WAIT_L(0); PG8_MMA(0, 0, At, B0); PG8_BAR; PG8_SCHED;
            PG8_LDB(B1, 0, 1); PG8_STAGE(PG8_SB(0, 0), b2, voffB);
            PG8_BAR; PG8_WAIT_L(0); PG8_MMA(0, 1, At, B1); PG8_BAR;
            PG8_LDA(At, 0, 1); PG8_STAGE(PG8_SA(0, 0), a2, voffA);
            PG8_BAR; PG8_WAIT_L(0); PG8_MMA(1, 0, At, B0); PG8_BAR; PG8_SCHED;
            PG8_STAGE(PG8_SB(0, 1), b2 + hstep, voffB);
            PG8_WAIT_V(6); PG8_BAR; PG8_MMA(1, 1, At, B1); PG8_BAR;
            PG8_LDB(B0, 1, 0); PG8_SCHED; PG8_LDA(At, 1, 0); PG8_STAGE(PG8_SA(0, 1), a2 + hstep, voffA);
            PG8_WAIT_L(8); PG8_BAR; PG8_WAIT_L(0); PG8_MMA(0, 0, At, B0); PG8_BAR; PG8_SCHED;
            PG8_LDB(B1, 1, 1); PG8_STAGE(PG8_SB(1, 0), b3, voffB);
            PG8_BAR; PG8_WAIT_L(0); PG8_MMA(0, 1, At, B1); PG8_BAR;
            PG8_LDA(At, 1, 1); PG8_STAGE(PG8_SA(1, 0), a3, voffA);
            PG8_BAR; PG8_WAIT_L(0); PG8_MMA(1, 0, At, B0); PG8_BAR; PG8_SCHED;
            PG8_STAGE(PG8_SB(1, 1), b3 + hstep, voffB);
            PG8_WAIT_V(6); PG8_BAR; PG8_MMA(1, 1, At, B1); PG8_BAR;
        }
        PG8_STAMP();
        if constexpr (!Epi::AFTER_DRAIN) { E(acc, cur, wr, wc, fr, fq); S.done(cur); }
        PG8_STAMP();
        if (!has_next) break;
#pragma unroll
        for (int a = 0; a < 2; ++a)
#pragma unroll
            for (int b = 0; b < 2; ++b)
#pragma unroll
                for (int m = 0; m < 4; ++m)
#pragma unroll
                    for (int n = 0; n < 2; ++n) acc[a][b][m][n] = (f32x4){0.f, 0.f, 0.f, 0.f};
        cur = nxt; cA = nA; cB = nB; ++ui;
    }
    PG8_WAIT_V(0);
    if (wr == 0) PG8_BAR;
    PG8_BAR;
    if constexpr (Epi::AFTER_DRAIN) { E.fused(acc, cur, wr, wc, fr, fq, lds, wid, lane); S.done(cur); }
    PG8_STAMP();
    if (STAMP && wid == 0) { stamps[lane] = lane < nts ? (((unsigned long long)(unsigned)ts_hi << 32) | (unsigned)ts_lo) : 0ull;
        if (lane == 62) stamps[62] = rt_entry; if (lane == 63) stamps[63] = (unsigned long long)wall_clock64(); }
#undef PG8_STAMP
#undef PG8_SA
#undef PG8_SB
#undef PG8_STAGE
#undef PG8_LDA
#undef PG8_LDB
#undef PG8_MMA
#undef PG8_WAIT_V
#undef PG8_WAIT_L
#undef PG8_BAR
#undef PG8_SCHED
}
}

constexpr size_t ws_al(size_t x) { return (x + 255) & ~(size_t)255; }
constexpr size_t OFF_BAR = 0;
constexpr size_t OFF_CTR = OFF_BAR + ws_al((size_t)3456 * 4);
constexpr size_t CTR_BYTES = 64 * 256;
constexpr size_t OFF_MOD = OFF_CTR + CTR_BYTES;
constexpr size_t OFF_XB = OFF_MOD + ws_al((size_t)DEPTH * BATCH * MODW * 4);
constexpr size_t OFF_HB = OFF_XB + ws_al((size_t)NTOK * D_MODEL * 4);
constexpr size_t OFF_PB = OFF_HB + ws_al((size_t)NTOK * D_MODEL * 2);
constexpr size_t OFF_CAT = OFF_PB + ws_al((size_t)NTOK * MIX_IN * 2);
constexpr size_t OFF_QB = OFF_CAT + ws_al((size_t)NTOK * D_MODEL * 2);
constexpr size_t OFF_WINT = OFF_QB + ws_al((size_t)NTOK * 2048 * 2);
constexpr size_t OFF_WOUTT = OFF_WINT + ws_al((size_t)DEPTH * MIX_IN * D_MODEL * 2);
constexpr size_t OFF_WQT = OFF_WOUTT + ws_al((size_t)DEPTH * D_MODEL * D_MODEL * 2);
constexpr size_t OFF_KEYSB = OFF_WQT + ws_al((size_t)DEPTH * 2048 * D_MODEL * 2);
constexpr size_t OFF_SGUWB = OFF_KEYSB + ws_al((size_t)DEPTH * 16 * 128 * 128 * 2);
constexpr size_t OFF_UB8 = OFF_SGUWB + ws_al((size_t)DEPTH * 4 * 128 * 128 * 2);
constexpr size_t OFF_VB8 = OFF_UB8 + ws_al((size_t)DEPTH * NEXP * D_MODEL);
constexpr size_t OFF_UINV = OFF_VB8 + ws_al((size_t)DEPTH * NEXP * D_MODEL);
constexpr size_t OFF_VINV = OFF_UINV + ws_al((size_t)DEPTH * NEXP * 4);
constexpr size_t OFF_EIDX = OFF_VINV + ws_al((size_t)DEPTH * NEXP * 4);
constexpr size_t OFF_EGATE = OFF_EIDX + ws_al((size_t)NTOK * 128 * 4);
constexpr size_t OFF_SSQ = OFF_EGATE + ws_al((size_t)NTOK * 128 * 4);
constexpr size_t OFF_BIASQ = OFF_SSQ + ws_al((size_t)NTOK * 16 * 4);
constexpr size_t WS_END = OFF_BIASQ + ws_al((size_t)DEPTH * BATCH * 2048 * 4);

struct Params {
    const float *x_in, *c, *rel_bias, *w_mod, *b_mod, *norm1_g, *norm2_g, *w_in, *w_out, *diff_lambda, *subln_g, *conf_dw, *conf_ln_g, *conf_ln_b, *sconv_w,
        *sgu_ln_g, *sgu_ln_b, *sgu_w, *sgu_b, *peer_wq, *peer_keys, *peer_u, *peer_v, *final_g;
    float* out;
    unsigned char* ws;
    float lam_init[DEPTH];
    __host__ __device__ unsigned* bar() const { return (unsigned*)(ws + OFF_BAR); }
    __host__ __device__ unsigned* ctr(int i) const { return (unsigned*)(ws + OFF_CTR + (size_t)i * 256); }
    __host__ __device__ float* mod() const { return (float*)(ws + OFF_MOD); }
    __host__ __device__ bf16_t* xb() const { return (bf16_t*)(ws + OFF_XB); }
    __host__ __device__ bf16_t* hb() const { return (bf16_t*)(ws + OFF_HB); }
    __host__ __device__ bf16_t* pb() const { return (bf16_t*)(ws + OFF_PB); }
    __host__ __device__ bf16_t* cat() const { return (bf16_t*)(ws + OFF_CAT); }
    __host__ __device__ bf16_t* qb() const { return (bf16_t*)(ws + OFF_QB); }
    __host__ __device__ bf16_t* WinT() const { return (bf16_t*)(ws + OFF_WINT); }
    __host__ __device__ bf16_t* WoutT() const { return (bf16_t*)(ws + OFF_WOUTT); }
    __host__ __device__ bf16_t* WqT() const { return (bf16_t*)(ws + OFF_WQT); }
    __host__ __device__ bf16_t* keysb() const { return (bf16_t*)(ws + OFF_KEYSB); }
    __host__ __device__ bf16_t* sguwb() const { return (bf16_t*)(ws + OFF_SGUWB); }
    __host__ __device__ unsigned char* ub8() const { return ws + OFF_UB8; }
    __host__ __device__ unsigned char* vb8() const { return ws + OFF_VB8; }
    __host__ __device__ float* uinv() const { return (float*)(ws + OFF_UINV); }
    __host__ __device__ float* vinv() const { return (float*)(ws + OFF_VINV); }
    __host__ __device__ int* eidx() const { return (int*)(ws + OFF_EIDX); }
    __host__ __device__ float* egate() const { return (float*)(ws + OFF_EGATE); }
    __host__ __device__ float* ssq() const { return (float*)(ws + OFF_SSQ); }
    __host__ __device__ float* biasq() const { return (float*)(ws + OFF_BIASQ); }
};

#define LDS_BYTES (160 * 1024)
#define NWAVES 8

__device__ __forceinline__ void transpose_item(const float* __restrict__ W, int K, int N, bf16_t* __restrict__ WT, LAS float* scr, int item, int lane) {
    const int nblk = N / 32, kb = item / nblk, nb = item % nblk, k0 = 64 * kb, n0 = 32 * nb;
#pragma unroll 8
    for (int i = 0; i < 32; ++i) { const int kk = 2 * i + (lane >> 5); scr[kk * 33 + (lane & 31)] = W[(size_t)(k0 + kk) * N + n0 + (lane & 31)]; }
    asm volatile("s_waitcnt lgkmcnt(0)" ::: "memory");
    const int c = lane & 7;
#pragma unroll
    for (int j = 0; j < 4; ++j) {
        const int n = (lane >> 3) + 8 * j; const LAS float* s = scr + (8 * c) * 33 + n;
        u32x4 o; o.x = pk2(s[0 * 33], s[1 * 33]); o.y = pk2(s[2 * 33], s[3 * 33]); o.z = pk2(s[4 * 33], s[5 * 33]); o.w = pk2(s[6 * 33], s[7 * 33]);
        *(u32x4*)(WT + (size_t)(n0 + n) * K + k0 + 8 * c) = o;
    }
    asm volatile("s_waitcnt lgkmcnt(0)" ::: "memory");
}
__device__ __forceinline__ void cvt8(const float* __restrict__ s, bf16_t* __restrict__ d) {
    const f32x4 a = *(const f32x4*)s, b = *(const f32x4*)(s + 4);
    u32x4 o; o.x = pk2(a[0], a[1]); o.y = pk2(a[2], a[3]); o.z = pk2(b[0], b[1]); o.w = pk2(b[2], b[3]);
    *(u32x4*)d = o;
}
#define CV_NR 4
__device__ __forceinline__ void convert_table_row(const Params& p, int tr0, int lane) {
    f32x4 a[CV_NR][4];
#pragma unroll
    for (int h2 = 0; h2 < CV_NR; ++h2) {
        const int tr = tr0 + h2, l = tr / (2 * NEXP), w2 = tr % (2 * NEXP); const bool isv = w2 >= NEXP; const size_t r = (size_t)l * NEXP + (isv ? w2 - NEXP : w2);
        const float* src = (isv ? p.peer_v : p.peer_u) + r * D_MODEL + lane * 16;
#pragma unroll
        for (int q = 0; q < 4; ++q) a[h2][q] = *(const f32x4*)(src + 4 * q);
    }
#pragma unroll
    for (int h2 = 0; h2 < CV_NR; ++h2) {
        const int tr = tr0 + h2, l = tr / (2 * NEXP), w2 = tr % (2 * NEXP); const bool isv = w2 >= NEXP; const size_t r = (size_t)l * NEXP + (isv ? w2 - NEXP : w2);
        float ss = 0.f;
#pragma unroll
        for (int q = 0; q < 4; ++q) ss += a[h2][q][0] * a[h2][q][0] + a[h2][q][1] * a[h2][q][1] + a[h2][q][2] * a[h2][q][2] + a[h2][q][3] * a[h2][q][3];
        ss = wave_sum(ss);
        const float step = fmaxf(0.335f * sqrtf(ss * (1.0f / D_MODEL)), 1e-30f), sc = 1.0f / step;
        unsigned o[2];
#pragma unroll
        for (int d = 0; d < 2; ++d) {
            unsigned w = 0;
#pragma unroll
            for (int e = 0; e < 8; ++e) {
                const float v = a[h2][2 * d + (e >> 2)][e & 3];
                const int qv = (int)fminf(fmaxf(rintf(v * sc), -8.f), 7.f) + 8;
                w |= (unsigned)qv << (8 * (e >> 1) + 4 * (e & 1));
            }
            o[d] = w;
        }
        *(u32x2*)((isv ? p.vb8() : p.ub8()) + r * (D_MODEL / 2) + lane * 8) = (u32x2){o[0], o[1]};
        if (lane == 0) (isv ? p.vinv() : p.uinv())[r] = step;
    }
}
constexpr int CV_I_IN = (D_MODEL / 64) * (MIX_IN / 32), CV_I_OUT = (D_MODEL / 64) * (D_MODEL / 32), CV_I_Q = (D_MODEL / 64) * (2048 / 32), CV_I_L = CV_I_IN + CV_I_OUT + CV_I_Q;
__device__ __forceinline__ void convert_weight_item(const Params& p, int l, int r, LAS float* scr, int lane) {
    if (r < CV_I_IN) { transpose_item(p.w_in + (size_t)l * D_MODEL * MIX_IN, D_MODEL, MIX_IN, p.WinT() + (size_t)l * MIX_IN * D_MODEL, scr, r, lane); return; } r -= CV_I_IN;
    if (r < CV_I_OUT) { transpose_item(p.w_out + (size_t)l * D_MODEL * D_MODEL, D_MODEL, D_MODEL, p.WoutT() + (size_t)l * D_MODEL * D_MODEL, scr, r, lane); return; } r -= CV_I_OUT;
    transpose_item(p.peer_wq + (size_t)l * D_MODEL * 2048, D_MODEL, 2048, p.WqT() + (size_t)l * 2048 * D_MODEL, scr, r, lane);
}
__device__ __forceinline__ void phase_convert(const Params& p, LAS unsigned char* lds, int wv) {
    const int tid = tid_opaque(wv), wave = tid >> 6, lane = tid & 63;
    LAS float* scr = (LAS float*)(lds + wave * 16384);
    const int gw = blockIdx.x * NWAVES + wave, NGW = gridDim.x * NWAVES;
    for (int it = gw; it < CV_I_L; it += NGW) convert_weight_item(p, 0, it, scr, lane);
    const size_t gt = (size_t)blockIdx.x * 512 + tid, NGT = (size_t)gridDim.x * 512;
    constexpr size_t N_KEYS8 = (size_t)DEPTH * 16 * 128 * 128 / 8, N_SGU8 = (size_t)DEPTH * 4 * 128 * 128 / 8;
    for (size_t i = gt; i < N_KEYS8; i += NGT) cvt8(p.peer_keys + i * 8, p.keysb() + i * 8);
    for (int tr = CV_NR * gw; tr < 2 * NEXP; tr += CV_NR * NGW) convert_table_row(p, tr, lane);
    for (size_t i = gt; i < N_SGU8; i += NGT) {
        const size_t e = i * 8; const int s0 = (int)(e & 127), t = (int)((e >> 7) & 127);
        const f32x4 a = *(const f32x4*)(p.sgu_w + e), b = *(const f32x4*)(p.sgu_w + e + 4);
        float v[8] = {a[0], a[1], a[2], a[3], b[0], b[1], b[2], b[3]};
#pragma unroll
        for (int j = 0; j < 8; ++j) v[j] = (s0 + j <= t) ? v[j] : 0.f;
        u32x4 o; o.x = pk2(v[0], v[1]); o.y = pk2(v[2], v[3]); o.z = pk2(v[4], v[5]); o.w = pk2(v[6], v[7]);
        *(u32x4*)(p.sguwb() + e) = o;
    }
}
__device__ __forceinline__ void convert_in_gemm1_slack(const Params& p, int l, LAS unsigned char* lds, int wv) {
    const int G = (int)gridDim.x;
    int rem = 640 - 2 * G;
    if (rem <= 0 || rem >= G) rem = 0;
    if ((int)blockIdx.x < rem) return;
    const int tid = tid_opaque(wv), wave = tid >> 6, lane = tid & 63;
    LAS float* scr = (LAS float*)(lds + wave * 16384);
    const int cw = ((int)blockIdx.x - rem) * NWAVES + wave, NCW = (G - rem) * NWAVES;
    if (l + 1 < DEPTH) for (int it = cw; it < CV_I_L; it += NCW) convert_weight_item(p, l + 1, it, scr, lane);
    constexpr int S_ROWS = (DEPTH - 1) * 2 * NEXP, W_ROWS = S_ROWS / DEPTH;
    for (int sr = l * W_ROWS + CV_NR * cw; sr < (l + 1) * W_ROWS; sr += CV_NR * NCW) convert_table_row(p, 2 * NEXP + sr, lane);
}

__device__ __forceinline__ void norm_row(const float* __restrict__ xr, const float* __restrict__ g, const float* __restrict__ sh, const float* __restrict__ sc, bf16_t* __restrict__ hr, int lane) {
    f32x4 v[4]; float ss = 0.f;
#pragma unroll
    for (int j = 0; j < 4; ++j) { v[j] = *(const f32x4*)(xr + j * 256 + lane * 4); ss += v[j][0] * v[j][0] + v[j][1] * v[j][1] + v[j][2] * v[j][2] + v[j][3] * v[j][3]; }
    const float rs = rsqrtf(wave_sum(ss) * (1.0f / D_MODEL) + 1e-6f);
#pragma unroll
    for (int j = 0; j < 4; ++j) {
        const int col = j * 256 + lane * 4;
        const f32x4 gv = *(const f32x4*)(g + col), scv = *(const f32x4*)(sc + col), shv = *(const f32x4*)(sh + col);
        f32x4 y;
#pragma unroll
        for (int e = 0; e < 4; ++e) y[e] = v[j][e] * rs * gv[e] * (1.0f + scv[e]) + shv[e];
        u32x2 o; o.x = pk2(y[0], y[1]); o.y = pk2(y[2], y[3]);
        *(u32x2*)(hr + col) = o;
    }
}
__device__ __forceinline__ void phase_norm(const Params& p, const float* __restrict__ x, const float* __restrict__ g, const float* __restrict__ modl, int sh_idx, int sc_idx, int wv) {
    const int tid = tid_opaque(wv), wave = tid >> 6, lane = tid & 63;
    for (int t = blockIdx.x * NWAVES + wave; t < NTOK; t += gridDim.x * NWAVES) {
        const float* mb = modl + (size_t)(t / SEQ) * MODW;
        norm_row(x + (size_t)t * D_MODEL, g, mb + sh_idx * D_MODEL, mb + sc_idx * D_MODEL, p.hb() + (size_t)t * D_MODEL, lane);
    }
}

struct EpiStoreBf16 {
    static constexpr bool PERM = true, AFTER_DRAIN = false;
    bf16_t* O; int ldc;
    __device__ __forceinline__ void operator()(const pg8::f32x4 (&acc)[2][2][4][2], const pg8::Unit& u, int wr, int wc, int fr, int fq) const {
        const int row0 = u.pm * 256 + wr * 64 + fr, col0 = u.pn * 256 + wc * 32 + 8 * fq;
#pragma unroll
        for (int ai = 0; ai < 2; ++ai)
#pragma unroll
            for (int m = 0; m < 4; ++m) {
                bf16_t* rowp = O + (size_t)(row0 + ai * 128 + m * 16) * ldc + col0;
#pragma unroll
                for (int bj = 0; bj < 2; ++bj) {
                    const pg8::f32x4 v0 = acc[ai][bj][m][0], v1 = acc[ai][bj][m][1];
                    u32x4 w; w.x = pk2(v0[0], v0[1]); w.y = pk2(v0[2], v0[3]); w.z = pk2(v1[0], v1[1]); w.w = pk2(v1[2], v1[3]);
                    *(u32x4*)(rowp + bj * 128) = w;
                }
            }
    }
};
struct EpiResid {
    static constexpr bool PERM = false, AFTER_DRAIN = false;
    const float* xin; float* xout; const float* gate;
    __device__ __forceinline__ void operator()(const pg8::f32x4 (&acc)[2][2][4][2], const pg8::Unit& u, int wr, int wc, int fr, int fq) const {
        const int row0 = u.pm * 256 + wr * 64 + fr, col0 = u.pn * 256 + wc * 32 + 4 * fq;
        const float* gb = gate + (size_t)((u.pm * 256) / SEQ) * MODW + col0;
        pg8::f32x4 gv[2][2];
#pragma unroll
        for (int bj = 0; bj < 2; ++bj)
#pragma unroll
            for (int n = 0; n < 2; ++n) gv[bj][n] = *(const pg8::f32x4*)(gb + bj * 128 + n * 16);
#pragma unroll
        for (int ai = 0; ai < 2; ++ai)
#pragma unroll
            for (int m = 0; m < 4; ++m) {
                const size_t off = (size_t)(row0 + ai * 128 + m * 16) * D_MODEL + col0;
#pragma unroll
                for (int bj = 0; bj < 2; ++bj)
#pragma unroll
                    for (int n = 0; n < 2; ++n) {
                        const pg8::f32x4 xv = *(const pg8::f32x4*)(xin + off + bj * 128 + n * 16);
                        *(pg8::f32x4*)(xout + off + bj * 128 + n * 16) = xv + gv[bj][n] * acc[ai][bj][m][n];
                    }
            }
    }
};

template <bool FIRST>
struct EpiResidNorm {
    static constexpr bool PERM = true, AFTER_DRAIN = false;
    const float* xin32; const bf16_t* xin16; bf16_t* xout; const float* modl; const float* n2g; bf16_t* hb; float* ssq;
    __device__ __forceinline__ void operator()(const pg8::f32x4 (&acc)[2][2][4][2], const pg8::Unit& u, int wr, int wc, int fr, int fq) const {
        const int row0 = u.pm * 256 + wr * 64 + fr, col0 = u.pn * 256 + wc * 32 + 8 * fq;
        const float* mb = modl + (size_t)((u.pm * 256) / SEQ) * MODW;
        pg8::f32x4 gv[2][2], gm[2][2];
#pragma unroll
        for (int bj = 0; bj < 2; ++bj)
#pragma unroll
            for (int n = 0; n < 2; ++n) {
                const int c = col0 + bj * 128 + n * 4;
                gv[bj][n] = *(const pg8::f32x4*)(mb + 2 * D_MODEL + c);
                gm[bj][n] = *(const pg8::f32x4*)(n2g + c) * (*(const pg8::f32x4*)(mb + 4 * D_MODEL + c) + 1.0f);
            }
#pragma unroll
        for (int ai = 0; ai < 2; ++ai)
#pragma unroll
            for (int m = 0; m < 4; ++m) {
                const int row = row0 + ai * 128 + m * 16;
                const size_t off = (size_t)row * D_MODEL + col0;
                float sq = 0.f;
#pragma unroll
                for (int bj = 0; bj < 2; ++bj) {
                    pg8::f32x4 x0, x1;
                    if (FIRST) { x0 = *(const pg8::f32x4*)(xin32 + off + bj * 128); x1 = *(const pg8::f32x4*)(xin32 + off + bj * 128 + 4); }
                    else { const u32x4 w = *(const u32x4*)(xin16 + off + bj * 128); x0 = (pg8::f32x4){bflo(w.x), bfhi(w.x), bflo(w.y), bfhi(w.y)}; x1 = (pg8::f32x4){bflo(w.z), bfhi(w.z), bflo(w.w), bfhi(w.w)}; }
                    x0 += gv[bj][0] * acc[ai][bj][m][0]; x1 += gv[bj][1] * acc[ai][bj][m][1];
                    u32x4 xo; xo.x = pk2(x0[0], x0[1]); xo.y = pk2(x0[2], x0[3]); xo.z = pk2(x1[0], x1[1]); xo.w = pk2(x1[2], x1[3]);
                    *(u32x4*)(xout + off + bj * 128) = xo;
                    x0 = (pg8::f32x4){bflo(xo.x), bfhi(xo.x), bflo(xo.y), bfhi(xo.y)}; x1 = (pg8::f32x4){bflo(xo.z), bfhi(xo.z), bflo(xo.w), bfhi(xo.w)};
                    sq += x0[0] * x0[0] + x0[1] * x0[1] + x0[2] * x0[2] + x0[3] * x0[3] + x1[0] * x1[0] + x1[1] * x1[1] + x1[2] * x1[2] + x1[3] * x1[3];
                    const pg8::f32x4 h0 = x0 * gm[bj][0], h1 = x1 * gm[bj][1];
                    u32x4 ho; ho.x = pk2(h0[0], h0[1]); ho.y = pk2(h0[2], h0[3]); ho.z = pk2(h1[0], h1[1]); ho.w = pk2(h1[2], h1[3]);
                    *(u32x4*)(hb + off + bj * 128) = ho;
                }
                sq += __shfl_xor(sq, 16, 64); sq += __shfl_xor(sq, 32, 64);
                if (fq == 0) ssq[(size_t)row * 16 + u.pn * 4 + wc] = sq;
            }
    }
};
struct EpiQ {
    static constexpr bool PERM = true, AFTER_DRAIN = false;
    bf16_t* O; const float* ssq; const float* biasq;
    __device__ __forceinline__ void operator()(const pg8::f32x4 (&acc)[2][2][4][2], const pg8::Unit& u, int wr, int wc, int fr, int fq) const {
        const int row0 = u.pm * 256 + wr * 64 + fr, col0 = u.pn * 256 + wc * 32 + 8 * fq;
        const float* bb = biasq + (size_t)((u.pm * 256) / SEQ) * 2048 + col0;
        pg8::f32x4 bv[2][2];
#pragma unroll
        for (int bj = 0; bj < 2; ++bj)
#pragma unroll
            for (int n = 0; n < 2; ++n) bv[bj][n] = *(const pg8::f32x4*)(bb + bj * 128 + 4 * n);
#pragma unroll
        for (int ai = 0; ai < 2; ++ai)
#pragma unroll
            for (int m = 0; m < 4; ++m) {
                const int row = row0 + ai * 128 + m * 16;
                const pg8::f32x4 s0 = *(const pg8::f32x4*)(ssq + (size_t)row * 16), s1 = *(const pg8::f32x4*)(ssq + (size_t)row * 16 + 4), s2 = *(const pg8::f32x4*)(ssq + (size_t)row * 16 + 8), s3 = *(const pg8::f32x4*)(ssq + (size_t)row * 16 + 12);
                const float tot = (((s0[0] + s0[1]) + (s0[2] + s0[3])) + ((s1[0] + s1[1]) + (s1[2] + s1[3]))) + (((s2[0] + s2[1]) + (s2[2] + s2[3])) + ((s3[0] + s3[1]) + (s3[2] + s3[3])));
                const float rs = rsqrtf(tot * (1.0f / D_MODEL) + 1e-6f);
                bf16_t* rowp = O + (size_t)row * 2048 + col0;
#pragma unroll
                for (int bj = 0; bj < 2; ++bj) {
                    const pg8::f32x4 v0 = acc[ai][bj][m][0] * rs + bv[bj][0], v1 = acc[ai][bj][m][1] * rs + bv[bj][1];
                    u32x4 w; w.x = pk2(v0[0], v0[1]); w.y = pk2(v0[2], v0[3]); w.z = pk2(v1[0], v1[1]); w.w = pk2(v1[2], v1[3]);
                    *(u32x4*)(rowp + bj * 128) = w;
                }
            }
    }
};

template <class Epi>
__device__ __forceinline__ void run_gemm(LAS unsigned char* lds, const bf16_t* A, const bf16_t* Bt, int M, int N, int K, const Epi& E, int wv) {
    pg8::StaticOrder S; S.init(M, N, (int)gridDim.x, (int)blockIdx.x);
    pg8::Gemm g; g.A = A; g.Bt = Bt; g.M = M; g.N = N; g.K = K;
    pg8::gemm_phase<Epi, pg8::StaticOrder, false>(lds, g, S, E, nullptr, wv);
}

typedef __amdgpu_buffer_rsrc_t rsrc_t;
struct G4 { u32x2 r[4]; };
__device__ __forceinline__ u32x2 bload8(rsrc_t r, int voff, int soff) { return __builtin_bit_cast(u32x2, __builtin_amdgcn_raw_buffer_load_b64(r, voff, soff, 0)); }
#define ROWB (D_MODEL / 2)
template <int G>
__device__ __forceinline__ void ex_issue(G4& R, rsrc_t rs, int e0, int e1, int voff, int emask = 0x3FFF) {
#pragma unroll
    for (int i = 0; i < 4; ++i) {
        const int e = __builtin_amdgcn_readlane(G < 16 ? e0 : e1, (4 * G + i) & 63) & emask;
        R.r[i] = bload8(rs, voff, e * ROWB);
    }
}
template <int CTRL, int ROWMASK = 0xF>
__device__ __forceinline__ int dpp_iadd(int x) { return x + __builtin_amdgcn_update_dpp(0, x, CTRL, ROWMASK, 0xF, false); }
__device__ __forceinline__ int wave_isum_l63(int v) {
    v = dpp_iadd<0xB1>(v); v = dpp_iadd<0x4E>(v); v = dpp_iadd<0x141>(v); v = dpp_iadd<0x140>(v); v = dpp_iadd<0x142, 0xA>(v); v = dpp_iadd<0x143, 0xC>(v);
    return v;
}
template <int G>
__device__ __forceinline__ void ex_passA(const G4& R, const int (&hq)[4], int hinit, int& KK0, int& KK1, int lane) {
    int a[4];
#pragma unroll
    for (int i = 0; i < 4; ++i) a[i] = hinit;
#pragma unroll
    for (int i = 0; i < 4; ++i) a[i] = __builtin_amdgcn_sdot4((int)(R.r[i][0] & 0x0F0F0F0Fu), hq[0], a[i], false);
#pragma unroll
    for (int i = 0; i < 4; ++i) a[i] = __builtin_amdgcn_sdot4((int)((R.r[i][0] >> 4) & 0x0F0F0F0Fu), hq[1], a[i], false);
#pragma unroll
    for (int i = 0; i < 4; ++i) a[i] = __builtin_amdgcn_sdot4((int)(R.r[i][1] & 0x0F0F0F0Fu), hq[2], a[i], false);
#pragma unroll
    for (int i = 0; i < 4; ++i) a[i] = __builtin_amdgcn_sdot4((int)((R.r[i][1] >> 4) & 0x0F0F0F0Fu), hq[3], a[i], false);
#pragma unroll
    for (int i = 0; i < 4; ++i) a[i] = dpp_iadd<0xB1>(a[i]);
#pragma unroll
    for (int i = 0; i < 4; ++i) a[i] = dpp_iadd<0x4E>(a[i]);
#pragma unroll
    for (int i = 0; i < 4; ++i) a[i] = dpp_iadd<0x141>(a[i]);
#pragma unroll
    for (int i = 0; i < 4; ++i) a[i] = dpp_iadd<0x140>(a[i]);
#pragma unroll
    for (int i = 0; i < 4; ++i) a[i] = dpp_iadd<0x142, 0xA>(a[i]);
#pragma unroll
    for (int i = 0; i < 4; ++i) a[i] = dpp_iadd<0x143, 0xC>(a[i]);
#pragma unroll
    for (int i = 0; i < 4; ++i) {
        const int tot = __builtin_amdgcn_readlane(a[i], 63);
        if (G < 16) KK0 = (lane == ((4 * G + i) & 63)) ? tot : KK0; else KK1 = (lane == ((4 * G + i) & 63)) ? tot : KK1;
    }
}
__device__ __forceinline__ void ex_passB(const G4& R, int cp, int (&yi)[16]) {
#pragma unroll
    for (int j = 0; j < 4; ++j) {
        const int sh4 = (j & 1) * 4;
        const unsigned A = (R.r[0][j >> 1] >> sh4) & 0x0F0F0F0Fu, B = (R.r[1][j >> 1] >> sh4) & 0x0F0F0F0Fu, C = (R.r[2][j >> 1] >> sh4) & 0x0F0F0F0Fu, D = (R.r[3][j >> 1] >> sh4) & 0x0F0F0F0Fu;
        const unsigned ablo = __builtin_amdgcn_perm(B, A, 0x05010400u), abhi = __builtin_amdgcn_perm(B, A, 0x07030602u);
        const unsigned cdlo = __builtin_amdgcn_perm(D, C, 0x05010400u), cdhi = __builtin_amdgcn_perm(D, C, 0x07030602u);
        const unsigned t0 = __builtin_amdgcn_perm(cdlo, ablo, 0x05040100u), t1 = __builtin_amdgcn_perm(cdlo, ablo, 0x07060302u);
        const unsigned t2 = __builtin_amdgcn_perm(cdhi, abhi, 0x05040100u), t3 = __builtin_amdgcn_perm(cdhi, abhi, 0x07060302u);
        yi[4 * j + 0] = __builtin_amdgcn_sdot4((int)t0, cp, yi[4 * j + 0], false);
        yi[4 * j + 1] = __builtin_amdgcn_sdot4((int)t1, cp, yi[4 * j + 1], false);
        yi[4 * j + 2] = __builtin_amdgcn_sdot4((int)t2, cp, yi[4 * j + 2], false);
        yi[4 * j + 3] = __builtin_amdgcn_sdot4((int)t3, cp, yi[4 * j + 3], false);
    }
}
__device__ __forceinline__ float wave_max(float v) {
#pragma unroll
    for (int o = 32; o > 0; o >>= 1) v = fmaxf(v, __shfl_xor(v, o, 64));
    return v;
}
__device__ __forceinline__ int quad_pack(int ci) {
    const int b = ci & 0xFF;
    const int d0 = __builtin_amdgcn_update_dpp(0, b, 0x00, 0xF, 0xF, false), d1 = __builtin_amdgcn_update_dpp(0, b, 0x55, 0xF, 0xF, false);
    const int d2 = __builtin_amdgcn_update_dpp(0, b, 0xAA, 0xF, 0xF, false), d3 = __builtin_amdgcn_update_dpp(0, b, 0xFF, 0xF, 0xF, false);
    return d0 | (d1 << 8) | (d2 << 16) | (d3 << 24);
}

__device__ __forceinline__ void ex_finish(const Params& p, int l, const bool LAST, int t, const float (&y)[16], int lane_) {
    const int lane = launder(lane_);
    const int c0 = lane * 16;
    const float* mb = p.mod() + ((size_t)l * BATCH + t / SEQ) * MODW;
    float xv[16];
    {
        const u32x4 w0 = *(const u32x4*)(p.xb() + (size_t)t * D_MODEL + c0), w1 = *(const u32x4*)(p.xb() + (size_t)t * D_MODEL + c0 + 8);
#pragma unroll
        for (int e = 0; e < 4; ++e) { xv[2 * e] = bflo(w0[e]); xv[2 * e + 1] = bfhi(w0[e]); xv[8 + 2 * e] = bflo(w1[e]); xv[8 + 2 * e + 1] = bfhi(w1[e]); }
    }
#pragma unroll
    for (int q = 0; q < 4; ++q) {
        const f32x4 g2 = *(const f32x4*)(mb + 5 * D_MODEL + c0 + 4 * q);
#pragma unroll
        for (int e = 0; e < 4; ++e) xv[4 * q + e] += g2[e] * y[4 * q + e];
    }
    float ss2 = 0.f;
#pragma unroll
    for (int e = 0; e < 16; ++e) ss2 += xv[e] * xv[e];
    const float rs2 = rsqrtf(wave_sum(ss2) * (1.0f / D_MODEL) + 1e-6f);
    if (LAST) {
#pragma unroll
        for (int q = 0; q < 4; ++q) {
            const int col = c0 + 4 * q;
            const f32x4 gv = *(const f32x4*)(p.final_g + col);
            f32x4 o;
#pragma unroll
            for (int e = 0; e < 4; ++e) o[e] = xv[4 * q + e] * rs2 * gv[e];
            *(f32x4*)(p.out + (size_t)t * D_MODEL + col) = o;
        }
    } else {
        const float* mn = p.mod() + ((size_t)(l + 1) * BATCH + t / SEQ) * MODW;
        const float* n1g = p.norm1_g + (l + 1) * D_MODEL;
        unsigned xw[8];
#pragma unroll
        for (int e = 0; e < 8; ++e) { xw[e] = pk2(xv[2 * e], xv[2 * e + 1]); xv[2 * e] = bflo(xw[e]); xv[2 * e + 1] = bfhi(xw[e]); }
        *(u32x4*)(p.xb() + (size_t)t * D_MODEL + c0) = (u32x4){xw[0], xw[1], xw[2], xw[3]};
        *(u32x4*)(p.xb() + (size_t)t * D_MODEL + c0 + 8) = (u32x4){xw[4], xw[5], xw[6], xw[7]};
        float ssr = 0.f;
#pragma unroll
        for (int e = 0; e < 16; ++e) ssr += xv[e] * xv[e];
        const float rs3 = rsqrtf(wave_sum(ssr) * (1.0f / D_MODEL) + 1e-6f);
        unsigned hw[8];
#pragma unroll
        for (int q = 0; q < 4; ++q) {
            const int col = c0 + 4 * q;
            const f32x4 gv = *(const f32x4*)(n1g + col), scv = *(const f32x4*)(mn + 1 * D_MODEL + col), shv = *(const f32x4*)(mn + 0 * D_MODEL + col);
            float h[4];
#pragma unroll
            for (int e = 0; e < 4; ++e) h[e] = xv[4 * q + e] * rs3 * gv[e] * (1.0f + scv[e]) + shv[e];
            hw[2 * q] = pk2(h[0], h[1]); hw[2 * q + 1] = pk2(h[2], h[3]);
        }
        *(u32x4*)(p.hb() + (size_t)t * D_MODEL + c0) = (u32x4){hw[0], hw[1], hw[2], hw[3]};
        *(u32x4*)(p.hb() + (size_t)t * D_MODEL + c0 + 8) = (u32x4){hw[4], hw[5], hw[6], hw[7]};
    }
}


#define EXR 8
#define EXT (32 / EXR)
template <int S>
__device__ __forceinline__ void ex_turnA(G4 (&R)[EXR], const int (&hq)[4], int hinit, int& KK0, int& KK1, rsrc_t ru, rsrc_t rv, int e0, int e1, int voff, int lane, int emask) {
#define EX_A(s) ex_passA<EXR * S + s>(R[s], hq, hinit, KK0, KK1, lane); asm volatile("" ::: "memory"); if (S < EXT - 1) ex_issue<(EXR * S + s + EXR) & 31>(R[s], ru, e0, e1, voff, emask); else ex_issue<s>(R[s], rv, e0, e1, voff, emask); asm volatile("" ::: "memory");
    EX_A(0) EX_A(1) EX_A(2) EX_A(3)
#if EXR == 8
    EX_A(4) EX_A(5) EX_A(6) EX_A(7)
#endif
#undef EX_A
}
template <int S>
__device__ __forceinline__ void ex_turnB(G4 (&R)[EXR], int cpk0, int cpk1, int (&yi)[16], rsrc_t ru, rsrc_t rv, int e0, int e1, int e0n, int e1n, bool has_next, int voff, int emask) {
#define EX_B(s) ex_passB(R[s], __builtin_amdgcn_readlane((EXR * S + s) < 16 ? cpk0 : cpk1, (4 * (EXR * S + s)) & 63), yi); \
    asm volatile("" ::: "memory"); if (S < EXT - 1) ex_issue<(EXR * S + s + EXR) & 31>(R[s], rv, e0, e1, voff, emask); asm volatile("" ::: "memory");
    EX_B(0) EX_B(1) EX_B(2) EX_B(3)
#if EXR == 8
    EX_B(4) EX_B(5) EX_B(6) EX_B(7)
#endif
#undef EX_B
}

__device__ __forceinline__ void phase_expert(const Params& p, int l, const bool LAST, LAS unsigned char* lds, int wv, const int emask = 0x3FFF, const bool synth = false) {
    const int tid = tid_opaque(wv), wave = tid >> 6, lane = tid & 63;
    const rsrc_t ru = __builtin_amdgcn_make_buffer_rsrc((void*)(p.ub8() + (size_t)l * NEXP * ROWB), 0, NEXP * ROWB, 0x00020000);
    const rsrc_t rv = __builtin_amdgcn_make_buffer_rsrc((void*)(p.vb8() + (size_t)l * NEXP * ROWB), 0, NEXP * ROWB, 0x00020000);
    const float* uinv = p.uinv() + (size_t)l * NEXP;
    const float* vinv = p.vinv() + (size_t)l * NEXP;
    const int voff = lane * 8, c0 = lane * 16;
    const float* n2g = p.norm2_g + l * D_MODEL;
    const int tstep = gridDim.x * NWAVES;
    int t = blockIdx.x * NWAVES + wave;
    if (t >= NTOK) return;
    int e0 = p.eidx()[(size_t)t * 128 + lane], e1 = p.eidx()[(size_t)t * 128 + 64 + lane];
    for (; t < NTOK; t += tstep) {
        G4 R[EXR];
        ex_issue<0>(R[0], ru, e0, e1, voff, emask); ex_issue<1>(R[1], ru, e0, e1, voff, emask); ex_issue<2>(R[2], ru, e0, e1, voff, emask); ex_issue<3>(R[3], ru, e0, e1, voff, emask);
#if EXR == 8
        ex_issue<4>(R[4], ru, e0, e1, voff); ex_issue<5>(R[5], ru, e0, e1, voff); ex_issue<6>(R[6], ru, e0, e1, voff); ex_issue<7>(R[7], ru, e0, e1, voff);
#endif
        asm volatile("" ::: "memory");
        const bool has_next = (t + tstep) < NTOK;
        const int tn = has_next ? t + tstep : t;
        const int e0n = p.eidx()[(size_t)tn * 128 + lane], e1n = p.eidx()[(size_t)tn * 128 + 64 + lane];
        const float us0 = uinv[e0], us1 = uinv[e1];
        const float gv0 = p.egate()[(size_t)t * 128 + lane] * vinv[e0], gv1 = p.egate()[(size_t)t * 128 + 64 + lane] * vinv[e1];
        int hq[4]; float sh;
        {
            const float* mb = p.mod() + ((size_t)l * BATCH + t / SEQ) * MODW;
            const float* sp = p.ssq() + (size_t)t * 16;
            const f32x4 s0 = *(const f32x4*)sp, s1 = *(const f32x4*)(sp + 4), s2 = *(const f32x4*)(sp + 8), s3 = *(const f32x4*)(sp + 12);
            const float tot = (((s0[0] + s0[1]) + (s0[2] + s0[3])) + ((s1[0] + s1[1]) + (s1[2] + s1[3]))) + (((s2[0] + s2[1]) + (s2[2] + s2[3])) + ((s3[0] + s3[1]) + (s3[2] + s3[3])));
            const float rs = rsqrtf(tot * (1.0f / D_MODEL) + 1e-6f);
            const u32x4 w0 = *(const u32x4*)(p.hb() + (size_t)t * D_MODEL + c0), w1 = *(const u32x4*)(p.hb() + (size_t)t * D_MODEL + c0 + 8);
            float hv[16];
#pragma unroll
            for (int e = 0; e < 4; ++e) { hv[2 * e] = bflo(w0[e]); hv[2 * e + 1] = bfhi(w0[e]); hv[8 + 2 * e] = bflo(w1[e]); hv[8 + 2 * e + 1] = bfhi(w1[e]); }
            float hm = 0.f;
#pragma unroll
            for (int q = 0; q < 4; ++q) {
                const f32x4 shv = *(const f32x4*)(mb + 3 * D_MODEL + c0 + 4 * q);
#pragma unroll
                for (int e = 0; e < 4; ++e) { hv[4 * q + e] = hv[4 * q + e] * rs + shv[e]; hm = fmaxf(hm, fabsf(hv[4 * q + e])); }
            }
            hm = fmaxf(wave_max(hm), 1e-30f);
            const float qs = 127.0f / hm; sh = hm * (1.0f / 127.0f);
            int hb[16];
#pragma unroll
            for (int e = 0; e < 16; ++e) hb[e] = (int)rintf(hv[e] * qs);
#pragma unroll
            for (int j = 0; j < 4; ++j) {
                const int b0 = (j & 1) + 8 * (j >> 1);
                hq[j] = (hb[b0] & 0xFF) | ((hb[b0 + 2] & 0xFF) << 8) | ((hb[b0 + 4] & 0xFF) << 16) | (hb[b0 + 6] << 24);
            }
        }
        int hinit = 0;
#pragma unroll
        for (int j = 0; j < 4; ++j) hinit = __builtin_amdgcn_sdot4(hq[j], 0x01010101, hinit, false);
        hinit *= -8;
        int KK0 = 0, KK1 = 0;
        ex_turnA<0>(R, hq, hinit, KK0, KK1, ru, rv, e0, e1, voff, lane, emask); ex_turnA<1>(R, hq, hinit, KK0, KK1, ru, rv, e0, e1, voff, lane, emask);
        ex_turnA<2>(R, hq, hinit, KK0, KK1, ru, rv, e0, e1, voff, lane, emask); ex_turnA<3>(R, hq, hinit, KK0, KK1, ru, rv, e0, e1, voff, lane, emask);
#if EXR == 4
        ex_turnA<4>(R, hq, hinit, KK0, KK1, ru, rv, e0, e1, voff, lane, emask); ex_turnA<5>(R, hq, hinit, KK0, KK1, ru, rv, e0, e1, voff, lane, emask);
        ex_turnA<6>(R, hq, hinit, KK0, KK1, ru, rv, e0, e1, voff, lane, emask); ex_turnA<7>(R, hq, hinit, KK0, KK1, ru, rv, e0, e1, voff, lane, emask);
#endif
        const float cf0 = gelu_as((float)KK0 * (us0 * sh)) * gv0, cf1 = gelu_as((float)KK1 * (us1 * sh)) * gv1;
        const float cm = fmaxf(wave_max(fmaxf(fabsf(cf0), fabsf(cf1))), 1e-30f);
        const float cq = 127.0f / cm;
        const int cpk0 = quad_pack((int)rintf(cf0 * cq)), cpk1 = quad_pack((int)rintf(cf1 * cq));
        int yi[16];
#pragma unroll
        for (int e = 0; e < 16; ++e) yi[e] = 0;
        ex_turnB<0>(R, cpk0, cpk1, yi, ru, rv, e0, e1, e0n, e1n, has_next, voff, emask); ex_turnB<1>(R, cpk0, cpk1, yi, ru, rv, e0, e1, e0n, e1n, has_next, voff, emask);
        ex_turnB<2>(R, cpk0, cpk1, yi, ru, rv, e0, e1, e0n, e1n, has_next, voff, emask); ex_turnB<3>(R, cpk0, cpk1, yi, ru, rv, e0, e1, e0n, e1n, has_next, voff, emask);
#if EXR == 4
        ex_turnB<4>(R, cpk0, cpk1, yi, ru, rv, e0, e1, e0n, e1n, has_next, voff, emask); ex_turnB<5>(R, cpk0, cpk1, yi, ru, rv, e0, e1, e0n, e1n, has_next, voff, emask);
        ex_turnB<6>(R, cpk0, cpk1, yi, ru, rv, e0, e1, e0n, e1n, has_next, voff, emask); ex_turnB<7>(R, cpk0, cpk1, yi, ru, rv, e0, e1, e0n, e1n, has_next, voff, emask);
#endif
        const int ci0s = (int)rintf(cf0 * cq) + (int)rintf(cf1 * cq);
        const int csum8 = 8 * __builtin_amdgcn_readlane(wave_isum_l63(ci0s), 63);
        float y[16];
        const float ys = cm * (1.0f / 127.0f);
#pragma unroll
        for (int j = 0; j < 4; ++j)
#pragma unroll
            for (int e = 0; e < 4; ++e) y[(j & 1) + 2 * e + 8 * (j >> 1)] = (float)(yi[4 * j + e] - csum8) * ys;
        if (synth) {
#pragma unroll
            for (int q = 0; q < 4; ++q) *(f32x4*)((float*)p.qb() + (size_t)t * D_MODEL + c0 + 4 * q) = (f32x4){y[4 * q], y[4 * q + 1], y[4 * q + 2], y[4 * q + 3]};
        } else ex_finish(p, l, LAST, t, y, lane);
        e0 = e0n; e1 = e1n;
    }
}
#if MK_MULTI
__global__ void __launch_bounds__(512, 2) k_expert(Params p, int l) {
    extern __shared__ __attribute__((aligned(16))) unsigned char smem_raw[];
    phase_expert(p, l, l == DEPTH - 1, (LAS unsigned char*)smem_raw, __builtin_amdgcn_readfirstlane((int)threadIdx.x >> 6));
}
#endif
typedef short s16x4 __attribute__((ext_vector_type(4)));
#define AT_KSTR 144
#define AT_VSTR 192
#define AT_KBUF 0
#define AT_VBUF 18432
#define AT_TBL  43008
#define AT_OEX  44032
#define AT_OSTR 272

__device__ __forceinline__ void phase_attn(const Params& p, int l, LAS unsigned char* lds, int wv) {
    const int tid = tid_opaque(wv), wave = tid >> 6, lane = tid & 63;
    const int w4 = wave & 3, m = wave >> 2, c = lane & 31, h = lane >> 5;
    const float LOG2E = 1.4426950408889634f;
    const float qscale = 0.17677669529663687f * LOG2E;
    float d01 = 0.f, d23 = 0.f;
    { const float* lp = p.diff_lambda + l * 128;
      for (int i = 0; i < 32; ++i) { d01 += lp[i] * lp[32 + i]; d23 += lp[64 + i] * lp[96 + i]; } }
    const float lam_init = p.lam_init[l];
    const float lam = expf(d01) - expf(d23) + lam_init;
    const float osc = 1.0f - lam_init;
    LAS float* tbl = (LAS float*)(lds + AT_TBL);
    const int skey = tid >> 3, sch = tid & 7;
    const int g16 = lane >> 4, li = lane & 15, tq = li >> 2, tp = li & 3;

    for (int u = blockIdx.x; u < 256; u += gridDim.x) {
        const int pi = u & 7, hd = (u >> 3) & 3, b = u >> 5;
        if (tid < 256) { const int bk = tid < 128 ? (int)kBucket[tid] : 31; tbl[tid] = p.rel_bias[bk * 4 + hd] * LOG2E; }
        const float c31 = p.rel_bias[31 * 4 + hd] * LOG2E;
        const bf16_t* pbase = p.pb() + (size_t)b * SEQ * MIX_IN;
        const bf16_t* kg = pbase + (size_t)skey * MIX_IN + 256 + hd * 64 + sch * 8;
        const bf16_t* vg = pbase + (size_t)skey * MIX_IN + 512 + hd * 64 + sch * 8;
        for (int half = 0; half < 2; ++half) {
            const int qb = half ? 15 - pi : pi;
            const int q0w = qb * 128 + 32 * w4, nkt = 2 * qb + 2;
            const int qpos = q0w + c;
            bf16x8 qf0, qf1;
            { const bf16_t* qp = pbase + (size_t)qpos * MIX_IN + hd * 64 + m * 32 + 8 * h; qf0 = *(const bf16x8*)qp; qf1 = *(const bf16x8*)(qp + 16); }
            f32x16 O0, O1;
#pragma unroll
            for (int r = 0; r < 16; ++r) { O0[r] = 0.f; O1[r] = 0.f; }
            float mrun = -1e30f, lrun = 0.f;
            u32x4 kreg = *(const u32x4*)kg, vreg = *(const u32x4*)vg;
            *(LAS u32x4*)(lds + AT_KBUF + skey * AT_KSTR + sch * 16) = kreg;
            *(LAS u32x4*)(lds + AT_VBUF + skey * AT_VSTR + sch * 16) = vreg;
            __syncthreads();
            for (int kt = 0; kt < nkt; ++kt) {
                const int k0 = kt * 64, cur = kt & 1;
                if (kt + 1 < nkt) { kreg = *(const u32x4*)(kg + (size_t)(k0 + 64) * MIX_IN); vreg = *(const u32x4*)(vg + (size_t)(k0 + 64) * MIX_IN); }
                if (k0 <= q0w + 31) {
                    LAS unsigned char* kb_ = lds + AT_KBUF + cur * (64 * AT_KSTR);
                    LAS unsigned char* vb_ = lds + AT_VBUF + cur * (64 * AT_VSTR);
                    f32x16 s0, s1;
#pragma unroll
                    for (int r = 0; r < 16; ++r) { s0[r] = 0.f; s1[r] = 0.f; }
                    {
                        const LAS unsigned char* ka = kb_ + c * AT_KSTR + m * 64 + h * 16;
                        const bf16x8 a00 = *(const LAS bf16x8*)ka, a01 = *(const LAS bf16x8*)(ka + 32);
                        const bf16x8 a10 = *(const LAS bf16x8*)(ka + 32 * AT_KSTR), a11 = *(const LAS bf16x8*)(ka + 32 * AT_KSTR + 32);
                        s0 = __builtin_amdgcn_mfma_f32_32x32x16_bf16(a00, qf0, s0, 0, 0, 0);
                        s0 = __builtin_amdgcn_mfma_f32_32x32x16_bf16(a01, qf1, s0, 0, 0, 0);
                        s1 = __builtin_amdgcn_mfma_f32_32x32x16_bf16(a10, qf0, s1, 0, 0, 0);
                        s1 = __builtin_amdgcn_mfma_f32_32x32x16_bf16(a11, qf1, s1, 0, 0, 0);
                    }
                    const bool far = (q0w - (k0 + 63)) >= 113;
                    if (far) {
#pragma unroll
                        for (int r = 0; r < 16; ++r) { s0[r] = s0[r] * qscale + c31; s1[r] = s1[r] * qscale + c31; }
                    } else {
                        const int dbase = qpos - k0 - 4 * h;
#pragma unroll
                        for (int r = 0; r < 16; ++r) {
                            const int d0 = dbase - ((r & 3) + 8 * (r >> 2)), d1 = d0 - 32;
                            const float b0 = tbl[min(max(d0, 0), 255)], b1 = tbl[min(max(d1, 0), 255)];
                            const float v0 = s0[r] * qscale + b0, v1 = s1[r] * qscale + b1;
                            s0[r] = d0 < 0 ? -1e30f : v0; s1[r] = d1 < 0 ? -1e30f : v1;
                        }
                    }
                    float tmax = fmaxf(s0[0], s1[0]);
#pragma unroll
                    for (int r = 1; r < 16; ++r) tmax = fmaxf(tmax, fmaxf(s0[r], s1[r]));
                    tmax = fmaxf(tmax, __shfl_xor(tmax, 32, 64));
                    const float mnew = fmaxf(mrun, tmax);
                    const float alpha = __builtin_amdgcn_exp2f(mrun - mnew);
                    mrun = mnew;
                    float psum = 0.f;
#pragma unroll
                    for (int r = 0; r < 16; ++r) { s0[r] = __builtin_amdgcn_exp2f(s0[r] - mnew); s1[r] = __builtin_amdgcn_exp2f(s1[r] - mnew); psum += s0[r] + s1[r]; }
                    lrun = lrun * alpha + psum;
#pragma unroll
                    for (int r = 0; r < 16; ++r) { O0[r] *= alpha; O1[r] *= alpha; }
#pragma unroll
                    for (int kb = 0; kb < 2; ++kb)
#pragma unroll
                        for (int sp = 0; sp < 2; ++sp) {
                            u32x4 pw;
                            if (kb == 0) { pw.x = pk2(s0[8 * sp + 0], s0[8 * sp + 1]); pw.y = pk2(s0[8 * sp + 2], s0[8 * sp + 3]); pw.z = pk2(s0[8 * sp + 4], s0[8 * sp + 5]); pw.w = pk2(s0[8 * sp + 6], s0[8 * sp + 7]); }
                            else         { pw.x = pk2(s1[8 * sp + 0], s1[8 * sp + 1]); pw.y = pk2(s1[8 * sp + 2], s1[8 * sp + 3]); pw.z = pk2(s1[8 * sp + 4], s1[8 * sp + 5]); pw.w = pk2(s1[8 * sp + 6], s1[8 * sp + 7]); }
                            const bf16x8 pf = __builtin_bit_cast(bf16x8, pw);
                            const int kA = 32 * kb + 16 * sp + 4 * h;
#pragma unroll
                            for (int mb = 0; mb < 2; ++mb) {
                                LAS unsigned char* va = vb_ + (kA + tq) * AT_VSTR + (32 * mb + 16 * (g16 & 1) + 4 * tp) * 2;
                                const s16x4 t0 = __builtin_amdgcn_ds_read_tr16_b64_v4i16((LAS s16x4*)va);
                                const s16x4 t1 = __builtin_amdgcn_ds_read_tr16_b64_v4i16((LAS s16x4*)(va + 8 * AT_VSTR));
                                const bf16x8 vf = {t0[0], t0[1], t0[2], t0[3], t1[0], t1[1], t1[2], t1[3]};
                                if (mb == 0) O0 = __builtin_amdgcn_mfma_f32_32x32x16_bf16(vf, pf, O0, 0, 0, 0);
                                else         O1 = __builtin_amdgcn_mfma_f32_32x32x16_bf16(vf, pf, O1, 0, 0, 0);
                            }
                        }
                }
                if (kt + 1 < nkt) {
                    *(LAS u32x4*)(lds + AT_KBUF + (cur ^ 1) * (64 * AT_KSTR) + skey * AT_KSTR + sch * 16) = kreg;
                    *(LAS u32x4*)(lds + AT_VBUF + (cur ^ 1) * (64 * AT_VSTR) + skey * AT_VSTR + sch * 16) = vreg;
                }
                __syncthreads();
            }
            const float inv = 1.0f / (lrun + __shfl_xor(lrun, 32, 64));
            LAS unsigned char* oex = lds + AT_OEX + (32 * w4 + c) * AT_OSTR + 16 * h;
            if (m == 1) {
#pragma unroll
                for (int r4 = 0; r4 < 4; ++r4) {
                    f32x4 a, bq;
#pragma unroll
                    for (int e = 0; e < 4; ++e) { a[e] = O0[4 * r4 + e] * inv; bq[e] = O1[4 * r4 + e] * inv; }
                    *(LAS f32x4*)(oex + (8 * r4) * 4) = a;
                    *(LAS f32x4*)(oex + (32 + 8 * r4) * 4) = bq;
                }
            }
            __syncthreads();
            if (m == 0) {
                float ss = 0.f;
#pragma unroll
                for (int r4 = 0; r4 < 4; ++r4) {
                    const f32x4 a = *(const LAS f32x4*)(oex + (8 * r4) * 4), bq = *(const LAS f32x4*)(oex + (32 + 8 * r4) * 4);
#pragma unroll
                    for (int e = 0; e < 4; ++e) {
                        O0[4 * r4 + e] = O0[4 * r4 + e] * inv - lam * a[e]; O1[4 * r4 + e] = O1[4 * r4 + e] * inv - lam * bq[e];
                        ss += O0[4 * r4 + e] * O0[4 * r4 + e] + O1[4 * r4 + e] * O1[4 * r4 + e];
                    }
                }
                ss += __shfl_xor(ss, 32, 64);
                const float rstd = rsqrtf(ss * (1.0f / 64.0f) + 1e-6f) * osc;
                bf16_t* orow = p.cat() + (size_t)(b * SEQ + qpos) * D_MODEL + hd * 64 + 4 * h;
                const float* sg = p.subln_g + l * 64 + 4 * h;
#pragma unroll
                for (int r4 = 0; r4 < 4; ++r4) {
                    const f32x4 ga = *(const f32x4*)(sg + 8 * r4), gb = *(const f32x4*)(sg + 32 + 8 * r4);
                    u32x2 oa, ob;
                    oa.x = pk2(O0[4 * r4 + 0] * rstd * ga[0], O0[4 * r4 + 1] * rstd * ga[1]); oa.y = pk2(O0[4 * r4 + 2] * rstd * ga[2], O0[4 * r4 + 3] * rstd * ga[3]);
                    ob.x = pk2(O1[4 * r4 + 0] * rstd * gb[0], O1[4 * r4 + 1] * rstd * gb[1]); ob.y = pk2(O1[4 * r4 + 2] * rstd * gb[2], O1[4 * r4 + 3] * rstd * gb[3]);
                    *(u32x2*)(orow + 8 * r4) = oa;
                    *(u32x2*)(orow + 32 + 8 * r4) = ob;
                }
            }
            __syncthreads();
        }
    }
}
#if MK_MULTI
template <int DUMMY>
__global__ void __launch_bounds__(512, 2) k_attn2(Params p, int l) {
    extern __shared__ __attribute__((aligned(16))) unsigned char smem_raw[];
    phase_attn(p, l, (LAS unsigned char*)smem_raw, __builtin_amdgcn_readfirstlane((int)threadIdx.x >> 6));
}
#endif
#define MR_VSTR 272

__device__ __forceinline__ void mixrest_conv(const Params& p, int l, int chunk, LAS unsigned char* lds, int wv) {
    const int tid = tid_opaque(wv), wave = tid >> 6, lane = tid & 63;
    const int t0 = chunk * 128, s0 = t0 % SEQ;
    LAS float* glu = (LAS float*)lds;
    const int c = tid & 255, th = tid >> 8;
    float w[31];
#pragma unroll
    for (int j = 0; j < 31; ++j) w[j] = p.conf_dw[((size_t)l * 31 + j) * 256 + c];
    for (int hf = 0; hf < 2; ++hf) {
        const int tb = t0 + hf * 64;
        for (int it = tid; it < 94 * 32; it += 512) {
            const int i = it >> 5, c8 = (it & 31) * 8;
            const int sp = s0 + hf * 64 - 30 + i;
            f32x4 o0 = {0.f, 0.f, 0.f, 0.f}, o1 = {0.f, 0.f, 0.f, 0.f};
            if (sp >= 0) {
                const bf16_t* pr = p.pb() + (size_t)(tb - 30 + i) * MIX_IN;
                const u32x4 a = *(const u32x4*)(pr + 3 * 256 + c8), g = *(const u32x4*)(pr + 4 * 256 + c8);
                o0[0] = bflo(a.x) * sigmoidf_(bflo(g.x)); o0[1] = bfhi(a.x) * sigmoidf_(bfhi(g.x));
                o0[2] = bflo(a.y) * sigmoidf_(bflo(g.y)); o0[3] = bfhi(a.y) * sigmoidf_(bfhi(g.y));
                o1[0] = bflo(a.z) * sigmoidf_(bflo(g.z)); o1[1] = bfhi(a.z) * sigmoidf_(bfhi(g.z));
                o1[2] = bflo(a.w) * sigmoidf_(bflo(g.w)); o1[3] = bfhi(a.w) * sigmoidf_(bfhi(g.w));
            }
            *(LAS f32x4*)(glu + i * 256 + c8) = o0; *(LAS f32x4*)(glu + i * 256 + c8 + 4) = o1;
        }
        __syncthreads();
        float acc[32];
#pragma unroll
        for (int o = 0; o < 32; ++o) acc[o] = 0.f;
#pragma unroll
        for (int i = 0; i < 62; ++i) {
            const float xval = glu[(th * 32 + i) * 256 + c];
#pragma unroll
            for (int o = 0; o < 32; ++o) if (i - o >= 0 && i - o <= 30) acc[o] += w[i - o] * xval;
        }
        __syncthreads();
#pragma unroll
        for (int o = 0; o < 32; ++o) glu[(th * 32 + o) * 256 + c] = acc[o];
        __syncthreads();
        const f32x4 lg = *(const f32x4*)(p.conf_ln_g + l * 256 + lane * 4), lb = *(const f32x4*)(p.conf_ln_b + l * 256 + lane * 4);
        for (int k = 0; k < 8; ++k) {
            const int tk = wave * 8 + k;
            const f32x4 z = *(const LAS f32x4*)(glu + tk * 256 + lane * 4);
            const float mu = wave_sum(z[0] + z[1] + z[2] + z[3]) * (1.0f / 256.0f);
            f32x4 dz; float sq = 0.f;
#pragma unroll
            for (int e = 0; e < 4; ++e) { dz[e] = z[e] - mu; sq += dz[e] * dz[e]; }
            const float rstd = rsqrtf(wave_sum(sq) * (1.0f / 256.0f) + 1e-6f);
            float y[4];
#pragma unroll
            for (int e = 0; e < 4; ++e) { const float v = dz[e] * rstd * lg[e] + lb[e]; y[e] = v * sigmoidf_(v); }
            u32x2 o; o.x = pk2(y[0], y[1]); o.y = pk2(y[2], y[3]);
            *(u32x2*)(p.cat() + (size_t)(tb + tk) * D_MODEL + 256 + lane * 4) = o;
        }
        __syncthreads();
    }
}

__device__ __forceinline__ void mixrest_sgu(const Params& p, int l, int chunk, LAS unsigned char* lds, int wv) {
    const int tid = tid_opaque(wv), wave = tid >> 6, lane = tid & 63;
    const int t0 = chunk * 128, s0 = t0 % SEQ;
    {
        const float* sw = p.sconv_w + (size_t)l * 3 * 256;
        for (int it = tid; it < 128 * 32; it += 512) {
            const int tt = it >> 5, c8 = (it & 31) * 8;
            const bf16_t* pr = p.pb() + (size_t)(t0 + tt) * MIX_IN;
            float z[8];
#pragma unroll
            for (int e = 0; e < 8; ++e) z[e] = 0.f;
#pragma unroll
            for (int j = 0; j < 3; ++j) {
                if (s0 + tt - 2 + j >= 0) {
                    const bf16_t* q = pr + (ptrdiff_t)(j - 2) * MIX_IN;
                    const u32x4 a = *(const u32x4*)(q + 6 * 256 + c8), bq = *(const u32x4*)(q + 7 * 256 + c8);
                    const f32x4 w0 = *(const f32x4*)(sw + j * 256 + c8), w1 = *(const f32x4*)(sw + j * 256 + c8 + 4);
                    z[0] += w0[0] * bflo(a.x) * bflo(bq.x); z[1] += w0[1] * bfhi(a.x) * bfhi(bq.x);
                    z[2] += w0[2] * bflo(a.y) * bflo(bq.y); z[3] += w0[3] * bfhi(a.y) * bfhi(bq.y);
                    z[4] += w1[0] * bflo(a.z) * bflo(bq.z); z[5] += w1[1] * bfhi(a.z) * bfhi(bq.z);
                    z[6] += w1[2] * bflo(a.w) * bflo(bq.w); z[7] += w1[3] * bfhi(a.w) * bfhi(bq.w);
                }
            }
            const u32x4 cb = *(const u32x4*)(pr + 5 * 256 + c8);
            u32x4 o;
            o.x = pk2(bflo(cb.x) * z[0], bfhi(cb.x) * z[1]); o.y = pk2(bflo(cb.y) * z[2], bfhi(cb.y) * z[3]);
            o.z = pk2(bflo(cb.z) * z[4], bfhi(cb.z) * z[5]); o.w = pk2(bflo(cb.w) * z[6], bfhi(cb.w) * z[7]);
            *(u32x4*)(p.cat() + (size_t)(t0 + tt) * D_MODEL + 512 + c8) = o;
        }
    }
    {
        const f32x4 lg = *(const f32x4*)(p.sgu_ln_g + l * 256 + lane * 4), lb = *(const f32x4*)(p.sgu_ln_b + l * 256 + lane * 4);
        for (int k = 0; k < 16; ++k) {
            const int s = wave * 16 + k;
            const u32x2 raw = *(const u32x2*)(p.pb() + (size_t)(t0 + s) * MIX_IN + 9 * 256 + lane * 4);
            float v[4] = {gelu_as(bflo(raw.x)), gelu_as(bfhi(raw.x)), gelu_as(bflo(raw.y)), gelu_as(bfhi(raw.y))};
            const float mu = wave_sum(v[0] + v[1] + v[2] + v[3]) * (1.0f / 256.0f);
            float sq = 0.f;
#pragma unroll
            for (int e = 0; e < 4; ++e) { v[e] -= mu; sq += v[e] * v[e]; }
            const float rstd = rsqrtf(wave_sum(sq) * (1.0f / 256.0f) + 1e-6f);
#pragma unroll
            for (int e = 0; e < 4; ++e) *(LAS bf16_t*)(lds + (lane * 4 + e) * MR_VSTR + s * 2) = f2bf(v[e] * rstd * lg[e] + lb[e]);
        }
    }
    __syncthreads();
    {
        const int hq = wave & 3, mb = wave >> 2, c = lane & 31, hh = lane >> 5;
        bf16x8 af[8];
#pragma unroll
        for (int ks = 0; ks < 8; ++ks) af[ks] = *(const LAS bf16x8*)(lds + (hq * 64 + mb * 32 + c) * MR_VSTR + (16 * ks + 8 * hh) * 2);
        const bf16_t* wb = p.sguwb() + ((size_t)(l * 4 + hq) * 128) * 128;
        f32x16 acc[4];
#pragma unroll
        for (int nb = 0; nb < 4; ++nb) {
#pragma unroll
            for (int r = 0; r < 16; ++r) acc[nb][r] = 0.f;
#pragma unroll
            for (int ks = 0; ks < 2 * nb + 2; ++ks) {
                const bf16x8 bfrag = *(const bf16x8*)(wb + (size_t)(32 * nb + c) * 128 + 16 * ks + 8 * hh);
                acc[nb] = __builtin_amdgcn_mfma_f32_32x32x16_bf16(af[ks], bfrag, acc[nb], 0, 0, 0);
            }
        }
        const float* bs = p.sgu_b + (size_t)(l * 4 + hq) * 128;
#pragma unroll
        for (int nb = 0; nb < 4; ++nb) {
            const int tt = 32 * nb + c;
            const float bias = bs[tt];
            const bf16_t* su = p.pb() + (size_t)(t0 + tt) * MIX_IN + 8 * 256 + hq * 64 + mb * 32 + 4 * hh;
            bf16_t* orow = p.cat() + (size_t)(t0 + tt) * D_MODEL + 768 + hq * 64 + mb * 32 + 4 * hh;
#pragma unroll
            for (int r4 = 0; r4 < 4; ++r4) {
                const u32x2 raw = *(const u32x2*)(su + 8 * r4);
                u32x2 o;
                o.x = pk2(gelu_as(bflo(raw.x)) * (acc[nb][4 * r4 + 0] + bias), gelu_as(bfhi(raw.x)) * (acc[nb][4 * r4 + 1] + bias));
                o.y = pk2(gelu_as(bflo(raw.y)) * (acc[nb][4 * r4 + 2] + bias), gelu_as(bfhi(raw.y)) * (acc[nb][4 * r4 + 3] + bias));
                *(u32x2*)(orow + 8 * r4) = o;
            }
        }
    }
    __syncthreads();
}

__device__ __forceinline__ void phase_mixrest(const Params& p, int l, LAS unsigned char* lds, int wv) {
    for (int u = blockIdx.x; u < 256; u += gridDim.x) {
        const int chunk = u >> 1;
        if (u & 1) mixrest_sgu(p, l, chunk, lds, wv); else mixrest_conv(p, l, chunk, lds, wv);
    }
}
#if MK_MULTI
template <int DUMMY>
__global__ void __launch_bounds__(512, 2) k_mixrest(Params p, int l) {
    extern __shared__ __attribute__((aligned(16))) unsigned char smem_raw[];
    phase_mixrest(p, l, (LAS unsigned char*)smem_raw, __builtin_amdgcn_readfirstlane((int)threadIdx.x >> 6));
}
#endif
__device__ __forceinline__ int f2sortable(float f) { const int x = __float_as_int(f); return x ^ ((x >> 31) & 0x7FFFFFFF); }
__device__ __forceinline__ float sortable2f(int s) { return __int_as_float(s ^ ((s >> 31) & 0x7FFFFFFF)); }

template <int N>
__device__ __forceinline__ void bitonic_sort_desc(int (&a)[N]) {
#pragma unroll
    for (int k = 2; k <= N; k <<= 1)
#pragma unroll
        for (int j = k >> 1; j > 0; j >>= 1)
#pragma unroll
            for (int i = 0; i < N; ++i) {
                const int q = i ^ j;
                if (q > i) {
                    const int hi = max(a[i], a[q]), lo = min(a[i], a[q]);
                    if ((i & k) == 0 || k == N) { a[i] = hi; a[q] = lo; } else { a[i] = lo; a[q] = hi; }
                }
            }
}
__device__ __forceinline__ void bitonic_merge_desc16(int (&a)[16]) {
#pragma unroll
    for (int j = 8; j > 0; j >>= 1)
#pragma unroll
        for (int i = 0; i < 16; ++i) {
            const int q = i ^ j;
            if (q > i) { const int hi = max(a[i], a[q]), lo = min(a[i], a[q]); a[i] = hi; a[q] = lo; }
        }
}
__device__ __forceinline__ void merge_top16(int (&a)[16], const int (&b)[16]) {
#pragma unroll
    for (int i = 0; i < 16; ++i) a[i] = max(a[i], b[15 - i]);
    bitonic_merge_desc16(a);
}

#define TK_KEYS 8192
#define TK_KSTR 272
template <bool TO_LDS>
__device__ __forceinline__ void topk_unit(const Params& p, int l, int u, int hd, LAS unsigned char* lds, int wave, int lane, LAS int* le, LAS float* lg) {
    const int c = lane & 31, hh = lane >> 5;
    LAS unsigned char* ilist = lds + wave * 1024 + c * 32;
    const int hx = hh << 2;
    const __amdgpu_buffer_rsrc_t rq = __builtin_amdgcn_make_buffer_rsrc((void*)p.qb(), 0, NTOK * 2048 * 2, 0x00020000);
    const int qvoff = c * 4096 + hh * 16;
    {
        const int t = u * 32 + c;
        int S0[16], S1[16];
#pragma unroll
        for (int pp = 0; pp < 2; ++pp) {
            bf16x8 qf[8];
            {
                const int qso = (u * 32) * 4096 + hd * 512 + pp * 256;
#pragma unroll
                for (int ks = 0; ks < 8; ++ks) qf[ks] = __builtin_bit_cast(bf16x8, __builtin_amdgcn_raw_buffer_load_b128(rq, qvoff + 32 * ks, qso, 0));
            }
            const LAS unsigned char* kl = lds + TK_KEYS + (pp * 128 + c) * TK_KSTR + hh * 16;
            int K0[16], K1[16], K2[16], K3[16];
#pragma unroll
            for (int kb = 0; kb < 4; ++kb) {
                asm volatile("" ::: "memory");
                f32x16 acc;
#pragma unroll
                for (int r = 0; r < 16; ++r) acc[r] = 0.f;
#pragma unroll
                for (int ks = 0; ks < 8; ++ks) {
                    const bf16x8 a = *(const LAS bf16x8*)(kl + (32 * kb) * TK_KSTR + 32 * ks);
                    acc = __builtin_amdgcn_mfma_f32_32x32x16_bf16(a, qf[ks], acc, 0, 0, 0);
                }
#pragma unroll
                for (int r = 0; r < 16; ++r) {
                    const int nconst = 32 * kb + (r & 3) + 8 * (r >> 2);
                    const int key = (f2sortable(acc[r]) & ~0x7F) | (127 - nconst);
                    if (kb == 0) K0[r] = key; else if (kb == 1) K1[r] = key; else if (kb == 2) K2[r] = key; else K3[r] = key;
                }
            }
            bitonic_sort_desc<16>(K0); bitonic_sort_desc<16>(K1); bitonic_sort_desc<16>(K2); bitonic_sort_desc<16>(K3);
            merge_top16(K0, K1); merge_top16(K2, K3); merge_top16(K0, K2);
            int P[16];
#pragma unroll
            for (int i = 0; i < 16; ++i) { K0[i] ^= hx; P[i] = __shfl_xor(K0[i], 32, 64); }
            merge_top16(K0, P);
#pragma unroll
            for (int i = 0; i < 16; ++i) { if (pp == 0) S0[i] = K0[i]; else S1[i] = K0[i]; }
        }
        {
            unsigned w4[4];
#pragma unroll
            for (int q = 0; q < 4; ++q) {
                unsigned w = 0;
#pragma unroll
                for (int e = 0; e < 4; ++e) { const int sv = hh ? S1[4 * q + e] : S0[4 * q + e]; w |= (unsigned)(127 - (sv & 127)) << (8 * e); }
                w4[q] = w;
            }
            u32x4 wv; wv.x = w4[0]; wv.y = w4[1]; wv.z = w4[2]; wv.w = w4[3];
            *(LAS u32x4*)(ilist + 16 * hh) = wv;
        }
        float a[16], b[16];
#pragma unroll
        for (int i = 0; i < 16; ++i) {
            const float f1 = sortable2f(S0[i] & ~0x7F), f2 = sortable2f(S1[i] & ~0x7F);
            a[i] = hh ? f2 : f1; b[i] = hh ? f1 : f2;
        }
        int CA[16], CB[16];
        const int org = hh << 8;
        {
            int n = 0;
#pragma unroll
            for (int i = 0; i < 4; ++i)
#pragma unroll
                for (int j = i; j < 16; ++j) {
                    if ((i + 1) * (j + 1) <= 16) {
                        int key = (f2sortable(a[i] + b[j]) & ~0x1FF) | org | (i * 16 + j);
                        if (i == j) key = hh ? (int)0x80000000 : key;
                        if (n < 16) CA[n] = key; else CB[n - 16] = key;
                        ++n;
                    }
                }
#pragma unroll
            for (int q = 27; q < 32; ++q) CB[q - 16] = (int)0x80000000;
        }
        bitonic_sort_desc<16>(CA); bitonic_sort_desc<16>(CB);
        merge_top16(CA, CB);
        int F[16], PF[16];
#pragma unroll
        for (int i = 0; i < 16; ++i) PF[i] = __shfl_xor(CA[i], 32, 64);
#pragma unroll
        for (int i = 0; i < 16; ++i) F[i] = max(CA[i], PF[15 - i]);
        int mxk = F[0];
#pragma unroll
        for (int i = 1; i < 16; ++i) mxk = max(mxk, F[i]);
        const float vmax = sortable2f(mxk & ~0x1FF);
        float e[8], psum = 0.f;
#pragma unroll
        for (int i = 0; i < 8; ++i) { e[i] = __expf(sortable2f(F[i] & ~0x1FF) - vmax); psum += e[i]; }
        const float inv = 1.0f / (psum + __shfl_xor(psum, 32, 64));
        asm volatile("s_waitcnt lgkmcnt(0)" ::: "memory");
        int ex[8];
#pragma unroll
        for (int i = 0; i < 8; ++i) {
            const int low = F[i] & 0x1FF, o = low >> 8, il = (low >> 4) & 15, jl = low & 15;
            const int ri = o ? jl : il, rj = o ? il : jl;
            const int i1 = (int)*(const LAS unsigned char*)(ilist + ri), i2 = (int)*(const LAS unsigned char*)(ilist + 16 + rj);
            ex[i] = i1 * 128 + i2;
        }
        if (TO_LDS) {
            LAS int* ep = le + (c * 8 + hd) * 16 + hh * 8;
            LAS float* gp = lg + (c * 8 + hd) * 16 + hh * 8;
            *(LAS u32x4*)ep = (u32x4){(unsigned)ex[0], (unsigned)ex[1], (unsigned)ex[2], (unsigned)ex[3]};
            *(LAS u32x4*)(ep + 4) = (u32x4){(unsigned)ex[4], (unsigned)ex[5], (unsigned)ex[6], (unsigned)ex[7]};
            *(LAS f32x4*)gp = (f32x4){e[0] * inv, e[1] * inv, e[2] * inv, e[3] * inv};
            *(LAS f32x4*)(gp + 4) = (f32x4){e[4] * inv, e[5] * inv, e[6] * inv, e[7] * inv};
        } else {
            int* ep = p.eidx() + ((size_t)t * 8 + hd) * 16 + hh * 8;
            float* gp = p.egate() + ((size_t)t * 8 + hd) * 16 + hh * 8;
            *(u32x4*)ep = (u32x4){(unsigned)ex[0], (unsigned)ex[1], (unsigned)ex[2], (unsigned)ex[3]};
            *(u32x4*)(ep + 4) = (u32x4){(unsigned)ex[4], (unsigned)ex[5], (unsigned)ex[6], (unsigned)ex[7]};
            *(f32x4*)gp = (f32x4){e[0] * inv, e[1] * inv, e[2] * inv, e[3] * inv};
            *(f32x4*)(gp + 4) = (f32x4){e[4] * inv, e[5] * inv, e[6] * inv, e[7] * inv};
        }
        asm volatile("s_waitcnt lgkmcnt(0)" ::: "memory");
    }
}
__device__ __forceinline__ void phase_topk(const Params& p, int l, LAS unsigned char* lds, int wv) {
    const int tid = tid_opaque(wv), wave = __builtin_amdgcn_readfirstlane(tid >> 6), lane = tid & 63;
    int cur_hd = -1;
    for (int u = blockIdx.x; u < 8 * (NTOK / 256); u += gridDim.x) {
        const int hd = u & 7, tg = u >> 3;
        if (hd != cur_hd) {
            __syncthreads();
            const bf16_t* kg = p.keysb() + ((size_t)(l * 8 + hd) * 2) * 128 * 128;
            for (int i = tid; i < 2 * 128 * 16; i += 512) {
                const u32x4 v = *(const u32x4*)(kg + (size_t)(i >> 4) * 128 + (i & 15) * 8);
                *(LAS u32x4*)(lds + TK_KEYS + (i >> 4) * TK_KSTR + (i & 15) * 16) = v;
            }
            __syncthreads();
            cur_hd = hd;
        }
        topk_unit<false>(p, l, tg * 8 + wave, hd, lds, wave, lane, nullptr, nullptr);
    }
}
#if MK_MULTI
template <int DUMMY>
__global__ void __launch_bounds__(512, 2) k_topk(Params p, int l) {
    extern __shared__ __attribute__((aligned(16))) unsigned char smem_raw[];
    phase_topk(p, l, (LAS unsigned char*)smem_raw, __builtin_amdgcn_readfirstlane((int)threadIdx.x >> 6));
}
#endif
#if PROBE_UB
__device__ __forceinline__ void ubench(int iters, unsigned seed) {
    float r[16]; f32x2 r2[8];
#pragma unroll
    for (int i = 0; i < 16; ++i) r[i] = __uint_as_float(seed + i);
#pragma unroll
    for (int i = 0; i < 8; ++i) r2[i] = (f32x2){r[2 * i], r[2 * i + 1]};
    float a = __uint_as_float(seed * 3u + 1u), b = __uint_as_float(seed * 5u + 7u);
    for (int it = 0; it < iters; ++it) {
#if PROBE_UB == 1
        asm volatile("v_fma_f32 %0, %16, %17, %0\n\tv_fma_f32 %1, %16, %17, %1\n\tv_fma_f32 %2, %16, %17, %2\n\tv_fma_f32 %3, %16, %17, %3\n\tv_fma_f32 %4, %16, %17, %4\n\tv_fma_f32 %5, %16, %17, %5\n\tv_fma_f32 %6, %16, %17, %6\n\tv_fma_f32 %7, %16, %17, %7\n\tv_fma_f32 %8, %16, %17, %8\n\tv_fma_f32 %9, %16, %17, %9\n\tv_fma_f32 %10, %16, %17, %10\n\tv_fma_f32 %11, %16, %17, %11\n\tv_fma_f32 %12, %16, %17, %12\n\tv_fma_f32 %13, %16, %17, %13\n\tv_fma_f32 %14, %16, %17, %14\n\tv_fma_f32 %15, %16, %17, %15\n\t" : "+v"(r[0]), "+v"(r[1]), "+v"(r[2]), "+v"(r[3]), "+v"(r[4]), "+v"(r[5]), "+v"(r[6]), "+v"(r[7]), "+v"(r[8]), "+v"(r[9]), "+v"(r[10]), "+v"(r[11]), "+v"(r[12]), "+v"(r[13]), "+v"(r[14]), "+v"(r[15]) : "v"(a), "v"(b) : "s40", "vcc");
        asm volatile("v_fma_f32 %0, %16, %17, %0\n\tv_fma_f32 %1, %16, %17, %1\n\tv_fma_f32 %2, %16, %17, %2\n\tv_fma_f32 %3, %16, %17, %3\n\tv_fma_f32 %4, %16, %17, %4\n\tv_fma_f32 %5, %16, %17, %5\n\tv_fma_f32 %6, %16, %17, %6\n\tv_fma_f32 %7, %16, %17, %7\n\tv_fma_f32 %8, %16, %17, %8\n\tv_fma_f32 %9, %16, %17, %9\n\tv_fma_f32 %10, %16, %17, %10\n\tv_fma_f32 %11, %16, %17, %11\n\tv_fma_f32 %12, %16, %17, %12\n\tv_fma_f32 %13, %16, %17, %13\n\tv_fma_f32 %14, %16, %17, %14\n\tv_fma_f32 %15, %16, %17, %15\n\t" : "+v"(r[0]), "+v"(r[1]), "+v"(r[2]), "+v"(r[3]), "+v"(r[4]), "+v"(r[5]), "+v"(r[6]), "+v"(r[7]), "+v"(r[8]), "+v"(r[9]), "+v"(r[10]), "+v"(r[11]), "+v"(r[12]), "+v"(r[13]), "+v"(r[14]), "+v"(r[15]) : "v"(a), "v"(b) : "s40", "vcc");
#endif
#if PROBE_UB == 2
        asm volatile("v_dot4c_i32_i8 %0, %16, %17\n\tv_dot4c_i32_i8 %1, %16, %17\n\tv_dot4c_i32_i8 %2, %16, %17\n\tv_dot4c_i32_i8 %3, %16, %17\n\tv_dot4c_i32_i8 %4, %16, %17\n\tv_dot4c_i32_i8 %5, %16, %17\n\tv_dot4c_i32_i8 %6, %16, %17\n\tv_dot4c_i32_i8 %7, %16, %17\n\tv_dot4c_i32_i8 %8, %16, %17\n\tv_dot4c_i32_i8 %9, %16, %17\n\tv_dot4c_i32_i8 %10, %16, %17\n\tv_dot4c_i32_i8 %11, %16, %17\n\tv_dot4c_i32_i8 %12, %16, %17\n\tv_dot4c_i32_i8 %13, %16, %17\n\tv_dot4c_i32_i8 %14, %16, %17\n\tv_dot4c_i32_i8 %15, %16, %17\n\t" : "+v"(r[0]), "+v"(r[1]), "+v"(r[2]), "+v"(r[3]), "+v"(r[4]), "+v"(r[5]), "+v"(r[6]), "+v"(r[7]), "+v"(r[8]), "+v"(r[9]), "+v"(r[10]), "+v"(r[11]), "+v"(r[12]), "+v"(r[13]), "+v"(r[14]), "+v"(r[15]) : "v"(a), "v"(b) : "s40", "vcc");
        asm volatile("v_dot4c_i32_i8 %0, %16, %17\n\tv_dot4c_i32_i8 %1, %16, %17\n\tv_dot4c_i32_i8 %2, %16, %17\n\tv_dot4c_i32_i8 %3, %16, %17\n\tv_dot4c_i32_i8 %4, %16, %17\n\tv_dot4c_i32_i8 %5, %16, %17\n\tv_dot4c_i32_i8 %6, %16, %17\n\tv_dot4c_i32_i8 %7, %16, %17\n\tv_dot4c_i32_i8 %8, %16, %17\n\tv_dot4c_i32_i8 %9, %16, %17\n\tv_dot4c_i32_i8 %10, %16, %17\n\tv_dot4c_i32_i8 %11, %16, %17\n\tv_dot4c_i32_i8 %12, %16, %17\n\tv_dot4c_i32_i8 %13, %16, %17\n\tv_dot4c_i32_i8 %14, %16, %17\n\tv_dot4c_i32_i8 %15, %16, %17\n\t" : "+v"(r[0]), "+v"(r[1]), "+v"(r[2]), "+v"(r[3]), "+v"(r[4]), "+v"(r[5]), "+v"(r[6]), "+v"(r[7]), "+v"(r[8]), "+v"(r[9]), "+v"(r[10]), "+v"(r[11]), "+v"(r[12]), "+v"(r[13]), "+v"(r[14]), "+v"(r[15]) : "v"(a), "v"(b) : "s40", "vcc");
#endif
#if PROBE_UB == 3
        asm volatile("v_perm_b32 %0, %0, %16, %17\n\tv_perm_b32 %1, %1, %16, %17\n\tv_perm_b32 %2, %2, %16, %17\n\tv_perm_b32 %3, %3, %16, %17\n\tv_perm_b32 %4, %4, %16, %17\n\tv_perm_b32 %5, %5, %16, %17\n\tv_perm_b32 %6, %6, %16, %17\n\tv_perm_b32 %7, %7, %16, %17\n\tv_perm_b32 %8, %8, %16, %17\n\tv_perm_b32 %9, %9, %16, %17\n\tv_perm_b32 %10, %10, %16, %17\n\tv_perm_b32 %11, %11, %16, %17\n\tv_perm_b32 %12, %12, %16, %17\n\tv_perm_b32 %13, %13, %16, %17\n\tv_perm_b32 %14, %14, %16, %17\n\tv_perm_b32 %15, %15, %16, %17\n\t" : "+v"(r[0]), "+v"(r[1]), "+v"(r[2]), "+v"(r[3]), "+v"(r[4]), "+v"(r[5]), "+v"(r[6]), "+v"(r[7]), "+v"(r[8]), "+v"(r[9]), "+v"(r[10]), "+v"(r[11]), "+v"(r[12]), "+v"(r[13]), "+v"(r[14]), "+v"(r[15]) : "v"(a), "v"(b) : "s40", "vcc");
        asm volatile("v_perm_b32 %0, %0, %16, %17\n\tv_perm_b32 %1, %1, %16, %17\n\tv_perm_b32 %2, %2, %16, %17\n\tv_perm_b32 %3, %3, %16, %17\n\tv_perm_b32 %4, %4, %16, %17\n\tv_perm_b32 %5, %5, %16, %17\n\tv_perm_b32 %6, %6, %16, %17\n\tv_perm_b32 %7, %7, %16, %17\n\tv_perm_b32 %8, %8, %16, %17\n\tv_perm_b32 %9, %9, %16, %17\n\tv_perm_b32 %10, %10, %16, %17\n\tv_perm_b32 %11, %11, %16, %17\n\tv_perm_b32 %12, %12, %16, %17\n\tv_perm_b32 %13, %13, %16, %17\n\tv_perm_b32 %14, %14, %16, %17\n\tv_perm_b32 %15, %15, %16, %17\n\t" : "+v"(r[0]), "+v"(r[1]), "+v"(r[2]), "+v"(r[3]), "+v"(r[4]), "+v"(r[5]), "+v"(r[6]), "+v"(r[7]), "+v"(r[8]), "+v"(r[9]), "+v"(r[10]), "+v"(r[11]), "+v"(r[12]), "+v"(r[13]), "+v"(r[14]), "+v"(r[15]) : "v"(a), "v"(b) : "s40", "vcc");
#endif
#if PROBE_UB == 4
        asm volatile("v_add_u32_dpp %0, %0, %0 quad_perm:[1,0,3,2] row_mask:0xf bank_mask:0xf\n\tv_add_u32_dpp %1, %1, %1 quad_perm:[1,0,3,2] row_mask:0xf bank_mask:0xf\n\tv_add_u32_dpp %2, %2, %2 quad_perm:[1,0,3,2] row_mask:0xf bank_mask:0xf\n\tv_add_u32_dpp %3, %3, %3 quad_perm:[1,0,3,2] row_mask:0xf bank_mask:0xf\n\tv_add_u32_dpp %4, %4, %4 quad_perm:[1,0,3,2] row_mask:0xf bank_mask:0xf\n\tv_add_u32_dpp %5, %5, %5 quad_perm:[1,0,3,2] row_mask:0xf bank_mask:0xf\n\tv_add_u32_dpp %6, %6, %6 quad_perm:[1,0,3,2] row_mask:0xf bank_mask:0xf\n\tv_add_u32_dpp %7, %7, %7 quad_perm:[1,0,3,2] row_mask:0xf bank_mask:0xf\n\tv_add_u32_dpp %8, %8, %8 quad_perm:[1,0,3,2] row_mask:0xf bank_mask:0xf\n\tv_add_u32_dpp %9, %9, %9 quad_perm:[1,0,3,2] row_mask:0xf bank_mask:0xf\n\tv_add_u32_dpp %10, %10, %10 quad_perm:[1,0,3,2] row_mask:0xf bank_mask:0xf\n\tv_add_u32_dpp %11, %11, %11 quad_perm:[1,0,3,2] row_mask:0xf bank_mask:0xf\n\tv_add_u32_dpp %12, %12, %12 quad_perm:[1,0,3,2] row_mask:0xf bank_mask:0xf\n\tv_add_u32_dpp %13, %13, %13 quad_perm:[1,0,3,2] row_mask:0xf bank_mask:0xf\n\tv_add_u32_dpp %14, %14, %14 quad_perm:[1,0,3,2] row_mask:0xf bank_mask:0xf\n\tv_add_u32_dpp %15, %15, %15 quad_perm:[1,0,3,2] row_mask:0xf bank_mask:0xf\n\t" : "+v"(r[0]), "+v"(r[1]), "+v"(r[2]), "+v"(r[3]), "+v"(r[4]), "+v"(r[5]), "+v"(r[6]), "+v"(r[7]), "+v"(r[8]), "+v"(r[9]), "+v"(r[10]), "+v"(r[11]), "+v"(r[12]), "+v"(r[13]), "+v"(r[14]), "+v"(r[15]) : "v"(a), "v"(b) : "s40", "vcc");
        asm volatile("v_add_u32_dpp %0, %0, %0 quad_perm:[1,0,3,2] row_mask:0xf bank_mask:0xf\n\tv_add_u32_dpp %1, %1, %1 quad_perm:[1,0,3,2] row_mask:0xf bank_mask:0xf\n\tv_add_u32_dpp %2, %2, %2 quad_perm:[1,0,3,2] row_mask:0xf bank_mask:0xf\n\tv_add_u32_dpp %3, %3, %3 quad_perm:[1,0,3,2] row_mask:0xf bank_mask:0xf\n\tv_add_u32_dpp %4, %4, %4 quad_perm:[1,0,3,2] row_mask:0xf bank_mask:0xf\n\tv_add_u32_dpp %5, %5, %5 quad_perm:[1,0,3,2] row_mask:0xf bank_mask:0xf\n\tv_add_u32_dpp %6, %6, %6 quad_perm:[1,0,3,2] row_mask:0xf bank_mask:0xf\n\tv_add_u32_dpp %7, %7, %7 quad_perm:[1,0,3,2] row_mask:0xf bank_mask:0xf\n\tv_add_u32_dpp %8, %8, %8 quad_perm:[1,0,3,2] row_mask:0xf bank_mask:0xf\n\tv_add_u32_dpp %9, %9, %9 quad_perm:[1,0,3,2] row_mask:0xf bank_mask:0xf\n\tv_add_u32_dpp %10, %10, %10 quad_perm:[1,0,3,2] row_mask:0xf bank_mask:0xf\n\tv_add_u32_dpp %11, %11, %11 quad_perm:[1,0,3,2] row_mask:0xf bank_mask:0xf\n\tv_add_u32_dpp %12, %12, %12 quad_perm:[1,0,3,2] row_mask:0xf bank_mask:0xf\n\tv_add_u32_dpp %13, %13, %13 quad_perm:[1,0,3,2] row_mask:0xf bank_mask:0xf\n\tv_add_u32_dpp %14, %14, %14 quad_perm:[1,0,3,2] row_mask:0xf bank_mask:0xf\n\tv_add_u32_dpp %15, %15, %15 quad_perm:[1,0,3,2] row_mask:0xf bank_mask:0xf\n\t" : "+v"(r[0]), "+v"(r[1]), "+v"(r[2]), "+v"(r[3]), "+v"(r[4]), "+v"(r[5]), "+v"(r[6]), "+v"(r[7]), "+v"(r[8]), "+v"(r[9]), "+v"(r[10]), "+v"(r[11]), "+v"(r[12]), "+v"(r[13]), "+v"(r[14]), "+v"(r[15]) : "v"(a), "v"(b) : "s40", "vcc");
#endif
#if PROBE_UB == 5
        asm volatile("v_readlane_b32 s40, %0, 5\n\tv_readlane_b32 s40, %1, 5\n\tv_readlane_b32 s40, %2, 5\n\tv_readlane_b32 s40, %3, 5\n\tv_readlane_b32 s40, %4, 5\n\tv_readlane_b32 s40, %5, 5\n\tv_readlane_b32 s40, %6, 5\n\tv_readlane_b32 s40, %7, 5\n\tv_readlane_b32 s40, %8, 5\n\tv_readlane_b32 s40, %9, 5\n\tv_readlane_b32 s40, %10, 5\n\tv_readlane_b32 s40, %11, 5\n\tv_readlane_b32 s40, %12, 5\n\tv_readlane_b32 s40, %13, 5\n\tv_readlane_b32 s40, %14, 5\n\tv_readlane_b32 s40, %15, 5\n\t" : "+v"(r[0]), "+v"(r[1]), "+v"(r[2]), "+v"(r[3]), "+v"(r[4]), "+v"(r[5]), "+v"(r[6]), "+v"(r[7]), "+v"(r[8]), "+v"(r[9]), "+v"(r[10]), "+v"(r[11]), "+v"(r[12]), "+v"(r[13]), "+v"(r[14]), "+v"(r[15]) : "v"(a), "v"(b) : "s40", "vcc");
        asm volatile("v_readlane_b32 s40, %0, 5\n\tv_readlane_b32 s40, %1, 5\n\tv_readlane_b32 s40, %2, 5\n\tv_readlane_b32 s40, %3, 5\n\tv_readlane_b32 s40, %4, 5\n\tv_readlane_b32 s40, %5, 5\n\tv_readlane_b32 s40, %6, 5\n\tv_readlane_b32 s40, %7, 5\n\tv_readlane_b32 s40, %8, 5\n\tv_readlane_b32 s40, %9, 5\n\tv_readlane_b32 s40, %10, 5\n\tv_readlane_b32 s40, %11, 5\n\tv_readlane_b32 s40, %12, 5\n\tv_readlane_b32 s40, %13, 5\n\tv_readlane_b32 s40, %14, 5\n\tv_readlane_b32 s40, %15, 5\n\t" : "+v"(r[0]), "+v"(r[1]), "+v"(r[2]), "+v"(r[3]), "+v"(r[4]), "+v"(r[5]), "+v"(r[6]), "+v"(r[7]), "+v"(r[8]), "+v"(r[9]), "+v"(r[10]), "+v"(r[11]), "+v"(r[12]), "+v"(r[13]), "+v"(r[14]), "+v"(r[15]) : "v"(a), "v"(b) : "s40", "vcc");
#endif
#if PROBE_UB == 6
        asm volatile("v_cvt_pk_f32_fp8 %0, %16\n\tv_cvt_pk_f32_fp8 %1, %16\n\tv_cvt_pk_f32_fp8 %2, %16\n\tv_cvt_pk_f32_fp8 %3, %16\n\tv_cvt_pk_f32_fp8 %4, %16\n\tv_cvt_pk_f32_fp8 %5, %16\n\tv_cvt_pk_f32_fp8 %6, %16\n\tv_cvt_pk_f32_fp8 %7, %16\n\t" : "+v"(r2[0]), "+v"(r2[1]), "+v"(r2[2]), "+v"(r2[3]), "+v"(r2[4]), "+v"(r2[5]), "+v"(r2[6]), "+v"(r2[7]), "+v"(r[8]), "+v"(r[9]), "+v"(r[10]), "+v"(r[11]), "+v"(r[12]), "+v"(r[13]), "+v"(r[14]), "+v"(r[15]) : "v"(a), "v"(b) : "s40", "vcc");
        asm volatile("v_cvt_pk_f32_fp8 %0, %16\n\tv_cvt_pk_f32_fp8 %1, %16\n\tv_cvt_pk_f32_fp8 %2, %16\n\tv_cvt_pk_f32_fp8 %3, %16\n\tv_cvt_pk_f32_fp8 %4, %16\n\tv_cvt_pk_f32_fp8 %5, %16\n\tv_cvt_pk_f32_fp8 %6, %16\n\tv_cvt_pk_f32_fp8 %7, %16\n\t" : "+v"(r2[0]), "+v"(r2[1]), "+v"(r2[2]), "+v"(r2[3]), "+v"(r2[4]), "+v"(r2[5]), "+v"(r2[6]), "+v"(r2[7]), "+v"(r[8]), "+v"(r[9]), "+v"(r[10]), "+v"(r[11]), "+v"(r[12]), "+v"(r[13]), "+v"(r[14]), "+v"(r[15]) : "v"(a), "v"(b) : "s40", "vcc");
        asm volatile("v_cvt_pk_f32_fp8 %0, %16\n\tv_cvt_pk_f32_fp8 %1, %16\n\tv_cvt_pk_f32_fp8 %2, %16\n\tv_cvt_pk_f32_fp8 %3, %16\n\tv_cvt_pk_f32_fp8 %4, %16\n\tv_cvt_pk_f32_fp8 %5, %16\n\tv_cvt_pk_f32_fp8 %6, %16\n\tv_cvt_pk_f32_fp8 %7, %16\n\t" : "+v"(r2[0]), "+v"(r2[1]), "+v"(r2[2]), "+v"(r2[3]), "+v"(r2[4]), "+v"(r2[5]), "+v"(r2[6]), "+v"(r2[7]), "+v"(r[8]), "+v"(r[9]), "+v"(r[10]), "+v"(r[11]), "+v"(r[12]), "+v"(r[13]), "+v"(r[14]), "+v"(r[15]) : "v"(a), "v"(b) : "s40", "vcc");
        asm volatile("v_cvt_pk_f32_fp8 %0, %16\n\tv_cvt_pk_f32_fp8 %1, %16\n\tv_cvt_pk_f32_fp8 %2, %16\n\tv_cvt_pk_f32_fp8 %3, %16\n\tv_cvt_pk_f32_fp8 %4, %16\n\tv_cvt_pk_f32_fp8 %5, %16\n\tv_cvt_pk_f32_fp8 %6, %16\n\tv_cvt_pk_f32_fp8 %7, %16\n\t" : "+v"(r2[0]), "+v"(r2[1]), "+v"(r2[2]), "+v"(r2[3]), "+v"(r2[4]), "+v"(r2[5]), "+v"(r2[6]), "+v"(r2[7]), "+v"(r[8]), "+v"(r[9]), "+v"(r[10]), "+v"(r[11]), "+v"(r[12]), "+v"(r[13]), "+v"(r[14]), "+v"(r[15]) : "v"(a), "v"(b) : "s40", "vcc");
#endif
#if PROBE_UB == 7
        asm volatile("v_pk_fma_f32 %0, %0, %0, %0\n\tv_pk_fma_f32 %1, %1, %1, %1\n\tv_pk_fma_f32 %2, %2, %2, %2\n\tv_pk_fma_f32 %3, %3, %3, %3\n\tv_pk_fma_f32 %4, %4, %4, %4\n\tv_pk_fma_f32 %5, %5, %5, %5\n\tv_pk_fma_f32 %6, %6, %6, %6\n\tv_pk_fma_f32 %7, %7, %7, %7\n\t" : "+v"(r2[0]), "+v"(r2[1]), "+v"(r2[2]), "+v"(r2[3]), "+v"(r2[4]), "+v"(r2[5]), "+v"(r2[6]), "+v"(r2[7]), "+v"(r[8]), "+v"(r[9]), "+v"(r[10]), "+v"(r[11]), "+v"(r[12]), "+v"(r[13]), "+v"(r[14]), "+v"(r[15]) : "v"(a), "v"(b) : "s40", "vcc");
        asm volatile("v_pk_fma_f32 %0, %0, %0, %0\n\tv_pk_fma_f32 %1, %1, %1, %1\n\tv_pk_fma_f32 %2, %2, %2, %2\n\tv_pk_fma_f32 %3, %3, %3, %3\n\tv_pk_fma_f32 %4, %4, %4, %4\n\tv_pk_fma_f32 %5, %5, %5, %5\n\tv_pk_fma_f32 %6, %6, %6, %6\n\tv_pk_fma_f32 %7, %7, %7, %7\n\t" : "+v"(r2[0]), "+v"(r2[1]), "+v"(r2[2]), "+v"(r2[3]), "+v"(r2[4]), "+v"(r2[5]), "+v"(r2[6]), "+v"(r2[7]), "+v"(r[8]), "+v"(r[9]), "+v"(r[10]), "+v"(r[11]), "+v"(r[12]), "+v"(r[13]), "+v"(r[14]), "+v"(r[15]) : "v"(a), "v"(b) : "s40", "vcc");
        asm volatile("v_pk_fma_f32 %0, %0, %0, %0\n\tv_pk_fma_f32 %1, %1, %1, %1\n\tv_pk_fma_f32 %2, %2, %2, %2\n\tv_pk_fma_f32 %3, %3, %3, %3\n\tv_pk_fma_f32 %4, %4, %4, %4\n\tv_pk_fma_f32 %5, %5, %5, %5\n\tv_pk_fma_f32 %6, %6, %6, %6\n\tv_pk_fma_f32 %7, %7, %7, %7\n\t" : "+v"(r2[0]), "+v"(r2[1]), "+v"(r2[2]), "+v"(r2[3]), "+v"(r2[4]), "+v"(r2[5]), "+v"(r2[6]), "+v"(r2[7]), "+v"(r[8]), "+v"(r[9]), "+v"(r[10]), "+v"(r[11]), "+v"(r[12]), "+v"(r[13]), "+v"(r[14]), "+v"(r[15]) : "v"(a), "v"(b) : "s40", "vcc");
        asm volatile("v_pk_fma_f32 %0, %0, %0, %0\n\tv_pk_fma_f32 %1, %1, %1, %1\n\tv_pk_fma_f32 %2, %2, %2, %2\n\tv_pk_fma_f32 %3, %3, %3, %3\n\tv_pk_fma_f32 %4, %4, %4, %4\n\tv_pk_fma_f32 %5, %5, %5, %5\n\tv_pk_fma_f32 %6, %6, %6, %6\n\tv_pk_fma_f32 %7, %7, %7, %7\n\t" : "+v"(r2[0]), "+v"(r2[1]), "+v"(r2[2]), "+v"(r2[3]), "+v"(r2[4]), "+v"(r2[5]), "+v"(r2[6]), "+v"(r2[7]), "+v"(r[8]), "+v"(r[9]), "+v"(r[10]), "+v"(r[11]), "+v"(r[12]), "+v"(r[13]), "+v"(r[14]), "+v"(r[15]) : "v"(a), "v"(b) : "s40", "vcc");
#endif
#if PROBE_UB == 8
        asm volatile("v_dot2c_f32_bf16 %0, %16, %17\n\tv_dot2c_f32_bf16 %1, %16, %17\n\tv_dot2c_f32_bf16 %2, %16, %17\n\tv_dot2c_f32_bf16 %3, %16, %17\n\tv_dot2c_f32_bf16 %4, %16, %17\n\tv_dot2c_f32_bf16 %5, %16, %17\n\tv_dot2c_f32_bf16 %6, %16, %17\n\tv_dot2c_f32_bf16 %7, %16, %17\n\tv_dot2c_f32_bf16 %8, %16, %17\n\tv_dot2c_f32_bf16 %9, %16, %17\n\tv_dot2c_f32_bf16 %10, %16, %17\n\tv_dot2c_f32_bf16 %11, %16, %17\n\tv_dot2c_f32_bf16 %12, %16, %17\n\tv_dot2c_f32_bf16 %13, %16, %17\n\tv_dot2c_f32_bf16 %14, %16, %17\n\tv_dot2c_f32_bf16 %15, %16, %17\n\t" : "+v"(r[0]), "+v"(r[1]), "+v"(r[2]), "+v"(r[3]), "+v"(r[4]), "+v"(r[5]), "+v"(r[6]), "+v"(r[7]), "+v"(r[8]), "+v"(r[9]), "+v"(r[10]), "+v"(r[11]), "+v"(r[12]), "+v"(r[13]), "+v"(r[14]), "+v"(r[15]) : "v"(a), "v"(b) : "s40", "vcc");
        asm volatile("v_dot2c_f32_bf16 %0, %16, %17\n\tv_dot2c_f32_bf16 %1, %16, %17\n\tv_dot2c_f32_bf16 %2, %16, %17\n\tv_dot2c_f32_bf16 %3, %16, %17\n\tv_dot2c_f32_bf16 %4, %16, %17\n\tv_dot2c_f32_bf16 %5, %16, %17\n\tv_dot2c_f32_bf16 %6, %16, %17\n\tv_dot2c_f32_bf16 %7, %16, %17\n\tv_dot2c_f32_bf16 %8, %16, %17\n\tv_dot2c_f32_bf16 %9, %16, %17\n\tv_dot2c_f32_bf16 %10, %16, %17\n\tv_dot2c_f32_bf16 %11, %16, %17\n\tv_dot2c_f32_bf16 %12, %16, %17\n\tv_dot2c_f32_bf16 %13, %16, %17\n\tv_dot2c_f32_bf16 %14, %16, %17\n\tv_dot2c_f32_bf16 %15, %16, %17\n\t" : "+v"(r[0]), "+v"(r[1]), "+v"(r[2]), "+v"(r[3]), "+v"(r[4]), "+v"(r[5]), "+v"(r[6]), "+v"(r[7]), "+v"(r[8]), "+v"(r[9]), "+v"(r[10]), "+v"(r[11]), "+v"(r[12]), "+v"(r[13]), "+v"(r[14]), "+v"(r[15]) : "v"(a), "v"(b) : "s40", "vcc");
#endif
#if PROBE_UB == 9
        asm volatile("v_cndmask_b32 %0, %0, %16, vcc\n\tv_cndmask_b32 %1, %1, %16, vcc\n\tv_cndmask_b32 %2, %2, %16, vcc\n\tv_cndmask_b32 %3, %3, %16, vcc\n\tv_cndmask_b32 %4, %4, %16, vcc\n\tv_cndmask_b32 %5, %5, %16, vcc\n\tv_cndmask_b32 %6, %6, %16, vcc\n\tv_cndmask_b32 %7, %7, %16, vcc\n\tv_cndmask_b32 %8, %8, %16, vcc\n\tv_cndmask_b32 %9, %9, %16, vcc\n\tv_cndmask_b32 %10, %10, %16, vcc\n\tv_cndmask_b32 %11, %11, %16, vcc\n\tv_cndmask_b32 %12, %12, %16, vcc\n\tv_cndmask_b32 %13, %13, %16, vcc\n\tv_cndmask_b32 %14, %14, %16, vcc\n\tv_cndmask_b32 %15, %15, %16, vcc\n\t" : "+v"(r[0]), "+v"(r[1]), "+v"(r[2]), "+v"(r[3]), "+v"(r[4]), "+v"(r[5]), "+v"(r[6]), "+v"(r[7]), "+v"(r[8]), "+v"(r[9]), "+v"(r[10]), "+v"(r[11]), "+v"(r[12]), "+v"(r[13]), "+v"(r[14]), "+v"(r[15]) : "v"(a), "v"(b) : "s40", "vcc");
        asm volatile("v_cndmask_b32 %0, %0, %16, vcc\n\tv_cndmask_b32 %1, %1, %16, vcc\n\tv_cndmask_b32 %2, %2, %16, vcc\n\tv_cndmask_b32 %3, %3, %16, vcc\n\tv_cndmask_b32 %4, %4, %16, vcc\n\tv_cndmask_b32 %5, %5, %16, vcc\n\tv_cndmask_b32 %6, %6, %16, vcc\n\tv_cndmask_b32 %7, %7, %16, vcc\n\tv_cndmask_b32 %8, %8, %16, vcc\n\tv_cndmask_b32 %9, %9, %16, vcc\n\tv_cndmask_b32 %10, %10, %16, vcc\n\tv_cndmask_b32 %11, %11, %16, vcc\n\tv_cndmask_b32 %12, %12, %16, vcc\n\tv_cndmask_b32 %13, %13, %16, vcc\n\tv_cndmask_b32 %14, %14, %16, vcc\n\tv_cndmask_b32 %15, %15, %16, vcc\n\t" : "+v"(r[0]), "+v"(r[1]), "+v"(r[2]), "+v"(r[3]), "+v"(r[4]), "+v"(r[5]), "+v"(r[6]), "+v"(r[7]), "+v"(r[8]), "+v"(r[9]), "+v"(r[10]), "+v"(r[11]), "+v"(r[12]), "+v"(r[13]), "+v"(r[14]), "+v"(r[15]) : "v"(a), "v"(b) : "s40", "vcc");
#endif
#if PROBE_UB == 10
        asm volatile("v_max_i32 %0, %0, %16\n\tv_max_i32 %1, %1, %16\n\tv_max_i32 %2, %2, %16\n\tv_max_i32 %3, %3, %16\n\tv_max_i32 %4, %4, %16\n\tv_max_i32 %5, %5, %16\n\tv_max_i32 %6, %6, %16\n\tv_max_i32 %7, %7, %16\n\tv_max_i32 %8, %8, %16\n\tv_max_i32 %9, %9, %16\n\tv_max_i32 %10, %10, %16\n\tv_max_i32 %11, %11, %16\n\tv_max_i32 %12, %12, %16\n\tv_max_i32 %13, %13, %16\n\tv_max_i32 %14, %14, %16\n\tv_max_i32 %15, %15, %16\n\t" : "+v"(r[0]), "+v"(r[1]), "+v"(r[2]), "+v"(r[3]), "+v"(r[4]), "+v"(r[5]), "+v"(r[6]), "+v"(r[7]), "+v"(r[8]), "+v"(r[9]), "+v"(r[10]), "+v"(r[11]), "+v"(r[12]), "+v"(r[13]), "+v"(r[14]), "+v"(r[15]) : "v"(a), "v"(b) : "s40", "vcc");
        asm volatile("v_max_i32 %0, %0, %16\n\tv_max_i32 %1, %1, %16\n\tv_max_i32 %2, %2, %16\n\tv_max_i32 %3, %3, %16\n\tv_max_i32 %4, %4, %16\n\tv_max_i32 %5, %5, %16\n\tv_max_i32 %6, %6, %16\n\tv_max_i32 %7, %7, %16\n\tv_max_i32 %8, %8, %16\n\tv_max_i32 %9, %9, %16\n\tv_max_i32 %10, %10, %16\n\tv_max_i32 %11, %11, %16\n\tv_max_i32 %12, %12, %16\n\tv_max_i32 %13, %13, %16\n\tv_max_i32 %14, %14, %16\n\tv_max_i32 %15, %15, %16\n\t" : "+v"(r[0]), "+v"(r[1]), "+v"(r[2]), "+v"(r[3]), "+v"(r[4]), "+v"(r[5]), "+v"(r[6]), "+v"(r[7]), "+v"(r[8]), "+v"(r[9]), "+v"(r[10]), "+v"(r[11]), "+v"(r[12]), "+v"(r[13]), "+v"(r[14]), "+v"(r[15]) : "v"(a), "v"(b) : "s40", "vcc");
#endif
#if PROBE_UB == 11
        asm volatile("v_exp_f32 %0, %0\n\tv_exp_f32 %1, %1\n\tv_exp_f32 %2, %2\n\tv_exp_f32 %3, %3\n\tv_exp_f32 %4, %4\n\tv_exp_f32 %5, %5\n\tv_exp_f32 %6, %6\n\tv_exp_f32 %7, %7\n\tv_exp_f32 %8, %8\n\tv_exp_f32 %9, %9\n\tv_exp_f32 %10, %10\n\tv_exp_f32 %11, %11\n\tv_exp_f32 %12, %12\n\tv_exp_f32 %13, %13\n\tv_exp_f32 %14, %14\n\tv_exp_f32 %15, %15\n\t" : "+v"(r[0]), "+v"(r[1]), "+v"(r[2]), "+v"(r[3]), "+v"(r[4]), "+v"(r[5]), "+v"(r[6]), "+v"(r[7]), "+v"(r[8]), "+v"(r[9]), "+v"(r[10]), "+v"(r[11]), "+v"(r[12]), "+v"(r[13]), "+v"(r[14]), "+v"(r[15]) : "v"(a), "v"(b) : "s40", "vcc");
        asm volatile("v_exp_f32 %0, %0\n\tv_exp_f32 %1, %1\n\tv_exp_f32 %2, %2\n\tv_exp_f32 %3, %3\n\tv_exp_f32 %4, %4\n\tv_exp_f32 %5, %5\n\tv_exp_f32 %6, %6\n\tv_exp_f32 %7, %7\n\tv_exp_f32 %8, %8\n\tv_exp_f32 %9, %9\n\tv_exp_f32 %10, %10\n\tv_exp_f32 %11, %11\n\tv_exp_f32 %12, %12\n\tv_exp_f32 %13, %13\n\tv_exp_f32 %14, %14\n\tv_exp_f32 %15, %15\n\t" : "+v"(r[0]), "+v"(r[1]), "+v"(r[2]), "+v"(r[3]), "+v"(r[4]), "+v"(r[5]), "+v"(r[6]), "+v"(r[7]), "+v"(r[8]), "+v"(r[9]), "+v"(r[10]), "+v"(r[11]), "+v"(r[12]), "+v"(r[13]), "+v"(r[14]), "+v"(r[15]) : "v"(a), "v"(b) : "s40", "vcc");
#endif
#if PROBE_UB == 12
        asm volatile("v_fmac_f32 %0, %16, %17\n\tv_fmac_f32 %1, %16, %17\n\tv_fmac_f32 %2, %16, %17\n\tv_fmac_f32 %3, %16, %17\n\tv_fmac_f32 %4, %16, %17\n\tv_fmac_f32 %5, %16, %17\n\tv_fmac_f32 %6, %16, %17\n\tv_fmac_f32 %7, %16, %17\n\tv_fmac_f32 %8, %16, %17\n\tv_fmac_f32 %9, %16, %17\n\tv_fmac_f32 %10, %16, %17\n\tv_fmac_f32 %11, %16, %17\n\tv_fmac_f32 %12, %16, %17\n\tv_fmac_f32 %13, %16, %17\n\tv_fmac_f32 %14, %16, %17\n\tv_fmac_f32 %15, %16, %17\n\t" : "+v"(r[0]), "+v"(r[1]), "+v"(r[2]), "+v"(r[3]), "+v"(r[4]), "+v"(r[5]), "+v"(r[6]), "+v"(r[7]), "+v"(r[8]), "+v"(r[9]), "+v"(r[10]), "+v"(r[11]), "+v"(r[12]), "+v"(r[13]), "+v"(r[14]), "+v"(r[15]) : "v"(a), "v"(b) : "s40", "vcc");
        asm volatile("v_fmac_f32 %0, %16, %17\n\tv_fmac_f32 %1, %16, %17\n\tv_fmac_f32 %2, %16, %17\n\tv_fmac_f32 %3, %16, %17\n\tv_fmac_f32 %4, %16, %17\n\tv_fmac_f32 %5, %16, %17\n\tv_fmac_f32 %6, %16, %17\n\tv_fmac_f32 %7, %16, %17\n\tv_fmac_f32 %8, %16, %17\n\tv_fmac_f32 %9, %16, %17\n\tv_fmac_f32 %10, %16, %17\n\tv_fmac_f32 %11, %16, %17\n\tv_fmac_f32 %12, %16, %17\n\tv_fmac_f32 %13, %16, %17\n\tv_fmac_f32 %14, %16, %17\n\tv_fmac_f32 %15, %16, %17\n\t" : "+v"(r[0]), "+v"(r[1]), "+v"(r[2]), "+v"(r[3]), "+v"(r[4]), "+v"(r[5]), "+v"(r[6]), "+v"(r[7]), "+v"(r[8]), "+v"(r[9]), "+v"(r[10]), "+v"(r[11]), "+v"(r[12]), "+v"(r[13]), "+v"(r[14]), "+v"(r[15]) : "v"(a), "v"(b) : "s40", "vcc");
#endif
#if PROBE_UB == 13
        asm volatile("v_add_u32_dpp %0, %16, %0 quad_perm:[1,0,3,2] row_mask:0xf bank_mask:0xf\n\tv_add_u32_dpp %1, %16, %1 quad_perm:[1,0,3,2] row_mask:0xf bank_mask:0xf\n\tv_add_u32_dpp %2, %16, %2 quad_perm:[1,0,3,2] row_mask:0xf bank_mask:0xf\n\tv_add_u32_dpp %3, %16, %3 quad_perm:[1,0,3,2] row_mask:0xf bank_mask:0xf\n\tv_add_u32_dpp %4, %16, %4 quad_perm:[1,0,3,2] row_mask:0xf bank_mask:0xf\n\tv_add_u32_dpp %5, %16, %5 quad_perm:[1,0,3,2] row_mask:0xf bank_mask:0xf\n\tv_add_u32_dpp %6, %16, %6 quad_perm:[1,0,3,2] row_mask:0xf bank_mask:0xf\n\tv_add_u32_dpp %7, %16, %7 quad_perm:[1,0,3,2] row_mask:0xf bank_mask:0xf\n\tv_add_u32_dpp %8, %16, %8 quad_perm:[1,0,3,2] row_mask:0xf bank_mask:0xf\n\tv_add_u32_dpp %9, %16, %9 quad_perm:[1,0,3,2] row_mask:0xf bank_mask:0xf\n\tv_add_u32_dpp %10, %16, %10 quad_perm:[1,0,3,2] row_mask:0xf bank_mask:0xf\n\tv_add_u32_dpp %11, %16, %11 quad_perm:[1,0,3,2] row_mask:0xf bank_mask:0xf\n\tv_add_u32_dpp %12, %16, %12 quad_perm:[1,0,3,2] row_mask:0xf bank_mask:0xf\n\tv_add_u32_dpp %13, %16, %13 quad_perm:[1,0,3,2] row_mask:0xf bank_mask:0xf\n\tv_add_u32_dpp %14, %16, %14 quad_perm:[1,0,3,2] row_mask:0xf bank_mask:0xf\n\tv_add_u32_dpp %15, %16, %15 quad_perm:[1,0,3,2] row_mask:0xf bank_mask:0xf\n\t" : "+v"(r[0]), "+v"(r[1]), "+v"(r[2]), "+v"(r[3]), "+v"(r[4]), "+v"(r[5]), "+v"(r[6]), "+v"(r[7]), "+v"(r[8]), "+v"(r[9]), "+v"(r[10]), "+v"(r[11]), "+v"(r[12]), "+v"(r[13]), "+v"(r[14]), "+v"(r[15]) : "v"(a), "v"(b) : "s40", "vcc");
        asm volatile("v_add_u32_dpp %0, %16, %0 quad_perm:[1,0,3,2] row_mask:0xf bank_mask:0xf\n\tv_add_u32_dpp %1, %16, %1 quad_perm:[1,0,3,2] row_mask:0xf bank_mask:0xf\n\tv_add_u32_dpp %2, %16, %2 quad_perm:[1,0,3,2] row_mask:0xf bank_mask:0xf\n\tv_add_u32_dpp %3, %16, %3 quad_perm:[1,0,3,2] row_mask:0xf bank_mask:0xf\n\tv_add_u32_dpp %4, %16, %4 quad_perm:[1,0,3,2] row_mask:0xf bank_mask:0xf\n\tv_add_u32_dpp %5, %16, %5 quad_perm:[1,0,3,2] row_mask:0xf bank_mask:0xf\n\tv_add_u32_dpp %6, %16, %6 quad_perm:[1,0,3,2] row_mask:0xf bank_mask:0xf\n\tv_add_u32_dpp %7, %16, %7 quad_perm:[1,0,3,2] row_mask:0xf bank_mask:0xf\n\tv_add_u32_dpp %8, %16, %8 quad_perm:[1,0,3,2] row_mask:0xf bank_mask:0xf\n\tv_add_u32_dpp %9, %16, %9 quad_perm:[1,0,3,2] row_mask:0xf bank_mask:0xf\n\tv_add_u32_dpp %10, %16, %10 quad_perm:[1,0,3,2] row_mask:0xf bank_mask:0xf\n\tv_add_u32_dpp %11, %16, %11 quad_perm:[1,0,3,2] row_mask:0xf bank_mask:0xf\n\tv_add_u32_dpp %12, %16, %12 quad_perm:[1,0,3,2] row_mask:0xf bank_mask:0xf\n\tv_add_u32_dpp %13, %16, %13 quad_perm:[1,0,3,2] row_mask:0xf bank_mask:0xf\n\tv_add_u32_dpp %14, %16, %14 quad_perm:[1,0,3,2] row_mask:0xf bank_mask:0xf\n\tv_add_u32_dpp %15, %16, %15 quad_perm:[1,0,3,2] row_mask:0xf bank_mask:0xf\n\t" : "+v"(r[0]), "+v"(r[1]), "+v"(r[2]), "+v"(r[3]), "+v"(r[4]), "+v"(r[5]), "+v"(r[6]), "+v"(r[7]), "+v"(r[8]), "+v"(r[9]), "+v"(r[10]), "+v"(r[11]), "+v"(r[12]), "+v"(r[13]), "+v"(r[14]), "+v"(r[15]) : "v"(a), "v"(b) : "s40", "vcc");
#endif
#if PROBE_UB == 14
        asm volatile("v_cvt_f32_ubyte1 %0, %16\n\tv_cvt_f32_ubyte1 %1, %16\n\tv_cvt_f32_ubyte1 %2, %16\n\tv_cvt_f32_ubyte1 %3, %16\n\tv_cvt_f32_ubyte1 %4, %16\n\tv_cvt_f32_ubyte1 %5, %16\n\tv_cvt_f32_ubyte1 %6, %16\n\tv_cvt_f32_ubyte1 %7, %16\n\tv_cvt_f32_ubyte1 %8, %16\n\tv_cvt_f32_ubyte1 %9, %16\n\tv_cvt_f32_ubyte1 %10, %16\n\tv_cvt_f32_ubyte1 %11, %16\n\tv_cvt_f32_ubyte1 %12, %16\n\tv_cvt_f32_ubyte1 %13, %16\n\tv_cvt_f32_ubyte1 %14, %16\n\tv_cvt_f32_ubyte1 %15, %16\n\t" : "+v"(r[0]), "+v"(r[1]), "+v"(r[2]), "+v"(r[3]), "+v"(r[4]), "+v"(r[5]), "+v"(r[6]), "+v"(r[7]), "+v"(r[8]), "+v"(r[9]), "+v"(r[10]), "+v"(r[11]), "+v"(r[12]), "+v"(r[13]), "+v"(r[14]), "+v"(r[15]) : "v"(a), "v"(b) : "s40", "vcc");
        asm volatile("v_cvt_f32_ubyte1 %0, %16\n\tv_cvt_f32_ubyte1 %1, %16\n\tv_cvt_f32_ubyte1 %2, %16\n\tv_cvt_f32_ubyte1 %3, %16\n\tv_cvt_f32_ubyte1 %4, %16\n\tv_cvt_f32_ubyte1 %5, %16\n\tv_cvt_f32_ubyte1 %6, %16\n\tv_cvt_f32_ubyte1 %7, %16\n\tv_cvt_f32_ubyte1 %8, %16\n\tv_cvt_f32_ubyte1 %9, %16\n\tv_cvt_f32_ubyte1 %10, %16\n\tv_cvt_f32_ubyte1 %11, %16\n\tv_cvt_f32_ubyte1 %12, %16\n\tv_cvt_f32_ubyte1 %13, %16\n\tv_cvt_f32_ubyte1 %14, %16\n\tv_cvt_f32_ubyte1 %15, %16\n\t" : "+v"(r[0]), "+v"(r[1]), "+v"(r[2]), "+v"(r[3]), "+v"(r[4]), "+v"(r[5]), "+v"(r[6]), "+v"(r[7]), "+v"(r[8]), "+v"(r[9]), "+v"(r[10]), "+v"(r[11]), "+v"(r[12]), "+v"(r[13]), "+v"(r[14]), "+v"(r[15]) : "v"(a), "v"(b) : "s40", "vcc");
#endif
#if PROBE_UB == 16
        asm volatile("v_max_f32 %0, %0, %16\n\tv_max_f32 %1, %1, %16\n\tv_max_f32 %2, %2, %16\n\tv_max_f32 %3, %3, %16\n\tv_max_f32 %4, %4, %16\n\tv_max_f32 %5, %5, %16\n\tv_max_f32 %6, %6, %16\n\tv_max_f32 %7, %7, %16\n\tv_max_f32 %8, %8, %16\n\tv_max_f32 %9, %9, %16\n\tv_max_f32 %10, %10, %16\n\tv_max_f32 %11, %11, %16\n\tv_max_f32 %12, %12, %16\n\tv_max_f32 %13, %13, %16\n\tv_max_f32 %14, %14, %16\n\tv_max_f32 %15, %15, %16\n\t" : "+v"(r[0]), "+v"(r[1]), "+v"(r[2]), "+v"(r[3]), "+v"(r[4]), "+v"(r[5]), "+v"(r[6]), "+v"(r[7]), "+v"(r[8]), "+v"(r[9]), "+v"(r[10]), "+v"(r[11]), "+v"(r[12]), "+v"(r[13]), "+v"(r[14]), "+v"(r[15]) : "v"(a), "v"(b) : "s40", "s41", "vcc");
        asm volatile("v_max_f32 %0, %0, %16\n\tv_max_f32 %1, %1, %16\n\tv_max_f32 %2, %2, %16\n\tv_max_f32 %3, %3, %16\n\tv_max_f32 %4, %4, %16\n\tv_max_f32 %5, %5, %16\n\tv_max_f32 %6, %6, %16\n\tv_max_f32 %7, %7, %16\n\tv_max_f32 %8, %8, %16\n\tv_max_f32 %9, %9, %16\n\tv_max_f32 %10, %10, %16\n\tv_max_f32 %11, %11, %16\n\tv_max_f32 %12, %12, %16\n\tv_max_f32 %13, %13, %16\n\tv_max_f32 %14, %14, %16\n\tv_max_f32 %15, %15, %16\n\t" : "+v"(r[0]), "+v"(r[1]), "+v"(r[2]), "+v"(r[3]), "+v"(r[4]), "+v"(r[5]), "+v"(r[6]), "+v"(r[7]), "+v"(r[8]), "+v"(r[9]), "+v"(r[10]), "+v"(r[11]), "+v"(r[12]), "+v"(r[13]), "+v"(r[14]), "+v"(r[15]) : "v"(a), "v"(b) : "s40", "s41", "vcc");
#endif
#if PROBE_UB == 17
        asm volatile("v_cndmask_b32 %0, %0, %16, s[40:41]\n\tv_cndmask_b32 %1, %1, %16, s[40:41]\n\tv_cndmask_b32 %2, %2, %16, s[40:41]\n\tv_cndmask_b32 %3, %3, %16, s[40:41]\n\tv_cndmask_b32 %4, %4, %16, s[40:41]\n\tv_cndmask_b32 %5, %5, %16, s[40:41]\n\tv_cndmask_b32 %6, %6, %16, s[40:41]\n\tv_cndmask_b32 %7, %7, %16, s[40:41]\n\tv_cndmask_b32 %8, %8, %16, s[40:41]\n\tv_cndmask_b32 %9, %9, %16, s[40:41]\n\tv_cndmask_b32 %10, %10, %16, s[40:41]\n\tv_cndmask_b32 %11, %11, %16, s[40:41]\n\tv_cndmask_b32 %12, %12, %16, s[40:41]\n\tv_cndmask_b32 %13, %13, %16, s[40:41]\n\tv_cndmask_b32 %14, %14, %16, s[40:41]\n\tv_cndmask_b32 %15, %15, %16, s[40:41]\n\t" : "+v"(r[0]), "+v"(r[1]), "+v"(r[2]), "+v"(r[3]), "+v"(r[4]), "+v"(r[5]), "+v"(r[6]), "+v"(r[7]), "+v"(r[8]), "+v"(r[9]), "+v"(r[10]), "+v"(r[11]), "+v"(r[12]), "+v"(r[13]), "+v"(r[14]), "+v"(r[15]) : "v"(a), "v"(b) : "s40", "s41", "vcc");
        asm volatile("v_cndmask_b32 %0, %0, %16, s[40:41]\n\tv_cndmask_b32 %1, %1, %16, s[40:41]\n\tv_cndmask_b32 %2, %2, %16, s[40:41]\n\tv_cndmask_b32 %3, %3, %16, s[40:41]\n\tv_cndmask_b32 %4, %4, %16, s[40:41]\n\tv_cndmask_b32 %5, %5, %16, s[40:41]\n\tv_cndmask_b32 %6, %6, %16, s[40:41]\n\tv_cndmask_b32 %7, %7, %16, s[40:41]\n\tv_cndmask_b32 %8, %8, %16, s[40:41]\n\tv_cndmask_b32 %9, %9, %16, s[40:41]\n\tv_cndmask_b32 %10, %10, %16, s[40:41]\n\tv_cndmask_b32 %11, %11, %16, s[40:41]\n\tv_cndmask_b32 %12, %12, %16, s[40:41]\n\tv_cndmask_b32 %13, %13, %16, s[40:41]\n\tv_cndmask_b32 %14, %14, %16, s[40:41]\n\tv_cndmask_b32 %15, %15, %16, s[40:41]\n\t" : "+v"(r[0]), "+v"(r[1]), "+v"(r[2]), "+v"(r[3]), "+v"(r[4]), "+v"(r[5]), "+v"(r[6]), "+v"(r[7]), "+v"(r[8]), "+v"(r[9]), "+v"(r[10]), "+v"(r[11]), "+v"(r[12]), "+v"(r[13]), "+v"(r[14]), "+v"(r[15]) : "v"(a), "v"(b) : "s40", "s41", "vcc");
#endif
#if PROBE_UB == 18
        asm volatile("v_min_u32 %0, %0, %16\n\tv_min_u32 %1, %1, %16\n\tv_min_u32 %2, %2, %16\n\tv_min_u32 %3, %3, %16\n\tv_min_u32 %4, %4, %16\n\tv_min_u32 %5, %5, %16\n\tv_min_u32 %6, %6, %16\n\tv_min_u32 %7, %7, %16\n\tv_min_u32 %8, %8, %16\n\tv_min_u32 %9, %9, %16\n\tv_min_u32 %10, %10, %16\n\tv_min_u32 %11, %11, %16\n\tv_min_u32 %12, %12, %16\n\tv_min_u32 %13, %13, %16\n\tv_min_u32 %14, %14, %16\n\tv_min_u32 %15, %15, %16\n\t" : "+v"(r[0]), "+v"(r[1]), "+v"(r[2]), "+v"(r[3]), "+v"(r[4]), "+v"(r[5]), "+v"(r[6]), "+v"(r[7]), "+v"(r[8]), "+v"(r[9]), "+v"(r[10]), "+v"(r[11]), "+v"(r[12]), "+v"(r[13]), "+v"(r[14]), "+v"(r[15]) : "v"(a), "v"(b) : "s40", "s41", "vcc");
        asm volatile("v_min_u32 %0, %0, %16\n\tv_min_u32 %1, %1, %16\n\tv_min_u32 %2, %2, %16\n\tv_min_u32 %3, %3, %16\n\tv_min_u32 %4, %4, %16\n\tv_min_u32 %5, %5, %16\n\tv_min_u32 %6, %6, %16\n\tv_min_u32 %7, %7, %16\n\tv_min_u32 %8, %8, %16\n\tv_min_u32 %9, %9, %16\n\tv_min_u32 %10, %10, %16\n\tv_min_u32 %11, %11, %16\n\tv_min_u32 %12, %12, %16\n\tv_min_u32 %13, %13, %16\n\tv_min_u32 %14, %14, %16\n\tv_min_u32 %15, %15, %16\n\t" : "+v"(r[0]), "+v"(r[1]), "+v"(r[2]), "+v"(r[3]), "+v"(r[4]), "+v"(r[5]), "+v"(r[6]), "+v"(r[7]), "+v"(r[8]), "+v"(r[9]), "+v"(r[10]), "+v"(r[11]), "+v"(r[12]), "+v"(r[13]), "+v"(r[14]), "+v"(r[15]) : "v"(a), "v"(b) : "s40", "s41", "vcc");
#endif
#if PROBE_UB == 19
        asm volatile("v_and_b32 %0, %0, %16\n\tv_and_b32 %1, %1, %16\n\tv_and_b32 %2, %2, %16\n\tv_and_b32 %3, %3, %16\n\tv_and_b32 %4, %4, %16\n\tv_and_b32 %5, %5, %16\n\tv_and_b32 %6, %6, %16\n\tv_and_b32 %7, %7, %16\n\tv_and_b32 %8, %8, %16\n\tv_and_b32 %9, %9, %16\n\tv_and_b32 %10, %10, %16\n\tv_and_b32 %11, %11, %16\n\tv_and_b32 %12, %12, %16\n\tv_and_b32 %13, %13, %16\n\tv_and_b32 %14, %14, %16\n\tv_and_b32 %15, %15, %16\n\t" : "+v"(r[0]), "+v"(r[1]), "+v"(r[2]), "+v"(r[3]), "+v"(r[4]), "+v"(r[5]), "+v"(r[6]), "+v"(r[7]), "+v"(r[8]), "+v"(r[9]), "+v"(r[10]), "+v"(r[11]), "+v"(r[12]), "+v"(r[13]), "+v"(r[14]), "+v"(r[15]) : "v"(a), "v"(b) : "s40", "s41", "vcc");
        asm volatile("v_and_b32 %0, %0, %16\n\tv_and_b32 %1, %1, %16\n\tv_and_b32 %2, %2, %16\n\tv_and_b32 %3, %3, %16\n\tv_and_b32 %4, %4, %16\n\tv_and_b32 %5, %5, %16\n\tv_and_b32 %6, %6, %16\n\tv_and_b32 %7, %7, %16\n\tv_and_b32 %8, %8, %16\n\tv_and_b32 %9, %9, %16\n\tv_and_b32 %10, %10, %16\n\tv_and_b32 %11, %11, %16\n\tv_and_b32 %12, %12, %16\n\tv_and_b32 %13, %13, %16\n\tv_and_b32 %14, %14, %16\n\tv_and_b32 %15, %15, %16\n\t" : "+v"(r[0]), "+v"(r[1]), "+v"(r[2]), "+v"(r[3]), "+v"(r[4]), "+v"(r[5]), "+v"(r[6]), "+v"(r[7]), "+v"(r[8]), "+v"(r[9]), "+v"(r[10]), "+v"(r[11]), "+v"(r[12]), "+v"(r[13]), "+v"(r[14]), "+v"(r[15]) : "v"(a), "v"(b) : "s40", "s41", "vcc");
#endif
#if PROBE_UB == 20
        asm volatile("v_lshrrev_b32 %0, 4, %0\n\tv_lshrrev_b32 %1, 4, %1\n\tv_lshrrev_b32 %2, 4, %2\n\tv_lshrrev_b32 %3, 4, %3\n\tv_lshrrev_b32 %4, 4, %4\n\tv_lshrrev_b32 %5, 4, %5\n\tv_lshrrev_b32 %6, 4, %6\n\tv_lshrrev_b32 %7, 4, %7\n\tv_lshrrev_b32 %8, 4, %8\n\tv_lshrrev_b32 %9, 4, %9\n\tv_lshrrev_b32 %10, 4, %10\n\tv_lshrrev_b32 %11, 4, %11\n\tv_lshrrev_b32 %12, 4, %12\n\tv_lshrrev_b32 %13, 4, %13\n\tv_lshrrev_b32 %14, 4, %14\n\tv_lshrrev_b32 %15, 4, %15\n\t" : "+v"(r[0]), "+v"(r[1]), "+v"(r[2]), "+v"(r[3]), "+v"(r[4]), "+v"(r[5]), "+v"(r[6]), "+v"(r[7]), "+v"(r[8]), "+v"(r[9]), "+v"(r[10]), "+v"(r[11]), "+v"(r[12]), "+v"(r[13]), "+v"(r[14]), "+v"(r[15]) : "v"(a), "v"(b) : "s40", "s41", "vcc");
        asm volatile("v_lshrrev_b32 %0, 4, %0\n\tv_lshrrev_b32 %1, 4, %1\n\tv_lshrrev_b32 %2, 4, %2\n\tv_lshrrev_b32 %3, 4, %3\n\tv_lshrrev_b32 %4, 4, %4\n\tv_lshrrev_b32 %5, 4, %5\n\tv_lshrrev_b32 %6, 4, %6\n\tv_lshrrev_b32 %7, 4, %7\n\tv_lshrrev_b32 %8, 4, %8\n\tv_lshrrev_b32 %9, 4, %9\n\tv_lshrrev_b32 %10, 4, %10\n\tv_lshrrev_b32 %11, 4, %11\n\tv_lshrrev_b32 %12, 4, %12\n\tv_lshrrev_b32 %13, 4, %13\n\tv_lshrrev_b32 %14, 4, %14\n\tv_lshrrev_b32 %15, 4, %15\n\t" : "+v"(r[0]), "+v"(r[1]), "+v"(r[2]), "+v"(r[3]), "+v"(r[4]), "+v"(r[5]), "+v"(r[6]), "+v"(r[7]), "+v"(r[8]), "+v"(r[9]), "+v"(r[10]), "+v"(r[11]), "+v"(r[12]), "+v"(r[13]), "+v"(r[14]), "+v"(r[15]) : "v"(a), "v"(b) : "s40", "s41", "vcc");
#endif
#if PROBE_UB == 21
        asm volatile("v_mul_f32 %0, %0, %16\n\tv_mul_f32 %1, %1, %16\n\tv_mul_f32 %2, %2, %16\n\tv_mul_f32 %3, %3, %16\n\tv_mul_f32 %4, %4, %16\n\tv_mul_f32 %5, %5, %16\n\tv_mul_f32 %6, %6, %16\n\tv_mul_f32 %7, %7, %16\n\tv_mul_f32 %8, %8, %16\n\tv_mul_f32 %9, %9, %16\n\tv_mul_f32 %10, %10, %16\n\tv_mul_f32 %11, %11, %16\n\tv_mul_f32 %12, %12, %16\n\tv_mul_f32 %13, %13, %16\n\tv_mul_f32 %14, %14, %16\n\tv_mul_f32 %15, %15, %16\n\t" : "+v"(r[0]), "+v"(r[1]), "+v"(r[2]), "+v"(r[3]), "+v"(r[4]), "+v"(r[5]), "+v"(r[6]), "+v"(r[7]), "+v"(r[8]), "+v"(r[9]), "+v"(r[10]), "+v"(r[11]), "+v"(r[12]), "+v"(r[13]), "+v"(r[14]), "+v"(r[15]) : "v"(a), "v"(b) : "s40", "s41", "vcc");
        asm volatile("v_mul_f32 %0, %0, %16\n\tv_mul_f32 %1, %1, %16\n\tv_mul_f32 %2, %2, %16\n\tv_mul_f32 %3, %3, %16\n\tv_mul_f32 %4, %4, %16\n\tv_mul_f32 %5, %5, %16\n\tv_mul_f32 %6, %6, %16\n\tv_mul_f32 %7, %7, %16\n\tv_mul_f32 %8, %8, %16\n\tv_mul_f32 %9, %9, %16\n\tv_mul_f32 %10, %10, %16\n\tv_mul_f32 %11, %11, %16\n\tv_mul_f32 %12, %12, %16\n\tv_mul_f32 %13, %13, %16\n\tv_mul_f32 %14, %14, %16\n\tv_mul_f32 %15, %15, %16\n\t" : "+v"(r[0]), "+v"(r[1]), "+v"(r[2]), "+v"(r[3]), "+v"(r[4]), "+v"(r[5]), "+v"(r[6]), "+v"(r[7]), "+v"(r[8]), "+v"(r[9]), "+v"(r[10]), "+v"(r[11]), "+v"(r[12]), "+v"(r[13]), "+v"(r[14]), "+v"(r[15]) : "v"(a), "v"(b) : "s40", "s41", "vcc");
#endif
#if PROBE_UB == 22
        asm volatile("v_add_u32 %0, %0, %16\n\tv_add_u32 %1, %1, %16\n\tv_add_u32 %2, %2, %16\n\tv_add_u32 %3, %3, %16\n\tv_add_u32 %4, %4, %16\n\tv_add_u32 %5, %5, %16\n\tv_add_u32 %6, %6, %16\n\tv_add_u32 %7, %7, %16\n\tv_add_u32 %8, %8, %16\n\tv_add_u32 %9, %9, %16\n\tv_add_u32 %10, %10, %16\n\tv_add_u32 %11, %11, %16\n\tv_add_u32 %12, %12, %16\n\tv_add_u32 %13, %13, %16\n\tv_add_u32 %14, %14, %16\n\tv_add_u32 %15, %15, %16\n\t" : "+v"(r[0]), "+v"(r[1]), "+v"(r[2]), "+v"(r[3]), "+v"(r[4]), "+v"(r[5]), "+v"(r[6]), "+v"(r[7]), "+v"(r[8]), "+v"(r[9]), "+v"(r[10]), "+v"(r[11]), "+v"(r[12]), "+v"(r[13]), "+v"(r[14]), "+v"(r[15]) : "v"(a), "v"(b) : "s40", "s41", "vcc");
        asm volatile("v_add_u32 %0, %0, %16\n\tv_add_u32 %1, %1, %16\n\tv_add_u32 %2, %2, %16\n\tv_add_u32 %3, %3, %16\n\tv_add_u32 %4, %4, %16\n\tv_add_u32 %5, %5, %16\n\tv_add_u32 %6, %6, %16\n\tv_add_u32 %7, %7, %16\n\tv_add_u32 %8, %8, %16\n\tv_add_u32 %9, %9, %16\n\tv_add_u32 %10, %10, %16\n\tv_add_u32 %11, %11, %16\n\tv_add_u32 %12, %12, %16\n\tv_add_u32 %13, %13, %16\n\tv_add_u32 %14, %14, %16\n\tv_add_u32 %15, %15, %16\n\t" : "+v"(r[0]), "+v"(r[1]), "+v"(r[2]), "+v"(r[3]), "+v"(r[4]), "+v"(r[5]), "+v"(r[6]), "+v"(r[7]), "+v"(r[8]), "+v"(r[9]), "+v"(r[10]), "+v"(r[11]), "+v"(r[12]), "+v"(r[13]), "+v"(r[14]), "+v"(r[15]) : "v"(a), "v"(b) : "s40", "s41", "vcc");
#endif
#if PROBE_UB == 23
        asm volatile("v_cvt_pk_bf16_f32 %0, %0, %16\n\tv_cvt_pk_bf16_f32 %1, %1, %16\n\tv_cvt_pk_bf16_f32 %2, %2, %16\n\tv_cvt_pk_bf16_f32 %3, %3, %16\n\tv_cvt_pk_bf16_f32 %4, %4, %16\n\tv_cvt_pk_bf16_f32 %5, %5, %16\n\tv_cvt_pk_bf16_f32 %6, %6, %16\n\tv_cvt_pk_bf16_f32 %7, %7, %16\n\tv_cvt_pk_bf16_f32 %8, %8, %16\n\tv_cvt_pk_bf16_f32 %9, %9, %16\n\tv_cvt_pk_bf16_f32 %10, %10, %16\n\tv_cvt_pk_bf16_f32 %11, %11, %16\n\tv_cvt_pk_bf16_f32 %12, %12, %16\n\tv_cvt_pk_bf16_f32 %13, %13, %16\n\tv_cvt_pk_bf16_f32 %14, %14, %16\n\tv_cvt_pk_bf16_f32 %15, %15, %16\n\t" : "+v"(r[0]), "+v"(r[1]), "+v"(r[2]), "+v"(r[3]), "+v"(r[4]), "+v"(r[5]), "+v"(r[6]), "+v"(r[7]), "+v"(r[8]), "+v"(r[9]), "+v"(r[10]), "+v"(r[11]), "+v"(r[12]), "+v"(r[13]), "+v"(r[14]), "+v"(r[15]) : "v"(a), "v"(b) : "s40", "s41", "vcc");
        asm volatile("v_cvt_pk_bf16_f32 %0, %0, %16\n\tv_cvt_pk_bf16_f32 %1, %1, %16\n\tv_cvt_pk_bf16_f32 %2, %2, %16\n\tv_cvt_pk_bf16_f32 %3, %3, %16\n\tv_cvt_pk_bf16_f32 %4, %4, %16\n\tv_cvt_pk_bf16_f32 %5, %5, %16\n\tv_cvt_pk_bf16_f32 %6, %6, %16\n\tv_cvt_pk_bf16_f32 %7, %7, %16\n\tv_cvt_pk_bf16_f32 %8, %8, %16\n\tv_cvt_pk_bf16_f32 %9, %9, %16\n\tv_cvt_pk_bf16_f32 %10, %10, %16\n\tv_cvt_pk_bf16_f32 %11, %11, %16\n\tv_cvt_pk_bf16_f32 %12, %12, %16\n\tv_cvt_pk_bf16_f32 %13, %13, %16\n\tv_cvt_pk_bf16_f32 %14, %14, %16\n\tv_cvt_pk_bf16_f32 %15, %15, %16\n\t" : "+v"(r[0]), "+v"(r[1]), "+v"(r[2]), "+v"(r[3]), "+v"(r[4]), "+v"(r[5]), "+v"(r[6]), "+v"(r[7]), "+v"(r[8]), "+v"(r[9]), "+v"(r[10]), "+v"(r[11]), "+v"(r[12]), "+v"(r[13]), "+v"(r[14]), "+v"(r[15]) : "v"(a), "v"(b) : "s40", "s41", "vcc");
#endif
    }
    float s = 0.f;
#pragma unroll
    for (int i = 0; i < 16; ++i) s += r[i];
#pragma unroll
    for (int i = 0; i < 8; ++i) s += r2[i].x + r2[i].y;
    if (s == 1.2345e-33f) asm volatile("s_nop 0" ::: "memory");
}
#endif
__device__ __forceinline__ void phase_mod(const Params& p, LAS unsigned char* lds, int wv) {
    const int tid = tid_opaque(wv);
    LAS float* sc = (LAS float*)lds;
    LAS float* red = (LAS float*)(lds + 32768);
    for (int i = tid; i < BATCH * D_MODEL; i += 512) { const int b = i >> 10, k = i & 1023; const float v = p.c[i]; sc[k * 8 + b] = v / (1.0f + __expf(-v)); }
    __syncthreads();
    const int kg = tid >> 5, cl = tid & 31;
    for (int u = blockIdx.x; u < DEPTH * 64; u += gridDim.x) {
        const int l = u >> 6, j0 = (u & 63) * 96;
        const float* w = p.w_mod + (size_t)l * D_MODEL * MODW + (size_t)(kg * 64) * MODW + j0 + cl;
        float acc[3][8];
#pragma unroll
        for (int q = 0; q < 3; ++q)
#pragma unroll
            for (int b = 0; b < 8; ++b) acc[q][b] = 0.f;
#pragma unroll 4
        for (int kk = 0; kk < 64; ++kk) {
            const float w0 = w[(size_t)kk * MODW], w1 = w[(size_t)kk * MODW + 32], w2 = w[(size_t)kk * MODW + 64];
            const f32x4 s0 = *(const LAS f32x4*)(sc + (kg * 64 + kk) * 8), s1 = *(const LAS f32x4*)(sc + (kg * 64 + kk) * 8 + 4);
#pragma unroll
            for (int b = 0; b < 4; ++b) { acc[0][b] += s0[b] * w0; acc[1][b] += s0[b] * w1; acc[2][b] += s0[b] * w2; acc[0][4 + b] += s1[b] * w0; acc[1][4 + b] += s1[b] * w1; acc[2][4 + b] += s1[b] * w2; }
        }
#pragma unroll
        for (int q = 0; q < 3; ++q)
#pragma unroll
            for (int b = 0; b < 8; ++b) red[((kg * 3 + q) * 8 + b) * 32 + cl] = acc[q][b];
        __syncthreads();
        for (int o = tid; o < 768; o += 512) {
            float s = 0.f;
#pragma unroll
            for (int g = 0; g < 16; ++g) s += red[g * 768 + o];
            const int ocl = o & 31, ob = (o >> 5) & 7, oq = o >> 8;
            const int j = j0 + oq * 32 + ocl;
            p.mod()[((size_t)l * BATCH + ob) * MODW + j] = s + p.b_mod[(size_t)l * MODW + j];
        }
        __syncthreads();
    }
}

__device__ __forceinline__ void phase_biasq(const Params& p, int l, int wv) {
    const int tid = tid_opaque(wv), wave = tid >> 6, lane = tid & 63;
    for (int n = blockIdx.x * NWAVES + wave; n < 2048; n += gridDim.x * NWAVES) {
        const bf16_t* wr = p.WqT() + ((size_t)l * 2048 + n) * D_MODEL + lane * 16;
        const u32x4 w0 = *(const u32x4*)wr, w1 = *(const u32x4*)(wr + 8);
        float w[16];
#pragma unroll
        for (int e = 0; e < 4; ++e) { w[2 * e] = bflo(w0[e]); w[2 * e + 1] = bfhi(w0[e]); w[8 + 2 * e] = bflo(w1[e]); w[8 + 2 * e + 1] = bfhi(w1[e]); }
#pragma unroll 1
        for (int b = 0; b < BATCH; ++b) {
            const float* sh = p.mod() + ((size_t)l * BATCH + b) * MODW + 3 * D_MODEL + lane * 16;
            float s = 0.f;
#pragma unroll
            for (int q = 0; q < 4; ++q) { const f32x4 v = *(const f32x4*)(sh + 4 * q); s += v[0] * w[4 * q] + v[1] * w[4 * q + 1] + v[2] * w[4 * q + 2] + v[3] * w[4 * q + 3]; }
            s = wave_sum(s);
            if (lane == 0) p.biasq()[((size_t)l * BATCH + b) * 2048 + n] = s;
        }
    }
}

#ifndef PROBE_TIME
#define PROBE_TIME 0
#endif
#if PROBE_TIME || PROBE_UB
#define PT_BEGIN(k) do { if ((k) == PROBE_TIME) pt_t0 = __builtin_amdgcn_s_memrealtime(); } while (0)
#define PT_END(k) do { if ((k) == PROBE_TIME) pt_acc += __builtin_amdgcn_s_memrealtime() - pt_t0; } while (0)
#else
#define PT_BEGIN(k) do { } while (0)
#define PT_END(k) do { } while (0)
#endif
__global__ void __launch_bounds__(512, 2) k_mega(Params p) {
    extern __shared__ __attribute__((aligned(16))) unsigned char smem_raw[];
    LAS unsigned char* lds = (LAS unsigned char*)smem_raw;
    volatile LAS unsigned* xbw = (volatile LAS unsigned*)(lds + LDS_BYTES - 16);
    const int wv = __builtin_amdgcn_readfirstlane((int)threadIdx.x >> 6);
    if (threadIdx.x == 0) { xbw[0] = 0u; xbw[1] = 0u; xbw[2] = 0u; xbw[3] = 0u; }
    __syncthreads();
    (void)xcd_barrier_post(p.bar(), xbw);
#define GRID_SYNC_AT(k) do { PT_BEGIN(30 + (k)); GRID_SYNC(); PT_END(30 + (k)); } while (0)
#define GRID_SYNC() do { XcdBarrier _b; _b.bar = p.bar(); _b.x = xb_xcc_id(); _b.st = (volatile LAS unsigned*)(lds + LDS_BYTES - 16); _b.t0 = (tid_opaque(wv) == 0); PT_BEGIN(20); xcd_barrier(_b); PT_END(20); } while (0)
#if PROBE_TIME || PROBE_UB
    unsigned long long pt_t0 = 0, pt_acc = 0;
#endif
#if PROBE_UB
    { GRID_SYNC(); const unsigned long long u0 = __builtin_amdgcn_s_memrealtime(); ubench(4000, (unsigned)blockIdx.x); pt_acc += __builtin_amdgcn_s_memrealtime() - u0; GRID_SYNC(); }
#endif
#if PROBE_MASK & 32
    for (int rep = 0; rep < 20; ++rep) GRID_SYNC();
#endif
    PT_BEGIN(1);
    for (int rep = 0; rep < ((PROBE_MASK & 8) ? 2 : 1); ++rep) { phase_mod(p, lds, wv); phase_convert(p, lds, wv); }
    GRID_SYNC();
    PT_END(1); PT_BEGIN(2);
    phase_norm(p, p.x_in, p.norm1_g, p.mod(), 0, 1, wv);
    GRID_SYNC();
    PT_END(2);
    for (int l = 0; l < DEPTH; ++l) {
        const float* modl = p.mod() + (size_t)l * BATCH * MODW;
        PT_BEGIN(3);
        for (int rep = 0; rep < ((PROBE_MASK & 1) ? 2 : 1); ++rep) { EpiStoreBf16 E; E.O = p.pb(); E.ldc = MIX_IN; run_gemm(lds, p.hb(), p.WinT() + (size_t)l * MIX_IN * D_MODEL, NTOK, MIX_IN, D_MODEL, E, wv); }
        convert_in_gemm1_slack(p, l, lds, wv);
        GRID_SYNC_AT(2);
        PT_END(3); PT_BEGIN(4); PT_BEGIN(10);
        for (int rep = 0; rep < ((PROBE_MASK & 2) ? 2 : 1); ++rep) phase_attn(p, l, lds, wv);
        PT_END(10);
        for (int rep = 0; rep < ((PROBE_MASK & 16) ? 2 : 1); ++rep) phase_mixrest(p, l, lds, wv);
        phase_biasq(p, l, wv);
        GRID_SYNC_AT(3);
        PT_END(4); PT_BEGIN(5);
        if (l == 0) { EpiResidNorm<true> E; E.xin32 = p.x_in; E.xin16 = nullptr; E.xout = p.xb(); E.modl = modl; E.n2g = p.norm2_g + l * D_MODEL; E.hb = p.hb(); E.ssq = p.ssq();
          run_gemm(lds, p.cat(), p.WoutT() + (size_t)l * D_MODEL * D_MODEL, NTOK, D_MODEL, D_MODEL, E, wv); }
        else { EpiResidNorm<false> E; E.xin32 = nullptr; E.xin16 = p.xb(); E.xout = p.xb(); E.modl = modl; E.n2g = p.norm2_g + l * D_MODEL; E.hb = p.hb(); E.ssq = p.ssq();
          run_gemm(lds, p.cat(), p.WoutT() + (size_t)l * D_MODEL * D_MODEL, NTOK, D_MODEL, D_MODEL, E, wv); }
        GRID_SYNC_AT(4);
        PT_END(5);
        PT_BEGIN(7);
        for (int rep = 0; rep < ((PROBE_MASK & 1) ? 2 : 1); ++rep) { EpiQ E; E.O = p.qb(); E.ssq = p.ssq(); E.biasq = p.biasq() + (size_t)l * BATCH * 2048; run_gemm(lds, p.hb(), p.WqT() + (size_t)l * 2048 * D_MODEL, NTOK, 2048, D_MODEL, E, wv); }
        GRID_SYNC_AT(5);
        PT_END(7); PT_BEGIN(8);
        for (int rep = 0; rep < ((PROBE_MASK & 4) ? 2 : 1); ++rep) phase_topk(p, l, lds, wv);
        GRID_SYNC_AT(6);
        PT_END(8); PT_BEGIN(9); PT_BEGIN(11);
        PT_BEGIN(12);
        if (PROBE_SYNTH) phase_expert(p, l, false, lds, wv, PROBE_SYNTH, true);
        PT_END(12);
        phase_expert(p, l, l == DEPTH - 1, lds, wv);
        PT_END(11);
        GRID_SYNC_AT(7);
        PT_END(9);
    }
#if PROBE_TIME || PROBE_UB
    if (blockIdx.x == PROBE_BLOCK) {
        const unsigned long long t1 = __builtin_amdgcn_s_memrealtime();
        while (__builtin_amdgcn_s_memrealtime() - t1 < 4ull * pt_acc) __builtin_amdgcn_s_sleep(8);
    }
#endif
}
#if MK_MULTI
enum { PH_CONVERT = 0, PH_NORM1, PH_GEMM1, PH_GEMM2, PH_NORM2, PH_GEMM3, PH_MOD };
template <int PH>
__global__ void __launch_bounds__(512, 2) k_ph(Params p, int l) {
    extern __shared__ __attribute__((aligned(16))) unsigned char smem_raw[];
    LAS unsigned char* lds = (LAS unsigned char*)smem_raw;
    const int wv = __builtin_amdgcn_readfirstlane((int)threadIdx.x >> 6);
    const float* modl = p.mod() + (size_t)l * BATCH * MODW;
    if (PH == PH_CONVERT) phase_convert(p, lds, wv);
    if (PH == PH_MOD) phase_mod(p, lds, wv);
    if (PH == PH_NORM1) phase_norm(p, l == 0 ? p.x_in : p.xb(), p.norm1_g + l * D_MODEL, modl, 0, 1, wv);
    if (PH == PH_GEMM1) { EpiStoreBf16 E; E.O = p.pb(); E.ldc = MIX_IN; run_gemm(lds, p.hb(), p.WinT() + (size_t)l * MIX_IN * D_MODEL, NTOK, MIX_IN, D_MODEL, E, wv); }
    if (PH == PH_GEMM2) { EpiResid E; E.xin = (l == 0) ? p.x_in : p.xb(); E.xout = p.xb(); E.gate = modl + 2 * D_MODEL; run_gemm(lds, p.cat(), p.WoutT() + (size_t)l * D_MODEL * D_MODEL, NTOK, D_MODEL, D_MODEL, E, wv); }
    if (PH == PH_NORM2) phase_norm(p, p.xb(), p.norm2_g + l * D_MODEL, modl, 3, 4, wv);
    if (PH == PH_GEMM3) { EpiStoreBf16 E; E.O = p.qb(); E.ldc = 2048; run_gemm(lds, p.hb(), p.WqT() + (size_t)l * 2048 * D_MODEL, NTOK, 2048, D_MODEL, E, wv); }
}

#endif

extern "C" void kernel_launch(void* const* d_in, const int* in_sizes, int n_in, void* d_out, int out_size, void* d_ws, size_t ws_size, hipStream_t stream) {
    Params p{};
    p.x_in = (const float*)d_in[0]; p.c = (const float*)d_in[1]; p.rel_bias = (const float*)d_in[2]; p.w_mod = (const float*)d_in[3]; p.b_mod = (const float*)d_in[4];
    p.norm1_g = (const float*)d_in[5]; p.norm2_g = (const float*)d_in[6]; p.w_in = (const float*)d_in[7]; p.w_out = (const float*)d_in[8]; p.diff_lambda = (const float*)d_in[9];
    p.subln_g = (const float*)d_in[10]; p.conf_dw = (const float*)d_in[11]; p.conf_ln_g = (const float*)d_in[12]; p.conf_ln_b = (const float*)d_in[13]; p.sconv_w = (const float*)d_in[14];
    p.sgu_ln_g = (const float*)d_in[15]; p.sgu_ln_b = (const float*)d_in[16]; p.sgu_w = (const float*)d_in[17]; p.sgu_b = (const float*)d_in[18]; p.peer_wq = (const float*)d_in[19];
    p.peer_keys = (const float*)d_in[20]; p.peer_u = (const float*)d_in[21]; p.peer_v = (const float*)d_in[22]; p.final_g = (const float*)d_in[23];
    p.out = (float*)d_out;
    for (int l = 0; l < DEPTH; ++l) p.lam_init[l] = (float)(0.8 - 0.6 * exp(-0.3 * (double)l));

    p.ws = (unsigned char*)d_ws;
    if (ws_size < WS_END) { fprintf(stderr, "kernel_launch: workspace too small\n"); return; }

    static int grid = 0;
    if (grid == 0) {
        int dev = 0, cus = 0;
        if (hipGetDevice(&dev) != hipSuccess || hipDeviceGetAttribute(&cus, hipDeviceAttributeMultiprocessorCount, dev) != hipSuccess) { grid = -1; return; }
        bool ok = true;
#if MK_MULTI
        ok &= hipFuncSetAttribute((const void*)k_ph<PH_CONVERT>, hipFuncAttributeMaxDynamicSharedMemorySize, LDS_BYTES) == hipSuccess;
        ok &= hipFuncSetAttribute((const void*)k_ph<PH_NORM1>, hipFuncAttributeMaxDynamicSharedMemorySize, LDS_BYTES) == hipSuccess;
        ok &= hipFuncSetAttribute((const void*)k_ph<PH_GEMM1>, hipFuncAttributeMaxDynamicSharedMemorySize, LDS_BYTES) == hipSuccess;
        ok &= hipFuncSetAttribute((const void*)k_ph<PH_GEMM2>, hipFuncAttributeMaxDynamicSharedMemorySize, LDS_BYTES) == hipSuccess;
        ok &= hipFuncSetAttribute((const void*)k_ph<PH_NORM2>, hipFuncAttributeMaxDynamicSharedMemorySize, LDS_BYTES) == hipSuccess;
        ok &= hipFuncSetAttribute((const void*)k_ph<PH_GEMM3>, hipFuncAttributeMaxDynamicSharedMemorySize, LDS_BYTES) == hipSuccess;
        ok &= hipFuncSetAttribute((const void*)k_ph<PH_MOD>, hipFuncAttributeMaxDynamicSharedMemorySize, LDS_BYTES) == hipSuccess;
        ok &= hipFuncSetAttribute((const void*)k_attn2<0>, hipFuncAttributeMaxDynamicSharedMemorySize, LDS_BYTES) == hipSuccess;
        ok &= hipFuncSetAttribute((const void*)k_topk<0>, hipFuncAttributeMaxDynamicSharedMemorySize, LDS_BYTES) == hipSuccess;
        ok &= hipFuncSetAttribute((const void*)k_mixrest<0>, hipFuncAttributeMaxDynamicSharedMemorySize, LDS_BYTES) == hipSuccess;
        ok &= hipFuncSetAttribute((const void*)k_expert, hipFuncAttributeMaxDynamicSharedMemorySize, LDS_BYTES) == hipSuccess;
#else
        ok &= hipFuncSetAttribute((const void*)k_mega, hipFuncAttributeMaxDynamicSharedMemorySize, LDS_BYTES) == hipSuccess;
#endif
        if (!ok) { fprintf(stderr, "kernel_launch: hipFuncSetAttribute failed\n"); grid = -1; return; }
        grid = cus;
    }
    if (grid < 0) return;
    const int G = grid;
#if MK_MULTI
    k_ph<PH_MOD><<<G, 512, LDS_BYTES, stream>>>(p, 0);
    k_ph<PH_CONVERT><<<G, 512, LDS_BYTES, stream>>>(p, 0);
    for (int l = 0; l < DEPTH; ++l) {
        if (l == 0) k_ph<PH_NORM1><<<G, 512, LDS_BYTES, stream>>>(p, l);
        k_ph<PH_GEMM1><<<G, 512, LDS_BYTES, stream>>>(p, l);
        k_attn2<0><<<G, 512, LDS_BYTES, stream>>>(p, l);
        k_mixrest<0><<<G, 512, LDS_BYTES, stream>>>(p, l);
        k_ph<PH_GEMM2><<<G, 512, LDS_BYTES, stream>>>(p, l);
        k_ph<PH_NORM2><<<G, 512, LDS_BYTES, stream>>>(p, l);
        k_ph<PH_GEMM3><<<G, 512, LDS_BYTES, stream>>>(p, l);
        k_topk<0><<<G, 512, LDS_BYTES, stream>>>(p, l);
        k_expert<<<G, 512, LDS_BYTES, stream>>>(p, l);
    }
#else
    (void)hipMemsetAsync(p.ws + OFF_BAR, 0, OFF_MOD - OFF_BAR, stream);
    k_mega<<<G, 512, LDS_BYTES, stream>>>(p);
#endif
}
```

```cpp
#include <hip/hip_runtime.h>
#include <stdint.h>
#include <stdio.h>
#include <math.h>

#define D_MODEL 1024
#define BATCH 8
#define SEQ 2048
#define DEPTH 4
#define NTOK (BATCH * SEQ)
#define MIX_IN 2560
#define N_MOD 6
#define MODW (N_MOD * D_MODEL)
#define NEXP 16384

#define MK_MULTI 0
#define FUSE_TOPK_EXPERT 0
#define EXPERT_MAP_GROUPED 1
#ifndef PROBE_MASK
#define PROBE_MASK 0
#endif
#define PROBE_TIME 0
#define PROBE_SYNTH 0
#define PROBE_UB 0
#define PROBE_BLOCK 0
#define LAS __attribute__((address_space(3)))
typedef unsigned short bf16_t;
typedef short bf16x8 __attribute__((ext_vector_type(8)));
typedef float f32x4 __attribute__((ext_vector_type(4)));
typedef float f32x16 __attribute__((ext_vector_type(16)));
typedef unsigned u32x4 __attribute__((ext_vector_type(4)));
typedef unsigned u32x2 __attribute__((ext_vector_type(2)));
typedef float f32x2 __attribute__((ext_vector_type(2)));

__device__ const unsigned char kBucket[128] = {
    0, 1, 2, 3, 4, 5, 6, 7, 8, 9, 10, 11, 12, 13, 14, 15, 16, 16, 16, 17, 17, 18, 18, 18, 19, 19, 19, 20, 20, 20, 20, 21,
    21, 21, 21, 22, 22, 22, 22, 22, 23, 23, 23, 23, 23, 23, 24, 24, 24, 24, 24, 24, 25, 25, 25, 25, 25, 25, 25, 26, 26, 26, 26, 26,
    26, 26, 26, 27, 27, 27, 27, 27, 27, 27, 27, 27, 27, 28, 28, 28, 28, 28, 28, 28, 28, 28, 28, 29, 29, 29, 29, 29, 29, 29, 29, 29,
    29, 29, 29, 30, 30, 30, 30, 30, 30, 30, 30, 30, 30, 30, 30, 30, 30, 31, 31, 31, 31, 31, 31, 31, 31, 31, 31, 31, 31, 31, 31, 31};

__device__ __forceinline__ float bf2f(bf16_t v) { return __uint_as_float(((unsigned)v) << 16); }
__device__ __forceinline__ float bflo(unsigned w) { return __uint_as_float(w << 16); }
__device__ __forceinline__ float bfhi(unsigned w) { return __uint_as_float(w & 0xFFFF0000u); }
__device__ __forceinline__ bf16_t f2bf(float f) { unsigned u = __float_as_uint(f); u += 0x7FFFu + ((u >> 16) & 1u); return (bf16_t)(u >> 16); }
__device__ __forceinline__ unsigned pk2(float lo, float hi) { unsigned r; asm volatile("v_cvt_pk_bf16_f32 %0, %1, %2" : "=v"(r) : "v"(lo), "v"(hi)); return r; }
__device__ __forceinline__ float ldf(const float* p) { return *p; }
__device__ __forceinline__ float ldf(const bf16_t* p) { return bf2f(*p); }

__device__ __forceinline__ float gelu_as(float v) {
    const float av = fabsf(v), t = __builtin_amdgcn_rcpf(av * 0.2316418882f + 1.0f);
    float q = t * 0.5307027145f + (-0.7265760135f); q = q * t + 0.7107068705f; q = q * t + (-0.142248368f); q = q * t + 0.127414796f; q = q * t;
    const float e = __builtin_amdgcn_exp2f((v * v) * (-0.72134752044f));
    const float m = v * (q * e);
    return v < 0.f ? m : v - m;
}
template <int CTRL, int ROWMASK = 0xF>
__device__ __forceinline__ float dpp_add(float x) {
    const int y = __builtin_amdgcn_update_dpp(0, __float_as_int(x), CTRL, ROWMASK, 0xF, false);
    return x + __int_as_float(y);
}
__device__ __forceinline__ float wave_sum_l63(float v) {
    v = dpp_add<0xB1>(v);
    v = dpp_add<0x4E>(v);
    v = dpp_add<0x141>(v);
    v = dpp_add<0x140>(v);
    v = dpp_add<0x142, 0xA>(v);
    v = dpp_add<0x143, 0xC>(v);
    return v;
}
__device__ __forceinline__ float gelu_exact(float v) { return 0.5f * v * (1.0f + erff(v * 0.70710678118654752f)); }
__device__ __forceinline__ float sigmoidf_(float v) { return 1.0f / (1.0f + __expf(-v)); }
__device__ __forceinline__ float wave_sum(float v) {
#pragma unroll
    for (int o = 32; o > 0; o >>= 1) v += __shfl_xor(v, o, 64);
    return v;
}
__device__ __forceinline__ float block_sum256(float v, float* red) {
    v = wave_sum(v);
    __syncthreads();
    if ((threadIdx.x & 63) == 0) red[threadIdx.x >> 6] = v;
    __syncthreads();
    return red[0] + red[1] + red[2] + red[3];
}

__device__ __forceinline__ int tid_opaque(int wv) {
    int t;
    asm volatile("v_mbcnt_lo_u32_b32 %0, -1, 0\n\tv_mbcnt_hi_u32_b32 %0, -1, %0" : "=v"(t));
    return (wv << 6) | t;
}
__device__ __forceinline__ int launder(int v) { asm volatile("" : "+v"(v)); return v; }
#define XB_TMO      128
#define XB_XCNT(j)  (256  + 64 * (j))
#define XB_XSUB(j)  (1280 + 64 * (j))
#define XB_XGEN(j)  (2304 + 64 * (j))
#define XB_TOP      3328
#define XB_TOPGEN   3392
#define XCD_BAR_WORDS 3456
#define XB_SPIN_CAP (1u << 18)

__device__ __forceinline__ unsigned xb_ld(unsigned* p)              { return __hip_atomic_load(p, __ATOMIC_RELAXED, __HIP_MEMORY_SCOPE_AGENT); }
__device__ __forceinline__ unsigned xb_add(unsigned* p, unsigned v) { return __hip_atomic_fetch_add(p, v, __ATOMIC_RELAXED, __HIP_MEMORY_SCOPE_AGENT); }
__device__ __forceinline__ unsigned xb_xcc_id() { return (unsigned)__builtin_amdgcn_s_getreg((3 << 11) | 20) & 0xFu; }
#define XB_SPIN(cond, bar) do { unsigned _sp = 0; while (cond) { __builtin_amdgcn_s_sleep(1); \
    if ((++_sp & 255u) == 0u) { if (xb_ld(&(bar)[XB_TMO])) break; if (_sp > XB_SPIN_CAP) { atomicAdd(&(bar)[XB_TMO], 1u); break; } } } } while (0)

struct XcdBarrier {
    unsigned* bar; unsigned x;
    bool t0;
    volatile LAS unsigned* st;
};

__device__ __forceinline__ XcdBarrier xcd_barrier_post(unsigned* bar, volatile LAS unsigned* st) {
    XcdBarrier b; b.bar = bar; b.x = xb_xcc_id(); b.st = st;
    if (threadIdx.x == 0) (void)xb_add(&bar[XB_XCNT(b.x)], 1u);
    return b;
}
__device__ __forceinline__ void xcd_barrier_complete(unsigned* bar, unsigned x, unsigned& nloc, unsigned& nx) {
    const unsigned G = gridDim.x * gridDim.y * gridDim.z;
    unsigned sum, cnt, mine, sp = 0u;
    for (;;) {
        sum = 0u; cnt = 0u; mine = 0u;
#pragma unroll
        for (unsigned j = 0; j < 16; ++j) { const unsigned c = xb_ld(&bar[XB_XCNT(j)]); sum += c; cnt += (c > 0u) ? 1u : 0u; mine = (j == x) ? c : mine; }
        if (sum == G) break;
        __builtin_amdgcn_s_sleep(1);
        if ((++sp & 255u) == 0u) { if (xb_ld(&bar[XB_TMO])) break; if (sp > XB_SPIN_CAP) { atomicAdd(&bar[XB_TMO], 1u); break; } }
    }
    nloc = mine > 0u ? mine : 1u; nx = cnt > 0u ? cnt : 1u;
}

__device__ __forceinline__ void xcd_barrier(const XcdBarrier& b) {
    asm volatile("s_waitcnt vmcnt(0)" ::: "memory");
    __syncthreads();
    if (b.t0) {
        unsigned* bar = b.bar;
        __builtin_amdgcn_s_waitcnt(0);
        unsigned nloc = b.st[0], nx = b.st[1];
        if (nloc == 0u) { xcd_barrier_complete(bar, b.x, nloc, nx); b.st[0] = nloc; b.st[1] = nx; }
        const unsigned old = xb_add(&bar[XB_XSUB(b.x)], 1u);
        const unsigned gen = old / nloc;
        if (old + 1u == (gen + 1u) * nloc) {
            __builtin_amdgcn_fence(__ATOMIC_RELEASE, "agent");
            asm volatile("s_waitcnt vmcnt(0)" ::: "memory");
            const unsigned og = xb_add(&bar[XB_TOP], 1u);
            const unsigned tg = og / nx;
            if (og + 1u == (tg + 1u) * nx) xb_add(&bar[XB_TOPGEN], 1u);
            else XB_SPIN(xb_ld(&bar[XB_TOPGEN]) == tg, bar);
            __builtin_amdgcn_fence(__ATOMIC_ACQUIRE, "agent");
            xb_add(&bar[XB_XGEN(b.x)], 1u);
            asm volatile("s_waitcnt vmcnt(0)" ::: "memory");
        } else {
            XB_SPIN(xb_ld(&bar[XB_XGEN(b.x)]) == gen, bar);
            __builtin_amdgcn_fence(__ATOMIC_ACQUIRE, "agent");
            asm volatile("s_waitcnt vmcnt(0)" ::: "memory");
        }
    }
    __syncthreads();
}
namespace pg8 {
#define PG8_LAS __attribute__((address_space(3)))
typedef unsigned short bf16_t;
typedef short bf16x8 __attribute__((ext_vector_type(8)));
typedef float f32x4 __attribute__((ext_vector_type(4)));
typedef unsigned u32x4 __attribute__((ext_vector_type(4)));
constexpr int BM = 256, BK = 64, HALF = 128, HTB = HALF * BK * 2  , STAGE_BYTES = 8 * HTB, NXCD = 8, WGM = 8;

__host__ __device__ __forceinline__ int lds_byte(int r, int c) { const int st = (r >> 4) * 2 + (c >> 5), rr = r & 15, cc = c & 31, ob = rr * 64 + cc * 2; return st * 1024 + (ob ^ (((ob >> 9) & 1) << 5)); }
__host__ __device__ __forceinline__ void stage_rc(int b, int& R, int& C) { const int st = b / 1024, sb = b % 1024, swz = sb ^ (((sb >> 9) & 1) << 5); R = (st >> 1) * 16 + swz / 64; C = (st & 1) * 32 + (swz % 64) / 2; }
__host__ __device__ __forceinline__ int perm32(int rho) { const int n = rho >> 4, i = rho & 15; return 8 * (i >> 2) + 4 * n + (i & 3); }

struct Unit { int pm, pn; };
struct Gemm { const bf16_t* A; const bf16_t* Bt; int M, N, K; };

struct StaticOrder {
    int nM, nN, nwg, G, c;
    __host__ __device__ void init(int M, int N, int G_, int c_) { nM = M / BM; nN = N / BM; nwg = nM * nN; G = G_; c = c_; }
    __host__ __device__ bool next(int i, Unit& u) const {
        const long L = (long)i * G + c; if (L >= nwg) return false;
        int wgid = (int)L; { const int q = nwg / NXCD, r = nwg % NXCD, xcd = wgid % NXCD, off = wgid / NXCD; wgid = (xcd < r ? xcd * (q + 1) : r * (q + 1) + (xcd - r) * q) + off; }
        const int nig = WGM * nN, gid = wgid / nig, fm = gid * WGM, gsz = (nM - fm) < WGM ? (nM - fm) : WGM;
        u.pm = fm + ((wgid % nig) % gsz); u.pn = (wgid % nig) / gsz; return true;
    }
    __device__ __forceinline__ void a_ready(const Unit&) const {}
    __device__ __forceinline__ void done(const Unit&) const {}
};
__device__ __forceinline__ unsigned cvt_pk_bf16(float lo, float hi) { unsigned r; asm volatile("v_cvt_pk_bf16_f32 %0, %1, %2" : "=v"(r) : "v"(lo), "v"(hi)); return r; }
template <class Epi, class Sched, bool STAMP = false>
__device__ __forceinline__ void gemm_phase(PG8_LAS unsigned char* lds, const Gemm g, const Sched& S, const Epi& E, unsigned long long* stamps, int wv) {
    const int tid = tid_opaque(wv), wid = __builtin_amdgcn_readfirstlane(tid >> 6), lane = tid & 63, wr = wid >> 2, wc = wid & 3, fr = lane & 15, fq = lane >> 4;
    const int K = g.K, nt = K / BK;
    int ts_lo = 0, ts_hi = 0, nts = 0; const unsigned long long rt_entry = STAMP ? (unsigned long long)wall_clock64() : 0ull;
#define PG8_STAMP() do { if (STAMP && wid == 0 && nts < 64) { const unsigned long long _c = (unsigned long long)clock64(); \
        ts_lo = (lane == nts) ? (int)(unsigned)_c : ts_lo; ts_hi = (lane == nts) ? (int)(unsigned)(_c >> 32) : ts_hi; ++nts; } } while (0)
    PG8_STAMP();
    unsigned voffA[2], voffB[2];
#pragma unroll
    for (int i = 0; i < 2; ++i) { int R, C; stage_rc(tid * 16 + i * 8192, R, C); const int Rb = Epi::PERM ? ((R & ~31) + perm32(R & 31)) : R;
        voffA[i] = (unsigned)(R * K + C) * 2u; voffB[i] = (unsigned)(Rb * K + C) * 2u; }
    const size_t kstep = (size_t)(BK * 2);
    const size_t hstep = (size_t)HALF * K * 2;
    const size_t tstep = 2 * hstep;
    const unsigned ldsw = (unsigned)wid * 1024u;
    const int aoff = lds_byte(wr * 64 + fr, fq * 8), boff = lds_byte(wc * 32 + fr, fq * 8);
#define PG8_SA(b, h) (((b) * 2 + (h)) * HTB)
#define PG8_SB(b, h) ((4 + (b) * 2 + (h)) * HTB)
#define PG8_STAGE(bufoff, gbase, voff) do { _Pragma("unroll") for (int _i = 0; _i < 2; ++_i) \
        __builtin_amdgcn_global_load_lds((const unsigned*)((const char*)(gbase) + (voff)[_i]), (PG8_LAS unsigned*)(lds + (bufoff) + ldsw + _i * 8192), 16, 0, 0); } while (0)
#define PG8_LDA(dst, b, h) do { _Pragma("unroll") for (int m = 0; m < 4; ++m) _Pragma("unroll") for (int k = 0; k < 2; ++k) dst[m][k] = *(const PG8_LAS bf16x8*)(lds + PG8_SA(b, h) + aoff + m * 2048 + k * 1024); } while (0)
#define PG8_LDB(dst, b, h) do { _Pragma("unroll") for (int n = 0; n < 2; ++n) _Pragma("unroll") for (int k = 0; k < 2; ++k) dst[n][k] = *(const PG8_LAS bf16x8*)(lds + PG8_SB(b, h) + boff + n * 2048 + k * 1024); } while (0)
#define PG8_MMA(ai, bj, At, Bt) do { __builtin_amdgcn_s_setprio(1); _Pragma("unroll") for (int m = 0; m < 4; ++m) _Pragma("unroll") for (int n = 0; n < 2; ++n) _Pragma("unroll") for (int k = 0; k < 2; ++k) \
        acc[ai][bj][m][n] = __builtin_amdgcn_mfma_f32_16x16x32_bf16(Bt[n][k], At[m][k], acc[ai][bj][m][n], 0, 0, 0); __builtin_amdgcn_s_setprio(0); } while (0)
#define PG8_WAIT_V(n) asm volatile("s_waitcnt vmcnt(" #n ")" ::: "memory")
#define PG8_WAIT_L(n) asm volatile("s_waitcnt lgkmcnt(" #n ")" ::: "memory")
#define PG8_BAR __builtin_amdgcn_s_barrier()
#define PG8_SCHED __builtin_amdgcn_sched_barrier(0)
    Unit cur, nxt; int ui = 0;
    if (!S.next(0, cur)) return;
    f32x4 acc[2][2][4][2];
#pragma unroll
    for (int a = 0; a < 2; ++a)
#pragma unroll
        for (int b = 0; b < 2; ++b)
#pragma unroll
            for (int m = 0; m < 4; ++m)
#pragma unroll
                for (int n = 0; n < 2; ++n) acc[a][b][m][n] = (f32x4){0.f, 0.f, 0.f, 0.f};
    bf16x8 At[4][2], B0[2][2], B1[2][2];
    const char* cA = (const char*)g.A + (size_t)cur.pm * tstep; const char* cB = (const char*)g.Bt + (size_t)cur.pn * tstep;
    S.a_ready(cur);
    PG8_STAGE(PG8_SB(0, 0), cB, voffB); PG8_STAGE(PG8_SA(0, 0), cA, voffA); PG8_STAGE(PG8_SB(0, 1), cB + hstep, voffB); PG8_STAGE(PG8_SA(0, 1), cA + hstep, voffA);
    if (wr == 1) PG8_BAR;
    PG8_WAIT_V(4); PG8_BAR;
    PG8_STAGE(PG8_SB(1, 0), cB + kstep, voffB); PG8_STAGE(PG8_SA(1, 0), cA + kstep, voffA); PG8_STAGE(PG8_SB(1, 1), cB + hstep + kstep, voffB);
    PG8_WAIT_V(6); PG8_BAR;
    PG8_STAMP();
    for (;;) {
        const bool has_next = S.next(ui + 1, nxt);
        const char* nA = has_next ? (const char*)g.A + (size_t)nxt.pm * tstep : cA; const char* nB = has_next ? (const char*)g.Bt + (size_t)nxt.pn * tstep : cB;
        for (int t = 0; t < nt; t += 2) {
            const bool last = (t == nt - 2);
            const char* a1 = cA + (size_t)(t + 1) * kstep;
            const char* a2 = last ? nA : cA + (size_t)(t + 2) * kstep; const char* b2 = last ? nB : cB + (size_t)(t + 2) * kstep;
            const char* a3 = a2 + kstep; const char* b3 = b2 + kstep;
            if (last && has_next) S.a_ready(nxt);
            PG8_LDB(B0, 0, 0); PG8_SCHED; PG8_LDA(At, 0, 0); PG8_STAGE(PG8_SA(1, 1), a1 + hstep, voffA);
            PG8_WAIT_L(8); PG8_BAR; PG8_WAIT_L(0); PG8_MMA(0, 0, At, B0); PG8_BAR; PG8_SCHED;
            PG8_LDB(B1, 0, 1); PG8_STAGE(PG8_SB(0, 0), b2, voffB);
            PG8_BAR; PG8_WAIT_L(0); PG8_MMA(0, 1, At, B1); PG8_BAR;
            PG8_LDA(At, 0, 1); PG8_STAGE(PG8_SA(0, 0), a2, voffA);
            PG8_BAR; PG8_WAIT_L(0); PG8_MMA(1, 0, At, B0); PG8_BAR; PG8_SCHED;
            PG8_STAGE(PG8_SB(0, 1), b2 + hstep, voffB);
            PG8_WAIT_V(6); PG8_BAR; PG8_MMA(1, 1, At, B1); PG8_BAR;
            PG8_LDB(B0, 1, 0); PG8_SCHED; PG8_LDA(At, 1, 0); PG8_STAGE(PG8_SA(0, 1), a2 + hstep, voffA);
            PG8_WAIT_L(8); PG8_BAR; PG8_WAIT_L(0); PG8_MMA(0, 0, At, B0); PG8_BAR; PG8_SCHED;
            PG8_LDB(B1, 1, 1); PG8_STAGE(PG8_SB(1, 0), b3, voffB);
            PG8_BAR; PG8_WAIT_L(0); PG8_MMA(0, 1, At, B1); PG8_BAR;
            PG8_LDA(At, 1, 1); PG8_STAGE(PG8_SA(1, 0), a3, voffA);
            PG8_BAR; PG8_WAIT_L(0); PG8_MMA(1, 0, At, B0); PG8_BAR; PG8_SCHED;
            PG8_STAGE(PG8_SB(1, 1), b3 + hstep, voffB);
            PG8_WAIT_V(6); PG8_BAR; PG8_MMA(1, 1, At, B1); PG8_BAR;
        }
        PG8_STAMP();
        if constexpr (!Epi::AFTER_DRAIN) { E(acc, cur, wr, wc, fr, fq); S.done(cur); }
        PG8_STAMP();
        if (!has_next) break;
#pragma unroll
        for (int a = 0; a < 2; ++a)
#pragma unroll
            for (int b = 0; b < 2; ++b)
#pragma unroll
                for (int m = 0; m < 4; ++m)
#pragma unroll
                    for (int n = 0; n < 2; ++n) acc[a][b][m][n] = (f32x4){0.f, 0.f, 0.f, 0.f};
        cur = nxt; cA = nA; cB = nB; ++ui;
    }
    PG8_WAIT_V(0);
    if (wr == 0) PG8_BAR;
    PG8_BAR;
    if constexpr (Epi::AFTER_DRAIN) { E.fused(acc, cur, wr, wc, fr, fq, lds, wid, lane); S.done(cur); }
    PG8_STAMP();
    if (STAMP && wid == 0) { stamps[lane] = lane < nts ? (((unsigned long long)(unsigned)ts_hi << 32) | (unsigned)ts_lo) : 0ull;
        if (lane == 62) stamps[62] = rt_entry; if (lane == 63) stamps[63] = (unsigned long long)wall_clock64(); }
#undef PG8_STAMP
#undef PG8_SA
#undef PG8_SB
#undef PG8_STAGE
#undef PG8_LDA
#undef PG8_LDB
#undef PG8_MMA
#undef PG8_WAIT_V
#undef PG8_WAIT_L
#undef PG8_BAR
#undef PG8_SCHED
}
}

constexpr size_t ws_al(size_t x) { return (x + 255) & ~(size_t)255; }
constexpr size_t OFF_BAR = 0;
constexpr size_t OFF_CTR = OFF_BAR + ws_al((size_t)3456 * 4);
constexpr size_t CTR_BYTES = 64 * 256;
constexpr size_t OFF_MOD = OFF_CTR + CTR_BYTES;
constexpr size_t OFF_XB = OFF_MOD + ws_al((size_t)DEPTH * BATCH * MODW * 4);
constexpr size_t OFF_HB = OFF_XB + ws_al((size_t)NTOK * D_MODEL * 4);
constexpr size_t OFF_PB = OFF_HB + ws_al((size_t)NTOK * D_MODEL * 2);
constexpr size_t OFF_CAT = OFF_PB + ws_al((size_t)NTOK * MIX_IN * 2);
constexpr size_t OFF_QB = OFF_CAT + ws_al((size_t)NTOK * D_MODEL * 2);
constexpr size_t OFF_WINT = OFF_QB + ws_al((size_t)NTOK * 2048 * 2);
constexpr size_t OFF_WOUTT = OFF_WINT + ws_al((size_t)DEPTH * MIX_IN * D_MODEL * 2);
constexpr size_t OFF_WQT = OFF_WOUTT + ws_al((size_t)DEPTH * D_MODEL * D_MODEL * 2);
constexpr size_t OFF_KEYSB = OFF_WQT + ws_al((size_t)DEPTH * 2048 * D_MODEL * 2);
constexpr size_t OFF_SGUWB = OFF_KEYSB + ws_al((size_t)DEPTH * 16 * 128 * 128 * 2);
constexpr size_t OFF_UB8 = OFF_SGUWB + ws_al((size_t)DEPTH * 4 * 128 * 128 * 2);
constexpr size_t OFF_VB8 = OFF_UB8 + ws_al((size_t)DEPTH * NEXP * D_MODEL);
constexpr size_t OFF_UINV = OFF_VB8 + ws_al((size_t)DEPTH * NEXP * D_MODEL);
constexpr size_t OFF_VINV = OFF_UINV + ws_al((size_t)DEPTH * NEXP * 4);
constexpr size_t OFF_EIDX = OFF_VINV + ws_al((size_t)DEPTH * NEXP * 4);
constexpr size_t OFF_EGATE = OFF_EIDX + ws_al((size_t)NTOK * 128 * 4);
constexpr size_t OFF_SSQ = OFF_EGATE + ws_al((size_t)NTOK * 128 * 4);
constexpr size_t OFF_BIASQ = OFF_SSQ + ws_al((size_t)NTOK * 16 * 4);
constexpr size_t WS_END = OFF_BIASQ + ws_al((size_t)DEPTH * BATCH * 2048 * 4);

struct Params {
    const float *x_in, *c, *rel_bias, *w_mod, *b_mod, *norm1_g, *norm2_g, *w_in, *w_out, *diff_lambda, *subln_g, *conf_dw, *conf_ln_g, *conf_ln_b, *sconv_w,
        *sgu_ln_g, *sgu_ln_b, *sgu_w, *sgu_b, *peer_wq, *peer_keys, *peer_u, *peer_v, *final_g;
    float* out;
    unsigned char* ws;
    float lam_init[DEPTH];
    __host__ __device__ unsigned* bar() const { return (unsigned*)(ws + OFF_BAR); }
    __host__ __device__ unsigned* ctr(int i) const { return (unsigned*)(ws + OFF_CTR + (size_t)i * 256); }
    __host__ __device__ float* mod() const { return (float*)(ws + OFF_MOD); }
    __host__ __device__ bf16_t* xb() const { return (bf16_t*)(ws + OFF_XB); }
    __host__ __device__ bf16_t* hb() const { return (bf16_t*)(ws + OFF_HB); }
    __host__ __device__ bf16_t* pb() const { return (bf16_t*)(ws + OFF_PB); }
    __host__ __device__ bf16_t* cat() const { return (bf16_t*)(ws + OFF_CAT); }
    __host__ __device__ bf16_t* qb() const { return (bf16_t*)(ws + OFF_QB); }
    __host__ __device__ bf16_t* WinT() const { return (bf16_t*)(ws + OFF_WINT); }
    __host__ __device__ bf16_t* WoutT() const { return (bf16_t*)(ws + OFF_WOUTT); }
    __host__ __device__ bf16_t* WqT() const { return (bf16_t*)(ws + OFF_WQT); }
    __host__ __device__ bf16_t* keysb() const { return (bf16_t*)(ws + OFF_KEYSB); }
    __host__ __device__ bf16_t* sguwb() const { return (bf16_t*)(ws + OFF_SGUWB); }
    __host__ __device__ unsigned char* ub8() const { return ws + OFF_UB8; }
    __host__ __device__ unsigned char* vb8() const { return ws + OFF_VB8; }
    __host__ __device__ float* uinv() const { return (float*)(ws + OFF_UINV); }
    __host__ __device__ float* vinv() const { return (float*)(ws + OFF_VINV); }
    __host__ __device__ int* eidx() const { return (int*)(ws + OFF_EIDX); }
    __host__ __device__ float* egate() const { return (float*)(ws + OFF_EGATE); }
    __host__ __device__ float* ssq() const { return (float*)(ws + OFF_SSQ); }
    __host__ __device__ float* biasq() const { return (float*)(ws + OFF_BIASQ); }
};

#define LDS_BYTES (160 * 1024)
#define NWAVES 8

__device__ __forceinline__ void transpose_item(const float* __restrict__ W, int K, int N, bf16_t* __restrict__ WT, LAS float* scr, int item, int lane) {
    const int nblk = N / 32, kb = item / nblk, nb = item % nblk, k0 = 64 * kb, n0 = 32 * nb;
#pragma unroll 8
    for (int i = 0; i < 32; ++i) { const int kk = 2 * i + (lane >> 5); scr[kk * 33 + (lane & 31)] = W[(size_t)(k0 + kk) * N + n0 + (lane & 31)]; }
    asm volatile("s_waitcnt lgkmcnt(0)" ::: "memory");
    const int c = lane & 7;
#pragma unroll
    for (int j = 0; j < 4; ++j) {
        const int n = (lane >> 3) + 8 * j; const LAS float* s = scr + (8 * c) * 33 + n;
        u32x4 o; o.x = pk2(s[0 * 33], s[1 * 33]); o.y = pk2(s[2 * 33], s[3 * 33]); o.z = pk2(s[4 * 33], s[5 * 33]); o.w = pk2(s[6 * 33], s[7 * 33]);
        *(u32x4*)(WT + (size_t)(n0 + n) * K + k0 + 8 * c) = o;
    }
    asm volatile("s_waitcnt lgkmcnt(0)" ::: "memory");
}
__device__ __forceinline__ void cvt8(const float* __restrict__ s, bf16_t* __restrict__ d) {
    const f32x4 a = *(const f32x4*)s, b = *(const f32x4*)(s + 4);
    u32x4 o; o.x = pk2(a[0], a[1]); o.y = pk2(a[2], a[3]); o.z = pk2(b[0], b[1]); o.w = pk2(b[2], b[3]);
    *(u32x4*)d = o;
}
#define CV_NR 4
__device__ __forceinline__ void convert_table_row(const Params& p, int tr0, int lane) {
    f32x4 a[CV_NR][4];
#pragma unroll
    for (int h2 = 0; h2 < CV_NR; ++h2) {
        const int tr = tr0 + h2, l = tr / (2 * NEXP), w2 = tr % (2 * NEXP); const bool isv = w2 >= NEXP; const size_t r = (size_t)l * NEXP + (isv ? w2 - NEXP : w2);
        const float* src = (isv ? p.peer_v : p.peer_u) + r * D_MODEL + lane * 16;
#pragma unroll
        for (int q = 0; q < 4; ++q) a[h2][q] = *(const f32x4*)(src + 4 * q);
    }
#pragma unroll
    for (int h2 = 0; h2 < CV_NR; ++h2) {
        const int tr = tr0 + h2, l = tr / (2 * NEXP), w2 = tr % (2 * NEXP); const bool isv = w2 >= NEXP; const size_t r = (size_t)l * NEXP + (isv ? w2 - NEXP : w2);
        float ss = 0.f;
#pragma unroll
        for (int q = 0; q < 4; ++q) ss += a[h2][q][0] * a[h2][q][0] + a[h2][q][1] * a[h2][q][1] + a[h2][q][2] * a[h2][q][2] + a[h2][q][3] * a[h2][q][3];
        ss = wave_sum(ss);
        const float step = fmaxf(0.335f * sqrtf(ss * (1.0f / D_MODEL)), 1e-30f), sc = 1.0f / step;
        unsigned o[2];
#pragma unroll
        for (int d = 0; d < 2; ++d) {
            unsigned w = 0;
#pragma unroll
            for (int e = 0; e < 8; ++e) {
                const float v = a[h2][2 * d + (e >> 2)][e & 3];
                const int qv = (int)fminf(fmaxf(rintf(v * sc), -8.f), 7.f) + 8;
                w |= (unsigned)qv << (8 * (e >> 1) + 4 * (e & 1));
            }
            o[d] = w;
        }
        *(u32x2*)((isv ? p.vb8() : p.ub8()) + r * (D_MODEL / 2) + lane * 8) = (u32x2){o[0], o[1]};
        if (lane == 0) (isv ? p.vinv() : p.uinv())[r] = step;
    }
}
constexpr int CV_I_IN = (D_MODEL / 64) * (MIX_IN / 32), CV_I_OUT = (D_MODEL / 64) * (D_MODEL / 32), CV_I_Q = (D_MODEL / 64) * (2048 / 32), CV_I_L = CV_I_IN + CV_I_OUT + CV_I_Q;
__device__ __forceinline__ void convert_weight_item(const Params& p, int l, int r, LAS float* scr, int lane) {
    if (r < CV_I_IN) { transpose_item(p.w_in + (size_t)l * D_MODEL * MIX_IN, D_MODEL, MIX_IN, p.WinT() + (size_t)l * MIX_IN * D_MODEL, scr, r, lane); return; } r -= CV_I_IN;
    if (r < CV_I_OUT) { transpose_item(p.w_out + (size_t)l * D_MODEL * D_MODEL, D_MODEL, D_MODEL, p.WoutT() + (size_t)l * D_MODEL * D_MODEL, scr, r, lane); return; } r -= CV_I_OUT;
    transpose_item(p.peer_wq + (size_t)l * D_MODEL * 2048, D_MODEL, 2048, p.WqT() + (size_t)l * 2048 * D_MODEL, scr, r, lane);
}
__device__ __forceinline__ void phase_convert(const Params& p, LAS unsigned char* lds, int wv) {
    const int tid = tid_opaque(wv), wave = tid >> 6, lane = tid & 63;
    LAS float* scr = (LAS float*)(lds + wave * 16384);
    const int gw = blockIdx.x * NWAVES + wave, NGW = gridDim.x * NWAVES;
    for (int it = gw; it < CV_I_L; it += NGW) convert_weight_item(p, 0, it, scr, lane);
    const size_t gt = (size_t)blockIdx.x * 512 + tid, NGT = (size_t)gridDim.x * 512;
    constexpr size_t N_KEYS8 = (size_t)DEPTH * 16 * 128 * 128 / 8, N_SGU8 = (size_t)DEPTH * 4 * 128 * 128 / 8;
    for (size_t i = gt; i < N_KEYS8; i += NGT) cvt8(p.peer_keys + i * 8, p.keysb() + i * 8);
    for (int tr = CV_NR * gw; tr < 2 * NEXP; tr += CV_NR * NGW) convert_table_row(p, tr, lane);
    for (size_t i = gt; i < N_SGU8; i += NGT) {
        const size_t e = i * 8; const int s0 = (int)(e & 127), t = (int)((e >> 7) & 127);
        const f32x4 a = *(const f32x4*)(p.sgu_w + e), b = *(const f32x4*)(p.sgu_w + e + 4);
        float v[8] = {a[0], a[1], a[2], a[3], b[0], b[1], b[2], b[3]};
#pragma unroll
        for (int j = 0; j < 8; ++j) v[j] = (s0 + j <= t) ? v[j] : 0.f;
        u32x4 o; o.x = pk2(v[0], v[1]); o.y = pk2(v[2], v[3]); o.z = pk2(v[4], v[5]); o.w = pk2(v[6], v[7]);
        *(u32x4*)(p.sguwb() + e) = o;
    }
}
__device__ __forceinline__ void convert_in_gemm1_slack(const Params& p, int l, LAS unsigned char* lds, int wv) {
    const int G = (int)gridDim.x;
    int rem = 640 - 2 * G;
    if (rem <= 0 || rem >= G) rem = 0;
    if ((int)blockIdx.x < rem) return;
    const int tid = tid_opaque(wv), wave = tid >> 6, lane = tid & 63;
    LAS float* scr = (LAS float*)(lds + wave * 16384);
    const int cw = ((int)blockIdx.x - rem) * NWAVES + wave, NCW = (G - rem) * NWAVES;
    if (l + 1 < DEPTH) for (int it = cw; it < CV_I_L; it += NCW) convert_weight_item(p, l + 1, it, scr, lane);
    constexpr int S_ROWS = (DEPTH - 1) * 2 * NEXP, W_ROWS = S_ROWS / DEPTH;
    for (int sr = l * W_ROWS + CV_NR * cw; sr < (l + 1) * W_ROWS; sr += CV_NR * NCW) convert_table_row(p, 2 * NEXP + sr, lane);
}

__device__ __forceinline__ void norm_row(const float* __restrict__ xr, const float* __restrict__ g, const float* __restrict__ sh, const float* __restrict__ sc, bf16_t* __restrict__ hr, int lane) {
    f32x4 v[4]; float ss = 0.f;
#pragma unroll
    for (int j = 0; j < 4; ++j) { v[j] = *(const f32x4*)(xr + j * 256 + lane * 4); ss += v[j][0] * v[j][0] + v[j][1] * v[j][1] + v[j][2] * v[j][2] + v[j][3] * v[j][3]; }
    const float rs = rsqrtf(wave_sum(ss) * (1.0f / D_MODEL) + 1e-6f);
#pragma unroll
    for (int j = 0; j < 4; ++j) {
        const int col = j * 256 + lane * 4;
        const f32x4 gv = *(const f32x4*)(g + col), scv = *(const f32x4*)(sc + col), shv = *(const f32x4*)(sh + col);
        f32x4 y;
#pragma unroll
        for (int e = 0; e < 4; ++e) y[e] = v[j][e] * rs * gv[e] * (1.0f + scv[e]) + shv[e];
        u32x2 o; o.x = pk2(y[0], y[1]); o.y = pk2(y[2], y[3]);
        *(u32x2*)(hr + col) = o;
    }
}
__device__ __forceinline__ void phase_norm(const Params& p, const float* __restrict__ x, const float* __restrict__ g, const float* __restrict__ modl, int sh_idx, int sc_idx, int wv) {
    const int tid = tid_opaque(wv), wave = tid >> 6, lane = tid & 63;
    for (int t = blockIdx.x * NWAVES + wave; t < NTOK; t += gridDim.x * NWAVES) {
        const float* mb = modl + (size_t)(t / SEQ) * MODW;
        norm_row(x + (size_t)t * D_MODEL, g, mb + sh_idx * D_MODEL, mb + sc_idx * D_MODEL, p.hb() + (size_t)t * D_MODEL, lane);
    }
}

struct EpiStoreBf16 {
    static constexpr bool PERM = true, AFTER_DRAIN = false;
    bf16_t* O; int ldc;
    __device__ __forceinline__ void operator()(const pg8::f32x4 (&acc)[2][2][4][2], const pg8::Unit& u, int wr, int wc, int fr, int fq) const {
        const int row0 = u.pm * 256 + wr * 64 + fr, col0 = u.pn * 256 + wc * 32 + 8 * fq;
#pragma unroll
        for (int ai = 0; ai < 2; ++ai)
#pragma unroll
            for (int m = 0; m < 4; ++m) {
                bf16_t* rowp = O + (size_t)(row0 + ai * 128 + m * 16) * ldc + col0;
#pragma unroll
                for (int bj = 0; bj < 2; ++bj) {
                    const pg8::f32x4 v0 = acc[ai][bj][m][0], v1 = acc[ai][bj][m][1];
                    u32x4 w; w.x = pk2(v0[0], v0[1]); w.y = pk2(v0[2], v0[3]); w.z = pk2(v1[0], v1[1]); w.w = pk2(v1[2], v1[3]);
                    *(u32x4*)(rowp + bj * 128) = w;
                }
            }
    }
};
struct EpiResid {
    static constexpr bool PERM = false, AFTER_DRAIN = false;
    const float* xin; float* xout; const float* gate;
    __device__ __forceinline__ void operator()(const pg8::f32x4 (&acc)[2][2][4][2], const pg8::Unit& u, int wr, int wc, int fr, int fq) const {
        const int row0 = u.pm * 256 + wr * 64 + fr, col0 = u.pn * 256 + wc * 32 + 4 * fq;
        const float* gb = gate + (size_t)((u.pm * 256) / SEQ) * MODW + col0;
        pg8::f32x4 gv[2][2];
#pragma unroll
        for (int bj = 0; bj < 2; ++bj)
#pragma unroll
            for (int n = 0; n < 2; ++n) gv[bj][n] = *(const pg8::f32x4*)(gb + bj * 128 + n * 16);
#pragma unroll
        for (int ai = 0; ai < 2; ++ai)
#pragma unroll
            for (int m = 0; m < 4; ++m) {
                const size_t off = (size_t)(row0 + ai * 128 + m * 16) * D_MODEL + col0;
#pragma unroll
                for (int bj = 0; bj < 2; ++bj)
#pragma unroll
                    for (int n = 0; n < 2; ++n) {
                        const pg8::f32x4 xv = *(const pg8::f32x4*)(xin + off + bj * 128 + n * 16);
                        *(pg8::f32x4*)(xout + off + bj * 128 + n * 16) = xv + gv[bj][n] * acc[ai][bj][m][n];
                    }
            }
    }
};

template <bool FIRST>
struct EpiResidNorm {
    static constexpr bool PERM = true, AFTER_DRAIN = false;
    const float* xin32; const bf16_t* xin16; bf16_t* xout; const float* modl; const float* n2g; bf16_t* hb; float* ssq;
    __device__ __forceinline__ void operator()(const pg8::f32x4 (&acc)[2][2][4][2], const pg8::Unit& u, int wr, int wc, int fr, int fq) const {
        const int row0 = u.pm * 256 + wr * 64 + fr, col0 = u.pn * 256 + wc * 32 + 8 * fq;
        const float* mb = modl + (size_t)((u.pm * 256) / SEQ) * MODW;
        pg8::f32x4 gv[2][2], gm[2][2];
#pragma unroll
        for (int bj = 0; bj < 2; ++bj)
#pragma unroll
            for (int n = 0; n < 2; ++n) {
                const int c = col0 + bj * 128 + n * 4;
                gv[bj][n] = *(const pg8::f32x4*)(mb + 2 * D_MODEL + c);
                gm[bj][n] = *(const pg8::f32x4*)(n2g + c) * (*(const pg8::f32x4*)(mb + 4 * D_MODEL + c) + 1.0f);
            }
#pragma unroll
        for (int ai = 0; ai < 2; ++ai)
#pragma unroll
            for (int m = 0; m < 4; ++m) {
                const int row = row0 + ai * 128 + m * 16;
                const size_t off = (size_t)row * D_MODEL + col0;
                float sq = 0.f;
#pragma unroll
                for (int bj = 0; bj < 2; ++bj) {
                    pg8::f32x4 x0, x1;
                    if (FIRST) { x0 = *(const pg8::f32x4*)(xin32 + off + bj * 128); x1 = *(const pg8::f32x4*)(xin32 + off + bj * 128 + 4); }
                    else { const u32x4 w = *(const u32x4*)(xin16 + off + bj * 128); x0 = (pg8::f32x4){bflo(w.x), bfhi(w.x), bflo(w.y), bfhi(w.y)}; x1 = (pg8::f32x4){bflo(w.z), bfhi(w.z), bflo(w.w), bfhi(w.w)}; }
                    x0 += gv[bj][0] * acc[ai][bj][m][0]; x1 += gv[bj][1] * acc[ai][bj][m][1];
                    u32x4 xo; xo.x = pk2(x0[0], x0[1]); xo.y = pk2(x0[2], x0[3]); xo.z = pk2(x1[0], x1[1]); xo.w = pk2(x1[2], x1[3]);
                    *(u32x4*)(xout + off + bj * 128) = xo;
                    x0 = (pg8::f32x4){bflo(xo.x), bfhi(xo.x), bflo(xo.y), bfhi(xo.y)}; x1 = (pg8::f32x4){bflo(xo.z), bfhi(xo.z), bflo(xo.w), bfhi(xo.w)};
                    sq += x0[0] * x0[0] + x0[1] * x0[1] + x0[2] * x0[2] + x0[3] * x0[3] + x1[0] * x1[0] + x1[1] * x1[1] + x1[2] * x1[2] + x1[3] * x1[3];
                    const pg8::f32x4 h0 = x0 * gm[bj][0], h1 = x1 * gm[bj][1];
                    u32x4 ho; ho.x = pk2(h0[0], h0[1]); ho.y = pk2(h0[2], h0[3]); ho.z = pk2(h1[0], h1[1]); ho.w = pk2(h1[2], h1[3]);
                    *(u32x4*)(hb + off + bj * 128) = ho;
                }
                sq += __shfl_xor(sq, 16, 64); sq += __shfl_xor(sq, 32, 64);
                if (fq == 0) ssq[(size_t)row * 16 + u.pn * 4 + wc] = sq;
            }
    }
};
struct EpiQ {
    static constexpr bool PERM = true, AFTER_DRAIN = false;
    bf16_t* O; const float* ssq; const float* biasq;
    __device__ __forceinline__ void operator()(const pg8::f32x4 (&acc)[2][2][4][2], const pg8::Unit& u, int wr, int wc, int fr, int fq) const {
        const int row0 = u.pm * 256 + wr * 64 + fr, col0 = u.pn * 256 + wc * 32 + 8 * fq;
        const float* bb = biasq + (size_t)((u.pm * 256) / SEQ) * 2048 + col0;
        pg8::f32x4 bv[2][2];
#pragma unroll
        for (int bj = 0; bj < 2; ++bj)
#pragma unroll
            for (int n = 0; n < 2; ++n) bv[bj][n] = *(const pg8::f32x4*)(bb + bj * 128 + 4 * n);
#pragma unroll
        for (int ai = 0; ai < 2; ++ai)
#pragma unroll
            for (int m = 0; m < 4; ++m) {
                const int row = row0 + ai * 128 + m * 16;
                const pg8::f32x4 s0 = *(const pg8::f32x4*)(ssq + (size_t)row * 16), s1 = *(const pg8::f32x4*)(ssq + (size_t)row * 16 + 4), s2 = *(const pg8::f32x4*)(ssq + (size_t)row * 16 + 8), s3 = *(const pg8::f32x4*)(ssq + (size_t)row * 16 + 12);
                const float tot = (((s0[0] + s0[1]) + (s0[2] + s0[3])) + ((s1[0] + s1[1]) + (s1[2] + s1[3]))) + (((s2[0] + s2[1]) + (s2[2] + s2[3])) + ((s3[0] + s3[1]) + (s3[2] + s3[3])));
                const float rs = rsqrtf(tot * (1.0f / D_MODEL) + 1e-6f);
                bf16_t* rowp = O + (size_t)row * 2048 + col0;
#pragma unroll
                for (int bj = 0; bj < 2; ++bj) {
                    const pg8::f32x4 v0 = acc[ai][bj][m][0] * rs + bv[bj][0], v1 = acc[ai][bj][m][1] * rs + bv[bj][1];
                    u32x4 w; w.x = pk2(v0[0], v0[1]); w.y = pk2(v0[2], v0[3]); w.z = pk2(v1[0], v1[1]); w.w = pk2(v1[2], v1[3]);
                    *(u32x4*)(rowp + bj * 128) = w;
                }
            }
    }
};

template <class Epi>
__device__ __forceinline__ void run_gemm(LAS unsigned char* lds, const bf16_t* A, const bf16_t* Bt, int M, int N, int K, const Epi& E, int wv) {
    pg8::StaticOrder S; S.init(M, N, (int)gridDim.x, (int)blockIdx.x);
    pg8::Gemm g; g.A = A; g.Bt = Bt; g.M = M; g.N = N; g.K = K;
    pg8::gemm_phase<Epi, pg8::StaticOrder, false>(lds, g, S, E, nullptr, wv);
}

typedef __amdgpu_buffer_rsrc_t rsrc_t;
struct G4 { u32x2 r[4]; };
__device__ __forceinline__ u32x2 bload8(rsrc_t r, int voff, int soff) { return __builtin_bit_cast(u32x2, __builtin_amdgcn_raw_buffer_load_b64(r, voff, soff, 0)); }
#define ROWB (D_MODEL / 2)
template <int G>
__device__ __forceinline__ void ex_issue(G4& R, rsrc_t rs, int e0, int e1, int voff, int emask = 0x3FFF) {
#pragma unroll
    for (int i = 0; i < 4; ++i) {
        const int e = __builtin_amdgcn_readlane(G < 16 ? e0 : e1, (4 * G + i) & 63) & emask;
        R.r[i] = bload8(rs, voff, e * ROWB);
    }
}
template <int CTRL, int ROWMASK = 0xF>
__device__ __forceinline__ int dpp_iadd(int x) { return x + __builtin_amdgcn_update_dpp(0, x, CTRL, ROWMASK, 0xF, false); }
__device__ __forceinline__ int wave_isum_l63(int v) {
    v = dpp_iadd<0xB1>(v); v = dpp_iadd<0x4E>(v); v = dpp_iadd<0x141>(v); v = dpp_iadd<0x140>(v); v = dpp_iadd<0x142, 0xA>(v); v = dpp_iadd<0x143, 0xC>(v);
    return v;
}
template <int G>
__device__ __forceinline__ void ex_passA(const G4& R, const int (&hq)[4], int hinit, int& KK0, int& KK1, int lane) {
    int a[4];
#pragma unroll
    for (int i = 0; i < 4; ++i) a[i] = hinit;
#pragma unroll
    for (int i = 0; i < 4; ++i) a[i] = __builtin_amdgcn_sdot4((int)(R.r[i][0] & 0x0F0F0F0Fu), hq[0], a[i], false);
#pragma unroll
    for (int i = 0; i < 4; ++i) a[i] = __builtin_amdgcn_sdot4((int)((R.r[i][0] >> 4) & 0x0F0F0F0Fu), hq[1], a[i], false);
#pragma unroll
    for (int i = 0; i < 4; ++i) a[i] = __builtin_amdgcn_sdot4((int)(R.r[i][1] & 0x0F0F0F0Fu), hq[2], a[i], false);
#pragma unroll
    for (int i = 0; i < 4; ++i) a[i] = __builtin_amdgcn_sdot4((int)((R.r[i][1] >> 4) & 0x0F0F0F0Fu), hq[3], a[i], false);
#pragma unroll
    for (int i = 0; i < 4; ++i) a[i] = dpp_iadd<0xB1>(a[i]);
#pragma unroll
    for (int i = 0; i < 4; ++i) a[i] = dpp_iadd<0x4E>(a[i]);
#pragma unroll
    for (int i = 0; i < 4; ++i) a[i] = dpp_iadd<0x141>(a[i]);
#pragma unroll
    for (int i = 0; i < 4; ++i) a[i] = dpp_iadd<0x140>(a[i]);
#pragma unroll
    for (int i = 0; i < 4; ++i) a[i] = dpp_iadd<0x142, 0xA>(a[i]);
#pragma unroll
    for (int i = 0; i < 4; ++i) a[i] = dpp_iadd<0x143, 0xC>(a[i]);
#pragma unroll
    for (int i = 0; i < 4; ++i) {
        const int tot = __builtin_amdgcn_readlane(a[i], 63);
        if (G < 16) KK0 = (lane == ((4 * G + i) & 63)) ? tot : KK0; else KK1 = (lane == ((4 * G + i) & 63)) ? tot : KK1;
    }
}
__device__ __forceinline__ void ex_passB(const G4& R, int cp, int (&yi)[16]) {
#pragma unroll
    for (int d = 0; d < 2; ++d) {
        const unsigned A = R.r[0][d], B = R.r[1][d], C = R.r[2][d], D = R.r[3][d];
        const unsigned ablo = __builtin_amdgcn_perm(B, A, 0x05010400u), abhi = __builtin_amdgcn_perm(B, A, 0x07030602u);
        const unsigned cdlo = __builtin_amdgcn_perm(D, C, 0x05010400u), cdhi = __builtin_amdgcn_perm(D, C, 0x07030602u);
        unsigned t[4];
        t[0] = __builtin_amdgcn_perm(cdlo, ablo, 0x05040100u); t[1] = __builtin_amdgcn_perm(cdlo, ablo, 0x07060302u);
        t[2] = __builtin_amdgcn_perm(cdhi, abhi, 0x05040100u); t[3] = __builtin_amdgcn_perm(cdhi, abhi, 0x07060302u);
#pragma unroll
        for (int b = 0; b < 4; ++b) {
            yi[8 * d + 2 * b] = __builtin_amdgcn_sdot4((int)(t[b] & 0x0F0F0F0Fu), cp, yi[8 * d + 2 * b], false);
            yi[8 * d + 2 * b + 1] = __builtin_amdgcn_sdot4((int)((t[b] >> 4) & 0x0F0F0F0Fu), cp, yi[8 * d + 2 * b + 1], false);
        }
    }
}
__device__ __forceinline__ float wave_max(float v) {
#pragma unroll
    for (int o = 32; o > 0; o >>= 1) v = fmaxf(v, __shfl_xor(v, o, 64));
    return v;
}
__device__ __forceinline__ int quad_pack(int ci) {
    const int b = ci & 0xFF;
    const int d0 = __builtin_amdgcn_update_dpp(0, b, 0x00, 0xF, 0xF, false), d1 = __builtin_amdgcn_update_dpp(0, b, 0x55, 0xF, 0xF, false);
    const int d2 = __builtin_amdgcn_update_dpp(0, b, 0xAA, 0xF, 0xF, false), d3 = __builtin_amdgcn_update_dpp(0, b, 0xFF, 0xF, 0xF, false);
    return d0 | (d1 << 8) | (d2 << 16) | (d3 << 24);
}

__device__ __forceinline__ void ex_finish(const Params& p, int l, const bool LAST, int t, const float (&y)[16], int lane_) {
    const int lane = launder(lane_);
    const int c0 = lane * 16;
    const float* mb = p.mod() + ((size_t)l * BATCH + t / SEQ) * MODW;
    float xv[16];
    {
        const u32x4 w0 = *(const u32x4*)(p.xb() + (size_t)t * D_MODEL + c0), w1 = *(const u32x4*)(p.xb() + (size_t)t * D_MODEL + c0 + 8);
#pragma unroll
        for (int e = 0; e < 4; ++e) { xv[2 * e] = bflo(w0[e]); xv[2 * e + 1] = bfhi(w0[e]); xv[8 + 2 * e] = bflo(w1[e]); xv[8 + 2 * e + 1] = bfhi(w1[e]); }
    }
#pragma unroll
    for (int q = 0; q < 4; ++q) {
        const f32x4 g2 = *(const f32x4*)(mb + 5 * D_MODEL + c0 + 4 * q);
#pragma unroll
        for (int e = 0; e < 4; ++e) xv[4 * q + e] += g2[e] * y[4 * q + e];
    }
    float ss2 = 0.f;
#pragma unroll
    for (int e = 0; e < 16; ++e) ss2 += xv[e] * xv[e];
    const float rs2 = rsqrtf(wave_sum(ss2) * (1.0f / D_MODEL) + 1e-6f);
    if (LAST) {
#pragma unroll
        for (int q = 0; q < 4; ++q) {
            const int col = c0 + 4 * q;
            const f32x4 gv = *(const f32x4*)(p.final_g + col);
            f32x4 o;
#pragma unroll
            for (int e = 0; e < 4; ++e) o[e] = xv[4 * q + e] * rs2 * gv[e];
            *(f32x4*)(p.out + (size_t)t * D_MODEL + col) = o;
        }
    } else {
        const float* mn = p.mod() + ((size_t)(l + 1) * BATCH + t / SEQ) * MODW;
        const float* n1g = p.norm1_g + (l + 1) * D_MODEL;
        unsigned xw[8];
#pragma unroll
        for (int e = 0; e < 8; ++e) { xw[e] = pk2(xv[2 * e], xv[2 * e + 1]); xv[2 * e] = bflo(xw[e]); xv[2 * e + 1] = bfhi(xw[e]); }
        *(u32x4*)(p.xb() + (size_t)t * D_MODEL + c0) = (u32x4){xw[0], xw[1], xw[2], xw[3]};
        *(u32x4*)(p.xb() + (size_t)t * D_MODEL + c0 + 8) = (u32x4){xw[4], xw[5], xw[6], xw[7]};
        float ssr = 0.f;
#pragma unroll
        for (int e = 0; e < 16; ++e) ssr += xv[e] * xv[e];
        const float rs3 = rsqrtf(wave_sum(ssr) * (1.0f / D_MODEL) + 1e-6f);
        unsigned hw[8];
#pragma unroll
        for (int q = 0; q < 4; ++q) {
            const int col = c0 + 4 * q;
            const f32x4 gv = *(const f32x4*)(n1g + col), scv = *(const f32x4*)(mn + 1 * D_MODEL + col), shv = *(const f32x4*)(mn + 0 * D_MODEL + col);
            float h[4];
#pragma unroll
            for (int e = 0; e < 4; ++e) h[e] = xv[4 * q + e] * rs3 * gv[e] * (1.0f + scv[e]) + shv[e];
            hw[2 * q] = pk2(h[0], h[1]); hw[2 * q + 1] = pk2(h[2], h[3]);
        }
        *(u32x4*)(p.hb() + (size_t)t * D_MODEL + c0) = (u32x4){hw[0], hw[1], hw[2], hw[3]};
        *(u32x4*)(p.hb() + (size_t)t * D_MODEL + c0 + 8) = (u32x4){hw[4], hw[5], hw[6], hw[7]};
    }
}


#define EXR 4
#define EXT (32 / EXR)
template <int S>
__device__ __forceinline__ void ex_turnA(G4 (&R)[EXR], const int (&hq)[4], int hinit, int& KK0, int& KK1, rsrc_t ru, rsrc_t rv, int e0, int e1, int voff, int lane, int emask) {
#define EX_A(s) ex_passA<EXR * S + s>(R[s], hq, hinit, KK0, KK1, lane); asm volatile("" ::: "memory"); if (S < EXT - 1) ex_issue<(EXR * S + s + EXR) & 31>(R[s], ru, e0, e1, voff, emask); else ex_issue<s>(R[s], rv, e0, e1, voff, emask); asm volatile("" ::: "memory");
    EX_A(0) EX_A(1)
#if EXR >= 4
    EX_A(2) EX_A(3)
#endif
#if EXR == 8
    EX_A(4) EX_A(5) EX_A(6) EX_A(7)
#endif
#undef EX_A
}
template <int S>
__device__ __forceinline__ void ex_turnB(G4 (&R)[EXR], int cpk0, int cpk1, int (&yi)[16], rsrc_t ru, rsrc_t rv, int e0, int e1, int e0n, int e1n, bool has_next, int voff, int emask) {
#define EX_B(s) ex_passB(R[s], __builtin_amdgcn_readlane((EXR * S + s) < 16 ? cpk0 : cpk1, (4 * (EXR * S + s)) & 63), yi); \
    asm volatile("" ::: "memory"); if (S < EXT - 1) ex_issue<(EXR * S + s + EXR) & 31>(R[s], rv, e0, e1, voff, emask); asm volatile("" ::: "memory");
    EX_B(0) EX_B(1)
#if EXR >= 4
    EX_B(2) EX_B(3)
#endif
#if EXR == 8
    EX_B(4) EX_B(5) EX_B(6) EX_B(7)
#endif
#undef EX_B
}

template <int S>
__device__ __forceinline__ void ex_allA(G4 (&R)[EXR], const int (&hq)[4], int hinit, int& KK0, int& KK1, rsrc_t ru, rsrc_t rv, int e0, int e1, int voff, int lane, int emask) {
    if constexpr (S < EXT) { ex_turnA<S>(R, hq, hinit, KK0, KK1, ru, rv, e0, e1, voff, lane, emask); ex_allA<S + 1>(R, hq, hinit, KK0, KK1, ru, rv, e0, e1, voff, lane, emask); }
}
template <int S>
__device__ __forceinline__ void ex_allB(G4 (&R)[EXR], int cpk0, int cpk1, int (&yi)[16], rsrc_t ru, rsrc_t rv, int e0, int e1, int e0n, int e1n, bool has_next, int voff, int emask) {
    if constexpr (S < EXT) { ex_turnB<S>(R, cpk0, cpk1, yi, ru, rv, e0, e1, e0n, e1n, has_next, voff, emask); ex_allB<S + 1>(R, cpk0, cpk1, yi, ru, rv, e0, e1, e0n, e1n, has_next, voff, emask); }
}
__device__ __forceinline__ void phase_expert(const Params& p, int l, const bool LAST, LAS unsigned char* lds, int wv, const int emask = 0x3FFF, const bool synth = false) {
    const int tid = tid_opaque(wv), wave = tid >> 6, lane = tid & 63;
    const rsrc_t ru = __builtin_amdgcn_make_buffer_rsrc((void*)(p.ub8() + (size_t)l * NEXP * ROWB), 0, NEXP * ROWB, 0x00020000);
    const rsrc_t rv = __builtin_amdgcn_make_buffer_rsrc((void*)(p.vb8() + (size_t)l * NEXP * ROWB), 0, NEXP * ROWB, 0x00020000);
    const float* uinv = p.uinv() + (size_t)l * NEXP;
    const float* vinv = p.vinv() + (size_t)l * NEXP;
    const int voff = lane * 8, c0 = lane * 16;
    const float* n2g = p.norm2_g + l * D_MODEL;
    const int tstep = gridDim.x * NWAVES;
    int t = blockIdx.x * NWAVES + wave;
    if (t >= NTOK) return;
    int e0 = p.eidx()[(size_t)t * 128 + lane], e1 = p.eidx()[(size_t)t * 128 + 64 + lane];
    for (; t < NTOK; t += tstep) {
        G4 R[EXR];
        ex_issue<0>(R[0], ru, e0, e1, voff, emask); ex_issue<1>(R[1], ru, e0, e1, voff, emask);
#if EXR >= 4
        ex_issue<2>(R[2], ru, e0, e1, voff, emask); ex_issue<3>(R[3], ru, e0, e1, voff, emask);
#endif
#if EXR == 8
        ex_issue<4>(R[4], ru, e0, e1, voff); ex_issue<5>(R[5], ru, e0, e1, voff); ex_issue<6>(R[6], ru, e0, e1, voff); ex_issue<7>(R[7], ru, e0, e1, voff);
#endif
        asm volatile("" ::: "memory");
        const bool has_next = (t + tstep) < NTOK;
        const int tn = has_next ? t + tstep : t;
        const int e0n = p.eidx()[(size_t)tn * 128 + lane], e1n = p.eidx()[(size_t)tn * 128 + 64 + lane];
        const float us0 = uinv[e0], us1 = uinv[e1];
        const float gv0 = p.egate()[(size_t)t * 128 + lane] * vinv[e0], gv1 = p.egate()[(size_t)t * 128 + 64 + lane] * vinv[e1];
        int hq[4]; float sh;
        {
            const float* mb = p.mod() + ((size_t)l * BATCH + t / SEQ) * MODW;
            const float* sp = p.ssq() + (size_t)t * 16;
            const f32x4 s0 = *(const f32x4*)sp, s1 = *(const f32x4*)(sp + 4), s2 = *(const f32x4*)(sp + 8), s3 = *(const f32x4*)(sp + 12);
            const float tot = (((s0[0] + s0[1]) + (s0[2] + s0[3])) + ((s1[0] + s1[1]) + (s1[2] + s1[3]))) + (((s2[0] + s2[1]) + (s2[2] + s2[3])) + ((s3[0] + s3[1]) + (s3[2] + s3[3])));
            const float rs = rsqrtf(tot * (1.0f / D_MODEL) + 1e-6f);
            const u32x4 w0 = *(const u32x4*)(p.hb() + (size_t)t * D_MODEL + c0), w1 = *(const u32x4*)(p.hb() + (size_t)t * D_MODEL + c0 + 8);
            float hv[16];
#pragma unroll
            for (int e = 0; e < 4; ++e) { hv[2 * e] = bflo(w0[e]); hv[2 * e + 1] = bfhi(w0[e]); hv[8 + 2 * e] = bflo(w1[e]); hv[8 + 2 * e + 1] = bfhi(w1[e]); }
            float hm = 0.f;
#pragma unroll
            for (int q = 0; q < 4; ++q) {
                const f32x4 shv = *(const f32x4*)(mb + 3 * D_MODEL + c0 + 4 * q);
#pragma unroll
                for (int e = 0; e < 4; ++e) { hv[4 * q + e] = hv[4 * q + e] * rs + shv[e]; hm = fmaxf(hm, fabsf(hv[4 * q + e])); }
            }
            hm = fmaxf(wave_max(hm), 1e-30f);
            const float qs = 127.0f / hm; sh = hm * (1.0f / 127.0f);
            int hb[16];
#pragma unroll
            for (int e = 0; e < 16; ++e) hb[e] = (int)rintf(hv[e] * qs);
#pragma unroll
            for (int j = 0; j < 4; ++j) {
                const int b0 = (j & 1) + 8 * (j >> 1);
                hq[j] = (hb[b0] & 0xFF) | ((hb[b0 + 2] & 0xFF) << 8) | ((hb[b0 + 4] & 0xFF) << 16) | (hb[b0 + 6] << 24);
            }
        }
        int hinit = 0;
#pragma unroll
        for (int j = 0; j < 4; ++j) hinit = __builtin_amdgcn_sdot4(hq[j], 0x01010101, hinit, false);
        hinit *= -8;
        int KK0 = 0, KK1 = 0;
        ex_allA<0>(R, hq, hinit, KK0, KK1, ru, rv, e0, e1, voff, lane, emask);
        const float cf0 = gelu_as((float)KK0 * (us0 * sh)) * gv0, cf1 = gelu_as((float)KK1 * (us1 * sh)) * gv1;
        const float cm = fmaxf(wave_max(fmaxf(fabsf(cf0), fabsf(cf1))), 1e-30f);
        const float cq = 127.0f / cm;
        const int cpk0 = quad_pack((int)rintf(cf0 * cq)), cpk1 = quad_pack((int)rintf(cf1 * cq));
        int yi[16];
#pragma unroll
        for (int e = 0; e < 16; ++e) yi[e] = 0;
        ex_allB<0>(R, cpk0, cpk1, yi, ru, rv, e0, e1, e0n, e1n, has_next, voff, emask);
        const int ci0s = (int)rintf(cf0 * cq) + (int)rintf(cf1 * cq);
        const int csum8 = 8 * __builtin_amdgcn_readlane(wave_isum_l63(ci0s), 63);
        float y[16];
        const float ys = cm * (1.0f / 127.0f);
#pragma unroll
        for (int j = 0; j < 4; ++j)
#pragma unroll
            for (int e = 0; e < 4; ++e) y[4 * j + e] = (float)(yi[4 * j + e] - csum8) * ys;
        if (synth) {
#pragma unroll
            for (int q = 0; q < 4; ++q) *(f32x4*)((float*)p.qb() + (size_t)t * D_MODEL + c0 + 4 * q) = (f32x4){y[4 * q], y[4 * q + 1], y[4 * q + 2], y[4 * q + 3]};
        } else ex_finish(p, l, LAST, t, y, lane);
        e0 = e0n; e1 = e1n;
    }
}
#if MK_MULTI
__global__ void __launch_bounds__(512, 2) k_expert(Params p, int l) {
    extern __shared__ __attribute__((aligned(16))) unsigned char smem_raw[];
    phase_expert(p, l, l == DEPTH - 1, (LAS unsigned char*)smem_raw, __builtin_amdgcn_readfirstlane((int)threadIdx.x >> 6));
}
#endif
typedef short s16x4 __attribute__((ext_vector_type(4)));
#define AT_KSTR 144
#define AT_VSTR 192
#define AT_KBUF 0
#define AT_VBUF 18432
#define AT_TBL  43008
#define AT_OEX  44032
#define AT_OSTR 272

__device__ __forceinline__ void phase_attn(const Params& p, int l, LAS unsigned char* lds, int wv) {
    const int tid = tid_opaque(wv), wave = tid >> 6, lane = tid & 63;
    const int w4 = wave & 3, m = wave >> 2, c = lane & 31, h = lane >> 5;
    const float LOG2E = 1.4426950408889634f;
    const float qscale = 0.17677669529663687f * LOG2E;
    float d01 = 0.f, d23 = 0.f;
    { const float* lp = p.diff_lambda + l * 128;
      for (int i = 0; i < 32; ++i) { d01 += lp[i] * lp[32 + i]; d23 += lp[64 + i] * lp[96 + i]; } }
    const float lam_init = p.lam_init[l];
    const float lam = expf(d01) - expf(d23) + lam_init;
    const float osc = 1.0f - lam_init;
    LAS float* tbl = (LAS float*)(lds + AT_TBL);
    const int skey = tid >> 3, sch = tid & 7;
    const int g16 = lane >> 4, li = lane & 15, tq = li >> 2, tp = li & 3;

    for (int u = blockIdx.x; u < 256; u += gridDim.x) {
        const int pi = u & 7, hd = (u >> 3) & 3, b = u >> 5;
        if (tid < 256) { const int bk = tid < 128 ? (int)kBucket[tid] : 31; tbl[tid] = p.rel_bias[bk * 4 + hd] * LOG2E; }
        const float c31 = p.rel_bias[31 * 4 + hd] * LOG2E;
        const bf16_t* pbase = p.pb() + (size_t)b * SEQ * MIX_IN;
        const bf16_t* kg = pbase + (size_t)skey * MIX_IN + 256 + hd * 64 + sch * 8;
        const bf16_t* vg = pbase + (size_t)skey * MIX_IN + 512 + hd * 64 + sch * 8;
        for (int half = 0; half < 2; ++half) {
            const int qb = half ? 15 - pi : pi;
            const int q0w = qb * 128 + 32 * w4, nkt = 2 * qb + 2;
            const int qpos = q0w + c;
            bf16x8 qf0, qf1;
            { const bf16_t* qp = pbase + (size_t)qpos * MIX_IN + hd * 64 + m * 32 + 8 * h; qf0 = *(const bf16x8*)qp; qf1 = *(const bf16x8*)(qp + 16); }
            f32x16 O0, O1;
#pragma unroll
            for (int r = 0; r < 16; ++r) { O0[r] = 0.f; O1[r] = 0.f; }
            float mrun = -1e30f, lrun = 0.f;
            u32x4 kreg = *(const u32x4*)kg, vreg = *(const u32x4*)vg;
            *(LAS u32x4*)(lds + AT_KBUF + skey * AT_KSTR + sch * 16) = kreg;
            *(LAS u32x4*)(lds + AT_VBUF + skey * AT_VSTR + sch * 16) = vreg;
            __syncthreads();
            for (int kt = 0; kt < nkt; ++kt) {
                const int k0 = kt * 64, cur = kt & 1;
                if (kt + 1 < nkt) { kreg = *(const u32x4*)(kg + (size_t)(k0 + 64) * MIX_IN); vreg = *(const u32x4*)(vg + (size_t)(k0 + 64) * MIX_IN); }
                if (k0 <= q0w + 31) {
                    LAS unsigned char* kb_ = lds + AT_KBUF + cur * (64 * AT_KSTR);
                    LAS unsigned char* vb_ = lds + AT_VBUF + cur * (64 * AT_VSTR);
                    f32x16 s0, s1;
#pragma unroll
                    for (int r = 0; r < 16; ++r) { s0[r] = 0.f; s1[r] = 0.f; }
                    {
                        const LAS unsigned char* ka = kb_ + c * AT_KSTR + m * 64 + h * 16;
                        const bf16x8 a00 = *(const LAS bf16x8*)ka, a01 = *(const LAS bf16x8*)(ka + 32);
                        const bf16x8 a10 = *(const LAS bf16x8*)(ka + 32 * AT_KSTR), a11 = *(const LAS bf16x8*)(ka + 32 * AT_KSTR + 32);
                        s0 = __builtin_amdgcn_mfma_f32_32x32x16_bf16(a00, qf0, s0, 0, 0, 0);
                        s0 = __builtin_amdgcn_mfma_f32_32x32x16_bf16(a01, qf1, s0, 0, 0, 0);
                        s1 = __builtin_amdgcn_mfma_f32_32x32x16_bf16(a10, qf0, s1, 0, 0, 0);
                        s1 = __builtin_amdgcn_mfma_f32_32x32x16_bf16(a11, qf1, s1, 0, 0, 0);
                    }
                    const bool far = (q0w - (k0 + 63)) >= 113;
                    if (far) {
#pragma unroll
                        for (int r = 0; r < 16; ++r) { s0[r] = s0[r] * qscale + c31; s1[r] = s1[r] * qscale + c31; }
                    } else {
                        const int dbase = qpos - k0 - 4 * h;
#pragma unroll
                        for (int r = 0; r < 16; ++r) {
                            const int d0 = dbase - ((r & 3) + 8 * (r >> 2)), d1 = d0 - 32;
                            const float b0 = tbl[min(max(d0, 0), 255)], b1 = tbl[min(max(d1, 0), 255)];
                            const float v0 = s0[r] * qscale + b0, v1 = s1[r] * qscale + b1;
                            s0[r] = d0 < 0 ? -1e30f : v0; s1[r] = d1 < 0 ? -1e30f : v1;
                        }
                    }
                    float tmax = fmaxf(s0[0], s1[0]);
#pragma unroll
                    for (int r = 1; r < 16; ++r) tmax = fmaxf(tmax, fmaxf(s0[r], s1[r]));
                    tmax = fmaxf(tmax, __shfl_xor(tmax, 32, 64));
                    const float mnew = fmaxf(mrun, tmax);
                    const float alpha = __builtin_amdgcn_exp2f(mrun - mnew);
                    mrun = mnew;
                    float psum = 0.f;
#pragma unroll
                    for (int r = 0; r < 16; ++r) { s0[r] = __builtin_amdgcn_exp2f(s0[r] - mnew); s1[r] = __builtin_amdgcn_exp2f(s1[r] - mnew); psum += s0[r] + s1[r]; }
                    lrun = lrun * alpha + psum;
#pragma unroll
                    for (int r = 0; r < 16; ++r) { O0[r] *= alpha; O1[r] *= alpha; }
#pragma unroll
                    for (int kb = 0; kb < 2; ++kb)
#pragma unroll
                        for (int sp = 0; sp < 2; ++sp) {
                            u32x4 pw;
                            if (kb == 0) { pw.x = pk2(s0[8 * sp + 0], s0[8 * sp + 1]); pw.y = pk2(s0[8 * sp + 2], s0[8 * sp + 3]); pw.z = pk2(s0[8 * sp + 4], s0[8 * sp + 5]); pw.w = pk2(s0[8 * sp + 6], s0[8 * sp + 7]); }
                            else         { pw.x = pk2(s1[8 * sp + 0], s1[8 * sp + 1]); pw.y = pk2(s1[8 * sp + 2], s1[8 * sp + 3]); pw.z = pk2(s1[8 * sp + 4], s1[8 * sp + 5]); pw.w = pk2(s1[8 * sp + 6], s1[8 * sp + 7]); }
                            const bf16x8 pf = __builtin_bit_cast(bf16x8, pw);
                            const int kA = 32 * kb + 16 * sp + 4 * h;
#pragma unroll
                            for (int mb = 0; mb < 2; ++mb) {
                                LAS unsigned char* va = vb_ + (kA + tq) * AT_VSTR + (32 * mb + 16 * (g16 & 1) + 4 * tp) * 2;
                                const s16x4 t0 = __builtin_amdgcn_ds_read_tr16_b64_v4i16((LAS s16x4*)va);
                                const s16x4 t1 = __builtin_amdgcn_ds_read_tr16_b64_v4i16((LAS s16x4*)(va + 8 * AT_VSTR));
                                const bf16x8 vf = {t0[0], t0[1], t0[2], t0[3], t1[0], t1[1], t1[2], t1[3]};
                                if (mb == 0) O0 = __builtin_amdgcn_mfma_f32_32x32x16_bf16(vf, pf, O0, 0, 0, 0);
                                else         O1 = __builtin_amdgcn_mfma_f32_32x32x16_bf16(vf, pf, O1, 0, 0, 0);
                            }
                        }
                }
                if (kt + 1 < nkt) {
                    *(LAS u32x4*)(lds + AT_KBUF + (cur ^ 1) * (64 * AT_KSTR) + skey * AT_KSTR + sch * 16) = kreg;
                    *(LAS u32x4*)(lds + AT_VBUF + (cur ^ 1) * (64 * AT_VSTR) + skey * AT_VSTR + sch * 16) = vreg;
                }
                __syncthreads();
            }
            const float inv = 1.0f / (lrun + __shfl_xor(lrun, 32, 64));
            LAS unsigned char* oex = lds + AT_OEX + (32 * w4 + c) * AT_OSTR + 16 * h;
            if (m == 1) {
#pragma unroll
                for (int r4 = 0; r4 < 4; ++r4) {
                    f32x4 a, bq;
#pragma unroll
                    for (int e = 0; e < 4; ++e) { a[e] = O0[4 * r4 + e] * inv; bq[e] = O1[4 * r4 + e] * inv; }
                    *(LAS f32x4*)(oex + (8 * r4) * 4) = a;
                    *(LAS f32x4*)(oex + (32 + 8 * r4) * 4) = bq;
                }
            }
            __syncthreads();
            if (m == 0) {
                float ss = 0.f;
#pragma unroll
                for (int r4 = 0; r4 < 4; ++r4) {
                    const f32x4 a = *(const LAS f32x4*)(oex + (8 * r4) * 4), bq = *(const LAS f32x4*)(oex + (32 + 8 * r4) * 4);
#pragma unroll
                    for (int e = 0; e < 4; ++e) {
                        O0[4 * r4 + e] = O0[4 * r4 + e] * inv - lam * a[e]; O1[4 * r4 + e] = O1[4 * r4 + e] * inv - lam * bq[e];
                        ss += O0[4 * r4 + e] * O0[4 * r4 + e] + O1[4 * r4 + e] * O1[4 * r4 + e];
                    }
                }
                ss += __shfl_xor(ss, 32, 64);
                const float rstd = rsqrtf(ss * (1.0f / 64.0f) + 1e-6f) * osc;
                bf16_t* orow = p.cat() + (size_t)(b * SEQ + qpos) * D_MODEL + hd * 64 + 4 * h;
                const float* sg = p.subln_g + l * 64 + 4 * h;
#pragma unroll
                for (int r4 = 0; r4 < 4; ++r4) {
                    const f32x4 ga = *(const f32x4*)(sg + 8 * r4), gb = *(const f32x4*)(sg + 32 + 8 * r4);
                    u32x2 oa, ob;
                    oa.x = pk2(O0[4 * r4 + 0] * rstd * ga[0], O0[4 * r4 + 1] * rstd * ga[1]); oa.y = pk2(O0[4 * r4 + 2] * rstd * ga[2], O0[4 * r4 + 3] * rstd * ga[3]);
                    ob.x = pk2(O1[4 * r4 + 0] * rstd * gb[0], O1[4 * r4 + 1] * rstd * gb[1]); ob.y = pk2(O1[4 * r4 + 2] * rstd * gb[2], O1[4 * r4 + 3] * rstd * gb[3]);
                    *(u32x2*)(orow + 8 * r4) = oa;
                    *(u32x2*)(orow + 32 + 8 * r4) = ob;
                }
            }
            __syncthreads();
        }
    }
}
#if MK_MULTI
template <int DUMMY>
__global__ void __launch_bounds__(512, 2) k_attn2(Params p, int l) {
    extern __shared__ __attribute__((aligned(16))) unsigned char smem_raw[];
    phase_attn(p, l, (LAS unsigned char*)smem_raw, __builtin_amdgcn_readfirstlane((int)threadIdx.x >> 6));
}
#endif
#define MR_VSTR 272

__device__ __forceinline__ void mixrest_conv(const Params& p, int l, int chunk, LAS unsigned char* lds, int wv) {
    const int tid = tid_opaque(wv), wave = tid >> 6, lane = tid & 63;
    const int t0 = chunk * 128, s0 = t0 % SEQ;
    LAS float* glu = (LAS float*)lds;
    const int c = tid & 255, th = tid >> 8;
    float w[31];
#pragma unroll
    for (int j = 0; j < 31; ++j) w[j] = p.conf_dw[((size_t)l * 31 + j) * 256 + c];
    for (int hf = 0; hf < 2; ++hf) {
        const int tb = t0 + hf * 64;
        for (int it = tid; it < 94 * 32; it += 512) {
            const int i = it >> 5, c8 = (it & 31) * 8;
            const int sp = s0 + hf * 64 - 30 + i;
            f32x4 o0 = {0.f, 0.f, 0.f, 0.f}, o1 = {0.f, 0.f, 0.f, 0.f};
            if (sp >= 0) {
                const bf16_t* pr = p.pb() + (size_t)(tb - 30 + i) * MIX_IN;
                const u32x4 a = *(const u32x4*)(pr + 3 * 256 + c8), g = *(const u32x4*)(pr + 4 * 256 + c8);
                o0[0] = bflo(a.x) * sigmoidf_(bflo(g.x)); o0[1] = bfhi(a.x) * sigmoidf_(bfhi(g.x));
                o0[2] = bflo(a.y) * sigmoidf_(bflo(g.y)); o0[3] = bfhi(a.y) * sigmoidf_(bfhi(g.y));
                o1[0] = bflo(a.z) * sigmoidf_(bflo(g.z)); o1[1] = bfhi(a.z) * sigmoidf_(bfhi(g.z));
                o1[2] = bflo(a.w) * sigmoidf_(bflo(g.w)); o1[3] = bfhi(a.w) * sigmoidf_(bfhi(g.w));
            }
            *(LAS f32x4*)(glu + i * 256 + c8) = o0; *(LAS f32x4*)(glu + i * 256 + c8 + 4) = o1;
        }
        __syncthreads();
        float acc[32];
#pragma unroll
        for (int o = 0; o < 32; ++o) acc[o] = 0.f;
#pragma unroll
        for (int i = 0; i < 62; ++i) {
            const float xval = glu[(th * 32 + i) * 256 + c];
#pragma unroll
            for (int o = 0; o < 32; ++o) if (i - o >= 0 && i - o <= 30) acc[o] += w[i - o] * xval;
        }
        __syncthreads();
#pragma unroll
        for (int o = 0; o < 32; ++o) glu[(th * 32 + o) * 256 + c] = acc[o];
        __syncthreads();
        const f32x4 lg = *(const f32x4*)(p.conf_ln_g + l * 256 + lane * 4), lb = *(const f32x4*)(p.conf_ln_b + l * 256 + lane * 4);
        for (int k = 0; k < 8; ++k) {
            const int tk = wave * 8 + k;
            const f32x4 z = *(const LAS f32x4*)(glu + tk * 256 + lane * 4);
            const float mu = wave_sum(z[0] + z[1] + z[2] + z[3]) * (1.0f / 256.0f);
            f32x4 dz; float sq = 0.f;
#pragma unroll
            for (int e = 0; e < 4; ++e) { dz[e] = z[e] - mu; sq += dz[e] * dz[e]; }
            const float rstd = rsqrtf(wave_sum(sq) * (1.0f / 256.0f) + 1e-6f);
            float y[4];
#pragma unroll
            for (int e = 0; e < 4; ++e) { const float v = dz[e] * rstd * lg[e] + lb[e]; y[e] = v * sigmoidf_(v); }
            u32x2 o; o.x = pk2(y[0], y[1]); o.y = pk2(y[2], y[3]);
            *(u32x2*)(p.cat() + (size_t)(tb + tk) * D_MODEL + 256 + lane * 4) = o;
        }
        __syncthreads();
    }
}

__device__ __forceinline__ void mixrest_sgu(const Params& p, int l, int chunk, LAS unsigned char* lds, int wv) {
    const int tid = tid_opaque(wv), wave = tid >> 6, lane = tid & 63;
    const int t0 = chunk * 128, s0 = t0 % SEQ;
    {
        const float* sw = p.sconv_w + (size_t)l * 3 * 256;
        for (int it = tid; it < 128 * 32; it += 512) {
            const int tt = it >> 5, c8 = (it & 31) * 8;
            const bf16_t* pr = p.pb() + (size_t)(t0 + tt) * MIX_IN;
            float z[8];
#pragma unroll
            for (int e = 0; e < 8; ++e) z[e] = 0.f;
#pragma unroll
            for (int j = 0; j < 3; ++j) {
                if (s0 + tt - 2 + j >= 0) {
                    const bf16_t* q = pr + (ptrdiff_t)(j - 2) * MIX_IN;
                    const u32x4 a = *(const u32x4*)(q + 6 * 256 + c8), bq = *(const u32x4*)(q + 7 * 256 + c8);
                    const f32x4 w0 = *(const f32x4*)(sw + j * 256 + c8), w1 = *(const f32x4*)(sw + j * 256 + c8 + 4);
                    z[0] += w0[0] * bflo(a.x) * bflo(bq.x); z[1] += w0[1] * bfhi(a.x) * bfhi(bq.x);
                    z[2] += w0[2] * bflo(a.y) * bflo(bq.y); z[3] += w0[3] * bfhi(a.y) * bfhi(bq.y);
                    z[4] += w1[0] * bflo(a.z) * bflo(bq.z); z[5] += w1[1] * bfhi(a.z) * bfhi(bq.z);
                    z[6] += w1[2] * bflo(a.w) * bflo(bq.w); z[7] += w1[3] * bfhi(a.w) * bfhi(bq.w);
                }
            }
            const u32x4 cb = *(const u32x4*)(pr + 5 * 256 + c8);
            u32x4 o;
            o.x = pk2(bflo(cb.x) * z[0], bfhi(cb.x) * z[1]); o.y = pk2(bflo(cb.y) * z[2], bfhi(cb.y) * z[3]);
            o.z = pk2(bflo(cb.z) * z[4], bfhi(cb.z) * z[5]); o.w = pk2(bflo(cb.w) * z[6], bfhi(cb.w) * z[7]);
            *(u32x4*)(p.cat() + (size_t)(t0 + tt) * D_MODEL + 512 + c8) = o;
        }
    }
    {
        const f32x4 lg = *(const f32x4*)(p.sgu_ln_g + l * 256 + lane * 4), lb = *(const f32x4*)(p.sgu_ln_b + l * 256 + lane * 4);
        for (int k = 0; k < 16; ++k) {
            const int s = wave * 16 + k;
            const u32x2 raw = *(const u32x2*)(p.pb() + (size_t)(t0 + s) * MIX_IN + 9 * 256 + lane * 4);
            float v[4] = {gelu_as(bflo(raw.x)), gelu_as(bfhi(raw.x)), gelu_as(bflo(raw.y)), gelu_as(bfhi(raw.y))};
            const float mu = wave_sum(v[0] + v[1] + v[2] + v[3]) * (1.0f / 256.0f);
            float sq = 0.f;
#pragma unroll
            for (int e = 0; e < 4; ++e) { v[e] -= mu; sq += v[e] * v[e]; }
            const float rstd = rsqrtf(wave_sum(sq) * (1.0f / 256.0f) + 1e-6f);
#pragma unroll
            for (int e = 0; e < 4; ++e) *(LAS bf16_t*)(lds + (lane * 4 + e) * MR_VSTR + s * 2) = f2bf(v[e] * rstd * lg[e] + lb[e]);
        }
    }
    __syncthreads();
    {
        const int hq = wave & 3, mb = wave >> 2, c = lane & 31, hh = lane >> 5;
        bf16x8 af[8];
#pragma unroll
        for (int ks = 0; ks < 8; ++ks) af[ks] = *(const LAS bf16x8*)(lds + (hq * 64 + mb * 32 + c) * MR_VSTR + (16 * ks + 8 * hh) * 2);
        const bf16_t* wb = p.sguwb() + ((size_t)(l * 4 + hq) * 128) * 128;
        f32x16 acc[4];
#pragma unroll
        for (int nb = 0; nb < 4; ++nb) {
#pragma unroll
            for (int r = 0; r < 16; ++r) acc[nb][r] = 0.f;
#pragma unroll
            for (int ks = 0; ks < 2 * nb + 2; ++ks) {
                const bf16x8 bfrag = *(const bf16x8*)(wb + (size_t)(32 * nb + c) * 128 + 16 * ks + 8 * hh);
                acc[nb] = __builtin_amdgcn_mfma_f32_32x32x16_bf16(af[ks], bfrag, acc[nb], 0, 0, 0);
            }
        }
        const float* bs = p.sgu_b + (size_t)(l * 4 + hq) * 128;
#pragma unroll
        for (int nb = 0; nb < 4; ++nb) {
            const int tt = 32 * nb + c;
            const float bias = bs[tt];
            const bf16_t* su = p.pb() + (size_t)(t0 + tt) * MIX_IN + 8 * 256 + hq * 64 + mb * 32 + 4 * hh;
            bf16_t* orow = p.cat() + (size_t)(t0 + tt) * D_MODEL + 768 + hq * 64 + mb * 32 + 4 * hh;
#pragma unroll
            for (int r4 = 0; r4 < 4; ++r4) {
                const u32x2 raw = *(const u32x2*)(su + 8 * r4);
                u32x2 o;
                o.x = pk2(gelu_as(bflo(raw.x)) * (acc[nb][4 * r4 + 0] + bias), gelu_as(bfhi(raw.x)) * (acc[nb][4 * r4 + 1] + bias));
                o.y = pk2(gelu_as(bflo(raw.y)) * (acc[nb][4 * r4 + 2] + bias), gelu_as(bfhi(raw.y)) * (acc[nb][4 * r4 + 3] + bias));
                *(u32x2*)(orow + 8 * r4) = o;
            }
        }
    }
    __syncthreads();
}

__device__ __forceinline__ void phase_mixrest(const Params& p, int l, LAS unsigned char* lds, int wv) {
    for (int u = blockIdx.x; u < 256; u += gridDim.x) {
        const int chunk = u >> 1;
        if (u & 1) mixrest_sgu(p, l, chunk, lds, wv); else mixrest_conv(p, l, chunk, lds, wv);
    }
}
#if MK_MULTI
template <int DUMMY>
__global__ void __launch_bounds__(512, 2) k_mixrest(Params p, int l) {
    extern __shared__ __attribute__((aligned(16))) unsigned char smem_raw[];
    phase_mixrest(p, l, (LAS unsigned char*)smem_raw, __builtin_amdgcn_readfirstlane((int)threadIdx.x >> 6));
}
#endif
__device__ __forceinline__ int f2sortable(float f) { const int x = __float_as_int(f); return x ^ ((x >> 31) & 0x7FFFFFFF); }
__device__ __forceinline__ float sortable2f(int s) { return __int_as_float(s ^ ((s >> 31) & 0x7FFFFFFF)); }

template <int N>
__device__ __forceinline__ void bitonic_sort_desc(int (&a)[N]) {
#pragma unroll
    for (int k = 2; k <= N; k <<= 1)
#pragma unroll
        for (int j = k >> 1; j > 0; j >>= 1)
#pragma unroll
            for (int i = 0; i < N; ++i) {
                const int q = i ^ j;
                if (q > i) {
                    const int hi = max(a[i], a[q]), lo = min(a[i], a[q]);
                    if ((i & k) == 0 || k == N) { a[i] = hi; a[q] = lo; } else { a[i] = lo; a[q] = hi; }
                }
            }
}
__device__ __forceinline__ void bitonic_merge_desc16(int (&a)[16]) {
#pragma unroll
    for (int j = 8; j > 0; j >>= 1)
#pragma unroll
        for (int i = 0; i < 16; ++i) {
            const int q = i ^ j;
            if (q > i) { const int hi = max(a[i], a[q]), lo = min(a[i], a[q]); a[i] = hi; a[q] = lo; }
        }
}
__device__ __forceinline__ void merge_top16(int (&a)[16], const int (&b)[16]) {
#pragma unroll
    for (int i = 0; i < 16; ++i) a[i] = max(a[i], b[15 - i]);
    bitonic_merge_desc16(a);
}

#define TK_KEYS 8192
#define TK_KSTR 272
template <bool TO_LDS>
__device__ __forceinline__ void topk_unit(const Params& p, int l, int u, int hd, LAS unsigned char* lds, int wave, int lane, LAS int* le, LAS float* lg) {
    const int c = lane & 31, hh = lane >> 5;
    LAS unsigned char* ilist = lds + wave * 1024 + c * 32;
    const int hx = hh << 2;
    const __amdgpu_buffer_rsrc_t rq = __builtin_amdgcn_make_buffer_rsrc((void*)p.qb(), 0, NTOK * 2048 * 2, 0x00020000);
    const int qvoff = c * 4096 + hh * 16;
    {
        const int t = u * 32 + c;
        int S0[16], S1[16];
#pragma unroll
        for (int pp = 0; pp < 2; ++pp) {
            bf16x8 qf[8];
            {
                const int qso = (u * 32) * 4096 + hd * 512 + pp * 256;
#pragma unroll
                for (int ks = 0; ks < 8; ++ks) qf[ks] = __builtin_bit_cast(bf16x8, __builtin_amdgcn_raw_buffer_load_b128(rq, qvoff + 32 * ks, qso, 0));
            }
            const LAS unsigned char* kl = lds + TK_KEYS + (pp * 128 + c) * TK_KSTR + hh * 16;
            int K0[16], K1[16], K2[16], K3[16];
#pragma unroll
            for (int kb = 0; kb < 4; ++kb) {
                asm volatile("" ::: "memory");
                f32x16 acc;
#pragma unroll
                for (int r = 0; r < 16; ++r) acc[r] = 0.f;
#pragma unroll
                for (int ks = 0; ks < 8; ++ks) {
                    const bf16x8 a = *(const LAS bf16x8*)(kl + (32 * kb) * TK_KSTR + 32 * ks);
                    acc = __builtin_amdgcn_mfma_f32_32x32x16_bf16(a, qf[ks], acc, 0, 0, 0);
                }
#pragma unroll
                for (int r = 0; r < 16; ++r) {
                    const int nconst = 32 * kb + (r & 3) + 8 * (r >> 2);
                    const int key = (f2sortable(acc[r]) & ~0x7F) | (127 - nconst);
                    if (kb == 0) K0[r] = key; else if (kb == 1) K1[r] = key; else if (kb == 2) K2[r] = key; else K3[r] = key;
                }
            }
            bitonic_sort_desc<16>(K0); bitonic_sort_desc<16>(K1); bitonic_sort_desc<16>(K2); bitonic_sort_desc<16>(K3);
            merge_top16(K0, K1); merge_top16(K2, K3); merge_top16(K0, K2);
            int P[16];
#pragma unroll
            for (int i = 0; i < 16; ++i) { K0[i] ^= hx; P[i] = __shfl_xor(K0[i], 32, 64); }
            merge_top16(K0, P);
#pragma unroll
            for (int i = 0; i < 16; ++i) { if (pp == 0) S0[i] = K0[i]; else S1[i] = K0[i]; }
        }
        {
            unsigned w4[4];
#pragma unroll
            for (int q = 0; q < 4; ++q) {
                unsigned w = 0;
#pragma unroll
                for (int e = 0; e < 4; ++e) { const int sv = hh ? S1[4 * q + e] : S0[4 * q + e]; w |= (unsigned)(127 - (sv & 127)) << (8 * e); }
                w4[q] = w;
            }
            u32x4 wv; wv.x = w4[0]; wv.y = w4[1]; wv.z = w4[2]; wv.w = w4[3];
            *(LAS u32x4*)(ilist + 16 * hh) = wv;
        }
        float a[16], b[16];
#pragma unroll
        for (int i = 0; i < 16; ++i) {
            const float f1 = sortable2f(S0[i] & ~0x7F), f2 = sortable2f(S1[i] & ~0x7F);
            a[i] = hh ? f2 : f1; b[i] = hh ? f1 : f2;
        }
        int CA[16], CB[16];
        const int org = hh << 8;
        {
            int n = 0;
#pragma unroll
            for (int i = 0; i < 4; ++i)
#pragma unroll
                for (int j = i; j < 16; ++j) {
                    if ((i + 1) * (j + 1) <= 16) {
                        int key = (f2sortable(a[i] + b[j]) & ~0x1FF) | org | (i * 16 + j);
                        if (i == j) key = hh ? (int)0x80000000 : key;
                        if (n < 16) CA[n] = key; else CB[n - 16] = key;
                        ++n;
                    }
                }
#pragma unroll
            for (int q = 27; q < 32; ++q) CB[q - 16] = (int)0x80000000;
        }
        bitonic_sort_desc<16>(CA); bitonic_sort_desc<16>(CB);
        merge_top16(CA, CB);
        int F[16], PF[16];
#pragma unroll
        for (int i = 0; i < 16; ++i) PF[i] = __shfl_xor(CA[i], 32, 64);
#pragma unroll
        for (int i = 0; i < 16; ++i) F[i] = max(CA[i], PF[15 - i]);
        int mxk = F[0];
#pragma unroll
        for (int i = 1; i < 16; ++i) mxk = max(mxk, F[i]);
        const float vmax = sortable2f(mxk & ~0x1FF);
        float e[8], psum = 0.f;
#pragma unroll
        for (int i = 0; i < 8; ++i) { e[i] = __expf(sortable2f(F[i] & ~0x1FF) - vmax); psum += e[i]; }
        const float inv = 1.0f / (psum + __shfl_xor(psum, 32, 64));
        asm volatile("s_waitcnt lgkmcnt(0)" ::: "memory");
        int ex[8];
#pragma unroll
        for (int i = 0; i < 8; ++i) {
            const int low = F[i] & 0x1FF, o = low >> 8, il = (low >> 4) & 15, jl = low & 15;
            const int ri = o ? jl : il, rj = o ? il : jl;
            const int i1 = (int)*(const LAS unsigned char*)(ilist + ri), i2 = (int)*(const LAS unsigned char*)(ilist + 16 + rj);
            ex[i] = i1 * 128 + i2;
        }
        if (TO_LDS) {
            LAS int* ep = le + (c * 8 + hd) * 16 + hh * 8;
            LAS float* gp = lg + (c * 8 + hd) * 16 + hh * 8;
            *(LAS u32x4*)ep = (u32x4){(unsigned)ex[0], (unsigned)ex[1], (unsigned)ex[2], (unsigned)ex[3]};
            *(LAS u32x4*)(ep + 4) = (u32x4){(unsigned)ex[4], (unsigned)ex[5], (unsigned)ex[6], (unsigned)ex[7]};
            *(LAS f32x4*)gp = (f32x4){e[0] * inv, e[1] * inv, e[2] * inv, e[3] * inv};
            *(LAS f32x4*)(gp + 4) = (f32x4){e[4] * inv, e[5] * inv, e[6] * inv, e[7] * inv};
        } else {
            int* ep = p.eidx() + ((size_t)t * 8 + hd) * 16 + hh * 8;
            float* gp = p.egate() + ((size_t)t * 8 + hd) * 16 + hh * 8;
            *(u32x4*)ep = (u32x4){(unsigned)ex[0], (unsigned)ex[1], (unsigned)ex[2], (unsigned)ex[3]};
            *(u32x4*)(ep + 4) = (u32x4){(unsigned)ex[4], (unsigned)ex[5], (unsigned)ex[6], (unsigned)ex[7]};
            *(f32x4*)gp = (f32x4){e[0] * inv, e[1] * inv, e[2] * inv, e[3] * inv};
            *(f32x4*)(gp + 4) = (f32x4){e[4] * inv, e[5] * inv, e[6] * inv, e[7] * inv};
        }
        asm volatile("s_waitcnt lgkmcnt(0)" ::: "memory");
    }
}
__device__ __forceinline__ void phase_topk(const Params& p, int l, LAS unsigned char* lds, int wv) {
    const int tid = tid_opaque(wv), wave = __builtin_amdgcn_readfirstlane(tid >> 6), lane = tid & 63;
    int cur_hd = -1;
    for (int u = blockIdx.x; u < 8 * (NTOK / 256); u += gridDim.x) {
        const int hd = u & 7, tg = u >> 3;
        if (hd != cur_hd) {
            __syncthreads();
            const bf16_t* kg = p.keysb() + ((size_t)(l * 8 + hd) * 2) * 128 * 128;
            for (int i = tid; i < 2 * 128 * 16; i += 512) {
                const u32x4 v = *(const u32x4*)(kg + (size_t)(i >> 4) * 128 + (i & 15) * 8);
                *(LAS u32x4*)(lds + TK_KEYS + (i >> 4) * TK_KSTR + (i & 15) * 16) = v;
            }
            __syncthreads();
            cur_hd = hd;
        }
        topk_unit<false>(p, l, tg * 8 + wave, hd, lds, wave, lane, nullptr, nullptr);
    }
}
#if MK_MULTI
template <int DUMMY>
__global__ void __launch_bounds__(512, 2) k_topk(Params p, int l) {
    extern __shared__ __attribute__((aligned(16))) unsigned char smem_raw[];
    phase_topk(p, l, (LAS unsigned char*)smem_raw, __builtin_amdgcn_readfirstlane((int)threadIdx.x >> 6));
}
#endif
#if PROBE_UB
__device__ __forceinline__ void ubench(int iters, unsigned seed) {
    float r[16]; f32x2 r2[8];
#pragma unroll
    for (int i = 0; i < 16; ++i) r[i] = __uint_as_float(seed + i);
#pragma unroll
    for (int i = 0; i < 8; ++i) r2[i] = (f32x2){r[2 * i], r[2 * i + 1]};
    float a = __uint_as_float(seed * 3u + 1u), b = __uint_as_float(seed * 5u + 7u);
    for (int it = 0; it < iters; ++it) {
#if PROBE_UB == 1
        asm volatile("v_fma_f32 %0, %16, %17, %0\n\tv_fma_f32 %1, %16, %17, %1\n\tv_fma_f32 %2, %16, %17, %2\n\tv_fma_f32 %3, %16, %17, %3\n\tv_fma_f32 %4, %16, %17, %4\n\tv_fma_f32 %5, %16, %17, %5\n\tv_fma_f32 %6, %16, %17, %6\n\tv_fma_f32 %7, %16, %17, %7\n\tv_fma_f32 %8, %16, %17, %8\n\tv_fma_f32 %9, %16, %17, %9\n\tv_fma_f32 %10, %16, %17, %10\n\tv_fma_f32 %11, %16, %17, %11\n\tv_fma_f32 %12, %16, %17, %12\n\tv_fma_f32 %13, %16, %17, %13\n\tv_fma_f32 %14, %16, %17, %14\n\tv_fma_f32 %15, %16, %17, %15\n\t" : "+v"(r[0]), "+v"(r[1]), "+v"(r[2]), "+v"(r[3]), "+v"(r[4]), "+v"(r[5]), "+v"(r[6]), "+v"(r[7]), "+v"(r[8]), "+v"(r[9]), "+v"(r[10]), "+v"(r[11]), "+v"(r[12]), "+v"(r[13]), "+v"(r[14]), "+v"(r[15]) : "v"(a), "v"(b) : "s40", "vcc");
        asm volatile("v_fma_f32 %0, %16, %17, %0\n\tv_fma_f32 %1, %16, %17, %1\n\tv_fma_f32 %2, %16, %17, %2\n\tv_fma_f32 %3, %16, %17, %3\n\tv_fma_f32 %4, %16, %17, %4\n\tv_fma_f32 %5, %16, %17, %5\n\tv_fma_f32 %6, %16, %17, %6\n\tv_fma_f32 %7, %16, %17, %7\n\tv_fma_f32 %8, %16, %17, %8\n\tv_fma_f32 %9, %16, %17, %9\n\tv_fma_f32 %10, %16, %17, %10\n\tv_fma_f32 %11, %16, %17, %11\n\tv_fma_f32 %12, %16, %17, %12\n\tv_fma_f32 %13, %16, %17, %13\n\tv_fma_f32 %14, %16, %17, %14\n\tv_fma_f32 %15, %16, %17, %15\n\t" : "+v"(r[0]), "+v"(r[1]), "+v"(r[2]), "+v"(r[3]), "+v"(r[4]), "+v"(r[5]), "+v"(r[6]), "+v"(r[7]), "+v"(r[8]), "+v"(r[9]), "+v"(r[10]), "+v"(r[11]), "+v"(r[12]), "+v"(r[13]), "+v"(r[14]), "+v"(r[15]) : "v"(a), "v"(b) : "s40", "vcc");
#endif
#if PROBE_UB == 2
        asm volatile("v_dot4c_i32_i8 %0, %16, %17\n\tv_dot4c_i32_i8 %1, %16, %17\n\tv_dot4c_i32_i8 %2, %16, %17\n\tv_dot4c_i32_i8 %3, %16, %17\n\tv_dot4c_i32_i8 %4, %16, %17\n\tv_dot4c_i32_i8 %5, %16, %17\n\tv_dot4c_i32_i8 %6, %16, %17\n\tv_dot4c_i32_i8 %7, %16, %17\n\tv_dot4c_i32_i8 %8, %16, %17\n\tv_dot4c_i32_i8 %9, %16, %17\n\tv_dot4c_i32_i8 %10, %16, %17\n\tv_dot4c_i32_i8 %11, %16, %17\n\tv_dot4c_i32_i8 %12, %16, %17\n\tv_dot4c_i32_i8 %13, %16, %17\n\tv_dot4c_i32_i8 %14, %16, %17\n\tv_dot4c_i32_i8 %15, %16, %17\n\t" : "+v"(r[0]), "+v"(r[1]), "+v"(r[2]), "+v"(r[3]), "+v"(r[4]), "+v"(r[5]), "+v"(r[6]), "+v"(r[7]), "+v"(r[8]), "+v"(r[9]), "+v"(r[10]), "+v"(r[11]), "+v"(r[12]), "+v"(r[13]), "+v"(r[14]), "+v"(r[15]) : "v"(a), "v"(b) : "s40", "vcc");
        asm volatile("v_dot4c_i32_i8 %0, %16, %17\n\tv_dot4c_i32_i8 %1, %16, %17\n\tv_dot4c_i32_i8 %2, %16, %17\n\tv_dot4c_i32_i8 %3, %16, %17\n\tv_dot4c_i32_i8 %4, %16, %17\n\tv_dot4c_i32_i8 %5, %16, %17\n\tv_dot4c_i32_i8 %6, %16, %17\n\tv_dot4c_i32_i8 %7, %16, %17\n\tv_dot4c_i32_i8 %8, %16, %17\n\tv_dot4c_i32_i8 %9, %16, %17\n\tv_dot4c_i32_i8 %10, %16, %17\n\tv_dot4c_i32_i8 %11, %16, %17\n\tv_dot4c_i32_i8 %12, %16, %17\n\tv_dot4c_i32_i8 %13, %16, %17\n\tv_dot4c_i32_i8 %14, %16, %17\n\tv_dot4c_i32_i8 %15, %16, %17\n\t" : "+v"(r[0]), "+v"(r[1]), "+v"(r[2]), "+v"(r[3]), "+v"(r[4]), "+v"(r[5]), "+v"(r[6]), "+v"(r[7]), "+v"(r[8]), "+v"(r[9]), "+v"(r[10]), "+v"(r[11]), "+v"(r[12]), "+v"(r[13]), "+v"(r[14]), "+v"(r[15]) : "v"(a), "v"(b) : "s40", "vcc");
#endif
#if PROBE_UB == 3
        asm volatile("v_perm_b32 %0, %0, %16, %17\n\tv_perm_b32 %1, %1, %16, %17\n\tv_perm_b32 %2, %2, %16, %17\n\tv_perm_b32 %3, %3, %16, %17\n\tv_perm_b32 %4, %4, %16, %17\n\tv_perm_b32 %5, %5, %16, %17\n\tv_perm_b32 %6, %6, %16, %17\n\tv_perm_b32 %7, %7, %16, %17\n\tv_perm_b32 %8, %8, %16, %17\n\tv_perm_b32 %9, %9, %16, %17\n\tv_perm_b32 %10, %10, %16, %17\n\tv_perm_b32 %11, %11, %16, %17\n\tv_perm_b32 %12, %12, %16, %17\n\tv_perm_b32 %13, %13, %16, %17\n\tv_perm_b32 %14, %14, %16, %17\n\tv_perm_b32 %15, %15, %16, %17\n\t" : "+v"(r[0]), "+v"(r[1]), "+v"(r[2]), "+v"(r[3]), "+v"(r[4]), "+v"(r[5]), "+v"(r[6]), "+v"(r[7]), "+v"(r[8]), "+v"(r[9]), "+v"(r[10]), "+v"(r[11]), "+v"(r[12]), "+v"(r[13]), "+v"(r[14]), "+v"(r[15]) : "v"(a), "v"(b) : "s40", "vcc");
        asm volatile("v_perm_b32 %0, %0, %16, %17\n\tv_perm_b32 %1, %1, %16, %17\n\tv_perm_b32 %2, %2, %16, %17\n\tv_perm_b32 %3, %3, %16, %17\n\tv_perm_b32 %4, %4, %16, %17\n\tv_perm_b32 %5, %5, %16, %17\n\tv_perm_b32 %6, %6, %16, %17\n\tv_perm_b32 %7, %7, %16, %17\n\tv_perm_b32 %8, %8, %16, %17\n\tv_perm_b32 %9, %9, %16, %17\n\tv_perm_b32 %10, %10, %16, %17\n\tv_perm_b32 %11, %11, %16, %17\n\tv_perm_b32 %12, %12, %16, %17\n\tv_perm_b32 %13, %13, %16, %17\n\tv_perm_b32 %14, %14, %16, %17\n\tv_perm_b32 %15, %15, %16, %17\n\t" : "+v"(r[0]), "+v"(r[1]), "+v"(r[2]), "+v"(r[3]), "+v"(r[4]), "+v"(r[5]), "+v"(r[6]), "+v"(r[7]), "+v"(r[8]), "+v"(r[9]), "+v"(r[10]), "+v"(r[11]), "+v"(r[12]), "+v"(r[13]), "+v"(r[14]), "+v"(r[15]) : "v"(a), "v"(b) : "s40", "vcc");
#endif
#if PROBE_UB == 4
        asm volatile("v_add_u32_dpp %0, %0, %0 quad_perm:[1,0,3,2] row_mask:0xf bank_mask:0xf\n\tv_add_u32_dpp %1, %1, %1 quad_perm:[1,0,3,2] row_mask:0xf bank_mask:0xf\n\tv_add_u32_dpp %2, %2, %2 quad_perm:[1,0,3,2] row_mask:0xf bank_mask:0xf\n\tv_add_u32_dpp %3, %3, %3 quad_perm:[1,0,3,2] row_mask:0xf bank_mask:0xf\n\tv_add_u32_dpp %4, %4, %4 quad_perm:[1,0,3,2] row_mask:0xf bank_mask:0xf\n\tv_add_u32_dpp %5, %5, %5 quad_perm:[1,0,3,2] row_mask:0xf bank_mask:0xf\n\tv_add_u32_dpp %6, %6, %6 quad_perm:[1,0,3,2] row_mask:0xf bank_mask:0xf\n\tv_add_u32_dpp %7, %7, %7 quad_perm:[1,0,3,2] row_mask:0xf bank_mask:0xf\n\tv_add_u32_dpp %8, %8, %8 quad_perm:[1,0,3,2] row_mask:0xf bank_mask:0xf\n\tv_add_u32_dpp %9, %9, %9 quad_perm:[1,0,3,2] row_mask:0xf bank_mask:0xf\n\tv_add_u32_dpp %10, %10, %10 quad_perm:[1,0,3,2] row_mask:0xf bank_mask:0xf\n\tv_add_u32_dpp %11, %11, %11 quad_perm:[1,0,3,2] row_mask:0xf bank_mask:0xf\n\tv_add_u32_dpp %12, %12, %12 quad_perm:[1,0,3,2] row_mask:0xf bank_mask:0xf\n\tv_add_u32_dpp %13, %13, %13 quad_perm:[1,0,3,2] row_mask:0xf bank_mask:0xf\n\tv_add_u32_dpp %14, %14, %14 quad_perm:[1,0,3,2] row_mask:0xf bank_mask:0xf\n\tv_add_u32_dpp %15, %15, %15 quad_perm:[1,0,3,2] row_mask:0xf bank_mask:0xf\n\t" : "+v"(r[0]), "+v"(r[1]), "+v"(r[2]), "+v"(r[3]), "+v"(r[4]), "+v"(r[5]), "+v"(r[6]), "+v"(r[7]), "+v"(r[8]), "+v"(r[9]), "+v"(r[10]), "+v"(r[11]), "+v"(r[12]), "+v"(r[13]), "+v"(r[14]), "+v"(r[15]) : "v"(a), "v"(b) : "s40", "vcc");
        asm volatile("v_add_u32_dpp %0, %0, %0 quad_perm:[1,0,3,2] row_mask:0xf bank_mask:0xf\n\tv_add_u32_dpp %1, %1, %1 quad_perm:[1,0,3,2] row_mask:0xf bank_mask:0xf\n\tv_add_u32_dpp %2, %2, %2 quad_perm:[1,0,3,2] row_mask:0xf bank_mask:0xf\n\tv_add_u32_dpp %3, %3, %3 quad_perm:[1,0,3,2] row_mask:0xf bank_mask:0xf\n\tv_add_u32_dpp %4, %4, %4 quad_perm:[1,0,3,2] row_mask:0xf bank_mask:0xf\n\tv_add_u32_dpp %5, %5, %5 quad_perm:[1,0,3,2] row_mask:0xf bank_mask:0xf\n\tv_add_u32_dpp %6, %6, %6 quad_perm:[1,0,3,2] row_mask:0xf bank_mask:0xf\n\tv_add_u32_dpp %7, %7, %7 quad_perm:[1,0,3,2] row_mask:0xf bank_mask:0xf\n\tv_add_u32_dpp %8, %8, %8 quad_perm:[1,0,3,2] row_mask:0xf bank_mask:0xf\n\tv_add_u32_dpp %9, %9, %9 quad_perm:[1,0,3,2] row_mask:0xf bank_mask:0xf\n\tv_add_u32_dpp %10, %10, %10 quad_perm:[1,0,3,2] row_mask:0xf bank_mask:0xf\n\tv_add_u32_dpp %11, %11, %11 quad_perm:[1,0,3,2] row_mask:0xf bank_mask:0xf\n\tv_add_u32_dpp %12, %12, %12 quad_perm:[1,0,3,2] row_mask:0xf bank_mask:0xf\n\tv_add_u32_dpp %13, %13, %13 quad_perm:[1,0,3,2] row_mask:0xf bank_mask:0xf\n\tv_add_u32_dpp %14, %14, %14 quad_perm:[1,0,3,2] row_mask:0xf bank_mask:0xf\n\tv_add_u32_dpp %15, %15, %15 quad_perm:[1,0,3,2] row_mask:0xf bank_mask:0xf\n\t" : "+v"(r[0]), "+v"(r[1]), "+v"(r[2]), "+v"(r[3]), "+v"(r[4]), "+v"(r[5]), "+v"(r[6]), "+v"(r[7]), "+v"(r[8]), "+v"(r[9]), "+v"(r[10]), "+v"(r[11]), "+v"(r[12]), "+v"(r[13]), "+v"(r[14]), "+v"(r[15]) : "v"(a), "v"(b) : "s40", "vcc");
#endif
#if PROBE_UB == 5
        asm volatile("v_readlane_b32 s40, %0, 5\n\tv_readlane_b32 s40, %1, 5\n\tv_readlane_b32 s40, %2, 5\n\tv_readlane_b32 s40, %3, 5\n\tv_readlane_b32 s40, %4, 5\n\tv_readlane_b32 s40, %5, 5\n\tv_readlane_b32 s40, %6, 5\n\tv_readlane_b32 s40, %7, 5\n\tv_readlane_b32 s40, %8, 5\n\tv_readlane_b32 s40, %9, 5\n\tv_readlane_b32 s40, %10, 5\n\tv_readlane_b32 s40, %11, 5\n\tv_readlane_b32 s40, %12, 5\n\tv_readlane_b32 s40, %13, 5\n\tv_readlane_b32 s40, %14, 5\n\tv_readlane_b32 s40, %15, 5\n\t" : "+v"(r[0]), "+v"(r[1]), "+v"(r[2]), "+v"(r[3]), "+v"(r[4]), "+v"(r[5]), "+v"(r[6]), "+v"(r[7]), "+v"(r[8]), "+v"(r[9]), "+v"(r[10]), "+v"(r[11]), "+v"(r[12]), "+v"(r[13]), "+v"(r[14]), "+v"(r[15]) : "v"(a), "v"(b) : "s40", "vcc");
        asm volatile("v_readlane_b32 s40, %0, 5\n\tv_readlane_b32 s40, %1, 5\n\tv_readlane_b32 s40, %2, 5\n\tv_readlane_b32 s40, %3, 5\n\tv_readlane_b32 s40, %4, 5\n\tv_readlane_b32 s40, %5, 5\n\tv_readlane_b32 s40, %6, 5\n\tv_readlane_b32 s40, %7, 5\n\tv_readlane_b32 s40, %8, 5\n\tv_readlane_b32 s40, %9, 5\n\tv_readlane_b32 s40, %10, 5\n\tv_readlane_b32 s40, %11, 5\n\tv_readlane_b32 s40, %12, 5\n\tv_readlane_b32 s40, %13, 5\n\tv_readlane_b32 s40, %14, 5\n\tv_readlane_b32 s40, %15, 5\n\t" : "+v"(r[0]), "+v"(r[1]), "+v"(r[2]), "+v"(r[3]), "+v"(r[4]), "+v"(r[5]), "+v"(r[6]), "+v"(r[7]), "+v"(r[8]), "+v"(r[9]), "+v"(r[10]), "+v"(r[11]), "+v"(r[12]), "+v"(r[13]), "+v"(r[14]), "+v"(r[15]) : "v"(a), "v"(b) : "s40", "vcc");
#endif
#if PROBE_UB == 6
        asm volatile("v_cvt_pk_f32_fp8 %0, %16\n\tv_cvt_pk_f32_fp8 %1, %16\n\tv_cvt_pk_f32_fp8 %2, %16\n\tv_cvt_pk_f32_fp8 %3, %16\n\tv_cvt_pk_f32_fp8 %4, %16\n\tv_cvt_pk_f32_fp8 %5, %16\n\tv_cvt_pk_f32_fp8 %6, %16\n\tv_cvt_pk_f32_fp8 %7, %16\n\t" : "+v"(r2[0]), "+v"(r2[1]), "+v"(r2[2]), "+v"(r2[3]), "+v"(r2[4]), "+v"(r2[5]), "+v"(r2[6]), "+v"(r2[7]), "+v"(r[8]), "+v"(r[9]), "+v"(r[10]), "+v"(r[11]), "+v"(r[12]), "+v"(r[13]), "+v"(r[14]), "+v"(r[15]) : "v"(a), "v"(b) : "s40", "vcc");
        asm volatile("v_cvt_pk_f32_fp8 %0, %16\n\tv_cvt_pk_f32_fp8 %1, %16\n\tv_cvt_pk_f32_fp8 %2, %16\n\tv_cvt_pk_f32_fp8 %3, %16\n\tv_cvt_pk_f32_fp8 %4, %16\n\tv_cvt_pk_f32_fp8 %5, %16\n\tv_cvt_pk_f32_fp8 %6, %16\n\tv_cvt_pk_f32_fp8 %7, %16\n\t" : "+v"(r2[0]), "+v"(r2[1]), "+v"(r2[2]), "+v"(r2[3]), "+v"(r2[4]), "+v"(r2[5]), "+v"(r2[6]), "+v"(r2[7]), "+v"(r[8]), "+v"(r[9]), "+v"(r[10]), "+v"(r[11]), "+v"(r[12]), "+v"(r[13]), "+v"(r[14]), "+v"(r[15]) : "v"(a), "v"(b) : "s40", "vcc");
        asm volatile("v_cvt_pk_f32_fp8 %0, %16\n\tv_cvt_pk_f32_fp8 %1, %16\n\tv_cvt_pk_f32_fp8 %2, %16\n\tv_cvt_pk_f32_fp8 %3, %16\n\tv_cvt_pk_f32_fp8 %4, %16\n\tv_cvt_pk_f32_fp8 %5, %16\n\tv_cvt_pk_f32_fp8 %6, %16\n\tv_cvt_pk_f32_fp8 %7, %16\n\t" : "+v"(r2[0]), "+v"(r2[1]), "+v"(r2[2]), "+v"(r2[3]), "+v"(r2[4]), "+v"(r2[5]), "+v"(r2[6]), "+v"(r2[7]), "+v"(r[8]), "+v"(r[9]), "+v"(r[10]), "+v"(r[11]), "+v"(r[12]), "+v"(r[13]), "+v"(r[14]), "+v"(r[15]) : "v"(a), "v"(b) : "s40", "vcc");
        asm volatile("v_cvt_pk_f32_fp8 %0, %16\n\tv_cvt_pk_f32_fp8 %1, %16\n\tv_cvt_pk_f32_fp8 %2, %16\n\tv_cvt_pk_f32_fp8 %3, %16\n\tv_cvt_pk_f32_fp8 %4, %16\n\tv_cvt_pk_f32_fp8 %5, %16\n\tv_cvt_pk_f32_fp8 %6, %16\n\tv_cvt_pk_f32_fp8 %7, %16\n\t" : "+v"(r2[0]), "+v"(r2[1]), "+v"(r2[2]), "+v"(r2[3]), "+v"(r2[4]), "+v"(r2[5]), "+v"(r2[6]), "+v"(r2[7]), "+v"(r[8]), "+v"(r[9]), "+v"(r[10]), "+v"(r[11]), "+v"(r[12]), "+v"(r[13]), "+v"(r[14]), "+v"(r[15]) : "v"(a), "v"(b) : "s40", "vcc");
#endif
#if PROBE_UB == 7
        asm volatile("v_pk_fma_f32 %0, %0, %0, %0\n\tv_pk_fma_f32 %1, %1, %1, %1\n\tv_pk_fma_f32 %2, %2, %2, %2\n\tv_pk_fma_f32 %3, %3, %3, %3\n\tv_pk_fma_f32 %4, %4, %4, %4\n\tv_pk_fma_f32 %5, %5, %5, %5\n\tv_pk_fma_f32 %6, %6, %6, %6\n\tv_pk_fma_f32 %7, %7, %7, %7\n\t" : "+v"(r2[0]), "+v"(r2[1]), "+v"(r2[2]), "+v"(r2[3]), "+v"(r2[4]), "+v"(r2[5]), "+v"(r2[6]), "+v"(r2[7]), "+v"(r[8]), "+v"(r[9]), "+v"(r[10]), "+v"(r[11]), "+v"(r[12]), "+v"(r[13]), "+v"(r[14]), "+v"(r[15]) : "v"(a), "v"(b) : "s40", "vcc");
        asm volatile("v_pk_fma_f32 %0, %0, %0, %0\n\tv_pk_fma_f32 %1, %1, %1, %1\n\tv_pk_fma_f32 %2, %2, %2, %2\n\tv_pk_fma_f32 %3, %3, %3, %3\n\tv_pk_fma_f32 %4, %4, %4, %4\n\tv_pk_fma_f32 %5, %5, %5, %5\n\tv_pk_fma_f32 %6, %6, %6, %6\n\tv_pk_fma_f32 %7, %7, %7, %7\n\t" : "+v"(r2[0]), "+v"(r2[1]), "+v"(r2[2]), "+v"(r2[3]), "+v"(r2[4]), "+v"(r2[5]), "+v"(r2[6]), "+v"(r2[7]), "+v"(r[8]), "+v"(r[9]), "+v"(r[10]), "+v"(r[11]), "+v"(r[12]), "+v"(r[13]), "+v"(r[14]), "+v"(r[15]) : "v"(a), "v"(b) : "s40", "vcc");
        asm volatile("v_pk_fma_f32 %0, %0, %0, %0\n\tv_pk_fma_f32 %1, %1, %1, %1\n\tv_pk_fma_f32 %2, %2, %2, %2\n\tv_pk_fma_f32 %3, %3, %3, %3\n\tv_pk_fma_f32 %4, %4, %4, %4\n\tv_pk_fma_f32 %5, %5, %5, %5\n\tv_pk_fma_f32 %6, %6, %6, %6\n\tv_pk_fma_f32 %7, %7, %7, %7\n\t" : "+v"(r2[0]), "+v"(r2[1]), "+v"(r2[2]), "+v"(r2[3]), "+v"(r2[4]), "+v"(r2[5]), "+v"(r2[6]), "+v"(r2[7]), "+v"(r[8]), "+v"(r[9]), "+v"(r[10]), "+v"(r[11]), "+v"(r[12]), "+v"(r[13]), "+v"(r[14]), "+v"(r[15]) : "v"(a), "v"(b) : "s40", "vcc");
        asm volatile("v_pk_fma_f32 %0, %0, %0, %0\n\tv_pk_fma_f32 %1, %1, %1, %1\n\tv_pk_fma_f32 %2, %2, %2, %2\n\tv_pk_fma_f32 %3, %3, %3, %3\n\tv_pk_fma_f32 %4, %4, %4, %4\n\tv_pk_fma_f32 %5, %5, %5, %5\n\tv_pk_fma_f32 %6, %6, %6, %6\n\tv_pk_fma_f32 %7, %7, %7, %7\n\t" : "+v"(r2[0]), "+v"(r2[1]), "+v"(r2[2]), "+v"(r2[3]), "+v"(r2[4]), "+v"(r2[5]), "+v"(r2[6]), "+v"(r2[7]), "+v"(r[8]), "+v"(r[9]), "+v"(r[10]), "+v"(r[11]), "+v"(r[12]), "+v"(r[13]), "+v"(r[14]), "+v"(r[15]) : "v"(a), "v"(b) : "s40", "vcc");
#endif
#if PROBE_UB == 8
        asm volatile("v_dot2c_f32_bf16 %0, %16, %17\n\tv_dot2c_f32_bf16 %1, %16, %17\n\tv_dot2c_f32_bf16 %2, %16, %17\n\tv_dot2c_f32_bf16 %3, %16, %17\n\tv_dot2c_f32_bf16 %4, %16, %17\n\tv_dot2c_f32_bf16 %5, %16, %17\n\tv_dot2c_f32_bf16 %6, %16, %17\n\tv_dot2c_f32_bf16 %7, %16, %17\n\tv_dot2c_f32_bf16 %8, %16, %17\n\tv_dot2c_f32_bf16 %9, %16, %17\n\tv_dot2c_f32_bf16 %10, %16, %17\n\tv_dot2c_f32_bf16 %11, %16, %17\n\tv_dot2c_f32_bf16 %12, %16, %17\n\tv_dot2c_f32_bf16 %13, %16, %17\n\tv_dot2c_f32_bf16 %14, %16, %17\n\tv_dot2c_f32_bf16 %15, %16, %17\n\t" : "+v"(r[0]), "+v"(r[1]), "+v"(r[2]), "+v"(r[3]), "+v"(r[4]), "+v"(r[5]), "+v"(r[6]), "+v"(r[7]), "+v"(r[8]), "+v"(r[9]), "+v"(r[10]), "+v"(r[11]), "+v"(r[12]), "+v"(r[13]), "+v"(r[14]), "+v"(r[15]) : "v"(a), "v"(b) : "s40", "vcc");
        asm volatile("v_dot2c_f32_bf16 %0, %16, %17\n\tv_dot2c_f32_bf16 %1, %16, %17\n\tv_dot2c_f32_bf16 %2, %16, %17\n\tv_dot2c_f32_bf16 %3, %16, %17\n\tv_dot2c_f32_bf16 %4, %16, %17\n\tv_dot2c_f32_bf16 %5, %16, %17\n\tv_dot2c_f32_bf16 %6, %16, %17\n\tv_dot2c_f32_bf16 %7, %16, %17\n\tv_dot2c_f32_bf16 %8, %16, %17\n\tv_dot2c_f32_bf16 %9, %16, %17\n\tv_dot2c_f32_bf16 %10, %16, %17\n\tv_dot2c_f32_bf16 %11, %16, %17\n\tv_dot2c_f32_bf16 %12, %16, %17\n\tv_dot2c_f32_bf16 %13, %16, %17\n\tv_dot2c_f32_bf16 %14, %16, %17\n\tv_dot2c_f32_bf16 %15, %16, %17\n\t" : "+v"(r[0]), "+v"(r[1]), "+v"(r[2]), "+v"(r[3]), "+v"(r[4]), "+v"(r[5]), "+v"(r[6]), "+v"(r[7]), "+v"(r[8]), "+v"(r[9]), "+v"(r[10]), "+v"(r[11]), "+v"(r[12]), "+v"(r[13]), "+v"(r[14]), "+v"(r[15]) : "v"(a), "v"(b) : "s40", "vcc");
#endif
#if PROBE_UB == 9
        asm volatile("v_cndmask_b32 %0, %0, %16, vcc\n\tv_cndmask_b32 %1, %1, %16, vcc\n\tv_cndmask_b32 %2, %2, %16, vcc\n\tv_cndmask_b32 %3, %3, %16, vcc\n\tv_cndmask_b32 %4, %4, %16, vcc\n\tv_cndmask_b32 %5, %5, %16, vcc\n\tv_cndmask_b32 %6, %6, %16, vcc\n\tv_cndmask_b32 %7, %7, %16, vcc\n\tv_cndmask_b32 %8, %8, %16, vcc\n\tv_cndmask_b32 %9, %9, %16, vcc\n\tv_cndmask_b32 %10, %10, %16, vcc\n\tv_cndmask_b32 %11, %11, %16, vcc\n\tv_cndmask_b32 %12, %12, %16, vcc\n\tv_cndmask_b32 %13, %13, %16, vcc\n\tv_cndmask_b32 %14, %14, %16, vcc\n\tv_cndmask_b32 %15, %15, %16, vcc\n\t" : "+v"(r[0]), "+v"(r[1]), "+v"(r[2]), "+v"(r[3]), "+v"(r[4]), "+v"(r[5]), "+v"(r[6]), "+v"(r[7]), "+v"(r[8]), "+v"(r[9]), "+v"(r[10]), "+v"(r[11]), "+v"(r[12]), "+v"(r[13]), "+v"(r[14]), "+v"(r[15]) : "v"(a), "v"(b) : "s40", "vcc");
        asm volatile("v_cndmask_b32 %0, %0, %16, vcc\n\tv_cndmask_b32 %1, %1, %16, vcc\n\tv_cndmask_b32 %2, %2, %16, vcc\n\tv_cndmask_b32 %3, %3, %16, vcc\n\tv_cndmask_b32 %4, %4, %16, vcc\n\tv_cndmask_b32 %5, %5, %16, vcc\n\tv_cndmask_b32 %6, %6, %16, vcc\n\tv_cndmask_b32 %7, %7, %16, vcc\n\tv_cndmask_b32 %8, %8, %16, vcc\n\tv_cndmask_b32 %9, %9, %16, vcc\n\tv_cndmask_b32 %10, %10, %16, vcc\n\tv_cndmask_b32 %11, %11, %16, vcc\n\tv_cndmask_b32 %12, %12, %16, vcc\n\tv_cndmask_b32 %13, %13, %16, vcc\n\tv_cndmask_b32 %14, %14, %16, vcc\n\tv_cndmask_b32 %15, %15, %16, vcc\n\t" : "+v"(r[0]), "+v"(r[1]), "+v"(r[2]), "+v"(r[3]), "+v"(r[4]), "+v"(r[5]), "+v"(r[6]), "+v"(r[7]), "+v"(r[8]), "+v"(r[9]), "+v"(r[10]), "+v"(r[11]), "+v"(r[12]), "+v"(r[13]), "+v"(r[14]), "+v"(r[15]) : "v"(a), "v"(b) : "s40", "vcc");
#endif
#if PROBE_UB == 10
        asm volatile("v_max_i32 %0, %0, %16\n\tv_max_i32 %1, %1, %16\n\tv_max_i32 %2, %2, %16\n\tv_max_i32 %3, %3, %16\n\tv_max_i32 %4, %4, %16\n\tv_max_i32 %5, %5, %16\n\tv_max_i32 %6, %6, %16\n\tv_max_i32 %7, %7, %16\n\tv_max_i32 %8, %8, %16\n\tv_max_i32 %9, %9, %16\n\tv_max_i32 %10, %10, %16\n\tv_max_i32 %11, %11, %16\n\tv_max_i32 %12, %12, %16\n\tv_max_i32 %13, %13, %16\n\tv_max_i32 %14, %14, %16\n\tv_max_i32 %15, %15, %16\n\t" : "+v"(r[0]), "+v"(r[1]), "+v"(r[2]), "+v"(r[3]), "+v"(r[4]), "+v"(r[5]), "+v"(r[6]), "+v"(r[7]), "+v"(r[8]), "+v"(r[9]), "+v"(r[10]), "+v"(r[11]), "+v"(r[12]), "+v"(r[13]), "+v"(r[14]), "+v"(r[15]) : "v"(a), "v"(b) : "s40", "vcc");
        asm volatile("v_max_i32 %0, %0, %16\n\tv_max_i32 %1, %1, %16\n\tv_max_i32 %2, %2, %16\n\tv_max_i32 %3, %3, %16\n\tv_max_i32 %4, %4, %16\n\tv_max_i32 %5, %5, %16\n\tv_max_i32 %6, %6, %16\n\tv_max_i32 %7, %7, %16\n\tv_max_i32 %8, %8, %16\n\tv_max_i32 %9, %9, %16\n\tv_max_i32 %10, %10, %16\n\tv_max_i32 %11, %11, %16\n\tv_max_i32 %12, %12, %16\n\tv_max_i32 %13, %13, %16\n\tv_max_i32 %14, %14, %16\n\tv_max_i32 %15, %15, %16\n\t" : "+v"(r[0]), "+v"(r[1]), "+v"(r[2]), "+v"(r[3]), "+v"(r[4]), "+v"(r[5]), "+v"(r[6]), "+v"(r[7]), "+v"(r[8]), "+v"(r[9]), "+v"(r[10]), "+v"(r[11]), "+v"(r[12]), "+v"(r[13]), "+v"(r[14]), "+v"(r[15]) : "v"(a), "v"(b) : "s40", "vcc");
#endif
#if PROBE_UB == 11
        asm volatile("v_exp_f32 %0, %0\n\tv_exp_f32 %1, %1\n\tv_exp_f32 %2, %2\n\tv_exp_f32 %3, %3\n\tv_exp_f32 %4, %4\n\tv_exp_f32 %5, %5\n\tv_exp_f32 %6, %6\n\tv_exp_f32 %7, %7\n\tv_exp_f32 %8, %8\n\tv_exp_f32 %9, %9\n\tv_exp_f32 %10, %10\n\tv_exp_f32 %11, %11\n\tv_exp_f32 %12, %12\n\tv_exp_f32 %13, %13\n\tv_exp_f32 %14, %14\n\tv_exp_f32 %15, %15\n\t" : "+v"(r[0]), "+v"(r[1]), "+v"(r[2]), "+v"(r[3]), "+v"(r[4]), "+v"(r[5]), "+v"(r[6]), "+v"(r[7]), "+v"(r[8]), "+v"(r[9]), "+v"(r[10]), "+v"(r[11]), "+v"(r[12]), "+v"(r[13]), "+v"(r[14]), "+v"(r[15]) : "v"(a), "v"(b) : "s40", "vcc");
        asm volatile("v_exp_f32 %0, %0\n\tv_exp_f32 %1, %1\n\tv_exp_f32 %2, %2\n\tv_exp_f32 %3, %3\n\tv_exp_f32 %4, %4\n\tv_exp_f32 %5, %5\n\tv_exp_f32 %6, %6\n\tv_exp_f32 %7, %7\n\tv_exp_f32 %8, %8\n\tv_exp_f32 %9, %9\n\tv_exp_f32 %10, %10\n\tv_exp_f32 %11, %11\n\tv_exp_f32 %12, %12\n\tv_exp_f32 %13, %13\n\tv_exp_f32 %14, %14\n\tv_exp_f32 %15, %15\n\t" : "+v"(r[0]), "+v"(r[1]), "+v"(r[2]), "+v"(r[3]), "+v"(r[4]), "+v"(r[5]), "+v"(r[6]), "+v"(r[7]), "+v"(r[8]), "+v"(r[9]), "+v"(r[10]), "+v"(r[11]), "+v"(r[12]), "+v"(r[13]), "+v"(r[14]), "+v"(r[15]) : "v"(a), "v"(b) : "s40", "vcc");
#endif
#if PROBE_UB == 12
        asm volatile("v_fmac_f32 %0, %16, %17\n\tv_fmac_f32 %1, %16, %17\n\tv_fmac_f32 %2, %16, %17\n\tv_fmac_f32 %3, %16, %17\n\tv_fmac_f32 %4, %16, %17\n\tv_fmac_f32 %5, %16, %17\n\tv_fmac_f32 %6, %16, %17\n\tv_fmac_f32 %7, %16, %17\n\tv_fmac_f32 %8, %16, %17\n\tv_fmac_f32 %9, %16, %17\n\tv_fmac_f32 %10, %16, %17\n\tv_fmac_f32 %11, %16, %17\n\tv_fmac_f32 %12, %16, %17\n\tv_fmac_f32 %13, %16, %17\n\tv_fmac_f32 %14, %16, %17\n\tv_fmac_f32 %15, %16, %17\n\t" : "+v"(r[0]), "+v"(r[1]), "+v"(r[2]), "+v"(r[3]), "+v"(r[4]), "+v"(r[5]), "+v"(r[6]), "+v"(r[7]), "+v"(r[8]), "+v"(r[9]), "+v"(r[10]), "+v"(r[11]), "+v"(r[12]), "+v"(r[13]), "+v"(r[14]), "+v"(r[15]) : "v"(a), "v"(b) : "s40", "vcc");
        asm volatile("v_fmac_f32 %0, %16, %17\n\tv_fmac_f32 %1, %16, %17\n\tv_fmac_f32 %2, %16, %17\n\tv_fmac_f32 %3, %16, %17\n\tv_fmac_f32 %4, %16, %17\n\tv_fmac_f32 %5, %16, %17\n\tv_fmac_f32 %6, %16, %17\n\tv_fmac_f32 %7, %16, %17\n\tv_fmac_f32 %8, %16, %17\n\tv_fmac_f32 %9, %16, %17\n\tv_fmac_f32 %10, %16, %17\n\tv_fmac_f32 %11, %16, %17\n\tv_fmac_f32 %12, %16, %17\n\tv_fmac_f32 %13, %16, %17\n\tv_fmac_f32 %14, %16, %17\n\tv_fmac_f32 %15, %16, %17\n\t" : "+v"(r[0]), "+v"(r[1]), "+v"(r[2]), "+v"(r[3]), "+v"(r[4]), "+v"(r[5]), "+v"(r[6]), "+v"(r[7]), "+v"(r[8]), "+v"(r[9]), "+v"(r[10]), "+v"(r[11]), "+v"(r[12]), "+v"(r[13]), "+v"(r[14]), "+v"(r[15]) : "v"(a), "v"(b) : "s40", "vcc");
#endif
#if PROBE_UB == 13
        asm volatile("v_add_u32_dpp %0, %16, %0 quad_perm:[1,0,3,2] row_mask:0xf bank_mask:0xf\n\tv_add_u32_dpp %1, %16, %1 quad_perm:[1,0,3,2] row_mask:0xf bank_mask:0xf\n\tv_add_u32_dpp %2, %16, %2 quad_perm:[1,0,3,2] row_mask:0xf bank_mask:0xf\n\tv_add_u32_dpp %3, %16, %3 quad_perm:[1,0,3,2] row_mask:0xf bank_mask:0xf\n\tv_add_u32_dpp %4, %16, %4 quad_perm:[1,0,3,2] row_mask:0xf bank_mask:0xf\n\tv_add_u32_dpp %5, %16, %5 quad_perm:[1,0,3,2] row_mask:0xf bank_mask:0xf\n\tv_add_u32_dpp %6, %16, %6 quad_perm:[1,0,3,2] row_mask:0xf bank_mask:0xf\n\tv_add_u32_dpp %7, %16, %7 quad_perm:[1,0,3,2] row_mask:0xf bank_mask:0xf\n\tv_add_u32_dpp %8, %16, %8 quad_perm:[1,0,3,2] row_mask:0xf bank_mask:0xf\n\tv_add_u32_dpp %9, %16, %9 quad_perm:[1,0,3,2] row_mask:0xf bank_mask:0xf\n\tv_add_u32_dpp %10, %16, %10 quad_perm:[1,0,3,2] row_mask:0xf bank_mask:0xf\n\tv_add_u32_dpp %11, %16, %11 quad_perm:[1,0,3,2] row_mask:0xf bank_mask:0xf\n\tv_add_u32_dpp %12, %16, %12 quad_perm:[1,0,3,2] row_mask:0xf bank_mask:0xf\n\tv_add_u32_dpp %13, %16, %13 quad_perm:[1,0,3,2] row_mask:0xf bank_mask:0xf\n\tv_add_u32_dpp %14, %16, %14 quad_perm:[1,0,3,2] row_mask:0xf bank_mask:0xf\n\tv_add_u32_dpp %15, %16, %15 quad_perm:[1,0,3,2] row_mask:0xf bank_mask:0xf\n\t" : "+v"(r[0]), "+v"(r[1]), "+v"(r[2]), "+v"(r[3]), "+v"(r[4]), "+v"(r[5]), "+v"(r[6]), "+v"(r[7]), "+v"(r[8]), "+v"(r[9]), "+v"(r[10]), "+v"(r[11]), "+v"(r[12]), "+v"(r[13]), "+v"(r[14]), "+v"(r[15]) : "v"(a), "v"(b) : "s40", "vcc");
        asm volatile("v_add_u32_dpp %0, %16, %0 quad_perm:[1,0,3,2] row_mask:0xf bank_mask:0xf\n\tv_add_u32_dpp %1, %16, %1 quad_perm:[1,0,3,2] row_mask:0xf bank_mask:0xf\n\tv_add_u32_dpp %2, %16, %2 quad_perm:[1,0,3,2] row_mask:0xf bank_mask:0xf\n\tv_add_u32_dpp %3, %16, %3 quad_perm:[1,0,3,2] row_mask:0xf bank_mask:0xf\n\tv_add_u32_dpp %4, %16, %4 quad_perm:[1,0,3,2] row_mask:0xf bank_mask:0xf\n\tv_add_u32_dpp %5, %16, %5 quad_perm:[1,0,3,2] row_mask:0xf bank_mask:0xf\n\tv_add_u32_dpp %6, %16, %6 quad_perm:[1,0,3,2] row_mask:0xf bank_mask:0xf\n\tv_add_u32_dpp %7, %16, %7 quad_perm:[1,0,3,2] row_mask:0xf bank_mask:0xf\n\tv_add_u32_dpp %8, %16, %8 quad_perm:[1,0,3,2] row_mask:0xf bank_mask:0xf\n\tv_add_u32_dpp %9, %16, %9 quad_perm:[1,0,3,2] row_mask:0xf bank_mask:0xf\n\tv_add_u32_dpp %10, %16, %10 quad_perm:[1,0,3,2] row_mask:0xf bank_mask:0xf\n\tv_add_u32_dpp %11, %16, %11 quad_perm:[1,0,3,2] row_mask:0xf bank_mask:0xf\n\tv_add_u32_dpp %12, %16, %12 quad_perm:[1,0,3,2] row_mask:0xf bank_mask:0xf\n\tv_add_u32_dpp %13, %16, %13 quad_perm:[1,0,3,2] row_mask:0xf bank_mask:0xf\n\tv_add_u32_dpp %14, %16, %14 quad_perm:[1,0,3,2] row_mask:0xf bank_mask:0xf\n\tv_add_u32_dpp %15, %16, %15 quad_perm:[1,0,3,2] row_mask:0xf bank_mask:0xf\n\t" : "+v"(r[0]), "+v"(r[1]), "+v"(r[2]), "+v"(r[3]), "+v"(r[4]), "+v"(r[5]), "+v"(r[6]), "+v"(r[7]), "+v"(r[8]), "+v"(r[9]), "+v"(r[10]), "+v"(r[11]), "+v"(r[12]), "+v"(r[13]), "+v"(r[14]), "+v"(r[15]) : "v"(a), "v"(b) : "s40", "vcc");
#endif
#if PROBE_UB == 14
        asm volatile("v_cvt_f32_ubyte1 %0, %16\n\tv_cvt_f32_ubyte1 %1, %16\n\tv_cvt_f32_ubyte1 %2, %16\n\tv_cvt_f32_ubyte1 %3, %16\n\tv_cvt_f32_ubyte1 %4, %16\n\tv_cvt_f32_ubyte1 %5, %16\n\tv_cvt_f32_ubyte1 %6, %16\n\tv_cvt_f32_ubyte1 %7, %16\n\tv_cvt_f32_ubyte1 %8, %16\n\tv_cvt_f32_ubyte1 %9, %16\n\tv_cvt_f32_ubyte1 %10, %16\n\tv_cvt_f32_ubyte1 %11, %16\n\tv_cvt_f32_ubyte1 %12, %16\n\tv_cvt_f32_ubyte1 %13, %16\n\tv_cvt_f32_ubyte1 %14, %16\n\tv_cvt_f32_ubyte1 %15, %16\n\t" : "+v"(r[0]), "+v"(r[1]), "+v"(r[2]), "+v"(r[3]), "+v"(r[4]), "+v"(r[5]), "+v"(r[6]), "+v"(r[7]), "+v"(r[8]), "+v"(r[9]), "+v"(r[10]), "+v"(r[11]), "+v"(r[12]), "+v"(r[13]), "+v"(r[14]), "+v"(r[15]) : "v"(a), "v"(b) : "s40", "vcc");
        asm volatile("v_cvt_f32_ubyte1 %0, %16\n\tv_cvt_f32_ubyte1 %1, %16\n\tv_cvt_f32_ubyte1 %2, %16\n\tv_cvt_f32_ubyte1 %3, %16\n\tv_cvt_f32_ubyte1 %4, %16\n\tv_cvt_f32_ubyte1 %5, %16\n\tv_cvt_f32_ubyte1 %6, %16\n\tv_cvt_f32_ubyte1 %7, %16\n\tv_cvt_f32_ubyte1 %8, %16\n\tv_cvt_f32_ubyte1 %9, %16\n\tv_cvt_f32_ubyte1 %10, %16\n\tv_cvt_f32_ubyte1 %11, %16\n\tv_cvt_f32_ubyte1 %12, %16\n\tv_cvt_f32_ubyte1 %13, %16\n\tv_cvt_f32_ubyte1 %14, %16\n\tv_cvt_f32_ubyte1 %15, %16\n\t" : "+v"(r[0]), "+v"(r[1]), "+v"(r[2]), "+v"(r[3]), "+v"(r[4]), "+v"(r[5]), "+v"(r[6]), "+v"(r[7]), "+v"(r[8]), "+v"(r[9]), "+v"(r[10]), "+v"(r[11]), "+v"(r[12]), "+v"(r[13]), "+v"(r[14]), "+v"(r[15]) : "v"(a), "v"(b) : "s40", "vcc");
#endif
#if PROBE_UB == 16
        asm volatile("v_max_f32 %0, %0, %16\n\tv_max_f32 %1, %1, %16\n\tv_max_f32 %2, %2, %16\n\tv_max_f32 %3, %3, %16\n\tv_max_f32 %4, %4, %16\n\tv_max_f32 %5, %5, %16\n\tv_max_f32 %6, %6, %16\n\tv_max_f32 %7, %7, %16\n\tv_max_f32 %8, %8, %16\n\tv_max_f32 %9, %9, %16\n\tv_max_f32 %10, %10, %16\n\tv_max_f32 %11, %11, %16\n\tv_max_f32 %12, %12, %16\n\tv_max_f32 %13, %13, %16\n\tv_max_f32 %14, %14, %16\n\tv_max_f32 %15, %15, %16\n\t" : "+v"(r[0]), "+v"(r[1]), "+v"(r[2]), "+v"(r[3]), "+v"(r[4]), "+v"(r[5]), "+v"(r[6]), "+v"(r[7]), "+v"(r[8]), "+v"(r[9]), "+v"(r[10]), "+v"(r[11]), "+v"(r[12]), "+v"(r[13]), "+v"(r[14]), "+v"(r[15]) : "v"(a), "v"(b) : "s40", "s41", "vcc");
        asm volatile("v_max_f32 %0, %0, %16\n\tv_max_f32 %1, %1, %16\n\tv_max_f32 %2, %2, %16\n\tv_max_f32 %3, %3, %16\n\tv_max_f32 %4, %4, %16\n\tv_max_f32 %5, %5, %16\n\tv_max_f32 %6, %6, %16\n\tv_max_f32 %7, %7, %16\n\tv_max_f32 %8, %8, %16\n\tv_max_f32 %9, %9, %16\n\tv_max_f32 %10, %10, %16\n\tv_max_f32 %11, %11, %16\n\tv_max_f32 %12, %12, %16\n\tv_max_f32 %13, %13, %16\n\tv_max_f32 %14, %14, %16\n\tv_max_f32 %15, %15, %16\n\t" : "+v"(r[0]), "+v"(r[1]), "+v"(r[2]), "+v"(r[3]), "+v"(r[4]), "+v"(r[5]), "+v"(r[6]), "+v"(r[7]), "+v"(r[8]), "+v"(r[9]), "+v"(r[10]), "+v"(r[11]), "+v"(r[12]), "+v"(r[13]), "+v"(r[14]), "+v"(r[15]) : "v"(a), "v"(b) : "s40", "s41", "vcc");
#endif
#if PROBE_UB == 17
        asm volatile("v_cndmask_b32 %0, %0, %16, s[40:41]\n\tv_cndmask_b32 %1, %1, %16, s[40:41]\n\tv_cndmask_b32 %2, %2, %16, s[40:41]\n\tv_cndmask_b32 %3, %3, %16, s[40:41]\n\tv_cndmask_b32 %4, %4, %16, s[40:41]\n\tv_cndmask_b32 %5, %5, %16, s[40:41]\n\tv_cndmask_b32 %6, %6, %16, s[40:41]\n\tv_cndmask_b32 %7, %7, %16, s[40:41]\n\tv_cndmask_b32 %8, %8, %16, s[40:41]\n\tv_cndmask_b32 %9, %9, %16, s[40:41]\n\tv_cndmask_b32 %10, %10, %16, s[40:41]\n\tv_cndmask_b32 %11, %11, %16, s[40:41]\n\tv_cndmask_b32 %12, %12, %16, s[40:41]\n\tv_cndmask_b32 %13, %13, %16, s[40:41]\n\tv_cndmask_b32 %14, %14, %16, s[40:41]\n\tv_cndmask_b32 %15, %15, %16, s[40:41]\n\t" : "+v"(r[0]), "+v"(r[1]), "+v"(r[2]), "+v"(r[3]), "+v"(r[4]), "+v"(r[5]), "+v"(r[6]), "+v"(r[7]), "+v"(r[8]), "+v"(r[9]), "+v"(r[10]), "+v"(r[11]), "+v"(r[12]), "+v"(r[13]), "+v"(r[14]), "+v"(r[15]) : "v"(a), "v"(b) : "s40", "s41", "vcc");
        asm volatile("v_cndmask_b32 %0, %0, %16, s[40:41]\n\tv_cndmask_b32 %1, %1, %16, s[40:41]\n\tv_cndmask_b32 %2, %2, %16, s[40:41]\n\tv_cndmask_b32 %3, %3, %16, s[40:41]\n\tv_cndmask_b32 %4, %4, %16, s[40:41]\n\tv_cndmask_b32 %5, %5, %16, s[40:41]\n\tv_cndmask_b32 %6, %6, %16, s[40:41]\n\tv_cndmask_b32 %7, %7, %16, s[40:41]\n\tv_cndmask_b32 %8, %8, %16, s[40:41]\n\tv_cndmask_b32 %9, %9, %16, s[40:41]\n\tv_cndmask_b32 %10, %10, %16, s[40:41]\n\tv_cndmask_b32 %11, %11, %16, s[40:41]\n\tv_cndmask_b32 %12, %12, %16, s[40:41]\n\tv_cndmask_b32 %13, %13, %16, s[40:41]\n\tv_cndmask_b32 %14, %14, %16, s[40:41]\n\tv_cndmask_b32 %15, %15, %16, s[40:41]\n\t" : "+v"(r[0]), "+v"(r[1]), "+v"(r[2]), "+v"(r[3]), "+v"(r[4]), "+v"(r[5]), "+v"(r[6]), "+v"(r[7]), "+v"(r[8]), "+v"(r[9]), "+v"(r[10]), "+v"(r[11]), "+v"(r[12]), "+v"(r[13]), "+v"(r[14]), "+v"(r[15]) : "v"(a), "v"(b) : "s40", "s41", "vcc");
#endif
#if PROBE_UB == 18
        asm volatile("v_min_u32 %0, %0, %16\n\tv_min_u32 %1, %1, %16\n\tv_min_u32 %2, %2, %16\n\tv_min_u32 %3, %3, %16\n\tv_min_u32 %4, %4, %16\n\tv_min_u32 %5, %5, %16\n\tv_min_u32 %6, %6, %16\n\tv_min_u32 %7, %7, %16\n\tv_min_u32 %8, %8, %16\n\tv_min_u32 %9, %9, %16\n\tv_min_u32 %10, %10, %16\n\tv_min_u32 %11, %11, %16\n\tv_min_u32 %12, %12, %16\n\tv_min_u32 %13, %13, %16\n\tv_min_u32 %14, %14, %16\n\tv_min_u32 %15, %15, %16\n\t" : "+v"(r[0]), "+v"(r[1]), "+v"(r[2]), "+v"(r[3]), "+v"(r[4]), "+v"(r[5]), "+v"(r[6]), "+v"(r[7]), "+v"(r[8]), "+v"(r[9]), "+v"(r[10]), "+v"(r[11]), "+v"(r[12]), "+v"(r[13]), "+v"(r[14]), "+v"(r[15]) : "v"(a), "v"(b) : "s40", "s41", "vcc");
        asm volatile("v_min_u32 %0, %0, %16\n\tv_min_u32 %1, %1, %16\n\tv_min_u32 %2, %2, %16\n\tv_min_u32 %3, %3, %16\n\tv_min_u32 %4, %4, %16\n\tv_min_u32 %5, %5, %16\n\tv_min_u32 %6, %6, %16\n\tv_min_u32 %7, %7, %16\n\tv_min_u32 %8, %8, %16\n\tv_min_u32 %9, %9, %16\n\tv_min_u32 %10, %10, %16\n\tv_min_u32 %11, %11, %16\n\tv_min_u32 %12, %12, %16\n\tv_min_u32 %13, %13, %16\n\tv_min_u32 %14, %14, %16\n\tv_min_u32 %15, %15, %16\n\t" : "+v"(r[0]), "+v"(r[1]), "+v"(r[2]), "+v"(r[3]), "+v"(r[4]), "+v"(r[5]), "+v"(r[6]), "+v"(r[7]), "+v"(r[8]), "+v"(r[9]), "+v"(r[10]), "+v"(r[11]), "+v"(r[12]), "+v"(r[13]), "+v"(r[14]), "+v"(r[15]) : "v"(a), "v"(b) : "s40", "s41", "vcc");
#endif
#if PROBE_UB == 19
        asm volatile("v_and_b32 %0, %0, %16\n\tv_and_b32 %1, %1, %16\n\tv_and_b32 %2, %2, %16\n\tv_and_b32 %3, %3, %16\n\tv_and_b32 %4, %4, %16\n\tv_and_b32 %5, %5, %16\n\tv_and_b32 %6, %6, %16\n\tv_and_b32 %7, %7, %16\n\tv_and_b32 %8, %8, %16\n\tv_and_b32 %9, %9, %16\n\tv_and_b32 %10, %10, %16\n\tv_and_b32 %11, %11, %16\n\tv_and_b32 %12, %12, %16\n\tv_and_b32 %13, %13, %16\n\tv_and_b32 %14, %14, %16\n\tv_and_b32 %15, %15, %16\n\t" : "+v"(r[0]), "+v"(r[1]), "+v"(r[2]), "+v"(r[3]), "+v"(r[4]), "+v"(r[5]), "+v"(r[6]), "+v"(r[7]), "+v"(r[8]), "+v"(r[9]), "+v"(r[10]), "+v"(r[11]), "+v"(r[12]), "+v"(r[13]), "+v"(r[14]), "+v"(r[15]) : "v"(a), "v"(b) : "s40", "s41", "vcc");
        asm volatile("v_and_b32 %0, %0, %16\n\tv_and_b32 %1, %1, %16\n\tv_and_b32 %2, %2, %16\n\tv_and_b32 %3, %3, %16\n\tv_and_b32 %4, %4, %16\n\tv_and_b32 %5, %5, %16\n\tv_and_b32 %6, %6, %16\n\tv_and_b32 %7, %7, %16\n\tv_and_b32 %8, %8, %16\n\tv_and_b32 %9, %9, %16\n\tv_and_b32 %10, %10, %16\n\tv_and_b32 %11, %11, %16\n\tv_and_b32 %12, %12, %16\n\tv_and_b32 %13, %13, %16\n\tv_and_b32 %14, %14, %16\n\tv_and_b32 %15, %15, %16\n\t" : "+v"(r[0]), "+v"(r[1]), "+v"(r[2]), "+v"(r[3]), "+v"(r[4]), "+v"(r[5]), "+v"(r[6]), "+v"(r[7]), "+v"(r[8]), "+v"(r[9]), "+v"(r[10]), "+v"(r[11]), "+v"(r[12]), "+v"(r[13]), "+v"(r[14]), "+v"(r[15]) : "v"(a), "v"(b) : "s40", "s41", "vcc");
#endif
#if PROBE_UB == 20
        asm volatile("v_lshrrev_b32 %0, 4, %0\n\tv_lshrrev_b32 %1, 4, %1\n\tv_lshrrev_b32 %2, 4, %2\n\tv_lshrrev_b32 %3, 4, %3\n\tv_lshrrev_b32 %4, 4, %4\n\tv_lshrrev_b32 %5, 4, %5\n\tv_lshrrev_b32 %6, 4, %6\n\tv_lshrrev_b32 %7, 4, %7\n\tv_lshrrev_b32 %8, 4, %8\n\tv_lshrrev_b32 %9, 4, %9\n\tv_lshrrev_b32 %10, 4, %10\n\tv_lshrrev_b32 %11, 4, %11\n\tv_lshrrev_b32 %12, 4, %12\n\tv_lshrrev_b32 %13, 4, %13\n\tv_lshrrev_b32 %14, 4, %14\n\tv_lshrrev_b32 %15, 4, %15\n\t" : "+v"(r[0]), "+v"(r[1]), "+v"(r[2]), "+v"(r[3]), "+v"(r[4]), "+v"(r[5]), "+v"(r[6]), "+v"(r[7]), "+v"(r[8]), "+v"(r[9]), "+v"(r[10]), "+v"(r[11]), "+v"(r[12]), "+v"(r[13]), "+v"(r[14]), "+v"(r[15]) : "v"(a), "v"(b) : "s40", "s41", "vcc");
        asm volatile("v_lshrrev_b32 %0, 4, %0\n\tv_lshrrev_b32 %1, 4, %1\n\tv_lshrrev_b32 %2, 4, %2\n\tv_lshrrev_b32 %3, 4, %3\n\tv_lshrrev_b32 %4, 4, %4\n\tv_lshrrev_b32 %5, 4, %5\n\tv_lshrrev_b32 %6, 4, %6\n\tv_lshrrev_b32 %7, 4, %7\n\tv_lshrrev_b32 %8, 4, %8\n\tv_lshrrev_b32 %9, 4, %9\n\tv_lshrrev_b32 %10, 4, %10\n\tv_lshrrev_b32 %11, 4, %11\n\tv_lshrrev_b32 %12, 4, %12\n\tv_lshrrev_b32 %13, 4, %13\n\tv_lshrrev_b32 %14, 4, %14\n\tv_lshrrev_b32 %15, 4, %15\n\t" : "+v"(r[0]), "+v"(r[1]), "+v"(r[2]), "+v"(r[3]), "+v"(r[4]), "+v"(r[5]), "+v"(r[6]), "+v"(r[7]), "+v"(r[8]), "+v"(r[9]), "+v"(r[10]), "+v"(r[11]), "+v"(r[12]), "+v"(r[13]), "+v"(r[14]), "+v"(r[15]) : "v"(a), "v"(b) : "s40", "s41", "vcc");
#endif
#if PROBE_UB == 21
        asm volatile("v_mul_f32 %0, %0, %16\n\tv_mul_f32 %1, %1, %16\n\tv_mul_f32 %2, %2, %16\n\tv_mul_f32 %3, %3, %16\n\tv_mul_f32 %4, %4, %16\n\tv_mul_f32 %5, %5, %16\n\tv_mul_f32 %6, %6, %16\n\tv_mul_f32 %7, %7, %16\n\tv_mul_f32 %8, %8, %16\n\tv_mul_f32 %9, %9, %16\n\tv_mul_f32 %10, %10, %16\n\tv_mul_f32 %11, %11, %16\n\tv_mul_f32 %12, %12, %16\n\tv_mul_f32 %13, %13, %16\n\tv_mul_f32 %14, %14, %16\n\tv_mul_f32 %15, %15, %16\n\t" : "+v"(r[0]), "+v"(r[1]), "+v"(r[2]), "+v"(r[3]), "+v"(r[4]), "+v"(r[5]), "+v"(r[6]), "+v"(r[7]), "+v"(r[8]), "+v"(r[9]), "+v"(r[10]), "+v"(r[11]), "+v"(r[12]), "+v"(r[13]), "+v"(r[14]), "+v"(r[15]) : "v"(a), "v"(b) : "s40", "s41", "vcc");
        asm volatile("v_mul_f32 %0, %0, %16\n\tv_mul_f32 %1, %1, %16\n\tv_mul_f32 %2, %2, %16\n\tv_mul_f32 %3, %3, %16\n\tv_mul_f32 %4, %4, %16\n\tv_mul_f32 %5, %5, %16\n\tv_mul_f32 %6, %6, %16\n\tv_mul_f32 %7, %7, %16\n\tv_mul_f32 %8, %8, %16\n\tv_mul_f32 %9, %9, %16\n\tv_mul_f32 %10, %10, %16\n\tv_mul_f32 %11, %11, %16\n\tv_mul_f32 %12, %12, %16\n\tv_mul_f32 %13, %13, %16\n\tv_mul_f32 %14, %14, %16\n\tv_mul_f32 %15, %15, %16\n\t" : "+v"(r[0]), "+v"(r[1]), "+v"(r[2]), "+v"(r[3]), "+v"(r[4]), "+v"(r[5]), "+v"(r[6]), "+v"(r[7]), "+v"(r[8]), "+v"(r[9]), "+v"(r[10]), "+v"(r[11]), "+v"(r[12]), "+v"(r[13]), "+v"(r[14]), "+v"(r[15]) : "v"(a), "v"(b) : "s40", "s41", "vcc");
#endif
#if PROBE_UB == 22
        asm volatile("v_add_u32 %0, %0, %16\n\tv_add_u32 %1, %1, %16\n\tv_add_u32 %2, %2, %16\n\tv_add_u32 %3, %3, %16\n\tv_add_u32 %4, %4, %16\n\tv_add_u32 %5, %5, %16\n\tv_add_u32 %6, %6, %16\n\tv_add_u32 %7, %7, %16\n\tv_add_u32 %8, %8, %16\n\tv_add_u32 %9, %9, %16\n\tv_add_u32 %10, %10, %16\n\tv_add_u32 %11, %11, %16\n\tv_add_u32 %12, %12, %16\n\tv_add_u32 %13, %13, %16\n\tv_add_u32 %14, %14, %16\n\tv_add_u32 %15, %15, %16\n\t" : "+v"(r[0]), "+v"(r[1]), "+v"(r[2]), "+v"(r[3]), "+v"(r[4]), "+v"(r[5]), "+v"(r[6]), "+v"(r[7]), "+v"(r[8]), "+v"(r[9]), "+v"(r[10]), "+v"(r[11]), "+v"(r[12]), "+v"(r[13]), "+v"(r[14]), "+v"(r[15]) : "v"(a), "v"(b) : "s40", "s41", "vcc");
        asm volatile("v_add_u32 %0, %0, %16\n\tv_add_u32 %1, %1, %16\n\tv_add_u32 %2, %2, %16\n\tv_add_u32 %3, %3, %16\n\tv_add_u32 %4, %4, %16\n\tv_add_u32 %5, %5, %16\n\tv_add_u32 %6, %6, %16\n\tv_add_u32 %7, %7, %16\n\tv_add_u32 %8, %8, %16\n\tv_add_u32 %9, %9, %16\n\tv_add_u32 %10, %10, %16\n\tv_add_u32 %11, %11, %16\n\tv_add_u32 %12, %12, %16\n\tv_add_u32 %13, %13, %16\n\tv_add_u32 %14, %14, %16\n\tv_add_u32 %15, %15, %16\n\t" : "+v"(r[0]), "+v"(r[1]), "+v"(r[2]), "+v"(r[3]), "+v"(r[4]), "+v"(r[5]), "+v"(r[6]), "+v"(r[7]), "+v"(r[8]), "+v"(r[9]), "+v"(r[10]), "+v"(r[11]), "+v"(r[12]), "+v"(r[13]), "+v"(r[14]), "+v"(r[15]) : "v"(a), "v"(b) : "s40", "s41", "vcc");
#endif
#if PROBE_UB == 23
        asm volatile("v_cvt_pk_bf16_f32 %0, %0, %16\n\tv_cvt_pk_bf16_f32 %1, %1, %16\n\tv_cvt_pk_bf16_f32 %2, %2, %16\n\tv_cvt_pk_bf16_f32 %3, %3, %16\n\tv_cvt_pk_bf16_f32 %4, %4, %16\n\tv_cvt_pk_bf16_f32 %5, %5, %16\n\tv_cvt_pk_bf16_f32 %6, %6, %16\n\tv_cvt_pk_bf16_f32 %7, %7, %16\n\tv_cvt_pk_bf16_f32 %8, %8, %16\n\tv_cvt_pk_bf16_f32 %9, %9, %16\n\tv_cvt_pk_bf16_f32 %10, %10, %16\n\tv_cvt_pk_bf16_f32 %11, %11, %16\n\tv_cvt_pk_bf16_f32 %12, %12, %16\n\tv_cvt_pk_bf16_f32 %13, %13, %16\n\tv_cvt_pk_bf16_f32 %14, %14, %16\n\tv_cvt_pk_bf16_f32 %15, %15, %16\n\t" : "+v"(r[0]), "+v"(r[1]), "+v"(r[2]), "+v"(r[3]), "+v"(r[4]), "+v"(r[5]), "+v"(r[6]), "+v"(r[7]), "+v"(r[8]), "+v"(r[9]), "+v"(r[10]), "+v"(r[11]), "+v"(r[12]), "+v"(r[13]), "+v"(r[14]), "+v"(r[15]) : "v"(a), "v"(b) : "s40", "s41", "vcc");
        asm volatile("v_cvt_pk_bf16_f32 %0, %0, %16\n\tv_cvt_pk_bf16_f32 %1, %1, %16\n\tv_cvt_pk_bf16_f32 %2, %2, %16\n\tv_cvt_pk_bf16_f32 %3, %3, %16\n\tv_cvt_pk_bf16_f32 %4, %4, %16\n\tv_cvt_pk_bf16_f32 %5, %5, %16\n\tv_cvt_pk_bf16_f32 %6, %6, %16\n\tv_cvt_pk_bf16_f32 %7, %7, %16\n\tv_cvt_pk_bf16_f32 %8, %8, %16\n\tv_cvt_pk_bf16_f32 %9, %9, %16\n\tv_cvt_pk_bf16_f32 %10, %10, %16\n\tv_cvt_pk_bf16_f32 %11, %11, %16\n\tv_cvt_pk_bf16_f32 %12, %12, %16\n\tv_cvt_pk_bf16_f32 %13, %13, %16\n\tv_cvt_pk_bf16_f32 %14, %14, %16\n\tv_cvt_pk_bf16_f32 %15, %15, %16\n\t" : "+v"(r[0]), "+v"(r[1]), "+v"(r[2]), "+v"(r[3]), "+v"(r[4]), "+v"(r[5]), "+v"(r[6]), "+v"(r[7]), "+v"(r[8]), "+v"(r[9]), "+v"(r[10]), "+v"(r[11]), "+v"(r[12]), "+v"(r[13]), "+v"(r[14]), "+v"(r[15]) : "v"(a), "v"(b) : "s40", "s41", "vcc");
#endif
    }
    float s = 0.f;
#pragma unroll
    for (int i = 0; i < 16; ++i) s += r[i];
#pragma unroll
    for (int i = 0; i < 8; ++i) s += r2[i].x + r2[i].y;
    if (s == 1.2345e-33f) asm volatile("s_nop 0" ::: "memory");
}
#endif
__device__ __forceinline__ void phase_mod(const Params& p, LAS unsigned char* lds, int wv) {
    const int tid = tid_opaque(wv);
    LAS float* sc = (LAS float*)lds;
    LAS float* red = (LAS float*)(lds + 32768);
    for (int i = tid; i < BATCH * D_MODEL; i += 512) { const int b = i >> 10, k = i & 1023; const float v = p.c[i]; sc[k * 8 + b] = v / (1.0f + __expf(-v)); }
    __syncthreads();
    const int kg = tid >> 5, cl = tid & 31;
    for (int u = blockIdx.x; u < DEPTH * 64; u += gridDim.x) {
        const int l = u >> 6, j0 = (u & 63) * 96;
        const float* w = p.w_mod + (size_t)l * D_MODEL * MODW + (size_t)(kg * 64) * MODW + j0 + cl;
        float acc[3][8];
#pragma unroll
        for (int q = 0; q < 3; ++q)
#pragma unroll
            for (int b = 0; b < 8; ++b) acc[q][b] = 0.f;
#pragma unroll 4
        for (int kk = 0; kk < 64; ++kk) {
            const float w0 = w[(size_t)kk * MODW], w1 = w[(size_t)kk * MODW + 32], w2 = w[(size_t)kk * MODW + 64];
            const f32x4 s0 = *(const LAS f32x4*)(sc + (kg * 64 + kk) * 8), s1 = *(const LAS f32x4*)(sc + (kg * 64 + kk) * 8 + 4);
#pragma unroll
            for (int b = 0; b < 4; ++b) { acc[0][b] += s0[b] * w0; acc[1][b] += s0[b] * w1; acc[2][b] += s0[b] * w2; acc[0][4 + b] += s1[b] * w0; acc[1][4 + b] += s1[b] * w1; acc[2][4 + b] += s1[b] * w2; }
        }
#pragma unroll
        for (int q = 0; q < 3; ++q)
#pragma unroll
            for (int b = 0; b < 8; ++b) red[((kg * 3 + q) * 8 + b) * 32 + cl] = acc[q][b];
        __syncthreads();
        for (int o = tid; o < 768; o += 512) {
            float s = 0.f;
#pragma unroll
            for (int g = 0; g < 16; ++g) s += red[g * 768 + o];
            const int ocl = o & 31, ob = (o >> 5) & 7, oq = o >> 8;
            const int j = j0 + oq * 32 + ocl;
            p.mod()[((size_t)l * BATCH + ob) * MODW + j] = s + p.b_mod[(size_t)l * MODW + j];
        }
        __syncthreads();
    }
}

__device__ __forceinline__ void phase_biasq(const Params& p, int l, int wv) {
    const int tid = tid_opaque(wv), wave = tid >> 6, lane = tid & 63;
    for (int n = blockIdx.x * NWAVES + wave; n < 2048; n += gridDim.x * NWAVES) {
        const bf16_t* wr = p.WqT() + ((size_t)l * 2048 + n) * D_MODEL + lane * 16;
        const u32x4 w0 = *(const u32x4*)wr, w1 = *(const u32x4*)(wr + 8);
        float w[16];
#pragma unroll
        for (int e = 0; e < 4; ++e) { w[2 * e] = bflo(w0[e]); w[2 * e + 1] = bfhi(w0[e]); w[8 + 2 * e] = bflo(w1[e]); w[8 + 2 * e + 1] = bfhi(w1[e]); }
#pragma unroll 1
        for (int b = 0; b < BATCH; ++b) {
            const float* sh = p.mod() + ((size_t)l * BATCH + b) * MODW + 3 * D_MODEL + lane * 16;
            float s = 0.f;
#pragma unroll
            for (int q = 0; q < 4; ++q) { const f32x4 v = *(const f32x4*)(sh + 4 * q); s += v[0] * w[4 * q] + v[1] * w[4 * q + 1] + v[2] * w[4 * q + 2] + v[3] * w[4 * q + 3]; }
            s = wave_sum(s);
            if (lane == 0) p.biasq()[((size_t)l * BATCH + b) * 2048 + n] = s;
        }
    }
}

#ifndef PROBE_TIME
#define PROBE_TIME 0
#endif
#if PROBE_TIME || PROBE_UB
#define PT_BEGIN(k) do { if ((k) == PROBE_TIME) pt_t0 = __builtin_amdgcn_s_memrealtime(); } while (0)
#define PT_END(k) do { if ((k) == PROBE_TIME) pt_acc += __builtin_amdgcn_s_memrealtime() - pt_t0; } while (0)
#else
#define PT_BEGIN(k) do { } while (0)
#define PT_END(k) do { } while (0)
#endif
__global__ void __launch_bounds__(512, 2) k_mega(Params p) {
    extern __shared__ __attribute__((aligned(16))) unsigned char smem_raw[];
    LAS unsigned char* lds = (LAS unsigned char*)smem_raw;
    volatile LAS unsigned* xbw = (volatile LAS unsigned*)(lds + LDS_BYTES - 16);
    const int wv = __builtin_amdgcn_readfirstlane((int)threadIdx.x >> 6);
    if (threadIdx.x == 0) { xbw[0] = 0u; xbw[1] = 0u; xbw[2] = 0u; xbw[3] = 0u; }
    __syncthreads();
    (void)xcd_barrier_post(p.bar(), xbw);
#define GRID_SYNC_AT(k) do { PT_BEGIN(30 + (k)); GRID_SYNC(); PT_END(30 + (k)); } while (0)
#define GRID_SYNC() do { XcdBarrier _b; _b.bar = p.bar(); _b.x = xb_xcc_id(); _b.st = (volatile LAS unsigned*)(lds + LDS_BYTES - 16); _b.t0 = (tid_opaque(wv) == 0); PT_BEGIN(20); xcd_barrier(_b); PT_END(20); } while (0)
#if PROBE_TIME || PROBE_UB
    unsigned long long pt_t0 = 0, pt_acc = 0;
#endif
#if PROBE_UB
    { GRID_SYNC(); const unsigned long long u0 = __builtin_amdgcn_s_memrealtime(); ubench(4000, (unsigned)blockIdx.x); pt_acc += __builtin_amdgcn_s_memrealtime() - u0; GRID_SYNC(); }
#endif
#if PROBE_MASK & 32
    for (int rep = 0; rep < 20; ++rep) GRID_SYNC();
#endif
    PT_BEGIN(1);
    for (int rep = 0; rep < ((PROBE_MASK & 8) ? 2 : 1); ++rep) { phase_mod(p, lds, wv); phase_convert(p, lds, wv); }
    GRID_SYNC();
    PT_END(1); PT_BEGIN(2);
    phase_norm(p, p.x_in, p.norm1_g, p.mod(), 0, 1, wv);
    GRID_SYNC();
    PT_END(2);
    for (int l = 0; l < DEPTH; ++l) {
        const float* modl = p.mod() + (size_t)l * BATCH * MODW;
        PT_BEGIN(3);
        for (int rep = 0; rep < ((PROBE_MASK & 1) ? 2 : 1); ++rep) { EpiStoreBf16 E; E.O = p.pb(); E.ldc = MIX_IN; run_gemm(lds, p.hb(), p.WinT() + (size_t)l * MIX_IN * D_MODEL, NTOK, MIX_IN, D_MODEL, E, wv); }
        convert_in_gemm1_slack(p, l, lds, wv);
        GRID_SYNC_AT(2);
        PT_END(3); PT_BEGIN(4); PT_BEGIN(10);
        for (int rep = 0; rep < ((PROBE_MASK & 2) ? 2 : 1); ++rep) phase_attn(p, l, lds, wv);
        PT_END(10);
        for (int rep = 0; rep < ((PROBE_MASK & 16) ? 2 : 1); ++rep) phase_mixrest(p, l, lds, wv);
        phase_biasq(p, l, wv);
        GRID_SYNC_AT(3);
        PT_END(4); PT_BEGIN(5);
        if (l == 0) { EpiResidNorm<true> E; E.xin32 = p.x_in; E.xin16 = nullptr; E.xout = p.xb(); E.modl = modl; E.n2g = p.norm2_g + l * D_MODEL; E.hb = p.hb(); E.ssq = p.ssq();
          run_gemm(lds, p.cat(), p.WoutT() + (size_t)l * D_MODEL * D_MODEL, NTOK, D_MODEL, D_MODEL, E, wv); }
        else { EpiResidNorm<false> E; E.xin32 = nullptr; E.xin16 = p.xb(); E.xout = p.xb(); E.modl = modl; E.n2g = p.norm2_g + l * D_MODEL; E.hb = p.hb(); E.ssq = p.ssq();
          run_gemm(lds, p.cat(), p.WoutT() + (size_t)l * D_MODEL * D_MODEL, NTOK, D_MODEL, D_MODEL, E, wv); }
        GRID_SYNC_AT(4);
        PT_END(5);
        PT_BEGIN(7);
        for (int rep = 0; rep < ((PROBE_MASK & 1) ? 2 : 1); ++rep) { EpiQ E; E.O = p.qb(); E.ssq = p.ssq(); E.biasq = p.biasq() + (size_t)l * BATCH * 2048; run_gemm(lds, p.hb(), p.WqT() + (size_t)l * 2048 * D_MODEL, NTOK, 2048, D_MODEL, E, wv); }
        GRID_SYNC_AT(5);
        PT_END(7); PT_BEGIN(8);
        for (int rep = 0; rep < ((PROBE_MASK & 4) ? 2 : 1); ++rep) phase_topk(p, l, lds, wv);
        GRID_SYNC_AT(6);
        PT_END(8); PT_BEGIN(9); PT_BEGIN(11);
        PT_BEGIN(12);
        if (PROBE_SYNTH) phase_expert(p, l, false, lds, wv, PROBE_SYNTH, true);
        PT_END(12);
        phase_expert(p, l, l == DEPTH - 1, lds, wv);
        PT_END(11);
        GRID_SYNC_AT(7);
        PT_END(9);
    }
#if PROBE_TIME || PROBE_UB
    if (blockIdx.x == PROBE_BLOCK) {
        const unsigned long long t1 = __builtin_amdgcn_s_memrealtime();
        while (__builtin_amdgcn_s_memrealtime() - t1 < 4ull * pt_acc) __builtin_amdgcn_s_sleep(8);
    }
#endif
}
#if MK_MULTI
enum { PH_CONVERT = 0, PH_NORM1, PH_GEMM1, PH_GEMM2, PH_NORM2, PH_GEMM3, PH_MOD };
template <int PH>
__global__ void __launch_bounds__(512, 2) k_ph(Params p, int l) {
    extern __shared__ __attribute__((aligned(16))) unsigned char smem_raw[];
    LAS unsigned char* lds = (LAS unsigned char*)smem_raw;
    const int wv = __builtin_amdgcn_readfirstlane((int)threadIdx.x >> 6);
    const float* modl = p.mod() + (size_t)l * BATCH * MODW;
    if (PH == PH_CONVERT) phase_convert(p, lds, wv);
    if (PH == PH_MOD) phase_mod(p, lds, wv);
    if (PH == PH_NORM1) phase_norm(p, l == 0 ? p.x_in : p.xb(), p.norm1_g + l * D_MODEL, modl, 0, 1, wv);
    if (PH == PH_GEMM1) { EpiStoreBf16 E; E.O = p.pb(); E.ldc = MIX_IN; run_gemm(lds, p.hb(), p.WinT() + (size_t)l * MIX_IN * D_MODEL, NTOK, MIX_IN, D_MODEL, E, wv); }
    if (PH == PH_GEMM2) { EpiResid E; E.xin = (l == 0) ? p.x_in : p.xb(); E.xout = p.xb(); E.gate = modl + 2 * D_MODEL; run_gemm(lds, p.cat(), p.WoutT() + (size_t)l * D_MODEL * D_MODEL, NTOK, D_MODEL, D_MODEL, E, wv); }
    if (PH == PH_NORM2) phase_norm(p, p.xb(), p.norm2_g + l * D_MODEL, modl, 3, 4, wv);
    if (PH == PH_GEMM3) { EpiStoreBf16 E; E.O = p.qb(); E.ldc = 2048; run_gemm(lds, p.hb(), p.WqT() + (size_t)l * 2048 * D_MODEL, NTOK, 2048, D_MODEL, E, wv); }
}

#endif

extern "C" void kernel_launch(void* const* d_in, const int* in_sizes, int n_in, void* d_out, int out_size, void* d_ws, size_t ws_size, hipStream_t stream) {
    Params p{};
    p.x_in = (const float*)d_in[0]; p.c = (const float*)d_in[1]; p.rel_bias = (const float*)d_in[2]; p.w_mod = (const float*)d_in[3]; p.b_mod = (const float*)d_in[4];
    p.norm1_g = (const float*)d_in[5]; p.norm2_g = (const float*)d_in[6]; p.w_in = (const float*)d_in[7]; p.w_out = (const float*)d_in[8]; p.diff_lambda = (const float*)d_in[9];
    p.subln_g = (const float*)d_in[10]; p.conf_dw = (const float*)d_in[11]; p.conf_ln_g = (const float*)d_in[12]; p.conf_ln_b = (const float*)d_in[13]; p.sconv_w = (const float*)d_in[14];
    p.sgu_ln_g = (const float*)d_in[15]; p.sgu_ln_b = (const float*)d_in[16]; p.sgu_w = (const float*)d_in[17]; p.sgu_b = (const float*)d_in[18]; p.peer_wq = (const float*)d_in[19];
    p.peer_keys = (const float*)d_in[20]; p.peer_u = (const float*)d_in[21]; p.peer_v = (const float*)d_in[22]; p.final_g = (const float*)d_in[23];
    p.out = (float*)d_out;
    for (int l = 0; l < DEPTH; ++l) p.lam_init[l] = (float)(0.8 - 0.6 * exp(-0.3 * (double)l));

    p.ws = (unsigned char*)d_ws;
    if (ws_size < WS_END) { fprintf(stderr, "kernel_launch: workspace too small\n"); return; }

    static int grid = 0;
    if (grid == 0) {
        int dev = 0, cus = 0;
        if (hipGetDevice(&dev) != hipSuccess || hipDeviceGetAttribute(&cus, hipDeviceAttributeMultiprocessorCount, dev) != hipSuccess) { grid = -1; return; }
        bool ok = true;
#if MK_MULTI
        ok &= hipFuncSetAttribute((const void*)k_ph<PH_CONVERT>, hipFuncAttributeMaxDynamicSharedMemorySize, LDS_BYTES) == hipSuccess;
        ok &= hipFuncSetAttribute((const void*)k_ph<PH_NORM1>, hipFuncAttributeMaxDynamicSharedMemorySize, LDS_BYTES) == hipSuccess;
        ok &= hipFuncSetAttribute((const void*)k_ph<PH_GEMM1>, hipFuncAttributeMaxDynamicSharedMemorySize, LDS_BYTES) == hipSuccess;
        ok &= hipFuncSetAttribute((const void*)k_ph<PH_GEMM2>, hipFuncAttributeMaxDynamicSharedMemorySize, LDS_BYTES) == hipSuccess;
        ok &= hipFuncSetAttribute((const void*)k_ph<PH_NORM2>, hipFuncAttributeMaxDynamicSharedMemorySize, LDS_BYTES) == hipSuccess;
        ok &= hipFuncSetAttribute((const void*)k_ph<PH_GEMM3>, hipFuncAttributeMaxDynamicSharedMemorySize, LDS_BYTES) == hipSuccess;
        ok &= hipFuncSetAttribute((const void*)k_ph<PH_MOD>, hipFuncAttributeMaxDynamicSharedMemorySize, LDS_BYTES) == hipSuccess;
        ok &= hipFuncSetAttribute((const void*)k_attn2<0>, hipFuncAttributeMaxDynamicSharedMemorySize, LDS_BYTES) == hipSuccess;
        ok &= hipFuncSetAttribute((const void*)k_topk<0>, hipFuncAttributeMaxDynamicSharedMemorySize, LDS_BYTES) == hipSuccess;
        ok &= hipFuncSetAttribute((const void*)k_mixrest<0>, hipFuncAttributeMaxDynamicSharedMemorySize, LDS_BYTES) == hipSuccess;
        ok &= hipFuncSetAttribute((const void*)k_expert, hipFuncAttributeMaxDynamicSharedMemorySize, LDS_BYTES) == hipSuccess;
#else
        ok &= hipFuncSetAttribute((const void*)k_mega, hipFuncAttributeMaxDynamicSharedMemorySize, LDS_BYTES) == hipSuccess;
#endif
        if (!ok) { fprintf(stderr, "kernel_launch: hipFuncSetAttribute failed\n"); grid = -1; return; }
        grid = cus;
    }
    if (grid < 0) return;
    const int G = grid;
#if MK_MULTI
    k_ph<PH_MOD><<<G, 512, LDS_BYTES, stream>>>(p, 0);
    k_ph<PH_CONVERT><<<G, 512, LDS_BYTES, stream>>>(p, 0);
    for (int l = 0; l < DEPTH; ++l) {
        if (l == 0) k_ph<PH_NORM1><<<G, 512, LDS_BYTES, stream>>>(p, l);
        k_ph<PH_GEMM1><<<G, 512, LDS_BYTES, stream>>>(p, l);
        k_attn2<0><<<G, 512, LDS_BYTES, stream>>>(p, l);
        k_mixrest<0><<<G, 512, LDS_BYTES, stream>>>(p, l);
        k_ph<PH_GEMM2><<<G, 512, LDS_BYTES, stream>>>(p, l);
        k_ph<PH_NORM2><<<G, 512, LDS_BYTES, stream>>>(p, l);
        k_ph<PH_GEMM3><<<G, 512, LDS_BYTES, stream>>>(p, l);
        k_topk<0><<<G, 512, LDS_BYTES, stream>>>(p, l);
        k_expert<<<G, 512, LDS_BYTES, stream>>>(p, l);
    }
#else
    (void)hipMemsetAsync(p.ws + OFF_BAR, 0, OFF_MOD - OFF_BAR, stream);
    k_mega<<<G, 512, LDS_BYTES, stream>>>(p);
#endif
}
```

```cpp
#include <hip/hip_runtime.h>
#include <stdint.h>
#include <stdio.h>
#include <math.h>

#define D_MODEL 1024
#define BATCH 8
#define SEQ 2048
#define DEPTH 4
#define NTOK (BATCH * SEQ)
#define MIX_IN 2560
#define N_MOD 6
#define MODW (N_MOD * D_MODEL)
#define NEXP 16384

#define MK_MULTI 0
#define FUSE_TOPK_EXPERT 0
#define EXPERT_MAP_GROUPED 1
#ifndef PROBE_MASK
#define PROBE_MASK 0
#endif
#define PROBE_TIME 0
#define PROBE_SYNTH 0
#define PROBE_UB 0
#define PROBE_BLOCK 0
#define LAS __attribute__((address_space(3)))
typedef unsigned short bf16_t;
typedef short bf16x8 __attribute__((ext_vector_type(8)));
typedef float f32x4 __attribute__((ext_vector_type(4)));
typedef float f32x16 __attribute__((ext_vector_type(16)));
typedef unsigned u32x4 __attribute__((ext_vector_type(4)));
typedef unsigned u32x2 __attribute__((ext_vector_type(2)));
typedef float f32x2 __attribute__((ext_vector_type(2)));

__device__ const unsigned char kBucket[128] = {
    0, 1, 2, 3, 4, 5, 6, 7, 8, 9, 10, 11, 12, 13, 14, 15, 16, 16, 16, 17, 17, 18, 18, 18, 19, 19, 19, 20, 20, 20, 20, 21,
    21, 21, 21, 22, 22, 22, 22, 22, 23, 23, 23, 23, 23, 23, 24, 24, 24, 24, 24, 24, 25, 25, 25, 25, 25, 25, 25, 26, 26, 26, 26, 26,
    26, 26, 26, 27, 27, 27, 27, 27, 27, 27, 27, 27, 27, 28, 28, 28, 28, 28, 28, 28, 28, 28, 28, 29, 29, 29, 29, 29, 29, 29, 29, 29,
    29, 29, 29, 30, 30, 30, 30, 30, 30, 30, 30, 30, 30, 30, 30, 30, 30, 31, 31, 31, 31, 31, 31, 31, 31, 31, 31, 31, 31, 31, 31, 31};

__device__ __forceinline__ float bf2f(bf16_t v) { return __uint_as_float(((unsigned)v) << 16); }
__device__ __forceinline__ float bflo(unsigned w) { return __uint_as_float(w << 16); }
__device__ __forceinline__ float bfhi(unsigned w) { return __uint_as_float(w & 0xFFFF0000u); }
__device__ __forceinline__ bf16_t f2bf(float f) { unsigned u = __float_as_uint(f); u += 0x7FFFu + ((u >> 16) & 1u); return (bf16_t)(u >> 16); }
__device__ __forceinline__ unsigned pk2(float lo, float hi) { unsigned r; asm("v_cvt_pk_bf16_f32 %0, %1, %2" : "=v"(r) : "v"(lo), "v"(hi)); return r; }
__device__ __forceinline__ float ldf(const float* p) { return *p; }
__device__ __forceinline__ float ldf(const bf16_t* p) { return bf2f(*p); }

__device__ __forceinline__ float gelu_as(float v) {
    const float av = fabsf(v), t = __builtin_amdgcn_rcpf(av * 0.2316418882f + 1.0f);
    float q = t * 0.5307027145f + (-0.7265760135f); q = q * t + 0.7107068705f; q = q * t + (-0.142248368f); q = q * t + 0.127414796f; q = q * t;
    const float e = __builtin_amdgcn_exp2f((v * v) * (-0.72134752044f));
    const float m = v * (q * e);
    return v < 0.f ? m : v - m;
}
template <int CTRL, int ROWMASK = 0xF>
__device__ __forceinline__ float dpp_add(float x) {
    const int y = __builtin_amdgcn_update_dpp(0, __float_as_int(x), CTRL, ROWMASK, 0xF, false);
    return x + __int_as_float(y);
}
__device__ __forceinline__ float wave_sum_l63(float v) {
    v = dpp_add<0xB1>(v);
    v = dpp_add<0x4E>(v);
    v = dpp_add<0x141>(v);
    v = dpp_add<0x140>(v);
    v = dpp_add<0x142, 0xA>(v);
    v = dpp_add<0x143, 0xC>(v);
    return v;
}
__device__ __forceinline__ float gelu_exact(float v) { return 0.5f * v * (1.0f + erff(v * 0.70710678118654752f)); }
__device__ __forceinline__ float sigmoidf_(float v) { return 1.0f / (1.0f + __expf(-v)); }
__device__ __forceinline__ float wave_sum(float v) {
#pragma unroll
    for (int o = 32; o > 0; o >>= 1) v += __shfl_xor(v, o, 64);
    return v;
}
__device__ __forceinline__ float block_sum256(float v, float* red) {
    v = wave_sum(v);
    __syncthreads();
    if ((threadIdx.x & 63) == 0) red[threadIdx.x >> 6] = v;
    __syncthreads();
    return red[0] + red[1] + red[2] + red[3];
}

__device__ __forceinline__ int tid_opaque(int wv) {
    int t;
    asm volatile("v_mbcnt_lo_u32_b32 %0, -1, 0\n\tv_mbcnt_hi_u32_b32 %0, -1, %0" : "=v"(t));
    return (wv << 6) | t;
}
__device__ __forceinline__ int launder(int v) { asm volatile("" : "+v"(v)); return v; }

template <int CTRL, int ROWMASK = 0xF>
__device__ __forceinline__ int dpp_iadd(int x) { return x + __builtin_amdgcn_update_dpp(0, x, CTRL, ROWMASK, 0xF, false); }
__device__ __forceinline__ int wave_isum_l63(int v) {
    v = dpp_iadd<0xB1>(v); v = dpp_iadd<0x4E>(v); v = dpp_iadd<0x141>(v); v = dpp_iadd<0x140>(v); v = dpp_iadd<0x142, 0xA>(v); v = dpp_iadd<0x143, 0xC>(v);
    return v;
}
#define XB_TMO      128
#define XB_XCNT(j)  (256  + 64 * (j))
#define XB_XSUB(j)  (1280 + 64 * (j))
#define XB_XGEN(j)  (2304 + 64 * (j))
#define XB_TOP      3328
#define XB_TOPGEN   3392
#define XCD_BAR_WORDS 3456
#define XB_SPIN_CAP (1u << 18)

__device__ __forceinline__ unsigned xb_ld(unsigned* p)              { return __hip_atomic_load(p, __ATOMIC_RELAXED, __HIP_MEMORY_SCOPE_AGENT); }
__device__ __forceinline__ unsigned xb_add(unsigned* p, unsigned v) { return __hip_atomic_fetch_add(p, v, __ATOMIC_RELAXED, __HIP_MEMORY_SCOPE_AGENT); }
__device__ __forceinline__ unsigned xb_xcc_id() { return (unsigned)__builtin_amdgcn_s_getreg((3 << 11) | 20) & 0xFu; }
#define XB_SPIN(cond, bar) do { unsigned _sp = 0; while (cond) { __builtin_amdgcn_s_sleep(1); \
    if ((++_sp & 255u) == 0u) { if (xb_ld(&(bar)[XB_TMO])) break; if (_sp > XB_SPIN_CAP) { atomicAdd(&(bar)[XB_TMO], 1u); break; } } } } while (0)

struct XcdBarrier {
    unsigned* bar; unsigned x;
    bool t0;
    volatile LAS unsigned* st;
};

__device__ __forceinline__ XcdBarrier xcd_barrier_post(unsigned* bar, volatile LAS unsigned* st) {
    XcdBarrier b; b.bar = bar; b.x = xb_xcc_id(); b.st = st;
    if (threadIdx.x == 0) (void)xb_add(&bar[XB_XCNT(b.x)], 1u);
    return b;
}
__device__ __forceinline__ void xcd_barrier_complete(unsigned* bar, unsigned x, unsigned& nloc, unsigned& nx) {
    const unsigned G = gridDim.x * gridDim.y * gridDim.z;
    unsigned sum, cnt, mine, sp = 0u;
    for (;;) {
        sum = 0u; cnt = 0u; mine = 0u;
#pragma unroll
        for (unsigned j = 0; j < 16; ++j) { const unsigned c = xb_ld(&bar[XB_XCNT(j)]); sum += c; cnt += (c > 0u) ? 1u : 0u; mine = (j == x) ? c : mine; }
        if (sum == G) break;
        __builtin_amdgcn_s_sleep(1);
        if ((++sp & 255u) == 0u) { if (xb_ld(&bar[XB_TMO])) break; if (sp > XB_SPIN_CAP) { atomicAdd(&bar[XB_TMO], 1u); break; } }
    }
    nloc = mine > 0u ? mine : 1u; nx = cnt > 0u ? cnt : 1u;
}

__device__ __forceinline__ void xcd_barrier(const XcdBarrier& b) {
    asm volatile("s_waitcnt vmcnt(0)" ::: "memory");
    __syncthreads();
    if (b.t0) {
        unsigned* bar = b.bar;
        __builtin_amdgcn_s_waitcnt(0);
        unsigned nloc = b.st[0], nx = b.st[1];
        if (nloc == 0u) { xcd_barrier_complete(bar, b.x, nloc, nx); b.st[0] = nloc; b.st[1] = nx; }
        const unsigned old = xb_add(&bar[XB_XSUB(b.x)], 1u);
        const unsigned gen = old / nloc;
        if (old + 1u == (gen + 1u) * nloc) {
            __builtin_amdgcn_fence(__ATOMIC_RELEASE, "agent");
            asm volatile("s_waitcnt vmcnt(0)" ::: "memory");
            const unsigned og = xb_add(&bar[XB_TOP], 1u);
            const unsigned tg = og / nx;
            if (og + 1u == (tg + 1u) * nx) xb_add(&bar[XB_TOPGEN], 1u);
            else XB_SPIN(xb_ld(&bar[XB_TOPGEN]) == tg, bar);
            __builtin_amdgcn_fence(__ATOMIC_ACQUIRE, "agent");
            asm volatile("s_waitcnt vmcnt(0)" ::: "memory");
        } else {
            XB_SPIN(xb_ld(&bar[XB_TOPGEN]) == gen, bar);
            __builtin_amdgcn_fence(__ATOMIC_ACQUIRE, "agent");
            asm volatile("s_waitcnt vmcnt(0)" ::: "memory");
        }
    }
    __syncthreads();
}
namespace pg8 {
#define PG8_LAS __attribute__((address_space(3)))
typedef unsigned short bf16_t;
typedef short bf16x8 __attribute__((ext_vector_type(8)));
typedef float f32x4 __attribute__((ext_vector_type(4)));
typedef unsigned u32x4 __attribute__((ext_vector_type(4)));
constexpr int BM = 256, BK = 64, HALF = 128, HTB = HALF * BK * 2  , STAGE_BYTES = 8 * HTB, NXCD = 8, WGM = 8;

__host__ __device__ __forceinline__ int lds_byte(int r, int c) { const int st = (r >> 4) * 2 + (c >> 5), rr = r & 15, cc = c & 31, ob = rr * 64 + cc * 2; return st * 1024 + (ob ^ (((ob >> 9) & 1) << 5)); }
__host__ __device__ __forceinline__ void stage_rc(int b, int& R, int& C) { const int st = b / 1024, sb = b % 1024, swz = sb ^ (((sb >> 9) & 1) << 5); R = (st >> 1) * 16 + swz / 64; C = (st & 1) * 32 + (swz % 64) / 2; }
__host__ __device__ __forceinline__ int perm32(int rho) { const int n = rho >> 4, i = rho & 15; return 8 * (i >> 2) + 4 * n + (i & 3); }

struct Unit { int pm, pn; };
struct Gemm { const bf16_t* A; const bf16_t* Bt; int M, N, K; };

struct StaticOrder {
    int nM, nN, nwg, G, c;
    __host__ __device__ void init(int M, int N, int G_, int c_) { nM = M / BM; nN = N / BM; nwg = nM * nN; G = G_; c = c_; }
    __host__ __device__ bool next(int i, Unit& u) const {
        const long L = (long)i * G + c; if (L >= nwg) return false;
        int wgid = (int)L; { const int q = nwg / NXCD, r = nwg % NXCD, xcd = wgid % NXCD, off = wgid / NXCD; wgid = (xcd < r ? xcd * (q + 1) : r * (q + 1) + (xcd - r) * q) + off; }
        const int nig = WGM * nN, gid = wgid / nig, fm = gid * WGM, gsz = (nM - fm) < WGM ? (nM - fm) : WGM;
        u.pm = fm + ((wgid % nig) % gsz); u.pn = (wgid % nig) / gsz; return true;
    }
    __device__ __forceinline__ void a_ready(const Unit&) const {}
    __device__ __forceinline__ void done(const Unit&) const {}
};
__device__ __forceinline__ unsigned cvt_pk_bf16(float lo, float hi) { unsigned r; asm("v_cvt_pk_bf16_f32 %0, %1, %2" : "=v"(r) : "v"(lo), "v"(hi)); return r; }
template <class Epi, class Sched, bool STAMP = false>
__device__ __forceinline__ void gemm_phase(PG8_LAS unsigned char* lds, const Gemm g, const Sched& S, const Epi& E, unsigned long long* stamps, int wv) {
    const int tid = tid_opaque(wv), wid = __builtin_amdgcn_readfirstlane(tid >> 6), lane = tid & 63, wr = wid >> 2, wc = wid & 3, fr = lane & 15, fq = lane >> 4;
    const int K = g.K, nt = K / BK;
    int ts_lo = 0, ts_hi = 0, nts = 0; const unsigned long long rt_entry = STAMP ? (unsigned long long)wall_clock64() : 0ull;
#define PG8_STAMP() do { if (STAMP && wid == 0 && nts < 64) { const unsigned long long _c = (unsigned long long)clock64(); \
        ts_lo = (lane == nts) ? (int)(unsigned)_c : ts_lo; ts_hi = (lane == nts) ? (int)(unsigned)(_c >> 32) : ts_hi; ++nts; } } while (0)
    PG8_STAMP();
    unsigned voffA[2], voffB[2];
#pragma unroll
    for (int i = 0; i < 2; ++i) { int R, C; stage_rc(tid * 16 + i * 8192, R, C); const int Rb = Epi::PERM ? ((R & ~31) + perm32(R & 31)) : R;
        voffA[i] = (unsigned)(R * K + C) * 2u; voffB[i] = (unsigned)(Rb * K + C) * 2u; }
    const size_t kstep = (size_t)(BK * 2);
    const size_t hstep = (size_t)HALF * K * 2;
    const size_t tstep = 2 * hstep;
    const unsigned ldsw = (unsigned)wid * 1024u;
    const int aoff = lds_byte(wr * 64 + fr, fq * 8), boff = lds_byte(wc * 32 + fr, fq * 8);
#define PG8_SA(b, h) (((b) * 2 + (h)) * HTB)
#define PG8_SB(b, h) ((4 + (b) * 2 + (h)) * HTB)
#define PG8_STAGE(bufoff, gbase, voff) do { _Pragma("unroll") for (int _i = 0; _i < 2; ++_i) \
        __builtin_amdgcn_global_load_lds((const unsigned*)((const char*)(gbase) + (voff)[_i]), (PG8_LAS unsigned*)(lds + (bufoff) + ldsw + _i * 8192), 16, 0, 0); } while (0)
#define PG8_LDA(dst, b, h) do { _Pragma("unroll") for (int m = 0; m < 4; ++m) _Pragma("unroll") for (int k = 0; k < 2; ++k) dst[m][k] = *(const PG8_LAS bf16x8*)(lds + PG8_SA(b, h) + aoff + m * 2048 + k * 1024); } while (0)
#define PG8_LDB(dst, b, h) do { _Pragma("unroll") for (int n = 0; n < 2; ++n) _Pragma("unroll") for (int k = 0; k < 2; ++k) dst[n][k] = *(const PG8_LAS bf16x8*)(lds + PG8_SB(b, h) + boff + n * 2048 + k * 1024); } while (0)
#define PG8_MMA(ai, bj, At, Bt) do { __builtin_amdgcn_s_setprio(1); _Pragma("unroll") for (int m = 0; m < 4; ++m) _Pragma("unroll") for (int n = 0; n < 2; ++n) _Pragma("unroll") for (int k = 0; k < 2; ++k) \
        acc[ai][bj][m][n] = __builtin_amdgcn_mfma_f32_16x16x32_bf16(Bt[n][k], At[m][k], acc[ai][bj][m][n], 0, 0, 0); __builtin_amdgcn_s_setprio(0); } while (0)
#define PG8_WAIT_V(n) asm volatile("s_waitcnt vmcnt(" #n ")" ::: "memory")
#define PG8_WAIT_L(n) asm volatile("s_waitcnt lgkmcnt(" #n ")" ::: "memory")
#define PG8_BAR __builtin_amdgcn_s_barrier()
#define PG8_SCHED __builtin_amdgcn_sched_barrier(0)
    Unit cur, nxt; int ui = 0;
    if (!S.next(0, cur)) return;
    f32x4 acc[2][2][4][2];
#pragma unroll
    for (int a = 0; a < 2; ++a)
#pragma unroll
        for (int b = 0; b < 2; ++b)
#pragma unroll
            for (int m = 0; m < 4; ++m)
#pragma unroll
                for (int n = 0; n < 2; ++n) acc[a][b][m][n] = (f32x4){0.f, 0.f, 0.f, 0.f};
    bf16x8 At[4][2], B0[2][2], B1[2][2];
    const char* cA = (const char*)g.A + (size_t)cur.pm * tstep; const char* cB = (const char*)g.Bt + (size_t)cur.pn * tstep;
    S.a_ready(cur);
    PG8_STAGE(PG8_SB(0, 0), cB, voffB); PG8_STAGE(PG8_SA(0, 0), cA, voffA); PG8_STAGE(PG8_SB(0, 1), cB + hstep, voffB); PG8_STAGE(PG8_SA(0, 1), cA + hstep, voffA);
    if (wr == 1) PG8_BAR;
    PG8_WAIT_V(4); PG8_BAR;
    PG8_STAGE(PG8_SB(1, 0), cB + kstep, voffB); PG8_STAGE(PG8_SA(1, 0), cA + kstep, voffA); PG8_STAGE(PG8_SB(1, 1), cB + hstep + kstep, voffB);
    PG8_WAIT_V(6); PG8_BAR;
    PG8_STAMP();
    for (;;) {
        const bool has_next = S.next(ui + 1, nxt);
        const char* nA = has_next ? (const char*)g.A + (size_t)nxt.pm * tstep : cA; const char* nB = has_next ? (const char*)g.Bt + (size_t)nxt.pn * tstep : cB;
        for (int t = 0; t < nt; t += 2) {
            const bool last = (t == nt - 2);
            const char* a1 = cA + (size_t)(t + 1) * kstep;
            const char* a2 = last ? nA : cA + (size_t)(t + 2) * kstep; const char* b2 = last ? nB : cB + (size_t)(t + 2) * kstep;
            const char* a3 = a2 + kstep; const char* b3 = b2 + kstep;
            if (last && has_next) S.a_ready(nxt);
            PG8_LDB(B0, 0, 0); PG8_SCHED; PG8_LDA(At, 0, 0); PG8_STAGE(PG8_SA(1, 1), a1 + hstep, voffA);
            PG8_WAIT_L(8); PG8_BAR; PG8_WAIT_L(0); PG8_MMA(0, 0, At, B0); PG8_BAR; PG8_SCHED;
            PG8_LDB(B1, 0, 1); PG8_STAGE(PG8_SB(0, 0), b2, voffB);
            PG8_BAR; PG8_WAIT_L(0); PG8_MMA(0, 1, At, B1); PG8_BAR;
            PG8_LDA(At, 0, 1); PG8_STAGE(PG8_SA(0, 0), a2, voffA);
            PG8_BAR; PG8_WAIT_L(0); PG8_MMA(1, 0, At, B0); PG8_BAR; PG8_SCHED;
            PG8_STAGE(PG8_SB(0, 1), b2 + hstep, voffB);
            PG8_WAIT_V(6); PG8_BAR; PG8_MMA(1, 1, At, B1); PG8_BAR;
            PG8_LDB(B0, 1, 0); PG8_SCHED; PG8_LDA(At, 1, 0); PG8_STAGE(PG8_SA(0, 1), a2 + hstep, voffA);
            PG8_WAIT_L(8); PG8_BAR; PG8_WAIT_L(0); PG8_MMA(0, 0, At, B0); PG8_BAR; PG8_SCHED;
            PG8_LDB(B1, 1, 1); PG8_STAGE(PG8_SB(1, 0), b3, voffB);
            PG8_BAR; PG8_WAIT_L(0); PG8_MMA(0, 1, At, B1); PG8_BAR;
            PG8_LDA(At, 1, 1); PG8_STAGE(PG8_SA(1, 0), a3, voffA);
            PG8_BAR; PG8_WAIT_L(0); PG8_MMA(1, 0, At, B0); PG8_BAR; PG8_SCHED;
            PG8_STAGE(PG8_SB(1, 1), b3 + hstep, voffB);
            PG8_WAIT_V(6); PG8_BAR; PG8_MMA(1, 1, At, B1); PG8_BAR;
        }
        PG8_STAMP();
        if constexpr (!Epi::AFTER_DRAIN) { E(acc, cur, wr, wc, fr, fq); S.done(cur); }
        PG8_STAMP();
        if (!has_next) break;
#pragma unroll
        for (int a = 0; a < 2; ++a)
#pragma unroll
            for (int b = 0; b < 2; ++b)
#pragma unroll
                for (int m = 0; m < 4; ++m)
#pragma unroll
                    for (int n = 0; n < 2; ++n) acc[a][b][m][n] = (f32x4){0.f, 0.f, 0.f, 0.f};
        cur = nxt; cA = nA; cB = nB; ++ui;
    }
    PG8_WAIT_V(0);
    if (wr == 0) PG8_BAR;
    PG8_BAR;
    if constexpr (Epi::AFTER_DRAIN) { E.fused(acc, cur, wr, wc, fr, fq, lds, wid, lane); S.done(cur); }
    PG8_STAMP();
    if (STAMP && wid == 0) { stamps[lane] = lane < nts ? (((unsigned long long)(unsigned)ts_hi << 32) | (unsigned)ts_lo) : 0ull;
        if (lane == 62) stamps[62] = rt_entry; if (lane == 63) stamps[63] = (unsigned long long)wall_clock64(); }
#undef PG8_STAMP
#undef PG8_SA
#undef PG8_SB
#undef PG8_STAGE
#undef PG8_LDA
#undef PG8_LDB
#undef PG8_MMA
#undef PG8_WAIT_V
#undef PG8_WAIT_L
#undef PG8_BAR
#undef PG8_SCHED
}
}

constexpr size_t ws_al(size_t x) { return (x + 255) & ~(size_t)255; }
constexpr size_t OFF_BAR = 0;
constexpr size_t OFF_CTR = OFF_BAR + ws_al((size_t)3456 * 4);
constexpr size_t CTR_BYTES = 64 * 256;
constexpr size_t OFF_MOD = OFF_CTR + CTR_BYTES;
constexpr size_t OFF_XB = OFF_MOD + ws_al((size_t)DEPTH * BATCH * MODW * 4);
constexpr size_t OFF_HB = OFF_XB + ws_al((size_t)NTOK * D_MODEL * 4);
constexpr size_t OFF_PB = OFF_HB + ws_al((size_t)NTOK * D_MODEL * 2);
constexpr size_t OFF_CAT = OFF_PB + ws_al((size_t)NTOK * MIX_IN * 2);
constexpr size_t OFF_QB = OFF_CAT + ws_al((size_t)NTOK * D_MODEL * 2);
constexpr size_t OFF_WINT = OFF_QB + ws_al((size_t)NTOK * 2048 * 2);
constexpr size_t OFF_WOUTT = OFF_WINT + ws_al((size_t)DEPTH * MIX_IN * D_MODEL * 2);
constexpr size_t OFF_WQT = OFF_WOUTT + ws_al((size_t)DEPTH * D_MODEL * D_MODEL * 2);
constexpr size_t OFF_KEYSB = OFF_WQT + ws_al((size_t)DEPTH * 2048 * D_MODEL * 2);
constexpr size_t OFF_SGUWB = OFF_KEYSB + ws_al((size_t)DEPTH * 16 * 128 * 128 * 2);
constexpr size_t OFF_UB8 = OFF_SGUWB + ws_al((size_t)DEPTH * 4 * 128 * 128 * 2);
constexpr size_t OFF_VB8 = OFF_UB8 + ws_al((size_t)DEPTH * NEXP * D_MODEL);
constexpr size_t OFF_UINV = OFF_VB8 + ws_al((size_t)DEPTH * NEXP * D_MODEL);
constexpr size_t OFF_VINV = OFF_UINV + ws_al((size_t)DEPTH * NEXP * 4);
constexpr size_t OFF_EIDX = OFF_VINV + ws_al((size_t)DEPTH * NEXP * 4);
constexpr size_t OFF_EGATE = OFF_EIDX + ws_al((size_t)NTOK * 128 * 4);
constexpr size_t OFF_SSQ = OFF_EGATE + ws_al((size_t)NTOK * 128 * 4);
constexpr size_t OFF_USUM = OFF_SSQ + ws_al((size_t)NTOK * 16 * 4);
constexpr size_t OFF_BIASQ = OFF_USUM + ws_al((size_t)DEPTH * NEXP * 4);
constexpr size_t WS_END = OFF_BIASQ + ws_al((size_t)DEPTH * BATCH * 2048 * 4);

struct Params {
    const float *x_in, *c, *rel_bias, *w_mod, *b_mod, *norm1_g, *norm2_g, *w_in, *w_out, *diff_lambda, *subln_g, *conf_dw, *conf_ln_g, *conf_ln_b, *sconv_w,
        *sgu_ln_g, *sgu_ln_b, *sgu_w, *sgu_b, *peer_wq, *peer_keys, *peer_u, *peer_v, *final_g;
    float* out;
    unsigned char* ws;
    float lam_init[DEPTH];
    __host__ __device__ unsigned* bar() const { return (unsigned*)(ws + OFF_BAR); }
    __host__ __device__ unsigned* ctr(int i) const { return (unsigned*)(ws + OFF_CTR + (size_t)i * 256); }
    __host__ __device__ float* mod() const { return (float*)(ws + OFF_MOD); }
    __host__ __device__ bf16_t* xb() const { return (bf16_t*)(ws + OFF_XB); }
    __host__ __device__ bf16_t* hb() const { return (bf16_t*)(ws + OFF_HB); }
    __host__ __device__ bf16_t* pb() const { return (bf16_t*)(ws + OFF_PB); }
    __host__ __device__ bf16_t* cat() const { return (bf16_t*)(ws + OFF_CAT); }
    __host__ __device__ bf16_t* qb() const { return (bf16_t*)(ws + OFF_QB); }
    __host__ __device__ bf16_t* WinT() const { return (bf16_t*)(ws + OFF_WINT); }
    __host__ __device__ bf16_t* WoutT() const { return (bf16_t*)(ws + OFF_WOUTT); }
    __host__ __device__ bf16_t* WqT() const { return (bf16_t*)(ws + OFF_WQT); }
    __host__ __device__ bf16_t* keysb() const { return (bf16_t*)(ws + OFF_KEYSB); }
    __host__ __device__ bf16_t* sguwb() const { return (bf16_t*)(ws + OFF_SGUWB); }
    __host__ __device__ unsigned char* ub8() const { return ws + OFF_UB8; }
    __host__ __device__ unsigned char* vb8() const { return ws + OFF_VB8; }
    __host__ __device__ float* uinv() const { return (float*)(ws + OFF_UINV); }
    __host__ __device__ float* vinv() const { return (float*)(ws + OFF_VINV); }
    __host__ __device__ int* eidx() const { return (int*)(ws + OFF_EIDX); }
    __host__ __device__ float* egate() const { return (float*)(ws + OFF_EGATE); }
    __host__ __device__ int* usum() const { return (int*)(ws + OFF_USUM); }
    __host__ __device__ float* ssq() const { return (float*)(ws + OFF_SSQ); }
    __host__ __device__ float* biasq() const { return (float*)(ws + OFF_BIASQ); }
};

#define LDS_BYTES (160 * 1024)
#define NWAVES 8

__device__ __forceinline__ void transpose_item(const float* __restrict__ W, int K, int N, bf16_t* __restrict__ WT, LAS float* scr, int item, int lane) {
    const int nblk = N / 32, kb = item / nblk, nb = item % nblk, k0 = 64 * kb, n0 = 32 * nb;
#pragma unroll 8
    for (int i = 0; i < 32; ++i) { const int kk = 2 * i + (lane >> 5); scr[kk * 33 + (lane & 31)] = W[(size_t)(k0 + kk) * N + n0 + (lane & 31)]; }
    asm volatile("s_waitcnt lgkmcnt(0)" ::: "memory");
    const int c = lane & 7;
#pragma unroll
    for (int j = 0; j < 4; ++j) {
        const int n = (lane >> 3) + 8 * j; const LAS float* s = scr + (8 * c) * 33 + n;
        u32x4 o; o.x = pk2(s[0 * 33], s[1 * 33]); o.y = pk2(s[2 * 33], s[3 * 33]); o.z = pk2(s[4 * 33], s[5 * 33]); o.w = pk2(s[6 * 33], s[7 * 33]);
        *(u32x4*)(WT + (size_t)(n0 + n) * K + k0 + 8 * c) = o;
    }
    asm volatile("s_waitcnt lgkmcnt(0)" ::: "memory");
}
__device__ __forceinline__ void cvt8(const float* __restrict__ s, bf16_t* __restrict__ d) {
    const f32x4 a = *(const f32x4*)s, b = *(const f32x4*)(s + 4);
    u32x4 o; o.x = pk2(a[0], a[1]); o.y = pk2(a[2], a[3]); o.z = pk2(b[0], b[1]); o.w = pk2(b[2], b[3]);
    *(u32x4*)d = o;
}
#define CV_NR 4
__device__ __forceinline__ void convert_table_row(const Params& p, int tr0, int lane) {
    f32x4 a[CV_NR][4];
#pragma unroll
    for (int h2 = 0; h2 < CV_NR; ++h2) {
        const int tr = tr0 + h2, l = tr / (2 * NEXP), w2 = tr % (2 * NEXP); const bool isv = w2 >= NEXP; const size_t r = (size_t)l * NEXP + (isv ? w2 - NEXP : w2);
        const float* src = (isv ? p.peer_v : p.peer_u) + r * D_MODEL + lane * 16;
#pragma unroll
        for (int q = 0; q < 4; ++q) a[h2][q] = *(const f32x4*)(src + 4 * q);
    }
#pragma unroll
    for (int h2 = 0; h2 < CV_NR; ++h2) {
        const int tr = tr0 + h2, l = tr / (2 * NEXP), w2 = tr % (2 * NEXP); const bool isv = w2 >= NEXP; const size_t r = (size_t)l * NEXP + (isv ? w2 - NEXP : w2);
        float ss = 0.f;
#pragma unroll
        for (int q = 0; q < 4; ++q) ss += a[h2][q][0] * a[h2][q][0] + a[h2][q][1] * a[h2][q][1] + a[h2][q][2] * a[h2][q][2] + a[h2][q][3] * a[h2][q][3];
        ss = wave_sum(ss);
        const float step = fmaxf(0.335f * sqrtf(ss * (1.0f / D_MODEL)), 1e-30f), sc = 1.0f / step;
        unsigned o[2]; int qs = 0;
#pragma unroll
        for (int d = 0; d < 2; ++d) {
            unsigned w = 0;
#pragma unroll
            for (int e = 0; e < 8; ++e) {
                const float v = a[h2][2 * d + (e >> 2)][e & 3];
                const int qv = (int)fminf(fmaxf(rintf(v * sc), -8.f), 7.f);
                qs += qv;
                w |= (unsigned)(((isv && !(e & 1)) ? qv + 8 : qv) & 0xF) << (8 * (e >> 1) + 4 * (e & 1));
            }
            o[d] = w;
        }
        qs = __builtin_amdgcn_readlane(wave_isum_l63(qs), 63);
        *(u32x2*)((isv ? p.vb8() : p.ub8()) + r * (D_MODEL / 2) + lane * 8) = (u32x2){o[0], o[1]};
        if (lane == 0) { (isv ? p.vinv() : p.uinv())[r] = step; if (!isv) p.usum()[r] = qs; }
    }
}
constexpr int CV_I_IN = (D_MODEL / 64) * (MIX_IN / 32), CV_I_OUT = (D_MODEL / 64) * (D_MODEL / 32), CV_I_Q = (D_MODEL / 64) * (2048 / 32), CV_I_L = CV_I_IN + CV_I_OUT + CV_I_Q;
__device__ __forceinline__ void convert_weight_item(const Params& p, int l, int r, LAS float* scr, int lane) {
    if (r < CV_I_IN) { transpose_item(p.w_in + (size_t)l * D_MODEL * MIX_IN, D_MODEL, MIX_IN, p.WinT() + (size_t)l * MIX_IN * D_MODEL, scr, r, lane); return; } r -= CV_I_IN;
    if (r < CV_I_OUT) { transpose_item(p.w_out + (size_t)l * D_MODEL * D_MODEL, D_MODEL, D_MODEL, p.WoutT() + (size_t)l * D_MODEL * D_MODEL, scr, r, lane); return; } r -= CV_I_OUT;
    transpose_item(p.peer_wq + (size_t)l * D_MODEL * 2048, D_MODEL, 2048, p.WqT() + (size_t)l * 2048 * D_MODEL, scr, r, lane);
}
__device__ __forceinline__ void phase_convert(const Params& p, LAS unsigned char* lds, int wv) {
    const int tid = tid_opaque(wv), wave = tid >> 6, lane = tid & 63;
    LAS float* scr = (LAS float*)(lds + wave * 16384);
    const int gw = blockIdx.x * NWAVES + wave, NGW = gridDim.x * NWAVES;
    for (int it = gw; it < CV_I_L; it += NGW) convert_weight_item(p, 0, it, scr, lane);
    const size_t gt = (size_t)blockIdx.x * 512 + tid, NGT = (size_t)gridDim.x * 512;
    constexpr size_t N_KEYS8 = (size_t)DEPTH * 16 * 128 * 128 / 8, N_SGU8 = (size_t)DEPTH * 4 * 128 * 128 / 8;
    for (size_t i = gt; i < N_KEYS8; i += NGT) cvt8(p.peer_keys + i * 8, p.keysb() + i * 8);
    for (int tr = CV_NR * gw; tr < 2 * NEXP; tr += CV_NR * NGW) convert_table_row(p, tr, lane);
    for (size_t i = gt; i < N_SGU8; i += NGT) {
        const size_t e = i * 8; const int s0 = (int)(e & 127), t = (int)((e >> 7) & 127);
        const f32x4 a = *(const f32x4*)(p.sgu_w + e), b = *(const f32x4*)(p.sgu_w + e + 4);
        float v[8] = {a[0], a[1], a[2], a[3], b[0], b[1], b[2], b[3]};
#pragma unroll
        for (int j = 0; j < 8; ++j) v[j] = (s0 + j <= t) ? v[j] : 0.f;
        u32x4 o; o.x = pk2(v[0], v[1]); o.y = pk2(v[2], v[3]); o.z = pk2(v[4], v[5]); o.w = pk2(v[6], v[7]);
        *(u32x4*)(p.sguwb() + e) = o;
    }
}
#define EX_TAILC 1
__device__ __forceinline__ void convert_in_gemm1_slack(const Params& p, int l, LAS unsigned char* lds, int wv, int part) {
    (void)part;
    const int G = (int)gridDim.x;
    int rem = 640 - 2 * G;
    if (rem <= 0 || rem >= G) rem = 0;
    const int tid = tid_opaque(wv), wave = tid >> 6, lane = tid & 63;
    constexpr int S_ROWS = (DEPTH - 1) * 2 * NEXP, W_ROWS = S_ROWS / DEPTH;
    const int tail = rem > 0 ? EX_TAILC * CV_NR * rem * NWAVES : 0;
    if ((int)blockIdx.x < rem) {
        for (int q = 0; q < EX_TAILC; ++q) {
            const int sr = (l + 1) * W_ROWS - tail + CV_NR * ((q * rem + (int)blockIdx.x) * NWAVES + wave);
            convert_table_row(p, 2 * NEXP + sr, lane);
        }
        return;
    }
    LAS float* scr = (LAS float*)(lds + wave * 16384);
    const int cw = ((int)blockIdx.x - rem) * NWAVES + wave, NCW = (G - rem) * NWAVES;
    if (l + 1 < DEPTH) for (int it = cw; it < CV_I_L; it += NCW) convert_weight_item(p, l + 1, it, scr, lane);
    for (int sr = l * W_ROWS + CV_NR * cw; sr < (l + 1) * W_ROWS - tail; sr += CV_NR * NCW) convert_table_row(p, 2 * NEXP + sr, lane);
}

__device__ __forceinline__ void norm_row(const float* __restrict__ xr, const float* __restrict__ g, const float* __restrict__ sh, const float* __restrict__ sc, bf16_t* __restrict__ hr, int lane) {
    f32x4 v[4]; float ss = 0.f;
#pragma unroll
    for (int j = 0; j < 4; ++j) { v[j] = *(const f32x4*)(xr + j * 256 + lane * 4); ss += v[j][0] * v[j][0] + v[j][1] * v[j][1] + v[j][2] * v[j][2] + v[j][3] * v[j][3]; }
    const float rs = rsqrtf(wave_sum(ss) * (1.0f / D_MODEL) + 1e-6f);
#pragma unroll
    for (int j = 0; j < 4; ++j) {
        const int col = j * 256 + lane * 4;
        const f32x4 gv = *(const f32x4*)(g + col), scv = *(const f32x4*)(sc + col), shv = *(const f32x4*)(sh + col);
        f32x4 y;
#pragma unroll
        for (int e = 0; e < 4; ++e) y[e] = v[j][e] * rs * gv[e] * (1.0f + scv[e]) + shv[e];
        u32x2 o; o.x = pk2(y[0], y[1]); o.y = pk2(y[2], y[3]);
        *(u32x2*)(hr + col) = o;
    }
}
__device__ __forceinline__ void phase_norm(const Params& p, const float* __restrict__ x, const float* __restrict__ g, const float* __restrict__ modl, int sh_idx, int sc_idx, int wv) {
    const int tid = tid_opaque(wv), wave = tid >> 6, lane = tid & 63;
    for (int t = blockIdx.x * NWAVES + wave; t < NTOK; t += gridDim.x * NWAVES) {
        const float* mb = modl + (size_t)(t / SEQ) * MODW;
        norm_row(x + (size_t)t * D_MODEL, g, mb + sh_idx * D_MODEL, mb + sc_idx * D_MODEL, p.hb() + (size_t)t * D_MODEL, lane);
    }
}

struct EpiStoreBf16 {
    static constexpr bool PERM = true, AFTER_DRAIN = false;
    bf16_t* O; int ldc; int live = 1;
    __device__ __forceinline__ void operator()(const pg8::f32x4 (&acc)[2][2][4][2], const pg8::Unit& u, int wr, int wc, int fr, int fq) const {
        const int row0 = u.pm * 256 + wr * 64 + fr, col0 = u.pn * 256 + wc * 32 + 8 * fq;
#pragma unroll
        for (int ai = 0; ai < 2; ++ai)
#pragma unroll
            for (int m = 0; m < 4; ++m) {
                bf16_t* rowp = O + (size_t)(row0 + ai * 128 + m * 16) * ldc + col0;
#pragma unroll
                for (int bj = 0; bj < 2; ++bj) {
                    const pg8::f32x4 v0 = acc[ai][bj][m][0], v1 = acc[ai][bj][m][1];
                    u32x4 w; w.x = pk2(v0[0], v0[1]); w.y = pk2(v0[2], v0[3]); w.z = pk2(v1[0], v1[1]); w.w = pk2(v1[2], v1[3]);
                    if (live) *(u32x4*)(rowp + bj * 128) = w;
                }
            }
    }
};
struct EpiResid {
    static constexpr bool PERM = false, AFTER_DRAIN = false;
    const float* xin; float* xout; const float* gate;
    __device__ __forceinline__ void operator()(const pg8::f32x4 (&acc)[2][2][4][2], const pg8::Unit& u, int wr, int wc, int fr, int fq) const {
        const int row0 = u.pm * 256 + wr * 64 + fr, col0 = u.pn * 256 + wc * 32 + 4 * fq;
        const float* gb = gate + (size_t)((u.pm * 256) / SEQ) * MODW + col0;
        pg8::f32x4 gv[2][2];
#pragma unroll
        for (int bj = 0; bj < 2; ++bj)
#pragma unroll
            for (int n = 0; n < 2; ++n) gv[bj][n] = *(const pg8::f32x4*)(gb + bj * 128 + n * 16);
#pragma unroll
        for (int ai = 0; ai < 2; ++ai)
#pragma unroll
            for (int m = 0; m < 4; ++m) {
                const size_t off = (size_t)(row0 + ai * 128 + m * 16) * D_MODEL + col0;
#pragma unroll
                for (int bj = 0; bj < 2; ++bj)
#pragma unroll
                    for (int n = 0; n < 2; ++n) {
                        const pg8::f32x4 xv = *(const pg8::f32x4*)(xin + off + bj * 128 + n * 16);
                        *(pg8::f32x4*)(xout + off + bj * 128 + n * 16) = xv + gv[bj][n] * acc[ai][bj][m][n];
                    }
            }
    }
};

template <bool FIRST>
struct EpiResidNorm {
    static constexpr bool PERM = true, AFTER_DRAIN = false;
    const float* xin32; const bf16_t* xin16; bf16_t* xout; const float* modl; const float* n2g; bf16_t* hb; float* ssq;
    __device__ __forceinline__ void operator()(const pg8::f32x4 (&acc)[2][2][4][2], const pg8::Unit& u, int wr, int wc, int fr, int fq) const {
        const int row0 = u.pm * 256 + wr * 64 + fr, col0 = u.pn * 256 + wc * 32 + 8 * fq;
        const float* mb = modl + (size_t)((u.pm * 256) / SEQ) * MODW;
        pg8::f32x4 gv[2][2], gm[2][2];
#pragma unroll
        for (int bj = 0; bj < 2; ++bj)
#pragma unroll
            for (int n = 0; n < 2; ++n) {
                const int c = col0 + bj * 128 + n * 4;
                gv[bj][n] = *(const pg8::f32x4*)(mb + 2 * D_MODEL + c);
                gm[bj][n] = *(const pg8::f32x4*)(n2g + c) * (*(const pg8::f32x4*)(mb + 4 * D_MODEL + c) + 1.0f);
            }
#pragma unroll
        for (int ai = 0; ai < 2; ++ai) {
            u32x4 xa[4][2];
            if (!FIRST) {
#pragma unroll
                for (int m = 0; m < 4; ++m)
#pragma unroll
                    for (int bj = 0; bj < 2; ++bj) xa[m][bj] = *(const u32x4*)(xin16 + (size_t)(row0 + ai * 128 + m * 16) * D_MODEL + col0 + bj * 128);
            }
#pragma unroll
            for (int m = 0; m < 4; ++m) {
                const int row = row0 + ai * 128 + m * 16;
                const size_t off = (size_t)row * D_MODEL + col0;
                float sq = 0.f;
#pragma unroll
                for (int bj = 0; bj < 2; ++bj) {
                    pg8::f32x4 x0, x1;
                    if (FIRST) { x0 = *(const pg8::f32x4*)(xin32 + off + bj * 128); x1 = *(const pg8::f32x4*)(xin32 + off + bj * 128 + 4); }
                    else { const u32x4 w = xa[m][bj]; x0 = (pg8::f32x4){bflo(w.x), bfhi(w.x), bflo(w.y), bfhi(w.y)}; x1 = (pg8::f32x4){bflo(w.z), bfhi(w.z), bflo(w.w), bfhi(w.w)}; }
                    x0 += gv[bj][0] * acc[ai][bj][m][0]; x1 += gv[bj][1] * acc[ai][bj][m][1];
                    u32x4 xo; xo.x = pk2(x0[0], x0[1]); xo.y = pk2(x0[2], x0[3]); xo.z = pk2(x1[0], x1[1]); xo.w = pk2(x1[2], x1[3]);
                    *(u32x4*)(xout + off + bj * 128) = xo;
                    x0 = (pg8::f32x4){bflo(xo.x), bfhi(xo.x), bflo(xo.y), bfhi(xo.y)}; x1 = (pg8::f32x4){bflo(xo.z), bfhi(xo.z), bflo(xo.w), bfhi(xo.w)};
                    sq += x0[0] * x0[0] + x0[1] * x0[1] + x0[2] * x0[2] + x0[3] * x0[3] + x1[0] * x1[0] + x1[1] * x1[1] + x1[2] * x1[2] + x1[3] * x1[3];
                    const pg8::f32x4 h0 = x0 * gm[bj][0], h1 = x1 * gm[bj][1];
                    u32x4 ho; ho.x = pk2(h0[0], h0[1]); ho.y = pk2(h0[2], h0[3]); ho.z = pk2(h1[0], h1[1]); ho.w = pk2(h1[2], h1[3]);
                    *(u32x4*)(hb + off + bj * 128) = ho;
                }
                sq += __shfl_xor(sq, 16, 64); sq += __shfl_xor(sq, 32, 64);
                if (fq == 0) ssq[(size_t)row * 16 + u.pn * 4 + wc] = sq;
            }
        }
    }
};
struct EpiQ {
    static constexpr bool PERM = true, AFTER_DRAIN = false;
    bf16_t* O; const float* ssq; const float* biasq; int live = 1;
    __device__ __forceinline__ void operator()(const pg8::f32x4 (&acc)[2][2][4][2], const pg8::Unit& u, int wr, int wc, int fr, int fq) const {
        const int row0 = u.pm * 256 + wr * 64 + fr, col0 = u.pn * 256 + wc * 32 + 8 * fq;
        const float* bb = biasq + (size_t)((u.pm * 256) / SEQ) * 2048 + col0;
        pg8::f32x4 bv[2][2];
#pragma unroll
        for (int bj = 0; bj < 2; ++bj)
#pragma unroll
            for (int n = 0; n < 2; ++n) bv[bj][n] = *(const pg8::f32x4*)(bb + bj * 128 + 4 * n);
#pragma unroll
        for (int ai = 0; ai < 2; ++ai) {
            pg8::f32x4 sp[4][4];
#pragma unroll
            for (int m = 0; m < 4; ++m)
#pragma unroll
                for (int k = 0; k < 4; ++k) sp[m][k] = *(const pg8::f32x4*)(ssq + (size_t)(row0 + ai * 128 + m * 16) * 16 + 4 * k);
#pragma unroll
            for (int m = 0; m < 4; ++m) {
                const int row = row0 + ai * 128 + m * 16;
                const pg8::f32x4 s0 = sp[m][0], s1 = sp[m][1], s2 = sp[m][2], s3 = sp[m][3];
                const float tot = (((s0[0] + s0[1]) + (s0[2] + s0[3])) + ((s1[0] + s1[1]) + (s1[2] + s1[3]))) + (((s2[0] + s2[1]) + (s2[2] + s2[3])) + ((s3[0] + s3[1]) + (s3[2] + s3[3])));
                const float rs = rsqrtf(tot * (1.0f / D_MODEL) + 1e-6f);
                bf16_t* rowp = O + (size_t)row * 2048 + col0;
#pragma unroll
                for (int bj = 0; bj < 2; ++bj) {
                    const pg8::f32x4 v0 = acc[ai][bj][m][0] * rs + bv[bj][0], v1 = acc[ai][bj][m][1] * rs + bv[bj][1];
                    u32x4 w; w.x = pk2(v0[0], v0[1]); w.y = pk2(v0[2], v0[3]); w.z = pk2(v1[0], v1[1]); w.w = pk2(v1[2], v1[3]);
                    if (live) *(u32x4*)(rowp + bj * 128) = w;
                }
            }
        }
    }
};

template <class Epi>
__device__ __forceinline__ void run_gemm(LAS unsigned char* lds, const bf16_t* A, const bf16_t* Bt, int M, int N, int K, const Epi& E, int wv) {
    pg8::StaticOrder S; S.init(M, N, (int)gridDim.x, (int)blockIdx.x);
    pg8::Gemm g; g.A = A; g.Bt = Bt; g.M = M; g.N = N; g.K = K;
    pg8::gemm_phase<Epi, pg8::StaticOrder, false>(lds, g, S, E, nullptr, wv);
}

typedef __amdgpu_buffer_rsrc_t rsrc_t;
struct G4 { u32x2 r[4]; };
__device__ __forceinline__ u32x2 bload8(rsrc_t r, int voff, int soff) { return __builtin_bit_cast(u32x2, __builtin_amdgcn_raw_buffer_load_b64(r, voff, soff, 0)); }
#define ROWB (D_MODEL / 2)
__device__ __forceinline__ u32x4 bload16v(rsrc_t r, int voff) { return __builtin_bit_cast(u32x4, __builtin_amdgcn_raw_buffer_load_b128(r, voff, 0, 0)); }
template <int G>
__device__ __forceinline__ void ex_issueA(G4& R, rsrc_t rs, int e0, int e1, int lane, int cofs, int emask) {
    int ek = __shfl(G < 8 ? e0 : e1, ((8 * G) & 63) + (lane >> 3), 64);
    if (PROBE_SYNTH) ek &= emask;
    const int vo = ek * ROWB + cofs + (lane & 7) * 32;
    const u32x4 a = bload16v(rs, vo), b = bload16v(rs, vo + 16);
    R.r[0] = (u32x2){a.x, a.y}; R.r[1] = (u32x2){a.z, a.w}; R.r[2] = (u32x2){b.x, b.y}; R.r[3] = (u32x2){b.z, b.w};
}
template <int G>
__device__ __forceinline__ void ex_passA(const G4& R, const int (&hh8)[8], const int (&hl8)[8], int (&ra)[5], int& KK0, int& KK1, int lane) {
#pragma unroll
    for (int d = 0; d < 8; d += 2) {
        const int x = (int)R.r[d >> 1][0], y = (int)R.r[d >> 1][1];
        ra[0] = __builtin_amdgcn_sdot8(x, hh8[d], ra[0], false); ra[2] = __builtin_amdgcn_sdot8(x, hl8[d], ra[2], false);
        ra[0] = __builtin_amdgcn_sdot8(y, hh8[d + 1], ra[0], false); ra[2] = __builtin_amdgcn_sdot8(y, hl8[d + 1], ra[2], false);
    }
    const int tot = (ra[0] << 4) + ra[2];
    int a = tot - ra[4]; ra[4] = tot;
    a = dpp_iadd<0xB1>(a); a = dpp_iadd<0x4E>(a); a = dpp_iadd<0x141>(a);
    const int v = __shfl(a, 8 * (lane & 7), 64);
    if (G < 8) KK0 = ((lane >> 3) == (G & 7)) ? v : KK0; else KK1 = ((lane >> 3) == (G & 7)) ? v : KK1;
}
__device__ __forceinline__ void ex_issueB(G4& R, rsrc_t rs, const u32x4 ids, int lbase, int emask) {
#pragma unroll
    for (int j = 0; j < 4; ++j) R.r[j] = bload8(rs, (int)(PROBE_SYNTH ? (ids[j] & (unsigned)emask) : ids[j]) * ROWB + lbase, 0);
}
__device__ __forceinline__ void ex_passB(const G4& R, int cp, int (&yi)[16]) {
#pragma unroll
    for (int d = 0; d < 2; ++d) {
        const unsigned A = R.r[0][d], B = R.r[1][d], C = R.r[2][d], D = R.r[3][d];
        const unsigned ablo = __builtin_amdgcn_perm(B, A, 0x05010400u), abhi = __builtin_amdgcn_perm(B, A, 0x07030602u);
        const unsigned cdlo = __builtin_amdgcn_perm(D, C, 0x05010400u), cdhi = __builtin_amdgcn_perm(D, C, 0x07030602u);
        unsigned t[4];
        t[0] = __builtin_amdgcn_perm(cdlo, ablo, 0x05040100u); t[1] = __builtin_amdgcn_perm(cdlo, ablo, 0x07060302u);
        t[2] = __builtin_amdgcn_perm(cdhi, abhi, 0x05040100u); t[3] = __builtin_amdgcn_perm(cdhi, abhi, 0x07060302u);
#pragma unroll
        for (int b = 0; b < 4; ++b) {
            yi[8 * d + 2 * b] = __builtin_amdgcn_sdot4((int)(t[b] & 0x0F0F0F0Fu), cp, yi[8 * d + 2 * b], false);
            yi[8 * d + 2 * b + 1] = __builtin_amdgcn_sdot4((int)(t[b] & 0xF0F0F0F0u), cp, yi[8 * d + 2 * b + 1], false);
        }
    }
}
template <int CTRL, int ROWMASK = 0xF>
__device__ __forceinline__ float dpp_max(float x) {
    const int y = __builtin_amdgcn_update_dpp(__float_as_int(x), __float_as_int(x), CTRL, ROWMASK, 0xF, false);
    return fmaxf(x, __int_as_float(y));
}
__device__ __forceinline__ float wave_max(float v) {
    v = dpp_max<0xB1>(v); v = dpp_max<0x4E>(v); v = dpp_max<0x141>(v); v = dpp_max<0x140>(v); v = dpp_max<0x142, 0xA>(v); v = dpp_max<0x143, 0xC>(v);
    return __int_as_float(__builtin_amdgcn_readlane(__float_as_int(v), 63));
}
__device__ __forceinline__ float wave_sum_b(float v) { return __int_as_float(__builtin_amdgcn_readlane(__float_as_int(wave_sum_l63(v)), 63)); }
__device__ __forceinline__ int quad_pack(int ci) {
    const int b = ci & 0xFF;
    const int d0 = __builtin_amdgcn_update_dpp(0, b, 0x00, 0xF, 0xF, false), d1 = __builtin_amdgcn_update_dpp(0, b, 0x55, 0xF, 0xF, false);
    const int d2 = __builtin_amdgcn_update_dpp(0, b, 0xAA, 0xF, 0xF, false), d3 = __builtin_amdgcn_update_dpp(0, b, 0xFF, 0xF, 0xF, false);
    return d0 | (d1 << 8) | (d2 << 16) | (d3 << 24);
}

__device__ __forceinline__ void ex_finish(const Params& p, int l, const bool LAST, int t, const float (&y)[16], int lane_, const u32x4 w0, const u32x4 w1, const f32x4 (&g2v)[4], const f32x4 (&ng)[4], const f32x4 (&nsc)[4], const f32x4 (&nsh)[4]) {
    const int lane = launder(lane_);
    const int c0 = lane * 16;
    float xv[16];
#pragma unroll
    for (int e = 0; e < 4; ++e) { xv[2 * e] = bflo(w0[e]); xv[2 * e + 1] = bfhi(w0[e]); xv[8 + 2 * e] = bflo(w1[e]); xv[8 + 2 * e + 1] = bfhi(w1[e]); }
#pragma unroll
    for (int q = 0; q < 4; ++q)
#pragma unroll
        for (int e = 0; e < 4; ++e) xv[4 * q + e] += g2v[q][e] * y[4 * q + e];
    if (LAST) {
        float ss2 = 0.f;
#pragma unroll
        for (int e = 0; e < 16; ++e) ss2 += xv[e] * xv[e];
        const float rs2 = rsqrtf(wave_sum_b(ss2) * (1.0f / D_MODEL) + 1e-6f);
#pragma unroll
        for (int q = 0; q < 4; ++q) {
            const int col = c0 + 4 * q;
            const f32x4 gv = ng[q];
            f32x4 o;
#pragma unroll
            for (int e = 0; e < 4; ++e) o[e] = xv[4 * q + e] * rs2 * gv[e];
            __builtin_nontemporal_store(o, (f32x4*)(p.out + (size_t)t * D_MODEL + col));
        }
    } else {
        unsigned xw[8];
#pragma unroll
        for (int e = 0; e < 8; ++e) { xw[e] = pk2(xv[2 * e], xv[2 * e + 1]); xv[2 * e] = bflo(xw[e]); xv[2 * e + 1] = bfhi(xw[e]); }
        __builtin_nontemporal_store((u32x4){xw[0], xw[1], xw[2], xw[3]}, (u32x4*)(p.xb() + (size_t)t * D_MODEL + c0));
        __builtin_nontemporal_store((u32x4){xw[4], xw[5], xw[6], xw[7]}, (u32x4*)(p.xb() + (size_t)t * D_MODEL + c0 + 8));
        float ssr = 0.f;
#pragma unroll
        for (int e = 0; e < 16; ++e) ssr += xv[e] * xv[e];
        const float rs3 = rsqrtf(wave_sum_b(ssr) * (1.0f / D_MODEL) + 1e-6f);
        unsigned hw[8];
#pragma unroll
        for (int q = 0; q < 4; ++q) {
            const int col = c0 + 4 * q;
            const f32x4 gv = ng[q], scv = nsc[q], shv = nsh[q];
            float h[4];
#pragma unroll
            for (int e = 0; e < 4; ++e) h[e] = xv[4 * q + e] * rs3 * gv[e] * (1.0f + scv[e]) + shv[e];
            hw[2 * q] = pk2(h[0], h[1]); hw[2 * q + 1] = pk2(h[2], h[3]);
        }
        __builtin_nontemporal_store((u32x4){hw[0], hw[1], hw[2], hw[3]}, (u32x4*)(p.hb() + (size_t)t * D_MODEL + c0));
        __builtin_nontemporal_store((u32x4){hw[4], hw[5], hw[6], hw[7]}, (u32x4*)(p.hb() + (size_t)t * D_MODEL + c0 + 8));
    }
}


#define EXR 4
#define EXT (16 / EXR)
#define EXTB (16 / EXR)
template <int S>
__device__ __forceinline__ void ex_turnA(G4 (&R)[EXR], const int (&hh8)[8], const int (&hl8)[8], int (&ra)[5], int& KK0, int& KK1, rsrc_t ru, int e0, int e1, int e0n, int e1n, int cofs, int cofsn, int lane, int emask) {
#define EX_A(s) ex_passA<EXR * S + s>(R[s], hh8, hl8, ra, KK0, KK1, lane); asm volatile("" ::: "memory"); \
    if (S < EXT - 1) ex_issueA<(EXR * S + s + EXR) & 15>(R[s], ru, e0, e1, lane, cofs, emask); else ex_issueA<s>(R[s], ru, e0n, e1n, lane, cofsn, emask); asm volatile("" ::: "memory");
    EX_A(0) EX_A(1) EX_A(2) EX_A(3)
#undef EX_A
}
template <int S>
__device__ __forceinline__ void ex_turnB(G4 (&R)[EXR], int (&yi)[16], rsrc_t rv, const LAS u32x4* idc, const LAS u32x4* idn, const LAS unsigned* cpq, int lbase, int lbasen, int emask) {
    u32x4 idv[EXR]; int cpv[EXR];
#pragma unroll
    for (int s = 0; s < EXR; ++s) {
        const int G = EXR * S + s, Gr = (S < EXTB - 1) ? G + EXR : s;
        idv[s] = (S < EXTB - 1 ? idc : idn)[2 * Gr];
        cpv[s] = (int)cpq[(2 * (G & 7)) * 4 + (G < 8 ? 0 : 1)];
    }
#define EX_B(s) ex_passB(R[s], cpv[s], yi); asm volatile("" ::: "memory"); ex_issueB(R[s], rv, idv[s], (S < EXTB - 1) ? lbase : lbasen, emask); asm volatile("" ::: "memory");
    EX_B(0) EX_B(1) EX_B(2) EX_B(3)
#undef EX_B
}
template <int S>
__device__ __forceinline__ void ex_allA(G4 (&R)[EXR], const int (&hh8)[8], const int (&hl8)[8], int (&ra)[5], int& KK0, int& KK1, rsrc_t ru, int e0, int e1, int e0n, int e1n, int cofs, int cofsn, int lane, int emask) {
    if constexpr (S < EXT) { ex_turnA<S>(R, hh8, hl8, ra, KK0, KK1, ru, e0, e1, e0n, e1n, cofs, cofsn, lane, emask); ex_allA<S + 1>(R, hh8, hl8, ra, KK0, KK1, ru, e0, e1, e0n, e1n, cofs, cofsn, lane, emask); }
}
template <int S>
__device__ __forceinline__ void ex_allB(G4 (&R)[EXR], int (&yi)[16], rsrc_t rv, const LAS u32x4* idc, const LAS u32x4* idn, const LAS unsigned* cpq, int lbase, int lbasen, int emask) {
    if constexpr (S < EXTB) { ex_turnB<S>(R, yi, rv, idc, idn, cpq, lbase, lbasen, emask); ex_allB<S + 1>(R, yi, rv, idc, idn, cpq, lbase, lbasen, emask); }
}
template <int V> struct ExIC { static constexpr int value = V; };
#define EX_PRIO(it) do { if ((((it) ^ (wv >> 2)) & 1) != 0) __builtin_amdgcn_s_setprio(1); else __builtin_amdgcn_s_setprio(0); } while (0)
#define EX_TW 8
__device__ __forceinline__ void phase_expert(const Params& p, int l, const bool LAST, LAS unsigned char* lds, int wv, const int emask = 0x3FFF, const bool synth = false) {
    const int tid = tid_opaque(wv), wave = tid >> 6, lane = tid & 63;
    const rsrc_t ru = __builtin_amdgcn_make_buffer_rsrc((void*)(p.ub8() + (size_t)l * NEXP * ROWB), 0, NEXP * ROWB, 0x00020000);
    const rsrc_t rv = __builtin_amdgcn_make_buffer_rsrc((void*)(p.vb8() + (size_t)l * NEXP * ROWB), 0, NEXP * ROWB, 0x00020000);
    const float* uinv = p.uinv() + (size_t)l * NEXP;
    const float* vinv = p.vinv() + (size_t)l * NEXP;
    const int c0 = lane * 16;
    const int tstep = gridDim.x * NWAVES;
    LAS u32x4* cst = (LAS u32x4*)lds + wave * (EX_TW * 16) + (lane >> 2);
    LAS u32x2* kkp = (LAS u32x2*)(lds + 16384 + wave * 16384) + lane;
    LAS u32x4* hsv = (LAS u32x4*)(lds + 16384 + wave * 16384 + 4096) + lane;
    LAS float* hss = (LAS float*)(lds + 16384 + wave * 16384 + 12288) + lane;
    LAS f32x4* yhalf = (LAS f32x4*)(lds + 16384 + wave * 16384) + (lane & 31) * 4;
    for (int tc = blockIdx.x * NWAVES + wave; tc < NTOK; tc += EX_TW * tstep) {
        const int ntw = min(EX_TW, (NTOK - tc + tstep - 1) / tstep), nit = 2 * ntw;
        {
            int e0 = p.eidx()[(size_t)tc * 128 + lane], e1 = p.eidx()[(size_t)tc * 128 + 64 + lane];
            u32x4 pw0 = __builtin_nontemporal_load((const u32x4*)(p.hb() + (size_t)tc * D_MODEL + c0)), pw1 = __builtin_nontemporal_load((const u32x4*)(p.hb() + (size_t)tc * D_MODEL + c0 + 8));
            float pss = p.ssq()[(size_t)tc * 16 + (lane & 15)];
            f32x4 psh[4];
            { const float* mb = p.mod() + ((size_t)l * BATCH + tc / SEQ) * MODW + 3 * D_MODEL + c0;
#pragma unroll
              for (int q = 0; q < 4; ++q) psh[q] = *(const f32x4*)(mb + 4 * q); }
            G4 R[EXR];
            ex_issueA<0>(R[0], ru, e0, e1, lane, 0, emask); ex_issueA<1>(R[1], ru, e0, e1, lane, 0, emask); ex_issueA<2>(R[2], ru, e0, e1, lane, 0, emask); ex_issueA<3>(R[3], ru, e0, e1, lane, 0, emask);
            for (int it = 0; it < nit; ++it) {
                asm volatile("" ::: "memory");
                EX_PRIO(it);
                const int c = it >= ntw ? 1 : 0, k = it - c * ntw, t = tc + k * tstep;
                const int itn = min(it + 1, nit - 1), cn = itn >= ntw ? 1 : 0, tn = tc + (itn - cn * ntw) * tstep;
                const int cofs = c * (ROWB / 2), cofsn = cn * (ROWB / 2);
                const int e0n = p.eidx()[(size_t)tn * 128 + lane], e1n = p.eidx()[(size_t)tn * 128 + 64 + lane];
                float us0, us1, eg0, eg1, vi0, vi1; int usm0, usm1;
                if (c) {
                    us0 = uinv[e0]; us1 = uinv[e1]; usm0 = p.usum()[(size_t)l * NEXP + e0]; usm1 = p.usum()[(size_t)l * NEXP + e1];
                    eg0 = p.egate()[(size_t)t * 128 + lane]; vi0 = vinv[e0]; eg1 = p.egate()[(size_t)t * 128 + 64 + lane]; vi1 = vinv[e1];
                }
                int hh8[8], hl8[8]; float sh;
                {
                    unsigned HH[2], HL[2];
                    if (c == 0) {
                        float tot = pss;
                        tot = dpp_add<0xB1>(tot); tot = dpp_add<0x4E>(tot); tot = dpp_add<0x141>(tot); tot = dpp_add<0x140>(tot);
                        const float rs = rsqrtf(tot * (1.0f / D_MODEL) + 1e-6f);
                        const u32x4 w0 = pw0, w1 = pw1;
                        float hv[16];
#pragma unroll
                        for (int e = 0; e < 4; ++e) { hv[2 * e] = bflo(w0[e]); hv[2 * e + 1] = bfhi(w0[e]); hv[8 + 2 * e] = bflo(w1[e]); hv[8 + 2 * e + 1] = bfhi(w1[e]); }
                        float hm = 0.f;
#pragma unroll
                        for (int q = 0; q < 4; ++q) {
                            const f32x4 shv = psh[q];
#pragma unroll
                            for (int e = 0; e < 4; ++e) { hv[4 * q + e] = hv[4 * q + e] * rs + shv[e]; hm = fmaxf(hm, fabsf(hv[4 * q + e])); }
                        }
                        hm = fmaxf(wave_max(hm), 1e-30f);
                        const float qs = 127.0f / hm; sh = hm * (1.0f / 127.0f);
                        int hb[16];
#pragma unroll
                        for (int e = 0; e < 16; ++e) hb[e] = (int)rintf(hv[e] * qs);
                        HH[0] = HH[1] = HL[0] = HL[1] = 0u;
#pragma unroll
                        for (int e = 0; e < 16; ++e) {
                            const int hi = hb[e] >> 4, lo = (hb[e] & 15) - 8;
                            HH[e >> 3] |= (unsigned)(hi & 0xF) << (4 * (e & 7)); HL[e >> 3] |= (unsigned)(lo & 0xF) << (4 * (e & 7));
                        }
                        hsv[k * 64] = (u32x4){HH[0], HH[1], HL[0], HL[1]}; hss[k * 64] = sh;
                        pw0 = __builtin_nontemporal_load((const u32x4*)(p.hb() + (size_t)tn * D_MODEL + c0)); pw1 = __builtin_nontemporal_load((const u32x4*)(p.hb() + (size_t)tn * D_MODEL + c0 + 8));
                        pss = p.ssq()[(size_t)tn * 16 + (lane & 15)];
                        { const float* mbn = p.mod() + ((size_t)l * BATCH + tn / SEQ) * MODW + 3 * D_MODEL + c0;
#pragma unroll
                          for (int q = 0; q < 4; ++q) psh[q] = *(const f32x4*)(mbn + 4 * q); }
                    } else {
                        const u32x4 hq = hsv[k * 64]; HH[0] = hq.x; HH[1] = hq.y; HL[0] = hq.z; HL[1] = hq.w; sh = hss[k * 64];
                    }
#pragma unroll
                    for (int d = 0; d < 8; ++d) {
                        const int src = c * 32 + 4 * (lane & 7) + (d >> 1);
                        hh8[d] = __shfl((int)HH[d & 1], src, 64); hl8[d] = __shfl((int)HL[d & 1], src, 64);
                    }
                }
                int KK0 = 0, KK1 = 0; int ra[5] = {0, 0, 0, 0, 0};
                ex_allA<0>(R, hh8, hl8, ra, KK0, KK1, ru, e0, e1, e0n, e1n, cofs, cofsn, lane, emask);
                if (c == 0) kkp[k * 64] = (u32x2){(unsigned)KK0, (unsigned)KK1};
                else {
                    const u32x2 kp = kkp[k * 64];
                    KK0 += (int)kp.x; KK1 += (int)kp.y;
                    const float cf0 = gelu_as((float)(KK0 + 8 * usm0) * (us0 * sh)) * (eg0 * vi0), cf1 = gelu_as((float)(KK1 + 8 * usm1) * (us1 * sh)) * (eg1 * vi1);
                    const float cm = fmaxf(wave_max(fmaxf(fabsf(cf0), fabsf(cf1))), 1e-30f);
                    const float cq = 127.0f / cm;
                    const int ci0 = (int)rintf(cf0 * cq), ci1 = (int)rintf(cf1 * cq);
                    const int csum8 = 8 * __builtin_amdgcn_readlane(wave_isum_l63(ci0 + ci1), 63);
                    const u32x4 cv = (u32x4){(unsigned)quad_pack(ci0), (unsigned)quad_pack(ci1), (unsigned)csum8, __float_as_uint(cm * (1.0f / 127.0f))};
                    if ((lane & 3) == 0) cst[k * 16] = cv;
                }
                e0 = e0n; e1 = e1n;
            }
        }
        {
            const int hw = lane >> 5;
            LAS unsigned* idb = (LAS unsigned*)(lds + 147456 + wave * 1024);
            int e0c, e1c;
            {
                const int e0 = p.eidx()[(size_t)tc * 128 + lane], e1 = p.eidx()[(size_t)tc * 128 + 64 + lane];
                idb[lane] = (unsigned)e0; idb[64 + lane] = (unsigned)e1;
                const int t1 = tc + (nit > 1 ? (1 >= ntw ? 1 - ntw : 1) : 0) * tstep;
                e0c = p.eidx()[(size_t)t1 * 128 + lane]; e1c = p.eidx()[(size_t)t1 * 128 + 64 + lane];
            }
            G4 R[EXR];
            {
                const LAS u32x4* idc = (const LAS u32x4*)idb + hw;
                const int lb0 = (lane & 31) * 8;
#pragma unroll
                for (int s = 0; s < EXR; ++s) ex_issueB(R[s], rv, idc[2 * s], lb0, emask);
            }
            auto itemB = [&](auto CC, const int it) __attribute__((always_inline)) {
                asm volatile("" ::: "memory");
                EX_PRIO(it);
                constexpr int c = decltype(CC)::value;
                const int k = it - c * ntw, t = tc + k * tstep;
                const int itn = min(it + 1, nit - 1), cn = itn >= ntw ? 1 : 0, tn = tc + (itn - cn * ntw) * tstep;
                const int lbase = c * (ROWB / 2) + (lane & 31) * 8, lbasen = cn * (ROWB / 2) + (lane & 31) * 8;
                const LAS u32x4* idc = (const LAS u32x4*)(idb + (it & 1) * 128) + hw;
                LAS unsigned* idnw = idb + ((it + 1) & 1) * 128;
                {
                    idnw[lane] = (unsigned)e0c; idnw[64 + lane] = (unsigned)e1c;
                    const int it2 = min(it + 2, nit - 1), c2 = it2 >= ntw ? 1 : 0, t2 = tc + (it2 - c2 * ntw) * tstep;
                    e0c = p.eidx()[(size_t)t2 * 128 + lane]; e1c = p.eidx()[(size_t)t2 * 128 + 64 + lane];
                }
                const LAS u32x4* idn = (const LAS u32x4*)idnw + hw;
                u32x4 fw0, fw1;
                f32x4 fg2[4], ng[4], nsc[4], nsh[4];
                if constexpr (c != 0) {
                    fw0 = __builtin_nontemporal_load((const u32x4*)(p.xb() + (size_t)t * D_MODEL + c0)); fw1 = __builtin_nontemporal_load((const u32x4*)(p.xb() + (size_t)t * D_MODEL + c0 + 8));
                    const float* mbf = p.mod() + ((size_t)l * BATCH + t / SEQ) * MODW + 5 * D_MODEL + c0;
#pragma unroll
                    for (int q = 0; q < 4; ++q) fg2[q] = *(const f32x4*)(mbf + 4 * q);
                    if (LAST) {
#pragma unroll
                        for (int q = 0; q < 4; ++q) ng[q] = *(const f32x4*)(p.final_g + c0 + 4 * q);
                    } else {
                        const float* mn = p.mod() + ((size_t)(l + 1) * BATCH + t / SEQ) * MODW + c0;
                        const float* n1g = p.norm1_g + (l + 1) * D_MODEL + c0;
#pragma unroll
                        for (int q = 0; q < 4; ++q) { ng[q] = *(const f32x4*)(n1g + 4 * q); nsc[q] = *(const f32x4*)(mn + 1 * D_MODEL + 4 * q); nsh[q] = *(const f32x4*)(mn + 4 * q); }
                    }
                }
                const LAS unsigned* cpq = (const LAS unsigned*)((LAS u32x4*)lds + wave * (EX_TW * 16) + k * 16 + hw);
                const u32x4 cs = cst[k * 16];
                const int csum8 = (int)cs.z; const float ys = __uint_as_float(cs.w);
                int yi[16];
#pragma unroll
                for (int e = 0; e < 16; ++e) yi[e] = 0;
                ex_allB<0>(R, yi, rv, idc, idn, cpq, lbase, lbasen, emask);
                float y[16];
#pragma unroll
                for (int e = 0; e < 16; ++e) {
                    const int yt = yi[e] + __shfl_xor(yi[e], 32, 64);
                    y[e] = (e & 1) ? (float)yt * (ys * 0.0625f) : (float)(yt - csum8) * ys;
                }
                if constexpr (c == 0) {
                    if (lane < 32) {
#pragma unroll
                        for (int q = 0; q < 4; ++q) yhalf[k * 128 + q] = (f32x4){y[4 * q], y[4 * q + 1], y[4 * q + 2], y[4 * q + 3]};
                    }
                } else {
                    if (lane < 32) {
#pragma unroll
                        for (int q = 0; q < 4; ++q) { const f32x4 v = yhalf[k * 128 + q]; y[4 * q] = v[0]; y[4 * q + 1] = v[1]; y[4 * q + 2] = v[2]; y[4 * q + 3] = v[3]; }
                    }
                    if (synth) {
#pragma unroll
                        for (int q = 0; q < 4; ++q) *(f32x4*)((float*)p.qb() + (size_t)t * D_MODEL + c0 + 4 * q) = (f32x4){y[4 * q], y[4 * q + 1], y[4 * q + 2], y[4 * q + 3]};
                    } else ex_finish(p, l, LAST, t, y, lane, fw0, fw1, fg2, ng, nsc, nsh);
                }
            };
            for (int it = 0; it < ntw; ++it) itemB(ExIC<0>{}, it);
            for (int it = ntw; it < nit; ++it) itemB(ExIC<1>{}, it);
        }
    }
    __builtin_amdgcn_s_setprio(0);
}
#if MK_MULTI
__global__ void __launch_bounds__(512, 2) k_expert(Params p, int l) {
    extern __shared__ __attribute__((aligned(16))) unsigned char smem_raw[];
    phase_expert(p, l, l == DEPTH - 1, (LAS unsigned char*)smem_raw, __builtin_amdgcn_readfirstlane((int)threadIdx.x >> 6));
}
#endif
typedef short s16x4 __attribute__((ext_vector_type(4)));
#define AT_KSTR 144
#define AT_VSTR 192
#define AT_KBUF 0
#define AT_VBUF 18432
#define AT_TBL  43008
#define AT_OEX  44032
#define AT_OSTR 272

__device__ __forceinline__ void phase_attn(const Params& p, int l, LAS unsigned char* lds, int wv) {
    const int tid = tid_opaque(wv), wave = tid >> 6, lane = tid & 63;
    const int w4 = wave & 3, m = wave >> 2, c = lane & 31, h = lane >> 5;
    const float LOG2E = 1.4426950408889634f;
    const float qscale = 0.17677669529663687f * LOG2E;
    float d01 = 0.f, d23 = 0.f;
    { const float* lp = p.diff_lambda + l * 128;
      for (int i = 0; i < 32; ++i) { d01 += lp[i] * lp[32 + i]; d23 += lp[64 + i] * lp[96 + i]; } }
    const float lam_init = p.lam_init[l];
    const float lam = expf(d01) - expf(d23) + lam_init;
    const float osc = 1.0f - lam_init;
    LAS float* tbl = (LAS float*)(lds + AT_TBL);
    const int skey = tid >> 3, sch = tid & 7;
    const int g16 = lane >> 4, li = lane & 15, tq = li >> 2, tp = li & 3;

    for (int u = blockIdx.x; u < 256; u += gridDim.x) {
        const int pi = u & 7, hd = (u >> 3) & 3, b = u >> 5;
        if (tid < 256) { const int bk = tid < 128 ? (int)kBucket[tid] : 31; tbl[tid] = p.rel_bias[bk * 4 + hd] * LOG2E; }
        const float c31 = p.rel_bias[31 * 4 + hd] * LOG2E;
        const bf16_t* pbase = p.pb() + (size_t)b * SEQ * MIX_IN;
        const bf16_t* kg = pbase + (size_t)skey * MIX_IN + 256 + hd * 64 + sch * 8;
        const bf16_t* vg = pbase + (size_t)skey * MIX_IN + 512 + hd * 64 + sch * 8;
        for (int half = 0; half < 2; ++half) {
            const int qb = half ? 15 - pi : pi;
            const int q0w = qb * 128 + 32 * w4, nkt = 2 * qb + 2;
            const int qpos = q0w + c;
            bf16x8 qf0, qf1;
            { const bf16_t* qp = pbase + (size_t)qpos * MIX_IN + hd * 64 + m * 32 + 8 * h; qf0 = *(const bf16x8*)qp; qf1 = *(const bf16x8*)(qp + 16); }
            f32x16 O0, O1;
#pragma unroll
            for (int r = 0; r < 16; ++r) { O0[r] = 0.f; O1[r] = 0.f; }
            float mrun = -1e30f, lrun = 0.f;
            u32x4 kreg = *(const u32x4*)kg, vreg = *(const u32x4*)vg;
            *(LAS u32x4*)(lds + AT_KBUF + skey * AT_KSTR + sch * 16) = kreg;
            *(LAS u32x4*)(lds + AT_VBUF + skey * AT_VSTR + sch * 16) = vreg;
            __syncthreads();
            for (int kt = 0; kt < nkt; ++kt) {
                const int k0 = kt * 64, cur = kt & 1;
                if (kt + 1 < nkt) { kreg = *(const u32x4*)(kg + (size_t)(k0 + 64) * MIX_IN); vreg = *(const u32x4*)(vg + (size_t)(k0 + 64) * MIX_IN); }
                if (k0 <= q0w + 31) {
                    LAS unsigned char* kb_ = lds + AT_KBUF + cur * (64 * AT_KSTR);
                    LAS unsigned char* vb_ = lds + AT_VBUF + cur * (64 * AT_VSTR);
                    f32x16 s0, s1;
#pragma unroll
                    for (int r = 0; r < 16; ++r) { s0[r] = 0.f; s1[r] = 0.f; }
                    {
                        const LAS unsigned char* ka = kb_ + c * AT_KSTR + m * 64 + h * 16;
                        const bf16x8 a00 = *(const LAS bf16x8*)ka, a01 = *(const LAS bf16x8*)(ka + 32);
                        const bf16x8 a10 = *(const LAS bf16x8*)(ka + 32 * AT_KSTR), a11 = *(const LAS bf16x8*)(ka + 32 * AT_KSTR + 32);
                        s0 = __builtin_amdgcn_mfma_f32_32x32x16_bf16(a00, qf0, s0, 0, 0, 0);
                        s0 = __builtin_amdgcn_mfma_f32_32x32x16_bf16(a01, qf1, s0, 0, 0, 0);
                        s1 = __builtin_amdgcn_mfma_f32_32x32x16_bf16(a10, qf0, s1, 0, 0, 0);
                        s1 = __builtin_amdgcn_mfma_f32_32x32x16_bf16(a11, qf1, s1, 0, 0, 0);
                    }
                    const bool far = (q0w - (k0 + 63)) >= 113;
                    if (far) {
#pragma unroll
                        for (int r = 0; r < 16; ++r) { s0[r] = s0[r] * qscale + c31; s1[r] = s1[r] * qscale + c31; }
                    } else {
                        const int dbase = qpos - k0 - 4 * h;
#pragma unroll
                        for (int r = 0; r < 16; ++r) {
                            const int d0 = dbase - ((r & 3) + 8 * (r >> 2)), d1 = d0 - 32;
                            const float b0 = tbl[min(max(d0, 0), 255)], b1 = tbl[min(max(d1, 0), 255)];
                            const float v0 = s0[r] * qscale + b0, v1 = s1[r] * qscale + b1;
                            s0[r] = d0 < 0 ? -1e30f : v0; s1[r] = d1 < 0 ? -1e30f : v1;
                        }
                    }
                    float tmax = fmaxf(s0[0], s1[0]);
#pragma unroll
                    for (int r = 1; r < 16; ++r) tmax = fmaxf(tmax, fmaxf(s0[r], s1[r]));
                    tmax = fmaxf(tmax, __shfl_xor(tmax, 32, 64));
                    const float mnew = fmaxf(mrun, tmax);
                    const float alpha = __builtin_amdgcn_exp2f(mrun - mnew);
                    mrun = mnew;
                    float psum = 0.f;
#pragma unroll
                    for (int r = 0; r < 16; ++r) { s0[r] = __builtin_amdgcn_exp2f(s0[r] - mnew); s1[r] = __builtin_amdgcn_exp2f(s1[r] - mnew); psum += s0[r] + s1[r]; }
                    lrun = lrun * alpha + psum;
#pragma unroll
                    for (int r = 0; r < 16; ++r) { O0[r] *= alpha; O1[r] *= alpha; }
#pragma unroll
                    for (int kb = 0; kb < 2; ++kb)
#pragma unroll
                        for (int sp = 0; sp < 2; ++sp) {
                            u32x4 pw;
                            if (kb == 0) { pw.x = pk2(s0[8 * sp + 0], s0[8 * sp + 1]); pw.y = pk2(s0[8 * sp + 2], s0[8 * sp + 3]); pw.z = pk2(s0[8 * sp + 4], s0[8 * sp + 5]); pw.w = pk2(s0[8 * sp + 6], s0[8 * sp + 7]); }
                            else         { pw.x = pk2(s1[8 * sp + 0], s1[8 * sp + 1]); pw.y = pk2(s1[8 * sp + 2], s1[8 * sp + 3]); pw.z = pk2(s1[8 * sp + 4], s1[8 * sp + 5]); pw.w = pk2(s1[8 * sp + 6], s1[8 * sp + 7]); }
                            const bf16x8 pf = __builtin_bit_cast(bf16x8, pw);
                            const int kA = 32 * kb + 16 * sp + 4 * h;
#pragma unroll
                            for (int mb = 0; mb < 2; ++mb) {
                                LAS unsigned char* va = vb_ + (kA + tq) * AT_VSTR + (32 * mb + 16 * (g16 & 1) + 4 * tp) * 2;
                                const s16x4 t0 = __builtin_amdgcn_ds_read_tr16_b64_v4i16((LAS s16x4*)va);
                                const s16x4 t1 = __builtin_amdgcn_ds_read_tr16_b64_v4i16((LAS s16x4*)(va + 8 * AT_VSTR));
                                const bf16x8 vf = {t0[0], t0[1], t0[2], t0[3], t1[0], t1[1], t1[2], t1[3]};
                                if (mb == 0) O0 = __builtin_amdgcn_mfma_f32_32x32x16_bf16(vf, pf, O0, 0, 0, 0);
                                else         O1 = __builtin_amdgcn_mfma_f32_32x32x16_bf16(vf, pf, O1, 0, 0, 0);
                            }
                        }
                }
                if (kt + 1 < nkt) {
                    *(LAS u32x4*)(lds + AT_KBUF + (cur ^ 1) * (64 * AT_KSTR) + skey * AT_KSTR + sch * 16) = kreg;
                    *(LAS u32x4*)(lds + AT_VBUF + (cur ^ 1) * (64 * AT_VSTR) + skey * AT_VSTR + sch * 16) = vreg;
                }
                __syncthreads();
            }
            const float inv = 1.0f / (lrun + __shfl_xor(lrun, 32, 64));
            LAS unsigned char* oex = lds + AT_OEX + (32 * w4 + c) * AT_OSTR + 16 * h;
            if (m == 1) {
#pragma unroll
                for (int r4 = 0; r4 < 4; ++r4) {
                    f32x4 a, bq;
#pragma unroll
                    for (int e = 0; e < 4; ++e) { a[e] = O0[4 * r4 + e] * inv; bq[e] = O1[4 * r4 + e] * inv; }
                    *(LAS f32x4*)(oex + (8 * r4) * 4) = a;
                    *(LAS f32x4*)(oex + (32 + 8 * r4) * 4) = bq;
                }
            }
            __syncthreads();
            if (m == 0) {
                float ss = 0.f;
#pragma unroll
                for (int r4 = 0; r4 < 4; ++r4) {
                    const f32x4 a = *(const LAS f32x4*)(oex + (8 * r4) * 4), bq = *(const LAS f32x4*)(oex + (32 + 8 * r4) * 4);
#pragma unroll
                    for (int e = 0; e < 4; ++e) {
                        O0[4 * r4 + e] = O0[4 * r4 + e] * inv - lam * a[e]; O1[4 * r4 + e] = O1[4 * r4 + e] * inv - lam * bq[e];
                        ss += O0[4 * r4 + e] * O0[4 * r4 + e] + O1[4 * r4 + e] * O1[4 * r4 + e];
                    }
                }
                ss += __shfl_xor(ss, 32, 64);
                const float rstd = rsqrtf(ss * (1.0f / 64.0f) + 1e-6f) * osc;
                bf16_t* orow = p.cat() + (size_t)(b * SEQ + qpos) * D_MODEL + hd * 64 + 4 * h;
                const float* sg = p.subln_g + l * 64 + 4 * h;
#pragma unroll
                for (int r4 = 0; r4 < 4; ++r4) {
                    const f32x4 ga = *(const f32x4*)(sg + 8 * r4), gb = *(const f32x4*)(sg + 32 + 8 * r4);
                    u32x2 oa, ob;
                    oa.x = pk2(O0[4 * r4 + 0] * rstd * ga[0], O0[4 * r4 + 1] * rstd * ga[1]); oa.y = pk2(O0[4 * r4 + 2] * rstd * ga[2], O0[4 * r4 + 3] * rstd * ga[3]);
                    ob.x = pk2(O1[4 * r4 + 0] * rstd * gb[0], O1[4 * r4 + 1] * rstd * gb[1]); ob.y = pk2(O1[4 * r4 + 2] * rstd * gb[2], O1[4 * r4 + 3] * rstd * gb[3]);
                    *(u32x2*)(orow + 8 * r4) = oa;
                    *(u32x2*)(orow + 32 + 8 * r4) = ob;
                }
            }
            __syncthreads();
        }
    }
}
#if MK_MULTI
template <int DUMMY>
__global__ void __launch_bounds__(512, 2) k_attn2(Params p, int l) {
    extern __shared__ __attribute__((aligned(16))) unsigned char smem_raw[];
    phase_attn(p, l, (LAS unsigned char*)smem_raw, __builtin_amdgcn_readfirstlane((int)threadIdx.x >> 6));
}
#endif
#define MR_VSTR 272

__device__ __forceinline__ void mixrest_sconv(const Params& p, int l, int t0, int s0, int tid, int k0) {
    const float* sw = p.sconv_w + (size_t)l * 3 * 256;
    const int c8 = (tid & 31) * 8;
    f32x4 w0[3], w1[3];
#pragma unroll
    for (int j = 0; j < 3; ++j) { w0[j] = *(const f32x4*)(sw + j * 256 + c8); w1[j] = *(const f32x4*)(sw + j * 256 + c8 + 4); }
#pragma unroll 2
    for (int k = k0; k < k0 + 4; ++k) {
        const int tt = (tid >> 5) + 16 * k;
        const bf16_t* pr = p.pb() + (size_t)(t0 + tt) * MIX_IN;
        u32x4 a[3], bq[3];
#pragma unroll
        for (int j = 0; j < 3; ++j) {
            const bool ok = (s0 + tt - 2 + j >= 0);
            const bf16_t* q = pr + (ptrdiff_t)(ok ? (j - 2) : 0) * MIX_IN;
            a[j] = *(const u32x4*)(q + 6 * 256 + c8); bq[j] = *(const u32x4*)(q + 7 * 256 + c8);
            if (!ok) { a[j] = (u32x4){0u, 0u, 0u, 0u}; }
        }
        const u32x4 cb = *(const u32x4*)(pr + 5 * 256 + c8);
        float z[8];
#pragma unroll
        for (int e = 0; e < 8; ++e) z[e] = 0.f;
#pragma unroll
        for (int j = 0; j < 3; ++j) {
            z[0] += w0[j][0] * bflo(a[j].x) * bflo(bq[j].x); z[1] += w0[j][1] * bfhi(a[j].x) * bfhi(bq[j].x);
            z[2] += w0[j][2] * bflo(a[j].y) * bflo(bq[j].y); z[3] += w0[j][3] * bfhi(a[j].y) * bfhi(bq[j].y);
            z[4] += w1[j][0] * bflo(a[j].z) * bflo(bq[j].z); z[5] += w1[j][1] * bfhi(a[j].z) * bfhi(bq[j].z);
            z[6] += w1[j][2] * bflo(a[j].w) * bflo(bq[j].w); z[7] += w1[j][3] * bfhi(a[j].w) * bfhi(bq[j].w);
        }
        u32x4 o;
        o.x = pk2(bflo(cb.x) * z[0], bfhi(cb.x) * z[1]); o.y = pk2(bflo(cb.y) * z[2], bfhi(cb.y) * z[3]);
        o.z = pk2(bflo(cb.z) * z[4], bfhi(cb.z) * z[5]); o.w = pk2(bflo(cb.w) * z[6], bfhi(cb.w) * z[7]);
        *(u32x4*)(p.cat() + (size_t)(t0 + tt) * D_MODEL + 512 + c8) = o;
    }
}

__device__ __forceinline__ void mixrest_conv(const Params& p, int l, int chunk, LAS unsigned char* lds, int wv) {
    const int tid = tid_opaque(wv), wave = tid >> 6, lane = tid & 63;
    const int t0 = chunk * 128, s0 = t0 % SEQ;
    LAS float* glu = (LAS float*)lds;
    mixrest_sconv(p, l, t0, s0, tid, 0);
    const int c = tid & 255, th = tid >> 8;
    float w[31];
#pragma unroll
    for (int j = 0; j < 31; ++j) w[j] = p.conf_dw[((size_t)l * 31 + j) * 256 + c];
    for (int hf = 0; hf < 2; ++hf) {
        const int tb = t0 + hf * 64;
        {
            u32x4 ga[6], gg[6];
#pragma unroll
            for (int q = 0; q < 6; ++q) {
                const int it = tid + 512 * q, i = it >> 5, c8 = (it & 31) * 8;
                const int sp = s0 + hf * 64 - 30 + i;
                ga[q] = (u32x4){0u, 0u, 0u, 0u}; gg[q] = ga[q];
                if (it < 94 * 32 && sp >= 0) {
                    const bf16_t* pr = p.pb() + (size_t)(tb - 30 + i) * MIX_IN;
                    ga[q] = *(const u32x4*)(pr + 3 * 256 + c8); gg[q] = *(const u32x4*)(pr + 4 * 256 + c8);
                }
            }
#pragma unroll
            for (int q = 0; q < 6; ++q) {
                const int it = tid + 512 * q, i = it >> 5, c8 = (it & 31) * 8;
                if (it < 94 * 32) {
                    const u32x4 a = ga[q], g = gg[q];
                    f32x4 o0, o1;
                    o0[0] = bflo(a.x) * sigmoidf_(bflo(g.x)); o0[1] = bfhi(a.x) * sigmoidf_(bfhi(g.x));
                    o0[2] = bflo(a.y) * sigmoidf_(bflo(g.y)); o0[3] = bfhi(a.y) * sigmoidf_(bfhi(g.y));
                    o1[0] = bflo(a.z) * sigmoidf_(bflo(g.z)); o1[1] = bfhi(a.z) * sigmoidf_(bfhi(g.z));
                    o1[2] = bflo(a.w) * sigmoidf_(bflo(g.w)); o1[3] = bfhi(a.w) * sigmoidf_(bfhi(g.w));
                    *(LAS f32x4*)(glu + i * 256 + c8) = o0; *(LAS f32x4*)(glu + i * 256 + c8 + 4) = o1;
                }
            }
        }
        __syncthreads();
        float acc[32];
#pragma unroll
        for (int o = 0; o < 32; ++o) acc[o] = 0.f;
#pragma unroll
        for (int i = 0; i < 62; ++i) {
            const float xval = glu[(th * 32 + i) * 256 + c];
#pragma unroll
            for (int o = 0; o < 32; ++o) if (i - o >= 0 && i - o <= 30) acc[o] += w[i - o] * xval;
        }
        __syncthreads();
#pragma unroll
        for (int o = 0; o < 32; ++o) glu[(th * 32 + o) * 256 + c] = acc[o];
        __syncthreads();
        const f32x4 lg = *(const f32x4*)(p.conf_ln_g + l * 256 + lane * 4), lb = *(const f32x4*)(p.conf_ln_b + l * 256 + lane * 4);
        {
            f32x4 z[8]; float mu[8], rstd[8];
#pragma unroll
            for (int k = 0; k < 8; ++k) { z[k] = *(const LAS f32x4*)(glu + (wave * 8 + k) * 256 + lane * 4); mu[k] = (z[k][0] + z[k][1]) + (z[k][2] + z[k][3]); }
#pragma unroll
            for (int o = 32; o > 0; o >>= 1)
#pragma unroll
                for (int k = 0; k < 8; ++k) mu[k] += __shfl_xor(mu[k], o, 64);
#pragma unroll
            for (int k = 0; k < 8; ++k) { mu[k] *= (1.0f / 256.0f); float sq = 0.f;
#pragma unroll
                for (int e = 0; e < 4; ++e) { z[k][e] -= mu[k]; sq += z[k][e] * z[k][e]; }
                rstd[k] = sq; }
#pragma unroll
            for (int o = 32; o > 0; o >>= 1)
#pragma unroll
                for (int k = 0; k < 8; ++k) rstd[k] += __shfl_xor(rstd[k], o, 64);
#pragma unroll
            for (int k = 0; k < 8; ++k) {
                const float rs = rsqrtf(rstd[k] * (1.0f / 256.0f) + 1e-6f);
                float y[4];
#pragma unroll
                for (int e = 0; e < 4; ++e) { const float v = z[k][e] * rs * lg[e] + lb[e]; y[e] = v * sigmoidf_(v); }
                u32x2 o; o.x = pk2(y[0], y[1]); o.y = pk2(y[2], y[3]);
                *(u32x2*)(p.cat() + (size_t)(tb + wave * 8 + k) * D_MODEL + 256 + lane * 4) = o;
            }
        }
        __syncthreads();
    }
}

__device__ __forceinline__ void mixrest_sgu(const Params& p, int l, int chunk, LAS unsigned char* lds, int wv) {
    const int tid = tid_opaque(wv), wave = tid >> 6, lane = tid & 63;
    const int t0 = chunk * 128, s0 = t0 % SEQ;
    mixrest_sconv(p, l, t0, s0, tid, 4);
    {
        const f32x4 lg = *(const f32x4*)(p.sgu_ln_g + l * 256 + lane * 4), lb = *(const f32x4*)(p.sgu_ln_b + l * 256 + lane * 4);
#pragma unroll 1
        for (int k0 = 0; k0 < 16; k0 += 8) {
            float v[8][4], mu[8], sq[8];
            u32x2 raw[8];
#pragma unroll
            for (int k = 0; k < 8; ++k) raw[k] = *(const u32x2*)(p.pb() + (size_t)(t0 + wave * 16 + k0 + k) * MIX_IN + 9 * 256 + lane * 4);
#pragma unroll
            for (int k = 0; k < 8; ++k) {
                v[k][0] = gelu_as(bflo(raw[k].x)); v[k][1] = gelu_as(bfhi(raw[k].x)); v[k][2] = gelu_as(bflo(raw[k].y)); v[k][3] = gelu_as(bfhi(raw[k].y));
                mu[k] = (v[k][0] + v[k][1]) + (v[k][2] + v[k][3]);
            }
#pragma unroll
            for (int o = 32; o > 0; o >>= 1)
#pragma unroll
                for (int k = 0; k < 8; ++k) mu[k] += __shfl_xor(mu[k], o, 64);
#pragma unroll
            for (int k = 0; k < 8; ++k) { mu[k] *= (1.0f / 256.0f); sq[k] = 0.f;
#pragma unroll
                for (int e = 0; e < 4; ++e) { v[k][e] -= mu[k]; sq[k] += v[k][e] * v[k][e]; } }
#pragma unroll
            for (int o = 32; o > 0; o >>= 1)
#pragma unroll
                for (int k = 0; k < 8; ++k) sq[k] += __shfl_xor(sq[k], o, 64);
#pragma unroll
            for (int k = 0; k < 8; ++k) {
                const float rstd = rsqrtf(sq[k] * (1.0f / 256.0f) + 1e-6f);
                const int s2 = wave * 16 + k0 + k;
#pragma unroll
                for (int e = 0; e < 4; ++e) *(LAS bf16_t*)(lds + (lane * 4 + e) * MR_VSTR + s2 * 2) = f2bf(v[k][e] * rstd * lg[e] + lb[e]);
            }
        }
    }
    __syncthreads();
    {
        const int hq = wave & 3, mb = wave >> 2, c = lane & 31, hh = lane >> 5;
        bf16x8 af[8];
#pragma unroll
        for (int ks = 0; ks < 8; ++ks) af[ks] = *(const LAS bf16x8*)(lds + (hq * 64 + mb * 32 + c) * MR_VSTR + (16 * ks + 8 * hh) * 2);
        const bf16_t* wb = p.sguwb() + ((size_t)(l * 4 + hq) * 128) * 128;
        u32x2 suw[4][4];
#pragma unroll
        for (int nb = 0; nb < 4; ++nb)
#pragma unroll
            for (int r4 = 0; r4 < 4; ++r4) suw[nb][r4] = *(const u32x2*)(p.pb() + (size_t)(t0 + 32 * nb + c) * MIX_IN + 8 * 256 + hq * 64 + mb * 32 + 4 * hh + 8 * r4);
        f32x16 acc[4];
#pragma unroll
        for (int nb = 0; nb < 4; ++nb) {
#pragma unroll
            for (int r = 0; r < 16; ++r) acc[nb][r] = 0.f;
#pragma unroll
            for (int ks = 0; ks < 2 * nb + 2; ++ks) {
                const bf16x8 bfrag = *(const bf16x8*)(wb + (size_t)(32 * nb + c) * 128 + 16 * ks + 8 * hh);
                acc[nb] = __builtin_amdgcn_mfma_f32_32x32x16_bf16(af[ks], bfrag, acc[nb], 0, 0, 0);
            }
        }
        const float* bs = p.sgu_b + (size_t)(l * 4 + hq) * 128;
#pragma unroll
        for (int nb = 0; nb < 4; ++nb) {
            const int tt = 32 * nb + c;
            const float bias = bs[tt];
            const bf16_t* su = p.pb() + (size_t)(t0 + tt) * MIX_IN + 8 * 256 + hq * 64 + mb * 32 + 4 * hh;
            bf16_t* orow = p.cat() + (size_t)(t0 + tt) * D_MODEL + 768 + hq * 64 + mb * 32 + 4 * hh;
#pragma unroll
            for (int r4 = 0; r4 < 4; ++r4) {
                const u32x2 raw = suw[nb][r4];
                u32x2 o;
                o.x = pk2(gelu_as(bflo(raw.x)) * (acc[nb][4 * r4 + 0] + bias), gelu_as(bfhi(raw.x)) * (acc[nb][4 * r4 + 1] + bias));
                o.y = pk2(gelu_as(bflo(raw.y)) * (acc[nb][4 * r4 + 2] + bias), gelu_as(bfhi(raw.y)) * (acc[nb][4 * r4 + 3] + bias));
                *(u32x2*)(orow + 8 * r4) = o;
            }
        }
    }
    __syncthreads();
}

__device__ __forceinline__ void phase_mixrest(const Params& p, int l, LAS unsigned char* lds, int wv) {
    for (int u = blockIdx.x; u < 256; u += gridDim.x) {
        const int chunk = u >> 1;
        if (u & 1) mixrest_sgu(p, l, chunk, lds, wv); else mixrest_conv(p, l, chunk, lds, wv);
    }
}
#if MK_MULTI
template <int DUMMY>
__global__ void __launch_bounds__(512, 2) k_mixrest(Params p, int l) {
    extern __shared__ __attribute__((aligned(16))) unsigned char smem_raw[];
    phase_mixrest(p, l, (LAS unsigned char*)smem_raw, __builtin_amdgcn_readfirstlane((int)threadIdx.x >> 6));
}
#endif
__device__ __forceinline__ int f2sortable(float f) { const int x = __float_as_int(f); return x ^ ((x >> 31) & 0x7FFFFFFF); }
__device__ __forceinline__ float sortable2f(int s) { return __int_as_float(s ^ ((s >> 31) & 0x7FFFFFFF)); }

template <int N>
__device__ __forceinline__ void bitonic_sort_desc(int (&a)[N]) {
#pragma unroll
    for (int k = 2; k <= N; k <<= 1)
#pragma unroll
        for (int j = k >> 1; j > 0; j >>= 1)
#pragma unroll
            for (int i = 0; i < N; ++i) {
                const int q = i ^ j;
                if (q > i) {
                    const int hi = max(a[i], a[q]), lo = min(a[i], a[q]);
                    if ((i & k) == 0 || k == N) { a[i] = hi; a[q] = lo; } else { a[i] = lo; a[q] = hi; }
                }
            }
}
__device__ __forceinline__ void sort16_desc(int (&a)[16]) {
#define CE(i, j) { const int hi_ = max(a[i], a[j]), lo_ = min(a[i], a[j]); a[i] = hi_; a[j] = lo_; }
    CE(0,13) CE(1,12) CE(2,15) CE(3,14) CE(4,8) CE(5,6) CE(7,11) CE(9,10) CE(0,5) CE(1,7) CE(2,9) CE(3,4) CE(6,13) CE(8,14) CE(10,15) CE(11,12) CE(0,1) CE(2,3) CE(4,5) CE(6,8) CE(7,9) CE(10,11) CE(12,13) CE(14,15) CE(0,2) CE(1,3) CE(4,10) CE(5,11) CE(6,7) CE(8,9) CE(12,14) CE(13,15) CE(1,2) CE(3,12) CE(4,6) CE(5,7) CE(8,10) CE(9,11) CE(13,14) CE(1,4) CE(2,6) CE(5,8) CE(7,10) CE(9,13) CE(11,14) CE(2,4) CE(3,6) CE(9,12) CE(11,13) CE(3,5) CE(6,8) CE(7,9) CE(10,12) CE(3,4) CE(5,6) CE(7,8) CE(9,10) CE(11,12) CE(6,7) CE(8,9)
#undef CE
}
__device__ __forceinline__ void bitonic_merge_desc16(int (&a)[16]) {
#pragma unroll
    for (int j = 8; j > 0; j >>= 1)
#pragma unroll
        for (int i = 0; i < 16; ++i) {
            const int q = i ^ j;
            if (q > i) { const int hi = max(a[i], a[q]), lo = min(a[i], a[q]); a[i] = hi; a[q] = lo; }
        }
}
__device__ __forceinline__ void merge_top16(int (&a)[16], const int (&b)[16]) {
#pragma unroll
    for (int i = 0; i < 16; ++i) a[i] = max(a[i], b[15 - i]);
    bitonic_merge_desc16(a);
}

#define TK_OFS 128.0f
#define TK_KEYS 8192
#define TK_KSTR 272
template <bool TO_LDS>
__device__ __forceinline__ void topk_unit(const Params& p, int l, int u, int hd, LAS unsigned char* lds, int wave, int lane, LAS int* le, LAS float* lg) {
    const int c = lane & 31, hh = lane >> 5;
    LAS unsigned char* ilist = lds + wave * 1024 + c * 32;
    const int hx = hh << 2;
    const __amdgpu_buffer_rsrc_t rq = __builtin_amdgcn_make_buffer_rsrc((void*)p.qb(), 0, NTOK * 2048 * 2, 0x00020000);
    const int qvoff = c * 4096 + hh * 16;
    {
        const int t = u * 32 + c;
        int S0[16], S1[16];
#pragma unroll
        for (int pp = 0; pp < 2; ++pp) {
            bf16x8 qf[8];
            {
                const int qso = (u * 32) * 4096 + hd * 512 + pp * 256;
#pragma unroll
                for (int ks = 0; ks < 8; ++ks) qf[ks] = __builtin_bit_cast(bf16x8, __builtin_amdgcn_raw_buffer_load_b128(rq, qvoff + 32 * ks, qso, 0));
            }
            const LAS unsigned char* kl = lds + TK_KEYS + (pp * 128 + c) * TK_KSTR + hh * 16;
            int K0[16], K1[16], K2[16], K3[16];
#pragma unroll
            for (int kb = 0; kb < 4; ++kb) {
                asm volatile("" ::: "memory");
                f32x16 acc;
#pragma unroll
                for (int r = 0; r < 16; ++r) acc[r] = TK_OFS;
#pragma unroll
                for (int ks = 0; ks < 8; ++ks) {
                    const bf16x8 a = *(const LAS bf16x8*)(kl + (32 * kb) * TK_KSTR + 32 * ks);
                    acc = __builtin_amdgcn_mfma_f32_32x32x16_bf16(a, qf[ks], acc, 0, 0, 0);
                }
#pragma unroll
                for (int r = 0; r < 16; ++r) {
                    const int nconst = 32 * kb + (r & 3) + 8 * (r >> 2);
                    const int key = (__float_as_int(acc[r]) & ~0x7F) | (127 - nconst);
                    if (kb == 0) K0[r] = key; else if (kb == 1) K1[r] = key; else if (kb == 2) K2[r] = key; else K3[r] = key;
                }
            }
            sort16_desc(K0); sort16_desc(K1); sort16_desc(K2); sort16_desc(K3);
            merge_top16(K0, K1); merge_top16(K2, K3); merge_top16(K0, K2);
            int P[16];
#pragma unroll
            for (int i = 0; i < 16; ++i) { K0[i] ^= hx; P[i] = __shfl_xor(K0[i], 32, 64); }
            merge_top16(K0, P);
#pragma unroll
            for (int i = 0; i < 16; ++i) { if (pp == 0) S0[i] = K0[i]; else S1[i] = K0[i]; }
        }
        {
            unsigned w4[4];
#pragma unroll
            for (int q = 0; q < 4; ++q) {
                unsigned w = 0;
#pragma unroll
                for (int e = 0; e < 4; ++e) { const int sv = hh ? S1[4 * q + e] : S0[4 * q + e]; w |= (unsigned)(127 - (sv & 127)) << (8 * e); }
                w4[q] = w;
            }
            u32x4 wv; wv.x = w4[0]; wv.y = w4[1]; wv.z = w4[2]; wv.w = w4[3];
            *(LAS u32x4*)(ilist + 16 * hh) = wv;
        }
        float a[16], b[16];
#pragma unroll
        for (int i = 0; i < 16; ++i) {
            const float f1 = __int_as_float(S0[i] & ~0x7F) - TK_OFS, f2 = __int_as_float(S1[i] & ~0x7F) - TK_OFS;
            a[i] = hh ? f2 : f1; b[i] = hh ? f1 : f2;
        }
        int CA[16], CB[16];
        const int org = hh << 8;
        {
            int n = 0;
#pragma unroll
            for (int i = 0; i < 4; ++i)
#pragma unroll
                for (int j = i; j < 16; ++j) {
                    if ((i + 1) * (j + 1) <= 16) {
                        int key = (f2sortable(a[i] + b[j]) & ~0x1FF) | org | (i * 16 + j);
                        if (i == j) key = hh ? (int)0x80000000 : key;
                        if (n < 16) CA[n] = key; else CB[n - 16] = key;
                        ++n;
                    }
                }
#pragma unroll
            for (int q = 27; q < 32; ++q) CB[q - 16] = (int)0x80000000;
        }
        sort16_desc(CA); sort16_desc(CB);
        merge_top16(CA, CB);
        int F[16], PF[16];
#pragma unroll
        for (int i = 0; i < 16; ++i) PF[i] = __shfl_xor(CA[i], 32, 64);
#pragma unroll
        for (int i = 0; i < 16; ++i) F[i] = max(CA[i], PF[15 - i]);
        int mxk = F[0];
#pragma unroll
        for (int i = 1; i < 16; ++i) mxk = max(mxk, F[i]);
        const float vmax = sortable2f(mxk & ~0x1FF);
        float e[8], psum = 0.f;
#pragma unroll
        for (int i = 0; i < 8; ++i) { e[i] = __expf(sortable2f(F[i] & ~0x1FF) - vmax); psum += e[i]; }
        const float inv = 1.0f / (psum + __shfl_xor(psum, 32, 64));
        asm volatile("s_waitcnt lgkmcnt(0)" ::: "memory");
        int ex[8];
#pragma unroll
        for (int i = 0; i < 8; ++i) {
            const int low = F[i] & 0x1FF, o = low >> 8, il = (low >> 4) & 15, jl = low & 15;
            const int ri = o ? jl : il, rj = o ? il : jl;
            const int i1 = (int)*(const LAS unsigned char*)(ilist + ri), i2 = (int)*(const LAS unsigned char*)(ilist + 16 + rj);
            ex[i] = i1 * 128 + i2;
        }
        if (TO_LDS) {
            LAS int* ep = le + (c * 8 + hd) * 16 + hh * 8;
            LAS float* gp = lg + (c * 8 + hd) * 16 + hh * 8;
            *(LAS u32x4*)ep = (u32x4){(unsigned)ex[0], (unsigned)ex[1], (unsigned)ex[2], (unsigned)ex[3]};
            *(LAS u32x4*)(ep + 4) = (u32x4){(unsigned)ex[4], (unsigned)ex[5], (unsigned)ex[6], (unsigned)ex[7]};
            *(LAS f32x4*)gp = (f32x4){e[0] * inv, e[1] * inv, e[2] * inv, e[3] * inv};
            *(LAS f32x4*)(gp + 4) = (f32x4){e[4] * inv, e[5] * inv, e[6] * inv, e[7] * inv};
        } else {
            int* ep = p.eidx() + ((size_t)t * 8 + hd) * 16 + hh * 8;
            float* gp = p.egate() + ((size_t)t * 8 + hd) * 16 + hh * 8;
            *(u32x4*)ep = (u32x4){(unsigned)ex[0], (unsigned)ex[1], (unsigned)ex[2], (unsigned)ex[3]};
            *(u32x4*)(ep + 4) = (u32x4){(unsigned)ex[4], (unsigned)ex[5], (unsigned)ex[6], (unsigned)ex[7]};
            *(f32x4*)gp = (f32x4){e[0] * inv, e[1] * inv, e[2] * inv, e[3] * inv};
            *(f32x4*)(gp + 4) = (f32x4){e[4] * inv, e[5] * inv, e[6] * inv, e[7] * inv};
        }
        asm volatile("s_waitcnt lgkmcnt(0)" ::: "memory");
    }
}
__device__ __forceinline__ void phase_topk(const Params& p, int l, LAS unsigned char* lds, int wv) {
    const int tid = tid_opaque(wv), wave = __builtin_amdgcn_readfirstlane(tid >> 6), lane = tid & 63;
    int cur_hd = -1;
    for (int u = blockIdx.x; u < 8 * (NTOK / 256); u += gridDim.x) {
        const int hd = u & 7, tg = u >> 3;
        if (hd != cur_hd) {
            __syncthreads();
            const bf16_t* kg = p.keysb() + ((size_t)(l * 8 + hd) * 2) * 128 * 128;
            u32x4 kv[8];
#pragma unroll
            for (int q = 0; q < 8; ++q) { const int i = tid + 512 * q; kv[q] = *(const u32x4*)(kg + (size_t)(i >> 4) * 128 + (i & 15) * 8); }
#pragma unroll
            for (int q = 0; q < 8; ++q) { const int i = tid + 512 * q; *(LAS u32x4*)(lds + TK_KEYS + (i >> 4) * TK_KSTR + (i & 15) * 16) = kv[q]; }
            __syncthreads();
            cur_hd = hd;
        }
        if ((((u / (int)gridDim.x) ^ (wv >> 2)) & 1) != 0) __builtin_amdgcn_s_setprio(1); else __builtin_amdgcn_s_setprio(0);
        topk_unit<false>(p, l, tg * 8 + wave, hd, lds, wave, lane, nullptr, nullptr);
    }
    __builtin_amdgcn_s_setprio(0);
}
#if MK_MULTI
template <int DUMMY>
__global__ void __launch_bounds__(512, 2) k_topk(Params p, int l) {
    extern __shared__ __attribute__((aligned(16))) unsigned char smem_raw[];
    phase_topk(p, l, (LAS unsigned char*)smem_raw, __builtin_amdgcn_readfirstlane((int)threadIdx.x >> 6));
}
#endif
#if PROBE_UB
__device__ __forceinline__ void ubench(int iters, unsigned seed) {
    float r[16]; f32x2 r2[8];
#pragma unroll
    for (int i = 0; i < 16; ++i) r[i] = __uint_as_float(seed + i);
#pragma unroll
    for (int i = 0; i < 8; ++i) r2[i] = (f32x2){r[2 * i], r[2 * i + 1]};
    float a = __uint_as_float(seed * 3u + 1u), b = __uint_as_float(seed * 5u + 7u);
    for (int it = 0; it < iters; ++it) {
#if PROBE_UB == 1
        asm volatile("v_fma_f32 %0, %16, %17, %0\n\tv_fma_f32 %1, %16, %17, %1\n\tv_fma_f32 %2, %16, %17, %2\n\tv_fma_f32 %3, %16, %17, %3\n\tv_fma_f32 %4, %16, %17, %4\n\tv_fma_f32 %5, %16, %17, %5\n\tv_fma_f32 %6, %16, %17, %6\n\tv_fma_f32 %7, %16, %17, %7\n\tv_fma_f32 %8, %16, %17, %8\n\tv_fma_f32 %9, %16, %17, %9\n\tv_fma_f32 %10, %16, %17, %10\n\tv_fma_f32 %11, %16, %17, %11\n\tv_fma_f32 %12, %16, %17, %12\n\tv_fma_f32 %13, %16, %17, %13\n\tv_fma_f32 %14, %16, %17, %14\n\tv_fma_f32 %15, %16, %17, %15\n\t" : "+v"(r[0]), "+v"(r[1]), "+v"(r[2]), "+v"(r[3]), "+v"(r[4]), "+v"(r[5]), "+v"(r[6]), "+v"(r[7]), "+v"(r[8]), "+v"(r[9]), "+v"(r[10]), "+v"(r[11]), "+v"(r[12]), "+v"(r[13]), "+v"(r[14]), "+v"(r[15]) : "v"(a), "v"(b) : "s40", "vcc");
        asm volatile("v_fma_f32 %0, %16, %17, %0\n\tv_fma_f32 %1, %16, %17, %1\n\tv_fma_f32 %2, %16, %17, %2\n\tv_fma_f32 %3, %16, %17, %3\n\tv_fma_f32 %4, %16, %17, %4\n\tv_fma_f32 %5, %16, %17, %5\n\tv_fma_f32 %6, %16, %17, %6\n\tv_fma_f32 %7, %16, %17, %7\n\tv_fma_f32 %8, %16, %17, %8\n\tv_fma_f32 %9, %16, %17, %9\n\tv_fma_f32 %10, %16, %17, %10\n\tv_fma_f32 %11, %16, %17, %11\n\tv_fma_f32 %12, %16, %17, %12\n\tv_fma_f32 %13, %16, %17, %13\n\tv_fma_f32 %14, %16, %17, %14\n\tv_fma_f32 %15, %16, %17, %15\n\t" : "+v"(r[0]), "+v"(r[1]), "+v"(r[2]), "+v"(r[3]), "+v"(r[4]), "+v"(r[5]), "+v"(r[6]), "+v"(r[7]), "+v"(r[8]), "+v"(r[9]), "+v"(r[10]), "+v"(r[11]), "+v"(r[12]), "+v"(r[13]), "+v"(r[14]), "+v"(r[15]) : "v"(a), "v"(b) : "s40", "vcc");
#endif
#if PROBE_UB == 2
        asm volatile("v_dot4c_i32_i8 %0, %16, %17\n\tv_dot4c_i32_i8 %1, %16, %17\n\tv_dot4c_i32_i8 %2, %16, %17\n\tv_dot4c_i32_i8 %3, %16, %17\n\tv_dot4c_i32_i8 %4, %16, %17\n\tv_dot4c_i32_i8 %5, %16, %17\n\tv_dot4c_i32_i8 %6, %16, %17\n\tv_dot4c_i32_i8 %7, %16, %17\n\tv_dot4c_i32_i8 %8, %16, %17\n\tv_dot4c_i32_i8 %9, %16, %17\n\tv_dot4c_i32_i8 %10, %16, %17\n\tv_dot4c_i32_i8 %11, %16, %17\n\tv_dot4c_i32_i8 %12, %16, %17\n\tv_dot4c_i32_i8 %13, %16, %17\n\tv_dot4c_i32_i8 %14, %16, %17\n\tv_dot4c_i32_i8 %15, %16, %17\n\t" : "+v"(r[0]), "+v"(r[1]), "+v"(r[2]), "+v"(r[3]), "+v"(r[4]), "+v"(r[5]), "+v"(r[6]), "+v"(r[7]), "+v"(r[8]), "+v"(r[9]), "+v"(r[10]), "+v"(r[11]), "+v"(r[12]), "+v"(r[13]), "+v"(r[14]), "+v"(r[15]) : "v"(a), "v"(b) : "s40", "vcc");
        asm volatile("v_dot4c_i32_i8 %0, %16, %17\n\tv_dot4c_i32_i8 %1, %16, %17\n\tv_dot4c_i32_i8 %2, %16, %17\n\tv_dot4c_i32_i8 %3, %16, %17\n\tv_dot4c_i32_i8 %4, %16, %17\n\tv_dot4c_i32_i8 %5, %16, %17\n\tv_dot4c_i32_i8 %6, %16, %17\n\tv_dot4c_i32_i8 %7, %16, %17\n\tv_dot4c_i32_i8 %8, %16, %17\n\tv_dot4c_i32_i8 %9, %16, %17\n\tv_dot4c_i32_i8 %10, %16, %17\n\tv_dot4c_i32_i8 %11, %16, %17\n\tv_dot4c_i32_i8 %12, %16, %17\n\tv_dot4c_i32_i8 %13, %16, %17\n\tv_dot4c_i32_i8 %14, %16, %17\n\tv_dot4c_i32_i8 %15, %16, %17\n\t" : "+v"(r[0]), "+v"(r[1]), "+v"(r[2]), "+v"(r[3]), "+v"(r[4]), "+v"(r[5]), "+v"(r[6]), "+v"(r[7]), "+v"(r[8]), "+v"(r[9]), "+v"(r[10]), "+v"(r[11]), "+v"(r[12]), "+v"(r[13]), "+v"(r[14]), "+v"(r[15]) : "v"(a), "v"(b) : "s40", "vcc");
#endif
#if PROBE_UB == 3
        asm volatile("v_perm_b32 %0, %0, %16, %17\n\tv_perm_b32 %1, %1, %16, %17\n\tv_perm_b32 %2, %2, %16, %17\n\tv_perm_b32 %3, %3, %16, %17\n\tv_perm_b32 %4, %4, %16, %17\n\tv_perm_b32 %5, %5, %16, %17\n\tv_perm_b32 %6, %6, %16, %17\n\tv_perm_b32 %7, %7, %16, %17\n\tv_perm_b32 %8, %8, %16, %17\n\tv_perm_b32 %9, %9, %16, %17\n\tv_perm_b32 %10, %10, %16, %17\n\tv_perm_b32 %11, %11, %16, %17\n\tv_perm_b32 %12, %12, %16, %17\n\tv_perm_b32 %13, %13, %16, %17\n\tv_perm_b32 %14, %14, %16, %17\n\tv_perm_b32 %15, %15, %16, %17\n\t" : "+v"(r[0]), "+v"(r[1]), "+v"(r[2]), "+v"(r[3]), "+v"(r[4]), "+v"(r[5]), "+v"(r[6]), "+v"(r[7]), "+v"(r[8]), "+v"(r[9]), "+v"(r[10]), "+v"(r[11]), "+v"(r[12]), "+v"(r[13]), "+v"(r[14]), "+v"(r[15]) : "v"(a), "v"(b) : "s40", "vcc");
        asm volatile("v_perm_b32 %0, %0, %16, %17\n\tv_perm_b32 %1, %1, %16, %17\n\tv_perm_b32 %2, %2, %16, %17\n\tv_perm_b32 %3, %3, %16, %17\n\tv_perm_b32 %4, %4, %16, %17\n\tv_perm_b32 %5, %5, %16, %17\n\tv_perm_b32 %6, %6, %16, %17\n\tv_perm_b32 %7, %7, %16, %17\n\tv_perm_b32 %8, %8, %16, %17\n\tv_perm_b32 %9, %9, %16, %17\n\tv_perm_b32 %10, %10, %16, %17\n\tv_perm_b32 %11, %11, %16, %17\n\tv_perm_b32 %12, %12, %16, %17\n\tv_perm_b32 %13, %13, %16, %17\n\tv_perm_b32 %14, %14, %16, %17\n\tv_perm_b32 %15, %15, %16, %17\n\t" : "+v"(r[0]), "+v"(r[1]), "+v"(r[2]), "+v"(r[3]), "+v"(r[4]), "+v"(r[5]), "+v"(r[6]), "+v"(r[7]), "+v"(r[8]), "+v"(r[9]), "+v"(r[10]), "+v"(r[11]), "+v"(r[12]), "+v"(r[13]), "+v"(r[14]), "+v"(r[15]) : "v"(a), "v"(b) : "s40", "vcc");
#endif
#if PROBE_UB == 4
        asm volatile("v_add_u32_dpp %0, %0, %0 quad_perm:[1,0,3,2] row_mask:0xf bank_mask:0xf\n\tv_add_u32_dpp %1, %1, %1 quad_perm:[1,0,3,2] row_mask:0xf bank_mask:0xf\n\tv_add_u32_dpp %2, %2, %2 quad_perm:[1,0,3,2] row_mask:0xf bank_mask:0xf\n\tv_add_u32_dpp %3, %3, %3 quad_perm:[1,0,3,2] row_mask:0xf bank_mask:0xf\n\tv_add_u32_dpp %4, %4, %4 quad_perm:[1,0,3,2] row_mask:0xf bank_mask:0xf\n\tv_add_u32_dpp %5, %5, %5 quad_perm:[1,0,3,2] row_mask:0xf bank_mask:0xf\n\tv_add_u32_dpp %6, %6, %6 quad_perm:[1,0,3,2] row_mask:0xf bank_mask:0xf\n\tv_add_u32_dpp %7, %7, %7 quad_perm:[1,0,3,2] row_mask:0xf bank_mask:0xf\n\tv_add_u32_dpp %8, %8, %8 quad_perm:[1,0,3,2] row_mask:0xf bank_mask:0xf\n\tv_add_u32_dpp %9, %9, %9 quad_perm:[1,0,3,2] row_mask:0xf bank_mask:0xf\n\tv_add_u32_dpp %10, %10, %10 quad_perm:[1,0,3,2] row_mask:0xf bank_mask:0xf\n\tv_add_u32_dpp %11, %11, %11 quad_perm:[1,0,3,2] row_mask:0xf bank_mask:0xf\n\tv_add_u32_dpp %12, %12, %12 quad_perm:[1,0,3,2] row_mask:0xf bank_mask:0xf\n\tv_add_u32_dpp %13, %13, %13 quad_perm:[1,0,3,2] row_mask:0xf bank_mask:0xf\n\tv_add_u32_dpp %14, %14, %14 quad_perm:[1,0,3,2] row_mask:0xf bank_mask:0xf\n\tv_add_u32_dpp %15, %15, %15 quad_perm:[1,0,3,2] row_mask:0xf bank_mask:0xf\n\t" : "+v"(r[0]), "+v"(r[1]), "+v"(r[2]), "+v"(r[3]), "+v"(r[4]), "+v"(r[5]), "+v"(r[6]), "+v"(r[7]), "+v"(r[8]), "+v"(r[9]), "+v"(r[10]), "+v"(r[11]), "+v"(r[12]), "+v"(r[13]), "+v"(r[14]), "+v"(r[15]) : "v"(a), "v"(b) : "s40", "vcc");
        asm volatile("v_add_u32_dpp %0, %0, %0 quad_perm:[1,0,3,2] row_mask:0xf bank_mask:0xf\n\tv_add_u32_dpp %1, %1, %1 quad_perm:[1,0,3,2] row_mask:0xf bank_mask:0xf\n\tv_add_u32_dpp %2, %2, %2 quad_perm:[1,0,3,2] row_mask:0xf bank_mask:0xf\n\tv_add_u32_dpp %3, %3, %3 quad_perm:[1,0,3,2] row_mask:0xf bank_mask:0xf\n\tv_add_u32_dpp %4, %4, %4 quad_perm:[1,0,3,2] row_mask:0xf bank_mask:0xf\n\tv_add_u32_dpp %5, %5, %5 quad_perm:[1,0,3,2] row_mask:0xf bank_mask:0xf\n\tv_add_u32_dpp %6, %6, %6 quad_perm:[1,0,3,2] row_mask:0xf bank_mask:0xf\n\tv_add_u32_dpp %7, %7, %7 quad_perm:[1,0,3,2] row_mask:0xf bank_mask:0xf\n\tv_add_u32_dpp %8, %8, %8 quad_perm:[1,0,3,2] row_mask:0xf bank_mask:0xf\n\tv_add_u32_dpp %9, %9, %9 quad_perm:[1,0,3,2] row_mask:0xf bank_mask:0xf\n\tv_add_u32_dpp %10, %10, %10 quad_perm:[1,0,3,2] row_mask:0xf bank_mask:0xf\n\tv_add_u32_dpp %11, %11, %11 quad_perm:[1,0,3,2] row_mask:0xf bank_mask:0xf\n\tv_add_u32_dpp %12, %12, %12 quad_perm:[1,0,3,2] row_mask:0xf bank_mask:0xf\n\tv_add_u32_dpp %13, %13, %13 quad_perm:[1,0,3,2] row_mask:0xf bank_mask:0xf\n\tv_add_u32_dpp %14, %14, %14 quad_perm:[1,0,3,2] row_mask:0xf bank_mask:0xf\n\tv_add_u32_dpp %15, %15, %15 quad_perm:[1,0,3,2] row_mask:0xf bank_mask:0xf\n\t" : "+v"(r[0]), "+v"(r[1]), "+v"(r[2]), "+v"(r[3]), "+v"(r[4]), "+v"(r[5]), "+v"(r[6]), "+v"(r[7]), "+v"(r[8]), "+v"(r[9]), "+v"(r[10]), "+v"(r[11]), "+v"(r[12]), "+v"(r[13]), "+v"(r[14]), "+v"(r[15]) : "v"(a), "v"(b) : "s40", "vcc");
#endif
#if PROBE_UB == 5
        asm volatile("v_readlane_b32 s40, %0, 5\n\tv_readlane_b32 s40, %1, 5\n\tv_readlane_b32 s40, %2, 5\n\tv_readlane_b32 s40, %3, 5\n\tv_readlane_b32 s40, %4, 5\n\tv_readlane_b32 s40, %5, 5\n\tv_readlane_b32 s40, %6, 5\n\tv_readlane_b32 s40, %7, 5\n\tv_readlane_b32 s40, %8, 5\n\tv_readlane_b32 s40, %9, 5\n\tv_readlane_b32 s40, %10, 5\n\tv_readlane_b32 s40, %11, 5\n\tv_readlane_b32 s40, %12, 5\n\tv_readlane_b32 s40, %13, 5\n\tv_readlane_b32 s40, %14, 5\n\tv_readlane_b32 s40, %15, 5\n\t" : "+v"(r[0]), "+v"(r[1]), "+v"(r[2]), "+v"(r[3]), "+v"(r[4]), "+v"(r[5]), "+v"(r[6]), "+v"(r[7]), "+v"(r[8]), "+v"(r[9]), "+v"(r[10]), "+v"(r[11]), "+v"(r[12]), "+v"(r[13]), "+v"(r[14]), "+v"(r[15]) : "v"(a), "v"(b) : "s40", "vcc");
        asm volatile("v_readlane_b32 s40, %0, 5\n\tv_readlane_b32 s40, %1, 5\n\tv_readlane_b32 s40, %2, 5\n\tv_readlane_b32 s40, %3, 5\n\tv_readlane_b32 s40, %4, 5\n\tv_readlane_b32 s40, %5, 5\n\tv_readlane_b32 s40, %6, 5\n\tv_readlane_b32 s40, %7, 5\n\tv_readlane_b32 s40, %8, 5\n\tv_readlane_b32 s40, %9, 5\n\tv_readlane_b32 s40, %10, 5\n\tv_readlane_b32 s40, %11, 5\n\tv_readlane_b32 s40, %12, 5\n\tv_readlane_b32 s40, %13, 5\n\tv_readlane_b32 s40, %14, 5\n\tv_readlane_b32 s40, %15, 5\n\t" : "+v"(r[0]), "+v"(r[1]), "+v"(r[2]), "+v"(r[3]), "+v"(r[4]), "+v"(r[5]), "+v"(r[6]), "+v"(r[7]), "+v"(r[8]), "+v"(r[9]), "+v"(r[10]), "+v"(r[11]), "+v"(r[12]), "+v"(r[13]), "+v"(r[14]), "+v"(r[15]) : "v"(a), "v"(b) : "s40", "vcc");
#endif
#if PROBE_UB == 6
        asm volatile("v_cvt_pk_f32_fp8 %0, %16\n\tv_cvt_pk_f32_fp8 %1, %16\n\tv_cvt_pk_f32_fp8 %2, %16\n\tv_cvt_pk_f32_fp8 %3, %16\n\tv_cvt_pk_f32_fp8 %4, %16\n\tv_cvt_pk_f32_fp8 %5, %16\n\tv_cvt_pk_f32_fp8 %6, %16\n\tv_cvt_pk_f32_fp8 %7, %16\n\t" : "+v"(r2[0]), "+v"(r2[1]), "+v"(r2[2]), "+v"(r2[3]), "+v"(r2[4]), "+v"(r2[5]), "+v"(r2[6]), "+v"(r2[7]), "+v"(r[8]), "+v"(r[9]), "+v"(r[10]), "+v"(r[11]), "+v"(r[12]), "+v"(r[13]), "+v"(r[14]), "+v"(r[15]) : "v"(a), "v"(b) : "s40", "vcc");
        asm volatile("v_cvt_pk_f32_fp8 %0, %16\n\tv_cvt_pk_f32_fp8 %1, %16\n\tv_cvt_pk_f32_fp8 %2, %16\n\tv_cvt_pk_f32_fp8 %3, %16\n\tv_cvt_pk_f32_fp8 %4, %16\n\tv_cvt_pk_f32_fp8 %5, %16\n\tv_cvt_pk_f32_fp8 %6, %16\n\tv_cvt_pk_f32_fp8 %7, %16\n\t" : "+v"(r2[0]), "+v"(r2[1]), "+v"(r2[2]), "+v"(r2[3]), "+v"(r2[4]), "+v"(r2[5]), "+v"(r2[6]), "+v"(r2[7]), "+v"(r[8]), "+v"(r[9]), "+v"(r[10]), "+v"(r[11]), "+v"(r[12]), "+v"(r[13]), "+v"(r[14]), "+v"(r[15]) : "v"(a), "v"(b) : "s40", "vcc");
        asm volatile("v_cvt_pk_f32_fp8 %0, %16\n\tv_cvt_pk_f32_fp8 %1, %16\n\tv_cvt_pk_f32_fp8 %2, %16\n\tv_cvt_pk_f32_fp8 %3, %16\n\tv_cvt_pk_f32_fp8 %4, %16\n\tv_cvt_pk_f32_fp8 %5, %16\n\tv_cvt_pk_f32_fp8 %6, %16\n\tv_cvt_pk_f32_fp8 %7, %16\n\t" : "+v"(r2[0]), "+v"(r2[1]), "+v"(r2[2]), "+v"(r2[3]), "+v"(r2[4]), "+v"(r2[5]), "+v"(r2[6]), "+v"(r2[7]), "+v"(r[8]), "+v"(r[9]), "+v"(r[10]), "+v"(r[11]), "+v"(r[12]), "+v"(r[13]), "+v"(r[14]), "+v"(r[15]) : "v"(a), "v"(b) : "s40", "vcc");
        asm volatile("v_cvt_pk_f32_fp8 %0, %16\n\tv_cvt_pk_f32_fp8 %1, %16\n\tv_cvt_pk_f32_fp8 %2, %16\n\tv_cvt_pk_f32_fp8 %3, %16\n\tv_cvt_pk_f32_fp8 %4, %16\n\tv_cvt_pk_f32_fp8 %5, %16\n\tv_cvt_pk_f32_fp8 %6, %16\n\tv_cvt_pk_f32_fp8 %7, %16\n\t" : "+v"(r2[0]), "+v"(r2[1]), "+v"(r2[2]), "+v"(r2[3]), "+v"(r2[4]), "+v"(r2[5]), "+v"(r2[6]), "+v"(r2[7]), "+v"(r[8]), "+v"(r[9]), "+v"(r[10]), "+v"(r[11]), "+v"(r[12]), "+v"(r[13]), "+v"(r[14]), "+v"(r[15]) : "v"(a), "v"(b) : "s40", "vcc");
#endif
#if PROBE_UB == 7
        asm volatile("v_pk_fma_f32 %0, %0, %0, %0\n\tv_pk_fma_f32 %1, %1, %1, %1\n\tv_pk_fma_f32 %2, %2, %2, %2\n\tv_pk_fma_f32 %3, %3, %3, %3\n\tv_pk_fma_f32 %4, %4, %4, %4\n\tv_pk_fma_f32 %5, %5, %5, %5\n\tv_pk_fma_f32 %6, %6, %6, %6\n\tv_pk_fma_f32 %7, %7, %7, %7\n\t" : "+v"(r2[0]), "+v"(r2[1]), "+v"(r2[2]), "+v"(r2[3]), "+v"(r2[4]), "+v"(r2[5]), "+v"(r2[6]), "+v"(r2[7]), "+v"(r[8]), "+v"(r[9]), "+v"(r[10]), "+v"(r[11]), "+v"(r[12]), "+v"(r[13]), "+v"(r[14]), "+v"(r[15]) : "v"(a), "v"(b) : "s40", "vcc");
        asm volatile("v_pk_fma_f32 %0, %0, %0, %0\n\tv_pk_fma_f32 %1, %1, %1, %1\n\tv_pk_fma_f32 %2, %2, %2, %2\n\tv_pk_fma_f32 %3, %3, %3, %3\n\tv_pk_fma_f32 %4, %4, %4, %4\n\tv_pk_fma_f32 %5, %5, %5, %5\n\tv_pk_fma_f32 %6, %6, %6, %6\n\tv_pk_fma_f32 %7, %7, %7, %7\n\t" : "+v"(r2[0]), "+v"(r2[1]), "+v"(r2[2]), "+v"(r2[3]), "+v"(r2[4]), "+v"(r2[5]), "+v"(r2[6]), "+v"(r2[7]), "+v"(r[8]), "+v"(r[9]), "+v"(r[10]), "+v"(r[11]), "+v"(r[12]), "+v"(r[13]), "+v"(r[14]), "+v"(r[15]) : "v"(a), "v"(b) : "s40", "vcc");
        asm volatile("v_pk_fma_f32 %0, %0, %0, %0\n\tv_pk_fma_f32 %1, %1, %1, %1\n\tv_pk_fma_f32 %2, %2, %2, %2\n\tv_pk_fma_f32 %3, %3, %3, %3\n\tv_pk_fma_f32 %4, %4, %4, %4\n\tv_pk_fma_f32 %5, %5, %5, %5\n\tv_pk_fma_f32 %6, %6, %6, %6\n\tv_pk_fma_f32 %7, %7, %7, %7\n\t" : "+v"(r2[0]), "+v"(r2[1]), "+v"(r2[2]), "+v"(r2[3]), "+v"(r2[4]), "+v"(r2[5]), "+v"(r2[6]), "+v"(r2[7]), "+v"(r[8]), "+v"(r[9]), "+v"(r[10]), "+v"(r[11]), "+v"(r[12]), "+v"(r[13]), "+v"(r[14]), "+v"(r[15]) : "v"(a), "v"(b) : "s40", "vcc");
        asm volatile("v_pk_fma_f32 %0, %0, %0, %0\n\tv_pk_fma_f32 %1, %1, %1, %1\n\tv_pk_fma_f32 %2, %2, %2, %2\n\tv_pk_fma_f32 %3, %3, %3, %3\n\tv_pk_fma_f32 %4, %4, %4, %4\n\tv_pk_fma_f32 %5, %5, %5, %5\n\tv_pk_fma_f32 %6, %6, %6, %6\n\tv_pk_fma_f32 %7, %7, %7, %7\n\t" : "+v"(r2[0]), "+v"(r2[1]), "+v"(r2[2]), "+v"(r2[3]), "+v"(r2[4]), "+v"(r2[5]), "+v"(r2[6]), "+v"(r2[7]), "+v"(r[8]), "+v"(r[9]), "+v"(r[10]), "+v"(r[11]), "+v"(r[12]), "+v"(r[13]), "+v"(r[14]), "+v"(r[15]) : "v"(a), "v"(b) : "s40", "vcc");
#endif
#if PROBE_UB == 8
        asm volatile("v_dot2c_f32_bf16 %0, %16, %17\n\tv_dot2c_f32_bf16 %1, %16, %17\n\tv_dot2c_f32_bf16 %2, %16, %17\n\tv_dot2c_f32_bf16 %3, %16, %17\n\tv_dot2c_f32_bf16 %4, %16, %17\n\tv_dot2c_f32_bf16 %5, %16, %17\n\tv_dot2c_f32_bf16 %6, %16, %17\n\tv_dot2c_f32_bf16 %7, %16, %17\n\tv_dot2c_f32_bf16 %8, %16, %17\n\tv_dot2c_f32_bf16 %9, %16, %17\n\tv_dot2c_f32_bf16 %10, %16, %17\n\tv_dot2c_f32_bf16 %11, %16, %17\n\tv_dot2c_f32_bf16 %12, %16, %17\n\tv_dot2c_f32_bf16 %13, %16, %17\n\tv_dot2c_f32_bf16 %14, %16, %17\n\tv_dot2c_f32_bf16 %15, %16, %17\n\t" : "+v"(r[0]), "+v"(r[1]), "+v"(r[2]), "+v"(r[3]), "+v"(r[4]), "+v"(r[5]), "+v"(r[6]), "+v"(r[7]), "+v"(r[8]), "+v"(r[9]), "+v"(r[10]), "+v"(r[11]), "+v"(r[12]), "+v"(r[13]), "+v"(r[14]), "+v"(r[15]) : "v"(a), "v"(b) : "s40", "vcc");
        asm volatile("v_dot2c_f32_bf16 %0, %16, %17\n\tv_dot2c_f32_bf16 %1, %16, %17\n\tv_dot2c_f32_bf16 %2, %16, %17\n\tv_dot2c_f32_bf16 %3, %16, %17\n\tv_dot2c_f32_bf16 %4, %16, %17\n\tv_dot2c_f32_bf16 %5, %16, %17\n\tv_dot2c_f32_bf16 %6, %16, %17\n\tv_dot2c_f32_bf16 %7, %16, %17\n\tv_dot2c_f32_bf16 %8, %16, %17\n\tv_dot2c_f32_bf16 %9, %16, %17\n\tv_dot2c_f32_bf16 %10, %16, %17\n\tv_dot2c_f32_bf16 %11, %16, %17\n\tv_dot2c_f32_bf16 %12, %16, %17\n\tv_dot2c_f32_bf16 %13, %16, %17\n\tv_dot2c_f32_bf16 %14, %16, %17\n\tv_dot2c_f32_bf16 %15, %16, %17\n\t" : "+v"(r[0]), "+v"(r[1]), "+v"(r[2]), "+v"(r[3]), "+v"(r[4]), "+v"(r[5]), "+v"(r[6]), "+v"(r[7]), "+v"(r[8]), "+v"(r[9]), "+v"(r[10]), "+v"(r[11]), "+v"(r[12]), "+v"(r[13]), "+v"(r[14]), "+v"(r[15]) : "v"(a), "v"(b) : "s40", "vcc");
#endif
#if PROBE_UB == 9
        asm volatile("v_cndmask_b32 %0, %0, %16, vcc\n\tv_cndmask_b32 %1, %1, %16, vcc\n\tv_cndmask_b32 %2, %2, %16, vcc\n\tv_cndmask_b32 %3, %3, %16, vcc\n\tv_cndmask_b32 %4, %4, %16, vcc\n\tv_cndmask_b32 %5, %5, %16, vcc\n\tv_cndmask_b32 %6, %6, %16, vcc\n\tv_cndmask_b32 %7, %7, %16, vcc\n\tv_cndmask_b32 %8, %8, %16, vcc\n\tv_cndmask_b32 %9, %9, %16, vcc\n\tv_cndmask_b32 %10, %10, %16, vcc\n\tv_cndmask_b32 %11, %11, %16, vcc\n\tv_cndmask_b32 %12, %12, %16, vcc\n\tv_cndmask_b32 %13, %13, %16, vcc\n\tv_cndmask_b32 %14, %14, %16, vcc\n\tv_cndmask_b32 %15, %15, %16, vcc\n\t" : "+v"(r[0]), "+v"(r[1]), "+v"(r[2]), "+v"(r[3]), "+v"(r[4]), "+v"(r[5]), "+v"(r[6]), "+v"(r[7]), "+v"(r[8]), "+v"(r[9]), "+v"(r[10]), "+v"(r[11]), "+v"(r[12]), "+v"(r[13]), "+v"(r[14]), "+v"(r[15]) : "v"(a), "v"(b) : "s40", "vcc");
        asm volatile("v_cndmask_b32 %0, %0, %16, vcc\n\tv_cndmask_b32 %1, %1, %16, vcc\n\tv_cndmask_b32 %2, %2, %16, vcc\n\tv_cndmask_b32 %3, %3, %16, vcc\n\tv_cndmask_b32 %4, %4, %16, vcc\n\tv_cndmask_b32 %5, %5, %16, vcc\n\tv_cndmask_b32 %6, %6, %16, vcc\n\tv_cndmask_b32 %7, %7, %16, vcc\n\tv_cndmask_b32 %8, %8, %16, vcc\n\tv_cndmask_b32 %9, %9, %16, vcc\n\tv_cndmask_b32 %10, %10, %16, vcc\n\tv_cndmask_b32 %11, %11, %16, vcc\n\tv_cndmask_b32 %12, %12, %16, vcc\n\tv_cndmask_b32 %13, %13, %16, vcc\n\tv_cndmask_b32 %14, %14, %16, vcc\n\tv_cndmask_b32 %15, %15, %16, vcc\n\t" : "+v"(r[0]), "+v"(r[1]), "+v"(r[2]), "+v"(r[3]), "+v"(r[4]), "+v"(r[5]), "+v"(r[6]), "+v"(r[7]), "+v"(r[8]), "+v"(r[9]), "+v"(r[10]), "+v"(r[11]), "+v"(r[12]), "+v"(r[13]), "+v"(r[14]), "+v"(r[15]) : "v"(a), "v"(b) : "s40", "vcc");
#endif
#if PROBE_UB == 10
        asm volatile("v_max_i32 %0, %0, %16\n\tv_max_i32 %1, %1, %16\n\tv_max_i32 %2, %2, %16\n\tv_max_i32 %3, %3, %16\n\tv_max_i32 %4, %4, %16\n\tv_max_i32 %5, %5, %16\n\tv_max_i32 %6, %6, %16\n\tv_max_i32 %7, %7, %16\n\tv_max_i32 %8, %8, %16\n\tv_max_i32 %9, %9, %16\n\tv_max_i32 %10, %10, %16\n\tv_max_i32 %11, %11, %16\n\tv_max_i32 %12, %12, %16\n\tv_max_i32 %13, %13, %16\n\tv_max_i32 %14, %14, %16\n\tv_max_i32 %15, %15, %16\n\t" : "+v"(r[0]), "+v"(r[1]), "+v"(r[2]), "+v"(r[3]), "+v"(r[4]), "+v"(r[5]), "+v"(r[6]), "+v"(r[7]), "+v"(r[8]), "+v"(r[9]), "+v"(r[10]), "+v"(r[11]), "+v"(r[12]), "+v"(r[13]), "+v"(r[14]), "+v"(r[15]) : "v"(a), "v"(b) : "s40", "vcc");
        asm volatile("v_max_i32 %0, %0, %16\n\tv_max_i32 %1, %1, %16\n\tv_max_i32 %2, %2, %16\n\tv_max_i32 %3, %3, %16\n\tv_max_i32 %4, %4, %16\n\tv_max_i32 %5, %5, %16\n\tv_max_i32 %6, %6, %16\n\tv_max_i32 %7, %7, %16\n\tv_max_i32 %8, %8, %16\n\tv_max_i32 %9, %9, %16\n\tv_max_i32 %10, %10, %16\n\tv_max_i32 %11, %11, %16\n\tv_max_i32 %12, %12, %16\n\tv_max_i32 %13, %13, %16\n\tv_max_i32 %14, %14, %16\n\tv_max_i32 %15, %15, %16\n\t" : "+v"(r[0]), "+v"(r[1]), "+v"(r[2]), "+v"(r[3]), "+v"(r[4]), "+v"(r[5]), "+v"(r[6]), "+v"(r[7]), "+v"(r[8]), "+v"(r[9]), "+v"(r[10]), "+v"(r[11]), "+v"(r[12]), "+v"(r[13]), "+v"(r[14]), "+v"(r[15]) : "v"(a), "v"(b) : "s40", "vcc");
#endif
#if PROBE_UB == 11
        asm volatile("v_exp_f32 %0, %0\n\tv_exp_f32 %1, %1\n\tv_exp_f32 %2, %2\n\tv_exp_f32 %3, %3\n\tv_exp_f32 %4, %4\n\tv_exp_f32 %5, %5\n\tv_exp_f32 %6, %6\n\tv_exp_f32 %7, %7\n\tv_exp_f32 %8, %8\n\tv_exp_f32 %9, %9\n\tv_exp_f32 %10, %10\n\tv_exp_f32 %11, %11\n\tv_exp_f32 %12, %12\n\tv_exp_f32 %13, %13\n\tv_exp_f32 %14, %14\n\tv_exp_f32 %15, %15\n\t" : "+v"(r[0]), "+v"(r[1]), "+v"(r[2]), "+v"(r[3]), "+v"(r[4]), "+v"(r[5]), "+v"(r[6]), "+v"(r[7]), "+v"(r[8]), "+v"(r[9]), "+v"(r[10]), "+v"(r[11]), "+v"(r[12]), "+v"(r[13]), "+v"(r[14]), "+v"(r[15]) : "v"(a), "v"(b) : "s40", "vcc");
        asm volatile("v_exp_f32 %0, %0\n\tv_exp_f32 %1, %1\n\tv_exp_f32 %2, %2\n\tv_exp_f32 %3, %3\n\tv_exp_f32 %4, %4\n\tv_exp_f32 %5, %5\n\tv_exp_f32 %6, %6\n\tv_exp_f32 %7, %7\n\tv_exp_f32 %8, %8\n\tv_exp_f32 %9, %9\n\tv_exp_f32 %10, %10\n\tv_exp_f32 %11, %11\n\tv_exp_f32 %12, %12\n\tv_exp_f32 %13, %13\n\tv_exp_f32 %14, %14\n\tv_exp_f32 %15, %15\n\t" : "+v"(r[0]), "+v"(r[1]), "+v"(r[2]), "+v"(r[3]), "+v"(r[4]), "+v"(r[5]), "+v"(r[6]), "+v"(r[7]), "+v"(r[8]), "+v"(r[9]), "+v"(r[10]), "+v"(r[11]), "+v"(r[12]), "+v"(r[13]), "+v"(r[14]), "+v"(r[15]) : "v"(a), "v"(b) : "s40", "vcc");
#endif
#if PROBE_UB == 12
        asm volatile("v_fmac_f32 %0, %16, %17\n\tv_fmac_f32 %1, %16, %17\n\tv_fmac_f32 %2, %16, %17\n\tv_fmac_f32 %3, %16, %17\n\tv_fmac_f32 %4, %16, %17\n\tv_fmac_f32 %5, %16, %17\n\tv_fmac_f32 %6, %16, %17\n\tv_fmac_f32 %7, %16, %17\n\tv_fmac_f32 %8, %16, %17\n\tv_fmac_f32 %9, %16, %17\n\tv_fmac_f32 %10, %16, %17\n\tv_fmac_f32 %11, %16, %17\n\tv_fmac_f32 %12, %16, %17\n\tv_fmac_f32 %13, %16, %17\n\tv_fmac_f32 %14, %16, %17\n\tv_fmac_f32 %15, %16, %17\n\t" : "+v"(r[0]), "+v"(r[1]), "+v"(r[2]), "+v"(r[3]), "+v"(r[4]), "+v"(r[5]), "+v"(r[6]), "+v"(r[7]), "+v"(r[8]), "+v"(r[9]), "+v"(r[10]), "+v"(r[11]), "+v"(r[12]), "+v"(r[13]), "+v"(r[14]), "+v"(r[15]) : "v"(a), "v"(b) : "s40", "vcc");
        asm volatile("v_fmac_f32 %0, %16, %17\n\tv_fmac_f32 %1, %16, %17\n\tv_fmac_f32 %2, %16, %17\n\tv_fmac_f32 %3, %16, %17\n\tv_fmac_f32 %4, %16, %17\n\tv_fmac_f32 %5, %16, %17\n\tv_fmac_f32 %6, %16, %17\n\tv_fmac_f32 %7, %16, %17\n\tv_fmac_f32 %8, %16, %17\n\tv_fmac_f32 %9, %16, %17\n\tv_fmac_f32 %10, %16, %17\n\tv_fmac_f32 %11, %16, %17\n\tv_fmac_f32 %12, %16, %17\n\tv_fmac_f32 %13, %16, %17\n\tv_fmac_f32 %14, %16, %17\n\tv_fmac_f32 %15, %16, %17\n\t" : "+v"(r[0]), "+v"(r[1]), "+v"(r[2]), "+v"(r[3]), "+v"(r[4]), "+v"(r[5]), "+v"(r[6]), "+v"(r[7]), "+v"(r[8]), "+v"(r[9]), "+v"(r[10]), "+v"(r[11]), "+v"(r[12]), "+v"(r[13]), "+v"(r[14]), "+v"(r[15]) : "v"(a), "v"(b) : "s40", "vcc");
#endif
#if PROBE_UB == 13
        asm volatile("v_add_u32_dpp %0, %16, %0 quad_perm:[1,0,3,2] row_mask:0xf bank_mask:0xf\n\tv_add_u32_dpp %1, %16, %1 quad_perm:[1,0,3,2] row_mask:0xf bank_mask:0xf\n\tv_add_u32_dpp %2, %16, %2 quad_perm:[1,0,3,2] row_mask:0xf bank_mask:0xf\n\tv_add_u32_dpp %3, %16, %3 quad_perm:[1,0,3,2] row_mask:0xf bank_mask:0xf\n\tv_add_u32_dpp %4, %16, %4 quad_perm:[1,0,3,2] row_mask:0xf bank_mask:0xf\n\tv_add_u32_dpp %5, %16, %5 quad_perm:[1,0,3,2] row_mask:0xf bank_mask:0xf\n\tv_add_u32_dpp %6, %16, %6 quad_perm:[1,0,3,2] row_mask:0xf bank_mask:0xf\n\tv_add_u32_dpp %7, %16, %7 quad_perm:[1,0,3,2] row_mask:0xf bank_mask:0xf\n\tv_add_u32_dpp %8, %16, %8 quad_perm:[1,0,3,2] row_mask:0xf bank_mask:0xf\n\tv_add_u32_dpp %9, %16, %9 quad_perm:[1,0,3,2] row_mask:0xf bank_mask:0xf\n\tv_add_u32_dpp %10, %16, %10 quad_perm:[1,0,3,2] row_mask:0xf bank_mask:0xf\n\tv_add_u32_dpp %11, %16, %11 quad_perm:[1,0,3,2] row_mask:0xf bank_mask:0xf\n\tv_add_u32_dpp %12, %16, %12 quad_perm:[1,0,3,2] row_mask:0xf bank_mask:0xf\n\tv_add_u32_dpp %13, %16, %13 quad_perm:[1,0,3,2] row_mask:0xf bank_mask:0xf\n\tv_add_u32_dpp %14, %16, %14 quad_perm:[1,0,3,2] row_mask:0xf bank_mask:0xf\n\tv_add_u32_dpp %15, %16, %15 quad_perm:[1,0,3,2] row_mask:0xf bank_mask:0xf\n\t" : "+v"(r[0]), "+v"(r[1]), "+v"(r[2]), "+v"(r[3]), "+v"(r[4]), "+v"(r[5]), "+v"(r[6]), "+v"(r[7]), "+v"(r[8]), "+v"(r[9]), "+v"(r[10]), "+v"(r[11]), "+v"(r[12]), "+v"(r[13]), "+v"(r[14]), "+v"(r[15]) : "v"(a), "v"(b) : "s40", "vcc");
        asm volatile("v_add_u32_dpp %0, %16, %0 quad_perm:[1,0,3,2] row_mask:0xf bank_mask:0xf\n\tv_add_u32_dpp %1, %16, %1 quad_perm:[1,0,3,2] row_mask:0xf bank_mask:0xf\n\tv_add_u32_dpp %2, %16, %2 quad_perm:[1,0,3,2] row_mask:0xf bank_mask:0xf\n\tv_add_u32_dpp %3, %16, %3 quad_perm:[1,0,3,2] row_mask:0xf bank_mask:0xf\n\tv_add_u32_dpp %4, %16, %4 quad_perm:[1,0,3,2] row_mask:0xf bank_mask:0xf\n\tv_add_u32_dpp %5, %16, %5 quad_perm:[1,0,3,2] row_mask:0xf bank_mask:0xf\n\tv_add_u32_dpp %6, %16, %6 quad_perm:[1,0,3,2] row_mask:0xf bank_mask:0xf\n\tv_add_u32_dpp %7, %16, %7 quad_perm:[1,0,3,2] row_mask:0xf bank_mask:0xf\n\tv_add_u32_dpp %8, %16, %8 quad_perm:[1,0,3,2] row_mask:0xf bank_mask:0xf\n\tv_add_u32_dpp %9, %16, %9 quad_perm:[1,0,3,2] row_mask:0xf bank_mask:0xf\n\tv_add_u32_dpp %10, %16, %10 quad_perm:[1,0,3,2] row_mask:0xf bank_mask:0xf\n\tv_add_u32_dpp %11, %16, %11 quad_perm:[1,0,3,2] row_mask:0xf bank_mask:0xf\n\tv_add_u32_dpp %12, %16, %12 quad_perm:[1,0,3,2] row_mask:0xf bank_mask:0xf\n\tv_add_u32_dpp %13, %16, %13 quad_perm:[1,0,3,2] row_mask:0xf bank_mask:0xf\n\tv_add_u32_dpp %14, %16, %14 quad_perm:[1,0,3,2] row_mask:0xf bank_mask:0xf\n\tv_add_u32_dpp %15, %16, %15 quad_perm:[1,0,3,2] row_mask:0xf bank_mask:0xf\n\t" : "+v"(r[0]), "+v"(r[1]), "+v"(r[2]), "+v"(r[3]), "+v"(r[4]), "+v"(r[5]), "+v"(r[6]), "+v"(r[7]), "+v"(r[8]), "+v"(r[9]), "+v"(r[10]), "+v"(r[11]), "+v"(r[12]), "+v"(r[13]), "+v"(r[14]), "+v"(r[15]) : "v"(a), "v"(b) : "s40", "vcc");
#endif
#if PROBE_UB == 14
        asm volatile("v_cvt_f32_ubyte1 %0, %16\n\tv_cvt_f32_ubyte1 %1, %16\n\tv_cvt_f32_ubyte1 %2, %16\n\tv_cvt_f32_ubyte1 %3, %16\n\tv_cvt_f32_ubyte1 %4, %16\n\tv_cvt_f32_ubyte1 %5, %16\n\tv_cvt_f32_ubyte1 %6, %16\n\tv_cvt_f32_ubyte1 %7, %16\n\tv_cvt_f32_ubyte1 %8, %16\n\tv_cvt_f32_ubyte1 %9, %16\n\tv_cvt_f32_ubyte1 %10, %16\n\tv_cvt_f32_ubyte1 %11, %16\n\tv_cvt_f32_ubyte1 %12, %16\n\tv_cvt_f32_ubyte1 %13, %16\n\tv_cvt_f32_ubyte1 %14, %16\n\tv_cvt_f32_ubyte1 %15, %16\n\t" : "+v"(r[0]), "+v"(r[1]), "+v"(r[2]), "+v"(r[3]), "+v"(r[4]), "+v"(r[5]), "+v"(r[6]), "+v"(r[7]), "+v"(r[8]), "+v"(r[9]), "+v"(r[10]), "+v"(r[11]), "+v"(r[12]), "+v"(r[13]), "+v"(r[14]), "+v"(r[15]) : "v"(a), "v"(b) : "s40", "vcc");
        asm volatile("v_cvt_f32_ubyte1 %0, %16\n\tv_cvt_f32_ubyte1 %1, %16\n\tv_cvt_f32_ubyte1 %2, %16\n\tv_cvt_f32_ubyte1 %3, %16\n\tv_cvt_f32_ubyte1 %4, %16\n\tv_cvt_f32_ubyte1 %5, %16\n\tv_cvt_f32_ubyte1 %6, %16\n\tv_cvt_f32_ubyte1 %7, %16\n\tv_cvt_f32_ubyte1 %8, %16\n\tv_cvt_f32_ubyte1 %9, %16\n\tv_cvt_f32_ubyte1 %10, %16\n\tv_cvt_f32_ubyte1 %11, %16\n\tv_cvt_f32_ubyte1 %12, %16\n\tv_cvt_f32_ubyte1 %13, %16\n\tv_cvt_f32_ubyte1 %14, %16\n\tv_cvt_f32_ubyte1 %15, %16\n\t" : "+v"(r[0]), "+v"(r[1]), "+v"(r[2]), "+v"(r[3]), "+v"(r[4]), "+v"(r[5]), "+v"(r[6]), "+v"(r[7]), "+v"(r[8]), "+v"(r[9]), "+v"(r[10]), "+v"(r[11]), "+v"(r[12]), "+v"(r[13]), "+v"(r[14]), "+v"(r[15]) : "v"(a), "v"(b) : "s40", "vcc");
#endif
#if PROBE_UB == 16
        asm volatile("v_max_f32 %0, %0, %16\n\tv_max_f32 %1, %1, %16\n\tv_max_f32 %2, %2, %16\n\tv_max_f32 %3, %3, %16\n\tv_max_f32 %4, %4, %16\n\tv_max_f32 %5, %5, %16\n\tv_max_f32 %6, %6, %16\n\tv_max_f32 %7, %7, %16\n\tv_max_f32 %8, %8, %16\n\tv_max_f32 %9, %9, %16\n\tv_max_f32 %10, %10, %16\n\tv_max_f32 %11, %11, %16\n\tv_max_f32 %12, %12, %16\n\tv_max_f32 %13, %13, %16\n\tv_max_f32 %14, %14, %16\n\tv_max_f32 %15, %15, %16\n\t" : "+v"(r[0]), "+v"(r[1]), "+v"(r[2]), "+v"(r[3]), "+v"(r[4]), "+v"(r[5]), "+v"(r[6]), "+v"(r[7]), "+v"(r[8]), "+v"(r[9]), "+v"(r[10]), "+v"(r[11]), "+v"(r[12]), "+v"(r[13]), "+v"(r[14]), "+v"(r[15]) : "v"(a), "v"(b) : "s40", "s41", "vcc");
        asm volatile("v_max_f32 %0, %0, %16\n\tv_max_f32 %1, %1, %16\n\tv_max_f32 %2, %2, %16\n\tv_max_f32 %3, %3, %16\n\tv_max_f32 %4, %4, %16\n\tv_max_f32 %5, %5, %16\n\tv_max_f32 %6, %6, %16\n\tv_max_f32 %7, %7, %16\n\tv_max_f32 %8, %8, %16\n\tv_max_f32 %9, %9, %16\n\tv_max_f32 %10, %10, %16\n\tv_max_f32 %11, %11, %16\n\tv_max_f32 %12, %12, %16\n\tv_max_f32 %13, %13, %16\n\tv_max_f32 %14, %14, %16\n\tv_max_f32 %15, %15, %16\n\t" : "+v"(r[0]), "+v"(r[1]), "+v"(r[2]), "+v"(r[3]), "+v"(r[4]), "+v"(r[5]), "+v"(r[6]), "+v"(r[7]), "+v"(r[8]), "+v"(r[9]), "+v"(r[10]), "+v"(r[11]), "+v"(r[12]), "+v"(r[13]), "+v"(r[14]), "+v"(r[15]) : "v"(a), "v"(b) : "s40", "s41", "vcc");
#endif
#if PROBE_UB == 17
        asm volatile("v_cndmask_b32 %0, %0, %16, s[40:41]\n\tv_cndmask_b32 %1, %1, %16, s[40:41]\n\tv_cndmask_b32 %2, %2, %16, s[40:41]\n\tv_cndmask_b32 %3, %3, %16, s[40:41]\n\tv_cndmask_b32 %4, %4, %16, s[40:41]\n\tv_cndmask_b32 %5, %5, %16, s[40:41]\n\tv_cndmask_b32 %6, %6, %16, s[40:41]\n\tv_cndmask_b32 %7, %7, %16, s[40:41]\n\tv_cndmask_b32 %8, %8, %16, s[40:41]\n\tv_cndmask_b32 %9, %9, %16, s[40:41]\n\tv_cndmask_b32 %10, %10, %16, s[40:41]\n\tv_cndmask_b32 %11, %11, %16, s[40:41]\n\tv_cndmask_b32 %12, %12, %16, s[40:41]\n\tv_cndmask_b32 %13, %13, %16, s[40:41]\n\tv_cndmask_b32 %14, %14, %16, s[40:41]\n\tv_cndmask_b32 %15, %15, %16, s[40:41]\n\t" : "+v"(r[0]), "+v"(r[1]), "+v"(r[2]), "+v"(r[3]), "+v"(r[4]), "+v"(r[5]), "+v"(r[6]), "+v"(r[7]), "+v"(r[8]), "+v"(r[9]), "+v"(r[10]), "+v"(r[11]), "+v"(r[12]), "+v"(r[13]), "+v"(r[14]), "+v"(r[15]) : "v"(a), "v"(b) : "s40", "s41", "vcc");
        asm volatile("v_cndmask_b32 %0, %0, %16, s[40:41]\n\tv_cndmask_b32 %1, %1, %16, s[40:41]\n\tv_cndmask_b32 %2, %2, %16, s[40:41]\n\tv_cndmask_b32 %3, %3, %16, s[40:41]\n\tv_cndmask_b32 %4, %4, %16, s[40:41]\n\tv_cndmask_b32 %5, %5, %16, s[40:41]\n\tv_cndmask_b32 %6, %6, %16, s[40:41]\n\tv_cndmask_b32 %7, %7, %16, s[40:41]\n\tv_cndmask_b32 %8, %8, %16, s[40:41]\n\tv_cndmask_b32 %9, %9, %16, s[40:41]\n\tv_cndmask_b32 %10, %10, %16, s[40:41]\n\tv_cndmask_b32 %11, %11, %16, s[40:41]\n\tv_cndmask_b32 %12, %12, %16, s[40:41]\n\tv_cndmask_b32 %13, %13, %16, s[40:41]\n\tv_cndmask_b32 %14, %14, %16, s[40:41]\n\tv_cndmask_b32 %15, %15, %16, s[40:41]\n\t" : "+v"(r[0]), "+v"(r[1]), "+v"(r[2]), "+v"(r[3]), "+v"(r[4]), "+v"(r[5]), "+v"(r[6]), "+v"(r[7]), "+v"(r[8]), "+v"(r[9]), "+v"(r[10]), "+v"(r[11]), "+v"(r[12]), "+v"(r[13]), "+v"(r[14]), "+v"(r[15]) : "v"(a), "v"(b) : "s40", "s41", "vcc");
#endif
#if PROBE_UB == 18
        asm volatile("v_min_u32 %0, %0, %16\n\tv_min_u32 %1, %1, %16\n\tv_min_u32 %2, %2, %16\n\tv_min_u32 %3, %3, %16\n\tv_min_u32 %4, %4, %16\n\tv_min_u32 %5, %5, %16\n\tv_min_u32 %6, %6, %16\n\tv_min_u32 %7, %7, %16\n\tv_min_u32 %8, %8, %16\n\tv_min_u32 %9, %9, %16\n\tv_min_u32 %10, %10, %16\n\tv_min_u32 %11, %11, %16\n\tv_min_u32 %12, %12, %16\n\tv_min_u32 %13, %13, %16\n\tv_min_u32 %14, %14, %16\n\tv_min_u32 %15, %15, %16\n\t" : "+v"(r[0]), "+v"(r[1]), "+v"(r[2]), "+v"(r[3]), "+v"(r[4]), "+v"(r[5]), "+v"(r[6]), "+v"(r[7]), "+v"(r[8]), "+v"(r[9]), "+v"(r[10]), "+v"(r[11]), "+v"(r[12]), "+v"(r[13]), "+v"(r[14]), "+v"(r[15]) : "v"(a), "v"(b) : "s40", "s41", "vcc");
        asm volatile("v_min_u32 %0, %0, %16\n\tv_min_u32 %1, %1, %16\n\tv_min_u32 %2, %2, %16\n\tv_min_u32 %3, %3, %16\n\tv_min_u32 %4, %4, %16\n\tv_min_u32 %5, %5, %16\n\tv_min_u32 %6, %6, %16\n\tv_min_u32 %7, %7, %16\n\tv_min_u32 %8, %8, %16\n\tv_min_u32 %9, %9, %16\n\tv_min_u32 %10, %10, %16\n\tv_min_u32 %11, %11, %16\n\tv_min_u32 %12, %12, %16\n\tv_min_u32 %13, %13, %16\n\tv_min_u32 %14, %14, %16\n\tv_min_u32 %15, %15, %16\n\t" : "+v"(r[0]), "+v"(r[1]), "+v"(r[2]), "+v"(r[3]), "+v"(r[4]), "+v"(r[5]), "+v"(r[6]), "+v"(r[7]), "+v"(r[8]), "+v"(r[9]), "+v"(r[10]), "+v"(r[11]), "+v"(r[12]), "+v"(r[13]), "+v"(r[14]), "+v"(r[15]) : "v"(a), "v"(b) : "s40", "s41", "vcc");
#endif
#if PROBE_UB == 19
        asm volatile("v_and_b32 %0, %0, %16\n\tv_and_b32 %1, %1, %16\n\tv_and_b32 %2, %2, %16\n\tv_and_b32 %3, %3, %16\n\tv_and_b32 %4, %4, %16\n\tv_and_b32 %5, %5, %16\n\tv_and_b32 %6, %6, %16\n\tv_and_b32 %7, %7, %16\n\tv_and_b32 %8, %8, %16\n\tv_and_b32 %9, %9, %16\n\tv_and_b32 %10, %10, %16\n\tv_and_b32 %11, %11, %16\n\tv_and_b32 %12, %12, %16\n\tv_and_b32 %13, %13, %16\n\tv_and_b32 %14, %14, %16\n\tv_and_b32 %15, %15, %16\n\t" : "+v"(r[0]), "+v"(r[1]), "+v"(r[2]), "+v"(r[3]), "+v"(r[4]), "+v"(r[5]), "+v"(r[6]), "+v"(r[7]), "+v"(r[8]), "+v"(r[9]), "+v"(r[10]), "+v"(r[11]), "+v"(r[12]), "+v"(r[13]), "+v"(r[14]), "+v"(r[15]) : "v"(a), "v"(b) : "s40", "s41", "vcc");
        asm volatile("v_and_b32 %0, %0, %16\n\tv_and_b32 %1, %1, %16\n\tv_and_b32 %2, %2, %16\n\tv_and_b32 %3, %3, %16\n\tv_and_b32 %4, %4, %16\n\tv_and_b32 %5, %5, %16\n\tv_and_b32 %6, %6, %16\n\tv_and_b32 %7, %7, %16\n\tv_and_b32 %8, %8, %16\n\tv_and_b32 %9, %9, %16\n\tv_and_b32 %10, %10, %16\n\tv_and_b32 %11, %11, %16\n\tv_and_b32 %12, %12, %16\n\tv_and_b32 %13, %13, %16\n\tv_and_b32 %14, %14, %16\n\tv_and_b32 %15, %15, %16\n\t" : "+v"(r[0]), "+v"(r[1]), "+v"(r[2]), "+v"(r[3]), "+v"(r[4]), "+v"(r[5]), "+v"(r[6]), "+v"(r[7]), "+v"(r[8]), "+v"(r[9]), "+v"(r[10]), "+v"(r[11]), "+v"(r[12]), "+v"(r[13]), "+v"(r[14]), "+v"(r[15]) : "v"(a), "v"(b) : "s40", "s41", "vcc");
#endif
#if PROBE_UB == 20
        asm volatile("v_lshrrev_b32 %0, 4, %0\n\tv_lshrrev_b32 %1, 4, %1\n\tv_lshrrev_b32 %2, 4, %2\n\tv_lshrrev_b32 %3, 4, %3\n\tv_lshrrev_b32 %4, 4, %4\n\tv_lshrrev_b32 %5, 4, %5\n\tv_lshrrev_b32 %6, 4, %6\n\tv_lshrrev_b32 %7, 4, %7\n\tv_lshrrev_b32 %8, 4, %8\n\tv_lshrrev_b32 %9, 4, %9\n\tv_lshrrev_b32 %10, 4, %10\n\tv_lshrrev_b32 %11, 4, %11\n\tv_lshrrev_b32 %12, 4, %12\n\tv_lshrrev_b32 %13, 4, %13\n\tv_lshrrev_b32 %14, 4, %14\n\tv_lshrrev_b32 %15, 4, %15\n\t" : "+v"(r[0]), "+v"(r[1]), "+v"(r[2]), "+v"(r[3]), "+v"(r[4]), "+v"(r[5]), "+v"(r[6]), "+v"(r[7]), "+v"(r[8]), "+v"(r[9]), "+v"(r[10]), "+v"(r[11]), "+v"(r[12]), "+v"(r[13]), "+v"(r[14]), "+v"(r[15]) : "v"(a), "v"(b) : "s40", "s41", "vcc");
        asm volatile("v_lshrrev_b32 %0, 4, %0\n\tv_lshrrev_b32 %1, 4, %1\n\tv_lshrrev_b32 %2, 4, %2\n\tv_lshrrev_b32 %3, 4, %3\n\tv_lshrrev_b32 %4, 4, %4\n\tv_lshrrev_b32 %5, 4, %5\n\tv_lshrrev_b32 %6, 4, %6\n\tv_lshrrev_b32 %7, 4, %7\n\tv_lshrrev_b32 %8, 4, %8\n\tv_lshrrev_b32 %9, 4, %9\n\tv_lshrrev_b32 %10, 4, %10\n\tv_lshrrev_b32 %11, 4, %11\n\tv_lshrrev_b32 %12, 4, %12\n\tv_lshrrev_b32 %13, 4, %13\n\tv_lshrrev_b32 %14, 4, %14\n\tv_lshrrev_b32 %15, 4, %15\n\t" : "+v"(r[0]), "+v"(r[1]), "+v"(r[2]), "+v"(r[3]), "+v"(r[4]), "+v"(r[5]), "+v"(r[6]), "+v"(r[7]), "+v"(r[8]), "+v"(r[9]), "+v"(r[10]), "+v"(r[11]), "+v"(r[12]), "+v"(r[13]), "+v"(r[14]), "+v"(r[15]) : "v"(a), "v"(b) : "s40", "s41", "vcc");
#endif
#if PROBE_UB == 21
        asm volatile("v_mul_f32 %0, %0, %16\n\tv_mul_f32 %1, %1, %16\n\tv_mul_f32 %2, %2, %16\n\tv_mul_f32 %3, %3, %16\n\tv_mul_f32 %4, %4, %16\n\tv_mul_f32 %5, %5, %16\n\tv_mul_f32 %6, %6, %16\n\tv_mul_f32 %7, %7, %16\n\tv_mul_f32 %8, %8, %16\n\tv_mul_f32 %9, %9, %16\n\tv_mul_f32 %10, %10, %16\n\tv_mul_f32 %11, %11, %16\n\tv_mul_f32 %12, %12, %16\n\tv_mul_f32 %13, %13, %16\n\tv_mul_f32 %14, %14, %16\n\tv_mul_f32 %15, %15, %16\n\t" : "+v"(r[0]), "+v"(r[1]), "+v"(r[2]), "+v"(r[3]), "+v"(r[4]), "+v"(r[5]), "+v"(r[6]), "+v"(r[7]), "+v"(r[8]), "+v"(r[9]), "+v"(r[10]), "+v"(r[11]), "+v"(r[12]), "+v"(r[13]), "+v"(r[14]), "+v"(r[15]) : "v"(a), "v"(b) : "s40", "s41", "vcc");
        asm volatile("v_mul_f32 %0, %0, %16\n\tv_mul_f32 %1, %1, %16\n\tv_mul_f32 %2, %2, %16\n\tv_mul_f32 %3, %3, %16\n\tv_mul_f32 %4, %4, %16\n\tv_mul_f32 %5, %5, %16\n\tv_mul_f32 %6, %6, %16\n\tv_mul_f32 %7, %7, %16\n\tv_mul_f32 %8, %8, %16\n\tv_mul_f32 %9, %9, %16\n\tv_mul_f32 %10, %10, %16\n\tv_mul_f32 %11, %11, %16\n\tv_mul_f32 %12, %12, %16\n\tv_mul_f32 %13, %13, %16\n\tv_mul_f32 %14, %14, %16\n\tv_mul_f32 %15, %15, %16\n\t" : "+v"(r[0]), "+v"(r[1]), "+v"(r[2]), "+v"(r[3]), "+v"(r[4]), "+v"(r[5]), "+v"(r[6]), "+v"(r[7]), "+v"(r[8]), "+v"(r[9]), "+v"(r[10]), "+v"(r[11]), "+v"(r[12]), "+v"(r[13]), "+v"(r[14]), "+v"(r[15]) : "v"(a), "v"(b) : "s40", "s41", "vcc");
#endif
#if PROBE_UB == 22
        asm volatile("v_add_u32 %0, %0, %16\n\tv_add_u32 %1, %1, %16\n\tv_add_u32 %2, %2, %16\n\tv_add_u32 %3, %3, %16\n\tv_add_u32 %4, %4, %16\n\tv_add_u32 %5, %5, %16\n\tv_add_u32 %6, %6, %16\n\tv_add_u32 %7, %7, %16\n\tv_add_u32 %8, %8, %16\n\tv_add_u32 %9, %9, %16\n\tv_add_u32 %10, %10, %16\n\tv_add_u32 %11, %11, %16\n\tv_add_u32 %12, %12, %16\n\tv_add_u32 %13, %13, %16\n\tv_add_u32 %14, %14, %16\n\tv_add_u32 %15, %15, %16\n\t" : "+v"(r[0]), "+v"(r[1]), "+v"(r[2]), "+v"(r[3]), "+v"(r[4]), "+v"(r[5]), "+v"(r[6]), "+v"(r[7]), "+v"(r[8]), "+v"(r[9]), "+v"(r[10]), "+v"(r[11]), "+v"(r[12]), "+v"(r[13]), "+v"(r[14]), "+v"(r[15]) : "v"(a), "v"(b) : "s40", "s41", "vcc");
        asm volatile("v_add_u32 %0, %0, %16\n\tv_add_u32 %1, %1, %16\n\tv_add_u32 %2, %2, %16\n\tv_add_u32 %3, %3, %16\n\tv_add_u32 %4, %4, %16\n\tv_add_u32 %5, %5, %16\n\tv_add_u32 %6, %6, %16\n\tv_add_u32 %7, %7, %16\n\tv_add_u32 %8, %8, %16\n\tv_add_u32 %9, %9, %16\n\tv_add_u32 %10, %10, %16\n\tv_add_u32 %11, %11, %16\n\tv_add_u32 %12, %12, %16\n\tv_add_u32 %13, %13, %16\n\tv_add_u32 %14, %14, %16\n\tv_add_u32 %15, %15, %16\n\t" : "+v"(r[0]), "+v"(r[1]), "+v"(r[2]), "+v"(r[3]), "+v"(r[4]), "+v"(r[5]), "+v"(r[6]), "+v"(r[7]), "+v"(r[8]), "+v"(r[9]), "+v"(r[10]), "+v"(r[11]), "+v"(r[12]), "+v"(r[13]), "+v"(r[14]), "+v"(r[15]) : "v"(a), "v"(b) : "s40", "s41", "vcc");
#endif
#if PROBE_UB == 23
        asm volatile("v_cvt_pk_bf16_f32 %0, %0, %16\n\tv_cvt_pk_bf16_f32 %1, %1, %16\n\tv_cvt_pk_bf16_f32 %2, %2, %16\n\tv_cvt_pk_bf16_f32 %3, %3, %16\n\tv_cvt_pk_bf16_f32 %4, %4, %16\n\tv_cvt_pk_bf16_f32 %5, %5, %16\n\tv_cvt_pk_bf16_f32 %6, %6, %16\n\tv_cvt_pk_bf16_f32 %7, %7, %16\n\tv_cvt_pk_bf16_f32 %8, %8, %16\n\tv_cvt_pk_bf16_f32 %9, %9, %16\n\tv_cvt_pk_bf16_f32 %10, %10, %16\n\tv_cvt_pk_bf16_f32 %11, %11, %16\n\tv_cvt_pk_bf16_f32 %12, %12, %16\n\tv_cvt_pk_bf16_f32 %13, %13, %16\n\tv_cvt_pk_bf16_f32 %14, %14, %16\n\tv_cvt_pk_bf16_f32 %15, %15, %16\n\t" : "+v"(r[0]), "+v"(r[1]), "+v"(r[2]), "+v"(r[3]), "+v"(r[4]), "+v"(r[5]), "+v"(r[6]), "+v"(r[7]), "+v"(r[8]), "+v"(r[9]), "+v"(r[10]), "+v"(r[11]), "+v"(r[12]), "+v"(r[13]), "+v"(r[14]), "+v"(r[15]) : "v"(a), "v"(b) : "s40", "s41", "vcc");
        asm volatile("v_cvt_pk_bf16_f32 %0, %0, %16\n\tv_cvt_pk_bf16_f32 %1, %1, %16\n\tv_cvt_pk_bf16_f32 %2, %2, %16\n\tv_cvt_pk_bf16_f32 %3, %3, %16\n\tv_cvt_pk_bf16_f32 %4, %4, %16\n\tv_cvt_pk_bf16_f32 %5, %5, %16\n\tv_cvt_pk_bf16_f32 %6, %6, %16\n\tv_cvt_pk_bf16_f32 %7, %7, %16\n\tv_cvt_pk_bf16_f32 %8, %8, %16\n\tv_cvt_pk_bf16_f32 %9, %9, %16\n\tv_cvt_pk_bf16_f32 %10, %10, %16\n\tv_cvt_pk_bf16_f32 %11, %11, %16\n\tv_cvt_pk_bf16_f32 %12, %12, %16\n\tv_cvt_pk_bf16_f32 %13, %13, %16\n\tv_cvt_pk_bf16_f32 %14, %14, %16\n\tv_cvt_pk_bf16_f32 %15, %15, %16\n\t" : "+v"(r[0]), "+v"(r[1]), "+v"(r[2]), "+v"(r[3]), "+v"(r[4]), "+v"(r[5]), "+v"(r[6]), "+v"(r[7]), "+v"(r[8]), "+v"(r[9]), "+v"(r[10]), "+v"(r[11]), "+v"(r[12]), "+v"(r[13]), "+v"(r[14]), "+v"(r[15]) : "v"(a), "v"(b) : "s40", "s41", "vcc");
#endif
#if PROBE_UB == 24
        asm volatile("v_dot8c_i32_i4 %0, %16, %17\n\tv_dot8c_i32_i4 %1, %16, %17\n\tv_dot8c_i32_i4 %2, %16, %17\n\tv_dot8c_i32_i4 %3, %16, %17\n\tv_dot8c_i32_i4 %4, %16, %17\n\tv_dot8c_i32_i4 %5, %16, %17\n\tv_dot8c_i32_i4 %6, %16, %17\n\tv_dot8c_i32_i4 %7, %16, %17\n\tv_dot8c_i32_i4 %8, %16, %17\n\tv_dot8c_i32_i4 %9, %16, %17\n\tv_dot8c_i32_i4 %10, %16, %17\n\tv_dot8c_i32_i4 %11, %16, %17\n\tv_dot8c_i32_i4 %12, %16, %17\n\tv_dot8c_i32_i4 %13, %16, %17\n\tv_dot8c_i32_i4 %14, %16, %17\n\tv_dot8c_i32_i4 %15, %16, %17\n\t" : "+v"(r[0]), "+v"(r[1]), "+v"(r[2]), "+v"(r[3]), "+v"(r[4]), "+v"(r[5]), "+v"(r[6]), "+v"(r[7]), "+v"(r[8]), "+v"(r[9]), "+v"(r[10]), "+v"(r[11]), "+v"(r[12]), "+v"(r[13]), "+v"(r[14]), "+v"(r[15]) : "v"(a), "v"(b) : "s40", "s41", "vcc");
        asm volatile("v_dot8c_i32_i4 %0, %16, %17\n\tv_dot8c_i32_i4 %1, %16, %17\n\tv_dot8c_i32_i4 %2, %16, %17\n\tv_dot8c_i32_i4 %3, %16, %17\n\tv_dot8c_i32_i4 %4, %16, %17\n\tv_dot8c_i32_i4 %5, %16, %17\n\tv_dot8c_i32_i4 %6, %16, %17\n\tv_dot8c_i32_i4 %7, %16, %17\n\tv_dot8c_i32_i4 %8, %16, %17\n\tv_dot8c_i32_i4 %9, %16, %17\n\tv_dot8c_i32_i4 %10, %16, %17\n\tv_dot8c_i32_i4 %11, %16, %17\n\tv_dot8c_i32_i4 %12, %16, %17\n\tv_dot8c_i32_i4 %13, %16, %17\n\tv_dot8c_i32_i4 %14, %16, %17\n\tv_dot8c_i32_i4 %15, %16, %17\n\t" : "+v"(r[0]), "+v"(r[1]), "+v"(r[2]), "+v"(r[3]), "+v"(r[4]), "+v"(r[5]), "+v"(r[6]), "+v"(r[7]), "+v"(r[8]), "+v"(r[9]), "+v"(r[10]), "+v"(r[11]), "+v"(r[12]), "+v"(r[13]), "+v"(r[14]), "+v"(r[15]) : "v"(a), "v"(b) : "s40", "s41", "vcc");
#endif
#if PROBE_UB == 25
        asm volatile("v_xor_b32 %0, %0, %16\n\tv_xor_b32 %1, %1, %16\n\tv_xor_b32 %2, %2, %16\n\tv_xor_b32 %3, %3, %16\n\tv_xor_b32 %4, %4, %16\n\tv_xor_b32 %5, %5, %16\n\tv_xor_b32 %6, %6, %16\n\tv_xor_b32 %7, %7, %16\n\tv_xor_b32 %8, %8, %16\n\tv_xor_b32 %9, %9, %16\n\tv_xor_b32 %10, %10, %16\n\tv_xor_b32 %11, %11, %16\n\tv_xor_b32 %12, %12, %16\n\tv_xor_b32 %13, %13, %16\n\tv_xor_b32 %14, %14, %16\n\tv_xor_b32 %15, %15, %16\n\t" : "+v"(r[0]), "+v"(r[1]), "+v"(r[2]), "+v"(r[3]), "+v"(r[4]), "+v"(r[5]), "+v"(r[6]), "+v"(r[7]), "+v"(r[8]), "+v"(r[9]), "+v"(r[10]), "+v"(r[11]), "+v"(r[12]), "+v"(r[13]), "+v"(r[14]), "+v"(r[15]) : "v"(a), "v"(b) : "s40", "s41", "vcc");
        asm volatile("v_xor_b32 %0, %0, %16\n\tv_xor_b32 %1, %1, %16\n\tv_xor_b32 %2, %2, %16\n\tv_xor_b32 %3, %3, %16\n\tv_xor_b32 %4, %4, %16\n\tv_xor_b32 %5, %5, %16\n\tv_xor_b32 %6, %6, %16\n\tv_xor_b32 %7, %7, %16\n\tv_xor_b32 %8, %8, %16\n\tv_xor_b32 %9, %9, %16\n\tv_xor_b32 %10, %10, %16\n\tv_xor_b32 %11, %11, %16\n\tv_xor_b32 %12, %12, %16\n\tv_xor_b32 %13, %13, %16\n\tv_xor_b32 %14, %14, %16\n\tv_xor_b32 %15, %15, %16\n\t" : "+v"(r[0]), "+v"(r[1]), "+v"(r[2]), "+v"(r[3]), "+v"(r[4]), "+v"(r[5]), "+v"(r[6]), "+v"(r[7]), "+v"(r[8]), "+v"(r[9]), "+v"(r[10]), "+v"(r[11]), "+v"(r[12]), "+v"(r[13]), "+v"(r[14]), "+v"(r[15]) : "v"(a), "v"(b) : "s40", "s41", "vcc");
#endif
    }
    float s = 0.f;
#pragma unroll
    for (int i = 0; i < 16; ++i) s += r[i];
#pragma unroll
    for (int i = 0; i < 8; ++i) s += r2[i].x + r2[i].y;
    if (s == 1.2345e-33f) asm volatile("s_nop 0" ::: "memory");
}
#endif
__device__ __forceinline__ void phase_mod(const Params& p, LAS unsigned char* lds, int wv) {
    const int tid = tid_opaque(wv);
    LAS float* sc = (LAS float*)lds;
    LAS float* red = (LAS float*)(lds + 32768);
    {
        float cv[16];
#pragma unroll
        for (int q = 0; q < 16; ++q) cv[q] = p.c[tid + 512 * q];
#pragma unroll
        for (int q = 0; q < 16; ++q) { const int i = tid + 512 * q, b = i >> 10, k = i & 1023; sc[k * 8 + b] = cv[q] / (1.0f + __expf(-cv[q])); }
    }
    __syncthreads();
    const int kg = tid >> 5, cl = tid & 31;
    for (int u = blockIdx.x; u < DEPTH * 64; u += gridDim.x) {
        const int l = u >> 6, j0 = (u & 63) * 96;
        const float* w = p.w_mod + (size_t)l * D_MODEL * MODW + (size_t)(kg * 64) * MODW + j0 + cl;
        float acc[3][8];
#pragma unroll
        for (int q = 0; q < 3; ++q)
#pragma unroll
            for (int b = 0; b < 8; ++b) acc[q][b] = 0.f;
#pragma unroll 8
        for (int kk = 0; kk < 64; ++kk) {
            const float w0 = w[(size_t)kk * MODW], w1 = w[(size_t)kk * MODW + 32], w2 = w[(size_t)kk * MODW + 64];
            const f32x4 s0 = *(const LAS f32x4*)(sc + (kg * 64 + kk) * 8), s1 = *(const LAS f32x4*)(sc + (kg * 64 + kk) * 8 + 4);
#pragma unroll
            for (int b = 0; b < 4; ++b) { acc[0][b] += s0[b] * w0; acc[1][b] += s0[b] * w1; acc[2][b] += s0[b] * w2; acc[0][4 + b] += s1[b] * w0; acc[1][4 + b] += s1[b] * w1; acc[2][4 + b] += s1[b] * w2; }
        }
#pragma unroll
        for (int q = 0; q < 3; ++q)
#pragma unroll
            for (int b = 0; b < 8; ++b) red[((kg * 3 + q) * 8 + b) * 32 + cl] = acc[q][b];
        __syncthreads();
        for (int o = tid; o < 768; o += 512) {
            float s = 0.f;
#pragma unroll
            for (int g = 0; g < 16; ++g) s += red[g * 768 + o];
            const int ocl = o & 31, ob = (o >> 5) & 7, oq = o >> 8;
            const int j = j0 + oq * 32 + ocl;
            p.mod()[((size_t)l * BATCH + ob) * MODW + j] = s + p.b_mod[(size_t)l * MODW + j];
        }
        __syncthreads();
    }
}

struct BiasqPre { u32x4 w0, w1; f32x4 s[4]; };
__device__ __forceinline__ void biasq_prefetch(const Params& p, int l, int wv, BiasqPre& bp) {
    const int tid = tid_opaque(wv), wave = tid >> 6, lane = tid & 63;
    const int n = min((int)blockIdx.x * NWAVES + wave, 2047);
    const bf16_t* wr = p.WqT() + ((size_t)l * 2048 + n) * D_MODEL + lane * 16;
    bp.w0 = *(const u32x4*)wr; bp.w1 = *(const u32x4*)(wr + 8);
    const float* sh = p.mod() + ((size_t)l * BATCH + wave) * MODW + 3 * D_MODEL + lane * 16;
#pragma unroll
    for (int q = 0; q < 4; ++q) bp.s[q] = *(const f32x4*)(sh + 4 * q);
}
__device__ __forceinline__ void phase_biasq(const Params& p, int l, LAS unsigned char* lds, int wv, const BiasqPre& bp) {
    const int tid = tid_opaque(wv), wave = tid >> 6, lane = tid & 63;
    LAS float* shl = (LAS float*)lds;
#pragma unroll
    for (int q = 0; q < 4; ++q) *(LAS f32x4*)(shl + wave * D_MODEL + lane * 16 + 4 * q) = bp.s[q];
    __syncthreads();
    u32x4 w0 = bp.w0, w1 = bp.w1;
    for (int n = blockIdx.x * NWAVES + wave; n < 2048; n += gridDim.x * NWAVES) {
        if (n != (int)blockIdx.x * NWAVES + wave) {
            const bf16_t* wr = p.WqT() + ((size_t)l * 2048 + n) * D_MODEL + lane * 16;
            w0 = *(const u32x4*)wr; w1 = *(const u32x4*)(wr + 8);
        }
        float w[16];
#pragma unroll
        for (int e = 0; e < 4; ++e) { w[2 * e] = bflo(w0[e]); w[2 * e + 1] = bfhi(w0[e]); w[8 + 2 * e] = bflo(w1[e]); w[8 + 2 * e + 1] = bfhi(w1[e]); }
        float sb[BATCH];
#pragma unroll
        for (int b = 0; b < BATCH; ++b) {
            float s2 = 0.f;
#pragma unroll
            for (int q = 0; q < 4; ++q) { const f32x4 v = *(const LAS f32x4*)(shl + b * D_MODEL + lane * 16 + 4 * q); s2 += v[0] * w[4 * q] + v[1] * w[4 * q + 1] + v[2] * w[4 * q + 2] + v[3] * w[4 * q + 3]; }
            sb[b] = s2;
        }
#pragma unroll
        for (int b = 0; b < BATCH; ++b) sb[b] = wave_sum_l63(sb[b]);
        if (lane == 63) {
#pragma unroll
            for (int b = 0; b < BATCH; ++b) p.biasq()[((size_t)l * BATCH + b) * 2048 + n] = sb[b];
        }
    }
    __syncthreads();
}

#ifndef PROBE_TIME
#define PROBE_TIME 0
#endif
#if PROBE_TIME || PROBE_UB
#define PT_BEGIN(k) do { if ((k) == PROBE_TIME) pt_t0 = __builtin_amdgcn_s_memrealtime(); } while (0)
#define PT_END(k) do { if ((k) == PROBE_TIME) pt_acc += __builtin_amdgcn_s_memrealtime() - pt_t0; } while (0)
#else
#define PT_BEGIN(k) do { } while (0)
#define PT_END(k) do { } while (0)
#endif
__global__ void __launch_bounds__(512, 2) k_mega(Params p) {
    extern __shared__ __attribute__((aligned(16))) unsigned char smem_raw[];
    LAS unsigned char* lds = (LAS unsigned char*)smem_raw;
    volatile LAS unsigned* xbw = (volatile LAS unsigned*)(lds + LDS_BYTES - 16);
    const int wv = __builtin_amdgcn_readfirstlane((int)threadIdx.x >> 6);
    if (threadIdx.x == 0) { xbw[0] = 0u; xbw[1] = 0u; xbw[2] = 0u; xbw[3] = 0u; }
    __syncthreads();
    (void)xcd_barrier_post(p.bar(), xbw);
#define GRID_SYNC_AT(k) do { PT_BEGIN(30 + (k)); GRID_SYNC(); PT_END(30 + (k)); } while (0)
#define GRID_SYNC() do { XcdBarrier _b; _b.bar = p.bar(); _b.x = xb_xcc_id(); _b.st = (volatile LAS unsigned*)(lds + LDS_BYTES - 16); _b.t0 = (tid_opaque(wv) == 0); PT_BEGIN(20); xcd_barrier(_b); PT_END(20); } while (0)
#if PROBE_TIME || PROBE_UB
    unsigned long long pt_t0 = 0, pt_acc = 0;
#endif
#if PROBE_UB
    { GRID_SYNC(); const unsigned long long u0 = __builtin_amdgcn_s_memrealtime(); ubench(4000, (unsigned)blockIdx.x); pt_acc += __builtin_amdgcn_s_memrealtime() - u0; GRID_SYNC(); }
#endif
#if PROBE_MASK & 32
    for (int rep = 0; rep < 20; ++rep) GRID_SYNC();
#endif
    PT_BEGIN(1);
    for (int rep = 0; rep < ((PROBE_MASK & 8) ? 2 : 1); ++rep) { phase_mod(p, lds, wv); phase_convert(p, lds, wv); }
    GRID_SYNC();
    PT_END(1); PT_BEGIN(2);
    phase_norm(p, p.x_in, p.norm1_g, p.mod(), 0, 1, wv);
    GRID_SYNC();
    PT_END(2);
    for (int l = 0; l < DEPTH; ++l) {
        const float* modl = p.mod() + (size_t)l * BATCH * MODW;
        PT_BEGIN(3);
        for (int rep = 0; rep < ((PROBE_MASK & 1) ? 2 : 1); ++rep) { EpiStoreBf16 E; E.O = p.pb(); E.ldc = MIX_IN; if (PROBE_MASK & 64) E.live = (rep == 1) || (p.out == nullptr); run_gemm(lds, p.hb(), p.WinT() + (size_t)l * MIX_IN * D_MODEL, NTOK, MIX_IN, D_MODEL, E, wv); }
        convert_in_gemm1_slack(p, l, lds, wv, 1);
        GRID_SYNC_AT(2);
        PT_END(3); PT_BEGIN(4);
        BiasqPre bqp; biasq_prefetch(p, l, wv, bqp);
        PT_BEGIN(10);
        for (int rep = 0; rep < ((PROBE_MASK & 2) ? 2 : 1); ++rep) phase_attn(p, l, lds, wv);
        PT_END(10);
        PT_BEGIN(13);
        for (int rep = 0; rep < ((PROBE_MASK & 16) ? 2 : 1); ++rep) phase_mixrest(p, l, lds, wv);
        PT_END(13);
        phase_biasq(p, l, lds, wv, bqp);
        GRID_SYNC_AT(3);
        PT_END(4); PT_BEGIN(5);
        if (l == 0) { EpiResidNorm<true> E; E.xin32 = p.x_in; E.xin16 = nullptr; E.xout = p.xb(); E.modl = modl; E.n2g = p.norm2_g + l * D_MODEL; E.hb = p.hb(); E.ssq = p.ssq();
          run_gemm(lds, p.cat(), p.WoutT() + (size_t)l * D_MODEL * D_MODEL, NTOK, D_MODEL, D_MODEL, E, wv); }
        else { EpiResidNorm<false> E; E.xin32 = nullptr; E.xin16 = p.xb(); E.xout = p.xb(); E.modl = modl; E.n2g = p.norm2_g + l * D_MODEL; E.hb = p.hb(); E.ssq = p.ssq();
          run_gemm(lds, p.cat(), p.WoutT() + (size_t)l * D_MODEL * D_MODEL, NTOK, D_MODEL, D_MODEL, E, wv); }
        GRID_SYNC_AT(4);
        PT_END(5);
        PT_BEGIN(7);
        for (int rep = 0; rep < ((PROBE_MASK & 1) ? 2 : 1); ++rep) { EpiQ E; E.O = p.qb(); E.ssq = p.ssq(); E.biasq = p.biasq() + (size_t)l * BATCH * 2048; if (PROBE_MASK & 64) E.live = (rep == 1) || (p.out == nullptr); run_gemm(lds, p.hb(), p.WqT() + (size_t)l * 2048 * D_MODEL, NTOK, 2048, D_MODEL, E, wv); }
        GRID_SYNC_AT(5);
        PT_END(7); PT_BEGIN(8);
        for (int rep = 0; rep < ((PROBE_MASK & 4) ? 2 : 1); ++rep) phase_topk(p, l, lds, wv);
        GRID_SYNC_AT(6);
        PT_END(8); PT_BEGIN(9); PT_BEGIN(11);
        PT_BEGIN(12);
        if (PROBE_SYNTH) phase_expert(p, l, false, lds, wv, PROBE_SYNTH, true);
        PT_END(12);
        phase_expert(p, l, l == DEPTH - 1, lds, wv);
        PT_END(11);
        GRID_SYNC_AT(7);
        PT_END(9);
    }
#if PROBE_TIME || PROBE_UB
#ifdef PROBE_WAVE
    if (wv != PROBE_WAVE) pt_acc = 0;
#endif
    if (blockIdx.x == PROBE_BLOCK) {
        const unsigned long long t1 = __builtin_amdgcn_s_memrealtime();
        while (__builtin_amdgcn_s_memrealtime() - t1 < 4ull * pt_acc) __builtin_amdgcn_s_sleep(8);
    }
#endif
}
#if MK_MULTI
enum { PH_CONVERT = 0, PH_NORM1, PH_GEMM1, PH_GEMM2, PH_NORM2, PH_GEMM3, PH_MOD };
template <int PH>
__global__ void __launch_bounds__(512, 2) k_ph(Params p, int l) {
    extern __shared__ __attribute__((aligned(16))) unsigned char smem_raw[];
    LAS unsigned char* lds = (LAS unsigned char*)smem_raw;
    const int wv = __builtin_amdgcn_readfirstlane((int)threadIdx.x >> 6);
    const float* modl = p.mod() + (size_t)l * BATCH * MODW;
    if (PH == PH_CONVERT) phase_convert(p, lds, wv);
    if (PH == PH_MOD) phase_mod(p, lds, wv);
    if (PH == PH_NORM1) phase_norm(p, l == 0 ? p.x_in : p.xb(), p.norm1_g + l * D_MODEL, modl, 0, 1, wv);
    if (PH == PH_GEMM1) { EpiStoreBf16 E; E.O = p.pb(); E.ldc = MIX_IN; run_gemm(lds, p.hb(), p.WinT() + (size_t)l * MIX_IN * D_MODEL, NTOK, MIX_IN, D_MODEL, E, wv); }
    if (PH == PH_GEMM2) { EpiResid E; E.xin = (l == 0) ? p.x_in : p.xb(); E.xout = p.xb(); E.gate = modl + 2 * D_MODEL; run_gemm(lds, p.cat(), p.WoutT() + (size_t)l * D_MODEL * D_MODEL, NTOK, D_MODEL, D_MODEL, E, wv); }
    if (PH == PH_NORM2) phase_norm(p, p.xb(), p.norm2_g + l * D_MODEL, modl, 3, 4, wv);
    if (PH == PH_GEMM3) { EpiStoreBf16 E; E.O = p.qb(); E.ldc = 2048; run_gemm(lds, p.hb(), p.WqT() + (size_t)l * 2048 * D_MODEL, NTOK, 2048, D_MODEL, E, wv); }
}

#endif

extern "C" void kernel_launch(void* const* d_in, const int* in_sizes, int n_in, void* d_out, int out_size, void* d_ws, size_t ws_size, hipStream_t stream) {
    Params p{};
    p.x_in = (const float*)d_in[0]; p.c = (const float*)d_in[1]; p.rel_bias = (const float*)d_in[2]; p.w_mod = (const float*)d_in[3]; p.b_mod = (const float*)d_in[4];
    p.norm1_g = (const float*)d_in[5]; p.norm2_g = (const float*)d_in[6]; p.w_in = (const float*)d_in[7]; p.w_out = (const float*)d_in[8]; p.diff_lambda = (const float*)d_in[9];
    p.subln_g = (const float*)d_in[10]; p.conf_dw = (const float*)d_in[11]; p.conf_ln_g = (const float*)d_in[12]; p.conf_ln_b = (const float*)d_in[13]; p.sconv_w = (const float*)d_in[14];
    p.sgu_ln_g = (const float*)d_in[15]; p.sgu_ln_b = (const float*)d_in[16]; p.sgu_w = (const float*)d_in[17]; p.sgu_b = (const float*)d_in[18]; p.peer_wq = (const float*)d_in[19];
    p.peer_keys = (const float*)d_in[20]; p.peer_u = (const float*)d_in[21]; p.peer_v = (const float*)d_in[22]; p.final_g = (const float*)d_in[23];
    p.out = (float*)d_out;
    for (int l = 0; l < DEPTH; ++l) p.lam_init[l] = (float)(0.8 - 0.6 * exp(-0.3 * (double)l));

    p.ws = (unsigned char*)d_ws;
    if (ws_size < WS_END) { fprintf(stderr, "kernel_launch: workspace too small\n"); return; }

    static int grid = 0;
    if (grid == 0) {
        int dev = 0, cus = 0;
        if (hipGetDevice(&dev) != hipSuccess || hipDeviceGetAttribute(&cus, hipDeviceAttributeMultiprocessorCount, dev) != hipSuccess) { grid = -1; return; }
        bool ok = true;
#if MK_MULTI
        ok &= hipFuncSetAttribute((const void*)k_ph<PH_CONVERT>, hipFuncAttributeMaxDynamicSharedMemorySize, LDS_BYTES) == hipSuccess;
        ok &= hipFuncSetAttribute((const void*)k_ph<PH_NORM1>, hipFuncAttributeMaxDynamicSharedMemorySize, LDS_BYTES) == hipSuccess;
        ok &= hipFuncSetAttribute((const void*)k_ph<PH_GEMM1>, hipFuncAttributeMaxDynamicSharedMemorySize, LDS_BYTES) == hipSuccess;
        ok &= hipFuncSetAttribute((const void*)k_ph<PH_GEMM2>, hipFuncAttributeMaxDynamicSharedMemorySize, LDS_BYTES) == hipSuccess;
        ok &= hipFuncSetAttribute((const void*)k_ph<PH_NORM2>, hipFuncAttributeMaxDynamicSharedMemorySize, LDS_BYTES) == hipSuccess;
        ok &= hipFuncSetAttribute((const void*)k_ph<PH_GEMM3>, hipFuncAttributeMaxDynamicSharedMemorySize, LDS_BYTES) == hipSuccess;
        ok &= hipFuncSetAttribute((const void*)k_ph<PH_MOD>, hipFuncAttributeMaxDynamicSharedMemorySize, LDS_BYTES) == hipSuccess;
        ok &= hipFuncSetAttribute((const void*)k_attn2<0>, hipFuncAttributeMaxDynamicSharedMemorySize, LDS_BYTES) == hipSuccess;
        ok &= hipFuncSetAttribute((const void*)k_topk<0>, hipFuncAttributeMaxDynamicSharedMemorySize, LDS_BYTES) == hipSuccess;
        ok &= hipFuncSetAttribute((const void*)k_mixrest<0>, hipFuncAttributeMaxDynamicSharedMemorySize, LDS_BYTES) == hipSuccess;
        ok &= hipFuncSetAttribute((const void*)k_expert, hipFuncAttributeMaxDynamicSharedMemorySize, LDS_BYTES) == hipSuccess;
#else
        ok &= hipFuncSetAttribute((const void*)k_mega, hipFuncAttributeMaxDynamicSharedMemorySize, LDS_BYTES) == hipSuccess;
#endif
        if (!ok) { fprintf(stderr, "kernel_launch: hipFuncSetAttribute failed\n"); grid = -1; return; }
        grid = cus;
    }
    if (grid < 0) return;
    const int G = grid;
#if MK_MULTI
    k_ph<PH_MOD><<<G, 512, LDS_BYTES, stream>>>(p, 0);
    k_ph<PH_CONVERT><<<G, 512, LDS_BYTES, stream>>>(p, 0);
    for (int l = 0; l < DEPTH; ++l) {
        if (l == 0) k_ph<PH_NORM1><<<G, 512, LDS_BYTES, stream>>>(p, l);
        k_ph<PH_GEMM1><<<G, 512, LDS_BYTES, stream>>>(p, l);
        k_attn2<0><<<G, 512, LDS_BYTES, stream>>>(p, l);
        k_mixrest<0><<<G, 512, LDS_BYTES, stream>>>(p, l);
        k_ph<PH_GEMM2><<<G, 512, LDS_BYTES, stream>>>(p, l);
        k_ph<PH_NORM2><<<G, 512, LDS_BYTES, stream>>>(p, l);
        k_ph<PH_GEMM3><<<G, 512, LDS_BYTES, stream>>>(p, l);
        k_topk<0><<<G, 512, LDS_BYTES, stream>>>(p, l);
        k_expert<<<G, 512, LDS_BYTES, stream>>>(p, l);
    }
#else
    (void)hipMemsetAsync(p.ws + OFF_BAR, 0, OFF_MOD - OFF_BAR, stream);
    k_mega<<<G, 512, LDS_BYTES, stream>>>(p);
#endif
}
```
